# Optimizing an MI355X kernel written in HIP

```python
import math
import jax, jax.numpy as jnp
from jax import lax
import numpy as np

D_MODEL = 1024
BATCH = 8
SEQ = 2048
DEPTH = 1

ROPE_THETA = 500000.0
POS_OFFSET_MAX = 4096
MLA_HEADS = 8
MLA_NOPE = 64
MLA_ROPE = 32
MLA_V = 64
Q_LORA = 256
KV_LORA = 128
ATTN_QBLOCK = 128
MOBA_HEADS = 8
MOBA_HD = 64
MOBA_ROT = MOBA_HD // 4
MOBA_BLOCK = 256
MOBA_TOPK = 3
MOBA_QCHUNK = 128
MIX_WIDTH = MLA_HEADS * MLA_V + MOBA_HEADS * MOBA_HD
IN_COLS = Q_LORA + KV_LORA + MLA_ROPE + 3 * MOBA_HEADS * MOBA_HD
N_EXPERTS = 32
MOE_TOPK = 4
D_FF = 1024
SWIGLU_LIMIT = 7.0
SWIGLU_ALPHA = 1.702
MOE_BLOCK = 128
DN_ALPHA = (2.0 * DEPTH) ** 0.25
DN_BETA = (8.0 * DEPTH) ** -0.25

kernel_name = 'hymba_mla_moba_gptoss_deepnorm'


def _rms_norm(x, g, eps=1e-6):
    xf = x.astype(jnp.float32)
    y = xf * lax.rsqrt(jnp.mean(xf * xf, axis=-1, keepdims=True) + eps)
    return (y * g.astype(jnp.float32)).astype(x.dtype)


def _layer_norm(x, g, b, eps=1e-5):
    xf = x.astype(jnp.float32)
    mu = jnp.mean(xf, axis=-1, keepdims=True)
    var = jnp.mean(jnp.square(xf - mu), axis=-1, keepdims=True)
    y = (xf - mu) * lax.rsqrt(var + eps)
    return (y * g.astype(jnp.float32) + b.astype(jnp.float32)).astype(x.dtype)


def _rope_tables(positions, d_rot):
    inv_freq = ROPE_THETA ** (-jnp.arange(0, d_rot, 2, dtype=jnp.float32) / d_rot)
    ang = positions.astype(jnp.float32)[..., None] * inv_freq
    return jnp.cos(ang), jnp.sin(ang)


def _apply_rope(x, cos, sin):
    half = x.shape[-1] // 2
    x1, x2 = x[..., :half], x[..., half:]
    c = cos.astype(x.dtype)
    s = sin.astype(x.dtype)
    return jnp.concatenate([x1 * c - x2 * s, x2 * c + x1 * s], axis=-1)


def _mla(q_lat, kv_lat, k_rope_raw, cos, sin, q_a_norm, w_q_b, kv_a_norm, w_kv_b):
    B, T = q_lat.shape[:2]
    q = (_rms_norm(q_lat, q_a_norm) @ w_q_b).reshape(B, T, MLA_HEADS, MLA_NOPE + MLA_ROPE)
    q_nope = q[..., :MLA_NOPE]
    q_rope = _apply_rope(q[..., MLA_NOPE:], cos[:, :, None, :], sin[:, :, None, :])
    kv = (_rms_norm(kv_lat, kv_a_norm) @ w_kv_b).reshape(B, T, MLA_HEADS, MLA_NOPE + MLA_V)
    k_nope = kv[..., :MLA_NOPE].transpose(0, 2, 1, 3)
    v = kv[..., MLA_NOPE:].transpose(0, 2, 1, 3)
    k_rope = _apply_rope(k_rope_raw, cos, sin)
    nqb = T // ATTN_QBLOCK
    qn_b = q_nope.reshape(B, nqb, ATTN_QBLOCK, MLA_HEADS, MLA_NOPE).transpose(1, 0, 3, 2, 4)
    qr_b = q_rope.reshape(B, nqb, ATTN_QBLOCK, MLA_HEADS, MLA_ROPE).transpose(1, 0, 3, 2, 4)
    scale = 1.0 / math.sqrt(MLA_NOPE + MLA_ROPE)
    kpos = jnp.arange(T)

    def q_block(args):
        i, qn_i, qr_i = args
        s = (jnp.einsum('bhqd,bhkd->bhqk', qn_i, k_nope)
             + jnp.einsum('bhqd,bkd->bhqk', qr_i, k_rope)).astype(jnp.float32) * scale
        qpos = i * ATTN_QBLOCK + jnp.arange(ATTN_QBLOCK)
        s = jnp.where(kpos[None, :] <= qpos[:, None], s, -jnp.inf)
        p = jax.nn.softmax(s, axis=-1).astype(v.dtype)
        return jnp.einsum('bhqk,bhkd->bhqd', p, v)

    out = lax.map(q_block, (jnp.arange(nqb), qn_b, qr_b))
    return out.transpose(1, 0, 3, 2, 4).reshape(B, T, MLA_HEADS * MLA_V)


def _moba(q, k, v, cos, sin):
    B, T = q.shape[:2]
    H, d = MOBA_HEADS, MOBA_HD
    q = q.reshape(B, T, H, d)
    k = k.reshape(B, T, H, d)
    v = v.reshape(B, T, H, d)
    c4, s4 = cos[:, :, None, :], sin[:, :, None, :]
    q = jnp.concatenate([_apply_rope(q[..., :MOBA_ROT], c4, s4), q[..., MOBA_ROT:]], axis=-1)
    k = jnp.concatenate([_apply_rope(k[..., :MOBA_ROT], c4, s4), k[..., MOBA_ROT:]], axis=-1)
    q, k, v = (t.transpose(0, 2, 1, 3) for t in (q, k, v))
    nb = -(-T // MOBA_BLOCK)
    lp = nb * MOBA_BLOCK
    pad = ((0, 0), (0, 0), (0, lp - T), (0, 0))
    kblk = jnp.pad(k, pad).reshape(B, H, nb, MOBA_BLOCK, d)
    vblk = jnp.pad(v, pad).reshape(B, H, nb, MOBA_BLOCK, d)
    kmean = jnp.mean(kblk.astype(jnp.float32), axis=3)
    gate = jnp.einsum('bhtd,bhnd->bhtn', q.astype(jnp.float32), kmean)
    cur = jnp.arange(T) // MOBA_BLOCK
    gate = jnp.where(jnp.arange(nb)[None, :] < cur[:, None], gate, -jnp.inf)
    k_sel = min(MOBA_TOPK, nb)
    _, sel = lax.top_k(gate, k_sel)
    nqc = T // MOBA_QCHUNK
    q_items = q.reshape(B, H, nqc, MOBA_QCHUNK, d).transpose(0, 2, 1, 3, 4).reshape(B * nqc, H, MOBA_QCHUNK, d)
    sel_items = sel.reshape(B, H, nqc, MOBA_QCHUNK, k_sel).transpose(0, 2, 1, 3, 4).reshape(B * nqc, H, MOBA_QCHUNK, k_sel)
    scale = 1.0 / math.sqrt(d)
    hidx = jnp.arange(H)[:, None, None]

    def chunk(args):
        j, qc, selc = args
        b = j // nqc
        c = j % nqc
        kb = kblk[b]
        vb = vblk[b]
        ks = kb[hidx, selc]
        vs = vb[hidx, selc]
        qpos = c * MOBA_QCHUNK + jnp.arange(MOBA_QCHUNK)
        valid = jnp.arange(k_sel)[None, :] < (qpos // MOBA_BLOCK)[:, None]
        s_sel = jnp.einsum('hqd,hqkpd->hqkp', qc, ks).astype(jnp.float32) * scale
        s_sel = jnp.where(valid[None, :, :, None], s_sel, -jnp.inf).reshape(H, MOBA_QCHUNK, k_sel * MOBA_BLOCK)
        own = (c * MOBA_QCHUNK) // MOBA_BLOCK
        kown = lax.dynamic_index_in_dim(kb, own, axis=1, keepdims=False)
        vown = lax.dynamic_index_in_dim(vb, own, axis=1, keepdims=False)
        kpos = own * MOBA_BLOCK + jnp.arange(MOBA_BLOCK)
        s_own = jnp.einsum('hqd,hpd->hqp', qc, kown).astype(jnp.float32) * scale
        s_own = jnp.where(kpos[None, :] <= qpos[:, None], s_own, -jnp.inf)
        p = jax.nn.softmax(jnp.concatenate([s_sel, s_own], axis=-1), axis=-1).astype(vs.dtype)
        p_sel = p[..., :k_sel * MOBA_BLOCK].reshape(H, MOBA_QCHUNK, k_sel, MOBA_BLOCK)
        p_own = p[..., k_sel * MOBA_BLOCK:]
        return (jnp.einsum('hqkp,hqkpd->hqd', p_sel, vs)
                + jnp.einsum('hqp,hpd->hqd', p_own, vown))

    out = lax.map(chunk, (jnp.arange(B * nqc), q_items, sel_items))
    return out.reshape(B, nqc, H, MOBA_QCHUNK, d).transpose(0, 1, 3, 2, 4).reshape(B, T, H * d)


def _moe(x, w_router, b_router, w_gate, b_gate, w_up, b_up, w_down, b_down):
    B, T, D = x.shape
    n_tok = B * T
    xf = x.reshape(n_tok, D)
    logits = (xf @ w_router + b_router).astype(jnp.float32)
    top_vals, top_idx = lax.top_k(logits, MOE_TOPK)
    gates = jax.nn.softmax(top_vals, axis=-1)
    n_asg = n_tok * MOE_TOPK
    e_flat = top_idx.reshape(n_asg).astype(jnp.int32)
    order = jnp.argsort(e_flat, stable=True)
    sorted_e = e_flat[order]
    counts = jnp.bincount(e_flat, length=N_EXPERTS).astype(jnp.int32)
    padded = (counts + MOE_BLOCK - 1) // MOE_BLOCK * MOE_BLOCK
    pad_end = jnp.cumsum(padded).astype(jnp.int32)
    pad_start = pad_end - padded
    grp_start = (jnp.cumsum(counts) - counts).astype(jnp.int32)
    rank = jnp.arange(n_asg, dtype=jnp.int32) - grp_start[sorted_e]
    dest_sorted = (pad_start[sorted_e] + rank).astype(jnp.int32)
    dest = jnp.zeros((n_asg,), jnp.int32).at[order].set(dest_sorted)
    n_rows = n_asg + N_EXPERTS * MOE_BLOCK
    n_blk = n_rows // MOE_BLOCK
    row_tok = jnp.full((n_rows,), n_tok, jnp.int32).at[dest_sorted].set((order // MOE_TOPK).astype(jnp.int32))
    blk_start = jnp.arange(n_blk, dtype=jnp.int32) * MOE_BLOCK
    blk_expert = jnp.clip(jnp.searchsorted(pad_end, blk_start, side='right'), 0, N_EXPERTS - 1)
    x_pad = jnp.concatenate([xf, jnp.zeros((1, D), xf.dtype)], axis=0)

    def expert_block(args):
        e, rows = args
        xb = x_pad[rows]
        g = jnp.minimum(xb @ w_gate[e] + b_gate[e], SWIGLU_LIMIT)
        u = jnp.clip(xb @ w_up[e] + b_up[e], -SWIGLU_LIMIT, SWIGLU_LIMIT)
        h = g * jax.nn.sigmoid(SWIGLU_ALPHA * g) * (u + 1.0)
        return h @ w_down[e] + b_down[e]

    y_rows = lax.map(expert_block, (blk_expert, row_tok.reshape(n_blk, MOE_BLOCK))).reshape(n_rows, D)
    y = jnp.einsum('nk,nkd->nd', gates.astype(x.dtype), y_rows[dest.reshape(n_tok, MOE_TOPK)])
    return y.reshape(B, T, D)


def setup_inputs(seed: int = 0) -> dict:
    key = jax.random.key(seed)
    ks = jax.random.split(key, 32)
    L, D = DEPTH, D_MODEL
    nrm = jax.random.normal
    sD = D ** -0.5
    x = nrm(ks[0], (BATCH, SEQ, D), jnp.float32)
    offs = jax.random.randint(ks[1], (BATCH, 1), 0, POS_OFFSET_MAX, dtype=jnp.int32)
    positions = (offs + jnp.arange(SEQ, dtype=jnp.int32)[None, :]).astype(jnp.int32)
    mh = MOBA_HEADS * MOBA_HD
    w_in = jnp.concatenate([
        nrm(ks[2], (L, D, Q_LORA)) * sD,
        nrm(ks[3], (L, D, KV_LORA)) * sD,
        nrm(ks[4], (L, D, MLA_ROPE)) * sD,
        nrm(ks[5], (L, D, mh)) * sD,
        nrm(ks[6], (L, D, mh)) * sD,
        nrm(ks[7], (L, D, mh)) * sD * DN_BETA,
    ], axis=-1)
    q_a_norm = 1.0 + 0.01 * nrm(ks[8], (L, Q_LORA))
    w_q_b = nrm(ks[9], (L, Q_LORA, MLA_HEADS * (MLA_NOPE + MLA_ROPE))) * Q_LORA ** -0.5
    kv_a_norm = 1.0 + 0.01 * nrm(ks[10], (L, KV_LORA))
    wk_b = nrm(ks[11], (L, KV_LORA, MLA_HEADS, MLA_NOPE)) * KV_LORA ** -0.5
    wv_b = nrm(ks[12], (L, KV_LORA, MLA_HEADS, MLA_V)) * KV_LORA ** -0.5 * DN_BETA
    w_kv_b = jnp.concatenate([wk_b, wv_b], axis=-1).reshape(L, KV_LORA, MLA_HEADS * (MLA_NOPE + MLA_V))
    w_o = nrm(ks[13], (L, MIX_WIDTH, D)) * MIX_WIDTH ** -0.5 * DN_BETA
    ln1_g = 1.0 + 0.01 * nrm(ks[14], (L, D))
    ln1_b = 0.01 * nrm(ks[15], (L, D))
    w_router = nrm(ks[16], (L, D, N_EXPERTS)) * sD
    b_router = 0.01 * nrm(ks[17], (L, N_EXPERTS))
    w_gate = nrm(ks[18], (L, N_EXPERTS, D, D_FF)) * sD
    b_gate = 0.01 * nrm(ks[19], (L, N_EXPERTS, D_FF))
    w_up = nrm(ks[20], (L, N_EXPERTS, D, D_FF)) * sD
    b_up = 0.01 * nrm(ks[21], (L, N_EXPERTS, D_FF))
    w_down = nrm(ks[22], (L, N_EXPERTS, D_FF, D)) * D_FF ** -0.5 * DN_BETA
    b_down = 0.01 * nrm(ks[23], (L, N_EXPERTS, D))
    ln2_g = 1.0 + 0.01 * nrm(ks[24], (L, D))
    ln2_b = 0.01 * nrm(ks[25], (L, D))
    return {'x': x, 'positions': positions, 'w_in': w_in, 'q_a_norm': q_a_norm, 'w_q_b': w_q_b,
            'kv_a_norm': kv_a_norm, 'w_kv_b': w_kv_b, 'w_o': w_o, 'ln1_g': ln1_g, 'ln1_b': ln1_b,
            'w_router': w_router, 'b_router': b_router, 'w_gate': w_gate, 'b_gate': b_gate,
            'w_up': w_up, 'b_up': b_up, 'w_down': w_down, 'b_down': b_down,
            'ln2_g': ln2_g, 'ln2_b': ln2_b}


def reference(x, positions, w_in, q_a_norm, w_q_b, kv_a_norm, w_kv_b, w_o, ln1_g, ln1_b,
              w_router, b_router, w_gate, b_gate, w_up, b_up, w_down, b_down, ln2_g, ln2_b):
    cos_a, sin_a = _rope_tables(positions, MLA_ROPE)
    cos_b, sin_b = _rope_tables(positions, MOBA_ROT)
    o1 = Q_LORA
    o2 = o1 + KV_LORA
    o3 = o2 + MLA_ROPE
    mh = MOBA_HEADS * MOBA_HD
    h = x
    for l in range(DEPTH):
        proj = h @ w_in[l]
        a = _mla(proj[..., :o1], proj[..., o1:o2], proj[..., o2:o3], cos_a, sin_a,
                 q_a_norm[l], w_q_b[l], kv_a_norm[l], w_kv_b[l])
        m = _moba(proj[..., o3:o3 + mh], proj[..., o3 + mh:o3 + 2 * mh], proj[..., o3 + 2 * mh:],
                  cos_b, sin_b)
        mix = jnp.concatenate([a, m], axis=-1) @ w_o[l]
        h = _layer_norm(DN_ALPHA * h + mix, ln1_g[l], ln1_b[l])
        ffn = _moe(h, w_router[l], b_router[l], w_gate[l], b_gate[l], w_up[l], b_up[l], w_down[l], b_down[l])
        h = _layer_norm(DN_ALPHA * h + ffn, ln2_g[l], ln2_b[l])
    return h
```

```cpp
#include <hip/hip_runtime.h>
#include <cstdio>
#include <cstdint>
#include <cmath>

#ifndef MK_ONE_LAUNCH
#define MK_ONE_LAUNCH 0
#endif

#define GAS __attribute__((address_space(1)))
#define LAS __attribute__((address_space(3)))
typedef unsigned short bf16_t;
typedef short bf16x8 __attribute__((ext_vector_type(8)));
typedef float f32x4 __attribute__((ext_vector_type(4)));
typedef float f32x2 __attribute__((ext_vector_type(2)));
typedef unsigned u32x4 __attribute__((ext_vector_type(4)));
typedef unsigned u32x2 __attribute__((ext_vector_type(2)));

constexpr int NTOK = 16384, DM = 1024, SEQ = 2048, NBATCH = 8;
constexpr int PN = 2048;
constexpr int C_QL = 0, C_KVL = 256, C_KR = 384, C_MQ = 416, C_MK = 928, C_MV = 1440, IN_COLS = 1952;
constexpr int NUP = 1792, KUP = 384;
constexpr int NE = 32, TOPK = 4;
constexpr int MAXROWS = 65536 + NE * 256, MAXTILES = MAXROWS / 256;
constexpr int NCHUNK = NTOK / 64;
constexpr float LN_EPS = 1e-5f, RMS_EPS = 1e-6f;
constexpr float DN_ALPHA = 1.189207115002721f;
constexpr float LOG2E = 1.4426950408889634f;
constexpr float C2A = 0.10206207261596575f * LOG2E;
constexpr float C2B = 0.125f * LOG2E;
constexpr int NWAVES = 8, NTHREADS = 512;

constexpr size_t MiB = 1u << 20;
constexpr size_t WS_CTL = 0, CTL_ZERO_BYTES = 1 * MiB;
constexpr size_t WS_HIST = 1 * MiB;
constexpr size_t WS_TIDX = WS_HIST + 64 * 1024;
constexpr size_t WS_TGATE = WS_TIDX + 256 * 1024;
constexpr size_t WS_DEST = WS_TGATE + 256 * 1024;
constexpr size_t WS_ROWTOK = WS_DEST + 256 * 1024;
constexpr size_t WS_ROWGATE = WS_ROWTOK + 288 * 1024;
constexpr size_t WS_TILEE = WS_ROWGATE + 288 * 1024;
constexpr size_t WS_RSTD = WS_TILEE + 4 * 1024;
constexpr size_t WS_KMEAN = WS_RSTD + 128 * 1024;
static_assert(WS_KMEAN + 128 * 1024 <= 4 * MiB, "route region");
constexpr size_t WS_ROPEA = 4 * MiB;
constexpr size_t WS_ROPEB = 6 * MiB;
constexpr size_t WS_WIN = 8 * MiB;
constexpr size_t WS_WO = 12 * MiB;
constexpr size_t WS_WUP = 14 * MiB;
constexpr size_t WS_X1B = 16 * MiB;
constexpr size_t WS_WD = 48 * MiB;
constexpr size_t WS_XB = 112 * MiB;
constexpr size_t WS_PROJ = 144 * MiB;
constexpr size_t WS_QM = 208 * MiB;
constexpr size_t WS_KM = 232 * MiB;
constexpr size_t WS_VM = 256 * MiB;
constexpr size_t WS_QB = 272 * MiB;
constexpr size_t WS_KB = 288 * MiB;
constexpr size_t WS_ATT = 304 * MiB;
constexpr size_t WS_H = 112 * MiB;
constexpr size_t WS_WGU = 336 * MiB;
constexpr size_t WS_Y = 336 * MiB;
constexpr size_t WS_END = 480 * MiB;
static_assert(WS_H + (size_t)MAXROWS * 1024 * 2 <= WS_VM + 0 * MiB + 0 && WS_Y + (size_t)MAXROWS * 1024 * 2 <= WS_END, "ws map");
constexpr int CW_BAR = 4096;

constexpr int LDS_BYTES = 147456;
constexpr int MISC_OFF = 131072 + 320;

__device__ __forceinline__ float bf2f(unsigned v) { return __uint_as_float(v << 16); }
__device__ __forceinline__ unsigned f2bf(float f) { unsigned u = __float_as_uint(f); return (u + 0x7fffu + ((u >> 16) & 1u)) >> 16; }
__device__ __forceinline__ unsigned pk2(float lo, float hi) { return f2bf(lo) | (f2bf(hi) << 16); }
__device__ __forceinline__ float wave_sum(float v) {
#pragma unroll
    for (int o = 1; o < 64; o <<= 1) v += __shfl_xor(v, o);
    return v;
}
__device__ __forceinline__ float wave_max(float v) {
#pragma unroll
    for (int o = 1; o < 64; o <<= 1) v = fmaxf(v, __shfl_xor(v, o));
    return v;
}

#define XB_TMO      128
#define XB_XCNT(j)  (256  + 64 * (j))
#define XB_XSUB(j)  (1280 + 64 * (j))
#define XB_XGEN(j)  (2304 + 64 * (j))
#define XB_TOP      3328
#define XB_TOPGEN   3392
#define XCD_BAR_WORDS 3456
#define XB_SPIN_CAP (1u << 18)
__device__ __forceinline__ unsigned xb_ld(unsigned* p)              { return __hip_atomic_load(p, __ATOMIC_RELAXED, __HIP_MEMORY_SCOPE_AGENT); }
__device__ __forceinline__ unsigned xb_add(unsigned* p, unsigned v) { return __hip_atomic_fetch_add(p, v, __ATOMIC_RELAXED, __HIP_MEMORY_SCOPE_AGENT); }
__device__ __forceinline__ unsigned xb_xcc_id() { return (unsigned)__builtin_amdgcn_s_getreg((3 << 11) | 20) & 0xFu; }
#define XB_SPIN(cond, bar) do { unsigned _sp = 0; while (cond) { __builtin_amdgcn_s_sleep(1); \
    if ((++_sp & 255u) == 0u) { if (xb_ld(&(bar)[XB_TMO])) break; if (_sp > XB_SPIN_CAP) { atomicAdd(&(bar)[XB_TMO], 1u); break; } } } } while (0)
struct XcdBarrier { unsigned* bar; unsigned x; volatile LAS unsigned* st; };
__device__ __forceinline__ XcdBarrier xcd_barrier_post(unsigned* bar, volatile LAS unsigned* st) {
    XcdBarrier b; b.bar = bar; b.x = xb_xcc_id(); b.st = st;
    if (threadIdx.x == 0) (void)xb_add(&bar[XB_XCNT(b.x)], 1u);
    return b;
}
__device__ __forceinline__ void xcd_barrier_complete(unsigned* bar, unsigned x, unsigned& nloc, unsigned& nx) {
    const unsigned G = gridDim.x * gridDim.y * gridDim.z;
    unsigned sum, cnt, mine, sp = 0u;
    for (;;) {
        sum = 0u; cnt = 0u; mine = 0u;
#pragma unroll
        for (unsigned j = 0; j < 16; ++j) { const unsigned c = xb_ld(&bar[XB_XCNT(j)]); sum += c; cnt += (c > 0u) ? 1u : 0u; mine = (j == x) ? c : mine; }
        if (sum == G) break;
        __builtin_amdgcn_s_sleep(1);
        if ((++sp & 255u) == 0u) { if (xb_ld(&bar[XB_TMO])) break; if (sp > XB_SPIN_CAP) { atomicAdd(&bar[XB_TMO], 1u); break; } }
    }
    nloc = mine > 0u ? mine : 1u; nx = cnt > 0u ? cnt : 1u;
}
__device__ __forceinline__ void xcd_barrier(const XcdBarrier& b) {
    asm volatile("s_waitcnt vmcnt(0)" ::: "memory");
    __syncthreads();
    if (threadIdx.x == 0) {
        unsigned* bar = b.bar;
        __builtin_amdgcn_s_waitcnt(0);
        unsigned nloc = b.st[0], nx = b.st[1];
        if (nloc == 0u) { xcd_barrier_complete(bar, b.x, nloc, nx); b.st[0] = nloc; b.st[1] = nx; }
        const unsigned old = xb_add(&bar[XB_XSUB(b.x)], 1u);
        const unsigned gen = old / nloc;
        if (old + 1u == (gen + 1u) * nloc) {
            __builtin_amdgcn_fence(__ATOMIC_RELEASE, "agent");
            asm volatile("s_waitcnt vmcnt(0)" ::: "memory");
            const unsigned og = xb_add(&bar[XB_TOP], 1u);
            const unsigned tg = og / nx;
            if (og + 1u == (tg + 1u) * nx) xb_add(&bar[XB_TOPGEN], 1u);
            else XB_SPIN(xb_ld(&bar[XB_TOPGEN]) == tg, bar);
            __builtin_amdgcn_fence(__ATOMIC_ACQUIRE, "agent");
            xb_add(&bar[XB_XGEN(b.x)], 1u);
            asm volatile("s_waitcnt vmcnt(0)" ::: "memory");
        } else {
            XB_SPIN(xb_ld(&bar[XB_XGEN(b.x)]) == gen, bar);
            __builtin_amdgcn_fence(__ATOMIC_ACQUIRE, "agent");
            asm volatile("s_waitcnt vmcnt(0)" ::: "memory");
        }
    }
    __syncthreads();
}

struct Params {
    const float* x; const int* pos;
    const float *w_in, *q_a_norm, *w_q_b, *kv_a_norm, *w_kv_b, *w_o, *ln1_g, *ln1_b, *w_router, *b_router;
    const float *w_gate, *b_gate, *w_up, *b_up, *w_down, *b_down, *ln2_g, *ln2_b;
    float* out; unsigned char* ws;
    double invfA[16]; double invfB[8];
    int ph_lo, ph_hi;
};

struct Unit { int pm, pn, e; };
struct GemmArgs { const bf16_t* A; int lda; const bf16_t* Bt; int ldb; int K; };
template <bool PERM> __device__ __forceinline__ int ecol(int bj, int n, int wc, int fq) { return 128 * bj + 32 * wc + (PERM ? 8 * fq + 4 * n : 16 * n + 4 * fq); }

template <class Epi, class Sched>
__device__ __forceinline__ void gemm_phase(LAS unsigned char* lds, const GemmArgs g, const Sched& S, const Epi& E) {
    const int tid = threadIdx.x, wid = __builtin_amdgcn_readfirstlane(tid >> 6), lane = tid & 63, wr = wid >> 2, wc = wid & 3, fr = lane & 15, fq = lane >> 4;
    Unit u;
    for (int ui = 0; S.next(ui, u); ++ui) {
        f32x4 acc[2][2][4][2];
#pragma unroll
        for (int a = 0; a < 2; ++a)
#pragma unroll
            for (int b = 0; b < 2; ++b)
#pragma unroll
                for (int m = 0; m < 4; ++m)
#pragma unroll
                    for (int n = 0; n < 2; ++n) acc[a][b][m][n] = (f32x4){0.f, 0.f, 0.f, 0.f};
        unsigned aoff[2][4];
#pragma unroll
        for (int a = 0; a < 2; ++a)
#pragma unroll
            for (int m = 0; m < 4; ++m) aoff[a][m] = (unsigned)S.arow(u, 128 * a + 64 * wr + 16 * m + fr) * (unsigned)g.lda;
        const bf16_t* bb = g.Bt + (size_t)(S.brow0(u) + 32 * wc) * g.ldb;
        const unsigned bl0 = (unsigned)(4 * fq) * (unsigned)g.ldb, bl1 = (unsigned)(8 * fq) * (unsigned)g.ldb;
#pragma unroll 1
        for (int k = 0; k < g.K; k += 2) {
            float af[2][4][2];
#pragma unroll
            for (int a = 0; a < 2; ++a)
#pragma unroll
                for (int m = 0; m < 4; ++m) { const unsigned v = *(const unsigned*)(g.A + aoff[a][m] + k); af[a][m][0] = __uint_as_float(v << 16); af[a][m][1] = __uint_as_float(v & 0xffff0000u); }
#pragma unroll
            for (int b = 0; b < 2; ++b)
#pragma unroll
                for (int n = 0; n < 2; ++n)
#pragma unroll
                    for (int j = 0; j < 4; ++j) {
                        const int ccol = 128 * b + (Epi::PERM ? 4 * n : 16 * n) + j;
                        const unsigned v = *(const unsigned*)(bb + (size_t)ccol * g.ldb + ((Epi::PERM ? bl1 : bl0) + (unsigned)k));
                        const float b0 = __uint_as_float(v << 16), b1 = __uint_as_float(v & 0xffff0000u);
#pragma unroll
                        for (int a = 0; a < 2; ++a)
#pragma unroll
                            for (int m = 0; m < 4; ++m) acc[a][b][m][n][j] = fmaf(af[a][m][1], b1, fmaf(af[a][m][0], b0, acc[a][b][m][n][j]));
                    }
        }
        E(acc, u, wr, wc, fr, fq);
    }
}

struct DenseSched {
    int nN, nunits, G, c;
    __device__ __forceinline__ void init(int M, int N, int G_, int c_) { nN = N / 256; nunits = (M / 256) * nN; G = G_; c = c_; }
    __device__ __forceinline__ bool next(int i, Unit& u) const { const int L = i * G + c; if (L >= nunits) return false; u.pm = L / nN; u.pn = L % nN; u.e = 0; return true; }
    __device__ __forceinline__ int arow(const Unit& u, int r) const { return 256 * u.pm + r; }
    __device__ __forceinline__ int brow0(const Unit& u) const { return 256 * u.pn; }
};
template <bool GATHER> struct GroupSched {
    const int* tile_e; const int* row_tok; int nN, nexp_rows, nunits, G, c;
    __device__ __forceinline__ void init(const int* te, const int* rt, int nN_, int nexp_rows_, int G_, int c_) { tile_e = te; row_tok = rt; nN = nN_; nexp_rows = nexp_rows_; nunits = te[MAXTILES] * nN_; G = G_; c = c_; }
    __device__ __forceinline__ bool next(int i, Unit& u) const { const int L = i * G + c; if (L >= nunits) return false; u.pm = L / nN; u.pn = L % nN; u.e = tile_e[u.pm]; return true; }
    __device__ __forceinline__ int arow(const Unit& u, int r) const { return GATHER ? row_tok[256 * u.pm + r] : 256 * u.pm + r; }
    __device__ __forceinline__ int brow0(const Unit& u) const { return u.e * nexp_rows + 256 * u.pn; }
};

struct EpiProj {
    static constexpr bool PERM = false;
    bf16_t* O;
    __device__ __forceinline__ void operator()(const f32x4 (&acc)[2][2][4][2], const Unit& u, int wr, int wc, int fr, int fq) const {
#pragma unroll
        for (int a = 0; a < 2; ++a)
#pragma unroll
            for (int m = 0; m < 4; ++m) { const int row = 256 * u.pm + 128 * a + 64 * wr + 16 * m + fr;
#pragma unroll
                for (int b = 0; b < 2; ++b)
#pragma unroll
                    for (int n = 0; n < 2; ++n) { const int col = 256 * u.pn + ecol<PERM>(b, n, wc, fq); const f32x4 v = acc[a][b][m][n];
                        u32x2 w; w.x = pk2(v[0], v[1]); w.y = pk2(v[2], v[3]); *(u32x2*)(O + (size_t)row * PN + col) = w; } }
    }
};
struct EpiUp {
    static constexpr bool PERM = false;
    bf16_t *QM, *KM, *VM; const float* rstd; const float* ropeA;
    __device__ __forceinline__ void operator()(const f32x4 (&acc)[2][2][4][2], const Unit& u, int wr, int wc, int fr, int fq) const {
#pragma unroll
        for (int a = 0; a < 2; ++a)
#pragma unroll
            for (int m = 0; m < 4; ++m) { const int row = 256 * u.pm + 128 * a + 64 * wr + 16 * m + fr;
                const float rq = rstd[2 * row] * C2A, rkv = rstd[2 * row + 1];
#pragma unroll
                for (int b = 0; b < 2; ++b) {
                    const int gidx = 8 * u.pn + 4 * b + wc;
                    if (gidx < 24) {
                        const int h = gidx / 3, part = gidx % 3;
                        f32x4 v0 = acc[a][b][m][0] * rq, v1 = acc[a][b][m][1] * rq;
                        if (part == 2) { const f32x4 c = *(const f32x4*)(ropeA + (size_t)row * 32 + 4 * fq), s = *(const f32x4*)(ropeA + (size_t)row * 32 + 16 + 4 * fq);
                            const f32x4 o0 = v0 * c - v1 * s, o1 = v1 * c + v0 * s; v0 = o0; v1 = o1; }
                        bf16_t* p = QM + (size_t)row * 768 + h * 96 + part * 32 + 4 * fq;
                        u32x2 w; w.x = pk2(v0[0], v0[1]); w.y = pk2(v0[2], v0[3]); *(u32x2*)p = w;
                        w.x = pk2(v1[0], v1[1]); w.y = pk2(v1[2], v1[3]); *(u32x2*)(p + 16) = w;
                    } else {
                        const int g2 = gidx - 24, h = g2 >> 2, part = g2 & 3;
                        const f32x4 v0 = acc[a][b][m][0] * rkv, v1 = acc[a][b][m][1] * rkv;
                        bf16_t* p = (part < 2) ? (KM + (size_t)row * 768 + h * 96 + part * 32 + 4 * fq) : (VM + (size_t)row * 512 + h * 64 + (part - 2) * 32 + 4 * fq);
                        u32x2 w; w.x = pk2(v0[0], v0[1]); w.y = pk2(v0[2], v0[3]); *(u32x2*)p = w;
                        w.x = pk2(v1[0], v1[1]); w.y = pk2(v1[2], v1[3]); *(u32x2*)(p + 16) = w;
                    }
                } }
    }
};
struct EpiWo {
    static constexpr bool PERM = false;
    const float* x; float* O;
    __device__ __forceinline__ void operator()(const f32x4 (&acc)[2][2][4][2], const Unit& u, int wr, int wc, int fr, int fq) const {
#pragma unroll
        for (int a = 0; a < 2; ++a)
#pragma unroll
            for (int m = 0; m < 4; ++m) { const int row = 256 * u.pm + 128 * a + 64 * wr + 16 * m + fr;
#pragma unroll
                for (int b = 0; b < 2; ++b)
#pragma unroll
                    for (int n = 0; n < 2; ++n) { const size_t off = (size_t)row * DM + 256 * u.pn + ecol<PERM>(b, n, wc, fq);
                        const f32x4 xv = *(const f32x4*)(x + off); *(f32x4*)(O + off) = xv * DN_ALPHA + acc[a][b][m][n]; } }
    }
};
struct EpiGateUp {
    static constexpr bool PERM = false;
    bf16_t* H; const float *bg, *bu;
    __device__ __forceinline__ void operator()(const f32x4 (&acc)[2][2][4][2], const Unit& u, int wr, int wc, int fr, int fq) const {
#pragma unroll
        for (int n = 0; n < 2; ++n) { const int hc = 128 * u.pn + 32 * wc + 16 * n + 4 * fq;
            const f32x4 vbg = *(const f32x4*)(bg + (size_t)u.e * 1024 + hc), vbu = *(const f32x4*)(bu + (size_t)u.e * 1024 + hc);
#pragma unroll
            for (int a = 0; a < 2; ++a)
#pragma unroll
                for (int m = 0; m < 4; ++m) { const int row = 256 * u.pm + 128 * a + 64 * wr + 16 * m + fr;
                    const f32x4 gv = acc[a][0][m][n] + vbg, uv = acc[a][1][m][n] + vbu; float hv[4];
#pragma unroll
                    for (int j = 0; j < 4; ++j) { const float gg = fminf(gv[j], 7.0f), uu = fminf(fmaxf(uv[j], -7.0f), 7.0f);
                        const float sg = 1.0f / (1.0f + __builtin_amdgcn_exp2f(-1.702f * LOG2E * gg)); hv[j] = gg * sg * (uu + 1.0f); }
                    u32x2 w; w.x = pk2(hv[0], hv[1]); w.y = pk2(hv[2], hv[3]); *(u32x2*)(H + (size_t)row * 1024 + hc) = w; } }
    }
};
struct EpiDown {
    static constexpr bool PERM = false;
    bf16_t* Y; const float* bd; const float* row_gate;
    __device__ __forceinline__ void operator()(const f32x4 (&acc)[2][2][4][2], const Unit& u, int wr, int wc, int fr, int fq) const {
#pragma unroll
        for (int a = 0; a < 2; ++a)
#pragma unroll
            for (int m = 0; m < 4; ++m) { const int row = 256 * u.pm + 128 * a + 64 * wr + 16 * m + fr; const float gw = row_gate[row];
#pragma unroll
                for (int b = 0; b < 2; ++b)
#pragma unroll
                    for (int n = 0; n < 2; ++n) { const int col = 256 * u.pn + ecol<PERM>(b, n, wc, fq); const f32x4 bv = *(const f32x4*)(bd + (size_t)u.e * 1024 + col);
                        const f32x4 v = (acc[a][b][m][n] + bv) * gw; u32x2 w; w.x = pk2(v[0], v[1]); w.y = pk2(v[2], v[3]); *(u32x2*)(Y + (size_t)row * 1024 + col) = w; } }
    }
};

__device__ __forceinline__ void tr_item(const float* W, int ldw, int k0, int n0, bf16_t* WT, int ldt, int orow0, int ocol0, const float* kscale, LAS float* scr, int lane) {
#pragma unroll 8
    for (int i = 0; i < 32; ++i) { const int kk = 2 * i + (lane >> 5); float v = W[(size_t)(k0 + kk) * ldw + n0 + (lane & 31)]; if (kscale) v *= kscale[k0 + kk]; scr[kk * 33 + (lane & 31)] = v; }
    asm volatile("s_waitcnt lgkmcnt(0)" ::: "memory");
    const int c = lane & 7;
#pragma unroll
    for (int j = 0; j < 4; ++j) { const int n = (lane >> 3) + 8 * j; const LAS float* s = scr + (8 * c) * 33 + n;
        u32x4 o; o.x = pk2(s[0 * 33], s[1 * 33]); o.y = pk2(s[2 * 33], s[3 * 33]); o.z = pk2(s[4 * 33], s[5 * 33]); o.w = pk2(s[6 * 33], s[7 * 33]);
        *(u32x4*)(WT + (size_t)(orow0 + n) * ldt + ocol0 + 8 * c) = o; }
    asm volatile("s_waitcnt lgkmcnt(0)" ::: "memory");
}
__device__ __forceinline__ void phase_prologue(const Params& p, LAS unsigned char* lds, int vcu, int G) {
    const int tid = threadIdx.x, wave = tid >> 6, lane = tid & 63;
    unsigned char* ws = p.ws;
    LAS float* scr = (LAS float*)(lds + wave * 16384);
    const int gw = vcu * NWAVES + wave, NGW = G * NWAVES;
    bf16_t* WinT = (bf16_t*)(ws + WS_WIN); bf16_t* WoT = (bf16_t*)(ws + WS_WO); bf16_t* WupT = (bf16_t*)(ws + WS_WUP);
    bf16_t* WguT = (bf16_t*)(ws + WS_WGU); bf16_t* WdT = (bf16_t*)(ws + WS_WD);
    constexpr int I_IN = 16 * 61, I_QB = 4 * 24, I_KVB = 2 * 32, I_O = 16 * 32, I_E = 16 * 32;
    constexpr int NITEMS = I_IN + I_QB + I_KVB + I_O + 3 * NE * I_E;
    for (int it = gw; it < NITEMS; it += NGW) {
        int r = it;
        if (r < I_IN) { const int kb = r / 61, nb = r % 61; tr_item(p.w_in, IN_COLS, 64 * kb, 32 * nb, WinT, 1024, 32 * nb, 64 * kb, nullptr, scr, lane); continue; } r -= I_IN;
        if (r < I_QB) { const int kb = r / 24, nb = r % 24; tr_item(p.w_q_b, 768, 64 * kb, 32 * nb, WupT, KUP, 32 * nb, 64 * kb, p.q_a_norm, scr, lane); continue; } r -= I_QB;
        if (r < I_KVB) { const int kb = r / 32, nb = r % 32; tr_item(p.w_kv_b, 1024, 64 * kb, 32 * nb, WupT, KUP, 768 + 32 * nb, 256 + 64 * kb, p.kv_a_norm, scr, lane); continue; } r -= I_KVB;
        if (r < I_O) { const int kb = r / 32, nb = r % 32; tr_item(p.w_o, 1024, 64 * kb, 32 * nb, WoT, 1024, 32 * nb, 64 * kb, nullptr, scr, lane); continue; } r -= I_O;
        const int mat = r / (NE * I_E), rr = r % (NE * I_E), e = rr / I_E, q = rr % I_E, kb = q / 32, nb = q % 32, n0 = 32 * nb;
        if (mat == 0) tr_item(p.w_gate + (size_t)e * 1048576, 1024, 64 * kb, n0, WguT, 1024, e * 2048 + (n0 >> 7) * 256 + (n0 & 127), 64 * kb, nullptr, scr, lane);
        else if (mat == 1) tr_item(p.w_up + (size_t)e * 1048576, 1024, 64 * kb, n0, WguT, 1024, e * 2048 + (n0 >> 7) * 256 + 128 + (n0 & 127), 64 * kb, nullptr, scr, lane);
        else tr_item(p.w_down + (size_t)e * 1048576, 1024, 64 * kb, n0, WdT, 1024, e * 1024 + n0, 64 * kb, nullptr, scr, lane);
    }
    const int gt = vcu * NTHREADS + tid, NGT = G * NTHREADS;
    for (int i = gt; i < 96 * 128; i += NGT) *(u32x4*)(WinT + (size_t)IN_COLS * 1024 + (size_t)i * 8) = (u32x4){0u, 0u, 0u, 0u};
    for (int i = gt; i < 768 * 16; i += NGT) { const int r = i / 16, c = i % 16; *(u32x4*)(WupT + (size_t)r * KUP + 256 + c * 8) = (u32x4){0u, 0u, 0u, 0u}; }
    for (int i = gt; i < 1024 * 32; i += NGT) { const int r = i / 32, c = i % 32; *(u32x4*)(WupT + (size_t)(768 + r) * KUP + c * 8) = (u32x4){0u, 0u, 0u, 0u}; }
    bf16_t* XB = (bf16_t*)(ws + WS_XB);
    for (int i = gt; i < NTOK * DM / 8; i += NGT) { const f32x4 a = *(const f32x4*)(p.x + (size_t)i * 8), b = *(const f32x4*)(p.x + (size_t)i * 8 + 4);
        u32x4 o; o.x = pk2(a[0], a[1]); o.y = pk2(a[2], a[3]); o.z = pk2(b[0], b[1]); o.w = pk2(b[2], b[3]); *(u32x4*)(XB + (size_t)i * 8) = o; }
    float* ropeA = (float*)(ws + WS_ROPEA); float* ropeB = (float*)(ws + WS_ROPEB);
    for (int i = gt; i < NTOK * 24; i += NGT) { const int tok = i / 24, j = i % 24; const double f = (j < 16) ? p.invfA[j] : p.invfB[j - 16];
        const double rev = (double)p.pos[tok] * f * 0.15915494309189535; const float fr = (float)(rev - __builtin_rint(rev));
        const float cs = __builtin_amdgcn_cosf(fr), sn = __builtin_amdgcn_sinf(fr);
        if (j < 16) { ropeA[(size_t)tok * 32 + j] = cs; ropeA[(size_t)tok * 32 + 16 + j] = sn; } else { ropeB[(size_t)tok * 16 + (j - 16)] = cs; ropeB[(size_t)tok * 16 + 8 + (j - 16)] = sn; } }
}

__device__ __forceinline__ void phase_prep(const Params& p, LAS unsigned char* lds, int vcu, int G) {
    const int tid = threadIdx.x, wave = tid >> 6, lane = tid & 63;
    unsigned char* ws = p.ws;
    const bf16_t* PROJ = (const bf16_t*)(ws + WS_PROJ);
    float* rstd = (float*)(ws + WS_RSTD); const float* ropeA = (const float*)(ws + WS_ROPEA); const float* ropeB = (const float*)(ws + WS_ROPEB);
    bf16_t* KM = (bf16_t*)(ws + WS_KM); bf16_t* QB = (bf16_t*)(ws + WS_QB); bf16_t* KB = (bf16_t*)(ws + WS_KB); float* kmean = (float*)(ws + WS_KMEAN);
    const int gw = vcu * NWAVES + wave, NGW = G * NWAVES;
    for (int row = gw; row < NTOK; row += NGW) {
        float s = 0.f;
        if (lane < 48) { const u32x4 v = *(const u32x4*)(PROJ + (size_t)row * PN + lane * 8);
#pragma unroll
            for (int q = 0; q < 4; ++q) { const float a = __uint_as_float(v[q] << 16), b = __uint_as_float(v[q] & 0xffff0000u); s += a * a + b * b; } }
#pragma unroll
        for (int o = 1; o < 32; o <<= 1) s += __shfl_xor(s, o);
        if (lane == 0) rstd[2 * row] = 1.0f / sqrtf(s * (1.0f / 256.0f) + RMS_EPS);
        if (lane == 32) rstd[2 * row + 1] = 1.0f / sqrtf(s * (1.0f / 128.0f) + RMS_EPS);
    }
    const int gt = vcu * NTHREADS + tid, NGT = G * NTHREADS;
    for (int i = gt; i < NTOK * 16; i += NGT) { const int tok = i >> 4, j = i & 15;
        const float x1 = bf2f(PROJ[(size_t)tok * PN + C_KR + j]), x2 = bf2f(PROJ[(size_t)tok * PN + C_KR + 16 + j]);
        const float c = ropeA[(size_t)tok * 32 + j], s = ropeA[(size_t)tok * 32 + 16 + j];
        const bf16_t o1 = (bf16_t)f2bf(x1 * c - x2 * s), o2 = (bf16_t)f2bf(x2 * c + x1 * s);
#pragma unroll
        for (int h = 0; h < 8; ++h) { KM[(size_t)tok * 768 + h * 96 + 64 + j] = o1; KM[(size_t)tok * 768 + h * 96 + 80 + j] = o2; } }
    for (int unit = vcu; unit < 64; unit += G) {
        const int c = tid, d = c & 63; float ksum = 0.f;
        for (int t = 0; t < 256; ++t) { const int tok = unit * 256 + t; const bf16_t* pr = PROJ + (size_t)tok * PN;
            float qv = bf2f(pr[C_MQ + c]), kv = bf2f(pr[C_MK + c]);
            if (d < 16) { const int j = d & 7; const float cs = ropeB[(size_t)tok * 16 + j], sn = ropeB[(size_t)tok * 16 + 8 + j];
                if (d < 8) { const float q2 = bf2f(pr[C_MQ + c + 8]), k2 = bf2f(pr[C_MK + c + 8]); qv = qv * cs - q2 * sn; kv = kv * cs - k2 * sn; }
                else { const float q1 = bf2f(pr[C_MQ + c - 8]), k1 = bf2f(pr[C_MK + c - 8]); qv = qv * cs + q1 * sn; kv = kv * cs + k1 * sn; } }
            QB[(size_t)tok * 512 + c] = (bf16_t)f2bf(qv * C2B); KB[(size_t)tok * 512 + c] = (bf16_t)f2bf(kv); ksum += kv; }
        kmean[(size_t)unit * 512 + c] = ksum * (1.0f / 256.0f);
    }
}

__device__ __forceinline__ void phase_attn(const Params& p, int vcu, int G) {
    const int tid = threadIdx.x, wave = __builtin_amdgcn_readfirstlane(tid >> 6);
    unsigned char* ws = p.ws;
    const bf16_t* QM = (const bf16_t*)(ws + WS_QM); const bf16_t* KM = (const bf16_t*)(ws + WS_KM); const bf16_t* VM = (const bf16_t*)(ws + WS_VM);
    const bf16_t* QB = (const bf16_t*)(ws + WS_QB); const bf16_t* KB = (const bf16_t*)(ws + WS_KB); const bf16_t* PROJ = (const bf16_t*)(ws + WS_PROJ);
    const float* kmean = (const float*)(ws + WS_KMEAN); bf16_t* ATT = (bf16_t*)(ws + WS_ATT);
    for (int U = vcu; U < 1024; U += G) {
        const int type = U >> 9, vh = (U >> 8) & 1, rem = U & 255, b = rem >> 5, h = (rem >> 2) & 7, ch = rem & 3;
        const int t = ch * 512 + tid, tok = b * SEQ + t;
        const int kmax = ch * 512 + wave * 64 + 63;
        float o[32];
#pragma unroll
        for (int d = 0; d < 32; ++d) o[d] = 0.f;
        float mx = -INFINITY, l = 0.f;
        if (type == 0) {
            u32x4 qp[12];
#pragma unroll
            for (int d8 = 0; d8 < 12; ++d8) qp[d8] = *(const u32x4*)(QM + (size_t)tok * 768 + h * 96 + d8 * 8);
#pragma unroll 1
            for (int key = 0; key <= kmax; ++key) {
                const bf16_t* kp = KM + (size_t)(b * SEQ + key) * 768 + h * 96; const bf16_t* vp = VM + (size_t)(b * SEQ + key) * 512 + h * 64 + vh * 32;
                float s = 0.f;
#pragma unroll
                for (int d8 = 0; d8 < 12; ++d8) { const u32x4 v = *(const u32x4*)(kp + d8 * 8);
#pragma unroll
                    for (int k = 0; k < 4; ++k) { s = fmaf(__uint_as_float(qp[d8][k] << 16), __uint_as_float(v[k] << 16), s); s = fmaf(__uint_as_float(qp[d8][k] & 0xffff0000u), __uint_as_float(v[k] & 0xffff0000u), s); } }
                if (key <= t) { const float mn = fmaxf(mx, s), al = __builtin_amdgcn_exp2f(mx - mn), pe = __builtin_amdgcn_exp2f(s - mn); l = l * al + pe; mx = mn;
#pragma unroll
                    for (int d8 = 0; d8 < 4; ++d8) { const u32x4 v = *(const u32x4*)(vp + d8 * 8);
#pragma unroll
                        for (int k = 0; k < 4; ++k) { o[d8 * 8 + 2 * k] = fmaf(pe, __uint_as_float(v[k] << 16), o[d8 * 8 + 2 * k] * al); o[d8 * 8 + 2 * k + 1] = fmaf(pe, __uint_as_float(v[k] & 0xffff0000u), o[d8 * 8 + 2 * k + 1] * al); } } }
            }
        } else {
            u32x4 qp[8];
#pragma unroll
            for (int d8 = 0; d8 < 8; ++d8) qp[d8] = *(const u32x4*)(QB + (size_t)tok * 512 + h * 64 + d8 * 8);
            const int cur = t >> 8;
            float gt[8];
#pragma unroll
            for (int n = 0; n < 8; ++n) gt[n] = -INFINITY;
#pragma unroll 1
            for (int n = 0; n < cur; ++n) { float s = 0.f; const float* km = kmean + (size_t)(b * 8 + n) * 512 + h * 64;
#pragma unroll
                for (int d8 = 0; d8 < 8; ++d8)
#pragma unroll
                    for (int k = 0; k < 4; ++k) { s = fmaf(__uint_as_float(qp[d8][k] << 16), km[d8 * 8 + 2 * k], s); s = fmaf(__uint_as_float(qp[d8][k] & 0xffff0000u), km[d8 * 8 + 2 * k + 1], s); }
#pragma unroll
                for (int j = 0; j < 8; ++j) gt[j] = (j == n) ? s : gt[j]; }
            unsigned sel = 0u;
#pragma unroll
            for (int n = 0; n < 8; ++n) { int cnt = 0;
#pragma unroll
                for (int n2 = 0; n2 < 8; ++n2) if (n2 != n) cnt += (n2 < cur && (gt[n2] > gt[n] || (gt[n2] == gt[n] && n2 < n))) ? 1 : 0;
                if (n < cur && cnt < 3) sel |= 1u << n; }
#pragma unroll 1
            for (int key = 0; key <= kmax; ++key) {
                const bf16_t* kp = KB + (size_t)(b * SEQ + key) * 512 + h * 64; const bf16_t* vp = PROJ + (size_t)(b * SEQ + key) * PN + C_MV + h * 64 + vh * 32;
                const int nb = key >> 8; const bool ok = (nb == cur) ? (key <= t) : (((sel >> nb) & 1u) != 0u);
                float s = 0.f;
#pragma unroll
                for (int d8 = 0; d8 < 8; ++d8) { const u32x4 v = *(const u32x4*)(kp + d8 * 8);
#pragma unroll
                    for (int k = 0; k < 4; ++k) { s = fmaf(__uint_as_float(qp[d8][k] << 16), __uint_as_float(v[k] << 16), s); s = fmaf(__uint_as_float(qp[d8][k] & 0xffff0000u), __uint_as_float(v[k] & 0xffff0000u), s); } }
                if (ok) { const float mn = fmaxf(mx, s), al = __builtin_amdgcn_exp2f(mx - mn), pe = __builtin_amdgcn_exp2f(s - mn); l = l * al + pe; mx = mn;
#pragma unroll
                    for (int d8 = 0; d8 < 4; ++d8) { const u32x4 v = *(const u32x4*)(vp + d8 * 8);
#pragma unroll
                        for (int k = 0; k < 4; ++k) { o[d8 * 8 + 2 * k] = fmaf(pe, __uint_as_float(v[k] << 16), o[d8 * 8 + 2 * k] * al); o[d8 * 8 + 2 * k + 1] = fmaf(pe, __uint_as_float(v[k] & 0xffff0000u), o[d8 * 8 + 2 * k + 1] * al); } } }
            }
        }
        const float il = 1.0f / l;
        bf16_t* op = ATT + (size_t)tok * 1024 + type * 512 + h * 64 + vh * 32;
#pragma unroll
        for (int d8 = 0; d8 < 4; ++d8) { u32x4 w; w.x = pk2(o[d8 * 8] * il, o[d8 * 8 + 1] * il); w.y = pk2(o[d8 * 8 + 2] * il, o[d8 * 8 + 3] * il); w.z = pk2(o[d8 * 8 + 4] * il, o[d8 * 8 + 5] * il); w.w = pk2(o[d8 * 8 + 6] * il, o[d8 * 8 + 7] * il);
            *(u32x4*)(op + d8 * 8) = w; }
    }
}

__device__ __forceinline__ void phase_ln1_route(const Params& p, LAS unsigned char* lds, int vcu, int G) {
    const int tid = threadIdx.x, wave = tid >> 6, lane = tid & 63;
    unsigned char* ws = p.ws;
    float* X1 = p.out; bf16_t* X1B = (bf16_t*)(ws + WS_X1B);
    int* tidx = (int*)(ws + WS_TIDX); float* tgate = (float*)(ws + WS_TGATE); unsigned* hist = (unsigned*)(ws + WS_HIST);
    LAS int* lidx = (LAS int*)lds;
    for (int chunk = vcu; chunk < NCHUNK; chunk += G) {
        for (int r = 0; r < 8; ++r) {
            const int tl = wave * 8 + r, tok = chunk * 64 + tl;
            f32x4 v[4]; float s = 0.f;
#pragma unroll
            for (int j = 0; j < 4; ++j) { v[j] = *(const f32x4*)(X1 + (size_t)tok * DM + 4 * lane + 256 * j); s += (v[j][0] + v[j][1]) + (v[j][2] + v[j][3]); }
            const float mean = wave_sum(s) * (1.0f / DM); float s2 = 0.f;
#pragma unroll
            for (int j = 0; j < 4; ++j) { v[j] = v[j] - mean; s2 += (v[j][0] * v[j][0] + v[j][1] * v[j][1]) + (v[j][2] * v[j][2] + v[j][3] * v[j][3]); }
            const float rs = 1.0f / sqrtf(wave_sum(s2) * (1.0f / DM) + LN_EPS);
#pragma unroll
            for (int j = 0; j < 4; ++j) { const f32x4 g = *(const f32x4*)(p.ln1_g + 4 * lane + 256 * j), bb = *(const f32x4*)(p.ln1_b + 4 * lane + 256 * j);
                v[j] = v[j] * rs * g + bb; *(f32x4*)(X1 + (size_t)tok * DM + 4 * lane + 256 * j) = v[j];
                u32x2 w; w.x = pk2(v[j][0], v[j][1]); w.y = pk2(v[j][2], v[j][3]); *(u32x2*)(X1B + (size_t)tok * DM + 4 * lane + 256 * j) = w; }
            float lg[32];
#pragma unroll
            for (int e = 0; e < 32; ++e) lg[e] = 0.f;
#pragma unroll
            for (int j = 0; j < 4; ++j)
#pragma unroll
                for (int i = 0; i < 4; ++i) { const float xv = v[j][i]; const float* wr = p.w_router + (size_t)(4 * lane + 256 * j + i) * 32;
#pragma unroll
                    for (int e4 = 0; e4 < 8; ++e4) { const f32x4 w = *(const f32x4*)(wr + 4 * e4); lg[4 * e4] = fmaf(xv, w[0], lg[4 * e4]); lg[4 * e4 + 1] = fmaf(xv, w[1], lg[4 * e4 + 1]); lg[4 * e4 + 2] = fmaf(xv, w[2], lg[4 * e4 + 2]); lg[4 * e4 + 3] = fmaf(xv, w[3], lg[4 * e4 + 3]); } }
            float my = 0.f;
#pragma unroll
            for (int e = 0; e < 32; ++e) { const float tsum = wave_sum(lg[e]); if ((lane & 31) == e) my = tsum; }
            my += p.b_router[lane & 31];
            if (lane >= 32) my = -INFINITY;
            float tv[4]; int ti[4];
#pragma unroll
            for (int k = 0; k < 4; ++k) { const float m = wave_max(my); const unsigned long long bal = __ballot(my == m); const int idx = __ffsll((long long)bal) - 1; tv[k] = m; ti[k] = idx; if (lane == idx) my = -INFINITY; }
            if (lane == 0) { const float e0 = 1.f, e1 = expf(tv[1] - tv[0]), e2 = expf(tv[2] - tv[0]), e3 = expf(tv[3] - tv[0]); const float is = 1.0f / (e0 + e1 + e2 + e3);
                *(f32x4*)(tgate + (size_t)tok * 4) = (f32x4){e0 * is, e1 * is, e2 * is, e3 * is};
                int* tp = tidx + (size_t)tok * 4; tp[0] = ti[0]; tp[1] = ti[1]; tp[2] = ti[2]; tp[3] = ti[3];
                lidx[tl * 4 + 0] = ti[0]; lidx[tl * 4 + 1] = ti[1]; lidx[tl * 4 + 2] = ti[2]; lidx[tl * 4 + 3] = ti[3]; }
        }
        __syncthreads();
        if (tid < 32) { unsigned c = 0; for (int a = 0; a < 256; ++a) c += (lidx[a] == tid) ? 1u : 0u; hist[chunk * 32 + tid] = c; }
        __syncthreads();
    }
}

__device__ __forceinline__ void phase_assign(const Params& p, LAS unsigned char* lds, int vcu, int G) {
    const int tid = threadIdx.x;
    unsigned char* ws = p.ws;
    const int* tidx = (const int*)(ws + WS_TIDX); const float* tgate = (const float*)(ws + WS_TGATE); const unsigned* hist = (const unsigned*)(ws + WS_HIST);
    int* dest = (int*)(ws + WS_DEST); int* row_tok = (int*)(ws + WS_ROWTOK); float* row_gate = (float*)(ws + WS_ROWGATE); int* tile_e = (int*)(ws + WS_TILEE);
    LAS int* lidx = (LAS int*)lds;
    LAS int* lcnt = (LAS int*)(lds + 1024);
    LAS int* lpre = (LAS int*)(lds + 1024 + 128);
    LAS int* lstart = (LAS int*)(lds + 1024 + 256);
    for (int chunk = vcu; chunk < NCHUNK; chunk += G) {
        if (tid < 256) lidx[tid] = tidx[chunk * 256 + tid];
        if (tid < 32) { int tot = 0, pre = 0; for (int c = 0; c < NCHUNK; ++c) { const int hv = (int)hist[c * 32 + tid]; tot += hv; pre += (c < chunk) ? hv : 0; } lcnt[tid] = tot; lpre[tid] = pre; }
        __syncthreads();
        if (tid == 0) { int s = 0; for (int e = 0; e < 32; ++e) { lstart[e] = s; s += (lcnt[e] + 255) / 256 * 256; } lstart[32] = s; }
        __syncthreads();
        if (tid < 256) { const int e = lidx[tid]; int rank = 0; for (int a = 0; a < tid; ++a) rank += (lidx[a] == e) ? 1 : 0;
            const int P = lstart[e] + lpre[e] + rank, tok = chunk * 64 + (tid >> 2);
            row_tok[P] = tok; row_gate[P] = tgate[chunk * 256 + tid]; dest[chunk * 256 + tid] = P; }
        if (chunk < 32) { const int e = chunk; for (int P = lstart[e] + lcnt[e] + tid; P < lstart[e + 1]; P += NTHREADS) { row_tok[P] = 0; row_gate[P] = 0.f; } }
        if (chunk == 0) { if (tid < 32) { for (int t = lstart[tid] / 256; t < lstart[tid + 1] / 256; ++t) tile_e[t] = tid; } if (tid == 32) tile_e[MAXTILES] = lstart[32] / 256; }
        __syncthreads();
    }
}

__device__ __forceinline__ void phase_final(const Params& p, int vcu, int G) {
    const int tid = threadIdx.x, wave = tid >> 6, lane = tid & 63;
    unsigned char* ws = p.ws;
    const int* dest = (const int*)(ws + WS_DEST); const bf16_t* Y = (const bf16_t*)(ws + WS_Y); float* X1 = p.out;
    const int gw = vcu * NWAVES + wave, NGW = G * NWAVES;
    for (int tok = gw; tok < NTOK; tok += NGW) {
        f32x4 v[4];
#pragma unroll
        for (int j = 0; j < 4; ++j) v[j] = *(const f32x4*)(X1 + (size_t)tok * DM + 4 * lane + 256 * j) * DN_ALPHA;
#pragma unroll
        for (int k = 0; k < 4; ++k) { const int P = dest[tok * 4 + k];
#pragma unroll
            for (int j = 0; j < 4; ++j) { const u32x2 w = *(const u32x2*)(Y + (size_t)P * 1024 + 4 * lane + 256 * j);
                v[j][0] += __uint_as_float(w.x << 16); v[j][1] += __uint_as_float(w.x & 0xffff0000u); v[j][2] += __uint_as_float(w.y << 16); v[j][3] += __uint_as_float(w.y & 0xffff0000u); } }
        float s = 0.f;
#pragma unroll
        for (int j = 0; j < 4; ++j) s += (v[j][0] + v[j][1]) + (v[j][2] + v[j][3]);
        const float mean = wave_sum(s) * (1.0f / DM); float s2 = 0.f;
#pragma unroll
        for (int j = 0; j < 4; ++j) { v[j] = v[j] - mean; s2 += (v[j][0] * v[j][0] + v[j][1] * v[j][1]) + (v[j][2] * v[j][2] + v[j][3] * v[j][3]); }
        const float rs = 1.0f / sqrtf(wave_sum(s2) * (1.0f / DM) + LN_EPS);
#pragma unroll
        for (int j = 0; j < 4; ++j) { const f32x4 g = *(const f32x4*)(p.ln2_g + 4 * lane + 256 * j), bb = *(const f32x4*)(p.ln2_b + 4 * lane + 256 * j);
            *(f32x4*)(p.out + (size_t)tok * DM + 4 * lane + 256 * j) = v[j] * rs * g + bb; }
    }
}

constexpr int NPHASE = 11;
__global__ void __launch_bounds__(NTHREADS, 2) fwd_kernel(Params p) {
    extern __shared__ __attribute__((aligned(16))) unsigned char lds_raw[];
    LAS unsigned char* lds = (LAS unsigned char*)lds_raw;
    const int tid = threadIdx.x;
    const int G = gridDim.x, bx = blockIdx.x;
    const int vcu = (G % 8 == 0) ? (bx % 8) * (G / 8) + bx / 8 : bx;
    unsigned char* ws = p.ws;
    volatile LAS unsigned* MISC = (volatile LAS unsigned*)(lds + MISC_OFF);
    if (tid < 32) MISC[tid] = 0u;
    __syncthreads();
    XcdBarrier bar; bar.bar = (unsigned*)(ws + WS_CTL) + CW_BAR; bar.x = 0; bar.st = nullptr;
    const bool one = (p.ph_hi - p.ph_lo) > 1;
    if (one) bar = xcd_barrier_post((unsigned*)(ws + WS_CTL) + CW_BAR, MISC + 8);
    const int lo = p.ph_lo, hi = p.ph_hi;
#ifdef ONLY_PHASE
#define IN(k) ((k) == ONLY_PHASE && lo <= (k) && (k) < hi)
#else
#define IN(k) (lo <= (k) && (k) < hi)
#endif
#define SEAM(k) do { if (IN(k) && IN((k) + 1)) xcd_barrier(bar); } while (0)

    if (IN(0)) { phase_prologue(p, lds, vcu, G); } SEAM(0);
    if (IN(1)) { GemmArgs g{(const bf16_t*)(ws + WS_XB), 1024, (const bf16_t*)(ws + WS_WIN), 1024, 1024}; DenseSched S; S.init(NTOK, PN, G, vcu);
        EpiProj E{(bf16_t*)(ws + WS_PROJ)}; gemm_phase(lds, g, S, E); } SEAM(1);
    if (IN(2)) { phase_prep(p, lds, vcu, G); } SEAM(2);
    if (IN(3)) { GemmArgs g{(const bf16_t*)(ws + WS_PROJ), PN, (const bf16_t*)(ws + WS_WUP), KUP, KUP}; DenseSched S; S.init(NTOK, NUP, G, vcu);
        EpiUp E{(bf16_t*)(ws + WS_QM), (bf16_t*)(ws + WS_KM), (bf16_t*)(ws + WS_VM), (const float*)(ws + WS_RSTD), (const float*)(ws + WS_ROPEA)}; gemm_phase(lds, g, S, E); } SEAM(3);
    if (IN(4)) { phase_attn(p, vcu, G); } SEAM(4);
    if (IN(5)) { GemmArgs g{(const bf16_t*)(ws + WS_ATT), 1024, (const bf16_t*)(ws + WS_WO), 1024, 1024}; DenseSched S; S.init(NTOK, DM, G, vcu);
        EpiWo E{p.x, p.out}; gemm_phase(lds, g, S, E); } SEAM(5);
    if (IN(6)) { phase_ln1_route(p, lds, vcu, G); } SEAM(6);
    if (IN(7)) { phase_assign(p, lds, vcu, G); } SEAM(7);
    if (IN(8)) { GemmArgs g{(const bf16_t*)(ws + WS_X1B), 1024, (const bf16_t*)(ws + WS_WGU), 1024, 1024}; GroupSched<true> S; S.init((const int*)(ws + WS_TILEE), (const int*)(ws + WS_ROWTOK), 8, 2048, G, vcu);
        EpiGateUp E{(bf16_t*)(ws + WS_H), p.b_gate, p.b_up}; gemm_phase(lds, g, S, E); } SEAM(8);
    if (IN(9)) { GemmArgs g{(const bf16_t*)(ws + WS_H), 1024, (const bf16_t*)(ws + WS_WD), 1024, 1024}; GroupSched<false> S; S.init((const int*)(ws + WS_TILEE), (const int*)(ws + WS_ROWTOK), 4, 1024, G, vcu);
        EpiDown E{(bf16_t*)(ws + WS_Y), p.b_down, (const float*)(ws + WS_ROWGATE)}; gemm_phase(lds, g, S, E); } SEAM(9);
    if (IN(10)) { phase_final(p, vcu, G); }
#undef IN
#undef SEAM
}

extern "C" void kernel_launch(void* const* d_in, const int* in_sizes, int n_in, void* d_out, int out_size, void* d_ws, size_t ws_size, hipStream_t stream) {
    static int grid = 0;
    if (grid == 0) {
        if (n_in != 20 || out_size != NTOK * DM || ws_size < WS_END) { fprintf(stderr, "kernel_launch: unexpected shapes (n_in %d out %d ws %zu)\n", n_in, out_size, ws_size); grid = -1; return; }
        int dev = 0, cus = 0, per_cu = 0;
        if (hipGetDevice(&dev) != hipSuccess || hipDeviceGetAttribute(&cus, hipDeviceAttributeMultiprocessorCount, dev) != hipSuccess) { grid = -1; return; }
        if (hipFuncSetAttribute((const void*)fwd_kernel, hipFuncAttributeMaxDynamicSharedMemorySize, LDS_BYTES) != hipSuccess) { fprintf(stderr, "kernel_launch: hipFuncSetAttribute failed\n"); grid = -1; return; }
        if (hipOccupancyMaxActiveBlocksPerMultiprocessor(&per_cu, (const void*)fwd_kernel, NTHREADS, LDS_BYTES) != hipSuccess || per_cu < 1) fprintf(stderr, "kernel_launch: occupancy query says %d\n", per_cu);
        (void)hipGetLastError();
        grid = cus;
    }
    if (grid < 0) return;
    (void)hipMemsetAsync((char*)d_ws + WS_CTL, 0, CTL_ZERO_BYTES, stream);
    Params p{};
    p.x = (const float*)d_in[0]; p.pos = (const int*)d_in[1]; p.w_in = (const float*)d_in[2]; p.q_a_norm = (const float*)d_in[3]; p.w_q_b = (const float*)d_in[4];
    p.kv_a_norm = (const float*)d_in[5]; p.w_kv_b = (const float*)d_in[6]; p.w_o = (const float*)d_in[7]; p.ln1_g = (const float*)d_in[8]; p.ln1_b = (const float*)d_in[9];
    p.w_router = (const float*)d_in[10]; p.b_router = (const float*)d_in[11]; p.w_gate = (const float*)d_in[12]; p.b_gate = (const float*)d_in[13];
    p.w_up = (const float*)d_in[14]; p.b_up = (const float*)d_in[15]; p.w_down = (const float*)d_in[16]; p.b_down = (const float*)d_in[17];
    p.ln2_g = (const float*)d_in[18]; p.ln2_b = (const float*)d_in[19];
    p.out = (float*)d_out; p.ws = (unsigned char*)d_ws;
    for (int i = 0; i < 16; ++i) p.invfA[i] = pow(500000.0, -(double)(2 * i) / 32.0);
    for (int i = 0; i < 8; ++i) p.invfB[i] = pow(500000.0, -(double)(2 * i) / 16.0);
#if MK_ONE_LAUNCH
    p.ph_lo = 0; p.ph_hi = NPHASE;
    hipLaunchKernelGGL(fwd_kernel, dim3(grid), dim3(NTHREADS), LDS_BYTES, stream, p);
#else
    for (int ph = 0; ph < NPHASE; ++ph) { p.ph_lo = ph; p.ph_hi = ph + 1; hipLaunchKernelGGL(fwd_kernel, dim3(grid), dim3(NTHREADS), LDS_BYTES, stream, p); }
#endif
}
```

```cpp
#include <hip/hip_runtime.h>
#include <cstdio>
#include <cstdint>
#include <cmath>

#ifndef MK_ONE_LAUNCH
#define MK_ONE_LAUNCH 1
#endif

#define GAS __attribute__((address_space(1)))
#define LAS __attribute__((address_space(3)))
typedef unsigned short bf16_t;
typedef short bf16x8 __attribute__((ext_vector_type(8)));
typedef float f32x4 __attribute__((ext_vector_type(4)));
typedef float f32x2 __attribute__((ext_vector_type(2)));
typedef unsigned u32x4 __attribute__((ext_vector_type(4)));
typedef unsigned u32x2 __attribute__((ext_vector_type(2)));

constexpr int NTOK = 16384, DM = 1024, SEQ = 2048, NBATCH = 8;
constexpr int PN = 2048;
constexpr int C_QL = 0, C_KVL = 256, C_KR = 384, C_MQ = 416, C_MK = 928, C_MV = 1440, IN_COLS = 1952;
constexpr int NUP = 1792, KUP = 384;
constexpr int NE = 32, TOPK = 4;
constexpr int MAXROWS = 65536 + NE * 256, MAXTILES = MAXROWS / 256;
constexpr int NCHUNK = NTOK / 64;
constexpr float LN_EPS = 1e-5f, RMS_EPS = 1e-6f;
constexpr float DN_ALPHA = 1.189207115002721f;
constexpr float LOG2E = 1.4426950408889634f;
constexpr float C2A = 0.10206207261596575f * LOG2E;
constexpr float C2B = 0.125f * LOG2E;
constexpr int NWAVES = 8, NTHREADS = 512;

constexpr size_t MiB = 1u << 20;
constexpr size_t WS_CTL = 0, CTL_ZERO_BYTES = 1 * MiB;
constexpr size_t WS_HIST = 1 * MiB;
constexpr size_t WS_TIDX = WS_HIST + 64 * 1024;
constexpr size_t WS_TGATE = WS_TIDX + 256 * 1024;
constexpr size_t WS_DEST = WS_TGATE + 256 * 1024;
constexpr size_t WS_ROWTOK = WS_DEST + 256 * 1024;
constexpr size_t WS_ROWGATE = WS_ROWTOK + 288 * 1024;
constexpr size_t WS_TILEE = WS_ROWGATE + 288 * 1024;
constexpr size_t WS_RSTD = WS_TILEE + 4 * 1024;
constexpr size_t WS_KMEAN = WS_RSTD + 128 * 1024;
static_assert(WS_KMEAN + 128 * 1024 <= 4 * MiB, "route region");
constexpr size_t WS_ROPEA = 4 * MiB;
constexpr size_t WS_ROPEB = 6 * MiB;
constexpr size_t WS_WIN = 8 * MiB;
constexpr size_t WS_WO = 12 * MiB;
constexpr size_t WS_WUP = 14 * MiB;
constexpr size_t WS_X1B = 16 * MiB;
constexpr size_t WS_WD = 48 * MiB;
constexpr size_t WS_XB = 112 * MiB;
constexpr size_t WS_PROJ = 144 * MiB;
constexpr size_t WS_QM = 208 * MiB;
constexpr size_t WS_KM = 232 * MiB;
constexpr size_t WS_VM = 256 * MiB;
constexpr size_t WS_QB = 272 * MiB;
constexpr size_t WS_KB = 288 * MiB;
constexpr size_t WS_ATT = 304 * MiB;
constexpr size_t WS_H = 112 * MiB;
constexpr size_t WS_WGU = 336 * MiB;
constexpr size_t WS_Y = 336 * MiB;
constexpr size_t WS_END = 480 * MiB;
static_assert(WS_H + (size_t)MAXROWS * 1024 * 2 <= WS_VM + 0 * MiB + 0 && WS_Y + (size_t)MAXROWS * 1024 * 2 <= WS_END, "ws map");
constexpr int CW_BAR = 4096;

constexpr int LDS_BYTES = 147456;
constexpr int MISC_OFF = 131072 + 320;

__device__ __forceinline__ float bf2f(unsigned v) { return __uint_as_float(v << 16); }
__device__ __forceinline__ unsigned f2bf(float f) { unsigned u = __float_as_uint(f); return (u + 0x7fffu + ((u >> 16) & 1u)) >> 16; }
__device__ __forceinline__ unsigned pk2(float lo, float hi) { return f2bf(lo) | (f2bf(hi) << 16); }
__device__ __forceinline__ float wave_sum(float v) {
#pragma unroll
    for (int o = 1; o < 64; o <<= 1) v += __shfl_xor(v, o);
    return v;
}
__device__ __forceinline__ float wave_max(float v) {
#pragma unroll
    for (int o = 1; o < 64; o <<= 1) v = fmaxf(v, __shfl_xor(v, o));
    return v;
}

#define XB_TMO      128
#define XB_XCNT(j)  (256  + 64 * (j))
#define XB_XSUB(j)  (1280 + 64 * (j))
#define XB_XGEN(j)  (2304 + 64 * (j))
#define XB_TOP      3328
#define XB_TOPGEN   3392
#define XCD_BAR_WORDS 3456
#define XB_SPIN_CAP (1u << 18)
__device__ __forceinline__ unsigned xb_ld(unsigned* p)              { return __hip_atomic_load(p, __ATOMIC_RELAXED, __HIP_MEMORY_SCOPE_AGENT); }
__device__ __forceinline__ unsigned xb_add(unsigned* p, unsigned v) { return __hip_atomic_fetch_add(p, v, __ATOMIC_RELAXED, __HIP_MEMORY_SCOPE_AGENT); }
__device__ __forceinline__ unsigned xb_xcc_id() { return (unsigned)__builtin_amdgcn_s_getreg((3 << 11) | 20) & 0xFu; }
#define XB_SPIN(cond, bar) do { unsigned _sp = 0; while (cond) { __builtin_amdgcn_s_sleep(1); \
    if ((++_sp & 255u) == 0u) { if (xb_ld(&(bar)[XB_TMO])) break; if (_sp > XB_SPIN_CAP) { atomicAdd(&(bar)[XB_TMO], 1u); break; } } } } while (0)
struct XcdBarrier { unsigned* bar; unsigned x; volatile LAS unsigned* st; };
__device__ __forceinline__ XcdBarrier xcd_barrier_post(unsigned* bar, volatile LAS unsigned* st) {
    XcdBarrier b; b.bar = bar; b.x = xb_xcc_id(); b.st = st;
    if (threadIdx.x == 0) (void)xb_add(&bar[XB_XCNT(b.x)], 1u);
    return b;
}
__device__ __forceinline__ void xcd_barrier_complete(unsigned* bar, unsigned x, unsigned& nloc, unsigned& nx) {
    const unsigned G = gridDim.x * gridDim.y * gridDim.z;
    unsigned sum, cnt, mine, sp = 0u;
    for (;;) {
        sum = 0u; cnt = 0u; mine = 0u;
#pragma unroll
        for (unsigned j = 0; j < 16; ++j) { const unsigned c = xb_ld(&bar[XB_XCNT(j)]); sum += c; cnt += (c > 0u) ? 1u : 0u; mine = (j == x) ? c : mine; }
        if (sum == G) break;
        __builtin_amdgcn_s_sleep(1);
        if ((++sp & 255u) == 0u) { if (xb_ld(&bar[XB_TMO])) break; if (sp > XB_SPIN_CAP) { atomicAdd(&bar[XB_TMO], 1u); break; } }
    }
    nloc = mine > 0u ? mine : 1u; nx = cnt > 0u ? cnt : 1u;
}
__device__ __forceinline__ void xcd_barrier(const XcdBarrier& b) {
    asm volatile("s_waitcnt vmcnt(0)" ::: "memory");
    __syncthreads();
    if (threadIdx.x == 0) {
        unsigned* bar = b.bar;
        __builtin_amdgcn_s_waitcnt(0);
        unsigned nloc = b.st[0], nx = b.st[1];
        if (nloc == 0u) { xcd_barrier_complete(bar, b.x, nloc, nx); b.st[0] = nloc; b.st[1] = nx; }
        const unsigned old = xb_add(&bar[XB_XSUB(b.x)], 1u);
        const unsigned gen = old / nloc;
        if (old + 1u == (gen + 1u) * nloc) {
            __builtin_amdgcn_fence(__ATOMIC_RELEASE, "agent");
            asm volatile("s_waitcnt vmcnt(0)" ::: "memory");
            const unsigned og = xb_add(&bar[XB_TOP], 1u);
            const unsigned tg = og / nx;
            if (og + 1u == (tg + 1u) * nx) xb_add(&bar[XB_TOPGEN], 1u);
            else XB_SPIN(xb_ld(&bar[XB_TOPGEN]) == tg, bar);
            __builtin_amdgcn_fence(__ATOMIC_ACQUIRE, "agent");
            xb_add(&bar[XB_XGEN(b.x)], 1u);
            asm volatile("s_waitcnt vmcnt(0)" ::: "memory");
        } else {
            XB_SPIN(xb_ld(&bar[XB_XGEN(b.x)]) == gen, bar);
            __builtin_amdgcn_fence(__ATOMIC_ACQUIRE, "agent");
            asm volatile("s_waitcnt vmcnt(0)" ::: "memory");
        }
    }
    __syncthreads();
}

struct Params {
    const float* x; const int* pos;
    const float *w_in, *q_a_norm, *w_q_b, *kv_a_norm, *w_kv_b, *w_o, *ln1_g, *ln1_b, *w_router, *b_router;
    const float *w_gate, *b_gate, *w_up, *b_up, *w_down, *b_down, *ln2_g, *ln2_b;
    float* out; unsigned char* ws;
    double invfA[16]; double invfB[8];
    int ph_lo, ph_hi;
};

struct Unit { int pm, pn, e; };
struct GemmArgs { const bf16_t* A; int lda; const bf16_t* Bt; int ldb; int K; };
template <bool PERM> __device__ __forceinline__ int ecol(int bj, int n, int wc, int fq) { return 128 * bj + 32 * wc + (PERM ? 8 * fq + 4 * n : 16 * n + 4 * fq); }

template <class Epi, class Sched>
__device__ __forceinline__ void gemm_phase(LAS unsigned char* lds, const GemmArgs g, const Sched& S, const Epi& E) {
    const int tid = threadIdx.x, wid = __builtin_amdgcn_readfirstlane(tid >> 6), lane = tid & 63, wr = wid >> 2, wc = wid & 3, fr = lane & 15, fq = lane >> 4;
    Unit u;
    for (int ui = 0; S.next(ui, u); ++ui) {
        f32x4 acc[2][2][4][2];
#pragma unroll
        for (int a = 0; a < 2; ++a)
#pragma unroll
            for (int b = 0; b < 2; ++b)
#pragma unroll
                for (int m = 0; m < 4; ++m)
#pragma unroll
                    for (int n = 0; n < 2; ++n) acc[a][b][m][n] = (f32x4){0.f, 0.f, 0.f, 0.f};
        unsigned aoff[2][4];
#pragma unroll
        for (int a = 0; a < 2; ++a)
#pragma unroll
            for (int m = 0; m < 4; ++m) aoff[a][m] = (unsigned)S.arow(u, 128 * a + 64 * wr + 16 * m + fr) * (unsigned)g.lda;
        const bf16_t* bb = g.Bt + (size_t)(S.brow0(u) + 32 * wc) * g.ldb;
        const unsigned bl0 = (unsigned)(4 * fq) * (unsigned)g.ldb, bl1 = (unsigned)(8 * fq) * (unsigned)g.ldb;
#pragma unroll 1
        for (int k = 0; k < g.K; k += 2) {
            float af[2][4][2];
#pragma unroll
            for (int a = 0; a < 2; ++a)
#pragma unroll
                for (int m = 0; m < 4; ++m) { const unsigned v = *(const unsigned*)(g.A + aoff[a][m] + k); af[a][m][0] = __uint_as_float(v << 16); af[a][m][1] = __uint_as_float(v & 0xffff0000u); }
#pragma unroll
            for (int b = 0; b < 2; ++b)
#pragma unroll
                for (int n = 0; n < 2; ++n)
#pragma unroll
                    for (int j = 0; j < 4; ++j) {
                        const int ccol = 128 * b + (Epi::PERM ? 4 * n : 16 * n) + j;
                        const unsigned v = *(const unsigned*)(bb + (size_t)ccol * g.ldb + ((Epi::PERM ? bl1 : bl0) + (unsigned)k));
                        const float b0 = __uint_as_float(v << 16), b1 = __uint_as_float(v & 0xffff0000u);
#pragma unroll
                        for (int a = 0; a < 2; ++a)
#pragma unroll
                            for (int m = 0; m < 4; ++m) acc[a][b][m][n][j] = fmaf(af[a][m][1], b1, fmaf(af[a][m][0], b0, acc[a][b][m][n][j]));
                    }
        }
        E(acc, u, wr, wc, fr, fq);
    }
}

struct DenseSched {
    int nN, nunits, G, c;
    __device__ __forceinline__ void init(int M, int N, int G_, int c_) { nN = N / 256; nunits = (M / 256) * nN; G = G_; c = c_; }
    __device__ __forceinline__ bool next(int i, Unit& u) const { const int L = i * G + c; if (L >= nunits) return false; u.pm = L / nN; u.pn = L % nN; u.e = 0; return true; }
    __device__ __forceinline__ int arow(const Unit& u, int r) const { return 256 * u.pm + r; }
    __device__ __forceinline__ int brow0(const Unit& u) const { return 256 * u.pn; }
};
template <bool GATHER> struct GroupSched {
    const int* tile_e; const int* row_tok; int nN, nexp_rows, nunits, G, c;
    __device__ __forceinline__ void init(const int* te, const int* rt, int nN_, int nexp_rows_, int G_, int c_) { tile_e = te; row_tok = rt; nN = nN_; nexp_rows = nexp_rows_; nunits = te[MAXTILES] * nN_; G = G_; c = c_; }
    __device__ __forceinline__ bool next(int i, Unit& u) const { const int L = i * G + c; if (L >= nunits) return false; u.pm = L / nN; u.pn = L % nN; u.e = tile_e[u.pm]; return true; }
    __device__ __forceinline__ int arow(const Unit& u, int r) const { return GATHER ? row_tok[256 * u.pm + r] : 256 * u.pm + r; }
    __device__ __forceinline__ int brow0(const Unit& u) const { return u.e * nexp_rows + 256 * u.pn; }
};

struct EpiProj {
    static constexpr bool PERM = false;
    bf16_t* O;
    __device__ __forceinline__ void operator()(const f32x4 (&acc)[2][2][4][2], const Unit& u, int wr, int wc, int fr, int fq) const {
#pragma unroll
        for (int a = 0; a < 2; ++a)
#pragma unroll
            for (int m = 0; m < 4; ++m) { const int row = 256 * u.pm + 128 * a + 64 * wr + 16 * m + fr;
#pragma unroll
                for (int b = 0; b < 2; ++b)
#pragma unroll
                    for (int n = 0; n < 2; ++n) { const int col = 256 * u.pn + ecol<PERM>(b, n, wc, fq); const f32x4 v = acc[a][b][m][n];
                        u32x2 w; w.x = pk2(v[0], v[1]); w.y = pk2(v[2], v[3]); *(u32x2*)(O + (size_t)row * PN + col) = w; } }
    }
};
struct EpiUp {
    static constexpr bool PERM = false;
    bf16_t *QM, *KM, *VM; const float* rstd; const float* ropeA;
    __device__ __forceinline__ void operator()(const f32x4 (&acc)[2][2][4][2], const Unit& u, int wr, int wc, int fr, int fq) const {
#pragma unroll
        for (int a = 0; a < 2; ++a)
#pragma unroll
            for (int m = 0; m < 4; ++m) { const int row = 256 * u.pm + 128 * a + 64 * wr + 16 * m + fr;
                const float rq = rstd[2 * row] * C2A, rkv = rstd[2 * row + 1];
#pragma unroll
                for (int b = 0; b < 2; ++b) {
                    const int gidx = 8 * u.pn + 4 * b + wc;
                    if (gidx < 24) {
                        const int h = gidx / 3, part = gidx % 3;
                        f32x4 v0 = acc[a][b][m][0] * rq, v1 = acc[a][b][m][1] * rq;
                        if (part == 2) { const f32x4 c = *(const f32x4*)(ropeA + (size_t)row * 32 + 4 * fq), s = *(const f32x4*)(ropeA + (size_t)row * 32 + 16 + 4 * fq);
                            const f32x4 o0 = v0 * c - v1 * s, o1 = v1 * c + v0 * s; v0 = o0; v1 = o1; }
                        bf16_t* p = QM + (size_t)row * 768 + h * 96 + part * 32 + 4 * fq;
                        u32x2 w; w.x = pk2(v0[0], v0[1]); w.y = pk2(v0[2], v0[3]); *(u32x2*)p = w;
                        w.x = pk2(v1[0], v1[1]); w.y = pk2(v1[2], v1[3]); *(u32x2*)(p + 16) = w;
                    } else {
                        const int g2 = gidx - 24, h = g2 >> 2, part = g2 & 3;
                        const f32x4 v0 = acc[a][b][m][0] * rkv, v1 = acc[a][b][m][1] * rkv;
                        bf16_t* p = (part < 2) ? (KM + (size_t)row * 768 + h * 96 + part * 32 + 4 * fq) : (VM + (size_t)row * 512 + h * 64 + (part - 2) * 32 + 4 * fq);
                        u32x2 w; w.x = pk2(v0[0], v0[1]); w.y = pk2(v0[2], v0[3]); *(u32x2*)p = w;
                        w.x = pk2(v1[0], v1[1]); w.y = pk2(v1[2], v1[3]); *(u32x2*)(p + 16) = w;
                    }
                } }
    }
};
struct EpiWo {
    static constexpr bool PERM = false;
    const float* x; float* O;
    __device__ __forceinline__ void operator()(const f32x4 (&acc)[2][2][4][2], const Unit& u, int wr, int wc, int fr, int fq) const {
#pragma unroll
        for (int a = 0; a < 2; ++a)
#pragma unroll
            for (int m = 0; m < 4; ++m) { const int row = 256 * u.pm + 128 * a + 64 * wr + 16 * m + fr;
#pragma unroll
                for (int b = 0; b < 2; ++b)
#pragma unroll
                    for (int n = 0; n < 2; ++n) { const size_t off = (size_t)row * DM + 256 * u.pn + ecol<PERM>(b, n, wc, fq);
                        const f32x4 xv = *(const f32x4*)(x + off); *(f32x4*)(O + off) = xv * DN_ALPHA + acc[a][b][m][n]; } }
    }
};
struct EpiGateUp {
    static constexpr bool PERM = false;
    bf16_t* H; const float *bg, *bu;
    __device__ __forceinline__ void operator()(const f32x4 (&acc)[2][2][4][2], const Unit& u, int wr, int wc, int fr, int fq) const {
#pragma unroll
        for (int n = 0; n < 2; ++n) { const int hc = 128 * u.pn + 32 * wc + 16 * n + 4 * fq;
            const f32x4 vbg = *(const f32x4*)(bg + (size_t)u.e * 1024 + hc), vbu = *(const f32x4*)(bu + (size_t)u.e * 1024 + hc);
#pragma unroll
            for (int a = 0; a < 2; ++a)
#pragma unroll
                for (int m = 0; m < 4; ++m) { const int row = 256 * u.pm + 128 * a + 64 * wr + 16 * m + fr;
                    const f32x4 gv = acc[a][0][m][n] + vbg, uv = acc[a][1][m][n] + vbu; float hv[4];
#pragma unroll
                    for (int j = 0; j < 4; ++j) { const float gg = fminf(gv[j], 7.0f), uu = fminf(fmaxf(uv[j], -7.0f), 7.0f);
                        const float sg = 1.0f / (1.0f + __builtin_amdgcn_exp2f(-1.702f * LOG2E * gg)); hv[j] = gg * sg * (uu + 1.0f); }
                    u32x2 w; w.x = pk2(hv[0], hv[1]); w.y = pk2(hv[2], hv[3]); *(u32x2*)(H + (size_t)row * 1024 + hc) = w; } }
    }
};
struct EpiDown {
    static constexpr bool PERM = false;
    bf16_t* Y; const float* bd; const float* row_gate;
    __device__ __forceinline__ void operator()(const f32x4 (&acc)[2][2][4][2], const Unit& u, int wr, int wc, int fr, int fq) const {
#pragma unroll
        for (int a = 0; a < 2; ++a)
#pragma unroll
            for (int m = 0; m < 4; ++m) { const int row = 256 * u.pm + 128 * a + 64 * wr + 16 * m + fr; const float gw = row_gate[row];
#pragma unroll
                for (int b = 0; b < 2; ++b)
#pragma unroll
                    for (int n = 0; n < 2; ++n) { const int col = 256 * u.pn + ecol<PERM>(b, n, wc, fq); const f32x4 bv = *(const f32x4*)(bd + (size_t)u.e * 1024 + col);
                        const f32x4 v = (acc[a][b][m][n] + bv) * gw; u32x2 w; w.x = pk2(v[0], v[1]); w.y = pk2(v[2], v[3]); *(u32x2*)(Y + (size_t)row * 1024 + col) = w; } }
    }
};

__device__ __forceinline__ void tr_item(const float* W, int ldw, int k0, int n0, bf16_t* WT, int ldt, int orow0, int ocol0, const float* kscale, LAS float* scr, int lane) {
#pragma unroll 8
    for (int i = 0; i < 32; ++i) { const int kk = 2 * i + (lane >> 5); float v = W[(size_t)(k0 + kk) * ldw + n0 + (lane & 31)]; if (kscale) v *= kscale[k0 + kk]; scr[kk * 33 + (lane & 31)] = v; }
    asm volatile("s_waitcnt lgkmcnt(0)" ::: "memory");
    const int c = lane & 7;
#pragma unroll
    for (int j = 0; j < 4; ++j) { const int n = (lane >> 3) + 8 * j; const LAS float* s = scr + (8 * c) * 33 + n;
        u32x4 o; o.x = pk2(s[0 * 33], s[1 * 33]); o.y = pk2(s[2 * 33], s[3 * 33]); o.z = pk2(s[4 * 33], s[5 * 33]); o.w = pk2(s[6 * 33], s[7 * 33]);
        *(u32x4*)(WT + (size_t)(orow0 + n) * ldt + ocol0 + 8 * c) = o; }
    asm volatile("s_waitcnt lgkmcnt(0)" ::: "memory");
}
__device__ __forceinline__ void phase_prologue(const Params& p, LAS unsigned char* lds, int vcu, int G) {
    const int tid = threadIdx.x, wave = tid >> 6, lane = tid & 63;
    unsigned char* ws = p.ws;
    LAS float* scr = (LAS float*)(lds + wave * 16384);
    const int gw = vcu * NWAVES + wave, NGW = G * NWAVES;
    bf16_t* WinT = (bf16_t*)(ws + WS_WIN); bf16_t* WoT = (bf16_t*)(ws + WS_WO); bf16_t* WupT = (bf16_t*)(ws + WS_WUP);
    bf16_t* WguT = (bf16_t*)(ws + WS_WGU); bf16_t* WdT = (bf16_t*)(ws + WS_WD);
    constexpr int I_IN = 16 * 61, I_QB = 4 * 24, I_KVB = 2 * 32, I_O = 16 * 32, I_E = 16 * 32;
    constexpr int NITEMS = I_IN + I_QB + I_KVB + I_O + 3 * NE * I_E;
    for (int it = gw; it < NITEMS; it += NGW) {
        int r = it;
        if (r < I_IN) { const int kb = r / 61, nb = r % 61; tr_item(p.w_in, IN_COLS, 64 * kb, 32 * nb, WinT, 1024, 32 * nb, 64 * kb, nullptr, scr, lane); continue; } r -= I_IN;
        if (r < I_QB) { const int kb = r / 24, nb = r % 24; tr_item(p.w_q_b, 768, 64 * kb, 32 * nb, WupT, KUP, 32 * nb, 64 * kb, p.q_a_norm, scr, lane); continue; } r -= I_QB;
        if (r < I_KVB) { const int kb = r / 32, nb = r % 32; tr_item(p.w_kv_b, 1024, 64 * kb, 32 * nb, WupT, KUP, 768 + 32 * nb, 256 + 64 * kb, p.kv_a_norm, scr, lane); continue; } r -= I_KVB;
        if (r < I_O) { const int kb = r / 32, nb = r % 32; tr_item(p.w_o, 1024, 64 * kb, 32 * nb, WoT, 1024, 32 * nb, 64 * kb, nullptr, scr, lane); continue; } r -= I_O;
        const int mat = r / (NE * I_E), rr = r % (NE * I_E), e = rr / I_E, q = rr % I_E, kb = q / 32, nb = q % 32, n0 = 32 * nb;
        if (mat == 0) tr_item(p.w_gate + (size_t)e * 1048576, 1024, 64 * kb, n0, WguT, 1024, e * 2048 + (n0 >> 7) * 256 + (n0 & 127), 64 * kb, nullptr, scr, lane);
        else if (mat == 1) tr_item(p.w_up + (size_t)e * 1048576, 1024, 64 * kb, n0, WguT, 1024, e * 2048 + (n0 >> 7) * 256 + 128 + (n0 & 127), 64 * kb, nullptr, scr, lane);
        else tr_item(p.w_down + (size_t)e * 1048576, 1024, 64 * kb, n0, WdT, 1024, e * 1024 + n0, 64 * kb, nullptr, scr, lane);
    }
    const int gt = vcu * NTHREADS + tid, NGT = G * NTHREADS;
    for (int i = gt; i < 96 * 128; i += NGT) *(u32x4*)(WinT + (size_t)IN_COLS * 1024 + (size_t)i * 8) = (u32x4){0u, 0u, 0u, 0u};
    for (int i = gt; i < 768 * 16; i += NGT) { const int r = i / 16, c = i % 16; *(u32x4*)(WupT + (size_t)r * KUP + 256 + c * 8) = (u32x4){0u, 0u, 0u, 0u}; }
    for (int i = gt; i < 1024 * 32; i += NGT) { const int r = i / 32, c = i % 32; *(u32x4*)(WupT + (size_t)(768 + r) * KUP + c * 8) = (u32x4){0u, 0u, 0u, 0u}; }
    bf16_t* XB = (bf16_t*)(ws + WS_XB);
    for (int i = gt; i < NTOK * DM / 8; i += NGT) { const f32x4 a = *(const f32x4*)(p.x + (size_t)i * 8), b = *(const f32x4*)(p.x + (size_t)i * 8 + 4);
        u32x4 o; o.x = pk2(a[0], a[1]); o.y = pk2(a[2], a[3]); o.z = pk2(b[0], b[1]); o.w = pk2(b[2], b[3]); *(u32x4*)(XB + (size_t)i * 8) = o; }
    float* ropeA = (float*)(ws + WS_ROPEA); float* ropeB = (float*)(ws + WS_ROPEB);
    for (int i = gt; i < NTOK * 24; i += NGT) { const int tok = i / 24, j = i % 24; const double f = (j < 16) ? p.invfA[j] : p.invfB[j - 16];
        const double rev = (double)p.pos[tok] * f * 0.15915494309189535; const float fr = (float)(rev - __builtin_rint(rev));
        const float cs = __builtin_amdgcn_cosf(fr), sn = __builtin_amdgcn_sinf(fr);
        if (j < 16) { ropeA[(size_t)tok * 32 + j] = cs; ropeA[(size_t)tok * 32 + 16 + j] = sn; } else { ropeB[(size_t)tok * 16 + (j - 16)] = cs; ropeB[(size_t)tok * 16 + 8 + (j - 16)] = sn; } }
}

__device__ __forceinline__ void phase_prep(const Params& p, LAS unsigned char* lds, int vcu, int G) {
    const int tid = threadIdx.x, wave = tid >> 6, lane = tid & 63;
    unsigned char* ws = p.ws;
    const bf16_t* PROJ = (const bf16_t*)(ws + WS_PROJ);
    float* rstd = (float*)(ws + WS_RSTD); const float* ropeA = (const float*)(ws + WS_ROPEA); const float* ropeB = (const float*)(ws + WS_ROPEB);
    bf16_t* KM = (bf16_t*)(ws + WS_KM); bf16_t* QB = (bf16_t*)(ws + WS_QB); bf16_t* KB = (bf16_t*)(ws + WS_KB); float* kmean = (float*)(ws + WS_KMEAN);
    const int gw = vcu * NWAVES + wave, NGW = G * NWAVES;
    for (int row = gw; row < NTOK; row += NGW) {
        float s = 0.f;
        if (lane < 48) { const u32x4 v = *(const u32x4*)(PROJ + (size_t)row * PN + lane * 8);
#pragma unroll
            for (int q = 0; q < 4; ++q) { const float a = __uint_as_float(v[q] << 16), b = __uint_as_float(v[q] & 0xffff0000u); s += a * a + b * b; } }
#pragma unroll
        for (int o = 1; o < 32; o <<= 1) s += __shfl_xor(s, o);
        if (lane == 0) rstd[2 * row] = 1.0f / sqrtf(s * (1.0f / 256.0f) + RMS_EPS);
        if (lane == 32) rstd[2 * row + 1] = 1.0f / sqrtf(s * (1.0f / 128.0f) + RMS_EPS);
    }
    const int gt = vcu * NTHREADS + tid, NGT = G * NTHREADS;
    for (int i = gt; i < NTOK * 16; i += NGT) { const int tok = i >> 4, j = i & 15;
        const float x1 = bf2f(PROJ[(size_t)tok * PN + C_KR + j]), x2 = bf2f(PROJ[(size_t)tok * PN + C_KR + 16 + j]);
        const float c = ropeA[(size_t)tok * 32 + j], s = ropeA[(size_t)tok * 32 + 16 + j];
        const bf16_t o1 = (bf16_t)f2bf(x1 * c - x2 * s), o2 = (bf16_t)f2bf(x2 * c + x1 * s);
#pragma unroll
        for (int h = 0; h < 8; ++h) { KM[(size_t)tok * 768 + h * 96 + 64 + j] = o1; KM[(size_t)tok * 768 + h * 96 + 80 + j] = o2; } }
    for (int unit = vcu; unit < 64; unit += G) {
        const int c = tid, d = c & 63; float ksum = 0.f;
        for (int t = 0; t < 256; ++t) { const int tok = unit * 256 + t; const bf16_t* pr = PROJ + (size_t)tok * PN;
            float qv = bf2f(pr[C_MQ + c]), kv = bf2f(pr[C_MK + c]);
            if (d < 16) { const int j = d & 7; const float cs = ropeB[(size_t)tok * 16 + j], sn = ropeB[(size_t)tok * 16 + 8 + j];
                if (d < 8) { const float q2 = bf2f(pr[C_MQ + c + 8]), k2 = bf2f(pr[C_MK + c + 8]); qv = qv * cs - q2 * sn; kv = kv * cs - k2 * sn; }
                else { const float q1 = bf2f(pr[C_MQ + c - 8]), k1 = bf2f(pr[C_MK + c - 8]); qv = qv * cs + q1 * sn; kv = kv * cs + k1 * sn; } }
            QB[(size_t)tok * 512 + c] = (bf16_t)f2bf(qv * C2B); KB[(size_t)tok * 512 + c] = (bf16_t)f2bf(kv); ksum += kv; }
        kmean[(size_t)unit * 512 + c] = ksum * (1.0f / 256.0f);
    }
}

__device__ __forceinline__ void phase_attn(const Params& p, int vcu, int G) {
    const int tid = threadIdx.x, wave = __builtin_amdgcn_readfirstlane(tid >> 6);
    unsigned char* ws = p.ws;
    const bf16_t* QM = (const bf16_t*)(ws + WS_QM); const bf16_t* KM = (const bf16_t*)(ws + WS_KM); const bf16_t* VM = (const bf16_t*)(ws + WS_VM);
    const bf16_t* QB = (const bf16_t*)(ws + WS_QB); const bf16_t* KB = (const bf16_t*)(ws + WS_KB); const bf16_t* PROJ = (const bf16_t*)(ws + WS_PROJ);
    const float* kmean = (const float*)(ws + WS_KMEAN); bf16_t* ATT = (bf16_t*)(ws + WS_ATT);
    for (int U = vcu; U < 1024; U += G) {
        const int type = U >> 9, vh = (U >> 8) & 1, rem = U & 255, b = rem >> 5, h = (rem >> 2) & 7, ch = rem & 3;
        const int t = ch * 512 + tid, tok = b * SEQ + t;
        const int kmax = ch * 512 + wave * 64 + 63;
        float o[32];
#pragma unroll
        for (int d = 0; d < 32; ++d) o[d] = 0.f;
        float mx = -INFINITY, l = 0.f;
        if (type == 0) {
            u32x4 qp[12];
#pragma unroll
            for (int d8 = 0; d8 < 12; ++d8) qp[d8] = *(const u32x4*)(QM + (size_t)tok * 768 + h * 96 + d8 * 8);
#pragma unroll 1
            for (int key = 0; key <= kmax; ++key) {
                const bf16_t* kp = KM + (size_t)(b * SEQ + key) * 768 + h * 96; const bf16_t* vp = VM + (size_t)(b * SEQ + key) * 512 + h * 64 + vh * 32;
                float s = 0.f;
#pragma unroll
                for (int d8 = 0; d8 < 12; ++d8) { const u32x4 v = *(const u32x4*)(kp + d8 * 8);
#pragma unroll
                    for (int k = 0; k < 4; ++k) { s = fmaf(__uint_as_float(qp[d8][k] << 16), __uint_as_float(v[k] << 16), s); s = fmaf(__uint_as_float(qp[d8][k] & 0xffff0000u), __uint_as_float(v[k] & 0xffff0000u), s); } }
                if (key <= t) { const float mn = fmaxf(mx, s), al = __builtin_amdgcn_exp2f(mx - mn), pe = __builtin_amdgcn_exp2f(s - mn); l = l * al + pe; mx = mn;
#pragma unroll
                    for (int d8 = 0; d8 < 4; ++d8) { const u32x4 v = *(const u32x4*)(vp + d8 * 8);
#pragma unroll
                        for (int k = 0; k < 4; ++k) { o[d8 * 8 + 2 * k] = fmaf(pe, __uint_as_float(v[k] << 16), o[d8 * 8 + 2 * k] * al); o[d8 * 8 + 2 * k + 1] = fmaf(pe, __uint_as_float(v[k] & 0xffff0000u), o[d8 * 8 + 2 * k + 1] * al); } } }
            }
        } else {
            u32x4 qp[8];
#pragma unroll
            for (int d8 = 0; d8 < 8; ++d8) qp[d8] = *(const u32x4*)(QB + (size_t)tok * 512 + h * 64 + d8 * 8);
            const int cur = t >> 8;
            float gt[8];
#pragma unroll
            for (int n = 0; n < 8; ++n) gt[n] = -INFINITY;
#pragma unroll 1
            for (int n = 0; n < cur; ++n) { float s = 0.f; const float* km = kmean + (size_t)(b * 8 + n) * 512 + h * 64;
#pragma unroll
                for (int d8 = 0; d8 < 8; ++d8)
#pragma unroll
                    for (int k = 0; k < 4; ++k) { s = fmaf(__uint_as_float(qp[d8][k] << 16), km[d8 * 8 + 2 * k], s); s = fmaf(__uint_as_float(qp[d8][k] & 0xffff0000u), km[d8 * 8 + 2 * k + 1], s); }
#pragma unroll
                for (int j = 0; j < 8; ++j) gt[j] = (j == n) ? s : gt[j]; }
            unsigned sel = 0u;
#pragma unroll
            for (int n = 0; n < 8; ++n) { int cnt = 0;
#pragma unroll
                for (int n2 = 0; n2 < 8; ++n2) if (n2 != n) cnt += (n2 < cur && (gt[n2] > gt[n] || (gt[n2] == gt[n] && n2 < n))) ? 1 : 0;
                if (n < cur && cnt < 3) sel |= 1u << n; }
#pragma unroll 1
            for (int key = 0; key <= kmax; ++key) {
                const bf16_t* kp = KB + (size_t)(b * SEQ + key) * 512 + h * 64; const bf16_t* vp = PROJ + (size_t)(b * SEQ + key) * PN + C_MV + h * 64 + vh * 32;
                const int nb = key >> 8; const bool ok = (nb == cur) ? (key <= t) : (((sel >> nb) & 1u) != 0u);
                float s = 0.f;
#pragma unroll
                for (int d8 = 0; d8 < 8; ++d8) { const u32x4 v = *(const u32x4*)(kp + d8 * 8);
#pragma unroll
                    for (int k = 0; k < 4; ++k) { s = fmaf(__uint_as_float(qp[d8][k] << 16), __uint_as_float(v[k] << 16), s); s = fmaf(__uint_as_float(qp[d8][k] & 0xffff0000u), __uint_as_float(v[k] & 0xffff0000u), s); } }
                if (ok) { const float mn = fmaxf(mx, s), al = __builtin_amdgcn_exp2f(mx - mn), pe = __builtin_amdgcn_exp2f(s - mn); l = l * al + pe; mx = mn;
#pragma unroll
                    for (int d8 = 0; d8 < 4; ++d8) { const u32x4 v = *(const u32x4*)(vp + d8 * 8);
#pragma unroll
                        for (int k = 0; k < 4; ++k) { o[d8 * 8 + 2 * k] = fmaf(pe, __uint_as_float(v[k] << 16), o[d8 * 8 + 2 * k] * al); o[d8 * 8 + 2 * k + 1] = fmaf(pe, __uint_as_float(v[k] & 0xffff0000u), o[d8 * 8 + 2 * k + 1] * al); } } }
            }
        }
        const float il = 1.0f / l;
        bf16_t* op = ATT + (size_t)tok * 1024 + type * 512 + h * 64 + vh * 32;
#pragma unroll
        for (int d8 = 0; d8 < 4; ++d8) { u32x4 w; w.x = pk2(o[d8 * 8] * il, o[d8 * 8 + 1] * il); w.y = pk2(o[d8 * 8 + 2] * il, o[d8 * 8 + 3] * il); w.z = pk2(o[d8 * 8 + 4] * il, o[d8 * 8 + 5] * il); w.w = pk2(o[d8 * 8 + 6] * il, o[d8 * 8 + 7] * il);
            *(u32x4*)(op + d8 * 8) = w; }
    }
}

__device__ __forceinline__ void phase_ln1_route(const Params& p, LAS unsigned char* lds, int vcu, int G) {
    const int tid = threadIdx.x, wave = tid >> 6, lane = tid & 63;
    unsigned char* ws = p.ws;
    float* X1 = p.out; bf16_t* X1B = (bf16_t*)(ws + WS_X1B);
    int* tidx = (int*)(ws + WS_TIDX); float* tgate = (float*)(ws + WS_TGATE); unsigned* hist = (unsigned*)(ws + WS_HIST);
    LAS int* lidx = (LAS int*)lds;
    for (int chunk = vcu; chunk < NCHUNK; chunk += G) {
        for (int r = 0; r < 8; ++r) {
            const int tl = wave * 8 + r, tok = chunk * 64 + tl;
            f32x4 v[4]; float s = 0.f;
#pragma unroll
            for (int j = 0; j < 4; ++j) { v[j] = *(const f32x4*)(X1 + (size_t)tok * DM + 4 * lane + 256 * j); s += (v[j][0] + v[j][1]) + (v[j][2] + v[j][3]); }
            const float mean = wave_sum(s) * (1.0f / DM); float s2 = 0.f;
#pragma unroll
            for (int j = 0; j < 4; ++j) { v[j] = v[j] - mean; s2 += (v[j][0] * v[j][0] + v[j][1] * v[j][1]) + (v[j][2] * v[j][2] + v[j][3] * v[j][3]); }
            const float rs = 1.0f / sqrtf(wave_sum(s2) * (1.0f / DM) + LN_EPS);
#pragma unroll
            for (int j = 0; j < 4; ++j) { const f32x4 g = *(const f32x4*)(p.ln1_g + 4 * lane + 256 * j), bb = *(const f32x4*)(p.ln1_b + 4 * lane + 256 * j);
                v[j] = v[j] * rs * g + bb; *(f32x4*)(X1 + (size_t)tok * DM + 4 * lane + 256 * j) = v[j];
                u32x2 w; w.x = pk2(v[j][0], v[j][1]); w.y = pk2(v[j][2], v[j][3]); *(u32x2*)(X1B + (size_t)tok * DM + 4 * lane + 256 * j) = w; }
            float lg[32];
#pragma unroll
            for (int e = 0; e < 32; ++e) lg[e] = 0.f;
#pragma unroll
            for (int j = 0; j < 4; ++j)
#pragma unroll
                for (int i = 0; i < 4; ++i) { const float xv = v[j][i]; const float* wr = p.w_router + (size_t)(4 * lane + 256 * j + i) * 32;
#pragma unroll
                    for (int e4 = 0; e4 < 8; ++e4) { const f32x4 w = *(const f32x4*)(wr + 4 * e4); lg[4 * e4] = fmaf(xv, w[0], lg[4 * e4]); lg[4 * e4 + 1] = fmaf(xv, w[1], lg[4 * e4 + 1]); lg[4 * e4 + 2] = fmaf(xv, w[2], lg[4 * e4 + 2]); lg[4 * e4 + 3] = fmaf(xv, w[3], lg[4 * e4 + 3]); } }
            float my = 0.f;
#pragma unroll
            for (int e = 0; e < 32; ++e) { const float tsum = wave_sum(lg[e]); if ((lane & 31) == e) my = tsum; }
            my += p.b_router[lane & 31];
            if (lane >= 32) my = -INFINITY;
            float tv[4]; int ti[4];
#pragma unroll
            for (int k = 0; k < 4; ++k) { const float m = wave_max(my); const unsigned long long bal = __ballot(my == m); const int idx = __ffsll((long long)bal) - 1; tv[k] = m; ti[k] = idx; if (lane == idx) my = -INFINITY; }
            if (lane == 0) { const float e0 = 1.f, e1 = expf(tv[1] - tv[0]), e2 = expf(tv[2] - tv[0]), e3 = expf(tv[3] - tv[0]); const float is = 1.0f / (e0 + e1 + e2 + e3);
                *(f32x4*)(tgate + (size_t)tok * 4) = (f32x4){e0 * is, e1 * is, e2 * is, e3 * is};
                int* tp = tidx + (size_t)tok * 4; tp[0] = ti[0]; tp[1] = ti[1]; tp[2] = ti[2]; tp[3] = ti[3];
                lidx[tl * 4 + 0] = ti[0]; lidx[tl * 4 + 1] = ti[1]; lidx[tl * 4 + 2] = ti[2]; lidx[tl * 4 + 3] = ti[3]; }
        }
        __syncthreads();
        if (tid < 32) { unsigned c = 0; for (int a = 0; a < 256; ++a) c += (lidx[a] == tid) ? 1u : 0u; hist[chunk * 32 + tid] = c; }
        __syncthreads();
    }
}

__device__ __forceinline__ void phase_assign(const Params& p, LAS unsigned char* lds, int vcu, int G) {
    const int tid = threadIdx.x;
    unsigned char* ws = p.ws;
    const int* tidx = (const int*)(ws + WS_TIDX); const float* tgate = (const float*)(ws + WS_TGATE); const unsigned* hist = (const unsigned*)(ws + WS_HIST);
    int* dest = (int*)(ws + WS_DEST); int* row_tok = (int*)(ws + WS_ROWTOK); float* row_gate = (float*)(ws + WS_ROWGATE); int* tile_e = (int*)(ws + WS_TILEE);
    LAS int* lidx = (LAS int*)lds;
    LAS int* lcnt = (LAS int*)(lds + 1024);
    LAS int* lpre = (LAS int*)(lds + 1024 + 128);
    LAS int* lstart = (LAS int*)(lds + 1024 + 256);
    for (int chunk = vcu; chunk < NCHUNK; chunk += G) {
        if (tid < 256) lidx[tid] = tidx[chunk * 256 + tid];
        if (tid < 32) { int tot = 0, pre = 0; for (int c = 0; c < NCHUNK; ++c) { const int hv = (int)hist[c * 32 + tid]; tot += hv; pre += (c < chunk) ? hv : 0; } lcnt[tid] = tot; lpre[tid] = pre; }
        __syncthreads();
        if (tid == 0) { int s = 0; for (int e = 0; e < 32; ++e) { lstart[e] = s; s += (lcnt[e] + 255) / 256 * 256; } lstart[32] = s; }
        __syncthreads();
        if (tid < 256) { const int e = lidx[tid]; int rank = 0; for (int a = 0; a < tid; ++a) rank += (lidx[a] == e) ? 1 : 0;
            const int P = lstart[e] + lpre[e] + rank, tok = chunk * 64 + (tid >> 2);
            row_tok[P] = tok; row_gate[P] = tgate[chunk * 256 + tid]; dest[chunk * 256 + tid] = P; }
        if (chunk < 32) { const int e = chunk; for (int P = lstart[e] + lcnt[e] + tid; P < lstart[e + 1]; P += NTHREADS) { row_tok[P] = 0; row_gate[P] = 0.f; } }
        if (chunk == 0) { if (tid < 32) { for (int t = lstart[tid] / 256; t < lstart[tid + 1] / 256; ++t) tile_e[t] = tid; } if (tid == 32) tile_e[MAXTILES] = lstart[32] / 256; }
        __syncthreads();
    }
}

__device__ __forceinline__ void phase_final(const Params& p, int vcu, int G) {
    const int tid = threadIdx.x, wave = tid >> 6, lane = tid & 63;
    unsigned char* ws = p.ws;
    const int* dest = (const int*)(ws + WS_DEST); const bf16_t* Y = (const bf16_t*)(ws + WS_Y); float* X1 = p.out;
    const int gw = vcu * NWAVES + wave, NGW = G * NWAVES;
    for (int tok = gw; tok < NTOK; tok += NGW) {
        f32x4 v[4];
#pragma unroll
        for (int j = 0; j < 4; ++j) v[j] = *(const f32x4*)(X1 + (size_t)tok * DM + 4 * lane + 256 * j) * DN_ALPHA;
#pragma unroll
        for (int k = 0; k < 4; ++k) { const int P = dest[tok * 4 + k];
#pragma unroll
            for (int j = 0; j < 4; ++j) { const u32x2 w = *(const u32x2*)(Y + (size_t)P * 1024 + 4 * lane + 256 * j);
                v[j][0] += __uint_as_float(w.x << 16); v[j][1] += __uint_as_float(w.x & 0xffff0000u); v[j][2] += __uint_as_float(w.y << 16); v[j][3] += __uint_as_float(w.y & 0xffff0000u); } }
        float s = 0.f;
#pragma unroll
        for (int j = 0; j < 4; ++j) s += (v[j][0] + v[j][1]) + (v[j][2] + v[j][3]);
        const float mean = wave_sum(s) * (1.0f / DM); float s2 = 0.f;
#pragma unroll
        for (int j = 0; j < 4; ++j) { v[j] = v[j] - mean; s2 += (v[j][0] * v[j][0] + v[j][1] * v[j][1]) + (v[j][2] * v[j][2] + v[j][3] * v[j][3]); }
        const float rs = 1.0f / sqrtf(wave_sum(s2) * (1.0f / DM) + LN_EPS);
#pragma unroll
        for (int j = 0; j < 4; ++j) { const f32x4 g = *(const f32x4*)(p.ln2_g + 4 * lane + 256 * j), bb = *(const f32x4*)(p.ln2_b + 4 * lane + 256 * j);
            *(f32x4*)(p.out + (size_t)tok * DM + 4 * lane + 256 * j) = v[j] * rs * g + bb; }
    }
}

constexpr int NPHASE = 11;
__global__ void __launch_bounds__(NTHREADS, 2) fwd_kernel(Params p) {
    extern __shared__ __attribute__((aligned(16))) unsigned char lds_raw[];
    LAS unsigned char* lds = (LAS unsigned char*)lds_raw;
    const int tid = threadIdx.x;
    const int G = gridDim.x, bx = blockIdx.x;
    const int vcu = (G % 8 == 0) ? (bx % 8) * (G / 8) + bx / 8 : bx;
    unsigned char* ws = p.ws;
    volatile LAS unsigned* MISC = (volatile LAS unsigned*)(lds + MISC_OFF);
    if (tid < 32) MISC[tid] = 0u;
    __syncthreads();
    XcdBarrier bar; bar.bar = (unsigned*)(ws + WS_CTL) + CW_BAR; bar.x = 0; bar.st = nullptr;
    const bool one = (p.ph_hi - p.ph_lo) > 1;
    if (one) bar = xcd_barrier_post((unsigned*)(ws + WS_CTL) + CW_BAR, MISC + 8);
    const int lo = p.ph_lo, hi = p.ph_hi;
#ifdef ONLY_PHASE
#define IN(k) ((k) == ONLY_PHASE && lo <= (k) && (k) < hi)
#else
#define IN(k) (lo <= (k) && (k) < hi)
#endif
#define SEAM(k) do { if (IN(k) && IN((k) + 1)) xcd_barrier(bar); } while (0)

    if (IN(0)) { phase_prologue(p, lds, vcu, G); } SEAM(0);
    if (IN(1)) { GemmArgs g{(const bf16_t*)(ws + WS_XB), 1024, (const bf16_t*)(ws + WS_WIN), 1024, 1024}; DenseSched S; S.init(NTOK, PN, G, vcu);
        EpiProj E{(bf16_t*)(ws + WS_PROJ)}; gemm_phase(lds, g, S, E); } SEAM(1);
    if (IN(2)) { phase_prep(p, lds, vcu, G); } SEAM(2);
    if (IN(3)) { GemmArgs g{(const bf16_t*)(ws + WS_PROJ), PN, (const bf16_t*)(ws + WS_WUP), KUP, KUP}; DenseSched S; S.init(NTOK, NUP, G, vcu);
        EpiUp E{(bf16_t*)(ws + WS_QM), (bf16_t*)(ws + WS_KM), (bf16_t*)(ws + WS_VM), (const float*)(ws + WS_RSTD), (const float*)(ws + WS_ROPEA)}; gemm_phase(lds, g, S, E); } SEAM(3);
    if (IN(4)) { phase_attn(p, vcu, G); } SEAM(4);
    if (IN(5)) { GemmArgs g{(const bf16_t*)(ws + WS_ATT), 1024, (const bf16_t*)(ws + WS_WO), 1024, 1024}; DenseSched S; S.init(NTOK, DM, G, vcu);
        EpiWo E{p.x, p.out}; gemm_phase(lds, g, S, E); } SEAM(5);
    if (IN(6)) { phase_ln1_route(p, lds, vcu, G); } SEAM(6);
    if (IN(7)) { phase_assign(p, lds, vcu, G); } SEAM(7);
    if (IN(8)) { GemmArgs g{(const bf16_t*)(ws + WS_X1B), 1024, (const bf16_t*)(ws + WS_WGU), 1024, 1024}; GroupSched<true> S; S.init((const int*)(ws + WS_TILEE), (const int*)(ws + WS_ROWTOK), 8, 2048, G, vcu);
        EpiGateUp E{(bf16_t*)(ws + WS_H), p.b_gate, p.b_up}; gemm_phase(lds, g, S, E); } SEAM(8);
    if (IN(9)) { GemmArgs g{(const bf16_t*)(ws + WS_H), 1024, (const bf16_t*)(ws + WS_WD), 1024, 1024}; GroupSched<false> S; S.init((const int*)(ws + WS_TILEE), (const int*)(ws + WS_ROWTOK), 4, 1024, G, vcu);
        EpiDown E{(bf16_t*)(ws + WS_Y), p.b_down, (const float*)(ws + WS_ROWGATE)}; gemm_phase(lds, g, S, E); } SEAM(9);
    if (IN(10)) { phase_final(p, vcu, G); }
#undef IN
#undef SEAM
}

extern "C" void kernel_launch(void* const* d_in, const int* in_sizes, int n_in, void* d_out, int out_size, void* d_ws, size_t ws_size, hipStream_t stream) {
    static int grid = 0;
    if (grid == 0) {
        if (n_in != 20 || out_size != NTOK * DM || ws_size < WS_END) { fprintf(stderr, "kernel_launch: unexpected shapes (n_in %d out %d ws %zu)\n", n_in, out_size, ws_size); grid = -1; return; }
        int dev = 0, cus = 0, per_cu = 0;
        if (hipGetDevice(&dev) != hipSuccess || hipDeviceGetAttribute(&cus, hipDeviceAttributeMultiprocessorCount, dev) != hipSuccess) { grid = -1; return; }
        if (hipFuncSetAttribute((const void*)fwd_kernel, hipFuncAttributeMaxDynamicSharedMemorySize, LDS_BYTES) != hipSuccess) { fprintf(stderr, "kernel_launch: hipFuncSetAttribute failed\n"); grid = -1; return; }
        if (hipOccupancyMaxActiveBlocksPerMultiprocessor(&per_cu, (const void*)fwd_kernel, NTHREADS, LDS_BYTES) != hipSuccess || per_cu < 1) fprintf(stderr, "kernel_launch: occupancy query says %d\n", per_cu);
        (void)hipGetLastError();
        grid = cus;
    }
    if (grid < 0) return;
    (void)hipMemsetAsync((char*)d_ws + WS_CTL, 0, CTL_ZERO_BYTES, stream);
    Params p{};
    p.x = (const float*)d_in[0]; p.pos = (const int*)d_in[1]; p.w_in = (const float*)d_in[2]; p.q_a_norm = (const float*)d_in[3]; p.w_q_b = (const float*)d_in[4];
    p.kv_a_norm = (const float*)d_in[5]; p.w_kv_b = (const float*)d_in[6]; p.w_o = (const float*)d_in[7]; p.ln1_g = (const float*)d_in[8]; p.ln1_b = (const float*)d_in[9];
    p.w_router = (const float*)d_in[10]; p.b_router = (const float*)d_in[11]; p.w_gate = (const float*)d_in[12]; p.b_gate = (const float*)d_in[13];
    p.w_up = (const float*)d_in[14]; p.b_up = (const float*)d_in[15]; p.w_down = (const float*)d_in[16]; p.b_down = (const float*)d_in[17];
    p.ln2_g = (const float*)d_in[18]; p.ln2_b = (const float*)d_in[19];
    p.out = (float*)d_out; p.ws = (unsigned char*)d_ws;
    for (int i = 0; i < 16; ++i) p.invfA[i] = pow(500000.0, -(double)(2 * i) / 32.0);
    for (int i = 0; i < 8; ++i) p.invfB[i] = pow(500000.0, -(double)(2 * i) / 16.0);
#if MK_ONE_LAUNCH
    p.ph_lo = 0; p.ph_hi = NPHASE;
    hipLaunchKernelGGL(fwd_kernel, dim3(grid), dim3(NTHREADS), LDS_BYTES, stream, p);
#else
    for (int ph = 0; ph < NPHASE; ++ph) { p.ph_lo = ph; p.ph_hi = ph + 1; hipLaunchKernelGGL(fwd_kernel, dim3(grid), dim3(NTHREADS), LDS_BYTES, stream, p); }
#endif
}
```

```cpp
#include <hip/hip_runtime.h>
#include <cstdio>
#include <cstdint>
#include <cmath>

#ifndef MK_ONE_LAUNCH
#define MK_ONE_LAUNCH 1
#endif

#define GAS __attribute__((address_space(1)))
#define LAS __attribute__((address_space(3)))
typedef unsigned short bf16_t;
typedef short bf16x8 __attribute__((ext_vector_type(8)));
typedef float f32x4 __attribute__((ext_vector_type(4)));
typedef float f32x2 __attribute__((ext_vector_type(2)));
typedef unsigned u32x4 __attribute__((ext_vector_type(4)));
typedef unsigned u32x2 __attribute__((ext_vector_type(2)));

constexpr int NTOK = 16384, DM = 1024, SEQ = 2048, NBATCH = 8;
constexpr int PN = 2048;
constexpr int C_QL = 0, C_KVL = 256, C_KR = 384, C_MQ = 416, C_MK = 928, C_MV = 1440, IN_COLS = 1952;
constexpr int NUP = 1792, KUP = 384;
constexpr int NE = 32, TOPK = 4;
constexpr int MAXROWS = 65536 + NE * 256, MAXTILES = MAXROWS / 256;
constexpr int NCHUNK = NTOK / 64;
constexpr float LN_EPS = 1e-5f, RMS_EPS = 1e-6f;
constexpr float DN_ALPHA = 1.189207115002721f;
constexpr float LOG2E = 1.4426950408889634f;
constexpr float C2A = 0.10206207261596575f * LOG2E;
constexpr float C2B = 0.125f * LOG2E;
constexpr int NWAVES = 8, NTHREADS = 512;

constexpr size_t MiB = 1u << 20;
constexpr size_t WS_CTL = 0, CTL_ZERO_BYTES = 1 * MiB;
constexpr size_t WS_HIST = 1 * MiB;
constexpr size_t WS_TIDX = WS_HIST + 64 * 1024;
constexpr size_t WS_TGATE = WS_TIDX + 256 * 1024;
constexpr size_t WS_DEST = WS_TGATE + 256 * 1024;
constexpr size_t WS_ROWTOK = WS_DEST + 256 * 1024;
constexpr size_t WS_ROWGATE = WS_ROWTOK + 288 * 1024;
constexpr size_t WS_TILEE = WS_ROWGATE + 288 * 1024;
constexpr size_t WS_RSTD = WS_TILEE + 4 * 1024;
constexpr size_t WS_KMEAN = WS_RSTD + 128 * 1024;
static_assert(WS_KMEAN + 128 * 1024 <= 4 * MiB, "route region");
constexpr size_t WS_ROPEA = 4 * MiB;
constexpr size_t WS_ROPEB = 6 * MiB;
constexpr size_t WS_WIN = 8 * MiB;
constexpr size_t WS_WO = 12 * MiB;
constexpr size_t WS_WUP = 14 * MiB;
constexpr size_t WS_X1B = 16 * MiB;
constexpr size_t WS_WD = 48 * MiB;
constexpr size_t WS_XB = 112 * MiB;
constexpr size_t WS_PROJ = 144 * MiB;
constexpr size_t WS_QM = 208 * MiB;
constexpr size_t WS_KM = 232 * MiB;
constexpr size_t WS_VM = 256 * MiB;
constexpr size_t WS_QB = 272 * MiB;
constexpr size_t WS_KB = 288 * MiB;
constexpr size_t WS_ATT = 304 * MiB;
constexpr size_t WS_H = 112 * MiB;
constexpr size_t WS_WGU = 336 * MiB;
constexpr size_t WS_Y = 336 * MiB;
constexpr size_t WS_END = 480 * MiB;
static_assert(WS_H + (size_t)MAXROWS * 1024 * 2 <= WS_VM + 0 * MiB + 0 && WS_Y + (size_t)MAXROWS * 1024 * 2 <= WS_END, "ws map");
constexpr int CW_BAR = 4096;

constexpr int LDS_BYTES = 147456;
constexpr int MISC_OFF = 131072 + 320;

__device__ __forceinline__ float bf2f(unsigned v) { return __uint_as_float(v << 16); }
__device__ __forceinline__ unsigned f2bf(float f) { unsigned u = __float_as_uint(f); return (u + 0x7fffu + ((u >> 16) & 1u)) >> 16; }
__device__ __forceinline__ unsigned pk2(float lo, float hi) { return f2bf(lo) | (f2bf(hi) << 16); }
__device__ __forceinline__ float wave_sum(float v) {
#pragma unroll
    for (int o = 1; o < 64; o <<= 1) v += __shfl_xor(v, o);
    return v;
}
__device__ __forceinline__ float wave_max(float v) {
#pragma unroll
    for (int o = 1; o < 64; o <<= 1) v = fmaxf(v, __shfl_xor(v, o));
    return v;
}

#define XB_TMO      128
#define XB_XCNT(j)  (256  + 64 * (j))
#define XB_XSUB(j)  (1280 + 64 * (j))
#define XB_XGEN(j)  (2304 + 64 * (j))
#define XB_TOP      3328
#define XB_TOPGEN   3392
#define XCD_BAR_WORDS 3456
#define XB_SPIN_CAP (1u << 18)
__device__ __forceinline__ unsigned xb_ld(unsigned* p)              { return __hip_atomic_load(p, __ATOMIC_RELAXED, __HIP_MEMORY_SCOPE_AGENT); }
__device__ __forceinline__ unsigned xb_add(unsigned* p, unsigned v) { return __hip_atomic_fetch_add(p, v, __ATOMIC_RELAXED, __HIP_MEMORY_SCOPE_AGENT); }
__device__ __forceinline__ unsigned xb_xcc_id() { return (unsigned)__builtin_amdgcn_s_getreg((3 << 11) | 20) & 0xFu; }
#define XB_SPIN(cond, bar) do { unsigned _sp = 0; while (cond) { __builtin_amdgcn_s_sleep(1); \
    if ((++_sp & 255u) == 0u) { if (xb_ld(&(bar)[XB_TMO])) break; if (_sp > XB_SPIN_CAP) { atomicAdd(&(bar)[XB_TMO], 1u); break; } } } } while (0)
struct XcdBarrier { unsigned* bar; unsigned x; volatile LAS unsigned* st; };
__device__ __forceinline__ XcdBarrier xcd_barrier_post(unsigned* bar, volatile LAS unsigned* st) {
    XcdBarrier b; b.bar = bar; b.x = xb_xcc_id(); b.st = st;
    if (threadIdx.x == 0) (void)xb_add(&bar[XB_XCNT(b.x)], 1u);
    return b;
}
__device__ __forceinline__ void xcd_barrier_complete(unsigned* bar, unsigned x, unsigned& nloc, unsigned& nx) {
    const unsigned G = gridDim.x * gridDim.y * gridDim.z;
    unsigned sum, cnt, mine, sp = 0u;
    for (;;) {
        sum = 0u; cnt = 0u; mine = 0u;
#pragma unroll
        for (unsigned j = 0; j < 16; ++j) { const unsigned c = xb_ld(&bar[XB_XCNT(j)]); sum += c; cnt += (c > 0u) ? 1u : 0u; mine = (j == x) ? c : mine; }
        if (sum == G) break;
        __builtin_amdgcn_s_sleep(1);
        if ((++sp & 255u) == 0u) { if (xb_ld(&bar[XB_TMO])) break; if (sp > XB_SPIN_CAP) { atomicAdd(&bar[XB_TMO], 1u); break; } }
    }
    nloc = mine > 0u ? mine : 1u; nx = cnt > 0u ? cnt : 1u;
}
__device__ __forceinline__ void xcd_barrier(const XcdBarrier& b) {
    asm volatile("s_waitcnt vmcnt(0)" ::: "memory");
    __syncthreads();
    if (threadIdx.x == 0) {
        unsigned* bar = b.bar;
        __builtin_amdgcn_s_waitcnt(0);
        unsigned nloc = b.st[0], nx = b.st[1];
        if (nloc == 0u) { xcd_barrier_complete(bar, b.x, nloc, nx); b.st[0] = nloc; b.st[1] = nx; }
        const unsigned old = xb_add(&bar[XB_XSUB(b.x)], 1u);
        const unsigned gen = old / nloc;
        if (old + 1u == (gen + 1u) * nloc) {
            __builtin_amdgcn_fence(__ATOMIC_RELEASE, "agent");
            asm volatile("s_waitcnt vmcnt(0)" ::: "memory");
            const unsigned og = xb_add(&bar[XB_TOP], 1u);
            const unsigned tg = og / nx;
            if (og + 1u == (tg + 1u) * nx) xb_add(&bar[XB_TOPGEN], 1u);
            else XB_SPIN(xb_ld(&bar[XB_TOPGEN]) == tg, bar);
            __builtin_amdgcn_fence(__ATOMIC_ACQUIRE, "agent");
            xb_add(&bar[XB_XGEN(b.x)], 1u);
            asm volatile("s_waitcnt vmcnt(0)" ::: "memory");
        } else {
            XB_SPIN(xb_ld(&bar[XB_XGEN(b.x)]) == gen, bar);
            __builtin_amdgcn_fence(__ATOMIC_ACQUIRE, "agent");
            asm volatile("s_waitcnt vmcnt(0)" ::: "memory");
        }
    }
    __syncthreads();
}

struct Params {
    const float* x; const int* pos;
    const float *w_in, *q_a_norm, *w_q_b, *kv_a_norm, *w_kv_b, *w_o, *ln1_g, *ln1_b, *w_router, *b_router;
    const float *w_gate, *b_gate, *w_up, *b_up, *w_down, *b_down, *ln2_g, *ln2_b;
    float* out; unsigned char* ws;
    double invfA[16]; double invfB[8];
    int ph_lo, ph_hi;
};

struct Unit { int pm, pn, e; };
struct GemmArgs { const bf16_t* A; int lda; const bf16_t* Bt; int ldb; int K; };
template <bool PERM> __device__ __forceinline__ int ecol(int bj, int n, int wc, int fq) { return 128 * bj + 32 * wc + (PERM ? 8 * fq + 4 * n : 16 * n + 4 * fq); }

template <class Epi, class Sched>
__device__ __forceinline__ void gemm_phase_naive(LAS unsigned char* lds, const GemmArgs g, const Sched& S, const Epi& E) {
    const int tid = threadIdx.x, wid = __builtin_amdgcn_readfirstlane(tid >> 6), lane = tid & 63, wr = wid >> 2, wc = wid & 3, fr = lane & 15, fq = lane >> 4;
    Unit u;
    for (int ui = 0; S.next(ui, u); ++ui) {
        f32x4 acc[2][2][4][2];
#pragma unroll
        for (int a = 0; a < 2; ++a)
#pragma unroll
            for (int b = 0; b < 2; ++b)
#pragma unroll
                for (int m = 0; m < 4; ++m)
#pragma unroll
                    for (int n = 0; n < 2; ++n) acc[a][b][m][n] = (f32x4){0.f, 0.f, 0.f, 0.f};
        unsigned aoff[2][4];
#pragma unroll
        for (int a = 0; a < 2; ++a)
#pragma unroll
            for (int m = 0; m < 4; ++m) aoff[a][m] = (unsigned)S.arow(u, ui, 128 * a + 64 * wr + 16 * m + fr) * (unsigned)g.lda;
        const bf16_t* bb = g.Bt + (size_t)(S.brow0(u) + 32 * wc) * g.ldb;
        const unsigned bl0 = (unsigned)(4 * fq) * (unsigned)g.ldb, bl1 = (unsigned)(8 * fq) * (unsigned)g.ldb;
#pragma unroll 1
        for (int k = 0; k < g.K; k += 2) {
            float af[2][4][2];
#pragma unroll
            for (int a = 0; a < 2; ++a)
#pragma unroll
                for (int m = 0; m < 4; ++m) { const unsigned v = *(const unsigned*)(g.A + aoff[a][m] + k); af[a][m][0] = __uint_as_float(v << 16); af[a][m][1] = __uint_as_float(v & 0xffff0000u); }
#pragma unroll
            for (int b = 0; b < 2; ++b)
#pragma unroll
                for (int n = 0; n < 2; ++n)
#pragma unroll
                    for (int j = 0; j < 4; ++j) {
                        const int ccol = 128 * b + (Epi::PERM ? 4 * n : 16 * n) + j;
                        const unsigned v = *(const unsigned*)(bb + (size_t)ccol * g.ldb + ((Epi::PERM ? bl1 : bl0) + (unsigned)k));
                        const float b0 = __uint_as_float(v << 16), b1 = __uint_as_float(v & 0xffff0000u);
#pragma unroll
                        for (int a = 0; a < 2; ++a)
#pragma unroll
                            for (int m = 0; m < 4; ++m) acc[a][b][m][n][j] = fmaf(af[a][m][1], b1, fmaf(af[a][m][0], b0, acc[a][b][m][n][j]));
                    }
        }
        E(acc, u, wr, wc, fr, fq);
    }
}

namespace pg {
constexpr int BK = 64, HALF = 128, HTB = HALF * BK * 2;
__device__ __forceinline__ int lds_byte(int r, int c) { const int st = (r >> 4) * 2 + (c >> 5), rr = r & 15, cc = c & 31, ob = rr * 64 + cc * 2; return st * 1024 + (ob ^ (((ob >> 9) & 1) << 5)); }
__device__ __forceinline__ void stage_rc(int b, int& R, int& C) { const int st = b / 1024, sb = b % 1024, swz = sb ^ (((sb >> 9) & 1) << 5); R = (st >> 1) * 16 + swz / 64; C = (st & 1) * 32 + (swz % 64) / 2; }
__device__ __forceinline__ int perm32(int rho) { const int n = rho >> 4, i = rho & 15; return 8 * (i >> 2) + 4 * n + (i & 3); }
}
template <class Epi, class Sched, bool ALIGN_EPI>
__device__ __forceinline__ void gemm_phase(LAS unsigned char* lds, const GemmArgs g, const Sched& S, const Epi& E) {
    using namespace pg;
    const int tid = threadIdx.x, wid = __builtin_amdgcn_readfirstlane(tid >> 6), lane = tid & 63, wr = wid >> 2, wc = wid & 3, fr = lane & 15, fq = lane >> 4;
    const int nt = g.K / BK;
    int sR[2], sC[2], sRb[2];
#pragma unroll
    for (int i = 0; i < 2; ++i) { int R, C; stage_rc(tid * 16 + i * 8192, R, C); sR[i] = R; sC[i] = C; sRb[i] = Epi::PERM ? ((R & ~31) + perm32(R & 31)) : R; }
    const unsigned ldsw = (unsigned)wid * 1024u;
    const int aoff = lds_byte(wr * 64 + fr, fq * 8), boff = lds_byte(wc * 32 + fr, fq * 8);
    const char* Ab = (const char*)g.A; const char* Bb = (const char*)g.Bt;
#define PG_SA(b, h) (((b) * 2 + (h)) * HTB)
#define PG_SB(b, h) ((4 + (b) * 2 + (h)) * HTB)
#define PG_STAGE(bufoff, gptr, v0, v1) do { \
        __builtin_amdgcn_global_load_lds((const unsigned*)((gptr) + (v0)), (LAS unsigned*)(lds + (bufoff) + ldsw), 16, 0, 0); \
        __builtin_amdgcn_global_load_lds((const unsigned*)((gptr) + (v1)), (LAS unsigned*)(lds + (bufoff) + ldsw + 8192), 16, 0, 0); } while (0)
#define PG_LDA(dst, b, h) do { _Pragma("unroll") for (int m = 0; m < 4; ++m) _Pragma("unroll") for (int k = 0; k < 2; ++k) dst[m][k] = *(const LAS bf16x8*)(lds + PG_SA(b, h) + aoff + m * 2048 + k * 1024); } while (0)
#define PG_LDB(dst, b, h) do { _Pragma("unroll") for (int n = 0; n < 2; ++n) _Pragma("unroll") for (int k = 0; k < 2; ++k) dst[n][k] = *(const LAS bf16x8*)(lds + PG_SB(b, h) + boff + n * 2048 + k * 1024); } while (0)
#define PG_MMA(ai, bj, At, Bt) do { __builtin_amdgcn_s_setprio(1); _Pragma("unroll") for (int m = 0; m < 4; ++m) _Pragma("unroll") for (int n = 0; n < 2; ++n) _Pragma("unroll") for (int k = 0; k < 2; ++k) \
        acc[ai][bj][m][n] = __builtin_amdgcn_mfma_f32_16x16x32_bf16(Bt[n][k], At[m][k], acc[ai][bj][m][n], 0, 0, 0); __builtin_amdgcn_s_setprio(0); } while (0)
#define PG_WAIT_V(n) asm volatile("s_waitcnt vmcnt(" #n ")" ::: "memory")
#define PG_WAIT_L(n) asm volatile("s_waitcnt lgkmcnt(" #n ")" ::: "memory")
#define PG_BAR __builtin_amdgcn_s_barrier()
#define PG_SCHED __builtin_amdgcn_sched_barrier(0)
#define PG_VOFFS(u, uidx, VA, VB) do { _Pragma("unroll") for (int h = 0; h < 2; ++h) _Pragma("unroll") for (int i = 0; i < 2; ++i) { \
        VA[h][i] = ((unsigned)S.arow(u, uidx, 128 * h + sR[i]) * (unsigned)g.lda + (unsigned)sC[i]) * 2u; \
        VB[h][i] = ((unsigned)(S.brow0(u) + 128 * h + sRb[i]) * (unsigned)g.ldb + (unsigned)sC[i]) * 2u; } } while (0)
    Unit cur, nxt; int ui = 0;
    if (!S.next(0, cur)) return;
    f32x4 acc[2][2][4][2];
#pragma unroll
    for (int a = 0; a < 2; ++a)
#pragma unroll
        for (int b = 0; b < 2; ++b)
#pragma unroll
            for (int m = 0; m < 4; ++m)
#pragma unroll
                for (int n = 0; n < 2; ++n) acc[a][b][m][n] = (f32x4){0.f, 0.f, 0.f, 0.f};
    bf16x8 At[4][2], B0[2][2], B1[2][2];
    unsigned vA[2][2], vB[2][2], nvA[2][2], nvB[2][2];
    PG_VOFFS(cur, 0, vA, vB);
    PG_STAGE(PG_SB(0, 0), Bb, vB[0][0], vB[0][1]); PG_STAGE(PG_SB(0, 1), Bb, vB[1][0], vB[1][1]); PG_STAGE(PG_SA(0, 0), Ab, vA[0][0], vA[0][1]); PG_STAGE(PG_SA(0, 1), Ab, vA[1][0], vA[1][1]);
    if (wr == 1) PG_BAR;
    PG_WAIT_V(2); PG_BAR;
    PG_STAGE(PG_SB(1, 0), Bb + 128, vB[0][0], vB[0][1]); PG_STAGE(PG_SA(1, 0), Ab + 128, vA[0][0], vA[0][1]); PG_STAGE(PG_SB(1, 1), Bb + 128, vB[1][0], vB[1][1]);
    PG_WAIT_V(6); PG_BAR;
    for (;;) {
        const bool has_next = S.next(ui + 1, nxt);
        if (has_next) { PG_VOFFS(nxt, ui + 1, nvA, nvB); }
        else {
#pragma unroll
            for (int h = 0; h < 2; ++h)
#pragma unroll
                for (int i = 0; i < 2; ++i) { nvA[h][i] = vA[h][i]; nvB[h][i] = vB[h][i]; } }
        for (int t = 0; t < nt; t += 2) {
            const bool last = (t == nt - 2);
            const char* a1 = Ab + (size_t)(t + 1) * 128;
            const char* a2 = last ? Ab : Ab + (size_t)(t + 2) * 128; const char* b2 = last ? Bb : Bb + (size_t)(t + 2) * 128;
            const char* a3 = a2 + 128; const char* b3 = b2 + 128;
            unsigned wA[2][2], wB[2][2];
#pragma unroll
            for (int h = 0; h < 2; ++h)
#pragma unroll
                for (int i = 0; i < 2; ++i) { wA[h][i] = last ? nvA[h][i] : vA[h][i]; wB[h][i] = last ? nvB[h][i] : vB[h][i]; }
            PG_LDB(B0, 0, 0); PG_LDB(B1, 0, 1); PG_SCHED; PG_LDA(At, 0, 0); PG_STAGE(PG_SA(1, 1), a1, vA[1][0], vA[1][1]);
            PG_WAIT_V(8); PG_WAIT_L(0); PG_BAR; PG_MMA(0, 0, At, B0); PG_MMA(0, 1, At, B1); PG_BAR; PG_SCHED;
            PG_LDA(At, 0, 1); PG_STAGE(PG_SB(0, 0), b2, wB[0][0], wB[0][1]); PG_STAGE(PG_SB(0, 1), b2, wB[1][0], wB[1][1]); PG_STAGE(PG_SA(0, 0), a2, wA[0][0], wA[0][1]);
            PG_WAIT_V(8); PG_WAIT_L(0); PG_BAR; PG_MMA(1, 0, At, B0); PG_MMA(1, 1, At, B1); PG_BAR; PG_SCHED;
            PG_LDB(B0, 1, 0); PG_LDB(B1, 1, 1); PG_SCHED; PG_LDA(At, 1, 0); PG_STAGE(PG_SA(0, 1), a2, wA[1][0], wA[1][1]);
            PG_WAIT_V(8); PG_WAIT_L(0); PG_BAR; PG_MMA(0, 0, At, B0); PG_MMA(0, 1, At, B1); PG_BAR; PG_SCHED;
            PG_LDA(At, 1, 1); PG_STAGE(PG_SB(1, 0), b3, wB[0][0], wB[0][1]); PG_STAGE(PG_SB(1, 1), b3, wB[1][0], wB[1][1]); PG_STAGE(PG_SA(1, 0), a3, wA[0][0], wA[0][1]);
            PG_WAIT_V(8); PG_WAIT_L(0); PG_BAR; PG_MMA(1, 0, At, B0); PG_MMA(1, 1, At, B1); PG_BAR; PG_SCHED;
        }
        if constexpr (ALIGN_EPI) { if (wr == 0) PG_BAR; }
        E(acc, cur, wr, wc, fr, fq);
        if (!has_next) break;
#pragma unroll
        for (int a = 0; a < 2; ++a)
#pragma unroll
            for (int b = 0; b < 2; ++b)
#pragma unroll
                for (int m = 0; m < 4; ++m)
#pragma unroll
                    for (int n = 0; n < 2; ++n) acc[a][b][m][n] = (f32x4){0.f, 0.f, 0.f, 0.f};
        cur = nxt; ++ui;
#pragma unroll
        for (int h = 0; h < 2; ++h)
#pragma unroll
            for (int i = 0; i < 2; ++i) { vA[h][i] = nvA[h][i]; vB[h][i] = nvB[h][i]; }
        if constexpr (ALIGN_EPI) { if (wr == 1) PG_BAR; }
    }
    PG_WAIT_V(0);
    if constexpr (!ALIGN_EPI) { if (wr == 0) PG_BAR; }
    PG_BAR;
#undef PG_SA
#undef PG_SB
#undef PG_STAGE
#undef PG_LDA
#undef PG_LDB
#undef PG_MMA
#undef PG_WAIT_V
#undef PG_WAIT_L
#undef PG_BAR
#undef PG_SCHED
#undef PG_VOFFS
}

constexpr int ROWTAB_OFF = 132096, ETAB_OFF = ROWTAB_OFF + 12 * 1024, MAXU = 12;
struct DenseSched {
    int nN, nunits, G, c;
    __device__ __forceinline__ void init(LAS unsigned char*, int M, int N, int G_, int c_) { nN = N / 256; nunits = (M / 256) * nN; G = G_; c = c_; }
    __device__ __forceinline__ bool next(int i, Unit& u) const { const int L = i * G + c; if (L >= nunits) return false; u.pm = L / nN; u.pn = L % nN; u.e = 0; return true; }
    __device__ __forceinline__ int arow(const Unit& u, int, int r) const { return 256 * u.pm + r; }
    __device__ __forceinline__ int brow0(const Unit& u) const { return 256 * u.pn; }
};
template <bool GATHER> struct GroupSched {
    LAS int* rowtab; LAS int* etab; int nN, nexp_rows, nunits, G, c;
    __device__ __forceinline__ void init(LAS unsigned char* lds, const int* te, const int* rt, int nN_, int nexp_rows_, int G_, int c_) {
        rowtab = (LAS int*)(lds + ROWTAB_OFF); etab = (LAS int*)(lds + ETAB_OFF); nN = nN_; nexp_rows = nexp_rows_; G = G_; c = c_;
        nunits = __builtin_amdgcn_readfirstlane(te[MAXTILES]) * nN_;
        for (int i = 0; i < MAXU; ++i) { const int L = i * G + c; if (L >= nunits) break; const int pm = L / nN;
            if (threadIdx.x == 0) etab[i] = te[pm];
            if (GATHER && threadIdx.x < 256) rowtab[i * 256 + threadIdx.x] = rt[256 * pm + threadIdx.x]; }
        __syncthreads();
    }
    __device__ __forceinline__ bool next(int i, Unit& u) const { const int L = i * G + c; if (L >= nunits || i >= MAXU) return false; u.pm = L / nN; u.pn = L % nN; u.e = etab[i]; return true; }
    __device__ __forceinline__ int arow(const Unit& u, int ui, int r) const { return GATHER ? rowtab[ui * 256 + r] : 256 * u.pm + r; }
    __device__ __forceinline__ int brow0(const Unit& u) const { return u.e * nexp_rows + 256 * u.pn; }
};

struct EpiProj {
    static constexpr bool PERM = false;
    bf16_t* O;
    __device__ __forceinline__ void operator()(const f32x4 (&acc)[2][2][4][2], const Unit& u, int wr, int wc, int fr, int fq) const {
#pragma unroll
        for (int a = 0; a < 2; ++a)
#pragma unroll
            for (int m = 0; m < 4; ++m) { const int row = 256 * u.pm + 128 * a + 64 * wr + 16 * m + fr;
#pragma unroll
                for (int b = 0; b < 2; ++b)
#pragma unroll
                    for (int n = 0; n < 2; ++n) { const int col = 256 * u.pn + ecol<PERM>(b, n, wc, fq); const f32x4 v = acc[a][b][m][n];
                        u32x2 w; w.x = pk2(v[0], v[1]); w.y = pk2(v[2], v[3]); *(u32x2*)(O + (size_t)row * PN + col) = w; } }
    }
};
struct EpiUp {
    static constexpr bool PERM = false;
    bf16_t *QM, *KM, *VM; const float* rstd; const float* ropeA;
    __device__ __forceinline__ void operator()(const f32x4 (&acc)[2][2][4][2], const Unit& u, int wr, int wc, int fr, int fq) const {
#pragma unroll
        for (int a = 0; a < 2; ++a)
#pragma unroll
            for (int m = 0; m < 4; ++m) { const int row = 256 * u.pm + 128 * a + 64 * wr + 16 * m + fr;
                const float rq = rstd[2 * row] * C2A, rkv = rstd[2 * row + 1];
#pragma unroll
                for (int b = 0; b < 2; ++b) {
                    const int gidx = 8 * u.pn + 4 * b + wc;
                    if (gidx < 24) {
                        const int h = gidx / 3, part = gidx % 3;
                        f32x4 v0 = acc[a][b][m][0] * rq, v1 = acc[a][b][m][1] * rq;
                        if (part == 2) { const f32x4 c = *(const f32x4*)(ropeA + (size_t)row * 32 + 4 * fq), s = *(const f32x4*)(ropeA + (size_t)row * 32 + 16 + 4 * fq);
                            const f32x4 o0 = v0 * c - v1 * s, o1 = v1 * c + v0 * s; v0 = o0; v1 = o1; }
                        bf16_t* p = QM + (size_t)row * 768 + h * 96 + part * 32 + 4 * fq;
                        u32x2 w; w.x = pk2(v0[0], v0[1]); w.y = pk2(v0[2], v0[3]); *(u32x2*)p = w;
                        w.x = pk2(v1[0], v1[1]); w.y = pk2(v1[2], v1[3]); *(u32x2*)(p + 16) = w;
                    } else {
                        const int g2 = gidx - 24, h = g2 >> 2, part = g2 & 3;
                        const f32x4 v0 = acc[a][b][m][0] * rkv, v1 = acc[a][b][m][1] * rkv;
                        bf16_t* p = (part < 2) ? (KM + (size_t)row * 768 + h * 96 + part * 32 + 4 * fq) : (VM + (size_t)row * 512 + h * 64 + (part - 2) * 32 + 4 * fq);
                        u32x2 w; w.x = pk2(v0[0], v0[1]); w.y = pk2(v0[2], v0[3]); *(u32x2*)p = w;
                        w.x = pk2(v1[0], v1[1]); w.y = pk2(v1[2], v1[3]); *(u32x2*)(p + 16) = w;
                    }
                } }
    }
};
struct EpiWo {
    static constexpr bool PERM = false;
    const float* x; float* O;
    __device__ __forceinline__ void operator()(const f32x4 (&acc)[2][2][4][2], const Unit& u, int wr, int wc, int fr, int fq) const {
#pragma unroll
        for (int a = 0; a < 2; ++a)
#pragma unroll
            for (int m = 0; m < 4; ++m) { const int row = 256 * u.pm + 128 * a + 64 * wr + 16 * m + fr;
#pragma unroll
                for (int b = 0; b < 2; ++b)
#pragma unroll
                    for (int n = 0; n < 2; ++n) { const size_t off = (size_t)row * DM + 256 * u.pn + ecol<PERM>(b, n, wc, fq);
                        const f32x4 xv = *(const f32x4*)(x + off); *(f32x4*)(O + off) = xv * DN_ALPHA + acc[a][b][m][n]; } }
    }
};
struct EpiGateUp {
    static constexpr bool PERM = false;
    bf16_t* H; const float *bg, *bu;
    __device__ __forceinline__ void operator()(const f32x4 (&acc)[2][2][4][2], const Unit& u, int wr, int wc, int fr, int fq) const {
#pragma unroll
        for (int n = 0; n < 2; ++n) { const int hc = 128 * u.pn + 32 * wc + 16 * n + 4 * fq;
            const f32x4 vbg = *(const f32x4*)(bg + (size_t)u.e * 1024 + hc), vbu = *(const f32x4*)(bu + (size_t)u.e * 1024 + hc);
#pragma unroll
            for (int a = 0; a < 2; ++a)
#pragma unroll
                for (int m = 0; m < 4; ++m) { const int row = 256 * u.pm + 128 * a + 64 * wr + 16 * m + fr;
                    const f32x4 gv = acc[a][0][m][n] + vbg, uv = acc[a][1][m][n] + vbu; float hv[4];
#pragma unroll
                    for (int j = 0; j < 4; ++j) { const float gg = fminf(gv[j], 7.0f), uu = fminf(fmaxf(uv[j], -7.0f), 7.0f);
                        const float sg = 1.0f / (1.0f + __builtin_amdgcn_exp2f(-1.702f * LOG2E * gg)); hv[j] = gg * sg * (uu + 1.0f); }
                    u32x2 w; w.x = pk2(hv[0], hv[1]); w.y = pk2(hv[2], hv[3]); *(u32x2*)(H + (size_t)row * 1024 + hc) = w; } }
    }
};
struct EpiDown {
    static constexpr bool PERM = false;
    bf16_t* Y; const float* bd; const float* row_gate;
    __device__ __forceinline__ void operator()(const f32x4 (&acc)[2][2][4][2], const Unit& u, int wr, int wc, int fr, int fq) const {
#pragma unroll
        for (int a = 0; a < 2; ++a)
#pragma unroll
            for (int m = 0; m < 4; ++m) { const int row = 256 * u.pm + 128 * a + 64 * wr + 16 * m + fr; const float gw = row_gate[row];
#pragma unroll
                for (int b = 0; b < 2; ++b)
#pragma unroll
                    for (int n = 0; n < 2; ++n) { const int col = 256 * u.pn + ecol<PERM>(b, n, wc, fq); const f32x4 bv = *(const f32x4*)(bd + (size_t)u.e * 1024 + col);
                        const f32x4 v = (acc[a][b][m][n] + bv) * gw; u32x2 w; w.x = pk2(v[0], v[1]); w.y = pk2(v[2], v[3]); *(u32x2*)(Y + (size_t)row * 1024 + col) = w; } }
    }
};

__device__ __forceinline__ void tr_item(const float* W, int ldw, int k0, int n0, bf16_t* WT, int ldt, int orow0, int ocol0, const float* kscale, LAS float* scr, int lane) {
#pragma unroll 8
    for (int i = 0; i < 32; ++i) { const int kk = 2 * i + (lane >> 5); float v = W[(size_t)(k0 + kk) * ldw + n0 + (lane & 31)]; if (kscale) v *= kscale[k0 + kk]; scr[kk * 33 + (lane & 31)] = v; }
    asm volatile("s_waitcnt lgkmcnt(0)" ::: "memory");
    const int c = lane & 7;
#pragma unroll
    for (int j = 0; j < 4; ++j) { const int n = (lane >> 3) + 8 * j; const LAS float* s = scr + (8 * c) * 33 + n;
        u32x4 o; o.x = pk2(s[0 * 33], s[1 * 33]); o.y = pk2(s[2 * 33], s[3 * 33]); o.z = pk2(s[4 * 33], s[5 * 33]); o.w = pk2(s[6 * 33], s[7 * 33]);
        *(u32x4*)(WT + (size_t)(orow0 + n) * ldt + ocol0 + 8 * c) = o; }
    asm volatile("s_waitcnt lgkmcnt(0)" ::: "memory");
}
__device__ __forceinline__ void phase_prologue(const Params& p, LAS unsigned char* lds, int vcu, int G) {
    const int tid = threadIdx.x, wave = tid >> 6, lane = tid & 63;
    unsigned char* ws = p.ws;
    LAS float* scr = (LAS float*)(lds + wave * 16384);
    const int gw = vcu * NWAVES + wave, NGW = G * NWAVES;
    bf16_t* WinT = (bf16_t*)(ws + WS_WIN); bf16_t* WoT = (bf16_t*)(ws + WS_WO); bf16_t* WupT = (bf16_t*)(ws + WS_WUP);
    bf16_t* WguT = (bf16_t*)(ws + WS_WGU); bf16_t* WdT = (bf16_t*)(ws + WS_WD);
    constexpr int I_IN = 16 * 61, I_QB = 4 * 24, I_KVB = 2 * 32, I_O = 16 * 32, I_E = 16 * 32;
    constexpr int NITEMS = I_IN + I_QB + I_KVB + I_O + 3 * NE * I_E;
    for (int it = gw; it < NITEMS; it += NGW) {
        int r = it;
        if (r < I_IN) { const int kb = r / 61, nb = r % 61; tr_item(p.w_in, IN_COLS, 64 * kb, 32 * nb, WinT, 1024, 32 * nb, 64 * kb, nullptr, scr, lane); continue; } r -= I_IN;
        if (r < I_QB) { const int kb = r / 24, nb = r % 24; tr_item(p.w_q_b, 768, 64 * kb, 32 * nb, WupT, KUP, 32 * nb, 64 * kb, p.q_a_norm, scr, lane); continue; } r -= I_QB;
        if (r < I_KVB) { const int kb = r / 32, nb = r % 32; tr_item(p.w_kv_b, 1024, 64 * kb, 32 * nb, WupT, KUP, 768 + 32 * nb, 256 + 64 * kb, p.kv_a_norm, scr, lane); continue; } r -= I_KVB;
        if (r < I_O) { const int kb = r / 32, nb = r % 32; tr_item(p.w_o, 1024, 64 * kb, 32 * nb, WoT, 1024, 32 * nb, 64 * kb, nullptr, scr, lane); continue; } r -= I_O;
        const int mat = r / (NE * I_E), rr = r % (NE * I_E), e = rr / I_E, q = rr % I_E, kb = q / 32, nb = q % 32, n0 = 32 * nb;
        if (mat == 0) tr_item(p.w_gate + (size_t)e * 1048576, 1024, 64 * kb, n0, WguT, 1024, e * 2048 + (n0 >> 7) * 256 + (n0 & 127), 64 * kb, nullptr, scr, lane);
        else if (mat == 1) tr_item(p.w_up + (size_t)e * 1048576, 1024, 64 * kb, n0, WguT, 1024, e * 2048 + (n0 >> 7) * 256 + 128 + (n0 & 127), 64 * kb, nullptr, scr, lane);
        else tr_item(p.w_down + (size_t)e * 1048576, 1024, 64 * kb, n0, WdT, 1024, e * 1024 + n0, 64 * kb, nullptr, scr, lane);
    }
    const int gt = vcu * NTHREADS + tid, NGT = G * NTHREADS;
    for (int i = gt; i < 96 * 128; i += NGT) *(u32x4*)(WinT + (size_t)IN_COLS * 1024 + (size_t)i * 8) = (u32x4){0u, 0u, 0u, 0u};
    for (int i = gt; i < 768 * 16; i += NGT) { const int r = i / 16, c = i % 16; *(u32x4*)(WupT + (size_t)r * KUP + 256 + c * 8) = (u32x4){0u, 0u, 0u, 0u}; }
    for (int i = gt; i < 1024 * 32; i += NGT) { const int r = i / 32, c = i % 32; *(u32x4*)(WupT + (size_t)(768 + r) * KUP + c * 8) = (u32x4){0u, 0u, 0u, 0u}; }
    bf16_t* XB = (bf16_t*)(ws + WS_XB);
    for (int i = gt; i < NTOK * DM / 8; i += NGT) { const f32x4 a = *(const f32x4*)(p.x + (size_t)i * 8), b = *(const f32x4*)(p.x + (size_t)i * 8 + 4);
        u32x4 o; o.x = pk2(a[0], a[1]); o.y = pk2(a[2], a[3]); o.z = pk2(b[0], b[1]); o.w = pk2(b[2], b[3]); *(u32x4*)(XB + (size_t)i * 8) = o; }
    float* ropeA = (float*)(ws + WS_ROPEA); float* ropeB = (float*)(ws + WS_ROPEB);
    for (int i = gt; i < NTOK * 24; i += NGT) { const int tok = i / 24, j = i % 24; const double f = (j < 16) ? p.invfA[j] : p.invfB[j - 16];
        const double rev = (double)p.pos[tok] * f * 0.15915494309189535; const float fr = (float)(rev - __builtin_rint(rev));
        const float cs = __builtin_amdgcn_cosf(fr), sn = __builtin_amdgcn_sinf(fr);
        if (j < 16) { ropeA[(size_t)tok * 32 + j] = cs; ropeA[(size_t)tok * 32 + 16 + j] = sn; } else { ropeB[(size_t)tok * 16 + (j - 16)] = cs; ropeB[(size_t)tok * 16 + 8 + (j - 16)] = sn; } }
}

__device__ __forceinline__ void phase_prep(const Params& p, LAS unsigned char* lds, int vcu, int G) {
    const int tid = threadIdx.x, wave = tid >> 6, lane = tid & 63;
    unsigned char* ws = p.ws;
    const bf16_t* PROJ = (const bf16_t*)(ws + WS_PROJ);
    float* rstd = (float*)(ws + WS_RSTD); const float* ropeA = (const float*)(ws + WS_ROPEA); const float* ropeB = (const float*)(ws + WS_ROPEB);
    bf16_t* KM = (bf16_t*)(ws + WS_KM); bf16_t* QB = (bf16_t*)(ws + WS_QB); bf16_t* KB = (bf16_t*)(ws + WS_KB); float* kmean = (float*)(ws + WS_KMEAN);
    const int gw = vcu * NWAVES + wave, NGW = G * NWAVES;
    for (int row = gw; row < NTOK; row += NGW) {
        float s = 0.f;
        if (lane < 48) { const u32x4 v = *(const u32x4*)(PROJ + (size_t)row * PN + lane * 8);
#pragma unroll
            for (int q = 0; q < 4; ++q) { const float a = __uint_as_float(v[q] << 16), b = __uint_as_float(v[q] & 0xffff0000u); s += a * a + b * b; } }
#pragma unroll
        for (int o = 1; o < 32; o <<= 1) s += __shfl_xor(s, o);
        if (lane == 0) rstd[2 * row] = 1.0f / sqrtf(s * (1.0f / 256.0f) + RMS_EPS);
        if (lane == 32) rstd[2 * row + 1] = 1.0f / sqrtf(s * (1.0f / 128.0f) + RMS_EPS);
    }
    const int gt = vcu * NTHREADS + tid, NGT = G * NTHREADS;
    for (int i = gt; i < NTOK * 16; i += NGT) { const int tok = i >> 4, j = i & 15;
        const float x1 = bf2f(PROJ[(size_t)tok * PN + C_KR + j]), x2 = bf2f(PROJ[(size_t)tok * PN + C_KR + 16 + j]);
        const float c = ropeA[(size_t)tok * 32 + j], s = ropeA[(size_t)tok * 32 + 16 + j];
        const bf16_t o1 = (bf16_t)f2bf(x1 * c - x2 * s), o2 = (bf16_t)f2bf(x2 * c + x1 * s);
#pragma unroll
        for (int h = 0; h < 8; ++h) { KM[(size_t)tok * 768 + h * 96 + 64 + j] = o1; KM[(size_t)tok * 768 + h * 96 + 80 + j] = o2; } }
    for (int unit = vcu; unit < 64; unit += G) {
        const int c = tid, d = c & 63; float ksum = 0.f;
        for (int t = 0; t < 256; ++t) { const int tok = unit * 256 + t; const bf16_t* pr = PROJ + (size_t)tok * PN;
            float qv = bf2f(pr[C_MQ + c]), kv = bf2f(pr[C_MK + c]);
            if (d < 16) { const int j = d & 7; const float cs = ropeB[(size_t)tok * 16 + j], sn = ropeB[(size_t)tok * 16 + 8 + j];
                if (d < 8) { const float q2 = bf2f(pr[C_MQ + c + 8]), k2 = bf2f(pr[C_MK + c + 8]); qv = qv * cs - q2 * sn; kv = kv * cs - k2 * sn; }
                else { const float q1 = bf2f(pr[C_MQ + c - 8]), k1 = bf2f(pr[C_MK + c - 8]); qv = qv * cs + q1 * sn; kv = kv * cs + k1 * sn; } }
            QB[(size_t)tok * 512 + c] = (bf16_t)f2bf(qv * C2B); KB[(size_t)tok * 512 + c] = (bf16_t)f2bf(kv); ksum += kv; }
        kmean[(size_t)unit * 512 + c] = ksum * (1.0f / 256.0f);
    }
}

typedef float f32x16 __attribute__((ext_vector_type(16)));
typedef short s16x4 __attribute__((ext_vector_type(4)));
namespace fa {
constexpr int KBUF = 12288, VBUF = 8192, BUF = KBUF + VBUF, WS_OFF = 2 * BUF, LDS_NEED = WS_OFF + 8 * 256;
constexpr float THR = 8.0f;
__device__ __forceinline__ int crow(int r, int hi) { return (r & 3) + 8 * (r >> 2) + 4 * hi; }
__device__ __forceinline__ unsigned cvtpk(float lo, float hi) { typedef __bf16 bf2 __attribute__((ext_vector_type(2))); f32x2 v = {lo, hi}; bf2 b = __builtin_convertvector(v, bf2); return __builtin_bit_cast(unsigned, b); }
__device__ __forceinline__ float xhalf_max(float m) { auto rr = __builtin_amdgcn_permlane32_swap(__float_as_uint(m), __float_as_uint(m), false, false); return fmaxf(__uint_as_float(rr[0]), __uint_as_float(rr[1])); }
__device__ __forceinline__ float xhalf_sum(float m) { auto rr = __builtin_amdgcn_permlane32_swap(__float_as_uint(m), __float_as_uint(m), false, false); return __uint_as_float(rr[0]) + __uint_as_float(rr[1]); }
}
template <int DQK>
__device__ __forceinline__ void attn_unit(LAS unsigned char* lds, const bf16_t* Q, int qpitch, const bf16_t* K, int kpitch, const bf16_t* V, int vpitch, bf16_t* O, int qb, const float* kmean) {
    using namespace fa;
    constexpr int ND = DQK / 16, NCH = DQK / 8;
    const int tid = threadIdx.x, lane = tid & 63, r32 = lane & 31, hi = lane >> 5, wid = __builtin_amdgcn_readfirstlane(tid >> 6);
    const int q0 = qb * 256, qrel = wid * 32 + r32;
    LAS float* wsf = (LAS float*)(lds + WS_OFF) + wid * 64;
    bf16x8 qr[ND];
#pragma unroll
    for (int d0 = 0; d0 < ND; ++d0) qr[d0] = *(const bf16x8*)(Q + (size_t)(q0 + qrel) * qpitch + d0 * 16 + hi * 8);
    unsigned sel = 0xffu;
    if (kmean) {
        float gt[8];
#pragma unroll
        for (int n = 0; n < 8; ++n) gt[n] = -INFINITY;
#pragma unroll 1
        for (int n = 0; n < qb; ++n) { float s = 0.f; const float* km = kmean + (size_t)n * 512;
#pragma unroll
            for (int d0 = 0; d0 < ND; ++d0) { const f32x4 k0 = *(const f32x4*)(km + d0 * 16 + hi * 8), k1 = *(const f32x4*)(km + d0 * 16 + hi * 8 + 4);
#pragma unroll
                for (int j = 0; j < 4; ++j) { s = fmaf(bf2f((unsigned short)qr[d0][j]), k0[j], s); s = fmaf(bf2f((unsigned short)qr[d0][4 + j]), k1[j], s); } }
            s = xhalf_sum(s);
#pragma unroll
            for (int j = 0; j < 8; ++j) gt[j] = (j == n) ? s : gt[j]; }
        sel = 0u;
#pragma unroll
        for (int n = 0; n < 8; ++n) { int cnt = 0;
#pragma unroll
            for (int n2 = 0; n2 < 8; ++n2) if (n2 != n) cnt += (n2 < qb && (gt[n2] > gt[n] || (gt[n2] == gt[n] && n2 < n))) ? 1 : 0;
            if (n < qb && cnt < 3) sel |= 1u << n; }
    }
    const bf16_t* ksrc = K + (size_t)lane * kpitch;
    const bf16_t* vsrc = V + (size_t)(16 * (wid & 3) + (lane >> 2)) * vpitch + (wid >> 2) * 32 + (lane & 3) * 8;
#define FA_DMA(ti, buf) do { \
        __builtin_amdgcn_global_load_lds((const unsigned*)(ksrc + (size_t)(ti) * 64 * kpitch + wid * 8), (LAS unsigned*)(lds + (buf) * BUF + wid * 1024), 16, 0, 0); \
        if (NCH > 8 && wid < NCH - 8) __builtin_amdgcn_global_load_lds((const unsigned*)(ksrc + (size_t)(ti) * 64 * kpitch + (wid + 8) * 8), (LAS unsigned*)(lds + (buf) * BUF + (wid + 8) * 1024), 16, 0, 0); \
        __builtin_amdgcn_global_load_lds((const unsigned*)(vsrc + (size_t)(ti) * 64 * vpitch), (LAS unsigned*)(lds + (buf) * BUF + KBUF + wid * 1024), 16, 0, 0); } while (0)
#define FA_TILE(i) (((i) < 4) ? 4 * qb + (i) : (i) - 4)
    const int NT = 4 * qb + 4;
    float mhat = 0.f, l_reg = 0.f; f32x16 o[2]; o[0] = f32x16{}; o[1] = f32x16{}; f32x16 negm = f32x16{};
    const int koff = hi * 1024 + r32 * 16;
    const int voff = ((lane >> 4) & 1) * 32 + (lane & 3) * 8 + (4 * hi + ((lane & 15) >> 2)) * 64;
    FA_DMA(FA_TILE(0), 0);
    asm volatile("s_waitcnt vmcnt(0)" ::: "memory"); __builtin_amdgcn_s_barrier(); asm volatile("" ::: "memory");
    for (int i = 0; i < NT; ++i) {
        const int buf = i & 1;
        if (i + 1 < NT) { const int tn = FA_TILE(i + 1); FA_DMA(tn, buf ^ 1); }
        const bool band = i < 4;
        if (!(band && 2 * i > wid)) {
            const LAS unsigned char* kb = lds + buf * BUF + koff;
            f32x16 p0 = negm, p1 = negm;
#pragma unroll
            for (int d0 = 0; d0 < ND; ++d0) { const bf16x8 a0 = *(const LAS bf16x8*)(kb + d0 * 2048), a1 = *(const LAS bf16x8*)(kb + d0 * 2048 + 512);
                p0 = __builtin_amdgcn_mfma_f32_32x32x16_bf16(a0, qr[d0], p0, 0, 0, 0); p1 = __builtin_amdgcn_mfma_f32_32x32x16_bf16(a1, qr[d0], p1, 0, 0, 0); }
            if (band) { if (64 * i + 63 > 32 * wid) {
#pragma unroll
                    for (int r = 0; r < 16; ++r) { const int kv = 64 * i + crow(r, hi); if (kv > qrel) p0[r] = -INFINITY; if (kv + 32 > qrel) p1[r] = -INFINITY; } } }
            else if (!((sel >> ((i - 4) >> 2)) & 1u)) {
#pragma unroll
                for (int r = 0; r < 16; ++r) { p0[r] = -INFINITY; p1[r] = -INFINITY; } }
            float rm = fmaxf(p0[0], p1[0]);
#pragma unroll
            for (int r = 1; r < 16; ++r) rm = fmaxf(rm, fmaxf(p0[r], p1[r]));
            rm = xhalf_max(rm);
            if (i == 0 || __any(rm > THR)) {
                const float dl = (i == 0) ? rm : fmaxf(rm, 0.f); mhat += dl;
#pragma unroll
                for (int r = 0; r < 16; ++r) { p0[r] -= dl; p1[r] -= dl; negm[r] = -mhat; }
                if (i != 0) { const float f = __builtin_amdgcn_exp2f(-dl); l_reg *= f; if (hi == 0) wsf[r32] = f;
                    asm volatile("s_waitcnt lgkmcnt(0)" ::: "memory");
#pragma unroll
                    for (int r = 0; r < 16; ++r) { const float fr_ = wsf[crow(r, hi)]; o[0][r] *= fr_; o[1][r] *= fr_; } }
            }
            float sacc = 0.f;
#pragma unroll
            for (int r = 0; r < 16; ++r) { p0[r] = __builtin_amdgcn_exp2f(p0[r]); p1[r] = __builtin_amdgcn_exp2f(p1[r]); sacc += p0[r] + p1[r]; }
            l_reg += sacc;
            u32x4 pw[4];
#pragma unroll
            for (int s = 0; s < 2; ++s)
#pragma unroll
                for (int j = 0; j < 4; ++j) { pw[s][j] = cvtpk(p0[8 * s + 2 * j], p0[8 * s + 2 * j + 1]); pw[2 + s][j] = cvtpk(p1[8 * s + 2 * j], p1[8 * s + 2 * j + 1]); }
            const LAS unsigned char* vb = lds + buf * BUF + KBUF + voff;
#pragma unroll
            for (int d0 = 0; d0 < 2; ++d0)
#pragma unroll
                for (int s = 0; s < 4; ++s) {
                    const s16x4 lo = __builtin_bit_cast(s16x4, __builtin_amdgcn_ds_read_tr16_b64_v4i16((LAS s16x4*)(vb + d0 * 4096 + s * 1024)));
                    const s16x4 hh = __builtin_bit_cast(s16x4, __builtin_amdgcn_ds_read_tr16_b64_v4i16((LAS s16x4*)(vb + d0 * 4096 + s * 1024 + 512)));
                    const bf16x8 vf = (bf16x8){lo[0], lo[1], lo[2], lo[3], hh[0], hh[1], hh[2], hh[3]};
                    o[d0] = __builtin_amdgcn_mfma_f32_32x32x16_bf16(__builtin_bit_cast(bf16x8, pw[s]), vf, o[d0], 0, 0, 0); }
        }
        asm volatile("s_waitcnt vmcnt(0) lgkmcnt(0)" ::: "memory"); __builtin_amdgcn_s_barrier(); asm volatile("" ::: "memory");
    }
    l_reg = xhalf_sum(l_reg);
    if (hi == 0) wsf[32 + r32] = l_reg;
    asm volatile("s_waitcnt lgkmcnt(0)" ::: "memory");
#pragma unroll
    for (int r = 0; r < 16; ++r) { const float rl = 1.0f / wsf[32 + crow(r, hi)]; bf16_t* op = O + (size_t)(q0 + wid * 32 + crow(r, hi)) * 1024 + r32;
        op[0] = (bf16_t)f2bf(o[0][r] * rl); op[32] = (bf16_t)f2bf(o[1][r] * rl); }
    asm volatile("s_waitcnt lgkmcnt(0)" ::: "memory"); __builtin_amdgcn_s_barrier(); asm volatile("" ::: "memory");
#undef FA_DMA
#undef FA_TILE
}
__device__ __forceinline__ void phase_attn_fast(const Params& p, LAS unsigned char* lds, int vcu, int G) {
    unsigned char* ws = p.ws;
    const bf16_t* QM = (const bf16_t*)(ws + WS_QM); const bf16_t* KM = (const bf16_t*)(ws + WS_KM); const bf16_t* VM = (const bf16_t*)(ws + WS_VM);
    const bf16_t* QB = (const bf16_t*)(ws + WS_QB); const bf16_t* KB = (const bf16_t*)(ws + WS_KB); const bf16_t* PROJ = (const bf16_t*)(ws + WS_PROJ);
    const float* kmean = (const float*)(ws + WS_KMEAN); bf16_t* ATT = (bf16_t*)(ws + WS_ATT);
    for (int su = vcu; su < 256; su += G) {
        const int bh = su >> 2, j = su & 3, b = bh >> 3, h = bh & 7; const size_t r0 = (size_t)b * SEQ;
#pragma unroll 1
        for (int k = 0; k < 2; ++k) { const int qb = k ? 7 - j : j;
            attn_unit<96>(lds, QM + r0 * 768 + h * 96, 768, KM + r0 * 768 + h * 96, 768, VM + r0 * 512 + h * 64, 512, ATT + r0 * 1024 + h * 64, qb, nullptr);
            attn_unit<64>(lds, QB + r0 * 512 + h * 64, 512, KB + r0 * 512 + h * 64, 512, PROJ + r0 * PN + C_MV + h * 64, PN, ATT + r0 * 1024 + 512 + h * 64, qb, kmean + (size_t)(b * 8) * 512 + h * 64); }
    }
}

__device__ __forceinline__ void phase_attn(const Params& p, int vcu, int G) {
    const int tid = threadIdx.x, wave = __builtin_amdgcn_readfirstlane(tid >> 6);
    unsigned char* ws = p.ws;
    const bf16_t* QM = (const bf16_t*)(ws + WS_QM); const bf16_t* KM = (const bf16_t*)(ws + WS_KM); const bf16_t* VM = (const bf16_t*)(ws + WS_VM);
    const bf16_t* QB = (const bf16_t*)(ws + WS_QB); const bf16_t* KB = (const bf16_t*)(ws + WS_KB); const bf16_t* PROJ = (const bf16_t*)(ws + WS_PROJ);
    const float* kmean = (const float*)(ws + WS_KMEAN); bf16_t* ATT = (bf16_t*)(ws + WS_ATT);
    for (int U = vcu; U < 1024; U += G) {
        const int type = U >> 9, vh = (U >> 8) & 1, rem = U & 255, b = rem >> 5, h = (rem >> 2) & 7, ch = rem & 3;
        const int t = ch * 512 + tid, tok = b * SEQ + t;
        const int kmax = ch * 512 + wave * 64 + 63;
        float o[32];
#pragma unroll
        for (int d = 0; d < 32; ++d) o[d] = 0.f;
        float mx = -INFINITY, l = 0.f;
        if (type == 0) {
            u32x4 qp[12];
#pragma unroll
            for (int d8 = 0; d8 < 12; ++d8) qp[d8] = *(const u32x4*)(QM + (size_t)tok * 768 + h * 96 + d8 * 8);
#pragma unroll 1
            for (int key = 0; key <= kmax; ++key) {
                const bf16_t* kp = KM + (size_t)(b * SEQ + key) * 768 + h * 96; const bf16_t* vp = VM + (size_t)(b * SEQ + key) * 512 + h * 64 + vh * 32;
                float s = 0.f;
#pragma unroll
                for (int d8 = 0; d8 < 12; ++d8) { const u32x4 v = *(const u32x4*)(kp + d8 * 8);
#pragma unroll
                    for (int k = 0; k < 4; ++k) { s = fmaf(__uint_as_float(qp[d8][k] << 16), __uint_as_float(v[k] << 16), s); s = fmaf(__uint_as_float(qp[d8][k] & 0xffff0000u), __uint_as_float(v[k] & 0xffff0000u), s); } }
                if (key <= t) { const float mn = fmaxf(mx, s), al = __builtin_amdgcn_exp2f(mx - mn), pe = __builtin_amdgcn_exp2f(s - mn); l = l * al + pe; mx = mn;
#pragma unroll
                    for (int d8 = 0; d8 < 4; ++d8) { const u32x4 v = *(const u32x4*)(vp + d8 * 8);
#pragma unroll
                        for (int k = 0; k < 4; ++k) { o[d8 * 8 + 2 * k] = fmaf(pe, __uint_as_float(v[k] << 16), o[d8 * 8 + 2 * k] * al); o[d8 * 8 + 2 * k + 1] = fmaf(pe, __uint_as_float(v[k] & 0xffff0000u), o[d8 * 8 + 2 * k + 1] * al); } } }
            }
        } else {
            u32x4 qp[8];
#pragma unroll
            for (int d8 = 0; d8 < 8; ++d8) qp[d8] = *(const u32x4*)(QB + (size_t)tok * 512 + h * 64 + d8 * 8);
            const int cur = t >> 8;
            float gt[8];
#pragma unroll
            for (int n = 0; n < 8; ++n) gt[n] = -INFINITY;
#pragma unroll 1
            for (int n = 0; n < cur; ++n) { float s = 0.f; const float* km = kmean + (size_t)(b * 8 + n) * 512 + h * 64;
#pragma unroll
                for (int d8 = 0; d8 < 8; ++d8)
#pragma unroll
                    for (int k = 0; k < 4; ++k) { s = fmaf(__uint_as_float(qp[d8][k] << 16), km[d8 * 8 + 2 * k], s); s = fmaf(__uint_as_float(qp[d8][k] & 0xffff0000u), km[d8 * 8 + 2 * k + 1], s); }
#pragma unroll
                for (int j = 0; j < 8; ++j) gt[j] = (j == n) ? s : gt[j]; }
            unsigned sel = 0u;
#pragma unroll
            for (int n = 0; n < 8; ++n) { int cnt = 0;
#pragma unroll
                for (int n2 = 0; n2 < 8; ++n2) if (n2 != n) cnt += (n2 < cur && (gt[n2] > gt[n] || (gt[n2] == gt[n] && n2 < n))) ? 1 : 0;
                if (n < cur && cnt < 3) sel |= 1u << n; }
#pragma unroll 1
            for (int key = 0; key <= kmax; ++key) {
                const bf16_t* kp = KB + (size_t)(b * SEQ + key) * 512 + h * 64; const bf16_t* vp = PROJ + (size_t)(b * SEQ + key) * PN + C_MV + h * 64 + vh * 32;
                const int nb = key >> 8; const bool ok = (nb == cur) ? (key <= t) : (((sel >> nb) & 1u) != 0u);
                float s = 0.f;
#pragma unroll
                for (int d8 = 0; d8 < 8; ++d8) { const u32x4 v = *(const u32x4*)(kp + d8 * 8);
#pragma unroll
                    for (int k = 0; k < 4; ++k) { s = fmaf(__uint_as_float(qp[d8][k] << 16), __uint_as_float(v[k] << 16), s); s = fmaf(__uint_as_float(qp[d8][k] & 0xffff0000u), __uint_as_float(v[k] & 0xffff0000u), s); } }
                if (ok) { const float mn = fmaxf(mx, s), al = __builtin_amdgcn_exp2f(mx - mn), pe = __builtin_amdgcn_exp2f(s - mn); l = l * al + pe; mx = mn;
#pragma unroll
                    for (int d8 = 0; d8 < 4; ++d8) { const u32x4 v = *(const u32x4*)(vp + d8 * 8);
#pragma unroll
                        for (int k = 0; k < 4; ++k) { o[d8 * 8 + 2 * k] = fmaf(pe, __uint_as_float(v[k] << 16), o[d8 * 8 + 2 * k] * al); o[d8 * 8 + 2 * k + 1] = fmaf(pe, __uint_as_float(v[k] & 0xffff0000u), o[d8 * 8 + 2 * k + 1] * al); } } }
            }
        }
        const float il = 1.0f / l;
        bf16_t* op = ATT + (size_t)tok * 1024 + type * 512 + h * 64 + vh * 32;
#pragma unroll
        for (int d8 = 0; d8 < 4; ++d8) { u32x4 w; w.x = pk2(o[d8 * 8] * il, o[d8 * 8 + 1] * il); w.y = pk2(o[d8 * 8 + 2] * il, o[d8 * 8 + 3] * il); w.z = pk2(o[d8 * 8 + 4] * il, o[d8 * 8 + 5] * il); w.w = pk2(o[d8 * 8 + 6] * il, o[d8 * 8 + 7] * il);
            *(u32x4*)(op + d8 * 8) = w; }
    }
}

__device__ __forceinline__ void phase_ln1_route(const Params& p, LAS unsigned char* lds, int vcu, int G) {
    const int tid = threadIdx.x, wave = tid >> 6, lane = tid & 63;
    unsigned char* ws = p.ws;
    float* X1 = p.out; bf16_t* X1B = (bf16_t*)(ws + WS_X1B);
    int* tidx = (int*)(ws + WS_TIDX); float* tgate = (float*)(ws + WS_TGATE); unsigned* hist = (unsigned*)(ws + WS_HIST);
    LAS int* lidx = (LAS int*)lds;
    for (int chunk = vcu; chunk < NCHUNK; chunk += G) {
        for (int r = 0; r < 8; ++r) {
            const int tl = wave * 8 + r, tok = chunk * 64 + tl;
            f32x4 v[4]; float s = 0.f;
#pragma unroll
            for (int j = 0; j < 4; ++j) { v[j] = *(const f32x4*)(X1 + (size_t)tok * DM + 4 * lane + 256 * j); s += (v[j][0] + v[j][1]) + (v[j][2] + v[j][3]); }
            const float mean = wave_sum(s) * (1.0f / DM); float s2 = 0.f;
#pragma unroll
            for (int j = 0; j < 4; ++j) { v[j] = v[j] - mean; s2 += (v[j][0] * v[j][0] + v[j][1] * v[j][1]) + (v[j][2] * v[j][2] + v[j][3] * v[j][3]); }
            const float rs = 1.0f / sqrtf(wave_sum(s2) * (1.0f / DM) + LN_EPS);
#pragma unroll
            for (int j = 0; j < 4; ++j) { const f32x4 g = *(const f32x4*)(p.ln1_g + 4 * lane + 256 * j), bb = *(const f32x4*)(p.ln1_b + 4 * lane + 256 * j);
                v[j] = v[j] * rs * g + bb; *(f32x4*)(X1 + (size_t)tok * DM + 4 * lane + 256 * j) = v[j];
                u32x2 w; w.x = pk2(v[j][0], v[j][1]); w.y = pk2(v[j][2], v[j][3]); *(u32x2*)(X1B + (size_t)tok * DM + 4 * lane + 256 * j) = w; }
            float lg[32];
#pragma unroll
            for (int e = 0; e < 32; ++e) lg[e] = 0.f;
#pragma unroll
            for (int j = 0; j < 4; ++j)
#pragma unroll
                for (int i = 0; i < 4; ++i) { const float xv = v[j][i]; const float* wr = p.w_router + (size_t)(4 * lane + 256 * j + i) * 32;
#pragma unroll
                    for (int e4 = 0; e4 < 8; ++e4) { const f32x4 w = *(const f32x4*)(wr + 4 * e4); lg[4 * e4] = fmaf(xv, w[0], lg[4 * e4]); lg[4 * e4 + 1] = fmaf(xv, w[1], lg[4 * e4 + 1]); lg[4 * e4 + 2] = fmaf(xv, w[2], lg[4 * e4 + 2]); lg[4 * e4 + 3] = fmaf(xv, w[3], lg[4 * e4 + 3]); } }
            float my = 0.f;
#pragma unroll
            for (int e = 0; e < 32; ++e) { const float tsum = wave_sum(lg[e]); if ((lane & 31) == e) my = tsum; }
            my += p.b_router[lane & 31];
            if (lane >= 32) my = -INFINITY;
            float tv[4]; int ti[4];
#pragma unroll
            for (int k = 0; k < 4; ++k) { const float m = wave_max(my); const unsigned long long bal = __ballot(my == m); const int idx = __ffsll((long long)bal) - 1; tv[k] = m; ti[k] = idx; if (lane == idx) my = -INFINITY; }
            if (lane == 0) { const float e0 = 1.f, e1 = expf(tv[1] - tv[0]), e2 = expf(tv[2] - tv[0]), e3 = expf(tv[3] - tv[0]); const float is = 1.0f / (e0 + e1 + e2 + e3);
                *(f32x4*)(tgate + (size_t)tok * 4) = (f32x4){e0 * is, e1 * is, e2 * is, e3 * is};
                int* tp = tidx + (size_t)tok * 4; tp[0] = ti[0]; tp[1] = ti[1]; tp[2] = ti[2]; tp[3] = ti[3];
                lidx[tl * 4 + 0] = ti[0]; lidx[tl * 4 + 1] = ti[1]; lidx[tl * 4 + 2] = ti[2]; lidx[tl * 4 + 3] = ti[3]; }
        }
        __syncthreads();
        if (tid < 32) { unsigned c = 0; for (int a = 0; a < 256; ++a) c += (lidx[a] == tid) ? 1u : 0u; hist[chunk * 32 + tid] = c; }
        __syncthreads();
    }
}

__device__ __forceinline__ void phase_assign(const Params& p, LAS unsigned char* lds, int vcu, int G) {
    const int tid = threadIdx.x;
    unsigned char* ws = p.ws;
    const int* tidx = (const int*)(ws + WS_TIDX); const float* tgate = (const float*)(ws + WS_TGATE); const unsigned* hist = (const unsigned*)(ws + WS_HIST);
    int* dest = (int*)(ws + WS_DEST); int* row_tok = (int*)(ws + WS_ROWTOK); float* row_gate = (float*)(ws + WS_ROWGATE); int* tile_e = (int*)(ws + WS_TILEE);
    LAS int* lidx = (LAS int*)lds;
    LAS int* lcnt = (LAS int*)(lds + 1024);
    LAS int* lpre = (LAS int*)(lds + 1024 + 128);
    LAS int* lstart = (LAS int*)(lds + 1024 + 256);
    for (int chunk = vcu; chunk < NCHUNK; chunk += G) {
        if (tid < 256) lidx[tid] = tidx[chunk * 256 + tid];
        if (tid < 32) { int tot = 0, pre = 0; for (int c = 0; c < NCHUNK; ++c) { const int hv = (int)hist[c * 32 + tid]; tot += hv; pre += (c < chunk) ? hv : 0; } lcnt[tid] = tot; lpre[tid] = pre; }
        __syncthreads();
        if (tid == 0) { int s = 0; for (int e = 0; e < 32; ++e) { lstart[e] = s; s += (lcnt[e] + 255) / 256 * 256; } lstart[32] = s; }
        __syncthreads();
        if (tid < 256) { const int e = lidx[tid]; int rank = 0; for (int a = 0; a < tid; ++a) rank += (lidx[a] == e) ? 1 : 0;
            const int P = lstart[e] + lpre[e] + rank, tok = chunk * 64 + (tid >> 2);
            row_tok[P] = tok; row_gate[P] = tgate[chunk * 256 + tid]; dest[chunk * 256 + tid] = P; }
        if (chunk < 32) { const int e = chunk; for (int P = lstart[e] + lcnt[e] + tid; P < lstart[e + 1]; P += NTHREADS) { row_tok[P] = 0; row_gate[P] = 0.f; } }
        if (chunk == 0) { if (tid < 32) { for (int t = lstart[tid] / 256; t < lstart[tid + 1] / 256; ++t) tile_e[t] = tid; } if (tid == 32) tile_e[MAXTILES] = lstart[32] / 256; }
        __syncthreads();
    }
}

__device__ __forceinline__ void phase_final(const Params& p, int vcu, int G) {
    const int tid = threadIdx.x, wave = tid >> 6, lane = tid & 63;
    unsigned char* ws = p.ws;
    const int* dest = (const int*)(ws + WS_DEST); const bf16_t* Y = (const bf16_t*)(ws + WS_Y); float* X1 = p.out;
    const int gw = vcu * NWAVES + wave, NGW = G * NWAVES;
    for (int tok = gw; tok < NTOK; tok += NGW) {
        f32x4 v[4];
#pragma unroll
        for (int j = 0; j < 4; ++j) v[j] = *(const f32x4*)(X1 + (size_t)tok * DM + 4 * lane + 256 * j) * DN_ALPHA;
#pragma unroll
        for (int k = 0; k < 4; ++k) { const int P = dest[tok * 4 + k];
#pragma unroll
            for (int j = 0; j < 4; ++j) { const u32x2 w = *(const u32x2*)(Y + (size_t)P * 1024 + 4 * lane + 256 * j);
                v[j][0] += __uint_as_float(w.x << 16); v[j][1] += __uint_as_float(w.x & 0xffff0000u); v[j][2] += __uint_as_float(w.y << 16); v[j][3] += __uint_as_float(w.y & 0xffff0000u); } }
        float s = 0.f;
#pragma unroll
        for (int j = 0; j < 4; ++j) s += (v[j][0] + v[j][1]) + (v[j][2] + v[j][3]);
        const float mean = wave_sum(s) * (1.0f / DM); float s2 = 0.f;
#pragma unroll
        for (int j = 0; j < 4; ++j) { v[j] = v[j] - mean; s2 += (v[j][0] * v[j][0] + v[j][1] * v[j][1]) + (v[j][2] * v[j][2] + v[j][3] * v[j][3]); }
        const float rs = 1.0f / sqrtf(wave_sum(s2) * (1.0f / DM) + LN_EPS);
#pragma unroll
        for (int j = 0; j < 4; ++j) { const f32x4 g = *(const f32x4*)(p.ln2_g + 4 * lane + 256 * j), bb = *(const f32x4*)(p.ln2_b + 4 * lane + 256 * j);
            *(f32x4*)(p.out + (size_t)tok * DM + 4 * lane + 256 * j) = v[j] * rs * g + bb; }
    }
}

constexpr int NPHASE = 11;
__global__ void __launch_bounds__(NTHREADS, 2) fwd_kernel(Params p) {
    extern __shared__ __attribute__((aligned(16))) unsigned char lds_raw[];
    LAS unsigned char* lds = (LAS unsigned char*)lds_raw;
    const int tid = threadIdx.x;
    const int G = gridDim.x, bx = blockIdx.x;
    const int vcu = (G % 8 == 0) ? (bx % 8) * (G / 8) + bx / 8 : bx;
    unsigned char* ws = p.ws;
    volatile LAS unsigned* MISC = (volatile LAS unsigned*)(lds + MISC_OFF);
    if (tid < 32) MISC[tid] = 0u;
    __syncthreads();
    XcdBarrier bar; bar.bar = (unsigned*)(ws + WS_CTL) + CW_BAR; bar.x = 0; bar.st = nullptr;
    const bool one = (p.ph_hi - p.ph_lo) > 1;
    if (one) bar = xcd_barrier_post((unsigned*)(ws + WS_CTL) + CW_BAR, MISC + 8);
    const int lo = p.ph_lo, hi = p.ph_hi;
#ifdef ONLY_PHASE
#define IN(k) ((k) == ONLY_PHASE && lo <= (k) && (k) < hi)
#else
#define IN(k) (lo <= (k) && (k) < hi)
#endif
#ifndef NAIVE_GEMM_MASK
#define NAIVE_GEMM_MASK 0
#endif
#define GEMM_CALL(EPI, SCHED) do { if constexpr (NAIVE_GEMM_MASK != 0) gemm_phase_naive<EPI, SCHED>(lds, g, S, E); else gemm_phase<EPI, SCHED, true>(lds, g, S, E); } while (0)
#define SEAM(k) do { if (IN(k) && IN((k) + 1)) xcd_barrier(bar); } while (0)

    if (IN(0)) { phase_prologue(p, lds, vcu, G); } SEAM(0);
    if (IN(1)) { GemmArgs g{(const bf16_t*)(ws + WS_XB), 1024, (const bf16_t*)(ws + WS_WIN), 1024, 1024}; DenseSched S; S.init(lds, NTOK, PN, G, vcu);
        EpiProj E{(bf16_t*)(ws + WS_PROJ)}; GEMM_CALL(EpiProj, DenseSched); } SEAM(1);
    if (IN(2)) { phase_prep(p, lds, vcu, G); } SEAM(2);
    if (IN(3)) { GemmArgs g{(const bf16_t*)(ws + WS_PROJ), PN, (const bf16_t*)(ws + WS_WUP), KUP, KUP}; DenseSched S; S.init(lds, NTOK, NUP, G, vcu);
        EpiUp E{(bf16_t*)(ws + WS_QM), (bf16_t*)(ws + WS_KM), (bf16_t*)(ws + WS_VM), (const float*)(ws + WS_RSTD), (const float*)(ws + WS_ROPEA)}; GEMM_CALL(EpiUp, DenseSched); } SEAM(3);
    #ifdef NAIVE_ATTN
    if (IN(4)) { phase_attn(p, vcu, G); } SEAM(4);
#else
    if (IN(4)) { phase_attn_fast(p, lds, vcu, G); } SEAM(4);
#endif
    if (IN(5)) { GemmArgs g{(const bf16_t*)(ws + WS_ATT), 1024, (const bf16_t*)(ws + WS_WO), 1024, 1024}; DenseSched S; S.init(lds, NTOK, DM, G, vcu);
        EpiWo E{p.x, p.out}; GEMM_CALL(EpiWo, DenseSched); } SEAM(5);
    if (IN(6)) { phase_ln1_route(p, lds, vcu, G); } SEAM(6);
    if (IN(7)) { phase_assign(p, lds, vcu, G); } SEAM(7);
    if (IN(8)) { GemmArgs g{(const bf16_t*)(ws + WS_X1B), 1024, (const bf16_t*)(ws + WS_WGU), 1024, 1024}; GroupSched<true> S; S.init(lds, (const int*)(ws + WS_TILEE), (const int*)(ws + WS_ROWTOK), 8, 2048, G, vcu);
        EpiGateUp E{(bf16_t*)(ws + WS_H), p.b_gate, p.b_up}; GEMM_CALL(EpiGateUp, GroupSched<true>); } SEAM(8);
    if (IN(9)) { GemmArgs g{(const bf16_t*)(ws + WS_H), 1024, (const bf16_t*)(ws + WS_WD), 1024, 1024}; GroupSched<false> S; S.init(lds, (const int*)(ws + WS_TILEE), (const int*)(ws + WS_ROWTOK), 4, 1024, G, vcu);
        EpiDown E{(bf16_t*)(ws + WS_Y), p.b_down, (const float*)(ws + WS_ROWGATE)}; GEMM_CALL(EpiDown, GroupSched<false>); } SEAM(9);
    if (IN(10)) { phase_final(p, vcu, G); }
#undef IN
#undef SEAM
}

extern "C" void kernel_launch(void* const* d_in, const int* in_sizes, int n_in, void* d_out, int out_size, void* d_ws, size_t ws_size, hipStream_t stream) {
    static int grid = 0;
    if (grid == 0) {
        if (n_in != 20 || out_size != NTOK * DM || ws_size < WS_END) { fprintf(stderr, "kernel_launch: unexpected shapes (n_in %d out %d ws %zu)\n", n_in, out_size, ws_size); grid = -1; return; }
        int dev = 0, cus = 0, per_cu = 0;
        if (hipGetDevice(&dev) != hipSuccess || hipDeviceGetAttribute(&cus, hipDeviceAttributeMultiprocessorCount, dev) != hipSuccess) { grid = -1; return; }
        if (hipFuncSetAttribute((const void*)fwd_kernel, hipFuncAttributeMaxDynamicSharedMemorySize, LDS_BYTES) != hipSuccess) { fprintf(stderr, "kernel_launch: hipFuncSetAttribute failed\n"); grid = -1; return; }
        if (hipOccupancyMaxActiveBlocksPerMultiprocessor(&per_cu, (const void*)fwd_kernel, NTHREADS, LDS_BYTES) != hipSuccess || per_cu < 1) fprintf(stderr, "kernel_launch: occupancy query says %d\n", per_cu);
        (void)hipGetLastError();
        grid = cus;
    }
    if (grid < 0) return;
    (void)hipMemsetAsync((char*)d_ws + WS_CTL, 0, CTL_ZERO_BYTES, stream);
    Params p{};
    p.x = (const float*)d_in[0]; p.pos = (const int*)d_in[1]; p.w_in = (const float*)d_in[2]; p.q_a_norm = (const float*)d_in[3]; p.w_q_b = (const float*)d_in[4];
    p.kv_a_norm = (const float*)d_in[5]; p.w_kv_b = (const float*)d_in[6]; p.w_o = (const float*)d_in[7]; p.ln1_g = (const float*)d_in[8]; p.ln1_b = (const float*)d_in[9];
    p.w_router = (const float*)d_in[10]; p.b_router = (const float*)d_in[11]; p.w_gate = (const float*)d_in[12]; p.b_gate = (const float*)d_in[13];
    p.w_up = (const float*)d_in[14]; p.b_up = (const float*)d_in[15]; p.w_down = (const float*)d_in[16]; p.b_down = (const float*)d_in[17];
    p.ln2_g = (const float*)d_in[18]; p.ln2_b = (const float*)d_in[19];
    p.out = (float*)d_out; p.ws = (unsigned char*)d_ws;
    for (int i = 0; i < 16; ++i) p.invfA[i] = pow(500000.0, -(double)(2 * i) / 32.0);
    for (int i = 0; i < 8; ++i) p.invfB[i] = pow(500000.0, -(double)(2 * i) / 16.0);
#if MK_ONE_LAUNCH
    p.ph_lo = 0; p.ph_hi = NPHASE;
    hipLaunchKernelGGL(fwd_kernel, dim3(grid), dim3(NTHREADS), LDS_BYTES, stream, p);
#else
    for (int ph = 0; ph < NPHASE; ++ph) { p.ph_lo = ph; p.ph_hi = ph + 1; hipLaunchKernelGGL(fwd_kernel, dim3(grid), dim3(NTHREADS), LDS_BYTES, stream, p); }
#endif
}
```

```cpp
#include <hip/hip_runtime.h>
#include <cstdio>
#include <cstdint>
#include <cmath>

#ifndef MK_ONE_LAUNCH
#define MK_ONE_LAUNCH 1
#endif

#define GAS __attribute__((address_space(1)))
#define LAS __attribute__((address_space(3)))
typedef unsigned short bf16_t;
typedef short bf16x8 __attribute__((ext_vector_type(8)));
typedef float f32x4 __attribute__((ext_vector_type(4)));
typedef float f32x2 __attribute__((ext_vector_type(2)));
typedef unsigned u32x4 __attribute__((ext_vector_type(4)));
typedef unsigned u32x2 __attribute__((ext_vector_type(2)));

constexpr int NTOK = 16384, DM = 1024, SEQ = 2048, NBATCH = 8;
constexpr int PN = 2048;
constexpr int C_QL = 0, C_KVL = 256, C_KR = 384, C_MQ = 416, C_MK = 928, C_MV = 1440, IN_COLS = 1952;
constexpr int NUP = 1792, KUP = 384;
constexpr int NE = 32, TOPK = 4;
constexpr int MAXROWS = 65536 + NE * 256, MAXTILES = MAXROWS / 256;
constexpr int NCHUNK = NTOK / 64;
constexpr float LN_EPS = 1e-5f, RMS_EPS = 1e-6f;
constexpr float DN_ALPHA = 1.189207115002721f;
constexpr float LOG2E = 1.4426950408889634f;
constexpr float C2A = 0.10206207261596575f * LOG2E;
constexpr float C2B = 0.125f * LOG2E;
constexpr int NWAVES = 8, NTHREADS = 512;

constexpr size_t MiB = 1u << 20;
constexpr size_t WS_CTL = 0, CTL_ZERO_BYTES = 1 * MiB;
constexpr size_t WS_HIST = 1 * MiB;
constexpr size_t WS_TIDX = WS_HIST + 64 * 1024;
constexpr size_t WS_TGATE = WS_TIDX + 256 * 1024;
constexpr size_t WS_DEST = WS_TGATE + 256 * 1024;
constexpr size_t WS_ROWTOK = WS_DEST + 256 * 1024;
constexpr size_t WS_ROWGATE = WS_ROWTOK + 288 * 1024;
constexpr size_t WS_TILEE = WS_ROWGATE + 288 * 1024;
constexpr size_t WS_RSTD = WS_TILEE + 4 * 1024;
constexpr size_t WS_KMEAN = WS_RSTD + 128 * 1024;
constexpr size_t WS_WRL = WS_KMEAN + 128 * 1024;
static_assert(WS_WRL + 128 * 1024 <= 4 * MiB, "route region");
constexpr size_t WS_ROPEA = 4 * MiB;
constexpr size_t WS_ROPEB = 6 * MiB;
constexpr size_t WS_WIN = 8 * MiB;
constexpr size_t WS_WO = 12 * MiB;
constexpr size_t WS_WUP = 14 * MiB;
constexpr size_t WS_X1B = 16 * MiB;
constexpr size_t WS_WD = 48 * MiB;
constexpr size_t WS_XB = 112 * MiB;
constexpr size_t WS_PROJ = 144 * MiB;
constexpr size_t WS_QM = 208 * MiB;
constexpr size_t WS_KM = 232 * MiB;
constexpr size_t WS_VM = 256 * MiB;
constexpr size_t WS_QB = 272 * MiB;
constexpr size_t WS_KB = 288 * MiB;
constexpr size_t WS_ATT = 304 * MiB;
constexpr size_t WS_H = 112 * MiB;
constexpr size_t WS_WGU = 336 * MiB;
constexpr size_t WS_Y = 336 * MiB;
constexpr size_t WS_X1PRE = 144 * MiB;
constexpr size_t WS_END = 480 * MiB;
static_assert(WS_H + (size_t)MAXROWS * 1024 * 2 <= WS_VM + 0 * MiB + 0 && WS_Y + (size_t)MAXROWS * 1024 * 2 <= WS_END, "ws map");
constexpr int CW_BAR = 4096;

constexpr int LDS_BYTES = 147456;
constexpr int MISC_OFF = 131072 + 320;

__device__ __forceinline__ float bf2f(unsigned v) { return __uint_as_float(v << 16); }
__device__ __forceinline__ unsigned f2bf(float f) { unsigned u = __float_as_uint(f); return (u + 0x7fffu + ((u >> 16) & 1u)) >> 16; }
__device__ __forceinline__ unsigned pk2(float lo, float hi) { return f2bf(lo) | (f2bf(hi) << 16); }
__device__ __forceinline__ float wave_sum(float v) {
#pragma unroll
    for (int o = 1; o < 64; o <<= 1) v += __shfl_xor(v, o);
    return v;
}
__device__ __forceinline__ float wave_max(float v) {
#pragma unroll
    for (int o = 1; o < 64; o <<= 1) v = fmaxf(v, __shfl_xor(v, o));
    return v;
}

#define XB_TMO      128
#define XB_XCNT(j)  (256  + 64 * (j))
#define XB_XSUB(j)  (1280 + 64 * (j))
#define XB_XGEN(j)  (2304 + 64 * (j))
#define XB_TOP      3328
#define XB_TOPGEN   3392
#define XCD_BAR_WORDS 3456
#define XB_SPIN_CAP (1u << 18)
__device__ __forceinline__ unsigned xb_ld(unsigned* p)              { return __hip_atomic_load(p, __ATOMIC_RELAXED, __HIP_MEMORY_SCOPE_AGENT); }
__device__ __forceinline__ unsigned xb_add(unsigned* p, unsigned v) { return __hip_atomic_fetch_add(p, v, __ATOMIC_RELAXED, __HIP_MEMORY_SCOPE_AGENT); }
__device__ __forceinline__ unsigned xb_xcc_id() { return (unsigned)__builtin_amdgcn_s_getreg((3 << 11) | 20) & 0xFu; }
#define XB_SPIN(cond, bar) do { unsigned _sp = 0; while (cond) { __builtin_amdgcn_s_sleep(1); \
    if ((++_sp & 255u) == 0u) { if (xb_ld(&(bar)[XB_TMO])) break; if (_sp > XB_SPIN_CAP) { atomicAdd(&(bar)[XB_TMO], 1u); break; } } } } while (0)
struct XcdBarrier { unsigned* bar; unsigned x; volatile LAS unsigned* st; };
__device__ __forceinline__ XcdBarrier xcd_barrier_post(unsigned* bar, volatile LAS unsigned* st) {
    XcdBarrier b; b.bar = bar; b.x = xb_xcc_id(); b.st = st;
    if (threadIdx.x == 0) (void)xb_add(&bar[XB_XCNT(b.x)], 1u);
    return b;
}
__device__ __forceinline__ void xcd_barrier_complete(unsigned* bar, unsigned x, unsigned& nloc, unsigned& nx) {
    const unsigned G = gridDim.x * gridDim.y * gridDim.z;
    unsigned sum, cnt, mine, sp = 0u;
    for (;;) {
        sum = 0u; cnt = 0u; mine = 0u;
#pragma unroll
        for (unsigned j = 0; j < 16; ++j) { const unsigned c = xb_ld(&bar[XB_XCNT(j)]); sum += c; cnt += (c > 0u) ? 1u : 0u; mine = (j == x) ? c : mine; }
        if (sum == G) break;
        __builtin_amdgcn_s_sleep(1);
        if ((++sp & 255u) == 0u) { if (xb_ld(&bar[XB_TMO])) break; if (sp > XB_SPIN_CAP) { atomicAdd(&bar[XB_TMO], 1u); break; } }
    }
    nloc = mine > 0u ? mine : 1u; nx = cnt > 0u ? cnt : 1u;
}
__device__ __forceinline__ void xcd_barrier(const XcdBarrier& b) {
    asm volatile("s_waitcnt vmcnt(0)" ::: "memory");
    __syncthreads();
    if (threadIdx.x == 0) {
        unsigned* bar = b.bar;
        __builtin_amdgcn_s_waitcnt(0);
        unsigned nloc = b.st[0], nx = b.st[1];
        if (nloc == 0u) { xcd_barrier_complete(bar, b.x, nloc, nx); b.st[0] = nloc; b.st[1] = nx; }
        const unsigned old = xb_add(&bar[XB_XSUB(b.x)], 1u);
        const unsigned gen = old / nloc;
        if (old + 1u == (gen + 1u) * nloc) {
            __builtin_amdgcn_fence(__ATOMIC_RELEASE, "agent");
            asm volatile("s_waitcnt vmcnt(0)" ::: "memory");
            const unsigned og = xb_add(&bar[XB_TOP], 1u);
            const unsigned tg = og / nx;
            if (og + 1u == (tg + 1u) * nx) xb_add(&bar[XB_TOPGEN], 1u);
            else XB_SPIN(xb_ld(&bar[XB_TOPGEN]) == tg, bar);
            __builtin_amdgcn_fence(__ATOMIC_ACQUIRE, "agent");
            xb_add(&bar[XB_XGEN(b.x)], 1u);
            asm volatile("s_waitcnt vmcnt(0)" ::: "memory");
        } else {
            XB_SPIN(xb_ld(&bar[XB_XGEN(b.x)]) == gen, bar);
            __builtin_amdgcn_fence(__ATOMIC_ACQUIRE, "agent");
            asm volatile("s_waitcnt vmcnt(0)" ::: "memory");
        }
    }
    __syncthreads();
}

struct Params {
    const float* x; const int* pos;
    const float *w_in, *q_a_norm, *w_q_b, *kv_a_norm, *w_kv_b, *w_o, *ln1_g, *ln1_b, *w_router, *b_router;
    const float *w_gate, *b_gate, *w_up, *b_up, *w_down, *b_down, *ln2_g, *ln2_b;
    float* out; unsigned char* ws;
    double invfA[16]; double invfB[8];
    int ph_lo, ph_hi;
};

struct Unit { int pm, pn, e; };
struct GemmArgs { const bf16_t* A; int lda; const bf16_t* Bt; int ldb; int K; };
template <bool PERM> __device__ __forceinline__ int ecol(int bj, int n, int wc, int fq) { return 128 * bj + 32 * wc + (PERM ? 8 * fq + 4 * n : 16 * n + 4 * fq); }

template <class Epi, class Sched>
__device__ __forceinline__ void gemm_phase_naive(LAS unsigned char* lds, const GemmArgs g, const Sched& S, const Epi& E) {
    const int tid = threadIdx.x, wid = __builtin_amdgcn_readfirstlane(tid >> 6), lane = tid & 63, wr = wid >> 2, wc = wid & 3, fr = lane & 15, fq = lane >> 4;
    Unit u;
    for (int ui = 0; S.next(ui, u); ++ui) {
        f32x4 acc[2][2][4][2];
#pragma unroll
        for (int a = 0; a < 2; ++a)
#pragma unroll
            for (int b = 0; b < 2; ++b)
#pragma unroll
                for (int m = 0; m < 4; ++m)
#pragma unroll
                    for (int n = 0; n < 2; ++n) acc[a][b][m][n] = (f32x4){0.f, 0.f, 0.f, 0.f};
        unsigned aoff[2][4];
#pragma unroll
        for (int a = 0; a < 2; ++a)
#pragma unroll
            for (int m = 0; m < 4; ++m) aoff[a][m] = (unsigned)S.arow(u, ui, 128 * a + 64 * wr + 16 * m + fr) * (unsigned)g.lda;
        const bf16_t* bb = g.Bt + (size_t)(S.brow0(u) + 32 * wc) * g.ldb;
        const unsigned bl0 = (unsigned)(4 * fq) * (unsigned)g.ldb, bl1 = (unsigned)(8 * fq) * (unsigned)g.ldb;
#pragma unroll 1
        for (int k = 0; k < g.K; k += 2) {
            float af[2][4][2];
#pragma unroll
            for (int a = 0; a < 2; ++a)
#pragma unroll
                for (int m = 0; m < 4; ++m) { const unsigned v = *(const unsigned*)(g.A + aoff[a][m] + k); af[a][m][0] = __uint_as_float(v << 16); af[a][m][1] = __uint_as_float(v & 0xffff0000u); }
#pragma unroll
            for (int b = 0; b < 2; ++b)
#pragma unroll
                for (int n = 0; n < 2; ++n)
#pragma unroll
                    for (int j = 0; j < 4; ++j) {
                        const int ccol = 128 * b + (Epi::PERM ? 4 * n : 16 * n) + j;
                        const unsigned v = *(const unsigned*)(bb + (size_t)ccol * g.ldb + ((Epi::PERM ? bl1 : bl0) + (unsigned)k));
                        const float b0 = __uint_as_float(v << 16), b1 = __uint_as_float(v & 0xffff0000u);
#pragma unroll
                        for (int a = 0; a < 2; ++a)
#pragma unroll
                            for (int m = 0; m < 4; ++m) acc[a][b][m][n][j] = fmaf(af[a][m][1], b1, fmaf(af[a][m][0], b0, acc[a][b][m][n][j]));
                    }
        }
        E(acc, u, wr, wc, fr, fq);
    }
}

namespace pg {
constexpr int BK = 64, HALF = 128, HTB = HALF * BK * 2;
__device__ __forceinline__ int lds_byte(int r, int c) { const int st = (r >> 4) * 2 + (c >> 5), rr = r & 15, cc = c & 31, ob = rr * 64 + cc * 2; return st * 1024 + (ob ^ (((ob >> 9) & 1) << 5)); }
__device__ __forceinline__ void stage_rc(int b, int& R, int& C) { const int st = b / 1024, sb = b % 1024, swz = sb ^ (((sb >> 9) & 1) << 5); R = (st >> 1) * 16 + swz / 64; C = (st & 1) * 32 + (swz % 64) / 2; }
__device__ __forceinline__ int perm32(int rho) { const int n = rho >> 4, i = rho & 15; return 8 * (i >> 2) + 4 * n + (i & 3); }
}
template <class Epi, class Sched, bool ALIGN_EPI>
__device__ __forceinline__ void gemm_phase(LAS unsigned char* lds, const GemmArgs g, const Sched& S, const Epi& E) {
    using namespace pg;
    const int tid = threadIdx.x, wid = __builtin_amdgcn_readfirstlane(tid >> 6), lane = tid & 63, wr = wid >> 2, wc = wid & 3, fr = lane & 15, fq = lane >> 4;
    const int nt = g.K / BK;
    int sR[2], sC[2], sRb[2];
#pragma unroll
    for (int i = 0; i < 2; ++i) { int R, C; stage_rc(tid * 16 + i * 8192, R, C); sR[i] = R; sC[i] = C; sRb[i] = Epi::PERM ? ((R & ~31) + perm32(R & 31)) : R; }
    const unsigned ldsw = (unsigned)wid * 1024u;
    const int aoff = lds_byte(wr * 64 + fr, fq * 8), boff = lds_byte(wc * 32 + fr, fq * 8);
    const char* Ab = (const char*)g.A; const char* Bb = (const char*)g.Bt;
#define PG_SA(b, h) (((b) * 2 + (h)) * HTB)
#define PG_SB(b, h) ((4 + (b) * 2 + (h)) * HTB)
#define PG_STAGE(bufoff, gptr, v0, v1) do { \
        __builtin_amdgcn_global_load_lds((const unsigned*)((gptr) + (v0)), (LAS unsigned*)(lds + (bufoff) + ldsw), 16, 0, 0); \
        __builtin_amdgcn_global_load_lds((const unsigned*)((gptr) + (v1)), (LAS unsigned*)(lds + (bufoff) + ldsw + 8192), 16, 0, 0); } while (0)
#define PG_LDA(dst, b, h) do { _Pragma("unroll") for (int m = 0; m < 4; ++m) _Pragma("unroll") for (int k = 0; k < 2; ++k) dst[m][k] = *(const LAS bf16x8*)(lds + PG_SA(b, h) + aoff + m * 2048 + k * 1024); } while (0)
#define PG_LDB(dst, b, h) do { _Pragma("unroll") for (int n = 0; n < 2; ++n) _Pragma("unroll") for (int k = 0; k < 2; ++k) dst[n][k] = *(const LAS bf16x8*)(lds + PG_SB(b, h) + boff + n * 2048 + k * 1024); } while (0)
#define PG_MMA(ai, bj, At, Bt) do { __builtin_amdgcn_s_setprio(1); _Pragma("unroll") for (int m = 0; m < 4; ++m) _Pragma("unroll") for (int n = 0; n < 2; ++n) _Pragma("unroll") for (int k = 0; k < 2; ++k) \
        acc[ai][bj][m][n] = __builtin_amdgcn_mfma_f32_16x16x32_bf16(Bt[n][k], At[m][k], acc[ai][bj][m][n], 0, 0, 0); __builtin_amdgcn_s_setprio(0); } while (0)
#define PG_WAIT_V(n) asm volatile("s_waitcnt vmcnt(" #n ")" ::: "memory")
#define PG_WAIT_L(n) asm volatile("s_waitcnt lgkmcnt(" #n ")" ::: "memory")
#define PG_BAR __builtin_amdgcn_s_barrier()
#define PG_SCHED __builtin_amdgcn_sched_barrier(0)
#define PG_VOFFS(u, uidx, VA, VB) do { _Pragma("unroll") for (int h = 0; h < 2; ++h) _Pragma("unroll") for (int i = 0; i < 2; ++i) { \
        VA[h][i] = ((unsigned)S.arow(u, uidx, 128 * h + sR[i]) * (unsigned)g.lda + (unsigned)sC[i]) * 2u; \
        VB[h][i] = ((unsigned)(S.brow0(u) + 128 * h + sRb[i]) * (unsigned)g.ldb + (unsigned)sC[i]) * 2u; } } while (0)
    Unit cur, nxt; int ui = 0;
    if (!S.next(0, cur)) return;
    f32x4 acc[2][2][4][2];
#pragma unroll
    for (int a = 0; a < 2; ++a)
#pragma unroll
        for (int b = 0; b < 2; ++b)
#pragma unroll
            for (int m = 0; m < 4; ++m)
#pragma unroll
                for (int n = 0; n < 2; ++n) acc[a][b][m][n] = (f32x4){0.f, 0.f, 0.f, 0.f};
    bf16x8 At[4][2], B0[2][2], B1[2][2];
    unsigned vA[2][2], vB[2][2], nvA[2][2], nvB[2][2];
    PG_VOFFS(cur, 0, vA, vB);
    PG_STAGE(PG_SB(0, 0), Bb, vB[0][0], vB[0][1]); PG_STAGE(PG_SB(0, 1), Bb, vB[1][0], vB[1][1]); PG_STAGE(PG_SA(0, 0), Ab, vA[0][0], vA[0][1]); PG_STAGE(PG_SA(0, 1), Ab, vA[1][0], vA[1][1]);
    if (wr == 1) PG_BAR;
    PG_WAIT_V(2); PG_BAR;
    PG_STAGE(PG_SB(1, 0), Bb + 128, vB[0][0], vB[0][1]); PG_STAGE(PG_SA(1, 0), Ab + 128, vA[0][0], vA[0][1]); PG_STAGE(PG_SB(1, 1), Bb + 128, vB[1][0], vB[1][1]);
    PG_WAIT_V(6); PG_BAR;
    for (;;) {
        const bool has_next = S.next(ui + 1, nxt);
        if (has_next) { PG_VOFFS(nxt, ui + 1, nvA, nvB); }
        else {
#pragma unroll
            for (int h = 0; h < 2; ++h)
#pragma unroll
                for (int i = 0; i < 2; ++i) { nvA[h][i] = vA[h][i]; nvB[h][i] = vB[h][i]; } }
        for (int t = 0; t < nt; t += 2) {
            const bool last = (t == nt - 2);
            const char* a1 = Ab + (size_t)(t + 1) * 128;
            const char* a2 = last ? Ab : Ab + (size_t)(t + 2) * 128; const char* b2 = last ? Bb : Bb + (size_t)(t + 2) * 128;
            const char* a3 = a2 + 128; const char* b3 = b2 + 128;
            unsigned wA[2][2], wB[2][2];
#pragma unroll
            for (int h = 0; h < 2; ++h)
#pragma unroll
                for (int i = 0; i < 2; ++i) { wA[h][i] = last ? nvA[h][i] : vA[h][i]; wB[h][i] = last ? nvB[h][i] : vB[h][i]; }
            PG_LDB(B0, 0, 0); PG_LDB(B1, 0, 1); PG_SCHED; PG_LDA(At, 0, 0); PG_STAGE(PG_SA(1, 1), a1, vA[1][0], vA[1][1]);
            PG_WAIT_V(8); PG_WAIT_L(0); PG_BAR; PG_MMA(0, 0, At, B0); PG_MMA(0, 1, At, B1); PG_BAR; PG_SCHED;
            PG_LDA(At, 0, 1); PG_STAGE(PG_SB(0, 0), b2, wB[0][0], wB[0][1]); PG_STAGE(PG_SB(0, 1), b2, wB[1][0], wB[1][1]); PG_STAGE(PG_SA(0, 0), a2, wA[0][0], wA[0][1]);
            PG_WAIT_V(8); PG_WAIT_L(0); PG_BAR; PG_MMA(1, 0, At, B0); PG_MMA(1, 1, At, B1); PG_BAR; PG_SCHED;
            PG_LDB(B0, 1, 0); PG_LDB(B1, 1, 1); PG_SCHED; PG_LDA(At, 1, 0); PG_STAGE(PG_SA(0, 1), a2, wA[1][0], wA[1][1]);
            PG_WAIT_V(8); PG_WAIT_L(0); PG_BAR; PG_MMA(0, 0, At, B0); PG_MMA(0, 1, At, B1); PG_BAR; PG_SCHED;
            PG_LDA(At, 1, 1); PG_STAGE(PG_SB(1, 0), b3, wB[0][0], wB[0][1]); PG_STAGE(PG_SB(1, 1), b3, wB[1][0], wB[1][1]); PG_STAGE(PG_SA(1, 0), a3, wA[0][0], wA[0][1]);
            PG_WAIT_V(8); PG_WAIT_L(0); PG_BAR; PG_MMA(1, 0, At, B0); PG_MMA(1, 1, At, B1); PG_BAR; PG_SCHED;
        }
        if constexpr (ALIGN_EPI) { if (wr == 0) PG_BAR; }
        E(acc, cur, wr, wc, fr, fq);
        if (!has_next) break;
#pragma unroll
        for (int a = 0; a < 2; ++a)
#pragma unroll
            for (int b = 0; b < 2; ++b)
#pragma unroll
                for (int m = 0; m < 4; ++m)
#pragma unroll
                    for (int n = 0; n < 2; ++n) acc[a][b][m][n] = (f32x4){0.f, 0.f, 0.f, 0.f};
        cur = nxt; ++ui;
#pragma unroll
        for (int h = 0; h < 2; ++h)
#pragma unroll
            for (int i = 0; i < 2; ++i) { vA[h][i] = nvA[h][i]; vB[h][i] = nvB[h][i]; }
        if constexpr (ALIGN_EPI) { if (wr == 1) PG_BAR; }
    }
    PG_WAIT_V(0);
    if constexpr (!ALIGN_EPI) { if (wr == 0) PG_BAR; }
    PG_BAR;
#undef PG_SA
#undef PG_SB
#undef PG_STAGE
#undef PG_LDA
#undef PG_LDB
#undef PG_MMA
#undef PG_WAIT_V
#undef PG_WAIT_L
#undef PG_BAR
#undef PG_SCHED
#undef PG_VOFFS
}

constexpr int ROWTAB_OFF = 132096, ETAB_OFF = ROWTAB_OFF + 12 * 1024, MAXU = 12;
struct DenseSched {
    int nN, nunits, G, c;
    __device__ __forceinline__ void init(LAS unsigned char*, int M, int N, int G_, int c_) { nN = N / 256; nunits = (M / 256) * nN; G = G_; c = c_; }
    __device__ __forceinline__ bool next(int i, Unit& u) const { const int L = i * G + c; if (L >= nunits) return false; u.pm = L / nN; u.pn = L % nN; u.e = 0; return true; }
    __device__ __forceinline__ int arow(const Unit& u, int, int r) const { return 256 * u.pm + r; }
    __device__ __forceinline__ int brow0(const Unit& u) const { return 256 * u.pn; }
};
template <bool GATHER> struct GroupSched {
    LAS int* rowtab; LAS int* etab; int nN, nexp_rows, nunits, G, c;
    __device__ __forceinline__ void init(LAS unsigned char* lds, const int* te, const int* rt, int nN_, int nexp_rows_, int G_, int c_) {
        rowtab = (LAS int*)(lds + ROWTAB_OFF); etab = (LAS int*)(lds + ETAB_OFF); nN = nN_; nexp_rows = nexp_rows_; G = G_; c = c_;
        nunits = __builtin_amdgcn_readfirstlane(te[MAXTILES]) * nN_;
        for (int i = 0; i < MAXU; ++i) { const int L = i * G + c; if (L >= nunits) break; const int pm = L / nN;
            if (threadIdx.x == 0) etab[i] = te[pm];
            if (GATHER && threadIdx.x < 256) rowtab[i * 256 + threadIdx.x] = rt[256 * pm + threadIdx.x]; }
        __syncthreads();
    }
    __device__ __forceinline__ bool next(int i, Unit& u) const { const int L = i * G + c; if (L >= nunits || i >= MAXU) return false; u.pm = L / nN; u.pn = L % nN; u.e = etab[i]; return true; }
    __device__ __forceinline__ int arow(const Unit& u, int ui, int r) const { return GATHER ? rowtab[ui * 256 + r] : 256 * u.pm + r; }
    __device__ __forceinline__ int brow0(const Unit& u) const { return u.e * nexp_rows + 256 * u.pn; }
};

struct EpiProj {
    static constexpr bool PERM = false;
    bf16_t* O;
    __device__ __forceinline__ void operator()(const f32x4 (&acc)[2][2][4][2], const Unit& u, int wr, int wc, int fr, int fq) const {
#pragma unroll
        for (int a = 0; a < 2; ++a)
#pragma unroll
            for (int m = 0; m < 4; ++m) { const int row = 256 * u.pm + 128 * a + 64 * wr + 16 * m + fr;
#pragma unroll
                for (int b = 0; b < 2; ++b)
#pragma unroll
                    for (int n = 0; n < 2; ++n) { const int col = 256 * u.pn + ecol<PERM>(b, n, wc, fq); const f32x4 v = acc[a][b][m][n];
                        u32x2 w; w.x = pk2(v[0], v[1]); w.y = pk2(v[2], v[3]); *(u32x2*)(O + (size_t)row * PN + col) = w; } }
    }
};
struct EpiUp {
    static constexpr bool PERM = false;
    bf16_t *QM, *KM, *VM; const float* rstd; const float* ropeA;
    __device__ __forceinline__ void operator()(const f32x4 (&acc)[2][2][4][2], const Unit& u, int wr, int wc, int fr, int fq) const {
#pragma unroll
        for (int a = 0; a < 2; ++a)
#pragma unroll
            for (int m = 0; m < 4; ++m) { const int row = 256 * u.pm + 128 * a + 64 * wr + 16 * m + fr;
                const float rq = rstd[2 * row] * C2A, rkv = rstd[2 * row + 1];
#pragma unroll
                for (int b = 0; b < 2; ++b) {
                    const int gidx = 8 * u.pn + 4 * b + wc;
                    if (gidx < 24) {
                        const int h = gidx / 3, part = gidx % 3;
                        f32x4 v0 = acc[a][b][m][0] * rq, v1 = acc[a][b][m][1] * rq;
                        if (part == 2) { const f32x4 c = *(const f32x4*)(ropeA + (size_t)row * 32 + 4 * fq), s = *(const f32x4*)(ropeA + (size_t)row * 32 + 16 + 4 * fq);
                            const f32x4 o0 = v0 * c - v1 * s, o1 = v1 * c + v0 * s; v0 = o0; v1 = o1; }
                        bf16_t* p = QM + (size_t)row * 768 + h * 96 + part * 32 + 4 * fq;
                        u32x2 w; w.x = pk2(v0[0], v0[1]); w.y = pk2(v0[2], v0[3]); *(u32x2*)p = w;
                        w.x = pk2(v1[0], v1[1]); w.y = pk2(v1[2], v1[3]); *(u32x2*)(p + 16) = w;
                    } else {
                        const int g2 = gidx - 24, h = g2 >> 2, part = g2 & 3;
                        const f32x4 v0 = acc[a][b][m][0] * rkv, v1 = acc[a][b][m][1] * rkv;
                        bf16_t* p = (part < 2) ? (KM + (size_t)row * 768 + h * 96 + part * 32 + 4 * fq) : (VM + (size_t)row * 512 + h * 64 + (part - 2) * 32 + 4 * fq);
                        u32x2 w; w.x = pk2(v0[0], v0[1]); w.y = pk2(v0[2], v0[3]); *(u32x2*)p = w;
                        w.x = pk2(v1[0], v1[1]); w.y = pk2(v1[2], v1[3]); *(u32x2*)(p + 16) = w;
                    }
                } }
    }
};
struct EpiWo {
    static constexpr bool PERM = false;
    const float* x; float* O;
    __device__ __forceinline__ void operator()(const f32x4 (&acc)[2][2][4][2], const Unit& u, int wr, int wc, int fr, int fq) const {
#pragma unroll
        for (int a = 0; a < 2; ++a)
#pragma unroll
            for (int m = 0; m < 4; ++m) { const int row = 256 * u.pm + 128 * a + 64 * wr + 16 * m + fr;
#pragma unroll
                for (int b = 0; b < 2; ++b)
#pragma unroll
                    for (int n = 0; n < 2; ++n) { const size_t off = (size_t)row * DM + 256 * u.pn + ecol<PERM>(b, n, wc, fq);
                        const f32x4 xv = *(const f32x4*)(x + off); *(f32x4*)(O + off) = xv * DN_ALPHA + acc[a][b][m][n]; } }
    }
};
struct EpiGateUp {
    static constexpr bool PERM = false;
    bf16_t* H; const float *bg, *bu;
    __device__ __forceinline__ void operator()(const f32x4 (&acc)[2][2][4][2], const Unit& u, int wr, int wc, int fr, int fq) const {
#pragma unroll
        for (int n = 0; n < 2; ++n) { const int hc = 128 * u.pn + 32 * wc + 16 * n + 4 * fq;
            const f32x4 vbg = *(const f32x4*)(bg + (size_t)u.e * 1024 + hc), vbu = *(const f32x4*)(bu + (size_t)u.e * 1024 + hc);
#pragma unroll
            for (int a = 0; a < 2; ++a)
#pragma unroll
                for (int m = 0; m < 4; ++m) { const int row = 256 * u.pm + 128 * a + 64 * wr + 16 * m + fr;
                    const f32x4 gv = acc[a][0][m][n] + vbg, uv = acc[a][1][m][n] + vbu; float hv[4];
#pragma unroll
                    for (int j = 0; j < 4; ++j) { const float gg = fminf(gv[j], 7.0f), uu = fminf(fmaxf(uv[j], -7.0f), 7.0f);
                        const float sg = 1.0f / (1.0f + __builtin_amdgcn_exp2f(-1.702f * LOG2E * gg)); hv[j] = gg * sg * (uu + 1.0f); }
                    u32x2 w; w.x = pk2(hv[0], hv[1]); w.y = pk2(hv[2], hv[3]); *(u32x2*)(H + (size_t)row * 1024 + hc) = w; } }
    }
};
struct EpiDown {
    static constexpr bool PERM = false;
    bf16_t* Y; const float* bd; const float* row_gate;
    __device__ __forceinline__ void operator()(const f32x4 (&acc)[2][2][4][2], const Unit& u, int wr, int wc, int fr, int fq) const {
#pragma unroll
        for (int a = 0; a < 2; ++a)
#pragma unroll
            for (int m = 0; m < 4; ++m) { const int row = 256 * u.pm + 128 * a + 64 * wr + 16 * m + fr; const float gw = row_gate[row];
#pragma unroll
                for (int b = 0; b < 2; ++b)
#pragma unroll
                    for (int n = 0; n < 2; ++n) { const int col = 256 * u.pn + ecol<PERM>(b, n, wc, fq); const f32x4 bv = *(const f32x4*)(bd + (size_t)u.e * 1024 + col);
                        const f32x4 v = (acc[a][b][m][n] + bv) * gw; u32x2 w; w.x = pk2(v[0], v[1]); w.y = pk2(v[2], v[3]); *(u32x2*)(Y + (size_t)row * 1024 + col) = w; } }
    }
};

__device__ __forceinline__ void tr_item(const float* W, int ldw, int k0, int n0, bf16_t* WT, int ldt, int orow0, int ocol0, const float* kscale, LAS float* scr, int lane) {
#pragma unroll 8
    for (int i = 0; i < 32; ++i) { const int kk = 2 * i + (lane >> 5); float v = W[(size_t)(k0 + kk) * ldw + n0 + (lane & 31)]; if (kscale) v *= kscale[k0 + kk]; scr[kk * 33 + (lane & 31)] = v; }
    asm volatile("s_waitcnt lgkmcnt(0)" ::: "memory");
    const int c = lane & 7;
#pragma unroll
    for (int j = 0; j < 4; ++j) { const int n = (lane >> 3) + 8 * j; const LAS float* s = scr + (8 * c) * 33 + n;
        u32x4 o; o.x = pk2(s[0 * 33], s[1 * 33]); o.y = pk2(s[2 * 33], s[3 * 33]); o.z = pk2(s[4 * 33], s[5 * 33]); o.w = pk2(s[6 * 33], s[7 * 33]);
        *(u32x4*)(WT + (size_t)(orow0 + n) * ldt + ocol0 + 8 * c) = o; }
    asm volatile("s_waitcnt lgkmcnt(0)" ::: "memory");
}
__device__ __forceinline__ void phase_prologue(const Params& p, LAS unsigned char* lds, int vcu, int G) {
    const int tid = threadIdx.x, wave = tid >> 6, lane = tid & 63;
    unsigned char* ws = p.ws;
    LAS float* scr = (LAS float*)(lds + wave * 16384);
    const int gw = vcu * NWAVES + wave, NGW = G * NWAVES;
    bf16_t* WinT = (bf16_t*)(ws + WS_WIN); bf16_t* WoT = (bf16_t*)(ws + WS_WO); bf16_t* WupT = (bf16_t*)(ws + WS_WUP);
    bf16_t* WguT = (bf16_t*)(ws + WS_WGU); bf16_t* WdT = (bf16_t*)(ws + WS_WD);
    constexpr int I_IN = 16 * 61, I_QB = 4 * 24, I_KVB = 2 * 32, I_O = 16 * 32, I_E = 16 * 32;
    constexpr int NITEMS = I_IN + I_QB + I_KVB + I_O + 3 * NE * I_E;
    for (int it = gw; it < NITEMS; it += NGW) {
        int r = it;
        if (r < I_IN) { const int kb = r / 61, nb = r % 61; tr_item(p.w_in, IN_COLS, 64 * kb, 32 * nb, WinT, 1024, 32 * nb, 64 * kb, nullptr, scr, lane); continue; } r -= I_IN;
        if (r < I_QB) { const int kb = r / 24, nb = r % 24; tr_item(p.w_q_b, 768, 64 * kb, 32 * nb, WupT, KUP, 32 * nb, 64 * kb, p.q_a_norm, scr, lane); continue; } r -= I_QB;
        if (r < I_KVB) { const int kb = r / 32, nb = r % 32; tr_item(p.w_kv_b, 1024, 64 * kb, 32 * nb, WupT, KUP, 768 + 32 * nb, 256 + 64 * kb, p.kv_a_norm, scr, lane); continue; } r -= I_KVB;
        if (r < I_O) { const int kb = r / 32, nb = r % 32; tr_item(p.w_o, 1024, 64 * kb, 32 * nb, WoT, 1024, 32 * nb, 64 * kb, nullptr, scr, lane); continue; } r -= I_O;
        const int mat = r / (NE * I_E), rr = r % (NE * I_E), e = rr / I_E, q = rr % I_E, kb = q / 32, nb = q % 32, n0 = 32 * nb;
        if (mat == 0) tr_item(p.w_gate + (size_t)e * 1048576, 1024, 64 * kb, n0, WguT, 1024, e * 2048 + (n0 >> 7) * 256 + (n0 & 127), 64 * kb, nullptr, scr, lane);
        else if (mat == 1) tr_item(p.w_up + (size_t)e * 1048576, 1024, 64 * kb, n0, WguT, 1024, e * 2048 + (n0 >> 7) * 256 + 128 + (n0 & 127), 64 * kb, nullptr, scr, lane);
        else tr_item(p.w_down + (size_t)e * 1048576, 1024, 64 * kb, n0, WdT, 1024, e * 1024 + n0, 64 * kb, nullptr, scr, lane);
    }
    const int gt = vcu * NTHREADS + tid, NGT = G * NTHREADS;
    for (int i = gt; i < 96 * 128; i += NGT) *(u32x4*)(WinT + (size_t)IN_COLS * 1024 + (size_t)i * 8) = (u32x4){0u, 0u, 0u, 0u};
    for (int i = gt; i < 768 * 16; i += NGT) { const int r = i / 16, c = i % 16; *(u32x4*)(WupT + (size_t)r * KUP + 256 + c * 8) = (u32x4){0u, 0u, 0u, 0u}; }
    for (int i = gt; i < 1024 * 32; i += NGT) { const int r = i / 32, c = i % 32; *(u32x4*)(WupT + (size_t)(768 + r) * KUP + c * 8) = (u32x4){0u, 0u, 0u, 0u}; }
    bf16_t* XB = (bf16_t*)(ws + WS_XB);
    for (int i = gt; i < NTOK * DM / 8; i += NGT) { const f32x4 a = *(const f32x4*)(p.x + (size_t)i * 8), b = *(const f32x4*)(p.x + (size_t)i * 8 + 4);
        u32x4 o; o.x = pk2(a[0], a[1]); o.y = pk2(a[2], a[3]); o.z = pk2(b[0], b[1]); o.w = pk2(b[2], b[3]); *(u32x4*)(XB + (size_t)i * 8) = o; }
    { float* WRL = (float*)(ws + WS_WRL);
      for (int n = gt; n < 32768; n += NGT) { const int ln = n & 63, q = n >> 6, e = q & 31, ji = q >> 5, j = ji >> 2, i = ji & 3; WRL[n] = p.w_router[(size_t)(4 * ln + 256 * j + i) * 32 + e]; } }
    float* ropeA = (float*)(ws + WS_ROPEA); float* ropeB = (float*)(ws + WS_ROPEB);
    for (int i = gt; i < NTOK * 24; i += NGT) { const int tok = i / 24, j = i % 24; const double f = (j < 16) ? p.invfA[j] : p.invfB[j - 16];
        const double rev = (double)p.pos[tok] * f * 0.15915494309189535; const float fr = (float)(rev - __builtin_rint(rev));
        const float cs = __builtin_amdgcn_cosf(fr), sn = __builtin_amdgcn_sinf(fr);
        if (j < 16) { ropeA[(size_t)tok * 32 + j] = cs; ropeA[(size_t)tok * 32 + 16 + j] = sn; } else { ropeB[(size_t)tok * 16 + (j - 16)] = cs; ropeB[(size_t)tok * 16 + 8 + (j - 16)] = sn; } }
}

__device__ __forceinline__ void phase_prep(const Params& p, LAS unsigned char* lds, int vcu, int G) {
    const int tid = threadIdx.x, wave = tid >> 6, lane = tid & 63;
    unsigned char* ws = p.ws;
    const bf16_t* PROJ = (const bf16_t*)(ws + WS_PROJ);
    float* rstd = (float*)(ws + WS_RSTD); const float* ropeA = (const float*)(ws + WS_ROPEA); const float* ropeB = (const float*)(ws + WS_ROPEB);
    bf16_t* KM = (bf16_t*)(ws + WS_KM); bf16_t* QB = (bf16_t*)(ws + WS_QB); bf16_t* KB = (bf16_t*)(ws + WS_KB); float* kmean = (float*)(ws + WS_KMEAN);
    const int gw = vcu * NWAVES + wave, NGW = G * NWAVES;
    for (int row = gw; row < NTOK; row += NGW) {
        float s = 0.f;
        if (lane < 48) { const u32x4 v = *(const u32x4*)(PROJ + (size_t)row * PN + lane * 8);
#pragma unroll
            for (int q = 0; q < 4; ++q) { const float a = __uint_as_float(v[q] << 16), b = __uint_as_float(v[q] & 0xffff0000u); s += a * a + b * b; } }
#pragma unroll
        for (int o = 1; o < 32; o <<= 1) s += __shfl_xor(s, o);
        if (lane == 0) rstd[2 * row] = 1.0f / sqrtf(s * (1.0f / 256.0f) + RMS_EPS);
        if (lane == 32) rstd[2 * row + 1] = 1.0f / sqrtf(s * (1.0f / 128.0f) + RMS_EPS);
    }
    const int gt = vcu * NTHREADS + tid, NGT = G * NTHREADS;
    for (int i = gt; i < NTOK * 16; i += NGT) { const int tok = i >> 4, j = i & 15;
        const float x1 = bf2f(PROJ[(size_t)tok * PN + C_KR + j]), x2 = bf2f(PROJ[(size_t)tok * PN + C_KR + 16 + j]);
        const float c = ropeA[(size_t)tok * 32 + j], s = ropeA[(size_t)tok * 32 + 16 + j];
        const bf16_t o1 = (bf16_t)f2bf(x1 * c - x2 * s), o2 = (bf16_t)f2bf(x2 * c + x1 * s);
#pragma unroll
        for (int h = 0; h < 8; ++h) { KM[(size_t)tok * 768 + h * 96 + 64 + j] = o1; KM[(size_t)tok * 768 + h * 96 + 80 + j] = o2; } }
    LAS float* red = (LAS float*)lds;
    for (int unit = vcu; unit < 512; unit += G) {
        const int ub = unit >> 3, h = unit & 7, tg = tid >> 6, d = tid & 63, c = h * 64 + d; float ksum = 0.f;
#pragma unroll 4
        for (int i = 0; i < 32; ++i) { const int tok = ub * 256 + tg * 32 + i; const bf16_t* pr = PROJ + (size_t)tok * PN;
            float qv = bf2f(pr[C_MQ + c]), kv = bf2f(pr[C_MK + c]);
            if (d < 16) { const int j = d & 7; const float cs = ropeB[(size_t)tok * 16 + j], sn = ropeB[(size_t)tok * 16 + 8 + j];
                if (d < 8) { const float q2 = bf2f(pr[C_MQ + c + 8]), k2 = bf2f(pr[C_MK + c + 8]); qv = qv * cs - q2 * sn; kv = kv * cs - k2 * sn; }
                else { const float q1 = bf2f(pr[C_MQ + c - 8]), k1 = bf2f(pr[C_MK + c - 8]); qv = qv * cs + q1 * sn; kv = kv * cs + k1 * sn; } }
            QB[(size_t)tok * 512 + c] = (bf16_t)f2bf(qv * C2B); KB[(size_t)tok * 512 + c] = (bf16_t)f2bf(kv); ksum += kv; }
        red[tg * 64 + d] = ksum;
        __syncthreads();
        if (tid < 64) { float t = 0.f;
#pragma unroll
            for (int g8 = 0; g8 < 8; ++g8) t += red[g8 * 64 + tid];
            kmean[(size_t)ub * 512 + h * 64 + tid] = t * (1.0f / 256.0f); }
        __syncthreads();
    }
}

typedef float f32x16 __attribute__((ext_vector_type(16)));
typedef short s16x4 __attribute__((ext_vector_type(4)));
namespace fa {
constexpr int KBUF = 12288, VBUF = 8192, BUF = KBUF + VBUF, WS_OFF = 2 * BUF, LDS_NEED = WS_OFF + 8 * 256;
constexpr float THR = 8.0f;
__device__ __forceinline__ int crow(int r, int hi) { return (r & 3) + 8 * (r >> 2) + 4 * hi; }
__device__ __forceinline__ unsigned cvtpk(float lo, float hi) { typedef __bf16 bf2 __attribute__((ext_vector_type(2))); f32x2 v = {lo, hi}; bf2 b = __builtin_convertvector(v, bf2); return __builtin_bit_cast(unsigned, b); }
__device__ __forceinline__ float xhalf_max(float m) { auto rr = __builtin_amdgcn_permlane32_swap(__float_as_uint(m), __float_as_uint(m), false, false); return fmaxf(__uint_as_float(rr[0]), __uint_as_float(rr[1])); }
__device__ __forceinline__ float xhalf_sum(float m) { auto rr = __builtin_amdgcn_permlane32_swap(__float_as_uint(m), __float_as_uint(m), false, false); return __uint_as_float(rr[0]) + __uint_as_float(rr[1]); }
}
template <int DQK>
__device__ __forceinline__ void attn_unit(LAS unsigned char* lds, const bf16_t* Q, int qpitch, const bf16_t* K, int kpitch, const bf16_t* V, int vpitch, bf16_t* O, int qb, const float* kmean) {
    using namespace fa;
    constexpr int ND = DQK / 16, NCH = DQK / 8;
    const int tid = threadIdx.x, lane = tid & 63, r32 = lane & 31, hi = lane >> 5, wid = __builtin_amdgcn_readfirstlane(tid >> 6);
    const int q0 = qb * 256, qrel = wid * 32 + r32;
    LAS float* wsf = (LAS float*)(lds + WS_OFF) + wid * 64;
    bf16x8 qr[ND];
#pragma unroll
    for (int d0 = 0; d0 < ND; ++d0) qr[d0] = *(const bf16x8*)(Q + (size_t)(q0 + qrel) * qpitch + d0 * 16 + hi * 8);
    unsigned sel = 0xffu;
    if (kmean) {
        float gt[8];
#pragma unroll
        for (int n = 0; n < 8; ++n) gt[n] = -INFINITY;
#pragma unroll 1
        for (int n = 0; n < qb; ++n) { float s = 0.f; const float* km = kmean + (size_t)n * 512;
#pragma unroll
            for (int d0 = 0; d0 < ND; ++d0) { const f32x4 k0 = *(const f32x4*)(km + d0 * 16 + hi * 8), k1 = *(const f32x4*)(km + d0 * 16 + hi * 8 + 4);
#pragma unroll
                for (int j = 0; j < 4; ++j) { s = fmaf(bf2f((unsigned short)qr[d0][j]), k0[j], s); s = fmaf(bf2f((unsigned short)qr[d0][4 + j]), k1[j], s); } }
            s = xhalf_sum(s);
#pragma unroll
            for (int j = 0; j < 8; ++j) gt[j] = (j == n) ? s : gt[j]; }
        sel = 0u;
#pragma unroll
        for (int n = 0; n < 8; ++n) { int cnt = 0;
#pragma unroll
            for (int n2 = 0; n2 < 8; ++n2) if (n2 != n) cnt += (n2 < qb && (gt[n2] > gt[n] || (gt[n2] == gt[n] && n2 < n))) ? 1 : 0;
            if (n < qb && cnt < 3) sel |= 1u << n; }
    }
    const bf16_t* ksrc = K + (size_t)lane * kpitch;
    const bf16_t* vsrc = V + (size_t)(16 * (wid & 3) + (lane >> 2)) * vpitch + (wid >> 2) * 32 + (lane & 3) * 8;
#define FA_DMA(ti, buf) do { \
        __builtin_amdgcn_global_load_lds((const unsigned*)(ksrc + (size_t)(ti) * 64 * kpitch + wid * 8), (LAS unsigned*)(lds + (buf) * BUF + wid * 1024), 16, 0, 0); \
        if (NCH > 8 && wid < NCH - 8) __builtin_amdgcn_global_load_lds((const unsigned*)(ksrc + (size_t)(ti) * 64 * kpitch + (wid + 8) * 8), (LAS unsigned*)(lds + (buf) * BUF + (wid + 8) * 1024), 16, 0, 0); \
        __builtin_amdgcn_global_load_lds((const unsigned*)(vsrc + (size_t)(ti) * 64 * vpitch), (LAS unsigned*)(lds + (buf) * BUF + KBUF + wid * 1024), 16, 0, 0); } while (0)
#define FA_TILE(i) (((i) < 4) ? 4 * qb + (i) : (i) - 4)
    const int NT = 4 * qb + 4;
    float mhat = 0.f, l_reg = 0.f; f32x16 o[2]; o[0] = f32x16{}; o[1] = f32x16{}; f32x16 negm = f32x16{};
    const int koff = hi * 1024 + r32 * 16;
    const int voff = ((lane >> 4) & 1) * 32 + (lane & 3) * 8 + (4 * hi + ((lane & 15) >> 2)) * 64;
    FA_DMA(FA_TILE(0), 0);
    asm volatile("s_waitcnt vmcnt(0)" ::: "memory"); __builtin_amdgcn_s_barrier(); asm volatile("" ::: "memory");
    for (int i = 0; i < NT; ++i) {
        const int buf = i & 1;
        if (i + 1 < NT) { const int tn = FA_TILE(i + 1); FA_DMA(tn, buf ^ 1); }
        const bool band = i < 4;
        if (!(band && 2 * i > wid)) {
            const LAS unsigned char* kb = lds + buf * BUF + koff;
            f32x16 p0 = negm, p1 = negm;
#pragma unroll
            for (int d0 = 0; d0 < ND; ++d0) { const bf16x8 a0 = *(const LAS bf16x8*)(kb + d0 * 2048), a1 = *(const LAS bf16x8*)(kb + d0 * 2048 + 512);
                p0 = __builtin_amdgcn_mfma_f32_32x32x16_bf16(a0, qr[d0], p0, 0, 0, 0); p1 = __builtin_amdgcn_mfma_f32_32x32x16_bf16(a1, qr[d0], p1, 0, 0, 0); }
            if (band) { if (64 * i + 63 > 32 * wid) {
#pragma unroll
                    for (int r = 0; r < 16; ++r) { const int kv = 64 * i + crow(r, hi); if (kv > qrel) p0[r] = -INFINITY; if (kv + 32 > qrel) p1[r] = -INFINITY; } } }
            else if (!((sel >> ((i - 4) >> 2)) & 1u)) {
#pragma unroll
                for (int r = 0; r < 16; ++r) { p0[r] = -INFINITY; p1[r] = -INFINITY; } }
            float rm = fmaxf(p0[0], p1[0]);
#pragma unroll
            for (int r = 1; r < 16; ++r) rm = fmaxf(rm, fmaxf(p0[r], p1[r]));
            rm = xhalf_max(rm);
            if (i == 0 || __any(rm > THR)) {
                const float dl = (i == 0) ? rm : fmaxf(rm, 0.f); mhat += dl;
#pragma unroll
                for (int r = 0; r < 16; ++r) { p0[r] -= dl; p1[r] -= dl; negm[r] = -mhat; }
                if (i != 0) { const float f = __builtin_amdgcn_exp2f(-dl); l_reg *= f; if (hi == 0) wsf[r32] = f;
                    asm volatile("s_waitcnt lgkmcnt(0)" ::: "memory");
#pragma unroll
                    for (int r = 0; r < 16; ++r) { const float fr_ = wsf[crow(r, hi)]; o[0][r] *= fr_; o[1][r] *= fr_; } }
            }
            float sacc = 0.f;
#pragma unroll
            for (int r = 0; r < 16; ++r) { p0[r] = __builtin_amdgcn_exp2f(p0[r]); p1[r] = __builtin_amdgcn_exp2f(p1[r]); sacc += p0[r] + p1[r]; }
            l_reg += sacc;
            u32x4 pw[4];
#pragma unroll
            for (int s = 0; s < 2; ++s)
#pragma unroll
                for (int j = 0; j < 4; ++j) { pw[s][j] = cvtpk(p0[8 * s + 2 * j], p0[8 * s + 2 * j + 1]); pw[2 + s][j] = cvtpk(p1[8 * s + 2 * j], p1[8 * s + 2 * j + 1]); }
            const LAS unsigned char* vb = lds + buf * BUF + KBUF + voff;
#pragma unroll
            for (int d0 = 0; d0 < 2; ++d0)
#pragma unroll
                for (int s = 0; s < 4; ++s) {
                    const s16x4 lo = __builtin_bit_cast(s16x4, __builtin_amdgcn_ds_read_tr16_b64_v4i16((LAS s16x4*)(vb + d0 * 4096 + s * 1024)));
                    const s16x4 hh = __builtin_bit_cast(s16x4, __builtin_amdgcn_ds_read_tr16_b64_v4i16((LAS s16x4*)(vb + d0 * 4096 + s * 1024 + 512)));
                    const bf16x8 vf = (bf16x8){lo[0], lo[1], lo[2], lo[3], hh[0], hh[1], hh[2], hh[3]};
                    o[d0] = __builtin_amdgcn_mfma_f32_32x32x16_bf16(__builtin_bit_cast(bf16x8, pw[s]), vf, o[d0], 0, 0, 0); }
        }
        asm volatile("s_waitcnt vmcnt(0) lgkmcnt(0)" ::: "memory"); __builtin_amdgcn_s_barrier(); asm volatile("" ::: "memory");
    }
    l_reg = xhalf_sum(l_reg);
    if (hi == 0) wsf[32 + r32] = l_reg;
    asm volatile("s_waitcnt lgkmcnt(0)" ::: "memory");
#pragma unroll
    for (int r = 0; r < 16; ++r) { const float rl = 1.0f / wsf[32 + crow(r, hi)]; bf16_t* op = O + (size_t)(q0 + wid * 32 + crow(r, hi)) * 1024 + r32;
        op[0] = (bf16_t)f2bf(o[0][r] * rl); op[32] = (bf16_t)f2bf(o[1][r] * rl); }
    asm volatile("s_waitcnt lgkmcnt(0)" ::: "memory"); __builtin_amdgcn_s_barrier(); asm volatile("" ::: "memory");
#undef FA_DMA
#undef FA_TILE
}
__device__ __forceinline__ void phase_attn_fast(const Params& p, LAS unsigned char* lds, int vcu, int G) {
    unsigned char* ws = p.ws;
    const bf16_t* QM = (const bf16_t*)(ws + WS_QM); const bf16_t* KM = (const bf16_t*)(ws + WS_KM); const bf16_t* VM = (const bf16_t*)(ws + WS_VM);
    const bf16_t* QB = (const bf16_t*)(ws + WS_QB); const bf16_t* KB = (const bf16_t*)(ws + WS_KB); const bf16_t* PROJ = (const bf16_t*)(ws + WS_PROJ);
    const float* kmean = (const float*)(ws + WS_KMEAN); bf16_t* ATT = (bf16_t*)(ws + WS_ATT);
    for (int su = vcu; su < 256; su += G) {
        const int bh = su >> 2, j = su & 3, b = bh >> 3, h = bh & 7; const size_t r0 = (size_t)b * SEQ;
#pragma unroll 1
        for (int k = 0; k < 2; ++k) { const int qb = k ? 7 - j : j;
            attn_unit<96>(lds, QM + r0 * 768 + h * 96, 768, KM + r0 * 768 + h * 96, 768, VM + r0 * 512 + h * 64, 512, ATT + r0 * 1024 + h * 64, qb, nullptr);
            attn_unit<64>(lds, QB + r0 * 512 + h * 64, 512, KB + r0 * 512 + h * 64, 512, PROJ + r0 * PN + C_MV + h * 64, PN, ATT + r0 * 1024 + 512 + h * 64, qb, kmean + (size_t)(b * 8) * 512 + h * 64); }
    }
}

__device__ __forceinline__ void phase_attn(const Params& p, int vcu, int G) {
    const int tid = threadIdx.x, wave = __builtin_amdgcn_readfirstlane(tid >> 6);
    unsigned char* ws = p.ws;
    const bf16_t* QM = (const bf16_t*)(ws + WS_QM); const bf16_t* KM = (const bf16_t*)(ws + WS_KM); const bf16_t* VM = (const bf16_t*)(ws + WS_VM);
    const bf16_t* QB = (const bf16_t*)(ws + WS_QB); const bf16_t* KB = (const bf16_t*)(ws + WS_KB); const bf16_t* PROJ = (const bf16_t*)(ws + WS_PROJ);
    const float* kmean = (const float*)(ws + WS_KMEAN); bf16_t* ATT = (bf16_t*)(ws + WS_ATT);
    for (int U = vcu; U < 1024; U += G) {
        const int type = U >> 9, vh = (U >> 8) & 1, rem = U & 255, b = rem >> 5, h = (rem >> 2) & 7, ch = rem & 3;
        const int t = ch * 512 + tid, tok = b * SEQ + t;
        const int kmax = ch * 512 + wave * 64 + 63;
        float o[32];
#pragma unroll
        for (int d = 0; d < 32; ++d) o[d] = 0.f;
        float mx = -INFINITY, l = 0.f;
        if (type == 0) {
            u32x4 qp[12];
#pragma unroll
            for (int d8 = 0; d8 < 12; ++d8) qp[d8] = *(const u32x4*)(QM + (size_t)tok * 768 + h * 96 + d8 * 8);
#pragma unroll 1
            for (int key = 0; key <= kmax; ++key) {
                const bf16_t* kp = KM + (size_t)(b * SEQ + key) * 768 + h * 96; const bf16_t* vp = VM + (size_t)(b * SEQ + key) * 512 + h * 64 + vh * 32;
                float s = 0.f;
#pragma unroll
                for (int d8 = 0; d8 < 12; ++d8) { const u32x4 v = *(const u32x4*)(kp + d8 * 8);
#pragma unroll
                    for (int k = 0; k < 4; ++k) { s = fmaf(__uint_as_float(qp[d8][k] << 16), __uint_as_float(v[k] << 16), s); s = fmaf(__uint_as_float(qp[d8][k] & 0xffff0000u), __uint_as_float(v[k] & 0xffff0000u), s); } }
                if (key <= t) { const float mn = fmaxf(mx, s), al = __builtin_amdgcn_exp2f(mx - mn), pe = __builtin_amdgcn_exp2f(s - mn); l = l * al + pe; mx = mn;
#pragma unroll
                    for (int d8 = 0; d8 < 4; ++d8) { const u32x4 v = *(const u32x4*)(vp + d8 * 8);
#pragma unroll
                        for (int k = 0; k < 4; ++k) { o[d8 * 8 + 2 * k] = fmaf(pe, __uint_as_float(v[k] << 16), o[d8 * 8 + 2 * k] * al); o[d8 * 8 + 2 * k + 1] = fmaf(pe, __uint_as_float(v[k] & 0xffff0000u), o[d8 * 8 + 2 * k + 1] * al); } } }
            }
        } else {
            u32x4 qp[8];
#pragma unroll
            for (int d8 = 0; d8 < 8; ++d8) qp[d8] = *(const u32x4*)(QB + (size_t)tok * 512 + h * 64 + d8 * 8);
            const int cur = t >> 8;
            float gt[8];
#pragma unroll
            for (int n = 0; n < 8; ++n) gt[n] = -INFINITY;
#pragma unroll 1
            for (int n = 0; n < cur; ++n) { float s = 0.f; const float* km = kmean + (size_t)(b * 8 + n) * 512 + h * 64;
#pragma unroll
                for (int d8 = 0; d8 < 8; ++d8)
#pragma unroll
                    for (int k = 0; k < 4; ++k) { s = fmaf(__uint_as_float(qp[d8][k] << 16), km[d8 * 8 + 2 * k], s); s = fmaf(__uint_as_float(qp[d8][k] & 0xffff0000u), km[d8 * 8 + 2 * k + 1], s); }
#pragma unroll
                for (int j = 0; j < 8; ++j) gt[j] = (j == n) ? s : gt[j]; }
            unsigned sel = 0u;
#pragma unroll
            for (int n = 0; n < 8; ++n) { int cnt = 0;
#pragma unroll
                for (int n2 = 0; n2 < 8; ++n2) if (n2 != n) cnt += (n2 < cur && (gt[n2] > gt[n] || (gt[n2] == gt[n] && n2 < n))) ? 1 : 0;
                if (n < cur && cnt < 3) sel |= 1u << n; }
#pragma unroll 1
            for (int key = 0; key <= kmax; ++key) {
                const bf16_t* kp = KB + (size_t)(b * SEQ + key) * 512 + h * 64; const bf16_t* vp = PROJ + (size_t)(b * SEQ + key) * PN + C_MV + h * 64 + vh * 32;
                const int nb = key >> 8; const bool ok = (nb == cur) ? (key <= t) : (((sel >> nb) & 1u) != 0u);
                float s = 0.f;
#pragma unroll
                for (int d8 = 0; d8 < 8; ++d8) { const u32x4 v = *(const u32x4*)(kp + d8 * 8);
#pragma unroll
                    for (int k = 0; k < 4; ++k) { s = fmaf(__uint_as_float(qp[d8][k] << 16), __uint_as_float(v[k] << 16), s); s = fmaf(__uint_as_float(qp[d8][k] & 0xffff0000u), __uint_as_float(v[k] & 0xffff0000u), s); } }
                if (ok) { const float mn = fmaxf(mx, s), al = __builtin_amdgcn_exp2f(mx - mn), pe = __builtin_amdgcn_exp2f(s - mn); l = l * al + pe; mx = mn;
#pragma unroll
                    for (int d8 = 0; d8 < 4; ++d8) { const u32x4 v = *(const u32x4*)(vp + d8 * 8);
#pragma unroll
                        for (int k = 0; k < 4; ++k) { o[d8 * 8 + 2 * k] = fmaf(pe, __uint_as_float(v[k] << 16), o[d8 * 8 + 2 * k] * al); o[d8 * 8 + 2 * k + 1] = fmaf(pe, __uint_as_float(v[k] & 0xffff0000u), o[d8 * 8 + 2 * k + 1] * al); } } }
            }
        }
        const float il = 1.0f / l;
        bf16_t* op = ATT + (size_t)tok * 1024 + type * 512 + h * 64 + vh * 32;
#pragma unroll
        for (int d8 = 0; d8 < 4; ++d8) { u32x4 w; w.x = pk2(o[d8 * 8] * il, o[d8 * 8 + 1] * il); w.y = pk2(o[d8 * 8 + 2] * il, o[d8 * 8 + 3] * il); w.z = pk2(o[d8 * 8 + 4] * il, o[d8 * 8 + 5] * il); w.w = pk2(o[d8 * 8 + 6] * il, o[d8 * 8 + 7] * il);
            *(u32x4*)(op + d8 * 8) = w; }
    }
}

__device__ __forceinline__ float rs32(float (&a)[32], int lane) {
#pragma unroll
    for (int e = 0; e < 16; ++e) { auto rr = __builtin_amdgcn_permlane32_swap(__float_as_uint(a[e]), __float_as_uint(a[e + 16]), false, false); a[e] = __uint_as_float(rr[0]) + __uint_as_float(rr[1]); }
#pragma unroll
    for (int e = 0; e < 8; ++e) { auto rr = __builtin_amdgcn_permlane16_swap(__float_as_uint(a[e]), __float_as_uint(a[e + 8]), false, false); a[e] = __uint_as_float(rr[0]) + __uint_as_float(rr[1]); }
    { const bool bit = (lane & 8) != 0;
#pragma unroll
      for (int e = 0; e < 4; ++e) { const float keep = bit ? a[e + 4] : a[e], send = bit ? a[e] : a[e + 4]; a[e] = keep + __shfl_xor(send, 8); } }
    { const bool bit = (lane & 4) != 0;
#pragma unroll
      for (int e = 0; e < 2; ++e) { const float keep = bit ? a[e + 2] : a[e], send = bit ? a[e] : a[e + 2]; a[e] = keep + __shfl_xor(send, 4); } }
    { const bool bit = (lane & 2) != 0; const float keep = bit ? a[1] : a[0], send = bit ? a[0] : a[1]; a[0] = keep + __shfl_xor(send, 2); }
    return a[0] + __shfl_xor(a[0], 1);
}
__device__ __forceinline__ void route_row(const Params& p, float logit, int tok, int tl, int lane, int* tidx, float* tgate, LAS int* lidx) {
    const int me = lane >> 1;
    const float my = (lane & 1) ? -INFINITY : logit + p.b_router[me];
    int rank = 0;
#pragma unroll
    for (int e = 0; e < 32; ++e) { const float ve = __uint_as_float(__builtin_amdgcn_readlane(__float_as_uint(my), 2 * e)); rank += (ve > my || (ve == my && e < me)) ? 1 : 0; }
    float tv[4]; int ti[4];
#pragma unroll
    for (int k = 0; k < 4; ++k) { const unsigned long long bal = __ballot(rank == k && !(lane & 1)); const int il = __ffsll((long long)bal) - 1;
        tv[k] = __uint_as_float(__builtin_amdgcn_readlane(__float_as_uint(my), il)); ti[k] = il >> 1; }
    if (lane == 0) { const float e1 = expf(tv[1] - tv[0]), e2 = expf(tv[2] - tv[0]), e3 = expf(tv[3] - tv[0]); const float is = 1.0f / (1.0f + e1 + e2 + e3);
        *(f32x4*)(tgate + (size_t)tok * 4) = (f32x4){is, e1 * is, e2 * is, e3 * is};
        int* tp = tidx + (size_t)tok * 4; tp[0] = ti[0]; tp[1] = ti[1]; tp[2] = ti[2]; tp[3] = ti[3];
        lidx[tl * 4 + 0] = ti[0]; lidx[tl * 4 + 1] = ti[1]; lidx[tl * 4 + 2] = ti[2]; lidx[tl * 4 + 3] = ti[3]; }
}
__device__ __forceinline__ void phase_ln1_route(const Params& p, LAS unsigned char* lds, int vcu, int G) {
    const int tid = threadIdx.x, wave = tid >> 6, lane = tid & 63;
    unsigned char* ws = p.ws;
    float* X1 = p.out; const float* X1P = (const float*)(ws + WS_X1PRE); bf16_t* X1B = (bf16_t*)(ws + WS_X1B);
    int* tidx = (int*)(ws + WS_TIDX); float* tgate = (float*)(ws + WS_TGATE); unsigned* hist = (unsigned*)(ws + WS_HIST);
    LAS int* lidx = (LAS int*)(lds + ROWTAB_OFF);
    { const float* WRL = (const float*)(ws + WS_WRL);
      for (int i = tid; i < 8192; i += NTHREADS) *(LAS f32x4*)(lds + (size_t)i * 16) = *(const f32x4*)(WRL + (size_t)i * 4); }
    __syncthreads();
    const LAS float* Wl = (const LAS float*)lds + lane;
    for (int chunk = vcu; chunk < NCHUNK; chunk += G) {
#pragma unroll 1
        for (int rp = 0; rp < 4; ++rp) {
            const int tl = wave * 8 + 2 * rp, tok = chunk * 64 + tl;
            f32x4 v0[4], v1[4]; float s0 = 0.f, s1 = 0.f;
#pragma unroll
            for (int j = 0; j < 4; ++j) { v0[j] = *(const f32x4*)(X1P + (size_t)tok * DM + 4 * lane + 256 * j); v1[j] = *(const f32x4*)(X1P + (size_t)(tok + 1) * DM + 4 * lane + 256 * j);
                s0 += (v0[j][0] + v0[j][1]) + (v0[j][2] + v0[j][3]); s1 += (v1[j][0] + v1[j][1]) + (v1[j][2] + v1[j][3]); }
            const float mean0 = wave_sum(s0) * (1.0f / DM), mean1 = wave_sum(s1) * (1.0f / DM); float q0 = 0.f, q1 = 0.f;
#pragma unroll
            for (int j = 0; j < 4; ++j) { v0[j] = v0[j] - mean0; v1[j] = v1[j] - mean1;
                q0 += (v0[j][0] * v0[j][0] + v0[j][1] * v0[j][1]) + (v0[j][2] * v0[j][2] + v0[j][3] * v0[j][3]); q1 += (v1[j][0] * v1[j][0] + v1[j][1] * v1[j][1]) + (v1[j][2] * v1[j][2] + v1[j][3] * v1[j][3]); }
            const float rs0 = 1.0f / sqrtf(wave_sum(q0) * (1.0f / DM) + LN_EPS), rs1 = 1.0f / sqrtf(wave_sum(q1) * (1.0f / DM) + LN_EPS);
#pragma unroll
            for (int j = 0; j < 4; ++j) { const f32x4 g = *(const f32x4*)(p.ln1_g + 4 * lane + 256 * j), bb = *(const f32x4*)(p.ln1_b + 4 * lane + 256 * j);
                v0[j] = v0[j] * rs0 * g + bb; v1[j] = v1[j] * rs1 * g + bb;
                *(f32x4*)(X1 + (size_t)tok * DM + 4 * lane + 256 * j) = v0[j]; *(f32x4*)(X1 + (size_t)(tok + 1) * DM + 4 * lane + 256 * j) = v1[j];
                u32x2 w; w.x = pk2(v0[j][0], v0[j][1]); w.y = pk2(v0[j][2], v0[j][3]); *(u32x2*)(X1B + (size_t)tok * DM + 4 * lane + 256 * j) = w;
                w.x = pk2(v1[j][0], v1[j][1]); w.y = pk2(v1[j][2], v1[j][3]); *(u32x2*)(X1B + (size_t)(tok + 1) * DM + 4 * lane + 256 * j) = w; }
            float a0[32], a1[32];
#pragma unroll
            for (int e = 0; e < 32; ++e) { a0[e] = 0.f; a1[e] = 0.f; }
            const LAS float* wlo = Wl; const LAS float* whi = Wl + 8 * 32 * 64;
            asm volatile("" : "+v"(wlo), "+v"(whi));
#pragma unroll
            for (int j = 0; j < 4; ++j)
#pragma unroll
                for (int i = 0; i < 4; ++i) { const float x0 = v0[j][i], x1 = v1[j][i]; const LAS float* wb = (j < 2) ? wlo + (j * 4 + i) * 32 * 64 : whi + ((j - 2) * 4 + i) * 32 * 64;
#pragma unroll
                    for (int e = 0; e < 32; ++e) { const float w = wb[e * 64]; a0[e] = fmaf(x0, w, a0[e]); a1[e] = fmaf(x1, w, a1[e]); }
                    asm volatile("" ::: "memory"); }
            const float l0 = rs32(a0, lane), l1 = rs32(a1, lane);
            route_row(p, l0, tok, tl, lane, tidx, tgate, lidx);
            route_row(p, l1, tok + 1, tl + 1, lane, tidx, tgate, lidx);
        }
        __syncthreads();
        if (tid < 32) { unsigned c = 0; for (int a = 0; a < 256; ++a) c += (lidx[a] == tid) ? 1u : 0u; hist[chunk * 32 + tid] = c; }
        __syncthreads();
    }
}

__device__ __forceinline__ void phase_assign(const Params& p, LAS unsigned char* lds, int vcu, int G) {
    const int tid = threadIdx.x;
    unsigned char* ws = p.ws;
    const int* tidx = (const int*)(ws + WS_TIDX); const float* tgate = (const float*)(ws + WS_TGATE); const unsigned* hist = (const unsigned*)(ws + WS_HIST);
    int* dest = (int*)(ws + WS_DEST); int* row_tok = (int*)(ws + WS_ROWTOK); float* row_gate = (float*)(ws + WS_ROWGATE); int* tile_e = (int*)(ws + WS_TILEE);
    LAS int* lidx = (LAS int*)lds;
    LAS int* lcnt = (LAS int*)(lds + 1024);
    LAS int* lpre = (LAS int*)(lds + 1024 + 128);
    LAS int* lstart = (LAS int*)(lds + 1024 + 256);
    LAS int* ptot = (LAS int*)(lds + 2048);
    LAS int* ppre = (LAS int*)(lds + 4096);
    for (int chunk = vcu; chunk < NCHUNK; chunk += G) {
        if (tid < 256) lidx[tid] = tidx[chunk * 256 + tid];
        { const int e = tid & 31, cg = tid >> 5; int tot = 0, pre = 0;
#pragma unroll
          for (int k = 0; k < 16; ++k) { const int c = cg * 16 + k; const int hv = (int)hist[c * 32 + e]; tot += hv; pre += (c < chunk) ? hv : 0; }
          ptot[cg * 32 + e] = tot; ppre[cg * 32 + e] = pre; }
        __syncthreads();
        if (tid < 32) { int tot = 0, pre = 0;
#pragma unroll
            for (int cg = 0; cg < 16; ++cg) { tot += ptot[cg * 32 + tid]; pre += ppre[cg * 32 + tid]; }
            lcnt[tid] = tot; lpre[tid] = pre; }
        __syncthreads();
        if (tid == 0) { int s2 = 0; for (int e = 0; e < 32; ++e) { lstart[e] = s2; s2 += (lcnt[e] + 255) / 256 * 256; } lstart[32] = s2; }
        __syncthreads();
        if (tid < 256) { const int e = lidx[tid]; int rank = 0; for (int a = 0; a < tid; ++a) rank += (lidx[a] == e) ? 1 : 0;
            const int P = lstart[e] + lpre[e] + rank, tok = chunk * 64 + (tid >> 2);
            row_tok[P] = tok; row_gate[P] = tgate[chunk * 256 + tid]; dest[chunk * 256 + tid] = P; }
        if (chunk < 32) { const int e = chunk; for (int P = lstart[e] + lcnt[e] + tid; P < lstart[e + 1]; P += NTHREADS) { row_tok[P] = 0; row_gate[P] = 0.f; } }
        if (chunk == 0) { if (tid < 32) { for (int t = lstart[tid] / 256; t < lstart[tid + 1] / 256; ++t) tile_e[t] = tid; } if (tid == 32) tile_e[MAXTILES] = lstart[32] / 256; }
        __syncthreads();
    }
}

__device__ __forceinline__ void phase_final(const Params& p, int vcu, int G) {
    const int tid = threadIdx.x, wave = tid >> 6, lane = tid & 63;
    unsigned char* ws = p.ws;
    const int* dest = (const int*)(ws + WS_DEST); const bf16_t* Y = (const bf16_t*)(ws + WS_Y); float* X1 = p.out;
    const int gw = vcu * NWAVES + wave, NGW = G * NWAVES;
    for (int tok = gw; tok < NTOK; tok += NGW) {
        f32x4 v[4];
#pragma unroll
        for (int j = 0; j < 4; ++j) v[j] = *(const f32x4*)(X1 + (size_t)tok * DM + 4 * lane + 256 * j) * DN_ALPHA;
#pragma unroll
        for (int k = 0; k < 4; ++k) { const int P = dest[tok * 4 + k];
#pragma unroll
            for (int j = 0; j < 4; ++j) { const u32x2 w = *(const u32x2*)(Y + (size_t)P * 1024 + 4 * lane + 256 * j);
                v[j][0] += __uint_as_float(w.x << 16); v[j][1] += __uint_as_float(w.x & 0xffff0000u); v[j][2] += __uint_as_float(w.y << 16); v[j][3] += __uint_as_float(w.y & 0xffff0000u); } }
        float s = 0.f;
#pragma unroll
        for (int j = 0; j < 4; ++j) s += (v[j][0] + v[j][1]) + (v[j][2] + v[j][3]);
        const float mean = wave_sum(s) * (1.0f / DM); float s2 = 0.f;
#pragma unroll
        for (int j = 0; j < 4; ++j) { v[j] = v[j] - mean; s2 += (v[j][0] * v[j][0] + v[j][1] * v[j][1]) + (v[j][2] * v[j][2] + v[j][3] * v[j][3]); }
        const float rs = 1.0f / sqrtf(wave_sum(s2) * (1.0f / DM) + LN_EPS);
#pragma unroll
        for (int j = 0; j < 4; ++j) { const f32x4 g = *(const f32x4*)(p.ln2_g + 4 * lane + 256 * j), bb = *(const f32x4*)(p.ln2_b + 4 * lane + 256 * j);
            *(f32x4*)(p.out + (size_t)tok * DM + 4 * lane + 256 * j) = v[j] * rs * g + bb; }
    }
}

constexpr int NPHASE = 11;
__global__ void __launch_bounds__(NTHREADS, 2) fwd_kernel(Params p) {
    extern __shared__ __attribute__((aligned(16))) unsigned char lds_raw[];
    LAS unsigned char* lds = (LAS unsigned char*)lds_raw;
    const int tid = threadIdx.x;
    const int G = gridDim.x, bx = blockIdx.x;
    const int vcu = (G % 8 == 0) ? (bx % 8) * (G / 8) + bx / 8 : bx;
    unsigned char* ws = p.ws;
    volatile LAS unsigned* MISC = (volatile LAS unsigned*)(lds + MISC_OFF);
    if (tid < 32) MISC[tid] = 0u;
    __syncthreads();
    XcdBarrier bar; bar.bar = (unsigned*)(ws + WS_CTL) + CW_BAR; bar.x = 0; bar.st = nullptr;
    const bool one = (p.ph_hi - p.ph_lo) > 1;
    if (one) bar = xcd_barrier_post((unsigned*)(ws + WS_CTL) + CW_BAR, MISC + 8);
    const int lo = p.ph_lo, hi = p.ph_hi;
#ifdef ONLY_PHASE
#define IN(k) ((k) == ONLY_PHASE && lo <= (k) && (k) < hi)
#else
#define IN(k) (lo <= (k) && (k) < hi)
#endif
#ifndef NAIVE_GEMM_MASK
#define NAIVE_GEMM_MASK 0
#endif
#define GEMM_CALL(EPI, SCHED) do { if constexpr (NAIVE_GEMM_MASK != 0) gemm_phase_naive<EPI, SCHED>(lds, g, S, E); else gemm_phase<EPI, SCHED, true>(lds, g, S, E); } while (0)
#ifndef REPEAT_PHASE
#define REPEAT_PHASE (-1)
#endif
#define NREP(k) ((REPEAT_PHASE == (k)) ? 2 : 1)
#define REPBAR(k) do { if (REPEAT_PHASE == (k) && rep_ == 0) xcd_barrier(bar); } while (0)
#define SEAM(k) do { if (IN(k) && IN((k) + 1)) xcd_barrier(bar); } while (0)

    if (IN(0)) for (int rep_ = 0; rep_ < NREP(0); ++rep_) { phase_prologue(p, lds, vcu, G); REPBAR(0); } SEAM(0);
    if (IN(1)) for (int rep_ = 0; rep_ < NREP(1); ++rep_) { GemmArgs g{(const bf16_t*)(ws + WS_XB), 1024, (const bf16_t*)(ws + WS_WIN), 1024, 1024}; DenseSched S; S.init(lds, NTOK, PN, G, vcu);
        EpiProj E{(bf16_t*)(ws + WS_PROJ)}; GEMM_CALL(EpiProj, DenseSched); REPBAR(1); } SEAM(1);
    if (IN(2)) for (int rep_ = 0; rep_ < NREP(2); ++rep_) { phase_prep(p, lds, vcu, G); REPBAR(2); } SEAM(2);
    if (IN(3)) for (int rep_ = 0; rep_ < NREP(3); ++rep_) { GemmArgs g{(const bf16_t*)(ws + WS_PROJ), PN, (const bf16_t*)(ws + WS_WUP), KUP, KUP}; DenseSched S; S.init(lds, NTOK, NUP, G, vcu);
        EpiUp E{(bf16_t*)(ws + WS_QM), (bf16_t*)(ws + WS_KM), (bf16_t*)(ws + WS_VM), (const float*)(ws + WS_RSTD), (const float*)(ws + WS_ROPEA)}; GEMM_CALL(EpiUp, DenseSched); REPBAR(3); } SEAM(3);
    #ifdef NAIVE_ATTN
    if (IN(4)) for (int rep_ = 0; rep_ < NREP(4); ++rep_) { phase_attn(p, vcu, G); REPBAR(4); } SEAM(4);
#else
    if (IN(4)) for (int rep_ = 0; rep_ < NREP(4); ++rep_) { phase_attn_fast(p, lds, vcu, G); REPBAR(4); } SEAM(4);
#endif
    if (IN(5)) for (int rep_ = 0; rep_ < NREP(5); ++rep_) { GemmArgs g{(const bf16_t*)(ws + WS_ATT), 1024, (const bf16_t*)(ws + WS_WO), 1024, 1024}; DenseSched S; S.init(lds, NTOK, DM, G, vcu);
        EpiWo E{p.x, (float*)(ws + WS_X1PRE)}; GEMM_CALL(EpiWo, DenseSched); REPBAR(5); } SEAM(5);
    if (IN(6)) for (int rep_ = 0; rep_ < NREP(6); ++rep_) { phase_ln1_route(p, lds, vcu, G); REPBAR(6); } SEAM(6);
    if (IN(7)) for (int rep_ = 0; rep_ < NREP(7); ++rep_) { phase_assign(p, lds, vcu, G); REPBAR(7); } SEAM(7);
    if (IN(8)) for (int rep_ = 0; rep_ < NREP(8); ++rep_) { GemmArgs g{(const bf16_t*)(ws + WS_X1B), 1024, (const bf16_t*)(ws + WS_WGU), 1024, 1024}; GroupSched<true> S; S.init(lds, (const int*)(ws + WS_TILEE), (const int*)(ws + WS_ROWTOK), 8, 2048, G, vcu);
        EpiGateUp E{(bf16_t*)(ws + WS_H), p.b_gate, p.b_up}; GEMM_CALL(EpiGateUp, GroupSched<true>); REPBAR(8); } SEAM(8);
    if (IN(9)) for (int rep_ = 0; rep_ < NREP(9); ++rep_) { GemmArgs g{(const bf16_t*)(ws + WS_H), 1024, (const bf16_t*)(ws + WS_WD), 1024, 1024}; GroupSched<false> S; S.init(lds, (const int*)(ws + WS_TILEE), (const int*)(ws + WS_ROWTOK), 4, 1024, G, vcu);
        EpiDown E{(bf16_t*)(ws + WS_Y), p.b_down, (const float*)(ws + WS_ROWGATE)}; GEMM_CALL(EpiDown, GroupSched<false>); REPBAR(9); } SEAM(9);
    if (IN(10)) { phase_final(p, vcu, G); }
#undef IN
#undef SEAM
}

extern "C" void kernel_launch(void* const* d_in, const int* in_sizes, int n_in, void* d_out, int out_size, void* d_ws, size_t ws_size, hipStream_t stream) {
    static int grid = 0;
    if (grid == 0) {
        if (n_in != 20 || out_size != NTOK * DM || ws_size < WS_END) { fprintf(stderr, "kernel_launch: unexpected shapes (n_in %d out %d ws %zu)\n", n_in, out_size, ws_size); grid = -1; return; }
        int dev = 0, cus = 0, per_cu = 0;
        if (hipGetDevice(&dev) != hipSuccess || hipDeviceGetAttribute(&cus, hipDeviceAttributeMultiprocessorCount, dev) != hipSuccess) { grid = -1; return; }
        if (hipFuncSetAttribute((const void*)fwd_kernel, hipFuncAttributeMaxDynamicSharedMemorySize, LDS_BYTES) != hipSuccess) { fprintf(stderr, "kernel_launch: hipFuncSetAttribute failed\n"); grid = -1; return; }
        if (hipOccupancyMaxActiveBlocksPerMultiprocessor(&per_cu, (const void*)fwd_kernel, NTHREADS, LDS_BYTES) != hipSuccess || per_cu < 1) fprintf(stderr, "kernel_launch: occupancy query says %d\n", per_cu);
        (void)hipGetLastError();
        grid = cus;
    }
    if (grid < 0) return;
    (void)hipMemsetAsync((char*)d_ws + WS_CTL, 0, CTL_ZERO_BYTES, stream);
    Params p{};
    p.x = (const float*)d_in[0]; p.pos = (const int*)d_in[1]; p.w_in = (const float*)d_in[2]; p.q_a_norm = (const float*)d_in[3]; p.w_q_b = (const float*)d_in[4];
    p.kv_a_norm = (const float*)d_in[5]; p.w_kv_b = (const float*)d_in[6]; p.w_o = (const float*)d_in[7]; p.ln1_g = (const float*)d_in[8]; p.ln1_b = (const float*)d_in[9];
    p.w_router = (const float*)d_in[10]; p.b_router = (const float*)d_in[11]; p.w_gate = (const float*)d_in[12]; p.b_gate = (const float*)d_in[13];
    p.w_up = (const float*)d_in[14]; p.b_up = (const float*)d_in[15]; p.w_down = (const float*)d_in[16]; p.b_down = (const float*)d_in[17];
    p.ln2_g = (const float*)d_in[18]; p.ln2_b = (const float*)d_in[19];
    p.out = (float*)d_out; p.ws = (unsigned char*)d_ws;
    for (int i = 0; i < 16; ++i) p.invfA[i] = pow(500000.0, -(double)(2 * i) / 32.0);
    for (int i = 0; i < 8; ++i) p.invfB[i] = pow(500000.0, -(double)(2 * i) / 16.0);
#if MK_ONE_LAUNCH
    p.ph_lo = 0; p.ph_hi = NPHASE;
    hipLaunchKernelGGL(fwd_kernel, dim3(grid), dim3(NTHREADS), LDS_BYTES, stream, p);
#else
    for (int ph = 0; ph < NPHASE; ++ph) { p.ph_lo = ph; p.ph_hi = ph + 1; hipLaunchKernelGGL(fwd_kernel, dim3(grid), dim3(NTHREADS), LDS_BYTES, stream, p); }
#endif
}
```

```cpp
#include <hip/hip_runtime.h>
#include <cstdio>
#include <cstdint>
#include <cmath>

#ifndef MK_ONE_LAUNCH
#define MK_ONE_LAUNCH 1
#endif

#define GAS __attribute__((address_space(1)))
#define LAS __attribute__((address_space(3)))
typedef unsigned short bf16_t;
typedef short bf16x8 __attribute__((ext_vector_type(8)));
typedef float f32x4 __attribute__((ext_vector_type(4)));
typedef float f32x2 __attribute__((ext_vector_type(2)));
typedef unsigned u32x4 __attribute__((ext_vector_type(4)));
typedef unsigned u32x2 __attribute__((ext_vector_type(2)));

constexpr int NTOK = 16384, DM = 1024, SEQ = 2048, NBATCH = 8;
constexpr int PN = 2048;
constexpr int C_QL = 0, C_KVL = 256, C_KR = 384, C_MQ = 416, C_MK = 928, C_MV = 1440, IN_COLS = 1952;
constexpr int NUP = 1792, KUP = 384;
constexpr int NE = 32, TOPK = 4;
constexpr int MAXROWS = 65536 + NE * 256, MAXTILES = MAXROWS / 256;
constexpr int NCHUNK = NTOK / 64;
constexpr float LN_EPS = 1e-5f, RMS_EPS = 1e-6f;
constexpr float DN_ALPHA = 1.189207115002721f;
constexpr float LOG2E = 1.4426950408889634f;
constexpr float C2A = 0.10206207261596575f * LOG2E;
constexpr float C2B = 0.125f * LOG2E;
constexpr int NWAVES = 8, NTHREADS = 512;

constexpr size_t MiB = 1u << 20;
constexpr size_t WS_CTL = 0, CTL_ZERO_BYTES = 1 * MiB;
constexpr size_t WS_HIST = 1 * MiB;
constexpr size_t WS_TIDX = WS_HIST + 64 * 1024;
constexpr size_t WS_TGATE = WS_TIDX + 256 * 1024;
constexpr size_t WS_DEST = WS_TGATE + 256 * 1024;
constexpr size_t WS_ROWTOK = WS_DEST + 256 * 1024;
constexpr size_t WS_ROWGATE = WS_ROWTOK + 288 * 1024;
constexpr size_t WS_TILEE = WS_ROWGATE + 288 * 1024;
constexpr size_t WS_RSTD = WS_TILEE + 4 * 1024;
constexpr size_t WS_KMEAN = WS_RSTD + 128 * 1024;
constexpr size_t WS_WRL = WS_KMEAN + 128 * 1024;
static_assert(WS_WRL + 128 * 1024 <= 4 * MiB, "route region");
constexpr size_t WS_ROPEA = 4 * MiB;
constexpr size_t WS_ROPEB = 6 * MiB;
constexpr size_t WS_WIN = 8 * MiB;
constexpr size_t WS_WO = 12 * MiB;
constexpr size_t WS_WUP = 14 * MiB;
constexpr size_t WS_X1B = 16 * MiB;
constexpr size_t WS_WD = 48 * MiB;
constexpr size_t WS_XB = 112 * MiB;
constexpr size_t WS_PROJ = 144 * MiB;
constexpr size_t WS_QM = 208 * MiB;
constexpr size_t WS_KM = 232 * MiB;
constexpr size_t WS_VM = 256 * MiB;
constexpr size_t WS_QB = 272 * MiB;
constexpr size_t WS_KB = 288 * MiB;
constexpr size_t WS_ATT = 304 * MiB;
constexpr size_t WS_H = 112 * MiB;
constexpr size_t WS_WGU = 336 * MiB;
constexpr size_t WS_Y = 336 * MiB;
constexpr size_t WS_X1PRE = 144 * MiB;
constexpr size_t WS_END = 480 * MiB;
static_assert(WS_H + (size_t)MAXROWS * 1024 * 2 <= WS_VM + 0 * MiB + 0 && WS_Y + (size_t)MAXROWS * 1024 * 2 <= WS_END, "ws map");
constexpr int CW_BAR = 4096;

constexpr int LDS_BYTES = 147456;
constexpr int MISC_OFF = 131072 + 320;

__device__ __forceinline__ float bf2f(unsigned v) { return __uint_as_float(v << 16); }
__device__ __forceinline__ unsigned f2bf(float f) { unsigned u = __float_as_uint(f); return (u + 0x7fffu + ((u >> 16) & 1u)) >> 16; }
__device__ __forceinline__ unsigned pk2(float lo, float hi) { return f2bf(lo) | (f2bf(hi) << 16); }
__device__ __forceinline__ float wave_sum(float v) {
#pragma unroll
    for (int o = 1; o < 64; o <<= 1) v += __shfl_xor(v, o);
    return v;
}
__device__ __forceinline__ float wave_max(float v) {
#pragma unroll
    for (int o = 1; o < 64; o <<= 1) v = fmaxf(v, __shfl_xor(v, o));
    return v;
}

#define XB_TMO      128
#define XB_XCNT(j)  (256  + 64 * (j))
#define XB_XSUB(j)  (1280 + 64 * (j))
#define XB_XGEN(j)  (2304 + 64 * (j))
#define XB_TOP      3328
#define XB_TOPGEN   3392
#define XCD_BAR_WORDS 3456
#define XB_SPIN_CAP (1u << 18)
__device__ __forceinline__ unsigned xb_ld(unsigned* p)              { return __hip_atomic_load(p, __ATOMIC_RELAXED, __HIP_MEMORY_SCOPE_AGENT); }
__device__ __forceinline__ unsigned xb_add(unsigned* p, unsigned v) { return __hip_atomic_fetch_add(p, v, __ATOMIC_RELAXED, __HIP_MEMORY_SCOPE_AGENT); }
__device__ __forceinline__ unsigned xb_xcc_id() { return (unsigned)__builtin_amdgcn_s_getreg((3 << 11) | 20) & 0xFu; }
#define XB_SPIN(cond, bar) do { unsigned _sp = 0; while (cond) { __builtin_amdgcn_s_sleep(1); \
    if ((++_sp & 255u) == 0u) { if (xb_ld(&(bar)[XB_TMO])) break; if (_sp > XB_SPIN_CAP) { atomicAdd(&(bar)[XB_TMO], 1u); break; } } } } while (0)
struct XcdBarrier { unsigned* bar; unsigned x; volatile LAS unsigned* st; };
__device__ __forceinline__ XcdBarrier xcd_barrier_post(unsigned* bar, volatile LAS unsigned* st) {
    XcdBarrier b; b.bar = bar; b.x = xb_xcc_id(); b.st = st;
    if (threadIdx.x == 0) (void)xb_add(&bar[XB_XCNT(b.x)], 1u);
    return b;
}
__device__ __forceinline__ void xcd_barrier_complete(unsigned* bar, unsigned x, unsigned& nloc, unsigned& nx) {
    const unsigned G = gridDim.x * gridDim.y * gridDim.z;
    unsigned sum, cnt, mine, sp = 0u;
    for (;;) {
        sum = 0u; cnt = 0u; mine = 0u;
#pragma unroll
        for (unsigned j = 0; j < 16; ++j) { const unsigned c = xb_ld(&bar[XB_XCNT(j)]); sum += c; cnt += (c > 0u) ? 1u : 0u; mine = (j == x) ? c : mine; }
        if (sum == G) break;
        __builtin_amdgcn_s_sleep(1);
        if ((++sp & 255u) == 0u) { if (xb_ld(&bar[XB_TMO])) break; if (sp > XB_SPIN_CAP) { atomicAdd(&bar[XB_TMO], 1u); break; } }
    }
    nloc = mine > 0u ? mine : 1u; nx = cnt > 0u ? cnt : 1u;
}
__device__ __forceinline__ void xcd_barrier(const XcdBarrier& b) {
    asm volatile("s_waitcnt vmcnt(0)" ::: "memory");
    __syncthreads();
    if (threadIdx.x == 0) {
        unsigned* bar = b.bar;
        __builtin_amdgcn_s_waitcnt(0);
        unsigned nloc = b.st[0], nx = b.st[1];
        if (nloc == 0u) { xcd_barrier_complete(bar, b.x, nloc, nx); b.st[0] = nloc; b.st[1] = nx; }
        const unsigned old = xb_add(&bar[XB_XSUB(b.x)], 1u);
        const unsigned gen = old / nloc;
        if (old + 1u == (gen + 1u) * nloc) {
            __builtin_amdgcn_fence(__ATOMIC_RELEASE, "agent");
            asm volatile("s_waitcnt vmcnt(0)" ::: "memory");
            const unsigned og = xb_add(&bar[XB_TOP], 1u);
            const unsigned tg = og / nx;
            if (og + 1u == (tg + 1u) * nx) xb_add(&bar[XB_TOPGEN], 1u);
            else XB_SPIN(xb_ld(&bar[XB_TOPGEN]) == tg, bar);
            __builtin_amdgcn_fence(__ATOMIC_ACQUIRE, "agent");
            xb_add(&bar[XB_XGEN(b.x)], 1u);
            asm volatile("s_waitcnt vmcnt(0)" ::: "memory");
        } else {
            XB_SPIN(xb_ld(&bar[XB_XGEN(b.x)]) == gen, bar);
            __builtin_amdgcn_fence(__ATOMIC_ACQUIRE, "agent");
            asm volatile("s_waitcnt vmcnt(0)" ::: "memory");
        }
    }
    __syncthreads();
}

struct Params {
    const float* x; const int* pos;
    const float *w_in, *q_a_norm, *w_q_b, *kv_a_norm, *w_kv_b, *w_o, *ln1_g, *ln1_b, *w_router, *b_router;
    const float *w_gate, *b_gate, *w_up, *b_up, *w_down, *b_down, *ln2_g, *ln2_b;
    float* out; unsigned char* ws;
    double invfA[16]; double invfB[8];
    int ph_lo, ph_hi;
};

struct Unit { int pm, pn, e; };
struct GemmArgs { const bf16_t* A; int lda; const bf16_t* Bt; int ldb; int K; };
template <bool PERM> __device__ __forceinline__ int ecol(int bj, int n, int wc, int fq) { return 128 * bj + 32 * wc + (PERM ? 8 * fq + 4 * n : 16 * n + 4 * fq); }

template <class Epi, class Sched>
__device__ __forceinline__ void gemm_phase_naive(LAS unsigned char* lds, const GemmArgs g, const Sched& S, const Epi& E) {
    const int tid = threadIdx.x, wid = __builtin_amdgcn_readfirstlane(tid >> 6), lane = tid & 63, wr = wid >> 2, wc = wid & 3, fr = lane & 15, fq = lane >> 4;
    Unit u;
    for (int ui = 0; S.next(ui, u); ++ui) {
        f32x4 acc[2][2][4][2];
#pragma unroll
        for (int a = 0; a < 2; ++a)
#pragma unroll
            for (int b = 0; b < 2; ++b)
#pragma unroll
                for (int m = 0; m < 4; ++m)
#pragma unroll
                    for (int n = 0; n < 2; ++n) acc[a][b][m][n] = (f32x4){0.f, 0.f, 0.f, 0.f};
        unsigned aoff[2][4];
#pragma unroll
        for (int a = 0; a < 2; ++a)
#pragma unroll
            for (int m = 0; m < 4; ++m) aoff[a][m] = (unsigned)S.arow(u, ui, 128 * a + 64 * wr + 16 * m + fr) * (unsigned)g.lda;
        const bf16_t* bb = g.Bt + (size_t)(S.brow0(u) + 32 * wc) * g.ldb;
        const unsigned bl0 = (unsigned)(4 * fq) * (unsigned)g.ldb, bl1 = (unsigned)(8 * fq) * (unsigned)g.ldb;
#pragma unroll 1
        for (int k = 0; k < g.K; k += 2) {
            float af[2][4][2];
#pragma unroll
            for (int a = 0; a < 2; ++a)
#pragma unroll
                for (int m = 0; m < 4; ++m) { const unsigned v = *(const unsigned*)(g.A + aoff[a][m] + k); af[a][m][0] = __uint_as_float(v << 16); af[a][m][1] = __uint_as_float(v & 0xffff0000u); }
#pragma unroll
            for (int b = 0; b < 2; ++b)
#pragma unroll
                for (int n = 0; n < 2; ++n)
#pragma unroll
                    for (int j = 0; j < 4; ++j) {
                        const int ccol = 128 * b + (Epi::PERM ? 4 * n : 16 * n) + j;
                        const unsigned v = *(const unsigned*)(bb + (size_t)ccol * g.ldb + ((Epi::PERM ? bl1 : bl0) + (unsigned)k));
                        const float b0 = __uint_as_float(v << 16), b1 = __uint_as_float(v & 0xffff0000u);
#pragma unroll
                        for (int a = 0; a < 2; ++a)
#pragma unroll
                            for (int m = 0; m < 4; ++m) acc[a][b][m][n][j] = fmaf(af[a][m][1], b1, fmaf(af[a][m][0], b0, acc[a][b][m][n][j]));
                    }
        }
        E(acc, u, wr, wc, fr, fq);
    }
}

namespace pg {
constexpr int BK = 64, HALF = 128, HTB = HALF * BK * 2;
__device__ __forceinline__ int lds_byte(int r, int c) { const int st = (r >> 4) * 2 + (c >> 5), rr = r & 15, cc = c & 31, ob = rr * 64 + cc * 2; return st * 1024 + (ob ^ (((ob >> 9) & 1) << 5)); }
__device__ __forceinline__ void stage_rc(int b, int& R, int& C) { const int st = b / 1024, sb = b % 1024, swz = sb ^ (((sb >> 9) & 1) << 5); R = (st >> 1) * 16 + swz / 64; C = (st & 1) * 32 + (swz % 64) / 2; }
__device__ __forceinline__ int perm32(int rho) { const int n = rho >> 4, i = rho & 15; return 8 * (i >> 2) + 4 * n + (i & 3); }
}
template <class Epi, class Sched, bool ALIGN_EPI>
__device__ __forceinline__ void gemm_phase(LAS unsigned char* lds, const GemmArgs g, const Sched& S, const Epi& E) {
    using namespace pg;
    const int tid = threadIdx.x, wid = __builtin_amdgcn_readfirstlane(tid >> 6), lane = tid & 63, wr = wid >> 2, wc = wid & 3, fr = lane & 15, fq = lane >> 4;
    const int nt = g.K / BK;
    int sR[2], sC[2], sRb[2];
#pragma unroll
    for (int i = 0; i < 2; ++i) { int R, C; stage_rc(tid * 16 + i * 8192, R, C); sR[i] = R; sC[i] = C; sRb[i] = Epi::PERM ? ((R & ~31) + perm32(R & 31)) : R; }
    const unsigned ldsw = (unsigned)wid * 1024u;
    const int aoff = lds_byte(wr * 64 + fr, fq * 8), boff = lds_byte(wc * 32 + fr, fq * 8);
    const char* Ab = (const char*)g.A; const char* Bb = (const char*)g.Bt;
#define PG_SA(b, h) (((b) * 2 + (h)) * HTB)
#define PG_SB(b, h) ((4 + (b) * 2 + (h)) * HTB)
#define PG_STAGE(bufoff, gptr, v0, v1) do { \
        __builtin_amdgcn_global_load_lds((const unsigned*)((gptr) + (v0)), (LAS unsigned*)(lds + (bufoff) + ldsw), 16, 0, 0); \
        __builtin_amdgcn_global_load_lds((const unsigned*)((gptr) + (v1)), (LAS unsigned*)(lds + (bufoff) + ldsw + 8192), 16, 0, 0); } while (0)
#define PG_LDA(dst, b, h) do { _Pragma("unroll") for (int m = 0; m < 4; ++m) _Pragma("unroll") for (int k = 0; k < 2; ++k) dst[m][k] = *(const LAS bf16x8*)(lds + PG_SA(b, h) + aoff + m * 2048 + k * 1024); } while (0)
#define PG_LDB(dst, b, h) do { _Pragma("unroll") for (int n = 0; n < 2; ++n) _Pragma("unroll") for (int k = 0; k < 2; ++k) dst[n][k] = *(const LAS bf16x8*)(lds + PG_SB(b, h) + boff + n * 2048 + k * 1024); } while (0)
#define PG_MMA(ai, bj, At, Bt) do { __builtin_amdgcn_s_setprio(1); _Pragma("unroll") for (int m = 0; m < 4; ++m) _Pragma("unroll") for (int n = 0; n < 2; ++n) _Pragma("unroll") for (int k = 0; k < 2; ++k) \
        acc[ai][bj][m][n] = __builtin_amdgcn_mfma_f32_16x16x32_bf16(Bt[n][k], At[m][k], acc[ai][bj][m][n], 0, 0, 0); __builtin_amdgcn_s_setprio(0); } while (0)
#define PG_WAIT_V(n) asm volatile("s_waitcnt vmcnt(" #n ")" ::: "memory")
#define PG_WAIT_L(n) asm volatile("s_waitcnt lgkmcnt(" #n ")" ::: "memory")
#define PG_BAR __builtin_amdgcn_s_barrier()
#define PG_SCHED __builtin_amdgcn_sched_barrier(0)
    constexpr bool GA = Sched::GATHER;
    unsigned cA[2], cB[2];
#pragma unroll
    for (int i = 0; i < 2; ++i) { cA[i] = ((unsigned)sR[i] * (unsigned)g.lda + (unsigned)sC[i]) * 2u; cB[i] = ((unsigned)sRb[i] * (unsigned)g.ldb + (unsigned)sC[i]) * 2u; }
    const size_t hA = (size_t)128 * g.lda * 2, hB = (size_t)128 * g.ldb * 2;
#define PG_GOFFS(u, uidx, VA) do { if constexpr (GA) { _Pragma("unroll") for (int h = 0; h < 2; ++h) _Pragma("unroll") for (int i = 0; i < 2; ++i) \
        VA[h][i] = ((unsigned)S.arow(u, uidx, 128 * h + sR[i]) * (unsigned)g.lda + (unsigned)sC[i]) * 2u; } } while (0)
#define PG_UA(u) (GA ? (size_t)0 : (size_t)S.arow(u, 0, 0) * g.lda * 2)
#define PG_UB(u) ((size_t)S.brow0(u) * g.ldb * 2)
#define PG_STAGE_A(bufoff, ab, VA, h) do { if constexpr (GA) { PG_STAGE(bufoff, (ab), VA[h][0], VA[h][1]); } else { PG_STAGE(bufoff, (ab) + (h) * hA, cA[0], cA[1]); } } while (0)
#define PG_STAGE_B(bufoff, bb, h) PG_STAGE(bufoff, (bb) + (h) * hB, cB[0], cB[1])
    Unit cur, nxt; int ui = 0;
    if (!S.next(0, cur)) return;
    f32x4 acc[2][2][4][2];
#pragma unroll
    for (int a = 0; a < 2; ++a)
#pragma unroll
        for (int b = 0; b < 2; ++b)
#pragma unroll
            for (int m = 0; m < 4; ++m)
#pragma unroll
                for (int n = 0; n < 2; ++n) acc[a][b][m][n] = (f32x4){0.f, 0.f, 0.f, 0.f};
    bf16x8 At[4][2], B0[2][2], B1[2][2];
    unsigned vA[2][2], nvA[2][2];
    PG_GOFFS(cur, 0, vA);
    const char* cAp = Ab + PG_UA(cur); const char* cBp = Bb + PG_UB(cur);
    PG_STAGE_B(PG_SB(0, 0), cBp, 0); PG_STAGE_B(PG_SB(0, 1), cBp, 1); PG_STAGE_A(PG_SA(0, 0), cAp, vA, 0); PG_STAGE_A(PG_SA(0, 1), cAp, vA, 1);
    if (wr == 1) PG_BAR;
    PG_WAIT_V(2); PG_BAR;
    PG_STAGE_B(PG_SB(1, 0), cBp + 128, 0); PG_STAGE_A(PG_SA(1, 0), cAp + 128, vA, 0); PG_STAGE_B(PG_SB(1, 1), cBp + 128, 1);
    PG_WAIT_V(6); PG_BAR;
    for (;;) {
        const bool has_next = S.next(ui + 1, nxt);
        const char* nAp = cAp; const char* nBp = cBp;
        if (has_next) { PG_GOFFS(nxt, ui + 1, nvA); nAp = Ab + PG_UA(nxt); nBp = Bb + PG_UB(nxt); }
        else { if constexpr (GA) {
#pragma unroll
            for (int h = 0; h < 2; ++h)
#pragma unroll
                for (int i = 0; i < 2; ++i) nvA[h][i] = vA[h][i]; } }
#pragma unroll 1
        for (int t = 0; t < nt; t += 2) {
            const bool last = (t == nt - 2);
            const char* a1 = cAp + (size_t)(t + 1) * 128;
            const char* a2 = last ? nAp : cAp + (size_t)(t + 2) * 128; const char* b2 = last ? nBp : cBp + (size_t)(t + 2) * 128;
            const char* a3 = a2 + 128; const char* b3 = b2 + 128;
            unsigned wA[2][2];
            if constexpr (GA) {
#pragma unroll
                for (int h = 0; h < 2; ++h)
#pragma unroll
                    for (int i = 0; i < 2; ++i) wA[h][i] = last ? nvA[h][i] : vA[h][i]; }
            PG_LDB(B0, 0, 0); PG_LDB(B1, 0, 1); PG_SCHED; PG_LDA(At, 0, 0); PG_STAGE_A(PG_SA(1, 1), a1, vA, 1);
            PG_WAIT_V(8); PG_WAIT_L(0); PG_BAR; PG_MMA(0, 0, At, B0); PG_MMA(0, 1, At, B1); PG_BAR; PG_SCHED;
            PG_LDA(At, 0, 1); PG_STAGE_B(PG_SB(0, 0), b2, 0); PG_STAGE_B(PG_SB(0, 1), b2, 1); PG_STAGE_A(PG_SA(0, 0), a2, wA, 0);
            PG_WAIT_V(8); PG_WAIT_L(0); PG_BAR; PG_MMA(1, 0, At, B0); PG_MMA(1, 1, At, B1); PG_BAR; PG_SCHED;
            PG_LDB(B0, 1, 0); PG_LDB(B1, 1, 1); PG_SCHED; PG_LDA(At, 1, 0); PG_STAGE_A(PG_SA(0, 1), a2, wA, 1);
            PG_WAIT_V(8); PG_WAIT_L(0); PG_BAR; PG_MMA(0, 0, At, B0); PG_MMA(0, 1, At, B1); PG_BAR; PG_SCHED;
            PG_LDA(At, 1, 1); PG_STAGE_B(PG_SB(1, 0), b3, 0); PG_STAGE_B(PG_SB(1, 1), b3, 1); PG_STAGE_A(PG_SA(1, 0), a3, wA, 0);
            PG_WAIT_V(8); PG_WAIT_L(0); PG_BAR; PG_MMA(1, 0, At, B0); PG_MMA(1, 1, At, B1); PG_BAR; PG_SCHED;
        }
        if constexpr (ALIGN_EPI) { if (wr == 0) PG_BAR; }
        E(acc, cur, wr, wc, fr, fq);
        if (!has_next) break;
#pragma unroll
        for (int a = 0; a < 2; ++a)
#pragma unroll
            for (int b = 0; b < 2; ++b)
#pragma unroll
                for (int m = 0; m < 4; ++m)
#pragma unroll
                    for (int n = 0; n < 2; ++n) acc[a][b][m][n] = (f32x4){0.f, 0.f, 0.f, 0.f};
        cur = nxt; ++ui; cAp = nAp; cBp = nBp;
        if constexpr (GA) {
#pragma unroll
            for (int h = 0; h < 2; ++h)
#pragma unroll
                for (int i = 0; i < 2; ++i) vA[h][i] = nvA[h][i]; }
        if constexpr (ALIGN_EPI) { if (wr == 1) PG_BAR; }
    }
    PG_WAIT_V(0);
    if constexpr (!ALIGN_EPI) { if (wr == 0) PG_BAR; }
    PG_BAR;
#undef PG_SA
#undef PG_SB
#undef PG_STAGE
#undef PG_LDA
#undef PG_LDB
#undef PG_MMA
#undef PG_WAIT_V
#undef PG_WAIT_L
#undef PG_BAR
#undef PG_SCHED
#undef PG_GOFFS
#undef PG_UA
#undef PG_UB
#undef PG_STAGE_A
#undef PG_STAGE_B
}

constexpr int ROWTAB_OFF = 132096, ETAB_OFF = ROWTAB_OFF + 12 * 1024, MAXU = 12;
struct DenseSched {
    static constexpr bool GATHER = false;
    int nN, nunits, G, c;
    __device__ __forceinline__ void init(LAS unsigned char*, int M, int N, int G_, int c_) { nN = N / 256; nunits = (M / 256) * nN; G = G_; c = c_; }
    __device__ __forceinline__ bool next(int i, Unit& u) const { const int L = i * G + c; if (L >= nunits) return false; u.pm = L / nN; u.pn = L % nN; u.e = 0; return true; }
    __device__ __forceinline__ int arow(const Unit& u, int, int r) const { return 256 * u.pm + r; }
    __device__ __forceinline__ int brow0(const Unit& u) const { return 256 * u.pn; }
};
template <bool GATHER_> struct GroupSched {
    static constexpr bool GATHER = GATHER_;
    LAS int* rowtab; LAS int* etab; int nN, nexp_rows, nunits, G, c;
    __device__ __forceinline__ void init(LAS unsigned char* lds, const int* te, const int* rt, int nN_, int nexp_rows_, int G_, int c_) {
        rowtab = (LAS int*)(lds + ROWTAB_OFF); etab = (LAS int*)(lds + ETAB_OFF); nN = nN_; nexp_rows = nexp_rows_; G = G_; c = c_;
        nunits = __builtin_amdgcn_readfirstlane(te[MAXTILES]) * nN_;
        for (int i = 0; i < MAXU; ++i) { const int L = i * G + c; if (L >= nunits) break; const int pm = L / nN;
            if (threadIdx.x == 0) etab[i] = te[pm];
            if (GATHER && threadIdx.x < 256) rowtab[i * 256 + threadIdx.x] = rt[256 * pm + threadIdx.x]; }
        __syncthreads();
    }
    __device__ __forceinline__ bool next(int i, Unit& u) const { const int L = i * G + c; if (L >= nunits || i >= MAXU) return false; u.pm = L / nN; u.pn = L % nN; u.e = etab[i]; return true; }
    __device__ __forceinline__ int arow(const Unit& u, int ui, int r) const { return GATHER ? rowtab[ui * 256 + r] : 256 * u.pm + r; }
    __device__ __forceinline__ int brow0(const Unit& u) const { return u.e * nexp_rows + 256 * u.pn; }
};

struct EpiProj {
    static constexpr bool PERM = false;
    bf16_t* O;
    __device__ __forceinline__ void operator()(const f32x4 (&acc)[2][2][4][2], const Unit& u, int wr, int wc, int fr, int fq) const {
        asm volatile("" : "+v"(fr), "+v"(fq));
#pragma unroll
        for (int a = 0; a < 2; ++a)
#pragma unroll
            for (int m = 0; m < 4; ++m) { const int row = 256 * u.pm + 128 * a + 64 * wr + 16 * m + fr;
#pragma unroll
                for (int b = 0; b < 2; ++b)
#pragma unroll
                    for (int n = 0; n < 2; ++n) { const int col = 256 * u.pn + ecol<PERM>(b, n, wc, fq); const f32x4 v = acc[a][b][m][n];
                        u32x2 w; w.x = pk2(v[0], v[1]); w.y = pk2(v[2], v[3]); *(u32x2*)(O + (size_t)row * PN + col) = w; } }
    }
};
struct EpiUp {
    static constexpr bool PERM = false;
    bf16_t *QM, *KM, *VM; const float* rstd; const float* ropeA;
    __device__ __forceinline__ void operator()(const f32x4 (&acc)[2][2][4][2], const Unit& u, int wr, int wc, int fr, int fq) const {
        asm volatile("" : "+v"(fr), "+v"(fq));
#pragma unroll
        for (int a = 0; a < 2; ++a)
#pragma unroll
            for (int m = 0; m < 4; ++m) { const int row = 256 * u.pm + 128 * a + 64 * wr + 16 * m + fr;
                const float rq = rstd[2 * row] * C2A, rkv = rstd[2 * row + 1];
#pragma unroll
                for (int b = 0; b < 2; ++b) {
                    const int gidx = 8 * u.pn + 4 * b + wc;
                    if (gidx < 24) {
                        const int h = gidx / 3, part = gidx % 3;
                        f32x4 v0 = acc[a][b][m][0] * rq, v1 = acc[a][b][m][1] * rq;
                        if (part == 2) { const f32x4 c = *(const f32x4*)(ropeA + (size_t)row * 32 + 4 * fq), s = *(const f32x4*)(ropeA + (size_t)row * 32 + 16 + 4 * fq);
                            const f32x4 o0 = v0 * c - v1 * s, o1 = v1 * c + v0 * s; v0 = o0; v1 = o1; }
                        bf16_t* p = QM + (size_t)row * 768 + h * 96 + part * 32 + 4 * fq;
                        u32x2 w; w.x = pk2(v0[0], v0[1]); w.y = pk2(v0[2], v0[3]); *(u32x2*)p = w;
                        w.x = pk2(v1[0], v1[1]); w.y = pk2(v1[2], v1[3]); *(u32x2*)(p + 16) = w;
                    } else {
                        const int g2 = gidx - 24, h = g2 >> 2, part = g2 & 3;
                        const f32x4 v0 = acc[a][b][m][0] * rkv, v1 = acc[a][b][m][1] * rkv;
                        bf16_t* p = (part < 2) ? (KM + (size_t)row * 768 + h * 96 + part * 32 + 4 * fq) : (VM + (size_t)row * 512 + h * 64 + (part - 2) * 32 + 4 * fq);
                        u32x2 w; w.x = pk2(v0[0], v0[1]); w.y = pk2(v0[2], v0[3]); *(u32x2*)p = w;
                        w.x = pk2(v1[0], v1[1]); w.y = pk2(v1[2], v1[3]); *(u32x2*)(p + 16) = w;
                    }
                }
                asm volatile("" ::: "memory"); }
    }
};
struct EpiWo {
    static constexpr bool PERM = false;
    const float* x; float* O;
    __device__ __forceinline__ void operator()(const f32x4 (&acc)[2][2][4][2], const Unit& u, int wr, int wc, int fr, int fq) const {
        asm volatile("" : "+v"(fr), "+v"(fq));
#pragma unroll
        for (int a = 0; a < 2; ++a)
#pragma unroll
            for (int m = 0; m < 4; ++m) { const int row = 256 * u.pm + 128 * a + 64 * wr + 16 * m + fr;
#pragma unroll
                for (int b = 0; b < 2; ++b)
#pragma unroll
                    for (int n = 0; n < 2; ++n) { const size_t off = (size_t)row * DM + 256 * u.pn + ecol<PERM>(b, n, wc, fq);
                        const f32x4 xv = *(const f32x4*)(x + off); *(f32x4*)(O + off) = xv * DN_ALPHA + acc[a][b][m][n]; } }
    }
};
struct EpiGateUp {
    static constexpr bool PERM = false;
    bf16_t* H; const float *bg, *bu;
    __device__ __forceinline__ void operator()(const f32x4 (&acc)[2][2][4][2], const Unit& u, int wr, int wc, int fr, int fq) const {
        asm volatile("" : "+v"(fr), "+v"(fq));
#pragma unroll
        for (int n = 0; n < 2; ++n) { const int hc = 128 * u.pn + 32 * wc + 16 * n + 4 * fq;
            const f32x4 vbg = *(const f32x4*)(bg + (size_t)u.e * 1024 + hc), vbu = *(const f32x4*)(bu + (size_t)u.e * 1024 + hc);
#pragma unroll
            for (int a = 0; a < 2; ++a)
#pragma unroll
                for (int m = 0; m < 4; ++m) { const int row = 256 * u.pm + 128 * a + 64 * wr + 16 * m + fr;
                    const f32x4 gv = acc[a][0][m][n] + vbg, uv = acc[a][1][m][n] + vbu; float hv[4];
#pragma unroll
                    for (int j = 0; j < 4; ++j) { const float gg = fminf(gv[j], 7.0f), uu = fminf(fmaxf(uv[j], -7.0f), 7.0f);
                        const float sg = 1.0f / (1.0f + __builtin_amdgcn_exp2f(-1.702f * LOG2E * gg)); hv[j] = gg * sg * (uu + 1.0f); }
                    u32x2 w; w.x = pk2(hv[0], hv[1]); w.y = pk2(hv[2], hv[3]); *(u32x2*)(H + (size_t)row * 1024 + hc) = w; } }
    }
};
struct EpiDown {
    static constexpr bool PERM = false;
    bf16_t* Y; const float* bd; const float* row_gate;
    __device__ __forceinline__ void operator()(const f32x4 (&acc)[2][2][4][2], const Unit& u, int wr, int wc, int fr, int fq) const {
        asm volatile("" : "+v"(fr), "+v"(fq));
#pragma unroll
        for (int a = 0; a < 2; ++a)
#pragma unroll
            for (int m = 0; m < 4; ++m) { const int row = 256 * u.pm + 128 * a + 64 * wr + 16 * m + fr; const float gw = row_gate[row];
#pragma unroll
                for (int b = 0; b < 2; ++b)
#pragma unroll
                    for (int n = 0; n < 2; ++n) { const int col = 256 * u.pn + ecol<PERM>(b, n, wc, fq); const f32x4 bv = *(const f32x4*)(bd + (size_t)u.e * 1024 + col);
                        const f32x4 v = (acc[a][b][m][n] + bv) * gw; u32x2 w; w.x = pk2(v[0], v[1]); w.y = pk2(v[2], v[3]); *(u32x2*)(Y + (size_t)row * 1024 + col) = w; } }
    }
};

__device__ __forceinline__ unsigned cvtpk_hw(float lo, float hi) { typedef __bf16 bf2 __attribute__((ext_vector_type(2))); f32x2 v = {lo, hi}; bf2 b = __builtin_convertvector(v, bf2); return __builtin_bit_cast(unsigned, b); }
__device__ __forceinline__ void conv_issue(const float* W, int ldw, int k0, int n0, LAS unsigned char* scr, int lane) {
#pragma unroll
    for (int i = 0; i < 4; ++i) __builtin_amdgcn_global_load_lds((const unsigned*)(W + (size_t)(k0 + 4 * (lane >> 3) + i) * ldw + n0 + 4 * (lane & 7)), (LAS unsigned*)(scr + i * 1024), 16, 0, 2);
}
__device__ __forceinline__ void conv_finish(bf16_t* WT, int ldt, int orow0, int ocol0, const LAS unsigned char* scr, int lane) {
    f32x4 r[4];
#pragma unroll
    for (int i = 0; i < 4; ++i) r[i] = *(const LAS f32x4*)(scr + i * 1024 + lane * 16);
#pragma unroll
    for (int j = 0; j < 4; ++j) { u32x2 o; o.x = cvtpk_hw(r[0][j], r[1][j]); o.y = cvtpk_hw(r[2][j], r[3][j]);
        __builtin_nontemporal_store(o, (u32x2*)(WT + (size_t)(orow0 + 4 * (lane & 7) + j) * ldt + ocol0 + 4 * (lane >> 3))); }
}
constexpr int NEXP_ITEMS = 3 * NE * 1024;
__device__ __forceinline__ void expert_issue(const Params& p, int r, LAS unsigned char* scr, int lane) {
    const int mat = r >> 15, rr = r & 32767, e = rr >> 10, q = rr & 1023, kb = q >> 5, nb = q & 31;
    const float* W = (mat == 0 ? p.w_gate : mat == 1 ? p.w_up : p.w_down) + (size_t)e * 1048576;
    conv_issue(W, 1024, 32 * kb, 32 * nb, scr, lane);
}
__device__ __forceinline__ void expert_finish(const Params& p, int r, const LAS unsigned char* scr, int lane) {
    const int mat = r >> 15, rr = r & 32767, e = rr >> 10, q = rr & 1023, kb = q >> 5, nb = q & 31, n0 = 32 * nb;
    bf16_t* WguT = (bf16_t*)(p.ws + WS_WGU); bf16_t* WdT = (bf16_t*)(p.ws + WS_WD);
    if (mat == 2) conv_finish(WdT, 1024, e * 1024 + n0, 32 * kb, scr, lane);
    else conv_finish(WguT, 1024, e * 2048 + (n0 >> 7) * 256 + (mat == 1 ? 128 : 0) + (n0 & 127), 32 * kb, scr, lane);
}
struct BgConv { int next, stride, pend0, pend1, itc; };

__device__ __forceinline__ void tr_item(const float* W, int ldw, int k0, int n0, bf16_t* WT, int ldt, int orow0, int ocol0, const float* kscale, LAS float* scr, int lane) {
#pragma unroll 8
    for (int i = 0; i < 32; ++i) { const int kk = 2 * i + (lane >> 5); float v = W[(size_t)(k0 + kk) * ldw + n0 + (lane & 31)]; if (kscale) v *= kscale[k0 + kk]; scr[kk * 33 + (lane & 31)] = v; }
    asm volatile("s_waitcnt lgkmcnt(0)" ::: "memory");
    const int c = lane & 7;
#pragma unroll
    for (int j = 0; j < 4; ++j) { const int n = (lane >> 3) + 8 * j; const LAS float* s = scr + (8 * c) * 33 + n;
        u32x4 o; o.x = pk2(s[0 * 33], s[1 * 33]); o.y = pk2(s[2 * 33], s[3 * 33]); o.z = pk2(s[4 * 33], s[5 * 33]); o.w = pk2(s[6 * 33], s[7 * 33]);
        *(u32x4*)(WT + (size_t)(orow0 + n) * ldt + ocol0 + 8 * c) = o; }
    asm volatile("s_waitcnt lgkmcnt(0)" ::: "memory");
}
__device__ __forceinline__ void phase_prologue(const Params& p, LAS unsigned char* lds, int vcu, int G) {
    const int tid = threadIdx.x, wave = tid >> 6, lane = tid & 63;
    unsigned char* ws = p.ws;
    LAS float* scr = (LAS float*)(lds + wave * 16384);
    const int gw = vcu * NWAVES + wave, NGW = G * NWAVES;
    bf16_t* WinT = (bf16_t*)(ws + WS_WIN); bf16_t* WoT = (bf16_t*)(ws + WS_WO); bf16_t* WupT = (bf16_t*)(ws + WS_WUP);
    constexpr int I_IN = 16 * 61, I_QB = 4 * 24, I_KVB = 2 * 32, I_O = 16 * 32;
    constexpr int NITEMS = I_IN + I_QB + I_KVB + I_O;
    for (int it = gw; it < NITEMS; it += NGW) {
        int r = it;
        if (r < I_IN) { const int kb = r / 61, nb = r % 61; tr_item(p.w_in, IN_COLS, 64 * kb, 32 * nb, WinT, 1024, 32 * nb, 64 * kb, nullptr, scr, lane); continue; } r -= I_IN;
        if (r < I_QB) { const int kb = r / 24, nb = r % 24; tr_item(p.w_q_b, 768, 64 * kb, 32 * nb, WupT, KUP, 32 * nb, 64 * kb, p.q_a_norm, scr, lane); continue; } r -= I_QB;
        if (r < I_KVB) { const int kb = r / 32, nb = r % 32; tr_item(p.w_kv_b, 1024, 64 * kb, 32 * nb, WupT, KUP, 768 + 32 * nb, 256 + 64 * kb, p.kv_a_norm, scr, lane); continue; } r -= I_KVB;
        { const int kb = r / 32, nb = r % 32; tr_item(p.w_o, 1024, 64 * kb, 32 * nb, WoT, 1024, 32 * nb, 64 * kb, nullptr, scr, lane); }
    }
    const int gt = vcu * NTHREADS + tid, NGT = G * NTHREADS;
    for (int i = gt; i < 96 * 128; i += NGT) *(u32x4*)(WinT + (size_t)IN_COLS * 1024 + (size_t)i * 8) = (u32x4){0u, 0u, 0u, 0u};
    for (int i = gt; i < 768 * 16; i += NGT) { const int r = i / 16, c = i % 16; *(u32x4*)(WupT + (size_t)r * KUP + 256 + c * 8) = (u32x4){0u, 0u, 0u, 0u}; }
    for (int i = gt; i < 1024 * 32; i += NGT) { const int r = i / 32, c = i % 32; *(u32x4*)(WupT + (size_t)(768 + r) * KUP + c * 8) = (u32x4){0u, 0u, 0u, 0u}; }
    bf16_t* XB = (bf16_t*)(ws + WS_XB);
    for (int i = gt; i < NTOK * DM / 8; i += NGT) { const f32x4 a = *(const f32x4*)(p.x + (size_t)i * 8), b = *(const f32x4*)(p.x + (size_t)i * 8 + 4);
        u32x4 o; o.x = pk2(a[0], a[1]); o.y = pk2(a[2], a[3]); o.z = pk2(b[0], b[1]); o.w = pk2(b[2], b[3]); *(u32x4*)(XB + (size_t)i * 8) = o; }
    { float* WRL = (float*)(ws + WS_WRL);
      for (int n = gt; n < 32768; n += NGT) { const int ln = n & 63, q = n >> 6, e = q & 31, ji = q >> 5, j = ji >> 2, i = ji & 3; WRL[n] = p.w_router[(size_t)(4 * ln + 256 * j + i) * 32 + e]; } }
    float* ropeA = (float*)(ws + WS_ROPEA); float* ropeB = (float*)(ws + WS_ROPEB);
    for (int i = gt; i < NTOK * 24; i += NGT) { const int tok = i / 24, j = i % 24; const double f = (j < 16) ? p.invfA[j] : p.invfB[j - 16];
        const double rev = (double)p.pos[tok] * f * 0.15915494309189535; const float fr = (float)(rev - __builtin_rint(rev));
        const float cs = __builtin_amdgcn_cosf(fr), sn = __builtin_amdgcn_sinf(fr);
        if (j < 16) { ropeA[(size_t)tok * 32 + j] = cs; ropeA[(size_t)tok * 32 + 16 + j] = sn; } else { ropeB[(size_t)tok * 16 + (j - 16)] = cs; ropeB[(size_t)tok * 16 + 8 + (j - 16)] = sn; } }
}

__device__ __forceinline__ void phase_prep(const Params& p, LAS unsigned char* lds, int vcu, int G) {
    const int tid = threadIdx.x, wave = tid >> 6, lane = tid & 63;
    unsigned char* ws = p.ws;
    const bf16_t* PROJ = (const bf16_t*)(ws + WS_PROJ);
    float* rstd = (float*)(ws + WS_RSTD); const float* ropeA = (const float*)(ws + WS_ROPEA); const float* ropeB = (const float*)(ws + WS_ROPEB);
    bf16_t* KM = (bf16_t*)(ws + WS_KM); bf16_t* QB = (bf16_t*)(ws + WS_QB); bf16_t* KB = (bf16_t*)(ws + WS_KB); float* kmean = (float*)(ws + WS_KMEAN);
    const int gw = vcu * NWAVES + wave, NGW = G * NWAVES;
    for (int row = gw; row < NTOK; row += NGW) {
        float s = 0.f;
        if (lane < 48) { const u32x4 v = *(const u32x4*)(PROJ + (size_t)row * PN + lane * 8);
#pragma unroll
            for (int q = 0; q < 4; ++q) { const float a = __uint_as_float(v[q] << 16), b = __uint_as_float(v[q] & 0xffff0000u); s += a * a + b * b; } }
#pragma unroll
        for (int o = 1; o < 32; o <<= 1) s += __shfl_xor(s, o);
        if (lane == 0) rstd[2 * row] = 1.0f / sqrtf(s * (1.0f / 256.0f) + RMS_EPS);
        if (lane == 32) rstd[2 * row + 1] = 1.0f / sqrtf(s * (1.0f / 128.0f) + RMS_EPS);
    }
    const int gt = vcu * NTHREADS + tid, NGT = G * NTHREADS;
    for (int i = gt; i < NTOK * 16; i += NGT) { const int tok = i >> 4, j = i & 15;
        const float x1 = bf2f(PROJ[(size_t)tok * PN + C_KR + j]), x2 = bf2f(PROJ[(size_t)tok * PN + C_KR + 16 + j]);
        const float c = ropeA[(size_t)tok * 32 + j], s = ropeA[(size_t)tok * 32 + 16 + j];
        const bf16_t o1 = (bf16_t)f2bf(x1 * c - x2 * s), o2 = (bf16_t)f2bf(x2 * c + x1 * s);
#pragma unroll
        for (int h = 0; h < 8; ++h) { KM[(size_t)tok * 768 + h * 96 + 64 + j] = o1; KM[(size_t)tok * 768 + h * 96 + 80 + j] = o2; } }
    LAS float* red = (LAS float*)lds;
    for (int unit = vcu; unit < 512; unit += G) {
        const int ub = unit >> 3, h = unit & 7, tg = tid >> 6, d = tid & 63, c = h * 64 + d; float ksum = 0.f;
#pragma unroll 4
        for (int i = 0; i < 32; ++i) { const int tok = ub * 256 + tg * 32 + i; const bf16_t* pr = PROJ + (size_t)tok * PN;
            float qv = bf2f(pr[C_MQ + c]), kv = bf2f(pr[C_MK + c]);
            if (d < 16) { const int j = d & 7; const float cs = ropeB[(size_t)tok * 16 + j], sn = ropeB[(size_t)tok * 16 + 8 + j];
                if (d < 8) { const float q2 = bf2f(pr[C_MQ + c + 8]), k2 = bf2f(pr[C_MK + c + 8]); qv = qv * cs - q2 * sn; kv = kv * cs - k2 * sn; }
                else { const float q1 = bf2f(pr[C_MQ + c - 8]), k1 = bf2f(pr[C_MK + c - 8]); qv = qv * cs + q1 * sn; kv = kv * cs + k1 * sn; } }
            QB[(size_t)tok * 512 + c] = (bf16_t)f2bf(qv * C2B); KB[(size_t)tok * 512 + c] = (bf16_t)f2bf(kv); ksum += kv; }
        red[tg * 64 + d] = ksum;
        __syncthreads();
        if (tid < 64) { float t = 0.f;
#pragma unroll
            for (int g8 = 0; g8 < 8; ++g8) t += red[g8 * 64 + tid];
            kmean[(size_t)ub * 512 + h * 64 + tid] = t * (1.0f / 256.0f); }
        __syncthreads();
    }
}

typedef float f32x16 __attribute__((ext_vector_type(16)));
typedef short s16x4 __attribute__((ext_vector_type(4)));
namespace fa {
constexpr int KBUF = 12288, VBUF = 8192, BUF = KBUF + VBUF, WS_OFF = 2 * BUF, LDS_NEED = WS_OFF + 8 * 256;
constexpr float THR = 8.0f;
__device__ __forceinline__ int crow(int r, int hi) { return (r & 3) + 8 * (r >> 2) + 4 * hi; }
__device__ __forceinline__ unsigned cvtpk(float lo, float hi) { typedef __bf16 bf2 __attribute__((ext_vector_type(2))); f32x2 v = {lo, hi}; bf2 b = __builtin_convertvector(v, bf2); return __builtin_bit_cast(unsigned, b); }
__device__ __forceinline__ float xhalf_max(float m) { auto rr = __builtin_amdgcn_permlane32_swap(__float_as_uint(m), __float_as_uint(m), false, false); return fmaxf(__uint_as_float(rr[0]), __uint_as_float(rr[1])); }
__device__ __forceinline__ float xhalf_sum(float m) { auto rr = __builtin_amdgcn_permlane32_swap(__float_as_uint(m), __float_as_uint(m), false, false); return __uint_as_float(rr[0]) + __uint_as_float(rr[1]); }
}
template <int DQK>
__device__ __forceinline__ void attn_unit(LAS unsigned char* lds, const bf16_t* Q, int qpitch, const bf16_t* K, int kpitch, const bf16_t* V, int vpitch, bf16_t* O, int qb, const float* kmean, const Params& p, BgConv& bg) {
    using namespace fa;
    constexpr int ND = DQK / 16, NCH = DQK / 8;
    const int tid = threadIdx.x, lane = tid & 63, r32 = lane & 31, hi = lane >> 5, wid = __builtin_amdgcn_readfirstlane(tid >> 6);
    const int q0 = qb * 256, qrel = wid * 32 + r32;
    LAS float* wsf = (LAS float*)(lds + WS_OFF) + wid * 64;
    bf16x8 qr[ND];
#pragma unroll
    for (int d0 = 0; d0 < ND; ++d0) qr[d0] = *(const bf16x8*)(Q + (size_t)(q0 + qrel) * qpitch + d0 * 16 + hi * 8);
    unsigned sel = 0xffu;
    if (kmean) {
        float gt[8];
#pragma unroll
        for (int n = 0; n < 8; ++n) gt[n] = -INFINITY;
#pragma unroll 1
        for (int n = 0; n < qb; ++n) { float s = 0.f; const float* km = kmean + (size_t)n * 512;
#pragma unroll
            for (int d0 = 0; d0 < ND; ++d0) { const f32x4 k0 = *(const f32x4*)(km + d0 * 16 + hi * 8), k1 = *(const f32x4*)(km + d0 * 16 + hi * 8 + 4);
#pragma unroll
                for (int j = 0; j < 4; ++j) { s = fmaf(bf2f((unsigned short)qr[d0][j]), k0[j], s); s = fmaf(bf2f((unsigned short)qr[d0][4 + j]), k1[j], s); } }
            s = xhalf_sum(s);
#pragma unroll
            for (int j = 0; j < 8; ++j) gt[j] = (j == n) ? s : gt[j]; }
        sel = 0u;
#pragma unroll
        for (int n = 0; n < 8; ++n) { int cnt = 0;
#pragma unroll
            for (int n2 = 0; n2 < 8; ++n2) if (n2 != n) cnt += (n2 < qb && (gt[n2] > gt[n] || (gt[n2] == gt[n] && n2 < n))) ? 1 : 0;
            if (n < qb && cnt < 3) sel |= 1u << n; }
    }
    const bf16_t* ksrc = K + (size_t)lane * kpitch;
    const bf16_t* vsrc = V + (size_t)(16 * (wid & 3) + (lane >> 2)) * vpitch + (wid >> 2) * 32 + (lane & 3) * 8;
#define FA_DMA(ti, buf) do { \
        __builtin_amdgcn_global_load_lds((const unsigned*)(ksrc + (size_t)(ti) * 64 * kpitch + wid * 8), (LAS unsigned*)(lds + (buf) * BUF + wid * 1024), 16, 0, 0); \
        if (NCH > 8 && wid < NCH - 8) __builtin_amdgcn_global_load_lds((const unsigned*)(ksrc + (size_t)(ti) * 64 * kpitch + (wid + 8) * 8), (LAS unsigned*)(lds + (buf) * BUF + (wid + 8) * 1024), 16, 0, 0); \
        __builtin_amdgcn_global_load_lds((const unsigned*)(vsrc + (size_t)(ti) * 64 * vpitch), (LAS unsigned*)(lds + (buf) * BUF + KBUF + wid * 1024), 16, 0, 0); } while (0)
#define FA_TILE(i) (((i) < 4) ? 4 * qb + (i) : (i) - 4)
    const int NT = 4 * qb + 4;
    float mhat = 0.f, l_reg = 0.f; f32x16 o[2]; o[0] = f32x16{}; o[1] = f32x16{}; f32x16 negm = f32x16{};
    const int koff = hi * 1024 + r32 * 16;
    const int voff = ((lane >> 4) & 1) * 32 + (lane & 3) * 8 + (4 * hi + ((lane & 15) >> 2)) * 64;
    FA_DMA(FA_TILE(0), 0);
    asm volatile("s_waitcnt vmcnt(0)" ::: "memory"); __builtin_amdgcn_s_barrier(); asm volatile("" ::: "memory");
    for (int i = 0; i < NT; ++i) {
        const int buf = i & 1;
        LAS unsigned char* bscr = lds + LDS_NEED + wid * 8192 + (bg.itc & 1) * 4096;
        if (bg.itc & 1) { if (bg.pend1 >= 0) { expert_finish(p, bg.pend1, bscr, lane); bg.pend1 = -1; asm volatile("s_waitcnt lgkmcnt(0)" ::: "memory"); } }
        else            { if (bg.pend0 >= 0) { expert_finish(p, bg.pend0, bscr, lane); bg.pend0 = -1; asm volatile("s_waitcnt lgkmcnt(0)" ::: "memory"); } }
        if (i + 1 < NT) { const int tn = FA_TILE(i + 1); FA_DMA(tn, buf ^ 1); }
        const bool bgdo = (bg.itc % 3 != 2) && bg.next < NEXP_ITEMS;
        if (bgdo) { expert_issue(p, bg.next, bscr, lane); if (bg.itc & 1) bg.pend1 = bg.next; else bg.pend0 = bg.next; bg.next += bg.stride; }
        ++bg.itc;
        const bool band = i < 4;
        if (!(band && 2 * i > wid)) {
            const LAS unsigned char* kb = lds + buf * BUF + koff;
            f32x16 p0 = negm, p1 = negm;
#pragma unroll
            for (int d0 = 0; d0 < ND; ++d0) { const bf16x8 a0 = *(const LAS bf16x8*)(kb + d0 * 2048), a1 = *(const LAS bf16x8*)(kb + d0 * 2048 + 512);
                p0 = __builtin_amdgcn_mfma_f32_32x32x16_bf16(a0, qr[d0], p0, 0, 0, 0); p1 = __builtin_amdgcn_mfma_f32_32x32x16_bf16(a1, qr[d0], p1, 0, 0, 0);
                if ((d0 & 1) == 1) asm volatile("" ::: "memory"); }
            if (band) { if (64 * i + 63 > 32 * wid) {
#pragma unroll
                    for (int r = 0; r < 16; ++r) { const int kv = 64 * i + crow(r, hi); if (kv > qrel) p0[r] = -INFINITY; if (kv + 32 > qrel) p1[r] = -INFINITY; } } }
            else if (!((sel >> ((i - 4) >> 2)) & 1u)) {
#pragma unroll
                for (int r = 0; r < 16; ++r) { p0[r] = -INFINITY; p1[r] = -INFINITY; } }
            float rm = fmaxf(p0[0], p1[0]);
#pragma unroll
            for (int r = 1; r < 16; ++r) rm = fmaxf(rm, fmaxf(p0[r], p1[r]));
            rm = xhalf_max(rm);
            if (i == 0 || __any(rm > THR)) {
                const float dl = (i == 0) ? rm : fmaxf(rm, 0.f); mhat += dl;
#pragma unroll
                for (int r = 0; r < 16; ++r) { p0[r] -= dl; p1[r] -= dl; negm[r] = -mhat; }
                if (i != 0) { const float f = __builtin_amdgcn_exp2f(-dl); l_reg *= f; if (hi == 0) wsf[r32] = f;
                    asm volatile("s_waitcnt lgkmcnt(0)" ::: "memory");
#pragma unroll
                    for (int r = 0; r < 16; ++r) { const float fr_ = wsf[crow(r, hi)]; o[0][r] *= fr_; o[1][r] *= fr_; } }
            }
            float sacc = 0.f;
#pragma unroll
            for (int r = 0; r < 16; ++r) { p0[r] = __builtin_amdgcn_exp2f(p0[r]); p1[r] = __builtin_amdgcn_exp2f(p1[r]); sacc += p0[r] + p1[r]; }
            l_reg += sacc;
            u32x4 pw[4];
#pragma unroll
            for (int s = 0; s < 2; ++s)
#pragma unroll
                for (int j = 0; j < 4; ++j) { pw[s][j] = cvtpk(p0[8 * s + 2 * j], p0[8 * s + 2 * j + 1]); pw[2 + s][j] = cvtpk(p1[8 * s + 2 * j], p1[8 * s + 2 * j + 1]); }
            const LAS unsigned char* vb = lds + buf * BUF + KBUF + voff;
#pragma unroll
            for (int d0 = 0; d0 < 2; ++d0)
#pragma unroll
                for (int s = 0; s < 4; ++s) {
                    const s16x4 lo = __builtin_bit_cast(s16x4, __builtin_amdgcn_ds_read_tr16_b64_v4i16((LAS s16x4*)(vb + d0 * 4096 + s * 1024)));
                    const s16x4 hh = __builtin_bit_cast(s16x4, __builtin_amdgcn_ds_read_tr16_b64_v4i16((LAS s16x4*)(vb + d0 * 4096 + s * 1024 + 512)));
                    const bf16x8 vf = (bf16x8){lo[0], lo[1], lo[2], lo[3], hh[0], hh[1], hh[2], hh[3]};
                    o[d0] = __builtin_amdgcn_mfma_f32_32x32x16_bf16(__builtin_bit_cast(bf16x8, pw[s]), vf, o[d0], 0, 0, 0);
                    if ((s & 1) == 1) asm volatile("" ::: "memory"); }
        }
        if (bgdo) asm volatile("s_waitcnt vmcnt(4) lgkmcnt(0)" ::: "memory");
        else asm volatile("s_waitcnt vmcnt(0) lgkmcnt(0)" ::: "memory");
        __builtin_amdgcn_s_barrier(); asm volatile("" ::: "memory");
    }
    l_reg = xhalf_sum(l_reg);
    if (hi == 0) wsf[32 + r32] = l_reg;
    asm volatile("s_waitcnt lgkmcnt(0)" ::: "memory");
#pragma unroll
    for (int r = 0; r < 16; ++r) { const float rl = 1.0f / wsf[32 + crow(r, hi)]; bf16_t* op = O + (size_t)(q0 + wid * 32 + crow(r, hi)) * 1024 + r32;
        op[0] = (bf16_t)f2bf(o[0][r] * rl); op[32] = (bf16_t)f2bf(o[1][r] * rl); }
    asm volatile("s_waitcnt lgkmcnt(0)" ::: "memory"); __builtin_amdgcn_s_barrier(); asm volatile("" ::: "memory");
#undef FA_DMA
#undef FA_TILE
}
__device__ __forceinline__ void phase_attn_fast(const Params& p, LAS unsigned char* lds, int vcu, int G) {
    unsigned char* ws = p.ws;
    const bf16_t* QM = (const bf16_t*)(ws + WS_QM); const bf16_t* KM = (const bf16_t*)(ws + WS_KM); const bf16_t* VM = (const bf16_t*)(ws + WS_VM);
    const bf16_t* QB = (const bf16_t*)(ws + WS_QB); const bf16_t* KB = (const bf16_t*)(ws + WS_KB); const bf16_t* PROJ = (const bf16_t*)(ws + WS_PROJ);
    const float* kmean = (const float*)(ws + WS_KMEAN); bf16_t* ATT = (bf16_t*)(ws + WS_ATT);
    const int wave_ = __builtin_amdgcn_readfirstlane(threadIdx.x >> 6);
    BgConv bg; bg.next = vcu * NWAVES + wave_; bg.stride = G * NWAVES; bg.pend0 = -1; bg.pend1 = -1; bg.itc = 0;
    for (int su = vcu; su < 256; su += G) {
        const int bh = su >> 2, j = su & 3, b = bh >> 3, h = bh & 7; const size_t r0 = (size_t)b * SEQ;
#pragma unroll 1
        for (int k = 0; k < 2; ++k) { const int qb = k ? 7 - j : j;
            attn_unit<96>(lds, QM + r0 * 768 + h * 96, 768, KM + r0 * 768 + h * 96, 768, VM + r0 * 512 + h * 64, 512, ATT + r0 * 1024 + h * 64, qb, nullptr, p, bg);
            attn_unit<64>(lds, QB + r0 * 512 + h * 64, 512, KB + r0 * 512 + h * 64, 512, PROJ + r0 * PN + C_MV + h * 64, PN, ATT + r0 * 1024 + 512 + h * 64, qb, kmean + (size_t)(b * 8) * 512 + h * 64, p, bg); }
    }
    { const int lane = threadIdx.x & 63; LAS unsigned char* bscr = lds + fa::LDS_NEED + wave_ * 8192;
      asm volatile("s_waitcnt vmcnt(0)" ::: "memory");
      if (bg.pend0 >= 0) { expert_finish(p, bg.pend0, bscr, lane); bg.pend0 = -1; }
      if (bg.pend1 >= 0) { expert_finish(p, bg.pend1, bscr + 4096, lane); bg.pend1 = -1; }
      asm volatile("s_waitcnt lgkmcnt(0)" ::: "memory");
#pragma unroll 1
      for (; bg.next < NEXP_ITEMS; bg.next += bg.stride) { expert_issue(p, bg.next, bscr, lane); asm volatile("s_waitcnt vmcnt(0)" ::: "memory"); expert_finish(p, bg.next, bscr, lane); asm volatile("s_waitcnt lgkmcnt(0)" ::: "memory"); } }
}

__device__ __forceinline__ float rs32(float (&a)[32], int lane) {
#pragma unroll
    for (int e = 0; e < 16; ++e) { auto rr = __builtin_amdgcn_permlane32_swap(__float_as_uint(a[e]), __float_as_uint(a[e + 16]), false, false); a[e] = __uint_as_float(rr[0]) + __uint_as_float(rr[1]); }
#pragma unroll
    for (int e = 0; e < 8; ++e) { auto rr = __builtin_amdgcn_permlane16_swap(__float_as_uint(a[e]), __float_as_uint(a[e + 8]), false, false); a[e] = __uint_as_float(rr[0]) + __uint_as_float(rr[1]); }
    { const bool bit = (lane & 8) != 0;
#pragma unroll
      for (int e = 0; e < 4; ++e) { const float keep = bit ? a[e + 4] : a[e], send = bit ? a[e] : a[e + 4]; a[e] = keep + __shfl_xor(send, 8); } }
    { const bool bit = (lane & 4) != 0;
#pragma unroll
      for (int e = 0; e < 2; ++e) { const float keep = bit ? a[e + 2] : a[e], send = bit ? a[e] : a[e + 2]; a[e] = keep + __shfl_xor(send, 4); } }
    { const bool bit = (lane & 2) != 0; const float keep = bit ? a[1] : a[0], send = bit ? a[0] : a[1]; a[0] = keep + __shfl_xor(send, 2); }
    return a[0] + __shfl_xor(a[0], 1);
}
__device__ __forceinline__ void route_row(const Params& p, float logit, int tok, int tl, int lane, int* tidx, float* tgate, LAS int* lidx) {
    const int me = lane >> 1;
    const float my = (lane & 1) ? -INFINITY : logit + p.b_router[me];
    int rank = 0;
#pragma unroll
    for (int e = 0; e < 32; ++e) { const float ve = __uint_as_float(__builtin_amdgcn_readlane(__float_as_uint(my), 2 * e)); rank += (ve > my || (ve == my && e < me)) ? 1 : 0; }
    float tv[4]; int ti[4];
#pragma unroll
    for (int k = 0; k < 4; ++k) { const unsigned long long bal = __ballot(rank == k && !(lane & 1)); const int il = __ffsll((long long)bal) - 1;
        tv[k] = __uint_as_float(__builtin_amdgcn_readlane(__float_as_uint(my), il)); ti[k] = il >> 1; }
    if (lane == 0) { const float e1 = expf(tv[1] - tv[0]), e2 = expf(tv[2] - tv[0]), e3 = expf(tv[3] - tv[0]); const float is = 1.0f / (1.0f + e1 + e2 + e3);
        *(f32x4*)(tgate + (size_t)tok * 4) = (f32x4){is, e1 * is, e2 * is, e3 * is};
        int* tp = tidx + (size_t)tok * 4; tp[0] = ti[0]; tp[1] = ti[1]; tp[2] = ti[2]; tp[3] = ti[3];
        lidx[tl * 4 + 0] = ti[0]; lidx[tl * 4 + 1] = ti[1]; lidx[tl * 4 + 2] = ti[2]; lidx[tl * 4 + 3] = ti[3]; }
}
__device__ __forceinline__ void phase_ln1_route(const Params& p, LAS unsigned char* lds, int vcu, int G) {
    const int tid = threadIdx.x, wave = tid >> 6, lane = tid & 63;
    unsigned char* ws = p.ws;
    float* X1 = p.out; const float* X1P = (const float*)(ws + WS_X1PRE); bf16_t* X1B = (bf16_t*)(ws + WS_X1B);
    int* tidx = (int*)(ws + WS_TIDX); float* tgate = (float*)(ws + WS_TGATE); unsigned* hist = (unsigned*)(ws + WS_HIST);
    LAS int* lidx = (LAS int*)(lds + ROWTAB_OFF);
    { const float* WRL = (const float*)(ws + WS_WRL);
      for (int i = tid; i < 8192; i += NTHREADS) *(LAS f32x4*)(lds + (size_t)i * 16) = *(const f32x4*)(WRL + (size_t)i * 4); }
    __syncthreads();
    const LAS float* Wl = (const LAS float*)lds + lane;
    for (int chunk = vcu; chunk < NCHUNK; chunk += G) {
#pragma unroll 1
        for (int rp = 0; rp < 4; ++rp) {
            const int tl = wave * 8 + 2 * rp, tok = chunk * 64 + tl;
            f32x4 v0[4], v1[4]; float s0 = 0.f, s1 = 0.f;
#pragma unroll
            for (int j = 0; j < 4; ++j) { v0[j] = *(const f32x4*)(X1P + (size_t)tok * DM + 4 * lane + 256 * j); v1[j] = *(const f32x4*)(X1P + (size_t)(tok + 1) * DM + 4 * lane + 256 * j);
                s0 += (v0[j][0] + v0[j][1]) + (v0[j][2] + v0[j][3]); s1 += (v1[j][0] + v1[j][1]) + (v1[j][2] + v1[j][3]); }
            const float mean0 = wave_sum(s0) * (1.0f / DM), mean1 = wave_sum(s1) * (1.0f / DM); float q0 = 0.f, q1 = 0.f;
#pragma unroll
            for (int j = 0; j < 4; ++j) { v0[j] = v0[j] - mean0; v1[j] = v1[j] - mean1;
                q0 += (v0[j][0] * v0[j][0] + v0[j][1] * v0[j][1]) + (v0[j][2] * v0[j][2] + v0[j][3] * v0[j][3]); q1 += (v1[j][0] * v1[j][0] + v1[j][1] * v1[j][1]) + (v1[j][2] * v1[j][2] + v1[j][3] * v1[j][3]); }
            const float rs0 = 1.0f / sqrtf(wave_sum(q0) * (1.0f / DM) + LN_EPS), rs1 = 1.0f / sqrtf(wave_sum(q1) * (1.0f / DM) + LN_EPS);
#pragma unroll
            for (int j = 0; j < 4; ++j) { const f32x4 g = *(const f32x4*)(p.ln1_g + 4 * lane + 256 * j), bb = *(const f32x4*)(p.ln1_b + 4 * lane + 256 * j);
                v0[j] = v0[j] * rs0 * g + bb; v1[j] = v1[j] * rs1 * g + bb;
                *(f32x4*)(X1 + (size_t)tok * DM + 4 * lane + 256 * j) = v0[j]; *(f32x4*)(X1 + (size_t)(tok + 1) * DM + 4 * lane + 256 * j) = v1[j];
                u32x2 w; w.x = pk2(v0[j][0], v0[j][1]); w.y = pk2(v0[j][2], v0[j][3]); *(u32x2*)(X1B + (size_t)tok * DM + 4 * lane + 256 * j) = w;
                w.x = pk2(v1[j][0], v1[j][1]); w.y = pk2(v1[j][2], v1[j][3]); *(u32x2*)(X1B + (size_t)(tok + 1) * DM + 4 * lane + 256 * j) = w; }
            float a0[32], a1[32];
#pragma unroll
            for (int e = 0; e < 32; ++e) { a0[e] = 0.f; a1[e] = 0.f; }
            const LAS float* wlo = Wl; const LAS float* whi = Wl + 8 * 32 * 64;
            asm volatile("" : "+v"(wlo), "+v"(whi));
#pragma unroll
            for (int j = 0; j < 4; ++j)
#pragma unroll
                for (int i = 0; i < 4; ++i) { const float x0 = v0[j][i], x1 = v1[j][i]; const LAS float* wb = (j < 2) ? wlo + (j * 4 + i) * 32 * 64 : whi + ((j - 2) * 4 + i) * 32 * 64;
#pragma unroll
                    for (int e = 0; e < 32; ++e) { const float w = wb[e * 64]; a0[e] = fmaf(x0, w, a0[e]); a1[e] = fmaf(x1, w, a1[e]); }
                    asm volatile("" ::: "memory"); }
            const float l0 = rs32(a0, lane), l1 = rs32(a1, lane);
            route_row(p, l0, tok, tl, lane, tidx, tgate, lidx);
            route_row(p, l1, tok + 1, tl + 1, lane, tidx, tgate, lidx);
        }
        __syncthreads();
        if (tid < 32) { unsigned c = 0; for (int a = 0; a < 256; ++a) c += (lidx[a] == tid) ? 1u : 0u; hist[chunk * 32 + tid] = c; }
        __syncthreads();
    }
}

__device__ __forceinline__ void phase_assign(const Params& p, LAS unsigned char* lds, int vcu, int G) {
    const int tid = threadIdx.x;
    unsigned char* ws = p.ws;
    const int* tidx = (const int*)(ws + WS_TIDX); const float* tgate = (const float*)(ws + WS_TGATE); const unsigned* hist = (const unsigned*)(ws + WS_HIST);
    int* dest = (int*)(ws + WS_DEST); int* row_tok = (int*)(ws + WS_ROWTOK); float* row_gate = (float*)(ws + WS_ROWGATE); int* tile_e = (int*)(ws + WS_TILEE);
    LAS int* lidx = (LAS int*)lds;
    LAS int* lcnt = (LAS int*)(lds + 1024);
    LAS int* lpre = (LAS int*)(lds + 1024 + 128);
    LAS int* lstart = (LAS int*)(lds + 1024 + 256);
    LAS int* ptot = (LAS int*)(lds + 2048);
    LAS int* ppre = (LAS int*)(lds + 4096);
    for (int chunk = vcu; chunk < NCHUNK; chunk += G) {
        if (tid < 256) lidx[tid] = tidx[chunk * 256 + tid];
        { const int e = tid & 31, cg = tid >> 5; int tot = 0, pre = 0;
#pragma unroll
          for (int k = 0; k < 16; ++k) { const int c = cg * 16 + k; const int hv = (int)hist[c * 32 + e]; tot += hv; pre += (c < chunk) ? hv : 0; }
          ptot[cg * 32 + e] = tot; ppre[cg * 32 + e] = pre; }
        __syncthreads();
        if (tid < 32) { int tot = 0, pre = 0;
#pragma unroll
            for (int cg = 0; cg < 16; ++cg) { tot += ptot[cg * 32 + tid]; pre += ppre[cg * 32 + tid]; }
            lcnt[tid] = tot; lpre[tid] = pre; }
        __syncthreads();
        if (tid == 0) { int s2 = 0; for (int e = 0; e < 32; ++e) { lstart[e] = s2; s2 += (lcnt[e] + 255) / 256 * 256; } lstart[32] = s2; }
        __syncthreads();
        if (tid < 256) { const int e = lidx[tid]; int rank = 0; for (int a = 0; a < tid; ++a) rank += (lidx[a] == e) ? 1 : 0;
            const int P = lstart[e] + lpre[e] + rank, tok = chunk * 64 + (tid >> 2);
            row_tok[P] = tok; row_gate[P] = tgate[chunk * 256 + tid]; dest[chunk * 256 + tid] = P; }
        if (chunk < 32) { const int e = chunk; for (int P = lstart[e] + lcnt[e] + tid; P < lstart[e + 1]; P += NTHREADS) { row_tok[P] = 0; row_gate[P] = 0.f; } }
        if (chunk == 0) { if (tid < 32) { for (int t = lstart[tid] / 256; t < lstart[tid + 1] / 256; ++t) tile_e[t] = tid; } if (tid == 32) tile_e[MAXTILES] = lstart[32] / 256; }
        __syncthreads();
    }
}

__device__ __forceinline__ void phase_final(const Params& p, int vcu, int G) {
    const int tid = threadIdx.x, wave = tid >> 6, lane = tid & 63;
    unsigned char* ws = p.ws;
    const int* dest = (const int*)(ws + WS_DEST); const bf16_t* Y = (const bf16_t*)(ws + WS_Y); float* X1 = p.out;
    const int gw = vcu * NWAVES + wave, NGW = G * NWAVES;
    for (int tok = gw; tok < NTOK; tok += NGW) {
        f32x4 v[4];
#pragma unroll
        for (int j = 0; j < 4; ++j) v[j] = *(const f32x4*)(X1 + (size_t)tok * DM + 4 * lane + 256 * j) * DN_ALPHA;
#pragma unroll
        for (int k = 0; k < 4; ++k) { const int P = dest[tok * 4 + k];
#pragma unroll
            for (int j = 0; j < 4; ++j) { const u32x2 w = *(const u32x2*)(Y + (size_t)P * 1024 + 4 * lane + 256 * j);
                v[j][0] += __uint_as_float(w.x << 16); v[j][1] += __uint_as_float(w.x & 0xffff0000u); v[j][2] += __uint_as_float(w.y << 16); v[j][3] += __uint_as_float(w.y & 0xffff0000u); } }
        float s = 0.f;
#pragma unroll
        for (int j = 0; j < 4; ++j) s += (v[j][0] + v[j][1]) + (v[j][2] + v[j][3]);
        const float mean = wave_sum(s) * (1.0f / DM); float s2 = 0.f;
#pragma unroll
        for (int j = 0; j < 4; ++j) { v[j] = v[j] - mean; s2 += (v[j][0] * v[j][0] + v[j][1] * v[j][1]) + (v[j][2] * v[j][2] + v[j][3] * v[j][3]); }
        const float rs = 1.0f / sqrtf(wave_sum(s2) * (1.0f / DM) + LN_EPS);
#pragma unroll
        for (int j = 0; j < 4; ++j) { const f32x4 g = *(const f32x4*)(p.ln2_g + 4 * lane + 256 * j), bb = *(const f32x4*)(p.ln2_b + 4 * lane + 256 * j);
            *(f32x4*)(p.out + (size_t)tok * DM + 4 * lane + 256 * j) = v[j] * rs * g + bb; }
    }
}

constexpr int NPHASE = 11;
__global__ void __launch_bounds__(NTHREADS, 2) fwd_kernel(Params p) {
    extern __shared__ __attribute__((aligned(16))) unsigned char lds_raw[];
    LAS unsigned char* lds = (LAS unsigned char*)lds_raw;
    const int tid = threadIdx.x;
    const int G = gridDim.x, bx = blockIdx.x;
    const int vcu = (G % 8 == 0) ? (bx % 8) * (G / 8) + bx / 8 : bx;
    unsigned char* ws = p.ws;
    volatile LAS unsigned* MISC = (volatile LAS unsigned*)(lds + MISC_OFF);
    if (tid < 32) MISC[tid] = 0u;
    __syncthreads();
    XcdBarrier bar; bar.bar = (unsigned*)(ws + WS_CTL) + CW_BAR; bar.x = 0; bar.st = nullptr;
    const bool one = (p.ph_hi - p.ph_lo) > 1;
    if (one) bar = xcd_barrier_post((unsigned*)(ws + WS_CTL) + CW_BAR, MISC + 8);
    const int lo = p.ph_lo, hi = p.ph_hi;
#ifdef ONLY_PHASE
#define IN(k) ((k) == ONLY_PHASE && lo <= (k) && (k) < hi)
#else
#define IN(k) (lo <= (k) && (k) < hi)
#endif
#ifndef NAIVE_GEMM_MASK
#define NAIVE_GEMM_MASK 0
#endif
#define GEMM_CALL(EPI, SCHED) do { if constexpr (NAIVE_GEMM_MASK != 0) gemm_phase_naive<EPI, SCHED>(lds, g, S, E); else gemm_phase<EPI, SCHED, true>(lds, g, S, E); } while (0)
#ifndef REPEAT_PHASE
#define REPEAT_PHASE (-1)
#endif
#define NREP(k) ((REPEAT_PHASE == (k)) ? 2 : 1)
#define REPBAR(k) do { if (REPEAT_PHASE == (k) && rep_ == 0) xcd_barrier(bar); } while (0)
#define SEAM(k) do { if (IN(k) && IN((k) + 1)) xcd_barrier(bar); } while (0)

    if (IN(0)) for (int rep_ = 0; rep_ < NREP(0); ++rep_) { phase_prologue(p, lds, vcu, G); REPBAR(0); } SEAM(0);
    if (IN(1)) for (int rep_ = 0; rep_ < NREP(1); ++rep_) { GemmArgs g{(const bf16_t*)(ws + WS_XB), 1024, (const bf16_t*)(ws + WS_WIN), 1024, 1024}; DenseSched S; S.init(lds, NTOK, PN, G, vcu);
        EpiProj E{(bf16_t*)(ws + WS_PROJ)}; GEMM_CALL(EpiProj, DenseSched); REPBAR(1); } SEAM(1);
    if (IN(2)) for (int rep_ = 0; rep_ < NREP(2); ++rep_) { phase_prep(p, lds, vcu, G); REPBAR(2); } SEAM(2);
    if (IN(3)) for (int rep_ = 0; rep_ < NREP(3); ++rep_) { GemmArgs g{(const bf16_t*)(ws + WS_PROJ), PN, (const bf16_t*)(ws + WS_WUP), KUP, KUP}; DenseSched S; S.init(lds, NTOK, NUP, G, vcu);
        EpiUp E{(bf16_t*)(ws + WS_QM), (bf16_t*)(ws + WS_KM), (bf16_t*)(ws + WS_VM), (const float*)(ws + WS_RSTD), (const float*)(ws + WS_ROPEA)}; GEMM_CALL(EpiUp, DenseSched); REPBAR(3); } SEAM(3);
    #ifdef NAIVE_ATTN
    if (IN(4)) for (int rep_ = 0; rep_ < NREP(4); ++rep_) { phase_attn(p, vcu, G); REPBAR(4); } SEAM(4);
#else
    if (IN(4)) for (int rep_ = 0; rep_ < NREP(4); ++rep_) { phase_attn_fast(p, lds, vcu, G); REPBAR(4); } SEAM(4);
#endif
    if (IN(5)) for (int rep_ = 0; rep_ < NREP(5); ++rep_) { GemmArgs g{(const bf16_t*)(ws + WS_ATT), 1024, (const bf16_t*)(ws + WS_WO), 1024, 1024}; DenseSched S; S.init(lds, NTOK, DM, G, vcu);
        EpiWo E{p.x, (float*)(ws + WS_X1PRE)}; GEMM_CALL(EpiWo, DenseSched); REPBAR(5); } SEAM(5);
    if (IN(6)) for (int rep_ = 0; rep_ < NREP(6); ++rep_) { phase_ln1_route(p, lds, vcu, G); REPBAR(6); } SEAM(6);
    if (IN(7)) for (int rep_ = 0; rep_ < NREP(7); ++rep_) { phase_assign(p, lds, vcu, G); REPBAR(7); } SEAM(7);
    if (IN(8)) for (int rep_ = 0; rep_ < NREP(8); ++rep_) { GemmArgs g{(const bf16_t*)(ws + WS_X1B), 1024, (const bf16_t*)(ws + WS_WGU), 1024, 1024}; GroupSched<true> S; S.init(lds, (const int*)(ws + WS_TILEE), (const int*)(ws + WS_ROWTOK), 8, 2048, G, vcu);
        EpiGateUp E{(bf16_t*)(ws + WS_H), p.b_gate, p.b_up}; GEMM_CALL(EpiGateUp, GroupSched<true>); REPBAR(8); } SEAM(8);
    if (IN(9)) for (int rep_ = 0; rep_ < NREP(9); ++rep_) { GemmArgs g{(const bf16_t*)(ws + WS_H), 1024, (const bf16_t*)(ws + WS_WD), 1024, 1024}; GroupSched<false> S; S.init(lds, (const int*)(ws + WS_TILEE), (const int*)(ws + WS_ROWTOK), 4, 1024, G, vcu);
        EpiDown E{(bf16_t*)(ws + WS_Y), p.b_down, (const float*)(ws + WS_ROWGATE)}; GEMM_CALL(EpiDown, GroupSched<false>); REPBAR(9); } SEAM(9);
    if (IN(10)) { phase_final(p, vcu, G); }
#undef IN
#undef SEAM
}

extern "C" void kernel_launch(void* const* d_in, const int* in_sizes, int n_in, void* d_out, int out_size, void* d_ws, size_t ws_size, hipStream_t stream) {
    static int grid = 0;
    if (grid == 0) {
        if (n_in != 20 || out_size != NTOK * DM || ws_size < WS_END) { fprintf(stderr, "kernel_launch: unexpected shapes (n_in %d out %d ws %zu)\n", n_in, out_size, ws_size); grid = -1; return; }
        int dev = 0, cus = 0, per_cu = 0;
        if (hipGetDevice(&dev) != hipSuccess || hipDeviceGetAttribute(&cus, hipDeviceAttributeMultiprocessorCount, dev) != hipSuccess) { grid = -1; return; }
        if (hipFuncSetAttribute((const void*)fwd_kernel, hipFuncAttributeMaxDynamicSharedMemorySize, LDS_BYTES) != hipSuccess) { fprintf(stderr, "kernel_launch: hipFuncSetAttribute failed\n"); grid = -1; return; }
        if (hipOccupancyMaxActiveBlocksPerMultiprocessor(&per_cu, (const void*)fwd_kernel, NTHREADS, LDS_BYTES) != hipSuccess || per_cu < 1) fprintf(stderr, "kernel_launch: occupancy query says %d\n", per_cu);
        (void)hipGetLastError();
        grid = cus;
    }
    if (grid < 0) return;
    (void)hipMemsetAsync((char*)d_ws + WS_CTL, 0, CTL_ZERO_BYTES, stream);
    Params p{};
    p.x = (const float*)d_in[0]; p.pos = (const int*)d_in[1]; p.w_in = (const float*)d_in[2]; p.q_a_norm = (const float*)d_in[3]; p.w_q_b = (const float*)d_in[4];
    p.kv_a_norm = (const float*)d_in[5]; p.w_kv_b = (const float*)d_in[6]; p.w_o = (const float*)d_in[7]; p.ln1_g = (const float*)d_in[8]; p.ln1_b = (const float*)d_in[9];
    p.w_router = (const float*)d_in[10]; p.b_router = (const float*)d_in[11]; p.w_gate = (const float*)d_in[12]; p.b_gate = (const float*)d_in[13];
    p.w_up = (const float*)d_in[14]; p.b_up = (const float*)d_in[15]; p.w_down = (const float*)d_in[16]; p.b_down = (const float*)d_in[17];
    p.ln2_g = (const float*)d_in[18]; p.ln2_b = (const float*)d_in[19];
    p.out = (float*)d_out; p.ws = (unsigned char*)d_ws;
    for (int i = 0; i < 16; ++i) p.invfA[i] = pow(500000.0, -(double)(2 * i) / 32.0);
    for (int i = 0; i < 8; ++i) p.invfB[i] = pow(500000.0, -(double)(2 * i) / 16.0);
#if MK_ONE_LAUNCH
    p.ph_lo = 0; p.ph_hi = NPHASE;
    hipLaunchKernelGGL(fwd_kernel, dim3(grid), dim3(NTHREADS), LDS_BYTES, stream, p);
#else
    for (int ph = 0; ph < NPHASE; ++ph) { p.ph_lo = ph; p.ph_hi = ph + 1; hipLaunchKernelGGL(fwd_kernel, dim3(grid), dim3(NTHREADS), LDS_BYTES, stream, p); }
#endif
}
```

```cpp
#include <hip/hip_runtime.h>
#include <cstdio>
#include <cstdint>
#include <cmath>

#ifndef MK_ONE_LAUNCH
#define MK_ONE_LAUNCH 1
#endif

#define GAS __attribute__((address_space(1)))
#define LAS __attribute__((address_space(3)))
typedef unsigned short bf16_t;
typedef short bf16x8 __attribute__((ext_vector_type(8)));
typedef float f32x4 __attribute__((ext_vector_type(4)));
typedef float f32x2 __attribute__((ext_vector_type(2)));
typedef unsigned u32x4 __attribute__((ext_vector_type(4)));
typedef unsigned u32x2 __attribute__((ext_vector_type(2)));

constexpr int NTOK = 16384, DM = 1024, SEQ = 2048, NBATCH = 8;
constexpr int PN = 2048;
constexpr int C_QL = 0, C_KVL = 256, C_KR = 384, C_MQ = 416, C_MK = 928, C_MV = 1440, IN_COLS = 1952;
constexpr int NUP = 1792, KUP = 384;
constexpr int NE = 32, TOPK = 4;
constexpr int MAXROWS = 65536 + NE * 256, MAXTILES = MAXROWS / 256;
constexpr int NCHUNK = NTOK / 64;
constexpr float LN_EPS = 1e-5f, RMS_EPS = 1e-6f;
constexpr float DN_ALPHA = 1.189207115002721f;
constexpr float LOG2E = 1.4426950408889634f;
constexpr float C2A = 0.10206207261596575f * LOG2E;
constexpr float C2B = 0.125f * LOG2E;
constexpr int NWAVES = 8, NTHREADS = 512;

constexpr size_t MiB = 1u << 20;
constexpr size_t WS_CTL = 0, CTL_ZERO_BYTES = 1 * MiB;
constexpr size_t WS_HIST = 1 * MiB;
constexpr size_t WS_TIDX = WS_HIST + 64 * 1024;
constexpr size_t WS_TGATE = WS_TIDX + 256 * 1024;
constexpr size_t WS_DEST = WS_TGATE + 256 * 1024;
constexpr size_t WS_ROWTOK = WS_DEST + 256 * 1024;
constexpr size_t WS_ROWGATE = WS_ROWTOK + 288 * 1024;
constexpr size_t WS_TILEE = WS_ROWGATE + 288 * 1024;
constexpr size_t WS_RSTD = WS_TILEE + 4 * 1024;
constexpr size_t WS_KMEAN = WS_RSTD + 128 * 1024;
constexpr size_t WS_WRL = WS_KMEAN + 128 * 1024;
static_assert(WS_WRL + 128 * 1024 <= 4 * MiB, "route region");
constexpr size_t WS_ROPEA = 4 * MiB;
constexpr size_t WS_ROPEB = 6 * MiB;
constexpr size_t WS_WIN = 8 * MiB;
constexpr size_t WS_WO = 12 * MiB;
constexpr size_t WS_WUP = 14 * MiB;
constexpr size_t WS_X1B = 16 * MiB;
constexpr size_t WS_WD = 48 * MiB;
constexpr size_t WS_XB = 112 * MiB;
constexpr size_t WS_PROJ = 144 * MiB;
constexpr size_t WS_QM = 208 * MiB;
constexpr size_t WS_KM = 232 * MiB;
constexpr size_t WS_VM = 256 * MiB;
constexpr size_t WS_QB = 272 * MiB;
constexpr size_t WS_KB = 288 * MiB;
constexpr size_t WS_ATT = 304 * MiB;
constexpr size_t WS_H = 112 * MiB;
constexpr size_t WS_WGU = 336 * MiB;
constexpr size_t WS_Y = 336 * MiB;
constexpr size_t WS_LAT = 144 * MiB;
constexpr size_t WS_VB = 160 * MiB;
constexpr size_t WS_RSTDP = 176 * MiB;
constexpr size_t WS_KMEANP = 177 * MiB;
constexpr size_t WS_X1PRE = 144 * MiB;
constexpr size_t WS_END = 480 * MiB;
static_assert(WS_H + (size_t)MAXROWS * 1024 * 2 <= WS_VM + 0 * MiB + 0 && WS_Y + (size_t)MAXROWS * 1024 * 2 <= WS_END, "ws map");
constexpr int CW_BAR = 4096;

constexpr int LDS_BYTES = 147456;
constexpr int MISC_OFF = 131072 + 320;

__device__ __forceinline__ float bf2f(unsigned v) { return __uint_as_float(v << 16); }
__device__ __forceinline__ unsigned f2bf(float f) { unsigned u = __float_as_uint(f); return (u + 0x7fffu + ((u >> 16) & 1u)) >> 16; }
__device__ __forceinline__ unsigned pk2(float lo, float hi) { return f2bf(lo) | (f2bf(hi) << 16); }
__device__ __forceinline__ float wave_sum(float v) {
#pragma unroll
    for (int o = 1; o < 64; o <<= 1) v += __shfl_xor(v, o);
    return v;
}
__device__ __forceinline__ float wave_max(float v) {
#pragma unroll
    for (int o = 1; o < 64; o <<= 1) v = fmaxf(v, __shfl_xor(v, o));
    return v;
}

#define XB_TMO      128
#define XB_XCNT(j)  (256  + 64 * (j))
#define XB_XSUB(j)  (1280 + 64 * (j))
#define XB_XGEN(j)  (2304 + 64 * (j))
#define XB_TOP      3328
#define XB_TOPGEN   3392
#define XCD_BAR_WORDS 3456
#define XB_SPIN_CAP (1u << 18)
__device__ __forceinline__ unsigned xb_ld(unsigned* p)              { return __hip_atomic_load(p, __ATOMIC_RELAXED, __HIP_MEMORY_SCOPE_AGENT); }
__device__ __forceinline__ unsigned xb_add(unsigned* p, unsigned v) { return __hip_atomic_fetch_add(p, v, __ATOMIC_RELAXED, __HIP_MEMORY_SCOPE_AGENT); }
__device__ __forceinline__ unsigned xb_xcc_id() { return (unsigned)__builtin_amdgcn_s_getreg((3 << 11) | 20) & 0xFu; }
#define XB_SPIN(cond, bar) do { unsigned _sp = 0; while (cond) { __builtin_amdgcn_s_sleep(1); \
    if ((++_sp & 255u) == 0u) { if (xb_ld(&(bar)[XB_TMO])) break; if (_sp > XB_SPIN_CAP) { atomicAdd(&(bar)[XB_TMO], 1u); break; } } } } while (0)
struct XcdBarrier { unsigned* bar; unsigned x; volatile LAS unsigned* st; };
__device__ __forceinline__ XcdBarrier xcd_barrier_post(unsigned* bar, volatile LAS unsigned* st) {
    XcdBarrier b; b.bar = bar; b.x = xb_xcc_id(); b.st = st;
    if (threadIdx.x == 0) (void)xb_add(&bar[XB_XCNT(b.x)], 1u);
    return b;
}
__device__ __forceinline__ void xcd_barrier_complete(unsigned* bar, unsigned x, unsigned& nloc, unsigned& nx) {
    const unsigned G = gridDim.x * gridDim.y * gridDim.z;
    unsigned sum, cnt, mine, sp = 0u;
    for (;;) {
        sum = 0u; cnt = 0u; mine = 0u;
#pragma unroll
        for (unsigned j = 0; j < 16; ++j) { const unsigned c = xb_ld(&bar[XB_XCNT(j)]); sum += c; cnt += (c > 0u) ? 1u : 0u; mine = (j == x) ? c : mine; }
        if (sum == G) break;
        __builtin_amdgcn_s_sleep(1);
        if ((++sp & 255u) == 0u) { if (xb_ld(&bar[XB_TMO])) break; if (sp > XB_SPIN_CAP) { atomicAdd(&bar[XB_TMO], 1u); break; } }
    }
    nloc = mine > 0u ? mine : 1u; nx = cnt > 0u ? cnt : 1u;
}
__device__ __forceinline__ void xcd_barrier(const XcdBarrier& b) {
    asm volatile("s_waitcnt vmcnt(0)" ::: "memory");
    __syncthreads();
    if (threadIdx.x == 0) {
        unsigned* bar = b.bar;
        __builtin_amdgcn_s_waitcnt(0);
        unsigned nloc = b.st[0], nx = b.st[1];
        if (nloc == 0u) { xcd_barrier_complete(bar, b.x, nloc, nx); b.st[0] = nloc; b.st[1] = nx; }
        const unsigned old = xb_add(&bar[XB_XSUB(b.x)], 1u);
        const unsigned gen = old / nloc;
        if (old + 1u == (gen + 1u) * nloc) {
            __builtin_amdgcn_fence(__ATOMIC_RELEASE, "agent");
            asm volatile("s_waitcnt vmcnt(0)" ::: "memory");
            const unsigned og = xb_add(&bar[XB_TOP], 1u);
            const unsigned tg = og / nx;
            if (og + 1u == (tg + 1u) * nx) xb_add(&bar[XB_TOPGEN], 1u);
            else XB_SPIN(xb_ld(&bar[XB_TOPGEN]) == tg, bar);
            __builtin_amdgcn_fence(__ATOMIC_ACQUIRE, "agent");
            xb_add(&bar[XB_XGEN(b.x)], 1u);
            asm volatile("s_waitcnt vmcnt(0)" ::: "memory");
        } else {
            XB_SPIN(xb_ld(&bar[XB_XGEN(b.x)]) == gen, bar);
            __builtin_amdgcn_fence(__ATOMIC_ACQUIRE, "agent");
            asm volatile("s_waitcnt vmcnt(0)" ::: "memory");
        }
    }
    __syncthreads();
}

struct Params {
    const float* x; const int* pos;
    const float *w_in, *q_a_norm, *w_q_b, *kv_a_norm, *w_kv_b, *w_o, *ln1_g, *ln1_b, *w_router, *b_router;
    const float *w_gate, *b_gate, *w_up, *b_up, *w_down, *b_down, *ln2_g, *ln2_b;
    float* out; unsigned char* ws;
    double invfA[16]; double invfB[8];
    int ph_lo, ph_hi;
};

struct Unit { int pm, pn, e; };
struct GemmArgs { const bf16_t* A; int lda; const bf16_t* Bt; int ldb; int K; };
template <bool PERM> __device__ __forceinline__ int ecol(int bj, int n, int wc, int fq) { return 128 * bj + 32 * wc + (PERM ? 8 * fq + 4 * n : 16 * n + 4 * fq); }

template <class Epi, class Sched>
__device__ __forceinline__ void gemm_phase_naive(LAS unsigned char* lds, const GemmArgs g, const Sched& S, const Epi& E) {
    const int tid = threadIdx.x, wid = __builtin_amdgcn_readfirstlane(tid >> 6), lane = tid & 63, wr = wid >> 2, wc = wid & 3, fr = lane & 15, fq = lane >> 4;
    Unit u;
    for (int ui = 0; S.next(ui, u); ++ui) {
        f32x4 acc[2][2][4][2];
#pragma unroll
        for (int a = 0; a < 2; ++a)
#pragma unroll
            for (int b = 0; b < 2; ++b)
#pragma unroll
                for (int m = 0; m < 4; ++m)
#pragma unroll
                    for (int n = 0; n < 2; ++n) acc[a][b][m][n] = (f32x4){0.f, 0.f, 0.f, 0.f};
        unsigned aoff[2][4];
#pragma unroll
        for (int a = 0; a < 2; ++a)
#pragma unroll
            for (int m = 0; m < 4; ++m) aoff[a][m] = (unsigned)S.arow(u, ui, 128 * a + 64 * wr + 16 * m + fr) * (unsigned)g.lda;
        const bf16_t* bb = g.Bt + (size_t)(S.brow0(u) + 32 * wc) * g.ldb;
        const unsigned bl0 = (unsigned)(4 * fq) * (unsigned)g.ldb, bl1 = (unsigned)(8 * fq) * (unsigned)g.ldb;
#pragma unroll 1
        for (int k = 0; k < g.K; k += 2) {
            float af[2][4][2];
#pragma unroll
            for (int a = 0; a < 2; ++a)
#pragma unroll
                for (int m = 0; m < 4; ++m) { const unsigned v = *(const unsigned*)(g.A + aoff[a][m] + k); af[a][m][0] = __uint_as_float(v << 16); af[a][m][1] = __uint_as_float(v & 0xffff0000u); }
#pragma unroll
            for (int b = 0; b < 2; ++b)
#pragma unroll
                for (int n = 0; n < 2; ++n)
#pragma unroll
                    for (int j = 0; j < 4; ++j) {
                        const int ccol = 128 * b + (Epi::PERM ? 4 * n : 16 * n) + j;
                        const unsigned v = *(const unsigned*)(bb + (size_t)ccol * g.ldb + ((Epi::PERM ? bl1 : bl0) + (unsigned)k));
                        const float b0 = __uint_as_float(v << 16), b1 = __uint_as_float(v & 0xffff0000u);
#pragma unroll
                        for (int a = 0; a < 2; ++a)
#pragma unroll
                            for (int m = 0; m < 4; ++m) acc[a][b][m][n][j] = fmaf(af[a][m][1], b1, fmaf(af[a][m][0], b0, acc[a][b][m][n][j]));
                    }
        }
        E(acc, u, wr, wc, fr, fq);
    }
}

namespace pg {
constexpr int BK = 64, HALF = 128, HTB = HALF * BK * 2;
__device__ __forceinline__ int lds_byte(int r, int c) { const int st = (r >> 4) * 2 + (c >> 5), rr = r & 15, cc = c & 31, ob = rr * 64 + cc * 2; return st * 1024 + (ob ^ (((ob >> 9) & 1) << 5)); }
__device__ __forceinline__ void stage_rc(int b, int& R, int& C) { const int st = b / 1024, sb = b % 1024, swz = sb ^ (((sb >> 9) & 1) << 5); R = (st >> 1) * 16 + swz / 64; C = (st & 1) * 32 + (swz % 64) / 2; }
__device__ __forceinline__ int perm32(int rho) { const int n = rho >> 4, i = rho & 15; return 8 * (i >> 2) + 4 * n + (i & 3); }
}
template <class Epi, class Sched, bool ALIGN_EPI>
__device__ __forceinline__ void gemm_phase(LAS unsigned char* lds, const GemmArgs g, const Sched& S, const Epi& E) {
    using namespace pg;
    const int tid = threadIdx.x, wid = __builtin_amdgcn_readfirstlane(tid >> 6), lane = tid & 63, wr = wid >> 2, wc = wid & 3, fr = lane & 15, fq = lane >> 4;
    const int nt = g.K / BK;
    int sR[2], sC[2], sRb[2];
#pragma unroll
    for (int i = 0; i < 2; ++i) { int R, C; stage_rc(tid * 16 + i * 8192, R, C); sR[i] = R; sC[i] = C; sRb[i] = Epi::PERM ? ((R & ~31) + perm32(R & 31)) : R; }
    const unsigned ldsw = (unsigned)wid * 1024u;
    const int aoff = lds_byte(wr * 64 + fr, fq * 8), boff = lds_byte(wc * 32 + fr, fq * 8);
    const char* Ab = (const char*)g.A; const char* Bb = (const char*)g.Bt;
#define PG_SA(b, h) (((b) * 2 + (h)) * HTB)
#define PG_SB(b, h) ((4 + (b) * 2 + (h)) * HTB)
#define PG_STAGE(bufoff, gptr, v0, v1) do { \
        __builtin_amdgcn_global_load_lds((const unsigned*)((gptr) + (v0)), (LAS unsigned*)(lds + (bufoff) + ldsw), 16, 0, 0); \
        __builtin_amdgcn_global_load_lds((const unsigned*)((gptr) + (v1)), (LAS unsigned*)(lds + (bufoff) + ldsw + 8192), 16, 0, 0); } while (0)
#define PG_LDA(dst, b, h) do { _Pragma("unroll") for (int m = 0; m < 4; ++m) _Pragma("unroll") for (int k = 0; k < 2; ++k) dst[m][k] = *(const LAS bf16x8*)(lds + PG_SA(b, h) + aoff + m * 2048 + k * 1024); } while (0)
#define PG_LDB(dst, b, h) do { _Pragma("unroll") for (int n = 0; n < 2; ++n) _Pragma("unroll") for (int k = 0; k < 2; ++k) dst[n][k] = *(const LAS bf16x8*)(lds + PG_SB(b, h) + boff + n * 2048 + k * 1024); } while (0)
#define PG_MMA(ai, bj, At, Bt) do { __builtin_amdgcn_s_setprio(1); _Pragma("unroll") for (int m = 0; m < 4; ++m) _Pragma("unroll") for (int n = 0; n < 2; ++n) _Pragma("unroll") for (int k = 0; k < 2; ++k) \
        acc[ai][bj][m][n] = __builtin_amdgcn_mfma_f32_16x16x32_bf16(Bt[n][k], At[m][k], acc[ai][bj][m][n], 0, 0, 0); __builtin_amdgcn_s_setprio(0); } while (0)
#define PG_WAIT_V(n) asm volatile("s_waitcnt vmcnt(" #n ")" ::: "memory")
#define PG_WAIT_L(n) asm volatile("s_waitcnt lgkmcnt(" #n ")" ::: "memory")
#define PG_BAR __builtin_amdgcn_s_barrier()
#define PG_SCHED __builtin_amdgcn_sched_barrier(0)
    constexpr bool GA = Sched::GATHER;
    unsigned cA[2], cB[2];
#pragma unroll
    for (int i = 0; i < 2; ++i) { cA[i] = ((unsigned)sR[i] * (unsigned)g.lda + (unsigned)sC[i]) * 2u; cB[i] = ((unsigned)sRb[i] * (unsigned)g.ldb + (unsigned)sC[i]) * 2u; }
    const size_t hA = (size_t)128 * g.lda * 2, hB = (size_t)128 * g.ldb * 2;
#define PG_GOFFS(u, uidx, VA) do { if constexpr (GA) { _Pragma("unroll") for (int h = 0; h < 2; ++h) _Pragma("unroll") for (int i = 0; i < 2; ++i) \
        VA[h][i] = ((unsigned)S.arow(u, uidx, 128 * h + sR[i]) * (unsigned)g.lda + (unsigned)sC[i]) * 2u; } } while (0)
#define PG_UA(u) (GA ? (size_t)0 : (size_t)S.arow(u, 0, 0) * g.lda * 2)
#define PG_UB(u) ((size_t)S.brow0(u) * g.ldb * 2)
#define PG_STAGE_A(bufoff, ab, VA, h) do { if constexpr (GA) { PG_STAGE(bufoff, (ab), VA[h][0], VA[h][1]); } else { PG_STAGE(bufoff, (ab) + (h) * hA, cA[0], cA[1]); } } while (0)
#define PG_STAGE_B(bufoff, bb, h) PG_STAGE(bufoff, (bb) + (h) * hB, cB[0], cB[1])
    Unit cur, nxt; int ui = 0;
    if (!S.next(0, cur)) return;
    f32x4 acc[2][2][4][2];
#pragma unroll
    for (int a = 0; a < 2; ++a)
#pragma unroll
        for (int b = 0; b < 2; ++b)
#pragma unroll
            for (int m = 0; m < 4; ++m)
#pragma unroll
                for (int n = 0; n < 2; ++n) acc[a][b][m][n] = (f32x4){0.f, 0.f, 0.f, 0.f};
    bf16x8 At[4][2], B0[2][2], B1[2][2];
    unsigned vA[2][2], nvA[2][2];
    PG_GOFFS(cur, 0, vA);
    const char* cAp = Ab + PG_UA(cur); const char* cBp = Bb + PG_UB(cur);
    PG_STAGE_B(PG_SB(0, 0), cBp, 0); PG_STAGE_B(PG_SB(0, 1), cBp, 1); PG_STAGE_A(PG_SA(0, 0), cAp, vA, 0); PG_STAGE_A(PG_SA(0, 1), cAp, vA, 1);
    if (wr == 1) PG_BAR;
    PG_WAIT_V(2); PG_BAR;
    PG_STAGE_B(PG_SB(1, 0), cBp + 128, 0); PG_STAGE_A(PG_SA(1, 0), cAp + 128, vA, 0); PG_STAGE_B(PG_SB(1, 1), cBp + 128, 1);
    PG_WAIT_V(6); PG_BAR;
    for (;;) {
        const bool has_next = S.next(ui + 1, nxt);
        const char* nAp = cAp; const char* nBp = cBp;
        if (has_next) { PG_GOFFS(nxt, ui + 1, nvA); nAp = Ab + PG_UA(nxt); nBp = Bb + PG_UB(nxt); }
        else { if constexpr (GA) {
#pragma unroll
            for (int h = 0; h < 2; ++h)
#pragma unroll
                for (int i = 0; i < 2; ++i) nvA[h][i] = vA[h][i]; } }
#pragma unroll 1
        for (int t = 0; t < nt; t += 2) {
            const bool last = (t == nt - 2);
            const char* a1 = cAp + (size_t)(t + 1) * 128;
            const char* a2 = last ? nAp : cAp + (size_t)(t + 2) * 128; const char* b2 = last ? nBp : cBp + (size_t)(t + 2) * 128;
            const char* a3 = a2 + 128; const char* b3 = b2 + 128;
            unsigned wA[2][2];
            if constexpr (GA) {
#pragma unroll
                for (int h = 0; h < 2; ++h)
#pragma unroll
                    for (int i = 0; i < 2; ++i) wA[h][i] = last ? nvA[h][i] : vA[h][i]; }
            PG_LDB(B0, 0, 0); PG_LDB(B1, 0, 1); PG_SCHED; PG_LDA(At, 0, 0); PG_STAGE_A(PG_SA(1, 1), a1, vA, 1);
            PG_WAIT_V(8); PG_WAIT_L(0); PG_BAR; PG_MMA(0, 0, At, B0); PG_MMA(0, 1, At, B1); PG_BAR; PG_SCHED;
            PG_LDA(At, 0, 1); PG_STAGE_B(PG_SB(0, 0), b2, 0); PG_STAGE_B(PG_SB(0, 1), b2, 1); PG_STAGE_A(PG_SA(0, 0), a2, wA, 0);
            PG_WAIT_V(8); PG_WAIT_L(0); PG_BAR; PG_MMA(1, 0, At, B0); PG_MMA(1, 1, At, B1); PG_BAR; PG_SCHED;
            PG_LDB(B0, 1, 0); PG_LDB(B1, 1, 1); PG_SCHED; PG_LDA(At, 1, 0); PG_STAGE_A(PG_SA(0, 1), a2, wA, 1);
            PG_WAIT_V(8); PG_WAIT_L(0); PG_BAR; PG_MMA(0, 0, At, B0); PG_MMA(0, 1, At, B1); PG_BAR; PG_SCHED;
            PG_LDA(At, 1, 1); PG_STAGE_B(PG_SB(1, 0), b3, 0); PG_STAGE_B(PG_SB(1, 1), b3, 1); PG_STAGE_A(PG_SA(1, 0), a3, wA, 0);
            PG_WAIT_V(8); PG_WAIT_L(0); PG_BAR; PG_MMA(1, 0, At, B0); PG_MMA(1, 1, At, B1); PG_BAR; PG_SCHED;
        }
        if constexpr (ALIGN_EPI) { if (wr == 0) PG_BAR; }
        E(acc, cur, wr, wc, fr, fq);
        if (!has_next) break;
#pragma unroll
        for (int a = 0; a < 2; ++a)
#pragma unroll
            for (int b = 0; b < 2; ++b)
#pragma unroll
                for (int m = 0; m < 4; ++m)
#pragma unroll
                    for (int n = 0; n < 2; ++n) acc[a][b][m][n] = (f32x4){0.f, 0.f, 0.f, 0.f};
        cur = nxt; ++ui; cAp = nAp; cBp = nBp;
        if constexpr (GA) {
#pragma unroll
            for (int h = 0; h < 2; ++h)
#pragma unroll
                for (int i = 0; i < 2; ++i) vA[h][i] = nvA[h][i]; }
        if constexpr (ALIGN_EPI) { if (wr == 1) PG_BAR; }
    }
    PG_WAIT_V(0);
    if constexpr (!ALIGN_EPI) { if (wr == 0) PG_BAR; }
    PG_BAR;
#undef PG_SA
#undef PG_SB
#undef PG_STAGE
#undef PG_LDA
#undef PG_LDB
#undef PG_MMA
#undef PG_WAIT_V
#undef PG_WAIT_L
#undef PG_BAR
#undef PG_SCHED
#undef PG_GOFFS
#undef PG_UA
#undef PG_UB
#undef PG_STAGE_A
#undef PG_STAGE_B
}

constexpr int ROWTAB_OFF = 132096, ETAB_OFF = ROWTAB_OFF + 12 * 1024, MAXU = 12;
struct DenseSched {
    static constexpr bool GATHER = false;
    int nN, nunits, G, c;
    __device__ __forceinline__ void init(LAS unsigned char*, int M, int N, int G_, int c_) { nN = N / 256; nunits = (M / 256) * nN; G = G_; c = c_; }
    __device__ __forceinline__ bool next(int i, Unit& u) const { const int L = i * G + c; if (L >= nunits) return false; u.pm = L / nN; u.pn = L % nN; u.e = 0; return true; }
    __device__ __forceinline__ int arow(const Unit& u, int, int r) const { return 256 * u.pm + r; }
    __device__ __forceinline__ int brow0(const Unit& u) const { return 256 * u.pn; }
};
template <bool GATHER_> struct GroupSched {
    static constexpr bool GATHER = GATHER_;
    LAS int* rowtab; LAS int* etab; int nN, nexp_rows, nunits, G, c;
    __device__ __forceinline__ void init(LAS unsigned char* lds, const int* te, const int* rt, int nN_, int nexp_rows_, int G_, int c_) {
        rowtab = (LAS int*)(lds + ROWTAB_OFF); etab = (LAS int*)(lds + ETAB_OFF); nN = nN_; nexp_rows = nexp_rows_; G = G_; c = c_;
        nunits = __builtin_amdgcn_readfirstlane(te[MAXTILES]) * nN_;
        for (int i = 0; i < MAXU; ++i) { const int L = i * G + c; if (L >= nunits) break; const int pm = L / nN;
            if (threadIdx.x == 0) etab[i] = te[pm];
            if (GATHER && threadIdx.x < 256) rowtab[i * 256 + threadIdx.x] = rt[256 * pm + threadIdx.x]; }
        __syncthreads();
    }
    __device__ __forceinline__ bool next(int i, Unit& u) const { const int L = i * G + c; if (L >= nunits || i >= MAXU) return false; u.pm = L / nN; u.pn = L % nN; u.e = etab[i]; return true; }
    __device__ __forceinline__ int arow(const Unit& u, int ui, int r) const { return GATHER ? rowtab[ui * 256 + r] : 256 * u.pm + r; }
    __device__ __forceinline__ int brow0(const Unit& u) const { return u.e * nexp_rows + 256 * u.pn; }
};

struct EpiProj {
    static constexpr bool PERM = false;
    unsigned char* ws;
    __device__ __forceinline__ void operator()(const f32x4 (&acc)[2][2][4][2], const Unit& u, int wr, int wc, int fr, int fq) const {
        asm volatile("" : "+v"(fr), "+v"(fq));
        bf16_t* LAT = (bf16_t*)(ws + WS_LAT); bf16_t* KM = (bf16_t*)(ws + WS_KM); bf16_t* QB = (bf16_t*)(ws + WS_QB); bf16_t* KB = (bf16_t*)(ws + WS_KB); bf16_t* VB = (bf16_t*)(ws + WS_VB);
        float* rstdp = (float*)(ws + WS_RSTDP); float* kmeanp = (float*)(ws + WS_KMEANP);
        const float* ropeA = (const float*)(ws + WS_ROPEA); const float* ropeB = (const float*)(ws + WS_ROPEB);
#pragma unroll
        for (int b = 0; b < 2; ++b) {
            const int g = 8 * u.pn + 4 * b + wc;
            if (g < 12) {
#pragma unroll
                for (int a = 0; a < 2; ++a)
#pragma unroll
                    for (int m = 0; m < 4; ++m) { const int row = 256 * u.pm + 128 * a + 64 * wr + 16 * m + fr; const f32x4 v0 = acc[a][b][m][0], v1 = acc[a][b][m][1];
                        u32x2 w0, w1; w0.x = pk2(v0[0], v0[1]); w0.y = pk2(v0[2], v0[3]); w1.x = pk2(v1[0], v1[1]); w1.y = pk2(v1[2], v1[3]);
                        bf16_t* lp = LAT + (size_t)row * 384 + g * 32 + 4 * fq; *(u32x2*)lp = w0; *(u32x2*)(lp + 16) = w1;
                        float ss = 0.f;
#pragma unroll
                        for (int k = 0; k < 2; ++k) { const float e0 = __uint_as_float(w0[k] << 16), e1 = __uint_as_float(w0[k] & 0xffff0000u), e2 = __uint_as_float(w1[k] << 16), e3 = __uint_as_float(w1[k] & 0xffff0000u);
                            ss += (e0 * e0 + e1 * e1) + (e2 * e2 + e3 * e3); }
                        ss += __shfl_xor(ss, 16); ss += __shfl_xor(ss, 32);
                        if (fq == 0) rstdp[(size_t)row * 12 + g] = ss; }
            } else if (g == 12) {
#pragma unroll
                for (int a = 0; a < 2; ++a)
#pragma unroll
                    for (int m = 0; m < 4; ++m) { const int row = 256 * u.pm + 128 * a + 64 * wr + 16 * m + fr; const f32x4 x1 = acc[a][b][m][0], x2 = acc[a][b][m][1];
                        const f32x4 c = *(const f32x4*)(ropeA + (size_t)row * 32 + 4 * fq), sn = *(const f32x4*)(ropeA + (size_t)row * 32 + 16 + 4 * fq);
                        const f32x4 o1 = x1 * c - x2 * sn, o2 = x2 * c + x1 * sn;
                        u32x2 w0, w1; w0.x = pk2(o1[0], o1[1]); w0.y = pk2(o1[2], o1[3]); w1.x = pk2(o2[0], o2[1]); w1.y = pk2(o2[2], o2[3]);
#pragma unroll
                        for (int h = 0; h < 8; ++h) { bf16_t* kp = KM + (size_t)row * 768 + h * 96 + 64 + 4 * fq; *(u32x2*)kp = w0; *(u32x2*)(kp + 16) = w1; } }
            } else if (g < 45) {
                const bool isk = g >= 29; const int rel = isk ? g - 29 : g - 13, head = rel >> 1, hf = rel & 1;
                bf16_t* dst = (isk ? KB : QB) + head * 64 + hf * 32 + 4 * fq;
                f32x4 cs0 = (f32x4){0.f, 0.f, 0.f, 0.f}, cs1 = cs0;
#pragma unroll
                for (int a = 0; a < 2; ++a)
#pragma unroll
                    for (int m = 0; m < 4; ++m) { const int row = 256 * u.pm + 128 * a + 64 * wr + 16 * m + fr; f32x4 v0 = acc[a][b][m][0]; const f32x4 v1 = acc[a][b][m][1];
                        if (hf == 0) { const f32x4 c = *(const f32x4*)(ropeB + (size_t)row * 16 + 4 * (fq & 1)), sn = *(const f32x4*)(ropeB + (size_t)row * 16 + 8 + 4 * (fq & 1));
                            f32x4 pv;
#pragma unroll
                            for (int j = 0; j < 4; ++j) { auto rr = __builtin_amdgcn_permlane32_swap(__float_as_uint(v0[j]), __float_as_uint(v0[j]), false, false); pv[j] = __uint_as_float(fq < 2 ? rr[1] : rr[0]); }
                            v0 = (fq < 2) ? (v0 * c - pv * sn) : (v0 * c + pv * sn); }
                        if (isk) { cs0 += v0; cs1 += v1; }
                        const f32x4 s0 = isk ? v0 : v0 * C2B, s1 = isk ? v1 : v1 * C2B;
                        u32x2 w0, w1; w0.x = pk2(s0[0], s0[1]); w0.y = pk2(s0[2], s0[3]); w1.x = pk2(s1[0], s1[1]); w1.y = pk2(s1[2], s1[3]);
                        bf16_t* dp = dst + (size_t)row * 512; *(u32x2*)dp = w0; *(u32x2*)(dp + 16) = w1; }
                if (isk) {
#pragma unroll
                    for (int j = 0; j < 4; ++j) {
#pragma unroll
                        for (int o = 1; o < 16; o <<= 1) { cs0[j] += __shfl_xor(cs0[j], o); cs1[j] += __shfl_xor(cs1[j], o); } }
                    if (fr == 0) { float* kp = kmeanp + ((size_t)u.pm * 2 + wr) * 512 + head * 64 + hf * 32 + 4 * fq; *(f32x4*)kp = cs0; *(f32x4*)(kp + 16) = cs1; } }
            } else if (g < 61) {
                const int rel = g - 45;
#pragma unroll
                for (int a = 0; a < 2; ++a)
#pragma unroll
                    for (int m = 0; m < 4; ++m) { const int row = 256 * u.pm + 128 * a + 64 * wr + 16 * m + fr; const f32x4 v0 = acc[a][b][m][0], v1 = acc[a][b][m][1];
                        u32x2 w0, w1; w0.x = pk2(v0[0], v0[1]); w0.y = pk2(v0[2], v0[3]); w1.x = pk2(v1[0], v1[1]); w1.y = pk2(v1[2], v1[3]);
                        bf16_t* dp = VB + (size_t)row * 512 + rel * 32 + 4 * fq; *(u32x2*)dp = w0; *(u32x2*)(dp + 16) = w1; }
            }
            asm volatile("" ::: "memory");
        }
    }
};
struct EpiUp {
    static constexpr bool PERM = false;
    bf16_t *QM, *KM, *VM; const float* rstd; const float* ropeA;
    __device__ __forceinline__ void operator()(const f32x4 (&acc)[2][2][4][2], const Unit& u, int wr, int wc, int fr, int fq) const {
        asm volatile("" : "+v"(fr), "+v"(fq));
#pragma unroll
        for (int a = 0; a < 2; ++a)
#pragma unroll
            for (int m = 0; m < 4; ++m) { const int row = 256 * u.pm + 128 * a + 64 * wr + 16 * m + fr;
                const f32x4 s0 = *(const f32x4*)(rstd + (size_t)row * 12), s1 = *(const f32x4*)(rstd + (size_t)row * 12 + 4), s2 = *(const f32x4*)(rstd + (size_t)row * 12 + 8);
                const float rq = C2A / sqrtf((((s0[0] + s0[1]) + (s0[2] + s0[3])) + ((s1[0] + s1[1]) + (s1[2] + s1[3]))) * (1.0f / 256.0f) + RMS_EPS);
                const float rkv = 1.0f / sqrtf(((s2[0] + s2[1]) + (s2[2] + s2[3])) * (1.0f / 128.0f) + RMS_EPS);
#pragma unroll
                for (int b = 0; b < 2; ++b) {
                    const int gidx = 8 * u.pn + 4 * b + wc;
                    if (gidx < 24) {
                        const int h = gidx / 3, part = gidx % 3;
                        f32x4 v0 = acc[a][b][m][0] * rq, v1 = acc[a][b][m][1] * rq;
                        if (part == 2) { const f32x4 c = *(const f32x4*)(ropeA + (size_t)row * 32 + 4 * fq), s = *(const f32x4*)(ropeA + (size_t)row * 32 + 16 + 4 * fq);
                            const f32x4 o0 = v0 * c - v1 * s, o1 = v1 * c + v0 * s; v0 = o0; v1 = o1; }
                        bf16_t* p = QM + (size_t)row * 768 + h * 96 + part * 32 + 4 * fq;
                        u32x2 w; w.x = pk2(v0[0], v0[1]); w.y = pk2(v0[2], v0[3]); *(u32x2*)p = w;
                        w.x = pk2(v1[0], v1[1]); w.y = pk2(v1[2], v1[3]); *(u32x2*)(p + 16) = w;
                    } else {
                        const int g2 = gidx - 24, h = g2 >> 2, part = g2 & 3;
                        const f32x4 v0 = acc[a][b][m][0] * rkv, v1 = acc[a][b][m][1] * rkv;
                        bf16_t* p = (part < 2) ? (KM + (size_t)row * 768 + h * 96 + part * 32 + 4 * fq) : (VM + (size_t)row * 512 + h * 64 + (part - 2) * 32 + 4 * fq);
                        u32x2 w; w.x = pk2(v0[0], v0[1]); w.y = pk2(v0[2], v0[3]); *(u32x2*)p = w;
                        w.x = pk2(v1[0], v1[1]); w.y = pk2(v1[2], v1[3]); *(u32x2*)(p + 16) = w;
                    }
                }
                asm volatile("" ::: "memory"); }
    }
};
struct EpiWo {
    static constexpr bool PERM = false;
    const float* x; float* O;
    __device__ __forceinline__ void operator()(const f32x4 (&acc)[2][2][4][2], const Unit& u, int wr, int wc, int fr, int fq) const {
        asm volatile("" : "+v"(fr), "+v"(fq));
#pragma unroll
        for (int a = 0; a < 2; ++a)
#pragma unroll
            for (int m = 0; m < 4; ++m) { const int row = 256 * u.pm + 128 * a + 64 * wr + 16 * m + fr;
#pragma unroll
                for (int b = 0; b < 2; ++b)
#pragma unroll
                    for (int n = 0; n < 2; ++n) { const size_t off = (size_t)row * DM + 256 * u.pn + ecol<PERM>(b, n, wc, fq);
                        const f32x4 xv = *(const f32x4*)(x + off); *(f32x4*)(O + off) = xv * DN_ALPHA + acc[a][b][m][n]; } }
    }
};
struct EpiGateUp {
    static constexpr bool PERM = false;
    bf16_t* H; const float *bg, *bu;
    __device__ __forceinline__ void operator()(const f32x4 (&acc)[2][2][4][2], const Unit& u, int wr, int wc, int fr, int fq) const {
        asm volatile("" : "+v"(fr), "+v"(fq));
#pragma unroll
        for (int n = 0; n < 2; ++n) { const int hc = 128 * u.pn + 32 * wc + 16 * n + 4 * fq;
            const f32x4 vbg = *(const f32x4*)(bg + (size_t)u.e * 1024 + hc), vbu = *(const f32x4*)(bu + (size_t)u.e * 1024 + hc);
#pragma unroll
            for (int a = 0; a < 2; ++a)
#pragma unroll
                for (int m = 0; m < 4; ++m) { const int row = 256 * u.pm + 128 * a + 64 * wr + 16 * m + fr;
                    const f32x4 gv = acc[a][0][m][n] + vbg, uv = acc[a][1][m][n] + vbu; float hv[4];
#pragma unroll
                    for (int j = 0; j < 4; ++j) { const float gg = fminf(gv[j], 7.0f), uu = fminf(fmaxf(uv[j], -7.0f), 7.0f);
                        const float sg = 1.0f / (1.0f + __builtin_amdgcn_exp2f(-1.702f * LOG2E * gg)); hv[j] = gg * sg * (uu + 1.0f); }
                    u32x2 w; w.x = pk2(hv[0], hv[1]); w.y = pk2(hv[2], hv[3]); *(u32x2*)(H + (size_t)row * 1024 + hc) = w; } }
    }
};
struct EpiDown {
    static constexpr bool PERM = false;
    bf16_t* Y; const float* bd; const float* row_gate;
    __device__ __forceinline__ void operator()(const f32x4 (&acc)[2][2][4][2], const Unit& u, int wr, int wc, int fr, int fq) const {
        asm volatile("" : "+v"(fr), "+v"(fq));
#pragma unroll
        for (int a = 0; a < 2; ++a)
#pragma unroll
            for (int m = 0; m < 4; ++m) { const int row = 256 * u.pm + 128 * a + 64 * wr + 16 * m + fr; const float gw = row_gate[row];
#pragma unroll
                for (int b = 0; b < 2; ++b)
#pragma unroll
                    for (int n = 0; n < 2; ++n) { const int col = 256 * u.pn + ecol<PERM>(b, n, wc, fq); const f32x4 bv = *(const f32x4*)(bd + (size_t)u.e * 1024 + col);
                        const f32x4 v = (acc[a][b][m][n] + bv) * gw; u32x2 w; w.x = pk2(v[0], v[1]); w.y = pk2(v[2], v[3]); *(u32x2*)(Y + (size_t)row * 1024 + col) = w; } }
    }
};

__device__ __forceinline__ unsigned cvtpk_hw(float lo, float hi) { typedef __bf16 bf2 __attribute__((ext_vector_type(2))); f32x2 v = {lo, hi}; bf2 b = __builtin_convertvector(v, bf2); return __builtin_bit_cast(unsigned, b); }
__device__ __forceinline__ void conv_issue(const float* W, int ldw, int k0, int n0, LAS unsigned char* scr, int lane) {
#pragma unroll
    for (int i = 0; i < 4; ++i) __builtin_amdgcn_global_load_lds((const unsigned*)(W + (size_t)(k0 + 4 * (lane >> 3) + i) * ldw + n0 + 4 * (lane & 7)), (LAS unsigned*)(scr + i * 1024), 16, 0, 2);
}
__device__ __forceinline__ void conv_finish(bf16_t* WT, int ldt, int orow0, int ocol0, const LAS unsigned char* scr, int lane) {
    f32x4 r[4];
#pragma unroll
    for (int i = 0; i < 4; ++i) r[i] = *(const LAS f32x4*)(scr + i * 1024 + lane * 16);
#pragma unroll
    for (int j = 0; j < 4; ++j) { u32x2 o; o.x = cvtpk_hw(r[0][j], r[1][j]); o.y = cvtpk_hw(r[2][j], r[3][j]);
        *(u32x2*)(WT + (size_t)(orow0 + 4 * (lane & 7) + j) * ldt + ocol0 + 4 * (lane >> 3)) = o; }
}
constexpr int NEXP_ITEMS = 3 * NE * 1024;
__device__ __forceinline__ void expert_issue(const Params& p, int r, LAS unsigned char* scr, int lane) {
    const int mat = r >> 15, rr = r & 32767, e = rr >> 10, q = rr & 1023, kb = (q & 1) | ((q >> 6) << 1), nb = (q >> 1) & 31;
    const float* W = (mat == 0 ? p.w_gate : mat == 1 ? p.w_up : p.w_down) + (size_t)e * 1048576;
    conv_issue(W, 1024, 32 * kb, 32 * nb, scr, lane);
}
__device__ __forceinline__ void expert_finish(const Params& p, int r, const LAS unsigned char* scr, int lane) {
    const int mat = r >> 15, rr = r & 32767, e = rr >> 10, q = rr & 1023, kb = (q & 1) | ((q >> 6) << 1), nb = (q >> 1) & 31, n0 = 32 * nb;
    bf16_t* WguT = (bf16_t*)(p.ws + WS_WGU); bf16_t* WdT = (bf16_t*)(p.ws + WS_WD);
    if (mat == 2) conv_finish(WdT, 1024, e * 1024 + n0, 32 * kb, scr, lane);
    else conv_finish(WguT, 1024, e * 2048 + (n0 >> 7) * 256 + (mat == 1 ? 128 : 0) + (n0 & 127), 32 * kb, scr, lane);
}
struct BgConv { int next, stride, pend0, pend1, itc; };

__device__ __forceinline__ void tr_item(const float* W, int ldw, int k0, int n0, bf16_t* WT, int ldt, int orow0, int ocol0, const float* kscale, LAS float* scr, int lane) {
#pragma unroll 8
    for (int i = 0; i < 32; ++i) { const int kk = 2 * i + (lane >> 5); float v = W[(size_t)(k0 + kk) * ldw + n0 + (lane & 31)]; if (kscale) v *= kscale[k0 + kk]; scr[kk * 33 + (lane & 31)] = v; }
    asm volatile("s_waitcnt lgkmcnt(0)" ::: "memory");
    const int c = lane & 7;
#pragma unroll
    for (int j = 0; j < 4; ++j) { const int n = (lane >> 3) + 8 * j; const LAS float* s = scr + (8 * c) * 33 + n;
        u32x4 o; o.x = pk2(s[0 * 33], s[1 * 33]); o.y = pk2(s[2 * 33], s[3 * 33]); o.z = pk2(s[4 * 33], s[5 * 33]); o.w = pk2(s[6 * 33], s[7 * 33]);
        *(u32x4*)(WT + (size_t)(orow0 + n) * ldt + ocol0 + 8 * c) = o; }
    asm volatile("s_waitcnt lgkmcnt(0)" ::: "memory");
}
__device__ __forceinline__ void phase_prologue(const Params& p, LAS unsigned char* lds, int vcu, int G) {
    const int tid = threadIdx.x, wave = tid >> 6, lane = tid & 63;
    unsigned char* ws = p.ws;
    LAS float* scr = (LAS float*)(lds + wave * 16384);
    const int gw = vcu * NWAVES + wave, NGW = G * NWAVES;
    bf16_t* WinT = (bf16_t*)(ws + WS_WIN); bf16_t* WoT = (bf16_t*)(ws + WS_WO); bf16_t* WupT = (bf16_t*)(ws + WS_WUP);
    constexpr int I_IN = 16 * 61, I_QB = 4 * 24, I_KVB = 2 * 32, I_O = 16 * 32;
    constexpr int NITEMS = I_IN + I_QB + I_KVB + I_O;
    for (int it = gw; it < NITEMS; it += NGW) {
        int r = it;
        if (r < I_IN) { const int kb = r / 61, nb = r % 61; tr_item(p.w_in, IN_COLS, 64 * kb, 32 * nb, WinT, 1024, 32 * nb, 64 * kb, nullptr, scr, lane); continue; } r -= I_IN;
        if (r < I_QB) { const int kb = r / 24, nb = r % 24; tr_item(p.w_q_b, 768, 64 * kb, 32 * nb, WupT, KUP, 32 * nb, 64 * kb, p.q_a_norm, scr, lane); continue; } r -= I_QB;
        if (r < I_KVB) { const int kb = r / 32, nb = r % 32; tr_item(p.w_kv_b, 1024, 64 * kb, 32 * nb, WupT, KUP, 768 + 32 * nb, 256 + 64 * kb, p.kv_a_norm, scr, lane); continue; } r -= I_KVB;
        { const int kb = r / 32, nb = r % 32; tr_item(p.w_o, 1024, 64 * kb, 32 * nb, WoT, 1024, 32 * nb, 64 * kb, nullptr, scr, lane); }
    }
    const int gt = vcu * NTHREADS + tid, NGT = G * NTHREADS;
    for (int i = gt; i < 96 * 128; i += NGT) *(u32x4*)(WinT + (size_t)IN_COLS * 1024 + (size_t)i * 8) = (u32x4){0u, 0u, 0u, 0u};
    for (int i = gt; i < 768 * 16; i += NGT) { const int r = i / 16, c = i % 16; *(u32x4*)(WupT + (size_t)r * KUP + 256 + c * 8) = (u32x4){0u, 0u, 0u, 0u}; }
    for (int i = gt; i < 1024 * 32; i += NGT) { const int r = i / 32, c = i % 32; *(u32x4*)(WupT + (size_t)(768 + r) * KUP + c * 8) = (u32x4){0u, 0u, 0u, 0u}; }
    bf16_t* XB = (bf16_t*)(ws + WS_XB);
    for (int i = gt; i < NTOK * DM / 8; i += NGT) { const f32x4 a = *(const f32x4*)(p.x + (size_t)i * 8), b = *(const f32x4*)(p.x + (size_t)i * 8 + 4);
        u32x4 o; o.x = pk2(a[0], a[1]); o.y = pk2(a[2], a[3]); o.z = pk2(b[0], b[1]); o.w = pk2(b[2], b[3]); *(u32x4*)(XB + (size_t)i * 8) = o; }
    { float* WRL = (float*)(ws + WS_WRL);
      for (int n = gt; n < 32768; n += NGT) { const int e = ((n >> 8) & 7) * 4 + (n & 3), ln = (n >> 2) & 63, ji = n >> 11, j = ji >> 2, i = ji & 3; WRL[n] = p.w_router[(size_t)(4 * ln + 256 * j + i) * 32 + e]; } }
    float* ropeA = (float*)(ws + WS_ROPEA); float* ropeB = (float*)(ws + WS_ROPEB);
    for (int i = gt; i < NTOK * 24; i += NGT) { const int tok = i / 24, j = i % 24; const double f = (j < 16) ? p.invfA[j] : p.invfB[j - 16];
        const double rev = (double)p.pos[tok] * f * 0.15915494309189535; const float fr = (float)(rev - __builtin_rint(rev));
        const float cs = __builtin_amdgcn_cosf(fr), sn = __builtin_amdgcn_sinf(fr);
        if (j < 16) { ropeA[(size_t)tok * 32 + j] = cs; ropeA[(size_t)tok * 32 + 16 + j] = sn; } else { ropeB[(size_t)tok * 16 + (j - 16)] = cs; ropeB[(size_t)tok * 16 + 8 + (j - 16)] = sn; } }
}

__device__ __forceinline__ void phase_prep(const Params& p, LAS unsigned char* lds, int vcu, int G) {
    const int tid = threadIdx.x, wave = tid >> 6, lane = tid & 63;
    unsigned char* ws = p.ws;
    const bf16_t* PROJ = (const bf16_t*)(ws + WS_PROJ);
    float* rstd = (float*)(ws + WS_RSTD); const float* ropeA = (const float*)(ws + WS_ROPEA); const float* ropeB = (const float*)(ws + WS_ROPEB);
    bf16_t* KM = (bf16_t*)(ws + WS_KM); bf16_t* QB = (bf16_t*)(ws + WS_QB); bf16_t* KB = (bf16_t*)(ws + WS_KB); float* kmean = (float*)(ws + WS_KMEAN);
    const int gw = vcu * NWAVES + wave, NGW = G * NWAVES;
    for (int row = gw; row < NTOK; row += NGW) {
        float s = 0.f;
        if (lane < 48) { const u32x4 v = *(const u32x4*)(PROJ + (size_t)row * PN + lane * 8);
#pragma unroll
            for (int q = 0; q < 4; ++q) { const float a = __uint_as_float(v[q] << 16), b = __uint_as_float(v[q] & 0xffff0000u); s += a * a + b * b; } }
#pragma unroll
        for (int o = 1; o < 32; o <<= 1) s += __shfl_xor(s, o);
        if (lane == 0) rstd[2 * row] = 1.0f / sqrtf(s * (1.0f / 256.0f) + RMS_EPS);
        if (lane == 32) rstd[2 * row + 1] = 1.0f / sqrtf(s * (1.0f / 128.0f) + RMS_EPS);
    }
    const int gt = vcu * NTHREADS + tid, NGT = G * NTHREADS;
    for (int i = gt; i < NTOK * 16; i += NGT) { const int tok = i >> 4, j = i & 15;
        const float x1 = bf2f(PROJ[(size_t)tok * PN + C_KR + j]), x2 = bf2f(PROJ[(size_t)tok * PN + C_KR + 16 + j]);
        const float c = ropeA[(size_t)tok * 32 + j], s = ropeA[(size_t)tok * 32 + 16 + j];
        const bf16_t o1 = (bf16_t)f2bf(x1 * c - x2 * s), o2 = (bf16_t)f2bf(x2 * c + x1 * s);
#pragma unroll
        for (int h = 0; h < 8; ++h) { KM[(size_t)tok * 768 + h * 96 + 64 + j] = o1; KM[(size_t)tok * 768 + h * 96 + 80 + j] = o2; } }
    LAS float* red = (LAS float*)lds;
    for (int unit = vcu; unit < 512; unit += G) {
        const int ub = unit >> 3, h = unit & 7, tg = tid >> 6, d = tid & 63, c = h * 64 + d; float ksum = 0.f;
#pragma unroll 4
        for (int i = 0; i < 32; ++i) { const int tok = ub * 256 + tg * 32 + i; const bf16_t* pr = PROJ + (size_t)tok * PN;
            float qv = bf2f(pr[C_MQ + c]), kv = bf2f(pr[C_MK + c]);
            if (d < 16) { const int j = d & 7; const float cs = ropeB[(size_t)tok * 16 + j], sn = ropeB[(size_t)tok * 16 + 8 + j];
                if (d < 8) { const float q2 = bf2f(pr[C_MQ + c + 8]), k2 = bf2f(pr[C_MK + c + 8]); qv = qv * cs - q2 * sn; kv = kv * cs - k2 * sn; }
                else { const float q1 = bf2f(pr[C_MQ + c - 8]), k1 = bf2f(pr[C_MK + c - 8]); qv = qv * cs + q1 * sn; kv = kv * cs + k1 * sn; } }
            QB[(size_t)tok * 512 + c] = (bf16_t)f2bf(qv * C2B); KB[(size_t)tok * 512 + c] = (bf16_t)f2bf(kv); ksum += kv; }
        red[tg * 64 + d] = ksum;
        __syncthreads();
        if (tid < 64) { float t = 0.f;
#pragma unroll
            for (int g8 = 0; g8 < 8; ++g8) t += red[g8 * 64 + tid];
            kmean[(size_t)ub * 512 + h * 64 + tid] = t * (1.0f / 256.0f); }
        __syncthreads();
    }
}

typedef float f32x16 __attribute__((ext_vector_type(16)));
typedef short s16x4 __attribute__((ext_vector_type(4)));
namespace fa {
constexpr int KBUF = 12288, VBUF = 8192, VOFF = 3 * KBUF, WS_OFF = VOFF + 3 * VBUF, LDS_NEED = WS_OFF + 8 * 256;
__device__ __forceinline__ void wait_vm(int n) {
    switch (n) {
#define FA_W(k) case k: asm volatile("s_waitcnt vmcnt(" #k ")" ::: "memory"); break;
        FA_W(0) FA_W(1) FA_W(2) FA_W(3) FA_W(4) FA_W(5) FA_W(6) FA_W(7) FA_W(8) FA_W(9) FA_W(10) FA_W(11) FA_W(12) FA_W(13) FA_W(14) FA_W(15)
#undef FA_W
        default: asm volatile("s_waitcnt vmcnt(15)" ::: "memory"); break; }
}
constexpr float THR = 8.0f;
__device__ __forceinline__ int crow(int r, int hi) { return (r & 3) + 8 * (r >> 2) + 4 * hi; }
__device__ __forceinline__ unsigned cvtpk(float lo, float hi) { typedef __bf16 bf2 __attribute__((ext_vector_type(2))); f32x2 v = {lo, hi}; bf2 b = __builtin_convertvector(v, bf2); return __builtin_bit_cast(unsigned, b); }
__device__ __forceinline__ float xhalf_max(float m) { auto rr = __builtin_amdgcn_permlane32_swap(__float_as_uint(m), __float_as_uint(m), false, false); return fmaxf(__uint_as_float(rr[0]), __uint_as_float(rr[1])); }
__device__ __forceinline__ float xhalf_sum(float m) { auto rr = __builtin_amdgcn_permlane32_swap(__float_as_uint(m), __float_as_uint(m), false, false); return __uint_as_float(rr[0]) + __uint_as_float(rr[1]); }
__device__ __forceinline__ float mx3(float a, float b, float c) { return __builtin_fmaxf(__builtin_fmaxf(a, b), c); }
}
template <int DQK>
__device__ __forceinline__ void attn_unit(LAS unsigned char* lds, const bf16_t* Q, int qpitch, const bf16_t* K, int kpitch, const bf16_t* V, int vpitch, bf16_t* O, int qb, const float* kmean, const Params& p, BgConv& bg) {
    using namespace fa;
    constexpr int ND = DQK / 16, NCH = DQK / 8;
    const int tid = threadIdx.x, lane = tid & 63, r32 = lane & 31, hi = lane >> 5, wid = __builtin_amdgcn_readfirstlane(tid >> 6);
    const int q0 = qb * 256, qrel = wid * 32 + r32;
    LAS float* wsf = (LAS float*)(lds + WS_OFF) + wid * 64;
    bf16x8 qr[ND];
#pragma unroll
    for (int d0 = 0; d0 < ND; ++d0) qr[d0] = *(const bf16x8*)(Q + (size_t)(q0 + qrel) * qpitch + d0 * 16 + hi * 8);
    unsigned sel = 0xffu;
    if (kmean) {
        float gt[8];
#pragma unroll
        for (int n = 0; n < 8; ++n) gt[n] = -INFINITY;
#pragma unroll 1
        for (int n = 0; n < qb; ++n) { float s = 0.f; const float* km = kmean + (size_t)n * 1024;
#pragma unroll
            for (int d0 = 0; d0 < ND; ++d0) { const f32x4 k0 = *(const f32x4*)(km + d0 * 16 + hi * 8) + *(const f32x4*)(km + 512 + d0 * 16 + hi * 8), k1 = *(const f32x4*)(km + d0 * 16 + hi * 8 + 4) + *(const f32x4*)(km + 512 + d0 * 16 + hi * 8 + 4);
#pragma unroll
                for (int j = 0; j < 4; ++j) { s = fmaf(bf2f((unsigned short)qr[d0][j]), k0[j], s); s = fmaf(bf2f((unsigned short)qr[d0][4 + j]), k1[j], s); } }
            s = xhalf_sum(s);
#pragma unroll
            for (int j = 0; j < 8; ++j) gt[j] = (j == n) ? s : gt[j]; }
        sel = 0u;
#pragma unroll
        for (int n = 0; n < 8; ++n) { int cnt = 0;
#pragma unroll
            for (int n2 = 0; n2 < 8; ++n2) if (n2 != n) cnt += (n2 < qb && (gt[n2] > gt[n] || (gt[n2] == gt[n] && n2 < n))) ? 1 : 0;
            if (n < qb && cnt < 3) sel |= 1u << n; }
    }
    const bf16_t* ksrc = K + (size_t)lane * kpitch;
    const bf16_t* vsrc = V + (size_t)(16 * (wid & 3) + (lane >> 2)) * vpitch + (wid >> 2) * 32 + (lane & 3) * 8;
#define FA_DMA(ti, kslot, vslot) do { \
        __builtin_amdgcn_global_load_lds((const unsigned*)(ksrc + (size_t)(ti) * 64 * kpitch + wid * 8), (LAS unsigned*)(lds + (kslot) * KBUF + wid * 1024), 16, 0, 0); \
        if (NCH > 8 && wid < NCH - 8) __builtin_amdgcn_global_load_lds((const unsigned*)(ksrc + (size_t)(ti) * 64 * kpitch + (wid + 8) * 8), (LAS unsigned*)(lds + (kslot) * KBUF + (wid + 8) * 1024), 16, 0, 0); \
        __builtin_amdgcn_global_load_lds((const unsigned*)(vsrc + (size_t)(ti) * 64 * vpitch), (LAS unsigned*)(lds + VOFF + (vslot) * VBUF + wid * 1024), 16, 0, 0); } while (0)
#define FA_TILE(i) (((i) < 4) ? 4 * qb + (i) : (i) - 4)
#define FA_PV(vslot) do { const LAS unsigned char* vb_ = lds + VOFF + (vslot) * VBUF + voff; \
        _Pragma("unroll") for (int d0 = 0; d0 < 2; ++d0) _Pragma("unroll") for (int s_ = 0; s_ < 4; ++s_) { \
            const s16x4 lo_ = __builtin_bit_cast(s16x4, __builtin_amdgcn_ds_read_tr16_b64_v4i16((LAS s16x4*)(vb_ + d0 * 4096 + s_ * 1024))); \
            const s16x4 hh_ = __builtin_bit_cast(s16x4, __builtin_amdgcn_ds_read_tr16_b64_v4i16((LAS s16x4*)(vb_ + d0 * 4096 + s_ * 1024 + 512))); \
            const bf16x8 vf_ = (bf16x8){lo_[0], lo_[1], lo_[2], lo_[3], hh_[0], hh_[1], hh_[2], hh_[3]}; \
            o[d0] = __builtin_amdgcn_mfma_f32_32x32x16_bf16(__builtin_bit_cast(bf16x8, pw[s_]), vf_, o[d0], 0, 0, 0); } } while (0)
    const int NT = 4 * qb + 4;
    float mhat = 0.f, l_reg = 0.f; f32x16 o[2]; o[0] = f32x16{}; o[1] = f32x16{}; f32x16 negm = f32x16{};
    const int koff = hi * 1024 + r32 * 16;
    const int voff = ((lane >> 4) & 1) * 32 + (lane & 3) * 8 + (4 * hi + ((lane & 15) >> 2)) * 64;
    u32x4 pw[4];
    const int nkv = (NCH > 8 && wid < NCH - 8) ? 3 : 2;
    FA_DMA(FA_TILE(0), 0, 0);
    if (NT > 1) { FA_DMA(FA_TILE(1), 1, 1); }
    wait_vm(NT > 1 ? nkv : 0); asm volatile("s_waitcnt lgkmcnt(0)" ::: "memory"); __builtin_amdgcn_s_barrier(); asm volatile("" ::: "memory");
    int sl = 0, prevB = 0, opsPrev = 0;
    for (int i = 0; i < NT; ++i) {
        const int sl1 = (sl == 2) ? 0 : sl + 1, sl2 = (sl1 == 2) ? 0 : sl1 + 1;
        LAS unsigned char* bscr = lds + LDS_NEED + wid * 8192 + (bg.itc & 1) * 4096;
        int young = prevB, ops = 0;
        if (bg.itc & 1) { if (bg.pend1 >= 0) { wait_vm(opsPrev); expert_finish(p, bg.pend1, bscr, lane); bg.pend1 = -1; ops += 4; asm volatile("s_waitcnt lgkmcnt(0)" ::: "memory"); } }
        else            { if (bg.pend0 >= 0) { wait_vm(opsPrev); expert_finish(p, bg.pend0, bscr, lane); bg.pend0 = -1; ops += 4; asm volatile("s_waitcnt lgkmcnt(0)" ::: "memory"); } }
        if (i + 2 < NT) { const int tn = FA_TILE(i + 2); FA_DMA(tn, sl2, sl2); ops += nkv; }
        const bool bgdo = (bg.itc % 3 != 2) && bg.next < NEXP_ITEMS;
        if (bgdo) { expert_issue(p, bg.next, bscr, lane); if (bg.itc & 1) bg.pend1 = bg.next; else bg.pend0 = bg.next; bg.next += bg.stride; ops += 4; }
        young += ops; prevB = bgdo ? 4 : 0;
        ++bg.itc;
        const bool band = i < 4;
        if (!(band && 2 * i > wid)) {
            const LAS unsigned char* kb = lds + sl * KBUF + koff;
            f32x16 p0 = negm, p1 = negm;
            if (kmean && !band) { if (!__all((sel >> ((i - 4) >> 2)) & 1u)) {
                    const bool ok = ((sel >> ((i - 4) >> 2)) & 1u) != 0u;
#pragma unroll
                    for (int r = 0; r < 16; ++r) p0[r] = ok ? negm[r] : -INFINITY;
                    p1 = p0; } }
#pragma unroll
            for (int d0 = 0; d0 < ND; ++d0) { const bf16x8 a0 = *(const LAS bf16x8*)(kb + d0 * 2048), a1 = *(const LAS bf16x8*)(kb + d0 * 2048 + 512);
                p0 = __builtin_amdgcn_mfma_f32_32x32x16_bf16(a0, qr[d0], p0, 0, 0, 0); p1 = __builtin_amdgcn_mfma_f32_32x32x16_bf16(a1, qr[d0], p1, 0, 0, 0); }
            if (band) { if (64 * i + 63 > 32 * wid) {
#pragma unroll
                    for (int r = 0; r < 16; ++r) { const int kv = 64 * i + crow(r, hi); if (kv > qrel) p0[r] = -INFINITY; if (kv + 32 > qrel) p1[r] = -INFINITY; } } }
            float ra = mx3(p0[0], p0[1], p1[0]), rb = mx3(p0[2], p0[3], p1[1]); ra = mx3(ra, p1[2], p1[3]);
#pragma unroll
            for (int r = 4; r < 16; r += 4) { ra = mx3(ra, p0[r], p0[r + 1]); rb = mx3(rb, p0[r + 2], p0[r + 3]); ra = mx3(ra, p1[r], p1[r + 1]); rb = mx3(rb, p1[r + 2], p1[r + 3]); }
            const float rm = xhalf_max(__builtin_fmaxf(ra, rb));
            if (i == 0 || __any(rm > THR)) {
                const float dl = (i == 0) ? rm : fmaxf(rm, 0.f); mhat += dl;
#pragma unroll
                for (int r = 0; r < 16; ++r) { p0[r] -= dl; p1[r] -= dl; negm[r] = -mhat; }
                if (i != 0) { const float f = __builtin_amdgcn_exp2f(-dl); l_reg *= f; if (hi == 0) wsf[r32] = f;
                    asm volatile("s_waitcnt lgkmcnt(0)" ::: "memory");
#pragma unroll
                    for (int r = 0; r < 16; ++r) { const float fr_ = wsf[crow(r, hi)]; o[0][r] *= fr_; o[1][r] *= fr_; } }
            }
            f32x2 sacc = {0.f, 0.f};
#pragma unroll
            for (int r = 0; r < 16; ++r) { p0[r] = __builtin_amdgcn_exp2f(p0[r]); p1[r] = __builtin_amdgcn_exp2f(p1[r]); }
#pragma unroll
            for (int r = 0; r < 16; r += 2) { sacc += (f32x2){p0[r], p0[r + 1]}; sacc += (f32x2){p1[r], p1[r + 1]}; }
            l_reg += sacc[0] + sacc[1];
#pragma unroll
            for (int s = 0; s < 2; ++s)
#pragma unroll
                for (int j = 0; j < 4; ++j) { pw[s][j] = cvtpk(p0[8 * s + 2 * j], p0[8 * s + 2 * j + 1]); pw[2 + s][j] = cvtpk(p1[8 * s + 2 * j], p1[8 * s + 2 * j + 1]); }
            FA_PV(sl);
        }
        asm volatile("s_waitcnt lgkmcnt(0)" ::: "memory"); wait_vm(young);
        __builtin_amdgcn_s_barrier(); asm volatile("" ::: "memory");
        sl = sl1; opsPrev = ops;
    }
    l_reg = xhalf_sum(l_reg);
    if (hi == 0) wsf[32 + r32] = l_reg;
    asm volatile("s_waitcnt lgkmcnt(0)" ::: "memory");
#pragma unroll
    for (int r = 0; r < 16; ++r) { const float rl = 1.0f / wsf[32 + crow(r, hi)]; bf16_t* op = O + (size_t)(q0 + wid * 32 + crow(r, hi)) * 1024 + r32;
        op[0] = (bf16_t)f2bf(o[0][r] * rl); op[32] = (bf16_t)f2bf(o[1][r] * rl); }
    asm volatile("s_waitcnt lgkmcnt(0)" ::: "memory"); __builtin_amdgcn_s_barrier(); asm volatile("" ::: "memory");
#undef FA_DMA
#undef FA_TILE
#undef FA_PV
}
__device__ __forceinline__ void phase_attn_fast(const Params& p, LAS unsigned char* lds, int vcu, int G, bool do_conv) {
    unsigned char* ws = p.ws;
    const bf16_t* QM = (const bf16_t*)(ws + WS_QM); const bf16_t* KM = (const bf16_t*)(ws + WS_KM); const bf16_t* VM = (const bf16_t*)(ws + WS_VM);
    const bf16_t* QB = (const bf16_t*)(ws + WS_QB); const bf16_t* KB = (const bf16_t*)(ws + WS_KB); const bf16_t* VB = (const bf16_t*)(ws + WS_VB);
    const float* kmean = (const float*)(ws + WS_KMEANP); bf16_t* ATT = (bf16_t*)(ws + WS_ATT);
    const int wave_ = __builtin_amdgcn_readfirstlane(threadIdx.x >> 6);
    BgConv bg; bg.next = do_conv ? vcu * NWAVES + wave_ : NEXP_ITEMS; bg.stride = G * NWAVES; bg.pend0 = -1; bg.pend1 = -1; bg.itc = 0;
    for (int su = vcu; su < 256; su += G) {
        const int bh = su >> 2, j = su & 3, b = bh >> 3, h = bh & 7; const size_t r0 = (size_t)b * SEQ;
#pragma unroll 1
        for (int k = 0; k < 2; ++k) { const int qb = k ? 7 - j : j;
            attn_unit<96>(lds, QM + r0 * 768 + h * 96, 768, KM + r0 * 768 + h * 96, 768, VM + r0 * 512 + h * 64, 512, ATT + r0 * 1024 + h * 64, qb, nullptr, p, bg);
            attn_unit<64>(lds, QB + r0 * 512 + h * 64, 512, KB + r0 * 512 + h * 64, 512, VB + r0 * 512 + h * 64, 512, ATT + r0 * 1024 + 512 + h * 64, qb, kmean + (size_t)(b * 8) * 1024 + h * 64, p, bg); }
    }
    { const int lane = threadIdx.x & 63; LAS unsigned char* bscr = lds + fa::LDS_NEED + wave_ * 8192;
      asm volatile("s_waitcnt vmcnt(0)" ::: "memory");
      if (bg.pend0 >= 0) { expert_finish(p, bg.pend0, bscr, lane); bg.pend0 = -1; }
      if (bg.pend1 >= 0) { expert_finish(p, bg.pend1, bscr + 4096, lane); bg.pend1 = -1; }
      asm volatile("s_waitcnt lgkmcnt(0)" ::: "memory");
#pragma unroll 1
      for (; bg.next < NEXP_ITEMS; bg.next += bg.stride) { expert_issue(p, bg.next, bscr, lane); asm volatile("s_waitcnt vmcnt(0)" ::: "memory"); expert_finish(p, bg.next, bscr, lane); asm volatile("s_waitcnt lgkmcnt(0)" ::: "memory"); } }
}

__device__ __forceinline__ float rs32(float (&a)[32], int lane) {
#pragma unroll
    for (int e = 0; e < 16; ++e) { auto rr = __builtin_amdgcn_permlane32_swap(__float_as_uint(a[e]), __float_as_uint(a[e + 16]), false, false); a[e] = __uint_as_float(rr[0]) + __uint_as_float(rr[1]); }
#pragma unroll
    for (int e = 0; e < 8; ++e) { auto rr = __builtin_amdgcn_permlane16_swap(__float_as_uint(a[e]), __float_as_uint(a[e + 8]), false, false); a[e] = __uint_as_float(rr[0]) + __uint_as_float(rr[1]); }
    { const bool bit = (lane & 8) != 0;
#pragma unroll
      for (int e = 0; e < 4; ++e) { const float keep = bit ? a[e + 4] : a[e], send = bit ? a[e] : a[e + 4]; a[e] = keep + __shfl_xor(send, 8); } }
    { const bool bit = (lane & 4) != 0;
#pragma unroll
      for (int e = 0; e < 2; ++e) { const float keep = bit ? a[e + 2] : a[e], send = bit ? a[e] : a[e + 2]; a[e] = keep + __shfl_xor(send, 4); } }
    { const bool bit = (lane & 2) != 0; const float keep = bit ? a[1] : a[0], send = bit ? a[0] : a[1]; a[0] = keep + __shfl_xor(send, 2); }
    return a[0] + __shfl_xor(a[0], 1);
}
__device__ __forceinline__ void route_row(const Params& p, float logit, int tok, int tl, int lane, int* tidx, float* tgate, LAS int* lidx) {
    const int me = lane >> 1;
    const float my = (lane & 1) ? -INFINITY : logit + p.b_router[me];
    int rank = 0;
#pragma unroll
    for (int e = 0; e < 32; ++e) { const float ve = __uint_as_float(__builtin_amdgcn_readlane(__float_as_uint(my), 2 * e)); rank += (ve > my || (ve == my && e < me)) ? 1 : 0; }
    float tv[4]; int ti[4];
#pragma unroll
    for (int k = 0; k < 4; ++k) { const unsigned long long bal = __ballot(rank == k && !(lane & 1)); const int il = __ffsll((long long)bal) - 1;
        tv[k] = __uint_as_float(__builtin_amdgcn_readlane(__float_as_uint(my), il)); ti[k] = il >> 1; }
    if (lane == 0) { const float e1 = expf(tv[1] - tv[0]), e2 = expf(tv[2] - tv[0]), e3 = expf(tv[3] - tv[0]); const float is = 1.0f / (1.0f + e1 + e2 + e3);
        *(f32x4*)(tgate + (size_t)tok * 4) = (f32x4){is, e1 * is, e2 * is, e3 * is};
        int* tp = tidx + (size_t)tok * 4; tp[0] = ti[0]; tp[1] = ti[1]; tp[2] = ti[2]; tp[3] = ti[3];
        lidx[tl * 4 + 0] = ti[0]; lidx[tl * 4 + 1] = ti[1]; lidx[tl * 4 + 2] = ti[2]; lidx[tl * 4 + 3] = ti[3]; }
}
__device__ __forceinline__ void phase_ln1_route(const Params& p, LAS unsigned char* lds, int vcu, int G) {
    const int tid = threadIdx.x, wave = tid >> 6, lane = tid & 63;
    unsigned char* ws = p.ws;
    float* X1 = p.out; const float* X1P = (const float*)(ws + WS_X1PRE); bf16_t* X1B = (bf16_t*)(ws + WS_X1B);
    int* tidx = (int*)(ws + WS_TIDX); float* tgate = (float*)(ws + WS_TGATE); unsigned* hist = (unsigned*)(ws + WS_HIST);
    LAS int* lidx = (LAS int*)(lds + ROWTAB_OFF);
    { const float* WRL = (const float*)(ws + WS_WRL);
      for (int i = tid; i < 8192; i += NTHREADS) *(LAS f32x4*)(lds + (size_t)i * 16) = *(const f32x4*)(WRL + (size_t)i * 4); }
    __syncthreads();
    const LAS float* Wl = (const LAS float*)lds + lane * 4;
    for (int chunk = vcu; chunk < NCHUNK; chunk += G) {
#pragma unroll 1
        for (int rp = 0; rp < 4; ++rp) {
            const int tl = wave * 8 + 2 * rp, tok = chunk * 64 + tl;
            f32x4 v0[4], v1[4]; float s0 = 0.f, s1 = 0.f;
#pragma unroll
            for (int j = 0; j < 4; ++j) { v0[j] = *(const f32x4*)(X1P + (size_t)tok * DM + 4 * lane + 256 * j); v1[j] = *(const f32x4*)(X1P + (size_t)(tok + 1) * DM + 4 * lane + 256 * j);
                s0 += (v0[j][0] + v0[j][1]) + (v0[j][2] + v0[j][3]); s1 += (v1[j][0] + v1[j][1]) + (v1[j][2] + v1[j][3]); }
            const float mean0 = wave_sum(s0) * (1.0f / DM), mean1 = wave_sum(s1) * (1.0f / DM); float q0 = 0.f, q1 = 0.f;
#pragma unroll
            for (int j = 0; j < 4; ++j) { v0[j] = v0[j] - mean0; v1[j] = v1[j] - mean1;
                q0 += (v0[j][0] * v0[j][0] + v0[j][1] * v0[j][1]) + (v0[j][2] * v0[j][2] + v0[j][3] * v0[j][3]); q1 += (v1[j][0] * v1[j][0] + v1[j][1] * v1[j][1]) + (v1[j][2] * v1[j][2] + v1[j][3] * v1[j][3]); }
            const float rs0 = 1.0f / sqrtf(wave_sum(q0) * (1.0f / DM) + LN_EPS), rs1 = 1.0f / sqrtf(wave_sum(q1) * (1.0f / DM) + LN_EPS);
#pragma unroll
            for (int j = 0; j < 4; ++j) { const f32x4 g = *(const f32x4*)(p.ln1_g + 4 * lane + 256 * j), bb = *(const f32x4*)(p.ln1_b + 4 * lane + 256 * j);
                v0[j] = v0[j] * rs0 * g + bb; v1[j] = v1[j] * rs1 * g + bb;
                *(f32x4*)(X1 + (size_t)tok * DM + 4 * lane + 256 * j) = v0[j]; *(f32x4*)(X1 + (size_t)(tok + 1) * DM + 4 * lane + 256 * j) = v1[j];
                u32x2 w; w.x = pk2(v0[j][0], v0[j][1]); w.y = pk2(v0[j][2], v0[j][3]); *(u32x2*)(X1B + (size_t)tok * DM + 4 * lane + 256 * j) = w;
                w.x = pk2(v1[j][0], v1[j][1]); w.y = pk2(v1[j][2], v1[j][3]); *(u32x2*)(X1B + (size_t)(tok + 1) * DM + 4 * lane + 256 * j) = w; }
            float a0[32], a1[32];
#pragma unroll
            for (int e = 0; e < 32; ++e) { a0[e] = 0.f; a1[e] = 0.f; }
            const LAS float* wlo = Wl; const LAS float* whi = Wl + 8 * 2048;
            asm volatile("" : "+v"(wlo), "+v"(whi));
#pragma unroll
            for (int j = 0; j < 4; ++j)
#pragma unroll
                for (int i = 0; i < 4; ++i) { const float x0 = v0[j][i], x1 = v1[j][i]; const LAS float* wb = (j < 2) ? wlo + (j * 4 + i) * 2048 : whi + ((j - 2) * 4 + i) * 2048;
#pragma unroll
                    for (int e4 = 0; e4 < 8; ++e4) { const f32x4 w = *(const LAS f32x4*)(wb + e4 * 256);
#pragma unroll
                        for (int k = 0; k < 4; ++k) { a0[4 * e4 + k] = fmaf(x0, w[k], a0[4 * e4 + k]); a1[4 * e4 + k] = fmaf(x1, w[k], a1[4 * e4 + k]); } }
                    asm volatile("" ::: "memory"); }
            const float l0 = rs32(a0, lane), l1 = rs32(a1, lane);
            route_row(p, l0, tok, tl, lane, tidx, tgate, lidx);
            route_row(p, l1, tok + 1, tl + 1, lane, tidx, tgate, lidx);
        }
        __syncthreads();
        if (tid < 32) { unsigned c = 0; for (int a = 0; a < 256; ++a) c += (lidx[a] == tid) ? 1u : 0u; hist[chunk * 32 + tid] = c; }
        __syncthreads();
    }
}

__device__ __forceinline__ void phase_assign(const Params& p, LAS unsigned char* lds, int vcu, int G) {
    const int tid = threadIdx.x;
    unsigned char* ws = p.ws;
    const int* tidx = (const int*)(ws + WS_TIDX); const float* tgate = (const float*)(ws + WS_TGATE); const unsigned* hist = (const unsigned*)(ws + WS_HIST);
    int* dest = (int*)(ws + WS_DEST); int* row_tok = (int*)(ws + WS_ROWTOK); float* row_gate = (float*)(ws + WS_ROWGATE); int* tile_e = (int*)(ws + WS_TILEE);
    LAS int* lidx = (LAS int*)lds;
    LAS int* lcnt = (LAS int*)(lds + 1024);
    LAS int* lpre = (LAS int*)(lds + 1024 + 128);
    LAS int* lstart = (LAS int*)(lds + 1024 + 256);
    LAS int* ptot = (LAS int*)(lds + 2048);
    LAS int* ppre = (LAS int*)(lds + 4096);
    for (int chunk = vcu; chunk < NCHUNK; chunk += G) {
        if (tid < 256) lidx[tid] = tidx[chunk * 256 + tid];
        { const int e = tid & 31, cg = tid >> 5; int tot = 0, pre = 0;
#pragma unroll
          for (int k = 0; k < 16; ++k) { const int c = cg * 16 + k; const int hv = (int)hist[c * 32 + e]; tot += hv; pre += (c < chunk) ? hv : 0; }
          ptot[cg * 32 + e] = tot; ppre[cg * 32 + e] = pre; }
        __syncthreads();
        if (tid < 32) { int tot = 0, pre = 0;
#pragma unroll
            for (int cg = 0; cg < 16; ++cg) { tot += ptot[cg * 32 + tid]; pre += ppre[cg * 32 + tid]; }
            lcnt[tid] = tot; lpre[tid] = pre; }
        __syncthreads();
        if (tid == 0) { int s2 = 0; for (int e = 0; e < 32; ++e) { lstart[e] = s2; s2 += (lcnt[e] + 255) / 256 * 256; } lstart[32] = s2; }
        __syncthreads();
        if (tid < 256) { const int e = lidx[tid]; int rank = 0; for (int a = 0; a < tid; ++a) rank += (lidx[a] == e) ? 1 : 0;
            const int P = lstart[e] + lpre[e] + rank, tok = chunk * 64 + (tid >> 2);
            row_tok[P] = tok; row_gate[P] = tgate[chunk * 256 + tid]; dest[chunk * 256 + tid] = P; }
        if (chunk < 32) { const int e = chunk; for (int P = lstart[e] + lcnt[e] + tid; P < lstart[e + 1]; P += NTHREADS) { row_tok[P] = 0; row_gate[P] = 0.f; } }
        if (chunk == 0) { if (tid < 32) { for (int t = lstart[tid] / 256; t < lstart[tid + 1] / 256; ++t) tile_e[t] = tid; } if (tid == 32) tile_e[MAXTILES] = lstart[32] / 256; }
        __syncthreads();
    }
}

__device__ __forceinline__ void phase_final(const Params& p, int vcu, int G, float* outp) {
    const int tid = threadIdx.x, wave = tid >> 6, lane = tid & 63;
    unsigned char* ws = p.ws;
    const int* dest = (const int*)(ws + WS_DEST); const bf16_t* Y = (const bf16_t*)(ws + WS_Y); float* X1 = p.out;
    const int gw = vcu * NWAVES + wave, NGW = G * NWAVES;
    for (int t0 = gw * 8; t0 < NTOK; t0 += NGW * 8) {
        const int dl = (lane < 32) ? dest[t0 * 4 + lane] : 0;
#pragma unroll
        for (int pr = 0; pr < 4; ++pr) {
            const int tok = t0 + 2 * pr;
            int P[2][4];
#pragma unroll
            for (int t = 0; t < 2; ++t)
#pragma unroll
                for (int k = 0; k < 4; ++k) P[t][k] = __builtin_amdgcn_readlane(dl, (2 * pr + t) * 4 + k);
            f32x4 v[2][4]; u32x2 y[2][4][4];
#pragma unroll
            for (int t = 0; t < 2; ++t)
#pragma unroll
                for (int j = 0; j < 4; ++j) { v[t][j] = *(const f32x4*)(X1 + (size_t)(tok + t) * DM + 4 * lane + 256 * j);
#pragma unroll
                    for (int k = 0; k < 4; ++k) y[t][k][j] = *(const u32x2*)(Y + (size_t)P[t][k] * 1024 + 4 * lane + 256 * j); }
            float s[2], q[2];
#pragma unroll
            for (int t = 0; t < 2; ++t) { s[t] = 0.f;
#pragma unroll
                for (int j = 0; j < 4; ++j) { v[t][j] = v[t][j] * DN_ALPHA;
#pragma unroll
                    for (int k = 0; k < 4; ++k) { const u32x2 w = y[t][k][j];
                        v[t][j][0] += __uint_as_float(w.x << 16); v[t][j][1] += __uint_as_float(w.x & 0xffff0000u); v[t][j][2] += __uint_as_float(w.y << 16); v[t][j][3] += __uint_as_float(w.y & 0xffff0000u); }
                    s[t] += (v[t][j][0] + v[t][j][1]) + (v[t][j][2] + v[t][j][3]); } }
            const float mean0 = wave_sum(s[0]) * (1.0f / DM), mean1 = wave_sum(s[1]) * (1.0f / DM);
            q[0] = 0.f; q[1] = 0.f;
#pragma unroll
            for (int j = 0; j < 4; ++j) { v[0][j] = v[0][j] - mean0; v[1][j] = v[1][j] - mean1;
                q[0] += (v[0][j][0] * v[0][j][0] + v[0][j][1] * v[0][j][1]) + (v[0][j][2] * v[0][j][2] + v[0][j][3] * v[0][j][3]);
                q[1] += (v[1][j][0] * v[1][j][0] + v[1][j][1] * v[1][j][1]) + (v[1][j][2] * v[1][j][2] + v[1][j][3] * v[1][j][3]); }
            const float rs0 = 1.0f / sqrtf(wave_sum(q[0]) * (1.0f / DM) + LN_EPS), rs1 = 1.0f / sqrtf(wave_sum(q[1]) * (1.0f / DM) + LN_EPS);
#pragma unroll
            for (int j = 0; j < 4; ++j) { const f32x4 g = *(const f32x4*)(p.ln2_g + 4 * lane + 256 * j), bb = *(const f32x4*)(p.ln2_b + 4 * lane + 256 * j);
                *(f32x4*)(outp + (size_t)tok * DM + 4 * lane + 256 * j) = v[0][j] * rs0 * g + bb;
                *(f32x4*)(outp + (size_t)(tok + 1) * DM + 4 * lane + 256 * j) = v[1][j] * rs1 * g + bb; }
        }
    }
}

constexpr int NPHASE = 11;
__global__ void __launch_bounds__(NTHREADS, 2) fwd_kernel(Params p) {
    extern __shared__ __attribute__((aligned(16))) unsigned char lds_raw[];
    LAS unsigned char* lds = (LAS unsigned char*)lds_raw;
    const int tid = threadIdx.x;
    const int G = gridDim.x, bx = blockIdx.x;
    const int vcu = (G % 8 == 0) ? (bx % 8) * (G / 8) + bx / 8 : bx;
    unsigned char* ws = p.ws;
    volatile LAS unsigned* MISC = (volatile LAS unsigned*)(lds + MISC_OFF);
    if (tid < 32) MISC[tid] = 0u;
    __syncthreads();
    XcdBarrier bar; bar.bar = (unsigned*)(ws + WS_CTL) + CW_BAR; bar.x = 0; bar.st = nullptr;
    const bool one = (p.ph_hi - p.ph_lo) > 1;
    if (one) bar = xcd_barrier_post((unsigned*)(ws + WS_CTL) + CW_BAR, MISC + 8);
    const int lo = p.ph_lo, hi = p.ph_hi;
#ifdef ONLY_PHASE
#define IN(k) ((k) == ONLY_PHASE && lo <= (k) && (k) < hi)
#else
#define IN(k) (lo <= (k) && (k) < hi)
#endif
#ifndef NAIVE_GEMM_MASK
#define NAIVE_GEMM_MASK 0
#endif
#define GEMM_CALL(EPI, SCHED) do { if constexpr (NAIVE_GEMM_MASK != 0) gemm_phase_naive<EPI, SCHED>(lds, g, S, E); else gemm_phase<EPI, SCHED, true>(lds, g, S, E); } while (0)
#ifndef REPEAT_PHASE
#define REPEAT_PHASE (-1)
#endif
#define SEAM(k) do { if (IN(k) && IN((k) == 1 ? 3 : (k) + 1)) xcd_barrier(bar); } while (0)

#define PHASE(k, ...) do { if (IN(k)) { if constexpr (REPEAT_PHASE == (k)) { __VA_ARGS__; xcd_barrier(bar); } __VA_ARGS__; } SEAM(k); } while (0)
    PHASE(0, phase_prologue(p, lds, vcu, G));
    PHASE(1, { GemmArgs g{(const bf16_t*)(ws + WS_XB), 1024, (const bf16_t*)(ws + WS_WIN), 1024, 1024}; DenseSched S; S.init(lds, NTOK, PN, G, vcu);
        EpiProj E{ws}; GEMM_CALL(EpiProj, DenseSched); });
    PHASE(3, { GemmArgs g{(const bf16_t*)(ws + WS_LAT), KUP, (const bf16_t*)(ws + WS_WUP), KUP, KUP}; DenseSched S; S.init(lds, NTOK, NUP, G, vcu);
        EpiUp E{(bf16_t*)(ws + WS_QM), (bf16_t*)(ws + WS_KM), (bf16_t*)(ws + WS_VM), (const float*)(ws + WS_RSTDP), (const float*)(ws + WS_ROPEA)}; GEMM_CALL(EpiUp, DenseSched); });
    if constexpr (REPEAT_PHASE == 44) { if (IN(4)) { phase_attn_fast(p, lds, vcu, G, false); xcd_barrier(bar); } }
    PHASE(4, phase_attn_fast(p, lds, vcu, G, true));
    PHASE(5, { GemmArgs g{(const bf16_t*)(ws + WS_ATT), 1024, (const bf16_t*)(ws + WS_WO), 1024, 1024}; DenseSched S; S.init(lds, NTOK, DM, G, vcu);
        EpiWo E{p.x, (float*)(ws + WS_X1PRE)}; GEMM_CALL(EpiWo, DenseSched); });
    PHASE(6, phase_ln1_route(p, lds, vcu, G));
    PHASE(7, phase_assign(p, lds, vcu, G));
    PHASE(8, { GemmArgs g{(const bf16_t*)(ws + WS_X1B), 1024, (const bf16_t*)(ws + WS_WGU), 1024, 1024}; GroupSched<true> S; S.init(lds, (const int*)(ws + WS_TILEE), (const int*)(ws + WS_ROWTOK), 8, 2048, G, vcu);
        EpiGateUp E{(bf16_t*)(ws + WS_H), p.b_gate, p.b_up}; GEMM_CALL(EpiGateUp, GroupSched<true>); });
    PHASE(9, { GemmArgs g{(const bf16_t*)(ws + WS_H), 1024, (const bf16_t*)(ws + WS_WD), 1024, 1024}; GroupSched<false> S; S.init(lds, (const int*)(ws + WS_TILEE), (const int*)(ws + WS_ROWTOK), 4, 1024, G, vcu);
        EpiDown E{(bf16_t*)(ws + WS_Y), p.b_down, (const float*)(ws + WS_ROWGATE)}; GEMM_CALL(EpiDown, GroupSched<false>); });
    if (IN(10)) { if constexpr (REPEAT_PHASE == 10) { phase_final(p, vcu, G, (float*)(ws + WS_X1PRE)); xcd_barrier(bar); } phase_final(p, vcu, G, p.out); }
#undef IN
#undef SEAM
}

extern "C" void kernel_launch(void* const* d_in, const int* in_sizes, int n_in, void* d_out, int out_size, void* d_ws, size_t ws_size, hipStream_t stream) {
    static int grid = 0;
    if (grid == 0) {
        if (n_in != 20 || out_size != NTOK * DM || ws_size < WS_END) { fprintf(stderr, "kernel_launch: unexpected shapes (n_in %d out %d ws %zu)\n", n_in, out_size, ws_size); grid = -1; return; }
        int dev = 0, cus = 0, per_cu = 0;
        if (hipGetDevice(&dev) != hipSuccess || hipDeviceGetAttribute(&cus, hipDeviceAttributeMultiprocessorCount, dev) != hipSuccess) { grid = -1; return; }
        if (hipFuncSetAttribute((const void*)fwd_kernel, hipFuncAttributeMaxDynamicSharedMemorySize, LDS_BYTES) != hipSuccess) { fprintf(stderr, "kernel_launch: hipFuncSetAttribute failed\n"); grid = -1; return; }
        if (hipOccupancyMaxActiveBlocksPerMultiprocessor(&per_cu, (const void*)fwd_kernel, NTHREADS, LDS_BYTES) != hipSuccess || per_cu < 1) fprintf(stderr, "kernel_launch: occupancy query says %d\n", per_cu);
        (void)hipGetLastError();
        grid = cus;
    }
    if (grid < 0) return;
    (void)hipMemsetAsync((char*)d_ws + WS_CTL, 0, CTL_ZERO_BYTES, stream);
    Params p{};
    p.x = (const float*)d_in[0]; p.pos = (const int*)d_in[1]; p.w_in = (const float*)d_in[2]; p.q_a_norm = (const float*)d_in[3]; p.w_q_b = (const float*)d_in[4];
    p.kv_a_norm = (const float*)d_in[5]; p.w_kv_b = (const float*)d_in[6]; p.w_o = (const float*)d_in[7]; p.ln1_g = (const float*)d_in[8]; p.ln1_b = (const float*)d_in[9];
    p.w_router = (const float*)d_in[10]; p.b_router = (const float*)d_in[11]; p.w_gate = (const float*)d_in[12]; p.b_gate = (const float*)d_in[13];
    p.w_up = (const float*)d_in[14]; p.b_up = (const float*)d_in[15]; p.w_down = (const float*)d_in[16]; p.b_down = (const float*)d_in[17];
    p.ln2_g = (const float*)d_in[18]; p.ln2_b = (const float*)d_in[19];
    p.out = (float*)d_out; p.ws = (unsigned char*)d_ws;
    for (int i = 0; i < 16; ++i) p.invfA[i] = pow(500000.0, -(double)(2 * i) / 32.0);
    for (int i = 0; i < 8; ++i) p.invfB[i] = pow(500000.0, -(double)(2 * i) / 16.0);
#if MK_ONE_LAUNCH
    p.ph_lo = 0; p.ph_hi = NPHASE;
    hipLaunchKernelGGL(fwd_kernel, dim3(grid), dim3(NTHREADS), LDS_BYTES, stream, p);
#else
    for (int ph = 0; ph < NPHASE; ++ph) { p.ph_lo = ph; p.ph_hi = ph + 1; hipLaunchKernelGGL(fwd_kernel, dim3(grid), dim3(NTHREADS), LDS_BYTES, stream, p); }
#endif
}
```

```cpp
#include <hip/hip_runtime.h>
#include <cstdio>
#include <cstdint>
#include <cmath>

#ifndef MK_ONE_LAUNCH
#define MK_ONE_LAUNCH 1
#endif

#define GAS __attribute__((address_space(1)))
#define LAS __attribute__((address_space(3)))
typedef unsigned short bf16_t;
typedef short bf16x8 __attribute__((ext_vector_type(8)));
typedef float f32x4 __attribute__((ext_vector_type(4)));
typedef float f32x2 __attribute__((ext_vector_type(2)));
typedef unsigned u32x4 __attribute__((ext_vector_type(4)));
typedef unsigned u32x2 __attribute__((ext_vector_type(2)));

constexpr int NTOK = 16384, DM = 1024, SEQ = 2048, NBATCH = 8;
constexpr int PN = 2048;
constexpr int C_QL = 0, C_KVL = 256, C_KR = 384, C_MQ = 416, C_MK = 928, C_MV = 1440, IN_COLS = 1952;
constexpr int NUP = 1792, KUP = 384;
constexpr int NE = 32, TOPK = 4;
constexpr int MAXROWS = 65536 + NE * 256, MAXTILES = MAXROWS / 256;
constexpr int NCHUNK = NTOK / 64;
constexpr float LN_EPS = 1e-5f, RMS_EPS = 1e-6f;
constexpr float DN_ALPHA = 1.189207115002721f;
constexpr float LOG2E = 1.4426950408889634f;
constexpr float C2A = 0.10206207261596575f * LOG2E;
constexpr float C2B = 0.125f * LOG2E;
constexpr int NWAVES = 8, NTHREADS = 512;

constexpr size_t MiB = 1u << 20;
constexpr size_t WS_CTL = 0, CTL_ZERO_BYTES = 1 * MiB;
constexpr size_t WS_HIST = 1 * MiB;
constexpr size_t WS_TIDX = WS_HIST + 64 * 1024;
constexpr size_t WS_TGATE = WS_TIDX + 256 * 1024;
constexpr size_t WS_DEST = WS_TGATE + 256 * 1024;
constexpr size_t WS_ROWTOK = WS_DEST + 256 * 1024;
constexpr size_t WS_ROWGATE = WS_ROWTOK + 288 * 1024;
constexpr size_t WS_TILEE = WS_ROWGATE + 288 * 1024;
constexpr size_t WS_RSTD = WS_TILEE + 4 * 1024;
constexpr size_t WS_KMEAN = WS_RSTD + 128 * 1024;
constexpr size_t WS_WRL = WS_KMEAN + 128 * 1024;
static_assert(WS_WRL + 128 * 1024 <= 4 * MiB, "route region");
constexpr size_t WS_ROPEA = 4 * MiB;
constexpr size_t WS_ROPEB = 6 * MiB;
constexpr size_t WS_WIN = 8 * MiB;
constexpr size_t WS_WO = 12 * MiB;
constexpr size_t WS_WUP = 14 * MiB;
constexpr size_t WS_X1B = 16 * MiB;
constexpr size_t WS_WD = 48 * MiB;
constexpr size_t WS_XB = 112 * MiB;
constexpr size_t WS_PROJ = 144 * MiB;
constexpr size_t WS_QM = 208 * MiB;
constexpr size_t WS_KM = 232 * MiB;
constexpr size_t WS_VM = 256 * MiB;
constexpr size_t WS_QB = 272 * MiB;
constexpr size_t WS_KB = 288 * MiB;
constexpr size_t WS_ATT = 304 * MiB;
constexpr size_t WS_H = 112 * MiB;
constexpr size_t WS_WGU = 336 * MiB;
constexpr size_t WS_Y = 336 * MiB;
constexpr size_t WS_LAT = 144 * MiB;
constexpr size_t WS_VB = 160 * MiB;
constexpr size_t WS_RSTDP = 176 * MiB;
constexpr size_t WS_KMEANP = 177 * MiB;
constexpr size_t WS_X1PRE = 144 * MiB;
constexpr size_t WS_END = 480 * MiB;
static_assert(WS_H + (size_t)MAXROWS * 1024 * 2 <= WS_VM + 0 * MiB + 0 && WS_Y + (size_t)MAXROWS * 1024 * 2 <= WS_END, "ws map");
constexpr int CW_BAR = 4096;

constexpr int LDS_BYTES = 147456;
constexpr int MISC_OFF = 131072 + 320;

__device__ __forceinline__ float bf2f(unsigned v) { return __uint_as_float(v << 16); }
__device__ __forceinline__ unsigned f2bf(float f) { unsigned u = __float_as_uint(f); return (u + 0x7fffu + ((u >> 16) & 1u)) >> 16; }
__device__ __forceinline__ unsigned pk2(float lo, float hi) { typedef __bf16 bf2_t __attribute__((ext_vector_type(2))); f32x2 v = {lo, hi}; bf2_t b = __builtin_convertvector(v, bf2_t); return __builtin_bit_cast(unsigned, b); }
__device__ __forceinline__ float wave_sum(float v) {
#pragma unroll
    for (int o = 1; o < 64; o <<= 1) v += __shfl_xor(v, o);
    return v;
}
__device__ __forceinline__ float wave_max(float v) {
#pragma unroll
    for (int o = 1; o < 64; o <<= 1) v = fmaxf(v, __shfl_xor(v, o));
    return v;
}

#define XB_TMO      128
#define XB_XCNT(j)  (256  + 64 * (j))
#define XB_XSUB(j)  (1280 + 64 * (j))
#define XB_XGEN(j)  (2304 + 64 * (j))
#define XB_TOP      3328
#define XB_TOPGEN   3392
#define XCD_BAR_WORDS 3456
#define XB_SPIN_CAP (1u << 18)
__device__ __forceinline__ unsigned xb_ld(unsigned* p)              { return __hip_atomic_load(p, __ATOMIC_RELAXED, __HIP_MEMORY_SCOPE_AGENT); }
__device__ __forceinline__ unsigned xb_add(unsigned* p, unsigned v) { return __hip_atomic_fetch_add(p, v, __ATOMIC_RELAXED, __HIP_MEMORY_SCOPE_AGENT); }
__device__ __forceinline__ unsigned xb_xcc_id() { return (unsigned)__builtin_amdgcn_s_getreg((3 << 11) | 20) & 0xFu; }
#define XB_SPIN(cond, bar) do { unsigned _sp = 0; while (cond) { __builtin_amdgcn_s_sleep(1); \
    if ((++_sp & 255u) == 0u) { if (xb_ld(&(bar)[XB_TMO])) break; if (_sp > XB_SPIN_CAP) { atomicAdd(&(bar)[XB_TMO], 1u); break; } } } } while (0)
struct XcdBarrier { unsigned* bar; unsigned x; volatile LAS unsigned* st; };
__device__ __forceinline__ XcdBarrier xcd_barrier_post(unsigned* bar, volatile LAS unsigned* st) {
    XcdBarrier b; b.bar = bar; b.x = xb_xcc_id(); b.st = st;
    if (threadIdx.x == 0) (void)xb_add(&bar[XB_XCNT(b.x)], 1u);
    return b;
}
__device__ __forceinline__ void xcd_barrier_complete(unsigned* bar, unsigned x, unsigned& nloc, unsigned& nx) {
    const unsigned G = gridDim.x * gridDim.y * gridDim.z;
    unsigned sum, cnt, mine, sp = 0u;
    for (;;) {
        sum = 0u; cnt = 0u; mine = 0u;
#pragma unroll
        for (unsigned j = 0; j < 16; ++j) { const unsigned c = xb_ld(&bar[XB_XCNT(j)]); sum += c; cnt += (c > 0u) ? 1u : 0u; mine = (j == x) ? c : mine; }
        if (sum == G) break;
        __builtin_amdgcn_s_sleep(1);
        if ((++sp & 255u) == 0u) { if (xb_ld(&bar[XB_TMO])) break; if (sp > XB_SPIN_CAP) { atomicAdd(&bar[XB_TMO], 1u); break; } }
    }
    nloc = mine > 0u ? mine : 1u; nx = cnt > 0u ? cnt : 1u;
}
__device__ __forceinline__ void xcd_barrier(const XcdBarrier& b) {
    asm volatile("s_waitcnt vmcnt(0)" ::: "memory");
    __syncthreads();
    if (threadIdx.x == 0) {
        unsigned* bar = b.bar;
        __builtin_amdgcn_s_waitcnt(0);
        unsigned nloc = b.st[0], nx = b.st[1];
        if (nloc == 0u) { xcd_barrier_complete(bar, b.x, nloc, nx); b.st[0] = nloc; b.st[1] = nx; }
        const unsigned old = xb_add(&bar[XB_XSUB(b.x)], 1u);
        const unsigned gen = old / nloc;
        if (old + 1u == (gen + 1u) * nloc) {
            __builtin_amdgcn_fence(__ATOMIC_RELEASE, "agent");
            asm volatile("s_waitcnt vmcnt(0)" ::: "memory");
            const unsigned og = xb_add(&bar[XB_TOP], 1u);
            const unsigned tg = og / nx;
            if (og + 1u == (tg + 1u) * nx) xb_add(&bar[XB_TOPGEN], 1u);
            else XB_SPIN(xb_ld(&bar[XB_TOPGEN]) == tg, bar);
            __builtin_amdgcn_fence(__ATOMIC_ACQUIRE, "agent");
            xb_add(&bar[XB_XGEN(b.x)], 1u);
            asm volatile("s_waitcnt vmcnt(0)" ::: "memory");
        } else {
            XB_SPIN(xb_ld(&bar[XB_XGEN(b.x)]) == gen, bar);
            __builtin_amdgcn_fence(__ATOMIC_ACQUIRE, "agent");
            asm volatile("s_waitcnt vmcnt(0)" ::: "memory");
        }
    }
    __syncthreads();
}

struct Params {
    const float* x; const int* pos;
    const float *w_in, *q_a_norm, *w_q_b, *kv_a_norm, *w_kv_b, *w_o, *ln1_g, *ln1_b, *w_router, *b_router;
    const float *w_gate, *b_gate, *w_up, *b_up, *w_down, *b_down, *ln2_g, *ln2_b;
    float* out; unsigned char* ws;
    double invfA[16]; double invfB[8];
    int ph_lo, ph_hi;
};

struct Unit { int pm, pn, e; };
struct GemmArgs { const bf16_t* A; int lda; const bf16_t* Bt; int ldb; int K; };
template <bool PERM> __device__ __forceinline__ int ecol(int bj, int n, int wc, int fq) { return 128 * bj + 32 * wc + (PERM ? 8 * fq + 4 * n : 16 * n + 4 * fq); }

template <class Epi, class Sched>
__device__ __forceinline__ void gemm_phase_naive(LAS unsigned char* lds, const GemmArgs g, const Sched& S, const Epi& E) {
    const int tid = threadIdx.x, wid = __builtin_amdgcn_readfirstlane(tid >> 6), lane = tid & 63, wr = wid >> 2, wc = wid & 3, fr = lane & 15, fq = lane >> 4;
    Unit u;
    for (int ui = 0; S.next(ui, u); ++ui) {
        f32x4 acc[2][2][4][2];
#pragma unroll
        for (int a = 0; a < 2; ++a)
#pragma unroll
            for (int b = 0; b < 2; ++b)
#pragma unroll
                for (int m = 0; m < 4; ++m)
#pragma unroll
                    for (int n = 0; n < 2; ++n) acc[a][b][m][n] = (f32x4){0.f, 0.f, 0.f, 0.f};
        unsigned aoff[2][4];
#pragma unroll
        for (int a = 0; a < 2; ++a)
#pragma unroll
            for (int m = 0; m < 4; ++m) aoff[a][m] = (unsigned)S.arow(u, ui, 128 * a + 64 * wr + 16 * m + fr) * (unsigned)g.lda;
        const bf16_t* bb = g.Bt + (size_t)(S.brow0(u) + 32 * wc) * g.ldb;
        const unsigned bl0 = (unsigned)(4 * fq) * (unsigned)g.ldb, bl1 = (unsigned)(8 * fq) * (unsigned)g.ldb;
#pragma unroll 1
        for (int k = 0; k < g.K; k += 2) {
            float af[2][4][2];
#pragma unroll
            for (int a = 0; a < 2; ++a)
#pragma unroll
                for (int m = 0; m < 4; ++m) { const unsigned v = *(const unsigned*)(g.A + aoff[a][m] + k); af[a][m][0] = __uint_as_float(v << 16); af[a][m][1] = __uint_as_float(v & 0xffff0000u); }
#pragma unroll
            for (int b = 0; b < 2; ++b)
#pragma unroll
                for (int n = 0; n < 2; ++n)
#pragma unroll
                    for (int j = 0; j < 4; ++j) {
                        const int ccol = 128 * b + (Epi::PERM ? 4 * n : 16 * n) + j;
                        const unsigned v = *(const unsigned*)(bb + (size_t)ccol * g.ldb + ((Epi::PERM ? bl1 : bl0) + (unsigned)k));
                        const float b0 = __uint_as_float(v << 16), b1 = __uint_as_float(v & 0xffff0000u);
#pragma unroll
                        for (int a = 0; a < 2; ++a)
#pragma unroll
                            for (int m = 0; m < 4; ++m) acc[a][b][m][n][j] = fmaf(af[a][m][1], b1, fmaf(af[a][m][0], b0, acc[a][b][m][n][j]));
                    }
        }
        E(acc, u, wr, wc, fr, fq);
    }
}

namespace pg {
constexpr int BK = 64, HALF = 128, HTB = HALF * BK * 2;
__device__ __forceinline__ int lds_byte(int r, int c) { const int st = (r >> 4) * 2 + (c >> 5), rr = r & 15, cc = c & 31, ob = rr * 64 + cc * 2; return st * 1024 + (ob ^ (((ob >> 9) & 1) << 5)); }
__device__ __forceinline__ void stage_rc(int b, int& R, int& C) { const int st = b / 1024, sb = b % 1024, swz = sb ^ (((sb >> 9) & 1) << 5); R = (st >> 1) * 16 + swz / 64; C = (st & 1) * 32 + (swz % 64) / 2; }
__device__ __forceinline__ int perm32(int rho) { const int n = rho >> 4, i = rho & 15; return 8 * (i >> 2) + 4 * n + (i & 3); }
}
template <class Epi, class Sched, bool ALIGN_EPI>
__device__ __forceinline__ void gemm_phase(LAS unsigned char* lds, const GemmArgs g, const Sched& S, const Epi& E) {
    using namespace pg;
    const int tid = threadIdx.x, wid = __builtin_amdgcn_readfirstlane(tid >> 6), lane = tid & 63, wr = wid >> 2, wc = wid & 3, fr = lane & 15, fq = lane >> 4;
    const int nt = g.K / BK;
    int sR[2], sC[2], sRb[2];
#pragma unroll
    for (int i = 0; i < 2; ++i) { int R, C; stage_rc(tid * 16 + i * 8192, R, C); sR[i] = R; sC[i] = C; sRb[i] = Epi::PERM ? ((R & ~31) + perm32(R & 31)) : R; }
    const unsigned ldsw = (unsigned)wid * 1024u;
    const int aoff = lds_byte(wr * 64 + fr, fq * 8), boff = lds_byte(wc * 32 + fr, fq * 8);
    const char* Ab = (const char*)g.A; const char* Bb = (const char*)g.Bt;
#define PG_SA(b, h) (((b) * 2 + (h)) * HTB)
#define PG_SB(b, h) ((4 + (b) * 2 + (h)) * HTB)
#define PG_STAGE(bufoff, gptr, v0, v1) do { \
        __builtin_amdgcn_global_load_lds((const unsigned*)((gptr) + (v0)), (LAS unsigned*)(lds + (bufoff) + ldsw), 16, 0, 0); \
        __builtin_amdgcn_global_load_lds((const unsigned*)((gptr) + (v1)), (LAS unsigned*)(lds + (bufoff) + ldsw + 8192), 16, 0, 0); } while (0)
#define PG_LDA(dst, b, h) do { _Pragma("unroll") for (int m = 0; m < 4; ++m) _Pragma("unroll") for (int k = 0; k < 2; ++k) dst[m][k] = *(const LAS bf16x8*)(lds + PG_SA(b, h) + aoff + m * 2048 + k * 1024); } while (0)
#define PG_LDB(dst, b, h) do { _Pragma("unroll") for (int n = 0; n < 2; ++n) _Pragma("unroll") for (int k = 0; k < 2; ++k) dst[n][k] = *(const LAS bf16x8*)(lds + PG_SB(b, h) + boff + n * 2048 + k * 1024); } while (0)
#define PG_MMA(ai, bj, At, Bt) do { __builtin_amdgcn_s_setprio(1); _Pragma("unroll") for (int m = 0; m < 4; ++m) _Pragma("unroll") for (int n = 0; n < 2; ++n) _Pragma("unroll") for (int k = 0; k < 2; ++k) \
        acc[ai][bj][m][n] = __builtin_amdgcn_mfma_f32_16x16x32_bf16(Bt[n][k], At[m][k], acc[ai][bj][m][n], 0, 0, 0); __builtin_amdgcn_s_setprio(0); } while (0)
#define PG_WAIT_V(n) asm volatile("s_waitcnt vmcnt(" #n ")" ::: "memory")
#define PG_WAIT_L(n) asm volatile("s_waitcnt lgkmcnt(" #n ")" ::: "memory")
#define PG_BAR __builtin_amdgcn_s_barrier()
#define PG_SCHED __builtin_amdgcn_sched_barrier(0)
    constexpr bool GA = Sched::GATHER;
    unsigned cA[2], cB[2];
#pragma unroll
    for (int i = 0; i < 2; ++i) { cA[i] = ((unsigned)sR[i] * (unsigned)g.lda + (unsigned)sC[i]) * 2u; cB[i] = ((unsigned)sRb[i] * (unsigned)g.ldb + (unsigned)sC[i]) * 2u; }
    const size_t hA = (size_t)128 * g.lda * 2, hB = (size_t)128 * g.ldb * 2;
#define PG_GOFFS(u, uidx, VA) do { if constexpr (GA) { _Pragma("unroll") for (int h = 0; h < 2; ++h) _Pragma("unroll") for (int i = 0; i < 2; ++i) \
        VA[h][i] = ((unsigned)S.arow(u, uidx, 128 * h + sR[i]) * (unsigned)g.lda + (unsigned)sC[i]) * 2u; } } while (0)
#define PG_UA(u) (GA ? (size_t)0 : (size_t)S.arow(u, 0, 0) * g.lda * 2)
#define PG_UB(u) ((size_t)S.brow0(u) * g.ldb * 2)
#define PG_STAGE_A(bufoff, ab, VA, h) do { if constexpr (GA) { PG_STAGE(bufoff, (ab), VA[h][0], VA[h][1]); } else { PG_STAGE(bufoff, (ab) + (h) * hA, cA[0], cA[1]); } } while (0)
#define PG_STAGE_B(bufoff, bb, h) PG_STAGE(bufoff, (bb) + (h) * hB, cB[0], cB[1])
    Unit cur, nxt; int ui = 0;
    if (!S.next(0, cur)) return;
    f32x4 acc[2][2][4][2];
#pragma unroll
    for (int a = 0; a < 2; ++a)
#pragma unroll
        for (int b = 0; b < 2; ++b)
#pragma unroll
            for (int m = 0; m < 4; ++m)
#pragma unroll
                for (int n = 0; n < 2; ++n) acc[a][b][m][n] = (f32x4){0.f, 0.f, 0.f, 0.f};
    bf16x8 At[4][2], B0[2][2], B1[2][2];
    unsigned vA[2][2], nvA[2][2];
    PG_GOFFS(cur, 0, vA);
    const char* cAp = Ab + PG_UA(cur); const char* cBp = Bb + PG_UB(cur);
    PG_STAGE_B(PG_SB(0, 0), cBp, 0); PG_STAGE_B(PG_SB(0, 1), cBp, 1); PG_STAGE_A(PG_SA(0, 0), cAp, vA, 0); PG_STAGE_A(PG_SA(0, 1), cAp, vA, 1);
    if (wr == 1) PG_BAR;
    PG_WAIT_V(2); PG_BAR;
    PG_STAGE_B(PG_SB(1, 0), cBp + 128, 0); PG_STAGE_A(PG_SA(1, 0), cAp + 128, vA, 0); PG_STAGE_B(PG_SB(1, 1), cBp + 128, 1);
    PG_WAIT_V(6); PG_BAR;
    for (;;) {
        const bool has_next = S.next(ui + 1, nxt);
        const char* nAp = cAp; const char* nBp = cBp;
        if (has_next) { PG_GOFFS(nxt, ui + 1, nvA); nAp = Ab + PG_UA(nxt); nBp = Bb + PG_UB(nxt); }
        else { if constexpr (GA) {
#pragma unroll
            for (int h = 0; h < 2; ++h)
#pragma unroll
                for (int i = 0; i < 2; ++i) nvA[h][i] = vA[h][i]; } }
#pragma unroll 1
        for (int t = 0; t < nt; t += 2) {
            const bool last = (t == nt - 2);
            const char* a1 = cAp + (size_t)(t + 1) * 128;
            const char* a2 = last ? nAp : cAp + (size_t)(t + 2) * 128; const char* b2 = last ? nBp : cBp + (size_t)(t + 2) * 128;
            const char* a3 = a2 + 128; const char* b3 = b2 + 128;
            unsigned wA[2][2];
            if constexpr (GA) {
#pragma unroll
                for (int h = 0; h < 2; ++h)
#pragma unroll
                    for (int i = 0; i < 2; ++i) wA[h][i] = last ? nvA[h][i] : vA[h][i]; }
            PG_LDB(B0, 0, 0); PG_LDB(B1, 0, 1); PG_SCHED; PG_LDA(At, 0, 0); PG_STAGE_A(PG_SA(1, 1), a1, vA, 1);
            PG_WAIT_V(8); PG_WAIT_L(0); PG_BAR; PG_MMA(0, 0, At, B0); PG_MMA(0, 1, At, B1); PG_BAR; PG_SCHED;
            PG_LDA(At, 0, 1); PG_STAGE_B(PG_SB(0, 0), b2, 0); PG_STAGE_B(PG_SB(0, 1), b2, 1); PG_STAGE_A(PG_SA(0, 0), a2, wA, 0);
            PG_WAIT_V(8); PG_WAIT_L(0); PG_BAR; PG_MMA(1, 0, At, B0); PG_MMA(1, 1, At, B1); PG_BAR; PG_SCHED;
            PG_LDB(B0, 1, 0); PG_LDB(B1, 1, 1); PG_SCHED; PG_LDA(At, 1, 0); PG_STAGE_A(PG_SA(0, 1), a2, wA, 1);
            PG_WAIT_V(8); PG_WAIT_L(0); PG_BAR; PG_MMA(0, 0, At, B0); PG_MMA(0, 1, At, B1); PG_BAR; PG_SCHED;
            PG_LDA(At, 1, 1); PG_STAGE_B(PG_SB(1, 0), b3, 0); PG_STAGE_B(PG_SB(1, 1), b3, 1); PG_STAGE_A(PG_SA(1, 0), a3, wA, 0);
            PG_WAIT_V(8); PG_WAIT_L(0); PG_BAR; PG_MMA(1, 0, At, B0); PG_MMA(1, 1, At, B1); PG_BAR; PG_SCHED;
        }
        if constexpr (ALIGN_EPI) { if (wr == 0) PG_BAR; }
        E(acc, cur, wr, wc, fr, fq);
        if (!has_next) break;
#pragma unroll
        for (int a = 0; a < 2; ++a)
#pragma unroll
            for (int b = 0; b < 2; ++b)
#pragma unroll
                for (int m = 0; m < 4; ++m)
#pragma unroll
                    for (int n = 0; n < 2; ++n) acc[a][b][m][n] = (f32x4){0.f, 0.f, 0.f, 0.f};
        cur = nxt; ++ui; cAp = nAp; cBp = nBp;
        if constexpr (GA) {
#pragma unroll
            for (int h = 0; h < 2; ++h)
#pragma unroll
                for (int i = 0; i < 2; ++i) vA[h][i] = nvA[h][i]; }
        if constexpr (ALIGN_EPI) { if (wr == 1) PG_BAR; }
    }
    PG_WAIT_V(0);
    if constexpr (!ALIGN_EPI) { if (wr == 0) PG_BAR; }
    PG_BAR;
#undef PG_SA
#undef PG_SB
#undef PG_STAGE
#undef PG_LDA
#undef PG_LDB
#undef PG_MMA
#undef PG_WAIT_V
#undef PG_WAIT_L
#undef PG_BAR
#undef PG_SCHED
#undef PG_GOFFS
#undef PG_UA
#undef PG_UB
#undef PG_STAGE_A
#undef PG_STAGE_B
}

constexpr int ROWTAB_OFF = 132096, ETAB_OFF = ROWTAB_OFF + 12 * 1024, MAXU = 12;
struct DenseSched {
    static constexpr bool GATHER = false;
    int nN, nunits, G, c;
    __device__ __forceinline__ void init(LAS unsigned char*, int M, int N, int G_, int c_) { nN = N / 256; nunits = (M / 256) * nN; G = G_; c = c_; }
    __device__ __forceinline__ bool next(int i, Unit& u) const { const int L = i * G + c; if (L >= nunits) return false; u.pm = L / nN; u.pn = L % nN; u.e = 0; return true; }
    __device__ __forceinline__ int arow(const Unit& u, int, int r) const { return 256 * u.pm + r; }
    __device__ __forceinline__ int brow0(const Unit& u) const { return 256 * u.pn; }
};
template <bool GATHER_> struct GroupSched {
    static constexpr bool GATHER = GATHER_;
    LAS int* rowtab; LAS int* etab; int nN, nexp_rows, nunits, G, c;
    __device__ __forceinline__ void init(LAS unsigned char* lds, const int* te, const int* rt, int nN_, int nexp_rows_, int G_, int c_) {
        rowtab = (LAS int*)(lds + ROWTAB_OFF); etab = (LAS int*)(lds + ETAB_OFF); nN = nN_; nexp_rows = nexp_rows_; G = G_; c = c_;
        nunits = __builtin_amdgcn_readfirstlane(te[MAXTILES]) * nN_;
        for (int i = 0; i < MAXU; ++i) { const int L = i * G + c; if (L >= nunits) break; const int pm = L / nN;
            if (threadIdx.x == 0) etab[i] = te[pm];
            if (GATHER && threadIdx.x < 256) rowtab[i * 256 + threadIdx.x] = rt[256 * pm + threadIdx.x]; }
        __syncthreads();
    }
    __device__ __forceinline__ bool next(int i, Unit& u) const { const int L = i * G + c; if (L >= nunits || i >= MAXU) return false; u.pm = L / nN; u.pn = L % nN; u.e = etab[i]; return true; }
    __device__ __forceinline__ int arow(const Unit& u, int ui, int r) const { return GATHER ? rowtab[ui * 256 + r] : 256 * u.pm + r; }
    __device__ __forceinline__ int brow0(const Unit& u) const { return u.e * nexp_rows + 256 * u.pn; }
};

struct EpiProj {
    static constexpr bool PERM = true;
    unsigned char* ws;
    __device__ __forceinline__ void operator()(const f32x4 (&acc)[2][2][4][2], const Unit& u, int wr, int wc, int fr, int fq) const {
        asm volatile("" : "+v"(fr), "+v"(fq));
        bf16_t* LAT = (bf16_t*)(ws + WS_LAT); bf16_t* KM = (bf16_t*)(ws + WS_KM); bf16_t* QB = (bf16_t*)(ws + WS_QB); bf16_t* KB = (bf16_t*)(ws + WS_KB); bf16_t* VB = (bf16_t*)(ws + WS_VB);
        float* rstdp = (float*)(ws + WS_RSTDP); float* kmeanp = (float*)(ws + WS_KMEANP);
        const float* ropeA = (const float*)(ws + WS_ROPEA); const float* ropeB = (const float*)(ws + WS_ROPEB);
#pragma unroll
        for (int b = 0; b < 2; ++b) {
            const int g = 8 * u.pn + 4 * b + wc;
            if (g < 12) {
#pragma unroll
                for (int a = 0; a < 2; ++a)
#pragma unroll
                    for (int m = 0; m < 4; ++m) { const int row = 256 * u.pm + 128 * a + 64 * wr + 16 * m + fr; const f32x4 v0 = acc[a][b][m][0], v1 = acc[a][b][m][1];
                        u32x4 w; w.x = pk2(v0[0], v0[1]); w.y = pk2(v0[2], v0[3]); w.z = pk2(v1[0], v1[1]); w.w = pk2(v1[2], v1[3]);
                        *(u32x4*)(LAT + (size_t)row * 384 + g * 32 + 8 * fq) = w;
                        float ss = 0.f;
#pragma unroll
                        for (int k = 0; k < 4; ++k) { const float e0 = __uint_as_float(w[k] << 16), e1 = __uint_as_float(w[k] & 0xffff0000u); ss += e0 * e0 + e1 * e1; }
                        ss += __shfl_xor(ss, 16); ss += __shfl_xor(ss, 32);
                        if (fq == 0) rstdp[(size_t)row * 12 + g] = ss; }
            } else if (g == 12) {
#pragma unroll
                for (int a = 0; a < 2; ++a)
#pragma unroll
                    for (int m = 0; m < 4; ++m) { const int row = 256 * u.pm + 128 * a + 64 * wr + 16 * m + fr; u32x4 w;
#pragma unroll
                        for (int n = 0; n < 2; ++n) { const f32x4 v = acc[a][b][m][n]; f32x4 pv;
#pragma unroll
                            for (int j = 0; j < 4; ++j) { auto rr = __builtin_amdgcn_permlane32_swap(__float_as_uint(v[j]), __float_as_uint(v[j]), false, false); pv[j] = __uint_as_float(fq < 2 ? rr[1] : rr[0]); }
                            const f32x4 c = *(const f32x4*)(ropeA + (size_t)row * 32 + 8 * (fq & 1) + 4 * n), sn = *(const f32x4*)(ropeA + (size_t)row * 32 + 16 + 8 * (fq & 1) + 4 * n);
                            const f32x4 o = (fq < 2) ? (v * c - pv * sn) : (v * c + pv * sn);
                            w[2 * n] = pk2(o[0], o[1]); w[2 * n + 1] = pk2(o[2], o[3]); }
#pragma unroll
                        for (int h = 0; h < 8; ++h) *(u32x4*)(KM + (size_t)row * 768 + h * 96 + 64 + 8 * fq) = w; }
            } else if (g < 45) {
                const bool isk = g >= 29; const int rel = isk ? g - 29 : g - 13, head = rel >> 1, hf = rel & 1;
                bf16_t* dst = (isk ? KB : QB) + head * 64 + hf * 32 + 8 * fq;
                f32x4 cs0 = (f32x4){0.f, 0.f, 0.f, 0.f}, cs1 = cs0;
#pragma unroll
                for (int a = 0; a < 2; ++a)
#pragma unroll
                    for (int m = 0; m < 4; ++m) { const int row = 256 * u.pm + 128 * a + 64 * wr + 16 * m + fr; f32x4 v0 = acc[a][b][m][0], v1 = acc[a][b][m][1];
                        if (hf == 0) {
#pragma unroll
                            for (int n = 0; n < 2; ++n) { const f32x4 v = n ? v1 : v0; f32x4 pv;
#pragma unroll
                                for (int j = 0; j < 4; ++j) { auto rr = __builtin_amdgcn_permlane16_swap(__float_as_uint(v[j]), __float_as_uint(v[j]), false, false); pv[j] = __uint_as_float((fq & 1) ? rr[0] : rr[1]); }
                                const f32x4 c = *(const f32x4*)(ropeB + (size_t)row * 16 + 4 * n), sn = *(const f32x4*)(ropeB + (size_t)row * 16 + 8 + 4 * n);
                                const f32x4 o = (fq == 0) ? (v * c - pv * sn) : (fq == 1) ? (v * c + pv * sn) : v;
                                if (n) v1 = o; else v0 = o; } }
                        if (isk) { cs0 += v0; cs1 += v1; }
                        const f32x4 s0 = isk ? v0 : v0 * C2B, s1 = isk ? v1 : v1 * C2B;
                        u32x4 w; w.x = pk2(s0[0], s0[1]); w.y = pk2(s0[2], s0[3]); w.z = pk2(s1[0], s1[1]); w.w = pk2(s1[2], s1[3]);
                        *(u32x4*)(dst + (size_t)row * 512) = w; }
                if (isk) {
#pragma unroll
                    for (int j = 0; j < 4; ++j) {
#pragma unroll
                        for (int o = 1; o < 16; o <<= 1) { cs0[j] += __shfl_xor(cs0[j], o); cs1[j] += __shfl_xor(cs1[j], o); } }
                    if (fr == 0) { float* kp = kmeanp + ((size_t)u.pm * 2 + wr) * 512 + head * 64 + hf * 32 + 8 * fq; *(f32x4*)kp = cs0; *(f32x4*)(kp + 4) = cs1; } }
            } else if (g < 61) {
                const int rel = g - 45;
#pragma unroll
                for (int a = 0; a < 2; ++a)
#pragma unroll
                    for (int m = 0; m < 4; ++m) { const int row = 256 * u.pm + 128 * a + 64 * wr + 16 * m + fr; const f32x4 v0 = acc[a][b][m][0], v1 = acc[a][b][m][1];
                        u32x4 w; w.x = pk2(v0[0], v0[1]); w.y = pk2(v0[2], v0[3]); w.z = pk2(v1[0], v1[1]); w.w = pk2(v1[2], v1[3]);
                        *(u32x4*)(VB + (size_t)row * 512 + rel * 32 + 8 * fq) = w; }
            }
            asm volatile("" ::: "memory");
        }
    }
};
struct EpiUp {
    static constexpr bool PERM = true;
    bf16_t *QM, *KM, *VM; const float* rstd; const float* ropeA;
    __device__ __forceinline__ void operator()(const f32x4 (&acc)[2][2][4][2], const Unit& u, int wr, int wc, int fr, int fq) const {
        asm volatile("" : "+v"(fr), "+v"(fq));
#pragma unroll
        for (int a = 0; a < 2; ++a)
#pragma unroll
            for (int m = 0; m < 4; ++m) { const int row = 256 * u.pm + 128 * a + 64 * wr + 16 * m + fr;
                const f32x4 s0 = *(const f32x4*)(rstd + (size_t)row * 12), s1 = *(const f32x4*)(rstd + (size_t)row * 12 + 4), s2 = *(const f32x4*)(rstd + (size_t)row * 12 + 8);
                const float rq = C2A / sqrtf((((s0[0] + s0[1]) + (s0[2] + s0[3])) + ((s1[0] + s1[1]) + (s1[2] + s1[3]))) * (1.0f / 256.0f) + RMS_EPS);
                const float rkv = 1.0f / sqrtf(((s2[0] + s2[1]) + (s2[2] + s2[3])) * (1.0f / 128.0f) + RMS_EPS);
#pragma unroll
                for (int b = 0; b < 2; ++b) {
                    const int gidx = 8 * u.pn + 4 * b + wc;
                    if (gidx < 24) {
                        const int h = gidx / 3, part = gidx % 3;
                        f32x4 v0 = acc[a][b][m][0] * rq, v1 = acc[a][b][m][1] * rq;
                        if (part == 2) {
#pragma unroll
                            for (int n = 0; n < 2; ++n) { const f32x4 v = n ? v1 : v0; f32x4 pv;
#pragma unroll
                                for (int j = 0; j < 4; ++j) { auto rr = __builtin_amdgcn_permlane32_swap(__float_as_uint(v[j]), __float_as_uint(v[j]), false, false); pv[j] = __uint_as_float(fq < 2 ? rr[1] : rr[0]); }
                                const f32x4 c = *(const f32x4*)(ropeA + (size_t)row * 32 + 8 * (fq & 1) + 4 * n), sn = *(const f32x4*)(ropeA + (size_t)row * 32 + 16 + 8 * (fq & 1) + 4 * n);
                                const f32x4 o = (fq < 2) ? (v * c - pv * sn) : (v * c + pv * sn);
                                if (n) v1 = o; else v0 = o; } }
                        u32x4 w; w.x = pk2(v0[0], v0[1]); w.y = pk2(v0[2], v0[3]); w.z = pk2(v1[0], v1[1]); w.w = pk2(v1[2], v1[3]);
                        *(u32x4*)(QM + (size_t)row * 768 + h * 96 + part * 32 + 8 * fq) = w;
                    } else {
                        const int g2 = gidx - 24, h = g2 >> 2, part = g2 & 3;
                        const f32x4 v0 = acc[a][b][m][0] * rkv, v1 = acc[a][b][m][1] * rkv;
                        bf16_t* pp = (part < 2) ? (KM + (size_t)row * 768 + h * 96 + part * 32 + 8 * fq) : (VM + (size_t)row * 512 + h * 64 + (part - 2) * 32 + 8 * fq);
                        u32x4 w; w.x = pk2(v0[0], v0[1]); w.y = pk2(v0[2], v0[3]); w.z = pk2(v1[0], v1[1]); w.w = pk2(v1[2], v1[3]);
                        *(u32x4*)pp = w;
                    }
                }
                asm volatile("" ::: "memory"); }
    }
};
struct EpiWo {
    static constexpr bool PERM = false;
    const float* x; float* O;
    __device__ __forceinline__ void operator()(const f32x4 (&acc)[2][2][4][2], const Unit& u, int wr, int wc, int fr, int fq) const {
        asm volatile("" : "+v"(fr), "+v"(fq));
#pragma unroll
        for (int a = 0; a < 2; ++a)
#pragma unroll
            for (int m = 0; m < 4; ++m) { const int row = 256 * u.pm + 128 * a + 64 * wr + 16 * m + fr;
#pragma unroll
                for (int b = 0; b < 2; ++b)
#pragma unroll
                    for (int n = 0; n < 2; ++n) { const size_t off = (size_t)row * DM + 256 * u.pn + ecol<PERM>(b, n, wc, fq);
                        const f32x4 xv = *(const f32x4*)(x + off); *(f32x4*)(O + off) = xv * DN_ALPHA + acc[a][b][m][n]; } }
    }
};
struct EpiGateUp {
    static constexpr bool PERM = true;
    bf16_t* H; const float *bg, *bu;
    __device__ __forceinline__ void operator()(const f32x4 (&acc)[2][2][4][2], const Unit& u, int wr, int wc, int fr, int fq) const {
        asm volatile("" : "+v"(fr), "+v"(fq));
        const int hc = 128 * u.pn + 32 * wc + 8 * fq;
        f32x4 vbg[2], vbu[2];
#pragma unroll
        for (int n = 0; n < 2; ++n) { vbg[n] = *(const f32x4*)(bg + (size_t)u.e * 1024 + hc + 4 * n); vbu[n] = *(const f32x4*)(bu + (size_t)u.e * 1024 + hc + 4 * n); }
#pragma unroll
        for (int a = 0; a < 2; ++a)
#pragma unroll
            for (int m = 0; m < 4; ++m) { const int row = 256 * u.pm + 128 * a + 64 * wr + 16 * m + fr; u32x4 w;
#pragma unroll
                for (int n = 0; n < 2; ++n) { const f32x4 gv = acc[a][0][m][n] + vbg[n], uv = acc[a][1][m][n] + vbu[n]; float hv[4];
#pragma unroll
                    for (int j = 0; j < 4; ++j) { const float gg = fminf(gv[j], 7.0f), uu = fminf(fmaxf(uv[j], -7.0f), 7.0f);
                        const float sg = __builtin_amdgcn_rcpf(1.0f + __builtin_amdgcn_exp2f(-1.702f * LOG2E * gg)); hv[j] = gg * sg * (uu + 1.0f); }
                    w[2 * n] = pk2(hv[0], hv[1]); w[2 * n + 1] = pk2(hv[2], hv[3]); }
                __builtin_nontemporal_store(w, (u32x4*)(H + (size_t)row * 1024 + hc)); }
    }
};
struct EpiDown {
    static constexpr bool PERM = true;
    bf16_t* Y; const float* bd; const float* row_gate;
    __device__ __forceinline__ void operator()(const f32x4 (&acc)[2][2][4][2], const Unit& u, int wr, int wc, int fr, int fq) const {
        asm volatile("" : "+v"(fr), "+v"(fq));
        f32x4 bv[2][2];
#pragma unroll
        for (int b = 0; b < 2; ++b)
#pragma unroll
            for (int n = 0; n < 2; ++n) bv[b][n] = *(const f32x4*)(bd + (size_t)u.e * 1024 + 256 * u.pn + 128 * b + 32 * wc + 8 * fq + 4 * n);
#pragma unroll
        for (int a = 0; a < 2; ++a)
#pragma unroll
            for (int m = 0; m < 4; ++m) { const int row = 256 * u.pm + 128 * a + 64 * wr + 16 * m + fr; const float gw = row_gate[row];
#pragma unroll
                for (int b = 0; b < 2; ++b) { const int col = 256 * u.pn + 128 * b + 32 * wc + 8 * fq;
                    const f32x4 v0 = (acc[a][b][m][0] + bv[b][0]) * gw, v1 = (acc[a][b][m][1] + bv[b][1]) * gw;
                    u32x4 w; w.x = pk2(v0[0], v0[1]); w.y = pk2(v0[2], v0[3]); w.z = pk2(v1[0], v1[1]); w.w = pk2(v1[2], v1[3]);
                    __builtin_nontemporal_store(w, (u32x4*)(Y + (size_t)row * 1024 + col)); } }
    }
};

__device__ __forceinline__ unsigned cvtpk_hw(float lo, float hi) { typedef __bf16 bf2 __attribute__((ext_vector_type(2))); f32x2 v = {lo, hi}; bf2 b = __builtin_convertvector(v, bf2); return __builtin_bit_cast(unsigned, b); }
__device__ __forceinline__ void conv_issue(const float* W, int ldw, int k0, int n0, LAS unsigned char* scr, int lane) {
#pragma unroll
    for (int i = 0; i < 4; ++i) __builtin_amdgcn_global_load_lds((const unsigned*)(W + (size_t)(k0 + 4 * (lane >> 3) + i) * ldw + n0 + 4 * (lane & 7)), (LAS unsigned*)(scr + i * 1024), 16, 0, 2);
}
__device__ __forceinline__ void conv_finish(bf16_t* WT, int ldt, int orow0, int ocol0, const LAS unsigned char* scr, int lane) {
    f32x4 r[4];
#pragma unroll
    for (int i = 0; i < 4; ++i) r[i] = *(const LAS f32x4*)(scr + i * 1024 + lane * 16);
#pragma unroll
    for (int j = 0; j < 4; ++j) { u32x2 o; o.x = cvtpk_hw(r[0][j], r[1][j]); o.y = cvtpk_hw(r[2][j], r[3][j]);
        *(u32x2*)(WT + (size_t)(orow0 + 4 * (lane & 7) + j) * ldt + ocol0 + 4 * (lane >> 3)) = o; }
}
constexpr int NEXP_ITEMS = 3 * NE * 1024;
__device__ __forceinline__ void expert_issue(const Params& p, int r, LAS unsigned char* scr, int lane) {
    const int mat = r >> 15, rr = r & 32767, e = rr >> 10, q = rr & 1023, kb = (q & 1) | ((q >> 6) << 1), nb = (q >> 1) & 31;
    const float* W = (mat == 0 ? p.w_gate : mat == 1 ? p.w_up : p.w_down) + (size_t)e * 1048576;
    conv_issue(W, 1024, 32 * kb, 32 * nb, scr, lane);
}
__device__ __forceinline__ void expert_finish(const Params& p, int r, const LAS unsigned char* scr, int lane) {
    const int mat = r >> 15, rr = r & 32767, e = rr >> 10, q = rr & 1023, kb = (q & 1) | ((q >> 6) << 1), nb = (q >> 1) & 31, n0 = 32 * nb;
    bf16_t* WguT = (bf16_t*)(p.ws + WS_WGU); bf16_t* WdT = (bf16_t*)(p.ws + WS_WD);
    if (mat == 2) conv_finish(WdT, 1024, e * 1024 + n0, 32 * kb, scr, lane);
    else conv_finish(WguT, 1024, e * 2048 + (n0 >> 7) * 256 + (mat == 1 ? 128 : 0) + (n0 & 127), 32 * kb, scr, lane);
}
struct BgConv { int next, stride, pend0, pend1, itc; };

__device__ __forceinline__ void tr_item(const float* W, int ldw, int k0, int n0, bf16_t* WT, int ldt, int orow0, int ocol0, const float* kscale, LAS float* scr, int lane) {
#pragma unroll 8
    for (int i = 0; i < 32; ++i) { const int kk = 2 * i + (lane >> 5); float v = W[(size_t)(k0 + kk) * ldw + n0 + (lane & 31)]; if (kscale) v *= kscale[k0 + kk]; scr[kk * 33 + (lane & 31)] = v; }
    asm volatile("s_waitcnt lgkmcnt(0)" ::: "memory");
    const int c = lane & 7;
#pragma unroll
    for (int j = 0; j < 4; ++j) { const int n = (lane >> 3) + 8 * j; const LAS float* s = scr + (8 * c) * 33 + n;
        u32x4 o; o.x = pk2(s[0 * 33], s[1 * 33]); o.y = pk2(s[2 * 33], s[3 * 33]); o.z = pk2(s[4 * 33], s[5 * 33]); o.w = pk2(s[6 * 33], s[7 * 33]);
        *(u32x4*)(WT + (size_t)(orow0 + n) * ldt + ocol0 + 8 * c) = o; }
    asm volatile("s_waitcnt lgkmcnt(0)" ::: "memory");
}
__device__ __forceinline__ void phase_prologue(const Params& p, LAS unsigned char* lds, int vcu, int G) {
    const int tid = threadIdx.x, wave = tid >> 6, lane = tid & 63;
    unsigned char* ws = p.ws;
    LAS float* scr = (LAS float*)(lds + wave * 16384);
    const int gw = vcu * NWAVES + wave, NGW = G * NWAVES;
    bf16_t* WinT = (bf16_t*)(ws + WS_WIN); bf16_t* WoT = (bf16_t*)(ws + WS_WO); bf16_t* WupT = (bf16_t*)(ws + WS_WUP);
    constexpr int I_IN = 16 * 61, I_QB = 4 * 24, I_KVB = 2 * 32, I_O = 16 * 32;
    constexpr int NITEMS = I_IN + I_QB + I_KVB + I_O;
    for (int it = gw; it < NITEMS; it += NGW) {
        int r = it;
        if (r < I_IN) { const int kb = r / 61, nb = r % 61; tr_item(p.w_in, IN_COLS, 64 * kb, 32 * nb, WinT, 1024, 32 * nb, 64 * kb, nullptr, scr, lane); continue; } r -= I_IN;
        if (r < I_QB) { const int kb = r / 24, nb = r % 24; tr_item(p.w_q_b, 768, 64 * kb, 32 * nb, WupT, KUP, 32 * nb, 64 * kb, p.q_a_norm, scr, lane); continue; } r -= I_QB;
        if (r < I_KVB) { const int kb = r / 32, nb = r % 32; tr_item(p.w_kv_b, 1024, 64 * kb, 32 * nb, WupT, KUP, 768 + 32 * nb, 256 + 64 * kb, p.kv_a_norm, scr, lane); continue; } r -= I_KVB;
        { const int kb = r / 32, nb = r % 32; tr_item(p.w_o, 1024, 64 * kb, 32 * nb, WoT, 1024, 32 * nb, 64 * kb, nullptr, scr, lane); }
    }
    const int gt = vcu * NTHREADS + tid, NGT = G * NTHREADS;
    for (int i = gt; i < 96 * 128; i += NGT) *(u32x4*)(WinT + (size_t)IN_COLS * 1024 + (size_t)i * 8) = (u32x4){0u, 0u, 0u, 0u};
    for (int i = gt; i < 768 * 16; i += NGT) { const int r = i / 16, c = i % 16; *(u32x4*)(WupT + (size_t)r * KUP + 256 + c * 8) = (u32x4){0u, 0u, 0u, 0u}; }
    for (int i = gt; i < 1024 * 32; i += NGT) { const int r = i / 32, c = i % 32; *(u32x4*)(WupT + (size_t)(768 + r) * KUP + c * 8) = (u32x4){0u, 0u, 0u, 0u}; }
    bf16_t* XB = (bf16_t*)(ws + WS_XB);
    for (int i = gt; i < NTOK * DM / 8; i += NGT) { const f32x4 a = *(const f32x4*)(p.x + (size_t)i * 8), b = *(const f32x4*)(p.x + (size_t)i * 8 + 4);
        u32x4 o; o.x = pk2(a[0], a[1]); o.y = pk2(a[2], a[3]); o.z = pk2(b[0], b[1]); o.w = pk2(b[2], b[3]); *(u32x4*)(XB + (size_t)i * 8) = o; }
    { float* WRL = (float*)(ws + WS_WRL);
      for (int n = gt; n < 32768; n += NGT) { const int e = ((n >> 8) & 7) * 4 + (n & 3), ln = (n >> 2) & 63, ji = n >> 11, j = ji >> 2, i = ji & 3; WRL[n] = p.w_router[(size_t)(4 * ln + 256 * j + i) * 32 + e]; } }
    float* ropeA = (float*)(ws + WS_ROPEA); float* ropeB = (float*)(ws + WS_ROPEB);
    for (int i = gt; i < NTOK * 24; i += NGT) { const int tok = i / 24, j = i % 24; const double f = (j < 16) ? p.invfA[j] : p.invfB[j - 16];
        const double rev = (double)p.pos[tok] * f * 0.15915494309189535; const float fr = (float)(rev - __builtin_rint(rev));
        const float cs = __builtin_amdgcn_cosf(fr), sn = __builtin_amdgcn_sinf(fr);
        if (j < 16) { ropeA[(size_t)tok * 32 + j] = cs; ropeA[(size_t)tok * 32 + 16 + j] = sn; } else { ropeB[(size_t)tok * 16 + (j - 16)] = cs; ropeB[(size_t)tok * 16 + 8 + (j - 16)] = sn; } }
}

__device__ __forceinline__ void phase_prep(const Params& p, LAS unsigned char* lds, int vcu, int G) {
    const int tid = threadIdx.x, wave = tid >> 6, lane = tid & 63;
    unsigned char* ws = p.ws;
    const bf16_t* PROJ = (const bf16_t*)(ws + WS_PROJ);
    float* rstd = (float*)(ws + WS_RSTD); const float* ropeA = (const float*)(ws + WS_ROPEA); const float* ropeB = (const float*)(ws + WS_ROPEB);
    bf16_t* KM = (bf16_t*)(ws + WS_KM); bf16_t* QB = (bf16_t*)(ws + WS_QB); bf16_t* KB = (bf16_t*)(ws + WS_KB); float* kmean = (float*)(ws + WS_KMEAN);
    const int gw = vcu * NWAVES + wave, NGW = G * NWAVES;
    for (int row = gw; row < NTOK; row += NGW) {
        float s = 0.f;
        if (lane < 48) { const u32x4 v = *(const u32x4*)(PROJ + (size_t)row * PN + lane * 8);
#pragma unroll
            for (int q = 0; q < 4; ++q) { const float a = __uint_as_float(v[q] << 16), b = __uint_as_float(v[q] & 0xffff0000u); s += a * a + b * b; } }
#pragma unroll
        for (int o = 1; o < 32; o <<= 1) s += __shfl_xor(s, o);
        if (lane == 0) rstd[2 * row] = 1.0f / sqrtf(s * (1.0f / 256.0f) + RMS_EPS);
        if (lane == 32) rstd[2 * row + 1] = 1.0f / sqrtf(s * (1.0f / 128.0f) + RMS_EPS);
    }
    const int gt = vcu * NTHREADS + tid, NGT = G * NTHREADS;
    for (int i = gt; i < NTOK * 16; i += NGT) { const int tok = i >> 4, j = i & 15;
        const float x1 = bf2f(PROJ[(size_t)tok * PN + C_KR + j]), x2 = bf2f(PROJ[(size_t)tok * PN + C_KR + 16 + j]);
        const float c = ropeA[(size_t)tok * 32 + j], s = ropeA[(size_t)tok * 32 + 16 + j];
        const bf16_t o1 = (bf16_t)f2bf(x1 * c - x2 * s), o2 = (bf16_t)f2bf(x2 * c + x1 * s);
#pragma unroll
        for (int h = 0; h < 8; ++h) { KM[(size_t)tok * 768 + h * 96 + 64 + j] = o1; KM[(size_t)tok * 768 + h * 96 + 80 + j] = o2; } }
    LAS float* red = (LAS float*)lds;
    for (int unit = vcu; unit < 512; unit += G) {
        const int ub = unit >> 3, h = unit & 7, tg = tid >> 6, d = tid & 63, c = h * 64 + d; float ksum = 0.f;
#pragma unroll 4
        for (int i = 0; i < 32; ++i) { const int tok = ub * 256 + tg * 32 + i; const bf16_t* pr = PROJ + (size_t)tok * PN;
            float qv = bf2f(pr[C_MQ + c]), kv = bf2f(pr[C_MK + c]);
            if (d < 16) { const int j = d & 7; const float cs = ropeB[(size_t)tok * 16 + j], sn = ropeB[(size_t)tok * 16 + 8 + j];
                if (d < 8) { const float q2 = bf2f(pr[C_MQ + c + 8]), k2 = bf2f(pr[C_MK + c + 8]); qv = qv * cs - q2 * sn; kv = kv * cs - k2 * sn; }
                else { const float q1 = bf2f(pr[C_MQ + c - 8]), k1 = bf2f(pr[C_MK + c - 8]); qv = qv * cs + q1 * sn; kv = kv * cs + k1 * sn; } }
            QB[(size_t)tok * 512 + c] = (bf16_t)f2bf(qv * C2B); KB[(size_t)tok * 512 + c] = (bf16_t)f2bf(kv); ksum += kv; }
        red[tg * 64 + d] = ksum;
        __syncthreads();
        if (tid < 64) { float t = 0.f;
#pragma unroll
            for (int g8 = 0; g8 < 8; ++g8) t += red[g8 * 64 + tid];
            kmean[(size_t)ub * 512 + h * 64 + tid] = t * (1.0f / 256.0f); }
        __syncthreads();
    }
}

typedef float f32x16 __attribute__((ext_vector_type(16)));
typedef short s16x4 __attribute__((ext_vector_type(4)));
namespace fa {
constexpr int KBUF = 12288, VBUF = 8192, VOFF = 3 * KBUF, WS_OFF = VOFF + 3 * VBUF, LDS_NEED = WS_OFF + 8 * 256;
__device__ __forceinline__ void wait_vm(int n) {
    switch (n) {
#define FA_W(k) case k: asm volatile("s_waitcnt vmcnt(" #k ")" ::: "memory"); break;
        FA_W(0) FA_W(1) FA_W(2) FA_W(3) FA_W(4) FA_W(5) FA_W(6) FA_W(7) FA_W(8) FA_W(9) FA_W(10) FA_W(11) FA_W(12) FA_W(13) FA_W(14) FA_W(15)
#undef FA_W
        default: asm volatile("s_waitcnt vmcnt(15)" ::: "memory"); break; }
}
constexpr float THR = 8.0f;
__device__ __forceinline__ int crow(int r, int hi) { return (r & 3) + 8 * (r >> 2) + 4 * hi; }
__device__ __forceinline__ unsigned cvtpk(float lo, float hi) { typedef __bf16 bf2 __attribute__((ext_vector_type(2))); f32x2 v = {lo, hi}; bf2 b = __builtin_convertvector(v, bf2); return __builtin_bit_cast(unsigned, b); }
__device__ __forceinline__ float xhalf_max(float m) { auto rr = __builtin_amdgcn_permlane32_swap(__float_as_uint(m), __float_as_uint(m), false, false); return fmaxf(__uint_as_float(rr[0]), __uint_as_float(rr[1])); }
__device__ __forceinline__ float xhalf_sum(float m) { auto rr = __builtin_amdgcn_permlane32_swap(__float_as_uint(m), __float_as_uint(m), false, false); return __uint_as_float(rr[0]) + __uint_as_float(rr[1]); }
__device__ __forceinline__ float mx3(float a, float b, float c) { return __builtin_fmaxf(__builtin_fmaxf(a, b), c); }
}
template <int DQK>
__device__ __forceinline__ void attn_unit(LAS unsigned char* lds, const bf16_t* Q, int qpitch, const bf16_t* K, int kpitch, const bf16_t* V, int vpitch, bf16_t* O, int qb, const float* kmean, const Params& p, BgConv& bg) {
    using namespace fa;
    constexpr int ND = DQK / 16, NCH = DQK / 8;
    const int tid = threadIdx.x, lane = tid & 63, r32 = lane & 31, hi = lane >> 5, wid = __builtin_amdgcn_readfirstlane(tid >> 6);
    const int q0 = qb * 256, qrel = wid * 32 + r32;
    LAS float* wsf = (LAS float*)(lds + WS_OFF) + wid * 64;
    bf16x8 qr[ND];
#pragma unroll
    for (int d0 = 0; d0 < ND; ++d0) qr[d0] = *(const bf16x8*)(Q + (size_t)(q0 + qrel) * qpitch + d0 * 16 + hi * 8);
    unsigned sel = 0xffu;
    if (kmean) {
        float gt[8];
#pragma unroll
        for (int n = 0; n < 8; ++n) gt[n] = -INFINITY;
#pragma unroll 1
        for (int n = 0; n < qb; ++n) { float s = 0.f; const float* km = kmean + (size_t)n * 1024;
#pragma unroll
            for (int d0 = 0; d0 < ND; ++d0) { const f32x4 k0 = *(const f32x4*)(km + d0 * 16 + hi * 8) + *(const f32x4*)(km + 512 + d0 * 16 + hi * 8), k1 = *(const f32x4*)(km + d0 * 16 + hi * 8 + 4) + *(const f32x4*)(km + 512 + d0 * 16 + hi * 8 + 4);
#pragma unroll
                for (int j = 0; j < 4; ++j) { s = fmaf(bf2f((unsigned short)qr[d0][j]), k0[j], s); s = fmaf(bf2f((unsigned short)qr[d0][4 + j]), k1[j], s); } }
            s = xhalf_sum(s);
#pragma unroll
            for (int j = 0; j < 8; ++j) gt[j] = (j == n) ? s : gt[j]; }
        sel = 0u;
#pragma unroll
        for (int n = 0; n < 8; ++n) { int cnt = 0;
#pragma unroll
            for (int n2 = 0; n2 < 8; ++n2) if (n2 != n) cnt += (n2 < qb && (gt[n2] > gt[n] || (gt[n2] == gt[n] && n2 < n))) ? 1 : 0;
            if (n < qb && cnt < 3) sel |= 1u << n; }
    }
    const bf16_t* ksrc = K + (size_t)lane * kpitch;
    const bf16_t* vsrc = V + (size_t)(16 * (wid & 3) + (lane >> 2)) * vpitch + (wid >> 2) * 32 + (lane & 3) * 8;
#define FA_DMA(ti, kslot, vslot) do { \
        __builtin_amdgcn_global_load_lds((const unsigned*)(ksrc + (size_t)(ti) * 64 * kpitch + wid * 8), (LAS unsigned*)(lds + (kslot) * KBUF + wid * 1024), 16, 0, 0); \
        if (NCH > 8 && wid < NCH - 8) __builtin_amdgcn_global_load_lds((const unsigned*)(ksrc + (size_t)(ti) * 64 * kpitch + (wid + 8) * 8), (LAS unsigned*)(lds + (kslot) * KBUF + (wid + 8) * 1024), 16, 0, 0); \
        __builtin_amdgcn_global_load_lds((const unsigned*)(vsrc + (size_t)(ti) * 64 * vpitch), (LAS unsigned*)(lds + VOFF + (vslot) * VBUF + wid * 1024), 16, 0, 0); } while (0)
#define FA_TILE(i) (((i) < 4) ? 4 * qb + (i) : (i) - 4)
#define FA_PV(vslot) do { const LAS unsigned char* vb_ = lds + VOFF + (vslot) * VBUF + voff; \
        _Pragma("unroll") for (int d0 = 0; d0 < 2; ++d0) _Pragma("unroll") for (int s_ = 0; s_ < 4; ++s_) { \
            const s16x4 lo_ = __builtin_bit_cast(s16x4, __builtin_amdgcn_ds_read_tr16_b64_v4i16((LAS s16x4*)(vb_ + d0 * 4096 + s_ * 1024))); \
            const s16x4 hh_ = __builtin_bit_cast(s16x4, __builtin_amdgcn_ds_read_tr16_b64_v4i16((LAS s16x4*)(vb_ + d0 * 4096 + s_ * 1024 + 512))); \
            const bf16x8 vf_ = (bf16x8){lo_[0], lo_[1], lo_[2], lo_[3], hh_[0], hh_[1], hh_[2], hh_[3]}; \
            o[d0] = __builtin_amdgcn_mfma_f32_32x32x16_bf16(__builtin_bit_cast(bf16x8, pw[s_]), vf_, o[d0], 0, 0, 0); } } while (0)
    const int NT = 4 * qb + 4;
    float mhat = 0.f, l_reg = 0.f; f32x16 o[2]; o[0] = f32x16{}; o[1] = f32x16{}; f32x16 negm = f32x16{};
    const int koff = hi * 1024 + r32 * 16;
    const int voff = ((lane >> 4) & 1) * 32 + (lane & 3) * 8 + (4 * hi + ((lane & 15) >> 2)) * 64;
    u32x4 pw[4];
    const int nkv = (NCH > 8 && wid < NCH - 8) ? 3 : 2;
    FA_DMA(FA_TILE(0), 0, 0);
    if (NT > 1) { FA_DMA(FA_TILE(1), 1, 1); }
    wait_vm(NT > 1 ? nkv : 0); asm volatile("s_waitcnt lgkmcnt(0)" ::: "memory"); __builtin_amdgcn_s_barrier(); asm volatile("" ::: "memory");
    int sl = 0, prevB = 0, opsPrev = 0;
    for (int i = 0; i < NT; ++i) {
        const int sl1 = (sl == 2) ? 0 : sl + 1, sl2 = (sl1 == 2) ? 0 : sl1 + 1;
        LAS unsigned char* bscr = lds + LDS_NEED + wid * 8192 + (bg.itc & 1) * 4096;
        int young = prevB, ops = 0;
        if (bg.itc & 1) { if (bg.pend1 >= 0) { wait_vm(opsPrev); expert_finish(p, bg.pend1, bscr, lane); bg.pend1 = -1; ops += 4; asm volatile("s_waitcnt lgkmcnt(0)" ::: "memory"); } }
        else            { if (bg.pend0 >= 0) { wait_vm(opsPrev); expert_finish(p, bg.pend0, bscr, lane); bg.pend0 = -1; ops += 4; asm volatile("s_waitcnt lgkmcnt(0)" ::: "memory"); } }
        if (i + 2 < NT) { const int tn = FA_TILE(i + 2); FA_DMA(tn, sl2, sl2); ops += nkv; }
        const bool bgdo = (bg.itc % 3 != 2) && bg.next < NEXP_ITEMS;
        if (bgdo) { expert_issue(p, bg.next, bscr, lane); if (bg.itc & 1) bg.pend1 = bg.next; else bg.pend0 = bg.next; bg.next += bg.stride; ops += 4; }
        young += ops; prevB = bgdo ? 4 : 0;
        ++bg.itc;
        const bool band = i < 4;
        if (!(band && 2 * i > wid)) {
            const LAS unsigned char* kb = lds + sl * KBUF + koff;
            f32x16 p0 = negm, p1 = negm;
            if (kmean && !band) { if (!__all((sel >> ((i - 4) >> 2)) & 1u)) {
                    const bool ok = ((sel >> ((i - 4) >> 2)) & 1u) != 0u;
#pragma unroll
                    for (int r = 0; r < 16; ++r) p0[r] = ok ? negm[r] : -INFINITY;
                    p1 = p0; } }
#pragma unroll
            for (int d0 = 0; d0 < ND; ++d0) { const bf16x8 a0 = *(const LAS bf16x8*)(kb + d0 * 2048), a1 = *(const LAS bf16x8*)(kb + d0 * 2048 + 512);
                p0 = __builtin_amdgcn_mfma_f32_32x32x16_bf16(a0, qr[d0], p0, 0, 0, 0); p1 = __builtin_amdgcn_mfma_f32_32x32x16_bf16(a1, qr[d0], p1, 0, 0, 0); }
            if (band) { if (64 * i + 63 > 32 * wid) {
#pragma unroll
                    for (int r = 0; r < 16; ++r) { const int kv = 64 * i + crow(r, hi); if (kv > qrel) p0[r] = -INFINITY; if (kv + 32 > qrel) p1[r] = -INFINITY; } } }
            float ra = mx3(p0[0], p0[1], p1[0]), rb = mx3(p0[2], p0[3], p1[1]); ra = mx3(ra, p1[2], p1[3]);
#pragma unroll
            for (int r = 4; r < 16; r += 4) { ra = mx3(ra, p0[r], p0[r + 1]); rb = mx3(rb, p0[r + 2], p0[r + 3]); ra = mx3(ra, p1[r], p1[r + 1]); rb = mx3(rb, p1[r + 2], p1[r + 3]); }
            const float rm = xhalf_max(__builtin_fmaxf(ra, rb));
            if (i == 0 || __any(rm > THR)) {
                const float dl = (i == 0) ? rm : fmaxf(rm, 0.f); mhat += dl;
#pragma unroll
                for (int r = 0; r < 16; ++r) { p0[r] -= dl; p1[r] -= dl; negm[r] = -mhat; }
                if (i != 0) { const float f = __builtin_amdgcn_exp2f(-dl); l_reg *= f; if (hi == 0) wsf[r32] = f;
                    asm volatile("s_waitcnt lgkmcnt(0)" ::: "memory");
#pragma unroll
                    for (int r = 0; r < 16; ++r) { const float fr_ = wsf[crow(r, hi)]; o[0][r] *= fr_; o[1][r] *= fr_; } }
            }
            f32x2 sacc = {0.f, 0.f};
#pragma unroll
            for (int r = 0; r < 16; ++r) { p0[r] = __builtin_amdgcn_exp2f(p0[r]); p1[r] = __builtin_amdgcn_exp2f(p1[r]); }
#pragma unroll
            for (int r = 0; r < 16; r += 2) { sacc += (f32x2){p0[r], p0[r + 1]}; sacc += (f32x2){p1[r], p1[r + 1]}; }
            l_reg += sacc[0] + sacc[1];
#pragma unroll
            for (int s = 0; s < 2; ++s)
#pragma unroll
                for (int j = 0; j < 4; ++j) { pw[s][j] = cvtpk(p0[8 * s + 2 * j], p0[8 * s + 2 * j + 1]); pw[2 + s][j] = cvtpk(p1[8 * s + 2 * j], p1[8 * s + 2 * j + 1]); }
            FA_PV(sl);
        }
        asm volatile("s_waitcnt lgkmcnt(0)" ::: "memory"); wait_vm(young);
        __builtin_amdgcn_s_barrier(); asm volatile("" ::: "memory");
        sl = sl1; opsPrev = ops;
    }
    l_reg = xhalf_sum(l_reg);
    if (hi == 0) wsf[32 + r32] = l_reg;
    asm volatile("s_waitcnt lgkmcnt(0)" ::: "memory");
#pragma unroll
    for (int r = 0; r < 16; ++r) { const float rl = 1.0f / wsf[32 + crow(r, hi)]; bf16_t* op = O + (size_t)(q0 + wid * 32 + crow(r, hi)) * 1024 + r32;
        op[0] = (bf16_t)f2bf(o[0][r] * rl); op[32] = (bf16_t)f2bf(o[1][r] * rl); }
    asm volatile("s_waitcnt lgkmcnt(0)" ::: "memory"); __builtin_amdgcn_s_barrier(); asm volatile("" ::: "memory");
#undef FA_DMA
#undef FA_TILE
#undef FA_PV
}
__device__ __forceinline__ void phase_attn_fast(const Params& p, LAS unsigned char* lds, int vcu, int G, bool do_conv) {
    unsigned char* ws = p.ws;
    const bf16_t* QM = (const bf16_t*)(ws + WS_QM); const bf16_t* KM = (const bf16_t*)(ws + WS_KM); const bf16_t* VM = (const bf16_t*)(ws + WS_VM);
    const bf16_t* QB = (const bf16_t*)(ws + WS_QB); const bf16_t* KB = (const bf16_t*)(ws + WS_KB); const bf16_t* VB = (const bf16_t*)(ws + WS_VB);
    const float* kmean = (const float*)(ws + WS_KMEANP); bf16_t* ATT = (bf16_t*)(ws + WS_ATT);
    const int wave_ = __builtin_amdgcn_readfirstlane(threadIdx.x >> 6);
    BgConv bg; bg.next = do_conv ? vcu * NWAVES + wave_ : NEXP_ITEMS; bg.stride = G * NWAVES; bg.pend0 = -1; bg.pend1 = -1; bg.itc = 0;
    for (int su = vcu; su < 256; su += G) {
        const int bh = su >> 2, j = su & 3, b = bh >> 3, h = bh & 7; const size_t r0 = (size_t)b * SEQ;
#pragma unroll 1
        for (int k = 0; k < 2; ++k) { const int qb = k ? 7 - j : j;
            attn_unit<96>(lds, QM + r0 * 768 + h * 96, 768, KM + r0 * 768 + h * 96, 768, VM + r0 * 512 + h * 64, 512, ATT + r0 * 1024 + h * 64, qb, nullptr, p, bg);
            attn_unit<64>(lds, QB + r0 * 512 + h * 64, 512, KB + r0 * 512 + h * 64, 512, VB + r0 * 512 + h * 64, 512, ATT + r0 * 1024 + 512 + h * 64, qb, kmean + (size_t)(b * 8) * 1024 + h * 64, p, bg); }
    }
    { const int lane = threadIdx.x & 63; LAS unsigned char* bscr = lds + fa::LDS_NEED + wave_ * 8192;
      asm volatile("s_waitcnt vmcnt(0)" ::: "memory");
      if (bg.pend0 >= 0) { expert_finish(p, bg.pend0, bscr, lane); bg.pend0 = -1; }
      if (bg.pend1 >= 0) { expert_finish(p, bg.pend1, bscr + 4096, lane); bg.pend1 = -1; }
      asm volatile("s_waitcnt lgkmcnt(0)" ::: "memory");
#pragma unroll 1
      for (; bg.next < NEXP_ITEMS; bg.next += bg.stride) { expert_issue(p, bg.next, bscr, lane); asm volatile("s_waitcnt vmcnt(0)" ::: "memory"); expert_finish(p, bg.next, bscr, lane); asm volatile("s_waitcnt lgkmcnt(0)" ::: "memory"); } }
}

__device__ __forceinline__ float rs32(float (&a)[32], int lane) {
#pragma unroll
    for (int e = 0; e < 16; ++e) { auto rr = __builtin_amdgcn_permlane32_swap(__float_as_uint(a[e]), __float_as_uint(a[e + 16]), false, false); a[e] = __uint_as_float(rr[0]) + __uint_as_float(rr[1]); }
#pragma unroll
    for (int e = 0; e < 8; ++e) { auto rr = __builtin_amdgcn_permlane16_swap(__float_as_uint(a[e]), __float_as_uint(a[e + 8]), false, false); a[e] = __uint_as_float(rr[0]) + __uint_as_float(rr[1]); }
    { const bool bit = (lane & 8) != 0;
#pragma unroll
      for (int e = 0; e < 4; ++e) { const float keep = bit ? a[e + 4] : a[e], send = bit ? a[e] : a[e + 4]; a[e] = keep + __shfl_xor(send, 8); } }
    { const bool bit = (lane & 4) != 0;
#pragma unroll
      for (int e = 0; e < 2; ++e) { const float keep = bit ? a[e + 2] : a[e], send = bit ? a[e] : a[e + 2]; a[e] = keep + __shfl_xor(send, 4); } }
    { const bool bit = (lane & 2) != 0; const float keep = bit ? a[1] : a[0], send = bit ? a[0] : a[1]; a[0] = keep + __shfl_xor(send, 2); }
    return a[0] + __shfl_xor(a[0], 1);
}
__device__ __forceinline__ void route_row(const Params& p, float logit, int tok, int tl, int lane, int* tidx, float* tgate, LAS int* lidx) {
    const int me = lane >> 1;
    const float my = (lane & 1) ? -INFINITY : logit + p.b_router[me];
    int rank = 0;
#pragma unroll
    for (int e = 0; e < 32; ++e) { const float ve = __uint_as_float(__builtin_amdgcn_readlane(__float_as_uint(my), 2 * e)); rank += (ve > my || (ve == my && e < me)) ? 1 : 0; }
    float tv[4]; int ti[4];
#pragma unroll
    for (int k = 0; k < 4; ++k) { const unsigned long long bal = __ballot(rank == k && !(lane & 1)); const int il = __ffsll((long long)bal) - 1;
        tv[k] = __uint_as_float(__builtin_amdgcn_readlane(__float_as_uint(my), il)); ti[k] = il >> 1; }
    if (lane == 0) { const float e1 = expf(tv[1] - tv[0]), e2 = expf(tv[2] - tv[0]), e3 = expf(tv[3] - tv[0]); const float is = 1.0f / (1.0f + e1 + e2 + e3);
        *(f32x4*)(tgate + (size_t)tok * 4) = (f32x4){is, e1 * is, e2 * is, e3 * is};
        int* tp = tidx + (size_t)tok * 4; tp[0] = ti[0]; tp[1] = ti[1]; tp[2] = ti[2]; tp[3] = ti[3];
        lidx[tl * 4 + 0] = ti[0]; lidx[tl * 4 + 1] = ti[1]; lidx[tl * 4 + 2] = ti[2]; lidx[tl * 4 + 3] = ti[3]; }
}
__device__ __forceinline__ void phase_ln1_route(const Params& p, LAS unsigned char* lds, int vcu, int G) {
    const int tid = threadIdx.x, wave = tid >> 6, lane = tid & 63;
    unsigned char* ws = p.ws;
    float* X1 = p.out; const float* X1P = (const float*)(ws + WS_X1PRE); bf16_t* X1B = (bf16_t*)(ws + WS_X1B);
    int* tidx = (int*)(ws + WS_TIDX); float* tgate = (float*)(ws + WS_TGATE); unsigned* hist = (unsigned*)(ws + WS_HIST);
    LAS int* lidx = (LAS int*)(lds + ROWTAB_OFF);
    { const float* WRL = (const float*)(ws + WS_WRL);
      for (int i = tid; i < 8192; i += NTHREADS) *(LAS f32x4*)(lds + (size_t)i * 16) = *(const f32x4*)(WRL + (size_t)i * 4); }
    __syncthreads();
    const LAS float* Wl = (const LAS float*)lds + lane * 4;
    for (int chunk = vcu; chunk < NCHUNK; chunk += G) {
#pragma unroll 1
        for (int rp = 0; rp < 4; ++rp) {
            const int tl = wave * 8 + 2 * rp, tok = chunk * 64 + tl;
            f32x4 v0[4], v1[4]; float s0 = 0.f, s1 = 0.f;
#pragma unroll
            for (int j = 0; j < 4; ++j) { v0[j] = *(const f32x4*)(X1P + (size_t)tok * DM + 4 * lane + 256 * j); v1[j] = *(const f32x4*)(X1P + (size_t)(tok + 1) * DM + 4 * lane + 256 * j);
                s0 += (v0[j][0] + v0[j][1]) + (v0[j][2] + v0[j][3]); s1 += (v1[j][0] + v1[j][1]) + (v1[j][2] + v1[j][3]); }
            const float mean0 = wave_sum(s0) * (1.0f / DM), mean1 = wave_sum(s1) * (1.0f / DM); float q0 = 0.f, q1 = 0.f;
#pragma unroll
            for (int j = 0; j < 4; ++j) { v0[j] = v0[j] - mean0; v1[j] = v1[j] - mean1;
                q0 += (v0[j][0] * v0[j][0] + v0[j][1] * v0[j][1]) + (v0[j][2] * v0[j][2] + v0[j][3] * v0[j][3]); q1 += (v1[j][0] * v1[j][0] + v1[j][1] * v1[j][1]) + (v1[j][2] * v1[j][2] + v1[j][3] * v1[j][3]); }
            const float rs0 = 1.0f / sqrtf(wave_sum(q0) * (1.0f / DM) + LN_EPS), rs1 = 1.0f / sqrtf(wave_sum(q1) * (1.0f / DM) + LN_EPS);
#pragma unroll
            for (int j = 0; j < 4; ++j) { const f32x4 g = *(const f32x4*)(p.ln1_g + 4 * lane + 256 * j), bb = *(const f32x4*)(p.ln1_b + 4 * lane + 256 * j);
                v0[j] = v0[j] * rs0 * g + bb; v1[j] = v1[j] * rs1 * g + bb;
                *(f32x4*)(X1 + (size_t)tok * DM + 4 * lane + 256 * j) = v0[j]; *(f32x4*)(X1 + (size_t)(tok + 1) * DM + 4 * lane + 256 * j) = v1[j];
                u32x2 w; w.x = pk2(v0[j][0], v0[j][1]); w.y = pk2(v0[j][2], v0[j][3]); *(u32x2*)(X1B + (size_t)tok * DM + 4 * lane + 256 * j) = w;
                w.x = pk2(v1[j][0], v1[j][1]); w.y = pk2(v1[j][2], v1[j][3]); *(u32x2*)(X1B + (size_t)(tok + 1) * DM + 4 * lane + 256 * j) = w; }
            float a0[32], a1[32];
#pragma unroll
            for (int e = 0; e < 32; ++e) { a0[e] = 0.f; a1[e] = 0.f; }
            const LAS float* wlo = Wl; const LAS float* whi = Wl + 8 * 2048;
            asm volatile("" : "+v"(wlo), "+v"(whi));
#pragma unroll
            for (int j = 0; j < 4; ++j)
#pragma unroll
                for (int i = 0; i < 4; ++i) { const float x0 = v0[j][i], x1 = v1[j][i]; const LAS float* wb = (j < 2) ? wlo + (j * 4 + i) * 2048 : whi + ((j - 2) * 4 + i) * 2048;
#pragma unroll
                    for (int e4 = 0; e4 < 8; ++e4) { const f32x4 w = *(const LAS f32x4*)(wb + e4 * 256);
#pragma unroll
                        for (int k = 0; k < 4; ++k) { a0[4 * e4 + k] = fmaf(x0, w[k], a0[4 * e4 + k]); a1[4 * e4 + k] = fmaf(x1, w[k], a1[4 * e4 + k]); } }
                    asm volatile("" ::: "memory"); }
            const float l0 = rs32(a0, lane), l1 = rs32(a1, lane);
            route_row(p, l0, tok, tl, lane, tidx, tgate, lidx);
            route_row(p, l1, tok + 1, tl + 1, lane, tidx, tgate, lidx);
        }
        __syncthreads();
        if (tid < 32) { unsigned c = 0; for (int a = 0; a < 256; ++a) c += (lidx[a] == tid) ? 1u : 0u; hist[chunk * 32 + tid] = c; }
        __syncthreads();
    }
}

__device__ __forceinline__ void phase_assign(const Params& p, LAS unsigned char* lds, int vcu, int G) {
    const int tid = threadIdx.x;
    unsigned char* ws = p.ws;
    const int* tidx = (const int*)(ws + WS_TIDX); const float* tgate = (const float*)(ws + WS_TGATE); const unsigned* hist = (const unsigned*)(ws + WS_HIST);
    int* dest = (int*)(ws + WS_DEST); int* row_tok = (int*)(ws + WS_ROWTOK); float* row_gate = (float*)(ws + WS_ROWGATE); int* tile_e = (int*)(ws + WS_TILEE);
    LAS int* lidx = (LAS int*)lds;
    LAS int* lcnt = (LAS int*)(lds + 1024);
    LAS int* lpre = (LAS int*)(lds + 1024 + 128);
    LAS int* lstart = (LAS int*)(lds + 1024 + 256);
    LAS int* ptot = (LAS int*)(lds + 2048);
    LAS int* ppre = (LAS int*)(lds + 4096);
    for (int chunk = vcu; chunk < NCHUNK; chunk += G) {
        if (tid < 256) lidx[tid] = tidx[chunk * 256 + tid];
        { const int e = tid & 31, cg = tid >> 5; int tot = 0, pre = 0;
#pragma unroll
          for (int k = 0; k < 16; ++k) { const int c = cg * 16 + k; const int hv = (int)hist[c * 32 + e]; tot += hv; pre += (c < chunk) ? hv : 0; }
          ptot[cg * 32 + e] = tot; ppre[cg * 32 + e] = pre; }
        __syncthreads();
        if (tid < 32) { int tot = 0, pre = 0;
#pragma unroll
            for (int cg = 0; cg < 16; ++cg) { tot += ptot[cg * 32 + tid]; pre += ppre[cg * 32 + tid]; }
            lcnt[tid] = tot; lpre[tid] = pre; }
        __syncthreads();
        if (tid == 0) { int s2 = 0; for (int e = 0; e < 32; ++e) { lstart[e] = s2; s2 += (lcnt[e] + 255) / 256 * 256; } lstart[32] = s2; }
        __syncthreads();
        if (tid < 256) { const int e = lidx[tid]; int rank = 0; for (int a = 0; a < tid; ++a) rank += (lidx[a] == e) ? 1 : 0;
            const int P = lstart[e] + lpre[e] + rank, tok = chunk * 64 + (tid >> 2);
            row_tok[P] = tok; row_gate[P] = tgate[chunk * 256 + tid]; dest[chunk * 256 + tid] = P; }
        if (chunk < 32) { const int e = chunk; for (int P = lstart[e] + lcnt[e] + tid; P < lstart[e + 1]; P += NTHREADS) { row_tok[P] = 0; row_gate[P] = 0.f; } }
        if (chunk == 0) { if (tid < 32) { for (int t = lstart[tid] / 256; t < lstart[tid + 1] / 256; ++t) tile_e[t] = tid; } if (tid == 32) tile_e[MAXTILES] = lstart[32] / 256; }
        __syncthreads();
    }
}

__device__ __forceinline__ void phase_final(const Params& p, int vcu, int G, float* outp) {
    const int tid = threadIdx.x, wave = tid >> 6, lane = tid & 63;
    unsigned char* ws = p.ws;
    const int* dest = (const int*)(ws + WS_DEST); const bf16_t* Y = (const bf16_t*)(ws + WS_Y); float* X1 = p.out;
    const int gw = vcu * NWAVES + wave, NGW = G * NWAVES;
    for (int t0 = gw * 8; t0 < NTOK; t0 += NGW * 8) {
        const int dl = (lane < 32) ? dest[t0 * 4 + lane] : 0;
#pragma unroll
        for (int pr = 0; pr < 4; ++pr) {
            const int tok = t0 + 2 * pr;
            int P[2][4];
#pragma unroll
            for (int t = 0; t < 2; ++t)
#pragma unroll
                for (int k = 0; k < 4; ++k) P[t][k] = __builtin_amdgcn_readlane(dl, (2 * pr + t) * 4 + k);
            f32x4 v[2][4]; u32x2 y[2][4][4];
#pragma unroll
            for (int t = 0; t < 2; ++t)
#pragma unroll
                for (int j = 0; j < 4; ++j) { v[t][j] = *(const f32x4*)(X1 + (size_t)(tok + t) * DM + 4 * lane + 256 * j);
#pragma unroll
                    for (int k = 0; k < 4; ++k) y[t][k][j] = *(const u32x2*)(Y + (size_t)P[t][k] * 1024 + 4 * lane + 256 * j); }
            float s[2], q[2];
#pragma unroll
            for (int t = 0; t < 2; ++t) { s[t] = 0.f;
#pragma unroll
                for (int j = 0; j < 4; ++j) { v[t][j] = v[t][j] * DN_ALPHA;
#pragma unroll
                    for (int k = 0; k < 4; ++k) { const u32x2 w = y[t][k][j];
                        v[t][j][0] += __uint_as_float(w.x << 16); v[t][j][1] += __uint_as_float(w.x & 0xffff0000u); v[t][j][2] += __uint_as_float(w.y << 16); v[t][j][3] += __uint_as_float(w.y & 0xffff0000u); }
                    s[t] += (v[t][j][0] + v[t][j][1]) + (v[t][j][2] + v[t][j][3]); } }
            const float mean0 = wave_sum(s[0]) * (1.0f / DM), mean1 = wave_sum(s[1]) * (1.0f / DM);
            q[0] = 0.f; q[1] = 0.f;
#pragma unroll
            for (int j = 0; j < 4; ++j) { v[0][j] = v[0][j] - mean0; v[1][j] = v[1][j] - mean1;
                q[0] += (v[0][j][0] * v[0][j][0] + v[0][j][1] * v[0][j][1]) + (v[0][j][2] * v[0][j][2] + v[0][j][3] * v[0][j][3]);
                q[1] += (v[1][j][0] * v[1][j][0] + v[1][j][1] * v[1][j][1]) + (v[1][j][2] * v[1][j][2] + v[1][j][3] * v[1][j][3]); }
            const float rs0 = 1.0f / sqrtf(wave_sum(q[0]) * (1.0f / DM) + LN_EPS), rs1 = 1.0f / sqrtf(wave_sum(q[1]) * (1.0f / DM) + LN_EPS);
#pragma unroll
            for (int j = 0; j < 4; ++j) { const f32x4 g = *(const f32x4*)(p.ln2_g + 4 * lane + 256 * j), bb = *(const f32x4*)(p.ln2_b + 4 * lane + 256 * j);
                *(f32x4*)(outp + (size_t)tok * DM + 4 * lane + 256 * j) = v[0][j] * rs0 * g + bb;
                *(f32x4*)(outp + (size_t)(tok + 1) * DM + 4 * lane + 256 * j) = v[1][j] * rs1 * g + bb; }
        }
    }
}

constexpr int NPHASE = 11;
__global__ void __launch_bounds__(NTHREADS, 2) fwd_kernel(Params p) {
    extern __shared__ __attribute__((aligned(16))) unsigned char lds_raw[];
    LAS unsigned char* lds = (LAS unsigned char*)lds_raw;
    const int tid = threadIdx.x;
    const int G = gridDim.x, bx = blockIdx.x;
    const int vcu = (G % 8 == 0) ? (bx % 8) * (G / 8) + bx / 8 : bx;
    unsigned char* ws = p.ws;
    volatile LAS unsigned* MISC = (volatile LAS unsigned*)(lds + MISC_OFF);
    if (tid < 32) MISC[tid] = 0u;
    __syncthreads();
    XcdBarrier bar; bar.bar = (unsigned*)(ws + WS_CTL) + CW_BAR; bar.x = 0; bar.st = nullptr;
    const bool one = (p.ph_hi - p.ph_lo) > 1;
    if (one) bar = xcd_barrier_post((unsigned*)(ws + WS_CTL) + CW_BAR, MISC + 8);
    const int lo = p.ph_lo, hi = p.ph_hi;
#ifdef ONLY_PHASE
#define IN(k) ((k) == ONLY_PHASE && lo <= (k) && (k) < hi)
#else
#define IN(k) (lo <= (k) && (k) < hi)
#endif
#ifndef NAIVE_GEMM_MASK
#define NAIVE_GEMM_MASK 0
#endif
#define GEMM_CALL(EPI, SCHED) do { if constexpr (NAIVE_GEMM_MASK != 0) gemm_phase_naive<EPI, SCHED>(lds, g, S, E); else gemm_phase<EPI, SCHED, true>(lds, g, S, E); } while (0)
#ifndef REPEAT_PHASE
#define REPEAT_PHASE (-1)
#endif
#define SEAM(k) do { if (IN(k) && IN((k) == 1 ? 3 : (k) + 1)) xcd_barrier(bar); } while (0)

#define PHASE(k, ...) do { if (IN(k)) { if constexpr (REPEAT_PHASE == (k)) { __VA_ARGS__; xcd_barrier(bar); } __VA_ARGS__; } SEAM(k); } while (0)
    PHASE(0, phase_prologue(p, lds, vcu, G));
    PHASE(1, { GemmArgs g{(const bf16_t*)(ws + WS_XB), 1024, (const bf16_t*)(ws + WS_WIN), 1024, 1024}; DenseSched S; S.init(lds, NTOK, PN, G, vcu);
        EpiProj E{ws}; GEMM_CALL(EpiProj, DenseSched); });
    PHASE(3, { GemmArgs g{(const bf16_t*)(ws + WS_LAT), KUP, (const bf16_t*)(ws + WS_WUP), KUP, KUP}; DenseSched S; S.init(lds, NTOK, NUP, G, vcu);
        EpiUp E{(bf16_t*)(ws + WS_QM), (bf16_t*)(ws + WS_KM), (bf16_t*)(ws + WS_VM), (const float*)(ws + WS_RSTDP), (const float*)(ws + WS_ROPEA)}; GEMM_CALL(EpiUp, DenseSched); });
    if constexpr (REPEAT_PHASE == 44) { if (IN(4)) { phase_attn_fast(p, lds, vcu, G, false); xcd_barrier(bar); } }
    PHASE(4, phase_attn_fast(p, lds, vcu, G, true));
    PHASE(5, { GemmArgs g{(const bf16_t*)(ws + WS_ATT), 1024, (const bf16_t*)(ws + WS_WO), 1024, 1024}; DenseSched S; S.init(lds, NTOK, DM, G, vcu);
        EpiWo E{p.x, (float*)(ws + WS_X1PRE)}; GEMM_CALL(EpiWo, DenseSched); });
    PHASE(6, phase_ln1_route(p, lds, vcu, G));
    PHASE(7, phase_assign(p, lds, vcu, G));
    PHASE(8, { GemmArgs g{(const bf16_t*)(ws + WS_X1B), 1024, (const bf16_t*)(ws + WS_WGU), 1024, 1024}; GroupSched<true> S; S.init(lds, (const int*)(ws + WS_TILEE), (const int*)(ws + WS_ROWTOK), 8, 2048, G, vcu);
        EpiGateUp E{(bf16_t*)(ws + WS_H), p.b_gate, p.b_up}; GEMM_CALL(EpiGateUp, GroupSched<true>); });
    PHASE(9, { GemmArgs g{(const bf16_t*)(ws + WS_H), 1024, (const bf16_t*)(ws + WS_WD), 1024, 1024}; GroupSched<false> S; S.init(lds, (const int*)(ws + WS_TILEE), (const int*)(ws + WS_ROWTOK), 4, 1024, G, vcu);
        EpiDown E{(bf16_t*)(ws + WS_Y), p.b_down, (const float*)(ws + WS_ROWGATE)}; GEMM_CALL(EpiDown, GroupSched<false>); });
    if (IN(10)) { if constexpr (REPEAT_PHASE == 10) { phase_final(p, vcu, G, (float*)(ws + WS_X1PRE)); xcd_barrier(bar); } phase_final(p, vcu, G, p.out); }
#undef IN
#undef SEAM
}

extern "C" void kernel_launch(void* const* d_in, const int* in_sizes, int n_in, void* d_out, int out_size, void* d_ws, size_t ws_size, hipStream_t stream) {
    static int grid = 0;
    if (grid == 0) {
        if (n_in != 20 || out_size != NTOK * DM || ws_size < WS_END) { fprintf(stderr, "kernel_launch: unexpected shapes (n_in %d out %d ws %zu)\n", n_in, out_size, ws_size); grid = -1; return; }
        int dev = 0, cus = 0, per_cu = 0;
        if (hipGetDevice(&dev) != hipSuccess || hipDeviceGetAttribute(&cus, hipDeviceAttributeMultiprocessorCount, dev) != hipSuccess) { grid = -1; return; }
        if (hipFuncSetAttribute((const void*)fwd_kernel, hipFuncAttributeMaxDynamicSharedMemorySize, LDS_BYTES) != hipSuccess) { fprintf(stderr, "kernel_launch: hipFuncSetAttribute failed\n"); grid = -1; return; }
        if (hipOccupancyMaxActiveBlocksPerMultiprocessor(&per_cu, (const void*)fwd_kernel, NTHREADS, LDS_BYTES) != hipSuccess || per_cu < 1) fprintf(stderr, "kernel_launch: occupancy query says %d\n", per_cu);
        (void)hipGetLastError();
        grid = cus;
    }
    if (grid < 0) return;
    (void)hipMemsetAsync((char*)d_ws + WS_CTL, 0, CTL_ZERO_BYTES, stream);
    Params p{};
    p.x = (const float*)d_in[0]; p.pos = (const int*)d_in[1]; p.w_in = (const float*)d_in[2]; p.q_a_norm = (const float*)d_in[3]; p.w_q_b = (const float*)d_in[4];
    p.kv_a_norm = (const float*)d_in[5]; p.w_kv_b = (const float*)d_in[6]; p.w_o = (const float*)d_in[7]; p.ln1_g = (const float*)d_in[8]; p.ln1_b = (const float*)d_in[9];
    p.w_router = (const float*)d_in[10]; p.b_router = (const float*)d_in[11]; p.w_gate = (const float*)d_in[12]; p.b_gate = (const float*)d_in[13];
    p.w_up = (const float*)d_in[14]; p.b_up = (const float*)d_in[15]; p.w_down = (const float*)d_in[16]; p.b_down = (const float*)d_in[17];
    p.ln2_g = (const float*)d_in[18]; p.ln2_b = (const float*)d_in[19];
    p.out = (float*)d_out; p.ws = (unsigned char*)d_ws;
    for (int i = 0; i < 16; ++i) p.invfA[i] = pow(500000.0, -(double)(2 * i) / 32.0);
    for (int i = 0; i < 8; ++i) p.invfB[i] = pow(500000.0, -(double)(2 * i) / 16.0);
#if MK_ONE_LAUNCH
    p.ph_lo = 0; p.ph_hi = NPHASE;
    hipLaunchKernelGGL(fwd_kernel, dim3(grid), dim3(NTHREADS), LDS_BYTES, stream, p);
#else
    for (int ph = 0; ph < NPHASE; ++ph) { p.ph_lo = ph; p.ph_hi = ph + 1; hipLaunchKernelGGL(fwd_kernel, dim3(grid), dim3(NTHREADS), LDS_BYTES, stream, p); }
#endif
}
```

```cpp
#include <hip/hip_runtime.h>
#include <cstdio>
#include <cstdint>
#include <cmath>

#ifndef MK_ONE_LAUNCH
#define MK_ONE_LAUNCH 1
#endif

#define GAS __attribute__((address_space(1)))
#define LAS __attribute__((address_space(3)))
typedef unsigned short bf16_t;
typedef short bf16x8 __attribute__((ext_vector_type(8)));
typedef float f32x4 __attribute__((ext_vector_type(4)));
typedef float f32x2 __attribute__((ext_vector_type(2)));
typedef unsigned u32x4 __attribute__((ext_vector_type(4)));
typedef unsigned u32x2 __attribute__((ext_vector_type(2)));

constexpr int NTOK = 16384, DM = 1024, SEQ = 2048, NBATCH = 8;
constexpr int PN = 2048;
constexpr int C_QL = 0, C_KVL = 256, C_KR = 384, C_MQ = 416, C_MK = 928, C_MV = 1440, IN_COLS = 1952;
constexpr int NUP = 1792, KUP = 384;
constexpr int NE = 32, TOPK = 4;
constexpr int MAXROWS = 65536 + NE * 256, MAXTILES = MAXROWS / 256;
constexpr int NCHUNK = NTOK / 64;
constexpr float LN_EPS = 1e-5f, RMS_EPS = 1e-6f;
constexpr float DN_ALPHA = 1.189207115002721f;
constexpr float LOG2E = 1.4426950408889634f;
constexpr float C2A = 0.10206207261596575f * LOG2E;
constexpr float C2B = 0.125f * LOG2E;
constexpr int NWAVES = 8, NTHREADS = 512;

constexpr size_t MiB = 1u << 20;
constexpr size_t WS_CTL = 0, CTL_ZERO_BYTES = 1 * MiB;
constexpr size_t WS_HIST = 1 * MiB;
constexpr size_t WS_TIDX = WS_HIST + 64 * 1024;
constexpr size_t WS_TGATE = WS_TIDX + 256 * 1024;
constexpr size_t WS_DEST = WS_TGATE + 256 * 1024;
constexpr size_t WS_ROWTOK = WS_DEST + 256 * 1024;
constexpr size_t WS_ROWGATE = WS_ROWTOK + 288 * 1024;
constexpr size_t WS_TILEE = WS_ROWGATE + 288 * 1024;
constexpr size_t WS_RSTD = WS_TILEE + 4 * 1024;
constexpr size_t WS_KMEAN = WS_RSTD + 128 * 1024;
constexpr size_t WS_WRL = WS_KMEAN + 128 * 1024;
static_assert(WS_WRL + 128 * 1024 <= 4 * MiB, "route region");
constexpr size_t WS_ROPEA = 4 * MiB;
constexpr size_t WS_ROPEB = 6 * MiB;
constexpr size_t WS_WIN = 8 * MiB;
constexpr size_t WS_WO = 12 * MiB;
constexpr size_t WS_WUP = 14 * MiB;
constexpr size_t WS_X1B = 16 * MiB;
constexpr size_t WS_WD = 48 * MiB;
constexpr size_t WS_XB = 112 * MiB;
constexpr size_t WS_PROJ = 144 * MiB;
constexpr size_t WS_QM = 208 * MiB;
constexpr size_t WS_KM = 232 * MiB;
constexpr size_t WS_VM = 256 * MiB;
constexpr size_t WS_QB = 272 * MiB;
constexpr size_t WS_KB = 288 * MiB;
constexpr size_t WS_ATT = 304 * MiB;
constexpr size_t WS_H = 112 * MiB;
constexpr size_t WS_WGU = 336 * MiB;
constexpr size_t WS_Y = 336 * MiB;
constexpr size_t WS_LAT = 144 * MiB;
constexpr size_t WS_VB = 160 * MiB;
constexpr size_t WS_RSTDP = 176 * MiB;
constexpr size_t WS_KMEANP = 177 * MiB;
constexpr size_t WS_X1PRE = 144 * MiB;
constexpr size_t WS_END = 480 * MiB;
static_assert(WS_H + (size_t)MAXROWS * 1024 * 2 <= WS_VM + 0 * MiB + 0 && WS_Y + (size_t)MAXROWS * 1024 * 2 <= WS_END, "ws map");
constexpr int CW_BAR = 4096;

constexpr int LDS_BYTES = 147456;
constexpr int MISC_OFF = 131072 + 320;

__device__ __forceinline__ float bf2f(unsigned v) { return __uint_as_float(v << 16); }
__device__ __forceinline__ unsigned f2bf(float f) { unsigned u = __float_as_uint(f); return (u + 0x7fffu + ((u >> 16) & 1u)) >> 16; }
__device__ __forceinline__ unsigned pk2(float lo, float hi) { typedef __bf16 bf2_t __attribute__((ext_vector_type(2))); f32x2 v = {lo, hi}; bf2_t b = __builtin_convertvector(v, bf2_t); return __builtin_bit_cast(unsigned, b); }
__device__ __forceinline__ float wave_sum(float v) {
#pragma unroll
    for (int o = 1; o < 64; o <<= 1) v += __shfl_xor(v, o);
    return v;
}
__device__ __forceinline__ float wave_max(float v) {
#pragma unroll
    for (int o = 1; o < 64; o <<= 1) v = fmaxf(v, __shfl_xor(v, o));
    return v;
}

#define XB_TMO      128
#define XB_XCNT(j)  (256  + 64 * (j))
#define XB_XSUB(j)  (1280 + 64 * (j))
#define XB_XGEN(j)  (2304 + 64 * (j))
#define XB_TOP      3328
#define XB_TOPGEN   3392
#define XCD_BAR_WORDS 3456
#define XB_SPIN_CAP (1u << 18)
__device__ __forceinline__ unsigned xb_ld(unsigned* p)              { return __hip_atomic_load(p, __ATOMIC_RELAXED, __HIP_MEMORY_SCOPE_AGENT); }
__device__ __forceinline__ unsigned xb_add(unsigned* p, unsigned v) { return __hip_atomic_fetch_add(p, v, __ATOMIC_RELAXED, __HIP_MEMORY_SCOPE_AGENT); }
__device__ __forceinline__ unsigned xb_xcc_id() { return (unsigned)__builtin_amdgcn_s_getreg((3 << 11) | 20) & 0xFu; }
#define XB_SPIN(cond, bar) do { unsigned _sp = 0; while (cond) { __builtin_amdgcn_s_sleep(1); \
    if ((++_sp & 255u) == 0u) { if (xb_ld(&(bar)[XB_TMO])) break; if (_sp > XB_SPIN_CAP) { atomicAdd(&(bar)[XB_TMO], 1u); break; } } } } while (0)
struct XcdBarrier { unsigned* bar; unsigned x; volatile LAS unsigned* st; };
__device__ __forceinline__ XcdBarrier xcd_barrier_post(unsigned* bar, volatile LAS unsigned* st) {
    XcdBarrier b; b.bar = bar; b.x = xb_xcc_id(); b.st = st;
    if (threadIdx.x == 0) (void)xb_add(&bar[XB_XCNT(b.x)], 1u);
    return b;
}
__device__ __forceinline__ void xcd_barrier_complete(unsigned* bar, unsigned x, unsigned& nloc, unsigned& nx) {
    const unsigned G = gridDim.x * gridDim.y * gridDim.z;
    unsigned sum, cnt, mine, sp = 0u;
    for (;;) {
        sum = 0u; cnt = 0u; mine = 0u;
#pragma unroll
        for (unsigned j = 0; j < 16; ++j) { const unsigned c = xb_ld(&bar[XB_XCNT(j)]); sum += c; cnt += (c > 0u) ? 1u : 0u; mine = (j == x) ? c : mine; }
        if (sum == G) break;
        __builtin_amdgcn_s_sleep(1);
        if ((++sp & 255u) == 0u) { if (xb_ld(&bar[XB_TMO])) break; if (sp > XB_SPIN_CAP) { atomicAdd(&bar[XB_TMO], 1u); break; } }
    }
    nloc = mine > 0u ? mine : 1u; nx = cnt > 0u ? cnt : 1u;
}
__device__ __forceinline__ void xcd_barrier(const XcdBarrier& b) {
    asm volatile("s_waitcnt vmcnt(0)" ::: "memory");
    __syncthreads();
    if (threadIdx.x == 0) {
        unsigned* bar = b.bar;
        __builtin_amdgcn_s_waitcnt(0);
        unsigned nloc = b.st[0], nx = b.st[1];
        if (nloc == 0u) { xcd_barrier_complete(bar, b.x, nloc, nx); b.st[0] = nloc; b.st[1] = nx; }
        const unsigned old = xb_add(&bar[XB_XSUB(b.x)], 1u);
        const unsigned gen = old / nloc;
        if (old + 1u == (gen + 1u) * nloc) {
            __builtin_amdgcn_fence(__ATOMIC_RELEASE, "agent");
            asm volatile("s_waitcnt vmcnt(0)" ::: "memory");
            const unsigned og = xb_add(&bar[XB_TOP], 1u);
            const unsigned tg = og / nx;
            if (og + 1u == (tg + 1u) * nx) xb_add(&bar[XB_TOPGEN], 1u);
            else XB_SPIN(xb_ld(&bar[XB_TOPGEN]) == tg, bar);
            __builtin_amdgcn_fence(__ATOMIC_ACQUIRE, "agent");
            xb_add(&bar[XB_XGEN(b.x)], 1u);
            asm volatile("s_waitcnt vmcnt(0)" ::: "memory");
        } else {
            XB_SPIN(xb_ld(&bar[XB_XGEN(b.x)]) == gen, bar);
            __builtin_amdgcn_fence(__ATOMIC_ACQUIRE, "agent");
            asm volatile("s_waitcnt vmcnt(0)" ::: "memory");
        }
    }
    __syncthreads();
}

struct Params {
    const float* x; const int* pos;
    const float *w_in, *q_a_norm, *w_q_b, *kv_a_norm, *w_kv_b, *w_o, *ln1_g, *ln1_b, *w_router, *b_router;
    const float *w_gate, *b_gate, *w_up, *b_up, *w_down, *b_down, *ln2_g, *ln2_b;
    float* out; unsigned char* ws;
    double invfA[16]; double invfB[8];
    int ph_lo, ph_hi;
};

struct Unit { int pm, pn, e; };
struct GemmArgs { const bf16_t* A; int lda; const bf16_t* Bt; int ldb; int K; };
template <bool PERM> __device__ __forceinline__ int ecol(int bj, int n, int wc, int fq) { return 128 * bj + 32 * wc + (PERM ? 8 * fq + 4 * n : 16 * n + 4 * fq); }

template <class Epi, class Sched>
__device__ __forceinline__ void gemm_phase_naive(LAS unsigned char* lds, const GemmArgs g, const Sched& S, const Epi& E) {
    const int tid = threadIdx.x, wid = __builtin_amdgcn_readfirstlane(tid >> 6), lane = tid & 63, wr = wid >> 2, wc = wid & 3, fr = lane & 15, fq = lane >> 4;
    Unit u;
    for (int ui = 0; S.next(ui, u); ++ui) {
        f32x4 acc[2][2][4][2];
#pragma unroll
        for (int a = 0; a < 2; ++a)
#pragma unroll
            for (int b = 0; b < 2; ++b)
#pragma unroll
                for (int m = 0; m < 4; ++m)
#pragma unroll
                    for (int n = 0; n < 2; ++n) acc[a][b][m][n] = (f32x4){0.f, 0.f, 0.f, 0.f};
        unsigned aoff[2][4];
#pragma unroll
        for (int a = 0; a < 2; ++a)
#pragma unroll
            for (int m = 0; m < 4; ++m) aoff[a][m] = (unsigned)S.arow(u, ui, 128 * a + 64 * wr + 16 * m + fr) * (unsigned)g.lda;
        const bf16_t* bb = g.Bt + (size_t)(S.brow0(u) + 32 * wc) * g.ldb;
        const unsigned bl0 = (unsigned)(4 * fq) * (unsigned)g.ldb, bl1 = (unsigned)(8 * fq) * (unsigned)g.ldb;
#pragma unroll 1
        for (int k = 0; k < g.K; k += 2) {
            float af[2][4][2];
#pragma unroll
            for (int a = 0; a < 2; ++a)
#pragma unroll
                for (int m = 0; m < 4; ++m) { const unsigned v = *(const unsigned*)(g.A + aoff[a][m] + k); af[a][m][0] = __uint_as_float(v << 16); af[a][m][1] = __uint_as_float(v & 0xffff0000u); }
#pragma unroll
            for (int b = 0; b < 2; ++b)
#pragma unroll
                for (int n = 0; n < 2; ++n)
#pragma unroll
                    for (int j = 0; j < 4; ++j) {
                        const int ccol = 128 * b + (Epi::PERM ? 4 * n : 16 * n) + j;
                        const unsigned v = *(const unsigned*)(bb + (size_t)ccol * g.ldb + ((Epi::PERM ? bl1 : bl0) + (unsigned)k));
                        const float b0 = __uint_as_float(v << 16), b1 = __uint_as_float(v & 0xffff0000u);
#pragma unroll
                        for (int a = 0; a < 2; ++a)
#pragma unroll
                            for (int m = 0; m < 4; ++m) acc[a][b][m][n][j] = fmaf(af[a][m][1], b1, fmaf(af[a][m][0], b0, acc[a][b][m][n][j]));
                    }
        }
        E(acc, u, wr, wc, fr, fq);
    }
}

namespace pg {
constexpr int BK = 64, HALF = 128, HTB = HALF * BK * 2;
__device__ __forceinline__ int lds_byte(int r, int c) { const int st = (r >> 4) * 2 + (c >> 5), rr = r & 15, cc = c & 31, ob = rr * 64 + cc * 2; return st * 1024 + (ob ^ (((ob >> 9) & 1) << 5)); }
__device__ __forceinline__ void stage_rc(int b, int& R, int& C) { const int st = b / 1024, sb = b % 1024, swz = sb ^ (((sb >> 9) & 1) << 5); R = (st >> 1) * 16 + swz / 64; C = (st & 1) * 32 + (swz % 64) / 2; }
__device__ __forceinline__ int perm32(int rho) { const int n = rho >> 4, i = rho & 15; return 8 * (i >> 2) + 4 * n + (i & 3); }
}
template <class Epi, class Sched, bool ALIGN_EPI>
__device__ __forceinline__ void gemm_phase(LAS unsigned char* lds, const GemmArgs g, const Sched& S, const Epi& E) {
    using namespace pg;
    const int tid = threadIdx.x, wid = __builtin_amdgcn_readfirstlane(tid >> 6), lane = tid & 63, wr = wid >> 2, wc = wid & 3, fr = lane & 15, fq = lane >> 4;
    const int nt = g.K / BK;
    int sR[2], sC[2], sRb[2];
#pragma unroll
    for (int i = 0; i < 2; ++i) { int R, C; stage_rc(tid * 16 + i * 8192, R, C); sR[i] = R; sC[i] = C; sRb[i] = Epi::PERM ? ((R & ~31) + perm32(R & 31)) : R; }
    const unsigned ldsw = (unsigned)wid * 1024u;
    const int aoff = lds_byte(wr * 64 + fr, fq * 8), boff = lds_byte(wc * 32 + fr, fq * 8);
    const char* Ab = (const char*)g.A; const char* Bb = (const char*)g.Bt;
#define PG_SA(b, h) (((b) * 2 + (h)) * HTB)
#define PG_SB(b, h) ((4 + (b) * 2 + (h)) * HTB)
#define PG_STAGE(bufoff, gptr, v0, v1) do { \
        __builtin_amdgcn_global_load_lds((const unsigned*)((gptr) + (v0)), (LAS unsigned*)(lds + (bufoff) + ldsw), 16, 0, 0); \
        __builtin_amdgcn_global_load_lds((const unsigned*)((gptr) + (v1)), (LAS unsigned*)(lds + (bufoff) + ldsw + 8192), 16, 0, 0); } while (0)
#define PG_LDA(dst, b, h) do { _Pragma("unroll") for (int m = 0; m < 4; ++m) _Pragma("unroll") for (int k = 0; k < 2; ++k) dst[m][k] = *(const LAS bf16x8*)(lds + PG_SA(b, h) + aoff + m * 2048 + k * 1024); } while (0)
#define PG_LDB(dst, b, h) do { _Pragma("unroll") for (int n = 0; n < 2; ++n) _Pragma("unroll") for (int k = 0; k < 2; ++k) dst[n][k] = *(const LAS bf16x8*)(lds + PG_SB(b, h) + boff + n * 2048 + k * 1024); } while (0)
#define PG_MMA(ai, bj, At, Bt) do { __builtin_amdgcn_s_setprio(1); _Pragma("unroll") for (int m = 0; m < 4; ++m) _Pragma("unroll") for (int n = 0; n < 2; ++n) _Pragma("unroll") for (int k = 0; k < 2; ++k) \
        acc[ai][bj][m][n] = __builtin_amdgcn_mfma_f32_16x16x32_bf16(Bt[n][k], At[m][k], acc[ai][bj][m][n], 0, 0, 0); __builtin_amdgcn_s_setprio(0); } while (0)
#define PG_WAIT_V(n) asm volatile("s_waitcnt vmcnt(" #n ")" ::: "memory")
#define PG_WAIT_L(n) asm volatile("s_waitcnt lgkmcnt(" #n ")" ::: "memory")
#define PG_BAR __builtin_amdgcn_s_barrier()
#define PG_SCHED __builtin_amdgcn_sched_barrier(0)
    constexpr bool GA = Sched::GATHER;
    unsigned cA[2], cB[2];
#pragma unroll
    for (int i = 0; i < 2; ++i) { cA[i] = ((unsigned)sR[i] * (unsigned)g.lda + (unsigned)sC[i]) * 2u; cB[i] = ((unsigned)sRb[i] * (unsigned)g.ldb + (unsigned)sC[i]) * 2u; }
    const size_t hA = (size_t)128 * g.lda * 2, hB = (size_t)128 * g.ldb * 2;
#define PG_GOFFS(u, uidx, VA) do { if constexpr (GA) { _Pragma("unroll") for (int h = 0; h < 2; ++h) _Pragma("unroll") for (int i = 0; i < 2; ++i) \
        VA[h][i] = ((unsigned)S.arow(u, uidx, 128 * h + sR[i]) * (unsigned)g.lda + (unsigned)sC[i]) * 2u; } } while (0)
#define PG_UA(u) (GA ? (size_t)0 : (size_t)S.arow(u, 0, 0) * g.lda * 2)
#define PG_UB(u) ((size_t)S.brow0(u) * g.ldb * 2)
#define PG_STAGE_A(bufoff, ab, VA, h) do { if constexpr (GA) { PG_STAGE(bufoff, (ab), VA[h][0], VA[h][1]); } else { PG_STAGE(bufoff, (ab) + (h) * hA, cA[0], cA[1]); } } while (0)
#define PG_STAGE_B(bufoff, bb, h) PG_STAGE(bufoff, (bb) + (h) * hB, cB[0], cB[1])
    Unit cur, nxt; int ui = 0;
    if (!S.next(0, cur)) return;
    f32x4 acc[2][2][4][2];
#pragma unroll
    for (int a = 0; a < 2; ++a)
#pragma unroll
        for (int b = 0; b < 2; ++b)
#pragma unroll
            for (int m = 0; m < 4; ++m)
#pragma unroll
                for (int n = 0; n < 2; ++n) acc[a][b][m][n] = (f32x4){0.f, 0.f, 0.f, 0.f};
    bf16x8 At[4][2], B0[2][2], B1[2][2];
    unsigned vA[2][2], nvA[2][2];
    PG_GOFFS(cur, 0, vA);
    const char* cAp = Ab + PG_UA(cur); const char* cBp = Bb + PG_UB(cur);
    PG_STAGE_B(PG_SB(0, 0), cBp, 0); PG_STAGE_B(PG_SB(0, 1), cBp, 1); PG_STAGE_A(PG_SA(0, 0), cAp, vA, 0); PG_STAGE_A(PG_SA(0, 1), cAp, vA, 1);
    if (wr == 1) PG_BAR;
    PG_WAIT_V(2); PG_BAR;
    PG_STAGE_B(PG_SB(1, 0), cBp + 128, 0); PG_STAGE_A(PG_SA(1, 0), cAp + 128, vA, 0); PG_STAGE_B(PG_SB(1, 1), cBp + 128, 1);
    PG_WAIT_V(6); PG_BAR;
    for (;;) {
        const bool has_next = S.next(ui + 1, nxt);
        const char* nAp = cAp; const char* nBp = cBp;
        if (has_next) { PG_GOFFS(nxt, ui + 1, nvA); nAp = Ab + PG_UA(nxt); nBp = Bb + PG_UB(nxt); }
        else { if constexpr (GA) {
#pragma unroll
            for (int h = 0; h < 2; ++h)
#pragma unroll
                for (int i = 0; i < 2; ++i) nvA[h][i] = vA[h][i]; } }
#pragma unroll 1
        for (int t = 0; t < nt; t += 2) {
            const bool last = (t == nt - 2);
            const char* a1 = cAp + (size_t)(t + 1) * 128;
            const char* a2 = last ? nAp : cAp + (size_t)(t + 2) * 128; const char* b2 = last ? nBp : cBp + (size_t)(t + 2) * 128;
            const char* a3 = a2 + 128; const char* b3 = b2 + 128;
            unsigned wA[2][2];
            if constexpr (GA) {
#pragma unroll
                for (int h = 0; h < 2; ++h)
#pragma unroll
                    for (int i = 0; i < 2; ++i) wA[h][i] = last ? nvA[h][i] : vA[h][i]; }
            PG_LDB(B0, 0, 0); PG_LDB(B1, 0, 1); PG_SCHED; PG_LDA(At, 0, 0); PG_STAGE_A(PG_SA(1, 1), a1, vA, 1);
            PG_WAIT_V(8); PG_WAIT_L(0); PG_BAR; PG_MMA(0, 0, At, B0); PG_MMA(0, 1, At, B1); PG_BAR; PG_SCHED;
            PG_LDA(At, 0, 1); PG_STAGE_B(PG_SB(0, 0), b2, 0); PG_STAGE_B(PG_SB(0, 1), b2, 1); PG_STAGE_A(PG_SA(0, 0), a2, wA, 0);
            PG_WAIT_V(8); PG_WAIT_L(0); PG_BAR; PG_MMA(1, 0, At, B0); PG_MMA(1, 1, At, B1); PG_BAR; PG_SCHED;
            PG_LDB(B0, 1, 0); PG_LDB(B1, 1, 1); PG_SCHED; PG_LDA(At, 1, 0); PG_STAGE_A(PG_SA(0, 1), a2, wA, 1);
            PG_WAIT_V(8); PG_WAIT_L(0); PG_BAR; PG_MMA(0, 0, At, B0); PG_MMA(0, 1, At, B1); PG_BAR; PG_SCHED;
            PG_LDA(At, 1, 1); PG_STAGE_B(PG_SB(1, 0), b3, 0); PG_STAGE_B(PG_SB(1, 1), b3, 1); PG_STAGE_A(PG_SA(1, 0), a3, wA, 0);
            PG_WAIT_V(8); PG_WAIT_L(0); PG_BAR; PG_MMA(1, 0, At, B0); PG_MMA(1, 1, At, B1); PG_BAR; PG_SCHED;
        }
        if constexpr (ALIGN_EPI) { if (wr == 0) PG_BAR; }
        E(acc, cur, wr, wc, fr, fq);
        if (!has_next) break;
#pragma unroll
        for (int a = 0; a < 2; ++a)
#pragma unroll
            for (int b = 0; b < 2; ++b)
#pragma unroll
                for (int m = 0; m < 4; ++m)
#pragma unroll
                    for (int n = 0; n < 2; ++n) acc[a][b][m][n] = (f32x4){0.f, 0.f, 0.f, 0.f};
        cur = nxt; ++ui; cAp = nAp; cBp = nBp;
        if constexpr (GA) {
#pragma unroll
            for (int h = 0; h < 2; ++h)
#pragma unroll
                for (int i = 0; i < 2; ++i) vA[h][i] = nvA[h][i]; }
        if constexpr (ALIGN_EPI) { if (wr == 1) PG_BAR; }
    }
    PG_WAIT_V(0);
    if constexpr (!ALIGN_EPI) { if (wr == 0) PG_BAR; }
    PG_BAR;
#undef PG_SA
#undef PG_SB
#undef PG_STAGE
#undef PG_LDA
#undef PG_LDB
#undef PG_MMA
#undef PG_WAIT_V
#undef PG_WAIT_L
#undef PG_BAR
#undef PG_SCHED
#undef PG_GOFFS
#undef PG_UA
#undef PG_UB
#undef PG_STAGE_A
#undef PG_STAGE_B
}

constexpr int ROWTAB_OFF = 132096, ETAB_OFF = ROWTAB_OFF + 12 * 1024, MAXU = 12;
struct DenseSched {
    static constexpr bool GATHER = false;
    int nN, nunits, G, c;
    __device__ __forceinline__ void init(LAS unsigned char*, int M, int N, int G_, int c_) { nN = N / 256; nunits = (M / 256) * nN; G = G_; c = c_; }
    __device__ __forceinline__ bool next(int i, Unit& u) const { const int L = i * G + c; if (L >= nunits) return false; u.pm = L / nN; u.pn = L % nN; u.e = 0; return true; }
    __device__ __forceinline__ int arow(const Unit& u, int, int r) const { return 256 * u.pm + r; }
    __device__ __forceinline__ int brow0(const Unit& u) const { return 256 * u.pn; }
};
template <bool GATHER_> struct GroupSched {
    static constexpr bool GATHER = GATHER_;
    LAS int* rowtab; LAS int* etab; int nN, nexp_rows, nunits, G, c;
    __device__ __forceinline__ void init(LAS unsigned char* lds, const int* te, const int* rt, int nN_, int nexp_rows_, int G_, int c_) {
        rowtab = (LAS int*)(lds + ROWTAB_OFF); etab = (LAS int*)(lds + ETAB_OFF); nN = nN_; nexp_rows = nexp_rows_; G = G_; c = c_;
        nunits = __builtin_amdgcn_readfirstlane(te[MAXTILES]) * nN_;
        for (int i = 0; i < MAXU; ++i) { const int L = i * G + c; if (L >= nunits) break; const int pm = L / nN;
            if (threadIdx.x == 0) etab[i] = te[pm];
            if (GATHER && threadIdx.x < 256) rowtab[i * 256 + threadIdx.x] = rt[256 * pm + threadIdx.x]; }
        __syncthreads();
    }
    __device__ __forceinline__ bool next(int i, Unit& u) const { const int L = i * G + c; if (L >= nunits || i >= MAXU) return false; u.pm = L / nN; u.pn = L % nN; u.e = etab[i]; return true; }
    __device__ __forceinline__ int arow(const Unit& u, int ui, int r) const { return GATHER ? rowtab[ui * 256 + r] : 256 * u.pm + r; }
    __device__ __forceinline__ int brow0(const Unit& u) const { return u.e * nexp_rows + 256 * u.pn; }
};

struct EpiProj {
    static constexpr bool PERM = true;
    unsigned char* ws;
    __device__ __forceinline__ void operator()(const f32x4 (&acc)[2][2][4][2], const Unit& u, int wr, int wc, int fr, int fq) const {
        asm volatile("" : "+v"(fr), "+v"(fq));
        bf16_t* LAT = (bf16_t*)(ws + WS_LAT); bf16_t* KM = (bf16_t*)(ws + WS_KM); bf16_t* QB = (bf16_t*)(ws + WS_QB); bf16_t* KB = (bf16_t*)(ws + WS_KB); bf16_t* VB = (bf16_t*)(ws + WS_VB);
        float* rstdp = (float*)(ws + WS_RSTDP); float* kmeanp = (float*)(ws + WS_KMEANP);
        const float* ropeA = (const float*)(ws + WS_ROPEA); const float* ropeB = (const float*)(ws + WS_ROPEB);
#pragma unroll
        for (int b = 0; b < 2; ++b) {
            const int g = 8 * u.pn + 4 * b + wc;
            if (g < 12) {
#pragma unroll
                for (int a = 0; a < 2; ++a)
#pragma unroll
                    for (int m = 0; m < 4; ++m) { const int row = 256 * u.pm + 128 * a + 64 * wr + 16 * m + fr; const f32x4 v0 = acc[a][b][m][0], v1 = acc[a][b][m][1];
                        u32x4 w; w.x = pk2(v0[0], v0[1]); w.y = pk2(v0[2], v0[3]); w.z = pk2(v1[0], v1[1]); w.w = pk2(v1[2], v1[3]);
                        *(u32x4*)(LAT + (size_t)row * 384 + g * 32 + 8 * fq) = w;
                        float ss = 0.f;
#pragma unroll
                        for (int k = 0; k < 4; ++k) { const float e0 = __uint_as_float(w[k] << 16), e1 = __uint_as_float(w[k] & 0xffff0000u); ss += e0 * e0 + e1 * e1; }
                        ss += __shfl_xor(ss, 16); ss += __shfl_xor(ss, 32);
                        if (fq == 0) rstdp[(size_t)row * 12 + g] = ss; }
            } else if (g == 12) {
#pragma unroll
                for (int a = 0; a < 2; ++a)
#pragma unroll
                    for (int m = 0; m < 4; ++m) { const int row = 256 * u.pm + 128 * a + 64 * wr + 16 * m + fr; u32x4 w;
#pragma unroll
                        for (int n = 0; n < 2; ++n) { const f32x4 v = acc[a][b][m][n]; f32x4 pv;
#pragma unroll
                            for (int j = 0; j < 4; ++j) { auto rr = __builtin_amdgcn_permlane32_swap(__float_as_uint(v[j]), __float_as_uint(v[j]), false, false); pv[j] = __uint_as_float(fq < 2 ? rr[1] : rr[0]); }
                            const f32x4 c = *(const f32x4*)(ropeA + (size_t)row * 32 + 8 * (fq & 1) + 4 * n), sn = *(const f32x4*)(ropeA + (size_t)row * 32 + 16 + 8 * (fq & 1) + 4 * n);
                            const f32x4 o = (fq < 2) ? (v * c - pv * sn) : (v * c + pv * sn);
                            w[2 * n] = pk2(o[0], o[1]); w[2 * n + 1] = pk2(o[2], o[3]); }
#pragma unroll
                        for (int h = 0; h < 8; ++h) *(u32x4*)(KM + (size_t)row * 768 + h * 96 + 64 + 8 * fq) = w; }
            } else if (g < 45) {
                const bool isk = g >= 29; const int rel = isk ? g - 29 : g - 13, head = rel >> 1, hf = rel & 1;
                bf16_t* dst = (isk ? KB : QB) + head * 64 + hf * 32 + 8 * fq;
                f32x4 cs0 = (f32x4){0.f, 0.f, 0.f, 0.f}, cs1 = cs0;
#pragma unroll
                for (int a = 0; a < 2; ++a)
#pragma unroll
                    for (int m = 0; m < 4; ++m) { const int row = 256 * u.pm + 128 * a + 64 * wr + 16 * m + fr; f32x4 v0 = acc[a][b][m][0], v1 = acc[a][b][m][1];
                        if (hf == 0) {
#pragma unroll
                            for (int n = 0; n < 2; ++n) { const f32x4 v = n ? v1 : v0; f32x4 pv;
#pragma unroll
                                for (int j = 0; j < 4; ++j) { auto rr = __builtin_amdgcn_permlane16_swap(__float_as_uint(v[j]), __float_as_uint(v[j]), false, false); pv[j] = __uint_as_float((fq & 1) ? rr[0] : rr[1]); }
                                const f32x4 c = *(const f32x4*)(ropeB + (size_t)row * 16 + 4 * n), sn = *(const f32x4*)(ropeB + (size_t)row * 16 + 8 + 4 * n);
                                const f32x4 o = (fq == 0) ? (v * c - pv * sn) : (fq == 1) ? (v * c + pv * sn) : v;
                                if (n) v1 = o; else v0 = o; } }
                        if (isk) { cs0 += v0; cs1 += v1; }
                        const f32x4 s0 = isk ? v0 : v0 * C2B, s1 = isk ? v1 : v1 * C2B;
                        u32x4 w; w.x = pk2(s0[0], s0[1]); w.y = pk2(s0[2], s0[3]); w.z = pk2(s1[0], s1[1]); w.w = pk2(s1[2], s1[3]);
                        *(u32x4*)(dst + (size_t)row * 512) = w; }
                if (isk) {
#pragma unroll
                    for (int j = 0; j < 4; ++j) {
#pragma unroll
                        for (int o = 1; o < 16; o <<= 1) { cs0[j] += __shfl_xor(cs0[j], o); cs1[j] += __shfl_xor(cs1[j], o); } }
                    if (fr == 0) { float* kp = kmeanp + ((size_t)u.pm * 2 + wr) * 512 + head * 64 + hf * 32 + 8 * fq; *(f32x4*)kp = cs0; *(f32x4*)(kp + 4) = cs1; } }
            } else if (g < 61) {
                const int rel = g - 45;
#pragma unroll
                for (int a = 0; a < 2; ++a)
#pragma unroll
                    for (int m = 0; m < 4; ++m) { const int row = 256 * u.pm + 128 * a + 64 * wr + 16 * m + fr; const f32x4 v0 = acc[a][b][m][0], v1 = acc[a][b][m][1];
                        u32x4 w; w.x = pk2(v0[0], v0[1]); w.y = pk2(v0[2], v0[3]); w.z = pk2(v1[0], v1[1]); w.w = pk2(v1[2], v1[3]);
                        *(u32x4*)(VB + (size_t)row * 512 + rel * 32 + 8 * fq) = w; }
            }
            asm volatile("" ::: "memory");
        }
    }
};
struct EpiUp {
    static constexpr bool PERM = true;
    bf16_t *QM, *KM, *VM; const float* rstd; const float* ropeA; int gbase;
    __device__ __forceinline__ void operator()(const f32x4 (&acc)[2][2][4][2], const Unit& u, int wr, int wc, int fr, int fq) const {
        asm volatile("" : "+v"(fr), "+v"(fq));
#pragma unroll
        for (int a = 0; a < 2; ++a)
#pragma unroll
            for (int m = 0; m < 4; ++m) { const int row = 256 * u.pm + 128 * a + 64 * wr + 16 * m + fr;
                const f32x4 s0 = *(const f32x4*)(rstd + (size_t)row * 12), s1 = *(const f32x4*)(rstd + (size_t)row * 12 + 4), s2 = *(const f32x4*)(rstd + (size_t)row * 12 + 8);
                const float rq = C2A / sqrtf((((s0[0] + s0[1]) + (s0[2] + s0[3])) + ((s1[0] + s1[1]) + (s1[2] + s1[3]))) * (1.0f / 256.0f) + RMS_EPS);
                const float rkv = 1.0f / sqrtf(((s2[0] + s2[1]) + (s2[2] + s2[3])) * (1.0f / 128.0f) + RMS_EPS);
#pragma unroll
                for (int b = 0; b < 2; ++b) {
                    const int gidx = gbase + 8 * u.pn + 4 * b + wc;
                    if (gidx < 24) {
                        const int h = gidx / 3, part = gidx % 3;
                        f32x4 v0 = acc[a][b][m][0] * rq, v1 = acc[a][b][m][1] * rq;
                        if (part == 2) {
#pragma unroll
                            for (int n = 0; n < 2; ++n) { const f32x4 v = n ? v1 : v0; f32x4 pv;
#pragma unroll
                                for (int j = 0; j < 4; ++j) { auto rr = __builtin_amdgcn_permlane32_swap(__float_as_uint(v[j]), __float_as_uint(v[j]), false, false); pv[j] = __uint_as_float(fq < 2 ? rr[1] : rr[0]); }
                                const f32x4 c = *(const f32x4*)(ropeA + (size_t)row * 32 + 8 * (fq & 1) + 4 * n), sn = *(const f32x4*)(ropeA + (size_t)row * 32 + 16 + 8 * (fq & 1) + 4 * n);
                                const f32x4 o = (fq < 2) ? (v * c - pv * sn) : (v * c + pv * sn);
                                if (n) v1 = o; else v0 = o; } }
                        u32x4 w; w.x = pk2(v0[0], v0[1]); w.y = pk2(v0[2], v0[3]); w.z = pk2(v1[0], v1[1]); w.w = pk2(v1[2], v1[3]);
                        *(u32x4*)(QM + (size_t)row * 768 + h * 96 + part * 32 + 8 * fq) = w;
                    } else {
                        const int g2 = gidx - 24, h = g2 >> 2, part = g2 & 3;
                        const f32x4 v0 = acc[a][b][m][0] * rkv, v1 = acc[a][b][m][1] * rkv;
                        bf16_t* pp = (part < 2) ? (KM + (size_t)row * 768 + h * 96 + part * 32 + 8 * fq) : (VM + (size_t)row * 512 + h * 64 + (part - 2) * 32 + 8 * fq);
                        u32x4 w; w.x = pk2(v0[0], v0[1]); w.y = pk2(v0[2], v0[3]); w.z = pk2(v1[0], v1[1]); w.w = pk2(v1[2], v1[3]);
                        *(u32x4*)pp = w;
                    }
                }
                asm volatile("" ::: "memory"); }
    }
};
struct EpiWo {
    static constexpr bool PERM = false;
    const float* x; float* O;
    __device__ __forceinline__ void operator()(const f32x4 (&acc)[2][2][4][2], const Unit& u, int wr, int wc, int fr, int fq) const {
        asm volatile("" : "+v"(fr), "+v"(fq));
#pragma unroll
        for (int a = 0; a < 2; ++a)
#pragma unroll
            for (int m = 0; m < 4; ++m) { const int row = 256 * u.pm + 128 * a + 64 * wr + 16 * m + fr;
#pragma unroll
                for (int b = 0; b < 2; ++b)
#pragma unroll
                    for (int n = 0; n < 2; ++n) { const size_t off = (size_t)row * DM + 256 * u.pn + ecol<PERM>(b, n, wc, fq);
                        const f32x4 xv = *(const f32x4*)(x + off); *(f32x4*)(O + off) = xv * DN_ALPHA + acc[a][b][m][n]; } }
    }
};
struct EpiGateUp {
    static constexpr bool PERM = true;
    bf16_t* H; const float *bg, *bu;
    __device__ __forceinline__ void operator()(const f32x4 (&acc)[2][2][4][2], const Unit& u, int wr, int wc, int fr, int fq) const {
        asm volatile("" : "+v"(fr), "+v"(fq));
        const int hc = 128 * u.pn + 32 * wc + 8 * fq;
        f32x4 vbg[2], vbu[2];
#pragma unroll
        for (int n = 0; n < 2; ++n) { vbg[n] = *(const f32x4*)(bg + (size_t)u.e * 1024 + hc + 4 * n); vbu[n] = *(const f32x4*)(bu + (size_t)u.e * 1024 + hc + 4 * n); }
#pragma unroll
        for (int a = 0; a < 2; ++a)
#pragma unroll
            for (int m = 0; m < 4; ++m) { const int row = 256 * u.pm + 128 * a + 64 * wr + 16 * m + fr; u32x4 w;
#pragma unroll
                for (int n = 0; n < 2; ++n) { const f32x4 gv = acc[a][0][m][n] + vbg[n], uv = acc[a][1][m][n] + vbu[n]; float hv[4];
#pragma unroll
                    for (int j = 0; j < 4; ++j) { const float gg = fminf(gv[j], 7.0f), uu = fminf(fmaxf(uv[j], -7.0f), 7.0f);
                        const float sg = __builtin_amdgcn_rcpf(1.0f + __builtin_amdgcn_exp2f(-1.702f * LOG2E * gg)); hv[j] = gg * sg * (uu + 1.0f); }
                    w[2 * n] = pk2(hv[0], hv[1]); w[2 * n + 1] = pk2(hv[2], hv[3]); }
                __builtin_nontemporal_store(w, (u32x4*)(H + (size_t)row * 1024 + hc)); }
    }
};
struct EpiDown {
    static constexpr bool PERM = true;
    bf16_t* Y; const float* bd; const float* row_gate;
    __device__ __forceinline__ void operator()(const f32x4 (&acc)[2][2][4][2], const Unit& u, int wr, int wc, int fr, int fq) const {
        asm volatile("" : "+v"(fr), "+v"(fq));
        f32x4 bv[2][2];
#pragma unroll
        for (int b = 0; b < 2; ++b)
#pragma unroll
            for (int n = 0; n < 2; ++n) bv[b][n] = *(const f32x4*)(bd + (size_t)u.e * 1024 + 256 * u.pn + 128 * b + 32 * wc + 8 * fq + 4 * n);
#pragma unroll
        for (int a = 0; a < 2; ++a)
#pragma unroll
            for (int m = 0; m < 4; ++m) { const int row = 256 * u.pm + 128 * a + 64 * wr + 16 * m + fr; const float gw = row_gate[row];
#pragma unroll
                for (int b = 0; b < 2; ++b) { const int col = 256 * u.pn + 128 * b + 32 * wc + 8 * fq;
                    const f32x4 v0 = (acc[a][b][m][0] + bv[b][0]) * gw, v1 = (acc[a][b][m][1] + bv[b][1]) * gw;
                    u32x4 w; w.x = pk2(v0[0], v0[1]); w.y = pk2(v0[2], v0[3]); w.z = pk2(v1[0], v1[1]); w.w = pk2(v1[2], v1[3]);
                    __builtin_nontemporal_store(w, (u32x4*)(Y + (size_t)row * 1024 + col)); } }
    }
};

__device__ __forceinline__ unsigned cvtpk_hw(float lo, float hi) { typedef __bf16 bf2 __attribute__((ext_vector_type(2))); f32x2 v = {lo, hi}; bf2 b = __builtin_convertvector(v, bf2); return __builtin_bit_cast(unsigned, b); }
__device__ __forceinline__ void conv_issue(const float* W, int ldw, int k0, int n0, LAS unsigned char* scr, int lane) {
#pragma unroll
    for (int i = 0; i < 4; ++i) __builtin_amdgcn_global_load_lds((const unsigned*)(W + (size_t)(k0 + 4 * (lane >> 3) + i) * ldw + n0 + 4 * (lane & 7)), (LAS unsigned*)(scr + i * 1024), 16, 0, 2);
}
__device__ __forceinline__ void conv_finish(bf16_t* WT, int ldt, int orow0, int ocol0, const LAS unsigned char* scr, int lane) {
    f32x4 r[4];
#pragma unroll
    for (int i = 0; i < 4; ++i) r[i] = *(const LAS f32x4*)(scr + i * 1024 + lane * 16);
#pragma unroll
    for (int j = 0; j < 4; ++j) { u32x2 o; o.x = cvtpk_hw(r[0][j], r[1][j]); o.y = cvtpk_hw(r[2][j], r[3][j]);
        *(u32x2*)(WT + (size_t)(orow0 + 4 * (lane & 7) + j) * ldt + ocol0 + 4 * (lane >> 3)) = o; }
}
constexpr int NEXP_ITEMS = 3 * NE * 1024;
__device__ __forceinline__ void expert_issue(const Params& p, int r, LAS unsigned char* scr, int lane) {
    const int mat = r >> 15, rr = r & 32767, e = rr >> 10, q = rr & 1023, kb = (q & 1) | ((q >> 6) << 1), nb = (q >> 1) & 31;
    const float* W = (mat == 0 ? p.w_gate : mat == 1 ? p.w_up : p.w_down) + (size_t)e * 1048576;
    conv_issue(W, 1024, 32 * kb, 32 * nb, scr, lane);
}
__device__ __forceinline__ void expert_finish(const Params& p, int r, const LAS unsigned char* scr, int lane) {
    const int mat = r >> 15, rr = r & 32767, e = rr >> 10, q = rr & 1023, kb = (q & 1) | ((q >> 6) << 1), nb = (q >> 1) & 31, n0 = 32 * nb;
    bf16_t* WguT = (bf16_t*)(p.ws + WS_WGU); bf16_t* WdT = (bf16_t*)(p.ws + WS_WD);
    if (mat == 2) conv_finish(WdT, 1024, e * 1024 + n0, 32 * kb, scr, lane);
    else conv_finish(WguT, 1024, e * 2048 + (n0 >> 7) * 256 + (mat == 1 ? 128 : 0) + (n0 & 127), 32 * kb, scr, lane);
}
struct BgConv { int next, stride, pend0, pend1, itc; };

__device__ __forceinline__ void tr_item(const float* W, int ldw, int k0, int n0, bf16_t* WT, int ldt, int orow0, int ocol0, const float* kscale, LAS float* scr, int lane) {
#pragma unroll 8
    for (int i = 0; i < 32; ++i) { const int kk = 2 * i + (lane >> 5); float v = W[(size_t)(k0 + kk) * ldw + n0 + (lane & 31)]; if (kscale) v *= kscale[k0 + kk]; scr[kk * 33 + (lane & 31)] = v; }
    asm volatile("s_waitcnt lgkmcnt(0)" ::: "memory");
    const int c = lane & 7;
#pragma unroll
    for (int j = 0; j < 4; ++j) { const int n = (lane >> 3) + 8 * j; const LAS float* s = scr + (8 * c) * 33 + n;
        u32x4 o; o.x = pk2(s[0 * 33], s[1 * 33]); o.y = pk2(s[2 * 33], s[3 * 33]); o.z = pk2(s[4 * 33], s[5 * 33]); o.w = pk2(s[6 * 33], s[7 * 33]);
        *(u32x4*)(WT + (size_t)(orow0 + n) * ldt + ocol0 + 8 * c) = o; }
    asm volatile("s_waitcnt lgkmcnt(0)" ::: "memory");
}
__device__ __forceinline__ void phase_prologue(const Params& p, LAS unsigned char* lds, int vcu, int G) {
    const int tid = threadIdx.x, wave = tid >> 6, lane = tid & 63;
    unsigned char* ws = p.ws;
    LAS float* scr = (LAS float*)(lds + wave * 16384);
    const int gw = vcu * NWAVES + wave, NGW = G * NWAVES;
    bf16_t* WinT = (bf16_t*)(ws + WS_WIN); bf16_t* WoT = (bf16_t*)(ws + WS_WO); bf16_t* WupT = (bf16_t*)(ws + WS_WUP);
    constexpr int I_IN = 16 * 61, I_QB = 4 * 24, I_KVB = 2 * 32, I_O = 16 * 32;
    constexpr int NITEMS = I_IN + I_QB + I_KVB + I_O;
    for (int it = gw; it < NITEMS; it += NGW) {
        int r = it;
        if (r < I_IN) { const int kb = r / 61, nb = r % 61; tr_item(p.w_in, IN_COLS, 64 * kb, 32 * nb, WinT, 1024, 32 * nb, 64 * kb, nullptr, scr, lane); continue; } r -= I_IN;
        if (r < I_QB) { const int kb = r / 24, nb = r % 24; tr_item(p.w_q_b, 768, 64 * kb, 32 * nb, WupT, KUP, 32 * nb, 64 * kb, p.q_a_norm, scr, lane); continue; } r -= I_QB;
        if (r < I_KVB) { const int kb = r / 32, nb = r % 32; tr_item(p.w_kv_b, 1024, 64 * kb, 32 * nb, WupT, KUP, 768 + 32 * nb, 256 + 64 * kb, p.kv_a_norm, scr, lane); continue; } r -= I_KVB;
        { const int kb = r / 32, nb = r % 32; tr_item(p.w_o, 1024, 64 * kb, 32 * nb, WoT, 1024, 32 * nb, 64 * kb, nullptr, scr, lane); }
    }
    const int gt = vcu * NTHREADS + tid, NGT = G * NTHREADS;
    for (int i = gt; i < 96 * 128; i += NGT) *(u32x4*)(WinT + (size_t)IN_COLS * 1024 + (size_t)i * 8) = (u32x4){0u, 0u, 0u, 0u};
    for (int i = gt; i < 768 * 16; i += NGT) { const int r = i / 16, c = i % 16; *(u32x4*)(WupT + (size_t)r * KUP + 256 + c * 8) = (u32x4){0u, 0u, 0u, 0u}; }
    for (int i = gt; i < 1024 * 32; i += NGT) { const int r = i / 32, c = i % 32; *(u32x4*)(WupT + (size_t)(768 + r) * KUP + c * 8) = (u32x4){0u, 0u, 0u, 0u}; }
    bf16_t* XB = (bf16_t*)(ws + WS_XB);
    for (int i = gt; i < NTOK * DM / 8; i += NGT) { const f32x4 a = *(const f32x4*)(p.x + (size_t)i * 8), b = *(const f32x4*)(p.x + (size_t)i * 8 + 4);
        u32x4 o; o.x = pk2(a[0], a[1]); o.y = pk2(a[2], a[3]); o.z = pk2(b[0], b[1]); o.w = pk2(b[2], b[3]); *(u32x4*)(XB + (size_t)i * 8) = o; }
    { float* WRL = (float*)(ws + WS_WRL);
      for (int n = gt; n < 32768; n += NGT) { const int e = ((n >> 8) & 7) * 4 + (n & 3), ln = (n >> 2) & 63, ji = n >> 11, j = ji >> 2, i = ji & 3; WRL[n] = p.w_router[(size_t)(4 * ln + 256 * j + i) * 32 + e]; } }
    float* ropeA = (float*)(ws + WS_ROPEA); float* ropeB = (float*)(ws + WS_ROPEB);
    for (int i = gt; i < NTOK * 24; i += NGT) { const int tok = i / 24, j = i % 24; const double f = (j < 16) ? p.invfA[j] : p.invfB[j - 16];
        const double rev = (double)p.pos[tok] * f * 0.15915494309189535; const float fr = (float)(rev - __builtin_rint(rev));
        const float cs = __builtin_amdgcn_cosf(fr), sn = __builtin_amdgcn_sinf(fr);
        if (j < 16) { ropeA[(size_t)tok * 32 + j] = cs; ropeA[(size_t)tok * 32 + 16 + j] = sn; } else { ropeB[(size_t)tok * 16 + (j - 16)] = cs; ropeB[(size_t)tok * 16 + 8 + (j - 16)] = sn; } }
}

__device__ __forceinline__ void phase_prep(const Params& p, LAS unsigned char* lds, int vcu, int G) {
    const int tid = threadIdx.x, wave = tid >> 6, lane = tid & 63;
    unsigned char* ws = p.ws;
    const bf16_t* PROJ = (const bf16_t*)(ws + WS_PROJ);
    float* rstd = (float*)(ws + WS_RSTD); const float* ropeA = (const float*)(ws + WS_ROPEA); const float* ropeB = (const float*)(ws + WS_ROPEB);
    bf16_t* KM = (bf16_t*)(ws + WS_KM); bf16_t* QB = (bf16_t*)(ws + WS_QB); bf16_t* KB = (bf16_t*)(ws + WS_KB); float* kmean = (float*)(ws + WS_KMEAN);
    const int gw = vcu * NWAVES + wave, NGW = G * NWAVES;
    for (int row = gw; row < NTOK; row += NGW) {
        float s = 0.f;
        if (lane < 48) { const u32x4 v = *(const u32x4*)(PROJ + (size_t)row * PN + lane * 8);
#pragma unroll
            for (int q = 0; q < 4; ++q) { const float a = __uint_as_float(v[q] << 16), b = __uint_as_float(v[q] & 0xffff0000u); s += a * a + b * b; } }
#pragma unroll
        for (int o = 1; o < 32; o <<= 1) s += __shfl_xor(s, o);
        if (lane == 0) rstd[2 * row] = 1.0f / sqrtf(s * (1.0f / 256.0f) + RMS_EPS);
        if (lane == 32) rstd[2 * row + 1] = 1.0f / sqrtf(s * (1.0f / 128.0f) + RMS_EPS);
    }
    const int gt = vcu * NTHREADS + tid, NGT = G * NTHREADS;
    for (int i = gt; i < NTOK * 16; i += NGT) { const int tok = i >> 4, j = i & 15;
        const float x1 = bf2f(PROJ[(size_t)tok * PN + C_KR + j]), x2 = bf2f(PROJ[(size_t)tok * PN + C_KR + 16 + j]);
        const float c = ropeA[(size_t)tok * 32 + j], s = ropeA[(size_t)tok * 32 + 16 + j];
        const bf16_t o1 = (bf16_t)f2bf(x1 * c - x2 * s), o2 = (bf16_t)f2bf(x2 * c + x1 * s);
#pragma unroll
        for (int h = 0; h < 8; ++h) { KM[(size_t)tok * 768 + h * 96 + 64 + j] = o1; KM[(size_t)tok * 768 + h * 96 + 80 + j] = o2; } }
    LAS float* red = (LAS float*)lds;
    for (int unit = vcu; unit < 512; unit += G) {
        const int ub = unit >> 3, h = unit & 7, tg = tid >> 6, d = tid & 63, c = h * 64 + d; float ksum = 0.f;
#pragma unroll 4
        for (int i = 0; i < 32; ++i) { const int tok = ub * 256 + tg * 32 + i; const bf16_t* pr = PROJ + (size_t)tok * PN;
            float qv = bf2f(pr[C_MQ + c]), kv = bf2f(pr[C_MK + c]);
            if (d < 16) { const int j = d & 7; const float cs = ropeB[(size_t)tok * 16 + j], sn = ropeB[(size_t)tok * 16 + 8 + j];
                if (d < 8) { const float q2 = bf2f(pr[C_MQ + c + 8]), k2 = bf2f(pr[C_MK + c + 8]); qv = qv * cs - q2 * sn; kv = kv * cs - k2 * sn; }
                else { const float q1 = bf2f(pr[C_MQ + c - 8]), k1 = bf2f(pr[C_MK + c - 8]); qv = qv * cs + q1 * sn; kv = kv * cs + k1 * sn; } }
            QB[(size_t)tok * 512 + c] = (bf16_t)f2bf(qv * C2B); KB[(size_t)tok * 512 + c] = (bf16_t)f2bf(kv); ksum += kv; }
        red[tg * 64 + d] = ksum;
        __syncthreads();
        if (tid < 64) { float t = 0.f;
#pragma unroll
            for (int g8 = 0; g8 < 8; ++g8) t += red[g8 * 64 + tid];
            kmean[(size_t)ub * 512 + h * 64 + tid] = t * (1.0f / 256.0f); }
        __syncthreads();
    }
}

typedef float f32x16 __attribute__((ext_vector_type(16)));
typedef short s16x4 __attribute__((ext_vector_type(4)));
namespace fa {
constexpr int KBUF = 12288, VBUF = 8192, VOFF = 3 * KBUF, WS_OFF = VOFF + 3 * VBUF, KML_OFF = WS_OFF + 8 * 256, LDS_NEED = KML_OFF + 2048;
__device__ __forceinline__ void wait_vm(int n) {
    switch (n) {
#define FA_W(k) case k: asm volatile("s_waitcnt vmcnt(" #k ")" ::: "memory"); break;
        FA_W(0) FA_W(1) FA_W(2) FA_W(3) FA_W(4) FA_W(5) FA_W(6) FA_W(7) FA_W(8) FA_W(9) FA_W(10) FA_W(11) FA_W(12) FA_W(13) FA_W(14) FA_W(15)
#undef FA_W
        default: asm volatile("s_waitcnt vmcnt(15)" ::: "memory"); break; }
}
constexpr float THR = 8.0f;
__device__ __forceinline__ int crow(int r, int hi) { return (r & 3) + 8 * (r >> 2) + 4 * hi; }
__device__ __forceinline__ unsigned cvtpk(float lo, float hi) { typedef __bf16 bf2 __attribute__((ext_vector_type(2))); f32x2 v = {lo, hi}; bf2 b = __builtin_convertvector(v, bf2); return __builtin_bit_cast(unsigned, b); }
__device__ __forceinline__ float xhalf_max(float m) { auto rr = __builtin_amdgcn_permlane32_swap(__float_as_uint(m), __float_as_uint(m), false, false); return fmaxf(__uint_as_float(rr[0]), __uint_as_float(rr[1])); }
__device__ __forceinline__ float xhalf_sum(float m) { auto rr = __builtin_amdgcn_permlane32_swap(__float_as_uint(m), __float_as_uint(m), false, false); return __uint_as_float(rr[0]) + __uint_as_float(rr[1]); }
__device__ __forceinline__ float mx3(float a, float b, float c) { return __builtin_fmaxf(__builtin_fmaxf(a, b), c); }
}
template <int DQK, int VAR>
__device__ __forceinline__ void attn_unit(LAS unsigned char* lds, const bf16_t* Q, int qpitch, const bf16_t* K, int kpitch, const bf16_t* V, int vpitch, bf16_t* O, int qb, const float* kmean, const Params& p, BgConv& bg) {
    using namespace fa;
    constexpr int ND = DQK / 16, NCH = DQK / 8;
    const int tid = threadIdx.x, lane = tid & 63, r32 = lane & 31, hi = lane >> 5, wid = __builtin_amdgcn_readfirstlane(tid >> 6);
    const int q0 = qb * 256, qrel = wid * 32 + r32;
    LAS float* wsf = (LAS float*)(lds + WS_OFF) + wid * 64;
    bf16x8 qr[ND];
#pragma unroll
    for (int d0 = 0; d0 < ND; ++d0) qr[d0] = *(const bf16x8*)(Q + (size_t)(q0 + qrel) * qpitch + d0 * 16 + hi * 8);
    unsigned sel = 0xffu;
    if (kmean) { const int n = tid >> 6, d = tid & 63; if (n < qb) ((LAS float*)(lds + KML_OFF))[tid] = kmean[(size_t)n * 1024 + d] + kmean[(size_t)n * 1024 + 512 + d]; }
    const bf16_t* ksrc = K + (size_t)lane * kpitch;
    const bf16_t* vsrc = V + (size_t)(16 * (wid & 3) + (lane >> 2)) * vpitch + (wid >> 2) * 32 + (lane & 3) * 8;
#define FA_DMA(ti, kslot, vslot) do { \
        __builtin_amdgcn_global_load_lds((const unsigned*)(ksrc + (size_t)(ti) * 64 * kpitch + wid * 8), (LAS unsigned*)(lds + (kslot) * KBUF + wid * 1024), 16, 0, 0); \
        if (NCH > 8 && wid < NCH - 8) __builtin_amdgcn_global_load_lds((const unsigned*)(ksrc + (size_t)(ti) * 64 * kpitch + (wid + 8) * 8), (LAS unsigned*)(lds + (kslot) * KBUF + (wid + 8) * 1024), 16, 0, 0); \
        __builtin_amdgcn_global_load_lds((const unsigned*)(vsrc + (size_t)(ti) * 64 * vpitch), (LAS unsigned*)(lds + VOFF + (vslot) * VBUF + wid * 1024), 16, 0, 0); } while (0)
#define FA_TILE(i) (((i) < 4) ? 4 * qb + (i) : (i) - 4)
#define FA_PV(vslot) do { const LAS unsigned char* vb_ = lds + VOFF + (vslot) * VBUF + voff; \
        _Pragma("unroll") for (int d0 = 0; d0 < 2; ++d0) _Pragma("unroll") for (int s_ = 0; s_ < 4; ++s_) { \
            const s16x4 lo_ = __builtin_bit_cast(s16x4, __builtin_amdgcn_ds_read_tr16_b64_v4i16((LAS s16x4*)(vb_ + d0 * 4096 + s_ * 1024))); \
            const s16x4 hh_ = __builtin_bit_cast(s16x4, __builtin_amdgcn_ds_read_tr16_b64_v4i16((LAS s16x4*)(vb_ + d0 * 4096 + s_ * 1024 + 512))); \
            const bf16x8 vf_ = (bf16x8){lo_[0], lo_[1], lo_[2], lo_[3], hh_[0], hh_[1], hh_[2], hh_[3]}; \
            o[d0] = __builtin_amdgcn_mfma_f32_32x32x16_bf16(__builtin_bit_cast(bf16x8, pw[s_]), vf_, o[d0], 0, 0, 0); } } while (0)
    const int NT = 4 * qb + 4;
    float mhat = 0.f, l_reg = 0.f; f32x16 o[2]; o[0] = f32x16{}; o[1] = f32x16{}; f32x16 negm = f32x16{};
    const int koff = hi * 1024 + r32 * 16;
    const int voff = ((lane >> 4) & 1) * 32 + (lane & 3) * 8 + (4 * hi + ((lane & 15) >> 2)) * 64;
    u32x4 pw[4];
    const int nkv = (NCH > 8 && wid < NCH - 8) ? 3 : 2;
    FA_DMA(FA_TILE(0), 0, 0);
    if (NT > 1) { FA_DMA(FA_TILE(1), 1, 1); }
    wait_vm(NT > 1 ? nkv : 0); asm volatile("s_waitcnt lgkmcnt(0)" ::: "memory"); __builtin_amdgcn_s_barrier(); asm volatile("" ::: "memory");
    if (kmean) {
        float gt[8];
#pragma unroll
        for (int n = 0; n < 8; ++n) { float s = 0.f; const LAS float* km = (const LAS float*)(lds + KML_OFF) + n * 64;
            if (n < qb) {
#pragma unroll
                for (int d0 = 0; d0 < ND; ++d0) { const f32x4 k0 = *(const LAS f32x4*)(km + d0 * 16 + hi * 8), k1 = *(const LAS f32x4*)(km + d0 * 16 + hi * 8 + 4);
#pragma unroll
                    for (int j = 0; j < 4; ++j) { s = fmaf(bf2f((unsigned short)qr[d0][j]), k0[j], s); s = fmaf(bf2f((unsigned short)qr[d0][4 + j]), k1[j], s); } }
                s = xhalf_sum(s); }
            gt[n] = (n < qb) ? s : -INFINITY; }
        sel = 0u;
#pragma unroll
        for (int n = 0; n < 8; ++n) { int cnt = 0;
#pragma unroll
            for (int n2 = 0; n2 < 8; ++n2) if (n2 != n) cnt += (n2 < qb && (gt[n2] > gt[n] || (gt[n2] == gt[n] && n2 < n))) ? 1 : 0;
            if (n < qb && cnt < 3) sel |= 1u << n; }
    }
    int sl = 0, prevB = 0, opsPrev = 0;
    for (int i = 0; i < NT; ++i) {
        const int sl1 = (sl == 2) ? 0 : sl + 1, sl2 = (sl1 == 2) ? 0 : sl1 + 1;
        LAS unsigned char* bscr = lds + LDS_NEED + wid * 8192 + (bg.itc & 1) * 4096;
        int young = prevB, ops = 0;
        if (bg.itc & 1) { if (bg.pend1 >= 0) { wait_vm(opsPrev); expert_finish(p, bg.pend1, bscr, lane); bg.pend1 = -1; ops += 4; asm volatile("s_waitcnt lgkmcnt(0)" ::: "memory"); } }
        else            { if (bg.pend0 >= 0) { wait_vm(opsPrev); expert_finish(p, bg.pend0, bscr, lane); bg.pend0 = -1; ops += 4; asm volatile("s_waitcnt lgkmcnt(0)" ::: "memory"); } }
        if constexpr (VAR != 4) { if (i + 2 < NT) { const int tn = FA_TILE(i + 2); FA_DMA(tn, sl2, sl2); ops += nkv; } }
        const bool bgdo = (bg.itc % 3 != 2) && bg.next < NEXP_ITEMS;
        if (bgdo) { expert_issue(p, bg.next, bscr, lane); if (bg.itc & 1) bg.pend1 = bg.next; else bg.pend0 = bg.next; bg.next += bg.stride; ops += 4; }
        young += ops; prevB = bgdo ? 4 : 0;
        ++bg.itc;
        const bool band = i < 4;
        if (!(band && 2 * i > wid)) {
            const LAS unsigned char* kb = lds + sl * KBUF + koff;
            f32x16 p0 = negm, p1 = negm;
            if (kmean && !band) { if (!__all((sel >> ((i - 4) >> 2)) & 1u)) {
                    const bool ok = ((sel >> ((i - 4) >> 2)) & 1u) != 0u;
#pragma unroll
                    for (int r = 0; r < 16; ++r) p0[r] = ok ? negm[r] : -INFINITY;
                    p1 = p0; } }
#pragma unroll
            for (int d0 = 0; d0 < (VAR == 5 ? 1 : ND); ++d0) { const bf16x8 a0 = *(const LAS bf16x8*)(kb + d0 * 2048), a1 = *(const LAS bf16x8*)(kb + d0 * 2048 + 512);
                p0 = __builtin_amdgcn_mfma_f32_32x32x16_bf16(a0, qr[d0], p0, 0, 0, 0); p1 = __builtin_amdgcn_mfma_f32_32x32x16_bf16(a1, qr[d0], p1, 0, 0, 0); }
            if (band) { if (64 * i + 63 > 32 * wid) {
#pragma unroll
                    for (int r = 0; r < 16; ++r) { const int kv = 64 * i + crow(r, hi); if (kv > qrel) p0[r] = -INFINITY; if (kv + 32 > qrel) p1[r] = -INFINITY; } } }
            if constexpr (VAR != 1 && VAR != 3) {
            float ra = mx3(p0[0], p0[1], p1[0]), rb = mx3(p0[2], p0[3], p1[1]); ra = mx3(ra, p1[2], p1[3]);
#pragma unroll
            for (int r = 4; r < 16; r += 4) { ra = mx3(ra, p0[r], p0[r + 1]); rb = mx3(rb, p0[r + 2], p0[r + 3]); ra = mx3(ra, p1[r], p1[r + 1]); rb = mx3(rb, p1[r + 2], p1[r + 3]); }
            const float rm = xhalf_max(__builtin_fmaxf(ra, rb));
            if (i == 0 || __any(rm > THR)) {
                const float dl = (i == 0) ? rm : fmaxf(rm, 0.f); mhat += dl;
#pragma unroll
                for (int r = 0; r < 16; ++r) { p0[r] -= dl; p1[r] -= dl; negm[r] = -mhat; }
                if (i != 0) { const float f = __builtin_amdgcn_exp2f(-dl); l_reg *= f; if (hi == 0) wsf[r32] = f;
                    asm volatile("s_waitcnt lgkmcnt(0)" ::: "memory");
#pragma unroll
                    for (int r = 0; r < 16; ++r) { const float fr_ = wsf[crow(r, hi)]; o[0][r] *= fr_; o[1][r] *= fr_; } }
            }
            f32x2 sacc = {0.f, 0.f};
#pragma unroll
            for (int r = 0; r < 16; ++r) { p0[r] = __builtin_amdgcn_exp2f(p0[r]); p1[r] = __builtin_amdgcn_exp2f(p1[r]); }
#pragma unroll
            for (int r = 0; r < 16; r += 2) { sacc += (f32x2){p0[r], p0[r + 1]}; sacc += (f32x2){p1[r], p1[r + 1]}; }
            l_reg += sacc[0] + sacc[1];
            }
#pragma unroll
            for (int s = 0; s < 2; ++s)
#pragma unroll
                for (int j = 0; j < 4; ++j) { pw[s][j] = cvtpk(p0[8 * s + 2 * j], p0[8 * s + 2 * j + 1]); pw[2 + s][j] = cvtpk(p1[8 * s + 2 * j], p1[8 * s + 2 * j + 1]); }
            if constexpr (VAR != 2 && VAR != 3) { FA_PV(sl); } else { o[0][0] += __uint_as_float(pw[0][0] ^ pw[1][1] ^ pw[2][2] ^ pw[3][3]); }
        }
        asm volatile("s_waitcnt lgkmcnt(0)" ::: "memory"); wait_vm(young);
        __builtin_amdgcn_s_barrier(); asm volatile("" ::: "memory");
        sl = sl1; opsPrev = ops;
    }
    l_reg = xhalf_sum(l_reg);
    if (hi == 0) wsf[32 + r32] = l_reg;
    asm volatile("s_waitcnt lgkmcnt(0)" ::: "memory");
#pragma unroll
    for (int r = 0; r < 16; ++r) { const float rl = 1.0f / wsf[32 + crow(r, hi)]; bf16_t* op = O + (size_t)(q0 + wid * 32 + crow(r, hi)) * 1024 + r32;
        op[0] = (bf16_t)f2bf(o[0][r] * rl); op[32] = (bf16_t)f2bf(o[1][r] * rl); }
    asm volatile("s_waitcnt lgkmcnt(0)" ::: "memory"); __builtin_amdgcn_s_barrier(); asm volatile("" ::: "memory");
#undef FA_DMA
#undef FA_TILE
#undef FA_PV
}
template <int VAR>
__device__ __forceinline__ void phase_attn_fast(const Params& p, LAS unsigned char* lds, int vcu, int G, bool do_conv) {
    unsigned char* ws = p.ws;
    const bf16_t* QM = (const bf16_t*)(ws + WS_QM); const bf16_t* KM = (const bf16_t*)(ws + WS_KM); const bf16_t* VM = (const bf16_t*)(ws + WS_VM);
    const bf16_t* QB = (const bf16_t*)(ws + WS_QB); const bf16_t* KB = (const bf16_t*)(ws + WS_KB); const bf16_t* VB = (const bf16_t*)(ws + WS_VB);
    const float* kmean = (const float*)(ws + WS_KMEANP); bf16_t* ATT = (bf16_t*)(ws + WS_ATT);
    const int wave_ = __builtin_amdgcn_readfirstlane(threadIdx.x >> 6);
    BgConv bg; bg.next = do_conv ? vcu * NWAVES + wave_ : NEXP_ITEMS; bg.stride = G * NWAVES; bg.pend0 = -1; bg.pend1 = -1; bg.itc = 0;
    for (int su = vcu; su < 256; su += G) {
        const int bh = su >> 2, j = su & 3, b = bh >> 3, h = bh & 7; const size_t r0 = (size_t)b * SEQ;
#pragma unroll 1
        for (int k = 0; k < 2; ++k) { const int qb = k ? 7 - j : j;
            attn_unit<96, VAR>(lds, QM + r0 * 768 + h * 96, 768, KM + r0 * 768 + h * 96, 768, VM + r0 * 512 + h * 64, 512, ATT + r0 * 1024 + h * 64, qb, nullptr, p, bg);
            attn_unit<64, VAR>(lds, QB + r0 * 512 + h * 64, 512, KB + r0 * 512 + h * 64, 512, VB + r0 * 512 + h * 64, 512, ATT + r0 * 1024 + 512 + h * 64, qb, kmean + (size_t)(b * 8) * 1024 + h * 64, p, bg); }
    }
    { const int lane = threadIdx.x & 63; LAS unsigned char* bscr = lds + fa::LDS_NEED + wave_ * 8192;
      asm volatile("s_waitcnt vmcnt(0)" ::: "memory");
      if (bg.pend0 >= 0) { expert_finish(p, bg.pend0, bscr, lane); bg.pend0 = -1; }
      if (bg.pend1 >= 0) { expert_finish(p, bg.pend1, bscr + 4096, lane); bg.pend1 = -1; }
      asm volatile("s_waitcnt lgkmcnt(0)" ::: "memory");
#pragma unroll 1
      for (; bg.next < NEXP_ITEMS; bg.next += bg.stride) { expert_issue(p, bg.next, bscr, lane); asm volatile("s_waitcnt vmcnt(0)" ::: "memory"); expert_finish(p, bg.next, bscr, lane); asm volatile("s_waitcnt lgkmcnt(0)" ::: "memory"); } }
}

__device__ __forceinline__ float rs32(float (&a)[32], int lane) {
#pragma unroll
    for (int e = 0; e < 16; ++e) { auto rr = __builtin_amdgcn_permlane32_swap(__float_as_uint(a[e]), __float_as_uint(a[e + 16]), false, false); a[e] = __uint_as_float(rr[0]) + __uint_as_float(rr[1]); }
#pragma unroll
    for (int e = 0; e < 8; ++e) { auto rr = __builtin_amdgcn_permlane16_swap(__float_as_uint(a[e]), __float_as_uint(a[e + 8]), false, false); a[e] = __uint_as_float(rr[0]) + __uint_as_float(rr[1]); }
    { const bool bit = (lane & 8) != 0;
#pragma unroll
      for (int e = 0; e < 4; ++e) { const float keep = bit ? a[e + 4] : a[e], send = bit ? a[e] : a[e + 4]; a[e] = keep + __shfl_xor(send, 8); } }
    { const bool bit = (lane & 4) != 0;
#pragma unroll
      for (int e = 0; e < 2; ++e) { const float keep = bit ? a[e + 2] : a[e], send = bit ? a[e] : a[e + 2]; a[e] = keep + __shfl_xor(send, 4); } }
    { const bool bit = (lane & 2) != 0; const float keep = bit ? a[1] : a[0], send = bit ? a[0] : a[1]; a[0] = keep + __shfl_xor(send, 2); }
    return a[0] + __shfl_xor(a[0], 1);
}
__device__ __forceinline__ void route_row(const Params& p, float logit, int tok, int tl, int lane, int* tidx, float* tgate, LAS int* lidx) {
    const int me = lane >> 1;
    const float my = (lane & 1) ? -INFINITY : logit + p.b_router[me];
    int rank = 0;
#pragma unroll
    for (int e = 0; e < 32; ++e) { const float ve = __uint_as_float(__builtin_amdgcn_readlane(__float_as_uint(my), 2 * e)); rank += (ve > my || (ve == my && e < me)) ? 1 : 0; }
    float tv[4]; int ti[4];
#pragma unroll
    for (int k = 0; k < 4; ++k) { const unsigned long long bal = __ballot(rank == k && !(lane & 1)); const int il = __ffsll((long long)bal) - 1;
        tv[k] = __uint_as_float(__builtin_amdgcn_readlane(__float_as_uint(my), il)); ti[k] = il >> 1; }
    if (lane == 0) { const float e1 = expf(tv[1] - tv[0]), e2 = expf(tv[2] - tv[0]), e3 = expf(tv[3] - tv[0]); const float is = 1.0f / (1.0f + e1 + e2 + e3);
        *(f32x4*)(tgate + (size_t)tok * 4) = (f32x4){is, e1 * is, e2 * is, e3 * is};
        int* tp = tidx + (size_t)tok * 4; tp[0] = ti[0]; tp[1] = ti[1]; tp[2] = ti[2]; tp[3] = ti[3];
        lidx[tl * 4 + 0] = ti[0]; lidx[tl * 4 + 1] = ti[1]; lidx[tl * 4 + 2] = ti[2]; lidx[tl * 4 + 3] = ti[3]; }
}
__device__ __forceinline__ void phase_ln1_route(const Params& p, LAS unsigned char* lds, int vcu, int G) {
    const int tid = threadIdx.x, wave = tid >> 6, lane = tid & 63;
    unsigned char* ws = p.ws;
    float* X1 = p.out; const float* X1P = (const float*)(ws + WS_X1PRE); bf16_t* X1B = (bf16_t*)(ws + WS_X1B);
    int* tidx = (int*)(ws + WS_TIDX); float* tgate = (float*)(ws + WS_TGATE); unsigned* hist = (unsigned*)(ws + WS_HIST);
    LAS int* lidx = (LAS int*)(lds + ROWTAB_OFF);
    { const float* WRL = (const float*)(ws + WS_WRL);
      for (int i = tid; i < 8192; i += NTHREADS) *(LAS f32x4*)(lds + (size_t)i * 16) = *(const f32x4*)(WRL + (size_t)i * 4); }
    __syncthreads();
    const LAS float* Wl = (const LAS float*)lds + lane * 4;
    for (int chunk = vcu; chunk < NCHUNK; chunk += G) {
#pragma unroll 1
        for (int rp = 0; rp < 4; ++rp) {
            const int tl = wave * 8 + 2 * rp, tok = chunk * 64 + tl;
            f32x4 v0[4], v1[4]; float s0 = 0.f, s1 = 0.f;
#pragma unroll
            for (int j = 0; j < 4; ++j) { v0[j] = *(const f32x4*)(X1P + (size_t)tok * DM + 4 * lane + 256 * j); v1[j] = *(const f32x4*)(X1P + (size_t)(tok + 1) * DM + 4 * lane + 256 * j);
                s0 += (v0[j][0] + v0[j][1]) + (v0[j][2] + v0[j][3]); s1 += (v1[j][0] + v1[j][1]) + (v1[j][2] + v1[j][3]); }
            const float mean0 = wave_sum(s0) * (1.0f / DM), mean1 = wave_sum(s1) * (1.0f / DM); float q0 = 0.f, q1 = 0.f;
#pragma unroll
            for (int j = 0; j < 4; ++j) { v0[j] = v0[j] - mean0; v1[j] = v1[j] - mean1;
                q0 += (v0[j][0] * v0[j][0] + v0[j][1] * v0[j][1]) + (v0[j][2] * v0[j][2] + v0[j][3] * v0[j][3]); q1 += (v1[j][0] * v1[j][0] + v1[j][1] * v1[j][1]) + (v1[j][2] * v1[j][2] + v1[j][3] * v1[j][3]); }
            const float rs0 = 1.0f / sqrtf(wave_sum(q0) * (1.0f / DM) + LN_EPS), rs1 = 1.0f / sqrtf(wave_sum(q1) * (1.0f / DM) + LN_EPS);
#pragma unroll
            for (int j = 0; j < 4; ++j) { const f32x4 g = *(const f32x4*)(p.ln1_g + 4 * lane + 256 * j), bb = *(const f32x4*)(p.ln1_b + 4 * lane + 256 * j);
                v0[j] = v0[j] * rs0 * g + bb; v1[j] = v1[j] * rs1 * g + bb;
                *(f32x4*)(X1 + (size_t)tok * DM + 4 * lane + 256 * j) = v0[j]; *(f32x4*)(X1 + (size_t)(tok + 1) * DM + 4 * lane + 256 * j) = v1[j];
                u32x2 w; w.x = pk2(v0[j][0], v0[j][1]); w.y = pk2(v0[j][2], v0[j][3]); *(u32x2*)(X1B + (size_t)tok * DM + 4 * lane + 256 * j) = w;
                w.x = pk2(v1[j][0], v1[j][1]); w.y = pk2(v1[j][2], v1[j][3]); *(u32x2*)(X1B + (size_t)(tok + 1) * DM + 4 * lane + 256 * j) = w; }
            float a0[32], a1[32];
#pragma unroll
            for (int e = 0; e < 32; ++e) { a0[e] = 0.f; a1[e] = 0.f; }
            const LAS float* wlo = Wl; const LAS float* whi = Wl + 8 * 2048;
            asm volatile("" : "+v"(wlo), "+v"(whi));
#pragma unroll
            for (int j = 0; j < 4; ++j)
#pragma unroll
                for (int i = 0; i < 4; ++i) { const float x0 = v0[j][i], x1 = v1[j][i]; const LAS float* wb = (j < 2) ? wlo + (j * 4 + i) * 2048 : whi + ((j - 2) * 4 + i) * 2048;
#pragma unroll
                    for (int e4 = 0; e4 < 8; ++e4) { const f32x4 w = *(const LAS f32x4*)(wb + e4 * 256);
#pragma unroll
                        for (int k = 0; k < 4; ++k) { a0[4 * e4 + k] = fmaf(x0, w[k], a0[4 * e4 + k]); a1[4 * e4 + k] = fmaf(x1, w[k], a1[4 * e4 + k]); } }
                    asm volatile("" ::: "memory"); }
            const float l0 = rs32(a0, lane), l1 = rs32(a1, lane);
            route_row(p, l0, tok, tl, lane, tidx, tgate, lidx);
            route_row(p, l1, tok + 1, tl + 1, lane, tidx, tgate, lidx);
        }
        __syncthreads();
        if (tid < 32) { unsigned c = 0; for (int a = 0; a < 256; ++a) c += (lidx[a] == tid) ? 1u : 0u; hist[chunk * 32 + tid] = c; }
        __syncthreads();
    }
}

__device__ __forceinline__ void phase_assign(const Params& p, LAS unsigned char* lds, int vcu, int G) {
    const int tid = threadIdx.x;
    unsigned char* ws = p.ws;
    const int* tidx = (const int*)(ws + WS_TIDX); const float* tgate = (const float*)(ws + WS_TGATE); const unsigned* hist = (const unsigned*)(ws + WS_HIST);
    int* dest = (int*)(ws + WS_DEST); int* row_tok = (int*)(ws + WS_ROWTOK); float* row_gate = (float*)(ws + WS_ROWGATE); int* tile_e = (int*)(ws + WS_TILEE);
    LAS int* lidx = (LAS int*)lds;
    LAS int* lcnt = (LAS int*)(lds + 1024);
    LAS int* lpre = (LAS int*)(lds + 1024 + 128);
    LAS int* lstart = (LAS int*)(lds + 1024 + 256);
    LAS int* ptot = (LAS int*)(lds + 2048);
    LAS int* ppre = (LAS int*)(lds + 4096);
    for (int chunk = vcu; chunk < NCHUNK; chunk += G) {
        if (tid < 256) lidx[tid] = tidx[chunk * 256 + tid];
        { const int e = tid & 31, cg = tid >> 5; int tot = 0, pre = 0;
#pragma unroll
          for (int k = 0; k < 16; ++k) { const int c = cg * 16 + k; const int hv = (int)hist[c * 32 + e]; tot += hv; pre += (c < chunk) ? hv : 0; }
          ptot[cg * 32 + e] = tot; ppre[cg * 32 + e] = pre; }
        __syncthreads();
        if (tid < 32) { int tot = 0, pre = 0;
#pragma unroll
            for (int cg = 0; cg < 16; ++cg) { tot += ptot[cg * 32 + tid]; pre += ppre[cg * 32 + tid]; }
            lcnt[tid] = tot; lpre[tid] = pre; }
        __syncthreads();
        if (tid == 0) { int s2 = 0; for (int e = 0; e < 32; ++e) { lstart[e] = s2; s2 += (lcnt[e] + 255) / 256 * 256; } lstart[32] = s2; }
        __syncthreads();
        if (tid < 256) { const int e = lidx[tid]; int rank = 0; for (int a = 0; a < tid; ++a) rank += (lidx[a] == e) ? 1 : 0;
            const int P = lstart[e] + lpre[e] + rank, tok = chunk * 64 + (tid >> 2);
            row_tok[P] = tok; row_gate[P] = tgate[chunk * 256 + tid]; dest[chunk * 256 + tid] = P; }
        if (chunk < 32) { const int e = chunk; for (int P = lstart[e] + lcnt[e] + tid; P < lstart[e + 1]; P += NTHREADS) { row_tok[P] = 0; row_gate[P] = 0.f; } }
        if (chunk == 0) { if (tid < 32) { for (int t = lstart[tid] / 256; t < lstart[tid + 1] / 256; ++t) tile_e[t] = tid; } if (tid == 32) tile_e[MAXTILES] = lstart[32] / 256; }
        __syncthreads();
    }
}

__device__ __forceinline__ void phase_final(const Params& p, int vcu, int G, float* outp) {
    const int tid = threadIdx.x, wave = tid >> 6, lane = tid & 63;
    unsigned char* ws = p.ws;
    const int* dest = (const int*)(ws + WS_DEST); const bf16_t* Y = (const bf16_t*)(ws + WS_Y); float* X1 = p.out;
    const int gw = vcu * NWAVES + wave, NGW = G * NWAVES;
    for (int t0 = gw * 8; t0 < NTOK; t0 += NGW * 8) {
        const int dl = (lane < 32) ? dest[t0 * 4 + lane] : 0;
#pragma unroll
        for (int pr = 0; pr < 4; ++pr) {
            const int tok = t0 + 2 * pr;
            int P[2][4];
#pragma unroll
            for (int t = 0; t < 2; ++t)
#pragma unroll
                for (int k = 0; k < 4; ++k) P[t][k] = __builtin_amdgcn_readlane(dl, (2 * pr + t) * 4 + k);
            f32x4 v[2][4]; u32x2 y[2][4][4];
#pragma unroll
            for (int t = 0; t < 2; ++t)
#pragma unroll
                for (int j = 0; j < 4; ++j) { v[t][j] = *(const f32x4*)(X1 + (size_t)(tok + t) * DM + 4 * lane + 256 * j);
#pragma unroll
                    for (int k = 0; k < 4; ++k) y[t][k][j] = *(const u32x2*)(Y + (size_t)P[t][k] * 1024 + 4 * lane + 256 * j); }
            float s[2], q[2];
#pragma unroll
            for (int t = 0; t < 2; ++t) { s[t] = 0.f;
#pragma unroll
                for (int j = 0; j < 4; ++j) { v[t][j] = v[t][j] * DN_ALPHA;
#pragma unroll
                    for (int k = 0; k < 4; ++k) { const u32x2 w = y[t][k][j];
                        v[t][j][0] += __uint_as_float(w.x << 16); v[t][j][1] += __uint_as_float(w.x & 0xffff0000u); v[t][j][2] += __uint_as_float(w.y << 16); v[t][j][3] += __uint_as_float(w.y & 0xffff0000u); }
                    s[t] += (v[t][j][0] + v[t][j][1]) + (v[t][j][2] + v[t][j][3]); } }
            const float mean0 = wave_sum(s[0]) * (1.0f / DM), mean1 = wave_sum(s[1]) * (1.0f / DM);
            q[0] = 0.f; q[1] = 0.f;
#pragma unroll
            for (int j = 0; j < 4; ++j) { v[0][j] = v[0][j] - mean0; v[1][j] = v[1][j] - mean1;
                q[0] += (v[0][j][0] * v[0][j][0] + v[0][j][1] * v[0][j][1]) + (v[0][j][2] * v[0][j][2] + v[0][j][3] * v[0][j][3]);
                q[1] += (v[1][j][0] * v[1][j][0] + v[1][j][1] * v[1][j][1]) + (v[1][j][2] * v[1][j][2] + v[1][j][3] * v[1][j][3]); }
            const float rs0 = 1.0f / sqrtf(wave_sum(q[0]) * (1.0f / DM) + LN_EPS), rs1 = 1.0f / sqrtf(wave_sum(q[1]) * (1.0f / DM) + LN_EPS);
#pragma unroll
            for (int j = 0; j < 4; ++j) { const f32x4 g = *(const f32x4*)(p.ln2_g + 4 * lane + 256 * j), bb = *(const f32x4*)(p.ln2_b + 4 * lane + 256 * j);
                *(f32x4*)(outp + (size_t)tok * DM + 4 * lane + 256 * j) = v[0][j] * rs0 * g + bb;
                *(f32x4*)(outp + (size_t)(tok + 1) * DM + 4 * lane + 256 * j) = v[1][j] * rs1 * g + bb; }
        }
    }
}

constexpr int NPHASE = 11;
__global__ void __launch_bounds__(NTHREADS, 2) fwd_kernel(Params p) {
    extern __shared__ __attribute__((aligned(16))) unsigned char lds_raw[];
    LAS unsigned char* lds = (LAS unsigned char*)lds_raw;
    const int tid = threadIdx.x;
    const int G = gridDim.x, bx = blockIdx.x;
    const int vcu = (G % 8 == 0) ? (bx % 8) * (G / 8) + bx / 8 : bx;
    unsigned char* ws = p.ws;
    volatile LAS unsigned* MISC = (volatile LAS unsigned*)(lds + MISC_OFF);
    if (tid < 32) MISC[tid] = 0u;
    __syncthreads();
    XcdBarrier bar; bar.bar = (unsigned*)(ws + WS_CTL) + CW_BAR; bar.x = 0; bar.st = nullptr;
    const bool one = (p.ph_hi - p.ph_lo) > 1;
    if (one) bar = xcd_barrier_post((unsigned*)(ws + WS_CTL) + CW_BAR, MISC + 8);
    const int lo = p.ph_lo, hi = p.ph_hi;
#ifdef ONLY_PHASE
#define IN(k) ((k) == ONLY_PHASE && lo <= (k) && (k) < hi)
#else
#define IN(k) (lo <= (k) && (k) < hi)
#endif
#ifndef NAIVE_GEMM_MASK
#define NAIVE_GEMM_MASK 0
#endif
#define GEMM_CALL(EPI, SCHED) do { if constexpr (NAIVE_GEMM_MASK != 0) gemm_phase_naive<EPI, SCHED>(lds, g, S, E); else gemm_phase<EPI, SCHED, true>(lds, g, S, E); } while (0)
#ifndef ATTN_VAR
#define ATTN_VAR 0
#endif
#ifndef REPEAT_PHASE
#define REPEAT_PHASE (-1)
#endif
#define SEAM(k) do { if (IN(k) && IN((k) == 1 ? 3 : (k) + 1)) xcd_barrier(bar); } while (0)

#define PHASE(k, ...) do { if (IN(k)) { if constexpr (REPEAT_PHASE == (k)) { __VA_ARGS__; xcd_barrier(bar); } __VA_ARGS__; } SEAM(k); } while (0)
    PHASE(0, phase_prologue(p, lds, vcu, G));
    PHASE(1, { GemmArgs g{(const bf16_t*)(ws + WS_XB), 1024, (const bf16_t*)(ws + WS_WIN), 1024, 1024}; DenseSched S; S.init(lds, NTOK, PN, G, vcu);
        EpiProj E{ws}; GEMM_CALL(EpiProj, DenseSched); });
    PHASE(3, { { GemmArgs g{(const bf16_t*)(ws + WS_LAT), KUP, (const bf16_t*)(ws + WS_WUP), KUP, 256}; DenseSched S; S.init(lds, NTOK, 768, G, vcu);
          EpiUp E{(bf16_t*)(ws + WS_QM), (bf16_t*)(ws + WS_KM), (bf16_t*)(ws + WS_VM), (const float*)(ws + WS_RSTDP), (const float*)(ws + WS_ROPEA), 0}; GEMM_CALL(EpiUp, DenseSched); }
        { GemmArgs g{(const bf16_t*)(ws + WS_LAT) + 256, KUP, (const bf16_t*)(ws + WS_WUP) + (size_t)768 * KUP + 256, KUP, 128}; DenseSched S; S.init(lds, NTOK, 1024, G, (vcu + 192) % G);
          EpiUp E{(bf16_t*)(ws + WS_QM), (bf16_t*)(ws + WS_KM), (bf16_t*)(ws + WS_VM), (const float*)(ws + WS_RSTDP), (const float*)(ws + WS_ROPEA), 24}; GEMM_CALL(EpiUp, DenseSched); } });
    if constexpr (REPEAT_PHASE == 44) { if (IN(4)) { phase_attn_fast<ATTN_VAR>(p, lds, vcu, G, false); xcd_barrier(bar); } }
    PHASE(4, phase_attn_fast<0>(p, lds, vcu, G, true));
    PHASE(5, { GemmArgs g{(const bf16_t*)(ws + WS_ATT), 1024, (const bf16_t*)(ws + WS_WO), 1024, 1024}; DenseSched S; S.init(lds, NTOK, DM, G, vcu);
        EpiWo E{p.x, (float*)(ws + WS_X1PRE)}; GEMM_CALL(EpiWo, DenseSched); });
    PHASE(6, phase_ln1_route(p, lds, vcu, G));
    PHASE(7, phase_assign(p, lds, vcu, G));
    PHASE(8, { GemmArgs g{(const bf16_t*)(ws + WS_X1B), 1024, (const bf16_t*)(ws + WS_WGU), 1024, 1024}; GroupSched<true> S; S.init(lds, (const int*)(ws + WS_TILEE), (const int*)(ws + WS_ROWTOK), 8, 2048, G, vcu);
        EpiGateUp E{(bf16_t*)(ws + WS_H), p.b_gate, p.b_up}; GEMM_CALL(EpiGateUp, GroupSched<true>); });
    PHASE(9, { GemmArgs g{(const bf16_t*)(ws + WS_H), 1024, (const bf16_t*)(ws + WS_WD), 1024, 1024}; GroupSched<false> S; S.init(lds, (const int*)(ws + WS_TILEE), (const int*)(ws + WS_ROWTOK), 4, 1024, G, vcu);
        EpiDown E{(bf16_t*)(ws + WS_Y), p.b_down, (const float*)(ws + WS_ROWGATE)}; GEMM_CALL(EpiDown, GroupSched<false>); });
    if (IN(10)) { if constexpr (REPEAT_PHASE == 10) { phase_final(p, vcu, G, (float*)(ws + WS_X1PRE)); xcd_barrier(bar); } phase_final(p, vcu, G, p.out); }
#undef IN
#undef SEAM
}

extern "C" void kernel_launch(void* const* d_in, const int* in_sizes, int n_in, void* d_out, int out_size, void* d_ws, size_t ws_size, hipStream_t stream) {
    static int grid = 0;
    if (grid == 0) {
        if (n_in != 20 || out_size != NTOK * DM || ws_size < WS_END) { fprintf(stderr, "kernel_launch: unexpected shapes (n_in %d out %d ws %zu)\n", n_in, out_size, ws_size); grid = -1; return; }
        int dev = 0, cus = 0, per_cu = 0;
        if (hipGetDevice(&dev) != hipSuccess || hipDeviceGetAttribute(&cus, hipDeviceAttributeMultiprocessorCount, dev) != hipSuccess) { grid = -1; return; }
        if (hipFuncSetAttribute((const void*)fwd_kernel, hipFuncAttributeMaxDynamicSharedMemorySize, LDS_BYTES) != hipSuccess) { fprintf(stderr, "kernel_launch: hipFuncSetAttribute failed\n"); grid = -1; return; }
        if (hipOccupancyMaxActiveBlocksPerMultiprocessor(&per_cu, (const void*)fwd_kernel, NTHREADS, LDS_BYTES) != hipSuccess || per_cu < 1) fprintf(stderr, "kernel_launch: occupancy query says %d\n", per_cu);
        (void)hipGetLastError();
        grid = cus;
    }
    if (grid < 0) return;
    (void)hipMemsetAsync((char*)d_ws + WS_CTL, 0, CTL_ZERO_BYTES, stream);
    Params p{};
    p.x = (const float*)d_in[0]; p.pos = (const int*)d_in[1]; p.w_in = (const float*)d_in[2]; p.q_a_norm = (const float*)d_in[3]; p.w_q_b = (const float*)d_in[4];
    p.kv_a_norm = (const float*)d_in[5]; p.w_kv_b = (const float*)d_in[6]; p.w_o = (const float*)d_in[7]; p.ln1_g = (const float*)d_in[8]; p.ln1_b = (const float*)d_in[9];
    p.w_router = (const float*)d_in[10]; p.b_router = (const float*)d_in[11]; p.w_gate = (const float*)d_in[12]; p.b_gate = (const float*)d_in[13];
    p.w_up = (const float*)d_in[14]; p.b_up = (const float*)d_in[15]; p.w_down = (const float*)d_in[16]; p.b_down = (const float*)d_in[17];
    p.ln2_g = (const float*)d_in[18]; p.ln2_b = (const float*)d_in[19];
    p.out = (float*)d_out; p.ws = (unsigned char*)d_ws;
    for (int i = 0; i < 16; ++i) p.invfA[i] = pow(500000.0, -(double)(2 * i) / 32.0);
    for (int i = 0; i < 8; ++i) p.invfB[i] = pow(500000.0, -(double)(2 * i) / 16.0);
#if MK_ONE_LAUNCH
    p.ph_lo = 0; p.ph_hi = NPHASE;
    hipLaunchKernelGGL(fwd_kernel, dim3(grid), dim3(NTHREADS), LDS_BYTES, stream, p);
#else
    for (int ph = 0; ph < NPHASE; ++ph) { p.ph_lo = ph; p.ph_hi = ph + 1; hipLaunchKernelGGL(fwd_kernel, dim3(grid), dim3(NTHREADS), LDS_BYTES, stream, p); }
#endif
}
```

```cpp
#include <hip/hip_runtime.h>
#include <cstdio>
#include <cstdint>
#include <cmath>

#ifndef MK_ONE_LAUNCH
#define MK_ONE_LAUNCH 1
#endif

#define GAS __attribute__((address_space(1)))
#define LAS __attribute__((address_space(3)))
typedef unsigned short bf16_t;
typedef short bf16x8 __attribute__((ext_vector_type(8)));
typedef float f32x4 __attribute__((ext_vector_type(4)));
typedef float f32x2 __attribute__((ext_vector_type(2)));
typedef unsigned u32x4 __attribute__((ext_vector_type(4)));
typedef unsigned u32x2 __attribute__((ext_vector_type(2)));

constexpr int NTOK = 16384, DM = 1024, SEQ = 2048, NBATCH = 8;
constexpr int PN = 2048;
constexpr int C_QL = 0, C_KVL = 256, C_KR = 384, C_MQ = 416, C_MK = 928, C_MV = 1440, IN_COLS = 1952;
constexpr int NUP = 1792, KUP = 384;
constexpr int NE = 32, TOPK = 4;
constexpr int MAXROWS = 65536 + NE * 256, MAXTILES = MAXROWS / 256;
constexpr int NCHUNK = NTOK / 64;
constexpr float LN_EPS = 1e-5f, RMS_EPS = 1e-6f;
constexpr float DN_ALPHA = 1.189207115002721f;
constexpr float LOG2E = 1.4426950408889634f;
constexpr float C2A = 0.10206207261596575f * LOG2E;
constexpr float C2B = 0.125f * LOG2E;
constexpr int NWAVES = 8, NTHREADS = 512;

constexpr size_t MiB = 1u << 20;
constexpr size_t WS_CTL = 0, CTL_ZERO_BYTES = 1 * MiB;
constexpr size_t WS_HIST = 1 * MiB;
constexpr size_t WS_TIDX = WS_HIST + 64 * 1024;
constexpr size_t WS_TGATE = WS_TIDX + 256 * 1024;
constexpr size_t WS_DEST = WS_TGATE + 256 * 1024;
constexpr size_t WS_ROWTOK = WS_DEST + 256 * 1024;
constexpr size_t WS_ROWGATE = WS_ROWTOK + 288 * 1024;
constexpr size_t WS_TILEE = WS_ROWGATE + 288 * 1024;
constexpr size_t WS_RSTD = WS_TILEE + 4 * 1024;
constexpr size_t WS_KMEAN = WS_RSTD + 128 * 1024;
constexpr size_t WS_WRL = WS_KMEAN + 128 * 1024;
static_assert(WS_WRL + 128 * 1024 <= 4 * MiB, "route region");
constexpr size_t WS_ROPEA = 4 * MiB;
constexpr size_t WS_ROPEB = 6 * MiB;
constexpr size_t WS_WIN = 8 * MiB;
constexpr size_t WS_WO = 12 * MiB;
constexpr size_t WS_WUP = 14 * MiB;
constexpr size_t WS_X1B = 16 * MiB;
constexpr size_t WS_WD = 48 * MiB;
constexpr size_t WS_XB = 112 * MiB;
constexpr size_t WS_PROJ = 144 * MiB;
constexpr size_t WS_QM = 208 * MiB;
constexpr size_t WS_KM = 232 * MiB;
constexpr size_t WS_VM = 256 * MiB;
constexpr size_t WS_QB = 272 * MiB;
constexpr size_t WS_KB = 288 * MiB;
constexpr size_t WS_ATT = 304 * MiB;
constexpr size_t WS_H = 112 * MiB;
constexpr size_t WS_WGU = 336 * MiB;
constexpr size_t WS_Y = 336 * MiB;
constexpr size_t WS_LAT = 144 * MiB;
constexpr size_t WS_VB = 160 * MiB;
constexpr size_t WS_RSTDP = 176 * MiB;
constexpr size_t WS_KMEANP = 177 * MiB;
constexpr size_t WS_X1PRE = 144 * MiB;
constexpr size_t WS_END = 480 * MiB;
static_assert(WS_H + (size_t)MAXROWS * 1024 * 2 <= WS_VM + 0 * MiB + 0 && WS_Y + (size_t)MAXROWS * 1024 * 2 <= WS_END, "ws map");
constexpr int CW_BAR = 4096;

constexpr int LDS_BYTES = 147456;
constexpr int MISC_OFF = 131072 + 320;

__device__ __forceinline__ float bf2f(unsigned v) { return __uint_as_float(v << 16); }
__device__ __forceinline__ unsigned f2bf(float f) { unsigned u = __float_as_uint(f); return (u + 0x7fffu + ((u >> 16) & 1u)) >> 16; }
__device__ __forceinline__ unsigned pk2(float lo, float hi) { typedef __bf16 bf2_t __attribute__((ext_vector_type(2))); f32x2 v = {lo, hi}; bf2_t b = __builtin_convertvector(v, bf2_t); return __builtin_bit_cast(unsigned, b); }
__device__ __forceinline__ float wave_sum(float v) {
#pragma unroll
    for (int o = 1; o < 64; o <<= 1) v += __shfl_xor(v, o);
    return v;
}
__device__ __forceinline__ float wave_max(float v) {
#pragma unroll
    for (int o = 1; o < 64; o <<= 1) v = fmaxf(v, __shfl_xor(v, o));
    return v;
}

#define XB_TMO      128
#define XB_XCNT(j)  (256  + 64 * (j))
#define XB_XSUB(j)  (1280 + 64 * (j))
#define XB_XGEN(j)  (2304 + 64 * (j))
#define XB_TOP      3328
#define XB_TOPGEN   3392
#define XCD_BAR_WORDS 3456
#define XB_SPIN_CAP (1u << 18)
__device__ __forceinline__ unsigned xb_ld(unsigned* p)              { return __hip_atomic_load(p, __ATOMIC_RELAXED, __HIP_MEMORY_SCOPE_AGENT); }
__device__ __forceinline__ unsigned xb_add(unsigned* p, unsigned v) { return __hip_atomic_fetch_add(p, v, __ATOMIC_RELAXED, __HIP_MEMORY_SCOPE_AGENT); }
__device__ __forceinline__ unsigned xb_xcc_id() { return (unsigned)__builtin_amdgcn_s_getreg((3 << 11) | 20) & 0xFu; }
#define XB_SPIN(cond, bar) do { unsigned _sp = 0; while (cond) { __builtin_amdgcn_s_sleep(1); \
    if ((++_sp & 255u) == 0u) { if (xb_ld(&(bar)[XB_TMO])) break; if (_sp > XB_SPIN_CAP) { atomicAdd(&(bar)[XB_TMO], 1u); break; } } } } while (0)
struct XcdBarrier { unsigned* bar; unsigned x; volatile LAS unsigned* st; };
__device__ __forceinline__ XcdBarrier xcd_barrier_post(unsigned* bar, volatile LAS unsigned* st) {
    XcdBarrier b; b.bar = bar; b.x = xb_xcc_id(); b.st = st;
    if (threadIdx.x == 0) (void)xb_add(&bar[XB_XCNT(b.x)], 1u);
    return b;
}
__device__ __forceinline__ void xcd_barrier_complete(unsigned* bar, unsigned x, unsigned& nloc, unsigned& nx) {
    const unsigned G = gridDim.x * gridDim.y * gridDim.z;
    unsigned sum, cnt, mine, sp = 0u;
    for (;;) {
        sum = 0u; cnt = 0u; mine = 0u;
#pragma unroll
        for (unsigned j = 0; j < 16; ++j) { const unsigned c = xb_ld(&bar[XB_XCNT(j)]); sum += c; cnt += (c > 0u) ? 1u : 0u; mine = (j == x) ? c : mine; }
        if (sum == G) break;
        __builtin_amdgcn_s_sleep(1);
        if ((++sp & 255u) == 0u) { if (xb_ld(&bar[XB_TMO])) break; if (sp > XB_SPIN_CAP) { atomicAdd(&bar[XB_TMO], 1u); break; } }
    }
    nloc = mine > 0u ? mine : 1u; nx = cnt > 0u ? cnt : 1u;
}
__device__ __forceinline__ void xcd_barrier(const XcdBarrier& b) {
    asm volatile("s_waitcnt vmcnt(0)" ::: "memory");
    __syncthreads();
    if (threadIdx.x == 0) {
        unsigned* bar = b.bar;
        __builtin_amdgcn_s_waitcnt(0);
        unsigned nloc = b.st[0], nx = b.st[1];
        if (nloc == 0u) { xcd_barrier_complete(bar, b.x, nloc, nx); b.st[0] = nloc; b.st[1] = nx; }
        const unsigned old = xb_add(&bar[XB_XSUB(b.x)], 1u);
        const unsigned gen = old / nloc;
        if (old + 1u == (gen + 1u) * nloc) {
            __builtin_amdgcn_fence(__ATOMIC_RELEASE, "agent");
            asm volatile("s_waitcnt vmcnt(0)" ::: "memory");
            const unsigned og = xb_add(&bar[XB_TOP], 1u);
            const unsigned tg = og / nx;
            if (og + 1u == (tg + 1u) * nx) xb_add(&bar[XB_TOPGEN], 1u);
            else XB_SPIN(xb_ld(&bar[XB_TOPGEN]) == tg, bar);
            __builtin_amdgcn_fence(__ATOMIC_ACQUIRE, "agent");
            xb_add(&bar[XB_XGEN(b.x)], 1u);
            asm volatile("s_waitcnt vmcnt(0)" ::: "memory");
        } else {
            XB_SPIN(xb_ld(&bar[XB_XGEN(b.x)]) == gen, bar);
            __builtin_amdgcn_fence(__ATOMIC_ACQUIRE, "agent");
            asm volatile("s_waitcnt vmcnt(0)" ::: "memory");
        }
    }
    __syncthreads();
}

struct Params {
    const float* x; const int* pos;
    const float *w_in, *q_a_norm, *w_q_b, *kv_a_norm, *w_kv_b, *w_o, *ln1_g, *ln1_b, *w_router, *b_router;
    const float *w_gate, *b_gate, *w_up, *b_up, *w_down, *b_down, *ln2_g, *ln2_b;
    float* out; unsigned char* ws;
    double invfA[16]; double invfB[8];
    int ph_lo, ph_hi;
};

struct Unit { int pm, pn, e; };
struct GemmArgs { const bf16_t* A; int lda; const bf16_t* Bt; int ldb; int K; };
template <bool PERM> __device__ __forceinline__ int ecol(int bj, int n, int wc, int fq) { return 128 * bj + 32 * wc + (PERM ? 8 * fq + 4 * n : 16 * n + 4 * fq); }

template <class Epi, class Sched>
__device__ __forceinline__ void gemm_phase_naive(LAS unsigned char* lds, const GemmArgs g, const Sched& S, const Epi& E) {
    const int tid = threadIdx.x, wid = __builtin_amdgcn_readfirstlane(tid >> 6), lane = tid & 63, wr = wid >> 2, wc = wid & 3, fr = lane & 15, fq = lane >> 4;
    Unit u;
    for (int ui = 0; S.next(ui, u); ++ui) {
        f32x4 acc[2][2][4][2];
#pragma unroll
        for (int a = 0; a < 2; ++a)
#pragma unroll
            for (int b = 0; b < 2; ++b)
#pragma unroll
                for (int m = 0; m < 4; ++m)
#pragma unroll
                    for (int n = 0; n < 2; ++n) acc[a][b][m][n] = (f32x4){0.f, 0.f, 0.f, 0.f};
        unsigned aoff[2][4];
#pragma unroll
        for (int a = 0; a < 2; ++a)
#pragma unroll
            for (int m = 0; m < 4; ++m) aoff[a][m] = (unsigned)S.arow(u, ui, 128 * a + 64 * wr + 16 * m + fr) * (unsigned)g.lda;
        const bf16_t* bb = g.Bt + (size_t)(S.brow0(u) + 32 * wc) * g.ldb;
        const unsigned bl0 = (unsigned)(4 * fq) * (unsigned)g.ldb, bl1 = (unsigned)(8 * fq) * (unsigned)g.ldb;
#pragma unroll 1
        for (int k = 0; k < g.K; k += 2) {
            float af[2][4][2];
#pragma unroll
            for (int a = 0; a < 2; ++a)
#pragma unroll
                for (int m = 0; m < 4; ++m) { const unsigned v = *(const unsigned*)(g.A + aoff[a][m] + k); af[a][m][0] = __uint_as_float(v << 16); af[a][m][1] = __uint_as_float(v & 0xffff0000u); }
#pragma unroll
            for (int b = 0; b < 2; ++b)
#pragma unroll
                for (int n = 0; n < 2; ++n)
#pragma unroll
                    for (int j = 0; j < 4; ++j) {
                        const int ccol = 128 * b + (Epi::PERM ? 4 * n : 16 * n) + j;
                        const unsigned v = *(const unsigned*)(bb + (size_t)ccol * g.ldb + ((Epi::PERM ? bl1 : bl0) + (unsigned)k));
                        const float b0 = __uint_as_float(v << 16), b1 = __uint_as_float(v & 0xffff0000u);
#pragma unroll
                        for (int a = 0; a < 2; ++a)
#pragma unroll
                            for (int m = 0; m < 4; ++m) acc[a][b][m][n][j] = fmaf(af[a][m][1], b1, fmaf(af[a][m][0], b0, acc[a][b][m][n][j]));
                    }
        }
        E(acc, u, wr, wc, fr, fq);
    }
}

namespace pg {
constexpr int BK = 64, HALF = 128, HTB = HALF * BK * 2;
__device__ __forceinline__ int lds_byte(int r, int c) { const int st = (r >> 4) * 2 + (c >> 5), rr = r & 15, cc = c & 31, ob = rr * 64 + cc * 2; return st * 1024 + (ob ^ (((ob >> 9) & 1) << 5)); }
__device__ __forceinline__ void stage_rc(int b, int& R, int& C) { const int st = b / 1024, sb = b % 1024, swz = sb ^ (((sb >> 9) & 1) << 5); R = (st >> 1) * 16 + swz / 64; C = (st & 1) * 32 + (swz % 64) / 2; }
__device__ __forceinline__ int perm32(int rho) { const int n = rho >> 4, i = rho & 15; return 8 * (i >> 2) + 4 * n + (i & 3); }
}
template <class Epi, class Sched, bool ALIGN_EPI>
__device__ __forceinline__ void gemm_phase(LAS unsigned char* lds, const GemmArgs g, const Sched& S, const Epi& E) {
    using namespace pg;
    const int tid = threadIdx.x, wid = __builtin_amdgcn_readfirstlane(tid >> 6), lane = tid & 63, wr = wid >> 2, wc = wid & 3, fr = lane & 15, fq = lane >> 4;
    const int nt = g.K / BK;
    int sR[2], sC[2], sRb[2];
#pragma unroll
    for (int i = 0; i < 2; ++i) { int R, C; stage_rc(tid * 16 + i * 8192, R, C); sR[i] = R; sC[i] = C; sRb[i] = Epi::PERM ? ((R & ~31) + perm32(R & 31)) : R; }
    const unsigned ldsw = (unsigned)wid * 1024u;
    const int aoff = lds_byte(wr * 64 + fr, fq * 8), boff = lds_byte(wc * 32 + fr, fq * 8);
    const char* Ab = (const char*)g.A; const char* Bb = (const char*)g.Bt;
#define PG_SA(b, h) (((b) * 2 + (h)) * HTB)
#define PG_SB(b, h) ((4 + (b) * 2 + (h)) * HTB)
#define PG_STAGE(bufoff, gptr, v0, v1) do { \
        __builtin_amdgcn_global_load_lds((const unsigned*)((gptr) + (v0)), (LAS unsigned*)(lds + (bufoff) + ldsw), 16, 0, 0); \
        __builtin_amdgcn_global_load_lds((const unsigned*)((gptr) + (v1)), (LAS unsigned*)(lds + (bufoff) + ldsw + 8192), 16, 0, 0); } while (0)
#define PG_LDA(dst, b, h) do { _Pragma("unroll") for (int m = 0; m < 4; ++m) _Pragma("unroll") for (int k = 0; k < 2; ++k) dst[m][k] = *(const LAS bf16x8*)(lds + PG_SA(b, h) + aoff + m * 2048 + k * 1024); } while (0)
#define PG_LDB(dst, b, h) do { _Pragma("unroll") for (int n = 0; n < 2; ++n) _Pragma("unroll") for (int k = 0; k < 2; ++k) dst[n][k] = *(const LAS bf16x8*)(lds + PG_SB(b, h) + boff + n * 2048 + k * 1024); } while (0)
#define PG_MMA(ai, bj, At, Bt) do { __builtin_amdgcn_s_setprio(1); _Pragma("unroll") for (int m = 0; m < 4; ++m) _Pragma("unroll") for (int n = 0; n < 2; ++n) _Pragma("unroll") for (int k = 0; k < 2; ++k) \
        acc[ai][bj][m][n] = __builtin_amdgcn_mfma_f32_16x16x32_bf16(Bt[n][k], At[m][k], acc[ai][bj][m][n], 0, 0, 0); __builtin_amdgcn_s_setprio(0); } while (0)
#define PG_WAIT_V(n) asm volatile("s_waitcnt vmcnt(" #n ")" ::: "memory")
#define PG_WAIT_L(n) asm volatile("s_waitcnt lgkmcnt(" #n ")" ::: "memory")
#define PG_BAR __builtin_amdgcn_s_barrier()
#define PG_SCHED __builtin_amdgcn_sched_barrier(0)
    constexpr bool GA = Sched::GATHER;
    unsigned cA[2], cB[2];
#pragma unroll
    for (int i = 0; i < 2; ++i) { cA[i] = ((unsigned)sR[i] * (unsigned)g.lda + (unsigned)sC[i]) * 2u; cB[i] = ((unsigned)sRb[i] * (unsigned)g.ldb + (unsigned)sC[i]) * 2u; }
    const size_t hA = (size_t)128 * g.lda * 2, hB = (size_t)128 * g.ldb * 2;
#define PG_GOFFS(u, uidx, VA) do { if constexpr (GA) { _Pragma("unroll") for (int h = 0; h < 2; ++h) _Pragma("unroll") for (int i = 0; i < 2; ++i) \
        VA[h][i] = ((unsigned)S.arow(u, uidx, 128 * h + sR[i]) * (unsigned)g.lda + (unsigned)sC[i]) * 2u; } } while (0)
#define PG_UA(u) (GA ? (size_t)0 : (size_t)S.arow(u, 0, 0) * g.lda * 2)
#define PG_UB(u) ((size_t)S.brow0(u) * g.ldb * 2)
#define PG_STAGE_A(bufoff, ab, VA, h) do { if constexpr (GA) { PG_STAGE(bufoff, (ab), VA[h][0], VA[h][1]); } else { PG_STAGE(bufoff, (ab) + (h) * hA, cA[0], cA[1]); } } while (0)
#define PG_STAGE_B(bufoff, bb, h) PG_STAGE(bufoff, (bb) + (h) * hB, cB[0], cB[1])
    Unit cur, nxt; int ui = 0;
    if (!S.next(0, cur)) return;
    f32x4 acc[2][2][4][2];
#pragma unroll
    for (int a = 0; a < 2; ++a)
#pragma unroll
        for (int b = 0; b < 2; ++b)
#pragma unroll
            for (int m = 0; m < 4; ++m)
#pragma unroll
                for (int n = 0; n < 2; ++n) acc[a][b][m][n] = (f32x4){0.f, 0.f, 0.f, 0.f};
    bf16x8 At[4][2], B0[2][2], B1[2][2];
    unsigned vA[2][2], nvA[2][2];
    PG_GOFFS(cur, 0, vA);
    const char* cAp = Ab + PG_UA(cur); const char* cBp = Bb + PG_UB(cur);
    PG_STAGE_B(PG_SB(0, 0), cBp, 0); PG_STAGE_B(PG_SB(0, 1), cBp, 1); PG_STAGE_A(PG_SA(0, 0), cAp, vA, 0); PG_STAGE_A(PG_SA(0, 1), cAp, vA, 1);
    if (wr == 1) PG_BAR;
    PG_WAIT_V(2); PG_BAR;
    PG_STAGE_B(PG_SB(1, 0), cBp + 128, 0); PG_STAGE_A(PG_SA(1, 0), cAp + 128, vA, 0); PG_STAGE_B(PG_SB(1, 1), cBp + 128, 1);
    PG_WAIT_V(6); PG_BAR;
    for (;;) {
        const bool has_next = S.next(ui + 1, nxt);
        const char* nAp = cAp; const char* nBp = cBp;
        if (has_next) { PG_GOFFS(nxt, ui + 1, nvA); nAp = Ab + PG_UA(nxt); nBp = Bb + PG_UB(nxt); }
        else { if constexpr (GA) {
#pragma unroll
            for (int h = 0; h < 2; ++h)
#pragma unroll
                for (int i = 0; i < 2; ++i) nvA[h][i] = vA[h][i]; } }
#pragma unroll 1
        for (int t = 0; t < nt; t += 2) {
            const bool last = (t == nt - 2);
            const char* a1 = cAp + (size_t)(t + 1) * 128;
            const char* a2 = last ? nAp : cAp + (size_t)(t + 2) * 128; const char* b2 = last ? nBp : cBp + (size_t)(t + 2) * 128;
            const char* a3 = a2 + 128; const char* b3 = b2 + 128;
            unsigned wA[2][2];
            if constexpr (GA) {
#pragma unroll
                for (int h = 0; h < 2; ++h)
#pragma unroll
                    for (int i = 0; i < 2; ++i) wA[h][i] = last ? nvA[h][i] : vA[h][i]; }
            PG_LDB(B0, 0, 0); PG_LDB(B1, 0, 1); PG_SCHED; PG_LDA(At, 0, 0); PG_STAGE_A(PG_SA(1, 1), a1, vA, 1);
            PG_WAIT_V(8); PG_WAIT_L(0); PG_BAR; PG_MMA(0, 0, At, B0); PG_MMA(0, 1, At, B1); PG_BAR; PG_SCHED;
            PG_LDA(At, 0, 1); PG_STAGE_B(PG_SB(0, 0), b2, 0); PG_STAGE_B(PG_SB(0, 1), b2, 1); PG_STAGE_A(PG_SA(0, 0), a2, wA, 0);
            PG_WAIT_V(8); PG_WAIT_L(0); PG_BAR; PG_MMA(1, 0, At, B0); PG_MMA(1, 1, At, B1); PG_BAR; PG_SCHED;
            PG_LDB(B0, 1, 0); PG_LDB(B1, 1, 1); PG_SCHED; PG_LDA(At, 1, 0); PG_STAGE_A(PG_SA(0, 1), a2, wA, 1);
            PG_WAIT_V(8); PG_WAIT_L(0); PG_BAR; PG_MMA(0, 0, At, B0); PG_MMA(0, 1, At, B1); PG_BAR; PG_SCHED;
            PG_LDA(At, 1, 1); PG_STAGE_B(PG_SB(1, 0), b3, 0); PG_STAGE_B(PG_SB(1, 1), b3, 1); PG_STAGE_A(PG_SA(1, 0), a3, wA, 0);
            PG_WAIT_V(8); PG_WAIT_L(0); PG_BAR; PG_MMA(1, 0, At, B0); PG_MMA(1, 1, At, B1); PG_BAR; PG_SCHED;
        }
        if constexpr (ALIGN_EPI) { if (wr == 0) PG_BAR; }
        E(acc, cur, wr, wc, fr, fq);
        if (!has_next) break;
#pragma unroll
        for (int a = 0; a < 2; ++a)
#pragma unroll
            for (int b = 0; b < 2; ++b)
#pragma unroll
                for (int m = 0; m < 4; ++m)
#pragma unroll
                    for (int n = 0; n < 2; ++n) acc[a][b][m][n] = (f32x4){0.f, 0.f, 0.f, 0.f};
        cur = nxt; ++ui; cAp = nAp; cBp = nBp;
        if constexpr (GA) {
#pragma unroll
            for (int h = 0; h < 2; ++h)
#pragma unroll
                for (int i = 0; i < 2; ++i) vA[h][i] = nvA[h][i]; }
        if constexpr (ALIGN_EPI) { if (wr == 1) PG_BAR; }
    }
    PG_WAIT_V(0);
    if constexpr (!ALIGN_EPI) { if (wr == 0) PG_BAR; }
    PG_BAR;
#undef PG_SA
#undef PG_SB
#undef PG_STAGE
#undef PG_LDA
#undef PG_LDB
#undef PG_MMA
#undef PG_WAIT_V
#undef PG_WAIT_L
#undef PG_BAR
#undef PG_SCHED
#undef PG_GOFFS
#undef PG_UA
#undef PG_UB
#undef PG_STAGE_A
#undef PG_STAGE_B
}

constexpr int ROWTAB_OFF = 132096, ETAB_OFF = ROWTAB_OFF + 12 * 1024, MAXU = 12;
struct DenseSched {
    static constexpr bool GATHER = false;
    int nN, nunits, G, c;
    __device__ __forceinline__ void init(LAS unsigned char*, int M, int N, int G_, int c_) { nN = N / 256; nunits = (M / 256) * nN; G = G_; c = c_; }
    __device__ __forceinline__ bool next(int i, Unit& u) const { const int L = i * G + c; if (L >= nunits) return false; u.pm = L / nN; u.pn = L % nN; u.e = 0; return true; }
    __device__ __forceinline__ int arow(const Unit& u, int, int r) const { return 256 * u.pm + r; }
    __device__ __forceinline__ int brow0(const Unit& u) const { return 256 * u.pn; }
};
template <bool GATHER_> struct GroupSched {
    static constexpr bool GATHER = GATHER_;
    LAS int* rowtab; LAS int* etab; int nN, nexp_rows, nunits, G, c;
    __device__ __forceinline__ void init(LAS unsigned char* lds, const int* te, const int* rt, int nN_, int nexp_rows_, int G_, int c_) {
        rowtab = (LAS int*)(lds + ROWTAB_OFF); etab = (LAS int*)(lds + ETAB_OFF); nN = nN_; nexp_rows = nexp_rows_; G = G_; c = c_;
        nunits = __builtin_amdgcn_readfirstlane(te[MAXTILES]) * nN_;
        for (int i = 0; i < MAXU; ++i) { const int L = i * G + c; if (L >= nunits) break; const int pm = L / nN;
            if (threadIdx.x == 0) etab[i] = te[pm];
            if (GATHER && threadIdx.x < 256) rowtab[i * 256 + threadIdx.x] = rt[256 * pm + threadIdx.x]; }
        __syncthreads();
    }
    __device__ __forceinline__ bool next(int i, Unit& u) const { const int L = i * G + c; if (L >= nunits || i >= MAXU) return false; u.pm = L / nN; u.pn = L % nN; u.e = etab[i]; return true; }
    __device__ __forceinline__ int arow(const Unit& u, int ui, int r) const { return GATHER ? rowtab[ui * 256 + r] : 256 * u.pm + r; }
    __device__ __forceinline__ int brow0(const Unit& u) const { return u.e * nexp_rows + 256 * u.pn; }
};

struct EpiProj {
    static constexpr bool PERM = true;
    unsigned char* ws;
    __device__ __forceinline__ void operator()(const f32x4 (&acc)[2][2][4][2], const Unit& u, int wr, int wc, int fr, int fq) const {
        asm volatile("" : "+v"(fr), "+v"(fq));
        bf16_t* LAT = (bf16_t*)(ws + WS_LAT); bf16_t* KM = (bf16_t*)(ws + WS_KM); bf16_t* QB = (bf16_t*)(ws + WS_QB); bf16_t* KB = (bf16_t*)(ws + WS_KB); bf16_t* VB = (bf16_t*)(ws + WS_VB);
        float* rstdp = (float*)(ws + WS_RSTDP); float* kmeanp = (float*)(ws + WS_KMEANP);
        const float* ropeA = (const float*)(ws + WS_ROPEA); const float* ropeB = (const float*)(ws + WS_ROPEB);
#pragma unroll
        for (int b = 0; b < 2; ++b) {
            const int g = 8 * u.pn + 4 * b + wc;
            if (g < 12) {
#pragma unroll
                for (int a = 0; a < 2; ++a)
#pragma unroll
                    for (int m = 0; m < 4; ++m) { const int row = 256 * u.pm + 128 * a + 64 * wr + 16 * m + fr; const f32x4 v0 = acc[a][b][m][0], v1 = acc[a][b][m][1];
                        u32x4 w; w.x = pk2(v0[0], v0[1]); w.y = pk2(v0[2], v0[3]); w.z = pk2(v1[0], v1[1]); w.w = pk2(v1[2], v1[3]);
                        *(u32x4*)(LAT + (size_t)row * 384 + g * 32 + 8 * fq) = w;
                        float ss = 0.f;
#pragma unroll
                        for (int k = 0; k < 4; ++k) { const float e0 = __uint_as_float(w[k] << 16), e1 = __uint_as_float(w[k] & 0xffff0000u); ss += e0 * e0 + e1 * e1; }
                        ss += __shfl_xor(ss, 16); ss += __shfl_xor(ss, 32);
                        if (fq == 0) rstdp[(size_t)row * 12 + g] = ss; }
            } else if (g == 12) {
#pragma unroll
                for (int a = 0; a < 2; ++a)
#pragma unroll
                    for (int m = 0; m < 4; ++m) { const int row = 256 * u.pm + 128 * a + 64 * wr + 16 * m + fr; u32x4 w;
#pragma unroll
                        for (int n = 0; n < 2; ++n) { const f32x4 v = acc[a][b][m][n]; f32x4 pv;
#pragma unroll
                            for (int j = 0; j < 4; ++j) { auto rr = __builtin_amdgcn_permlane32_swap(__float_as_uint(v[j]), __float_as_uint(v[j]), false, false); pv[j] = __uint_as_float(fq < 2 ? rr[1] : rr[0]); }
                            const f32x4 c = *(const f32x4*)(ropeA + (size_t)row * 32 + 8 * (fq & 1) + 4 * n), sn = *(const f32x4*)(ropeA + (size_t)row * 32 + 16 + 8 * (fq & 1) + 4 * n);
                            const f32x4 o = (fq < 2) ? (v * c - pv * sn) : (v * c + pv * sn);
                            w[2 * n] = pk2(o[0], o[1]); w[2 * n + 1] = pk2(o[2], o[3]); }
#pragma unroll
                        for (int h = 0; h < 8; ++h) *(u32x4*)(KM + (size_t)row * 768 + h * 96 + 64 + 8 * fq) = w; }
            } else if (g < 45) {
                const bool isk = g >= 29; const int rel = isk ? g - 29 : g - 13, head = rel >> 1, hf = rel & 1;
                bf16_t* dst = (isk ? KB : QB) + head * 64 + hf * 32 + 8 * fq;
                f32x4 cs0 = (f32x4){0.f, 0.f, 0.f, 0.f}, cs1 = cs0;
#pragma unroll
                for (int a = 0; a < 2; ++a)
#pragma unroll
                    for (int m = 0; m < 4; ++m) { const int row = 256 * u.pm + 128 * a + 64 * wr + 16 * m + fr; f32x4 v0 = acc[a][b][m][0], v1 = acc[a][b][m][1];
                        if (hf == 0) {
#pragma unroll
                            for (int n = 0; n < 2; ++n) { const f32x4 v = n ? v1 : v0; f32x4 pv;
#pragma unroll
                                for (int j = 0; j < 4; ++j) { auto rr = __builtin_amdgcn_permlane16_swap(__float_as_uint(v[j]), __float_as_uint(v[j]), false, false); pv[j] = __uint_as_float((fq & 1) ? rr[0] : rr[1]); }
                                const f32x4 c = *(const f32x4*)(ropeB + (size_t)row * 16 + 4 * n), sn = *(const f32x4*)(ropeB + (size_t)row * 16 + 8 + 4 * n);
                                const f32x4 o = (fq == 0) ? (v * c - pv * sn) : (fq == 1) ? (v * c + pv * sn) : v;
                                if (n) v1 = o; else v0 = o; } }
                        if (isk) { cs0 += v0; cs1 += v1; }
                        const f32x4 s0 = isk ? v0 : v0 * C2B, s1 = isk ? v1 : v1 * C2B;
                        u32x4 w; w.x = pk2(s0[0], s0[1]); w.y = pk2(s0[2], s0[3]); w.z = pk2(s1[0], s1[1]); w.w = pk2(s1[2], s1[3]);
                        *(u32x4*)(dst + (size_t)row * 512) = w; }
                if (isk) {
#pragma unroll
                    for (int j = 0; j < 4; ++j) {
#pragma unroll
                        for (int o = 1; o < 16; o <<= 1) { cs0[j] += __shfl_xor(cs0[j], o); cs1[j] += __shfl_xor(cs1[j], o); } }
                    if (fr == 0) { float* kp = kmeanp + ((size_t)u.pm * 2 + wr) * 512 + head * 64 + hf * 32 + 8 * fq; *(f32x4*)kp = cs0; *(f32x4*)(kp + 4) = cs1; } }
            } else if (g < 61) {
                const int rel = g - 45;
#pragma unroll
                for (int a = 0; a < 2; ++a)
#pragma unroll
                    for (int m = 0; m < 4; ++m) { const int row = 256 * u.pm + 128 * a + 64 * wr + 16 * m + fr; const f32x4 v0 = acc[a][b][m][0], v1 = acc[a][b][m][1];
                        u32x4 w; w.x = pk2(v0[0], v0[1]); w.y = pk2(v0[2], v0[3]); w.z = pk2(v1[0], v1[1]); w.w = pk2(v1[2], v1[3]);
                        *(u32x4*)(VB + (size_t)row * 512 + rel * 32 + 8 * fq) = w; }
            }
            asm volatile("" ::: "memory");
        }
    }
};
struct EpiUp {
    static constexpr bool PERM = true;
    bf16_t *QM, *KM, *VM; const float* rstd; const float* ropeA; int gbase;
    __device__ __forceinline__ void operator()(const f32x4 (&acc)[2][2][4][2], const Unit& u, int wr, int wc, int fr, int fq) const {
        asm volatile("" : "+v"(fr), "+v"(fq));
#pragma unroll
        for (int a = 0; a < 2; ++a)
#pragma unroll
            for (int m = 0; m < 4; ++m) { const int row = 256 * u.pm + 128 * a + 64 * wr + 16 * m + fr;
                const f32x4 s0 = *(const f32x4*)(rstd + (size_t)row * 12), s1 = *(const f32x4*)(rstd + (size_t)row * 12 + 4), s2 = *(const f32x4*)(rstd + (size_t)row * 12 + 8);
                const float rq = C2A / sqrtf((((s0[0] + s0[1]) + (s0[2] + s0[3])) + ((s1[0] + s1[1]) + (s1[2] + s1[3]))) * (1.0f / 256.0f) + RMS_EPS);
                const float rkv = 1.0f / sqrtf(((s2[0] + s2[1]) + (s2[2] + s2[3])) * (1.0f / 128.0f) + RMS_EPS);
#pragma unroll
                for (int b = 0; b < 2; ++b) {
                    const int gidx = gbase + 8 * u.pn + 4 * b + wc;
                    if (gidx < 24) {
                        const int h = gidx / 3, part = gidx % 3;
                        f32x4 v0 = acc[a][b][m][0] * rq, v1 = acc[a][b][m][1] * rq;
                        if (part == 2) {
#pragma unroll
                            for (int n = 0; n < 2; ++n) { const f32x4 v = n ? v1 : v0; f32x4 pv;
#pragma unroll
                                for (int j = 0; j < 4; ++j) { auto rr = __builtin_amdgcn_permlane32_swap(__float_as_uint(v[j]), __float_as_uint(v[j]), false, false); pv[j] = __uint_as_float(fq < 2 ? rr[1] : rr[0]); }
                                const f32x4 c = *(const f32x4*)(ropeA + (size_t)row * 32 + 8 * (fq & 1) + 4 * n), sn = *(const f32x4*)(ropeA + (size_t)row * 32 + 16 + 8 * (fq & 1) + 4 * n);
                                const f32x4 o = (fq < 2) ? (v * c - pv * sn) : (v * c + pv * sn);
                                if (n) v1 = o; else v0 = o; } }
                        u32x4 w; w.x = pk2(v0[0], v0[1]); w.y = pk2(v0[2], v0[3]); w.z = pk2(v1[0], v1[1]); w.w = pk2(v1[2], v1[3]);
                        *(u32x4*)(QM + (size_t)row * 768 + h * 96 + part * 32 + 8 * fq) = w;
                    } else {
                        const int g2 = gidx - 24, h = g2 >> 2, part = g2 & 3;
                        const f32x4 v0 = acc[a][b][m][0] * rkv, v1 = acc[a][b][m][1] * rkv;
                        bf16_t* pp = (part < 2) ? (KM + (size_t)row * 768 + h * 96 + part * 32 + 8 * fq) : (VM + (size_t)row * 512 + h * 64 + (part - 2) * 32 + 8 * fq);
                        u32x4 w; w.x = pk2(v0[0], v0[1]); w.y = pk2(v0[2], v0[3]); w.z = pk2(v1[0], v1[1]); w.w = pk2(v1[2], v1[3]);
                        *(u32x4*)pp = w;
                    }
                }
                asm volatile("" ::: "memory"); }
    }
};
struct EpiWo {
    static constexpr bool PERM = false;
    const float* x; float* O;
    __device__ __forceinline__ void operator()(const f32x4 (&acc)[2][2][4][2], const Unit& u, int wr, int wc, int fr, int fq) const {
        asm volatile("" : "+v"(fr), "+v"(fq));
#pragma unroll
        for (int a = 0; a < 2; ++a)
#pragma unroll
            for (int m = 0; m < 4; ++m) { const int row = 256 * u.pm + 128 * a + 64 * wr + 16 * m + fr;
#pragma unroll
                for (int b = 0; b < 2; ++b)
#pragma unroll
                    for (int n = 0; n < 2; ++n) { const size_t off = (size_t)row * DM + 256 * u.pn + ecol<PERM>(b, n, wc, fq);
                        const f32x4 xv = *(const f32x4*)(x + off); *(f32x4*)(O + off) = xv * DN_ALPHA + acc[a][b][m][n]; } }
    }
};
struct EpiGateUp {
    static constexpr bool PERM = true;
    bf16_t* H; const float *bg, *bu;
    __device__ __forceinline__ void operator()(const f32x4 (&acc)[2][2][4][2], const Unit& u, int wr, int wc, int fr, int fq) const {
        asm volatile("" : "+v"(fr), "+v"(fq));
        const int hc = 128 * u.pn + 32 * wc + 8 * fq;
        f32x4 vbg[2], vbu[2];
#pragma unroll
        for (int n = 0; n < 2; ++n) { vbg[n] = *(const f32x4*)(bg + (size_t)u.e * 1024 + hc + 4 * n); vbu[n] = *(const f32x4*)(bu + (size_t)u.e * 1024 + hc + 4 * n); }
#pragma unroll
        for (int a = 0; a < 2; ++a)
#pragma unroll
            for (int m = 0; m < 4; ++m) { const int row = 256 * u.pm + 128 * a + 64 * wr + 16 * m + fr; u32x4 w;
#pragma unroll
                for (int n = 0; n < 2; ++n) { const f32x4 gv = acc[a][0][m][n] + vbg[n], uv = acc[a][1][m][n] + vbu[n]; float hv[4];
#pragma unroll
                    for (int j = 0; j < 4; ++j) { const float gg = fminf(gv[j], 7.0f), uu = fminf(fmaxf(uv[j], -7.0f), 7.0f);
                        const float sg = __builtin_amdgcn_rcpf(1.0f + __builtin_amdgcn_exp2f(-1.702f * LOG2E * gg)); hv[j] = gg * sg * (uu + 1.0f); }
                    w[2 * n] = pk2(hv[0], hv[1]); w[2 * n + 1] = pk2(hv[2], hv[3]); }
                __builtin_nontemporal_store(w, (u32x4*)(H + (size_t)row * 1024 + hc)); }
    }
};
struct EpiDown {
    static constexpr bool PERM = true;
    bf16_t* Y; const float* bd; const float* row_gate;
    __device__ __forceinline__ void operator()(const f32x4 (&acc)[2][2][4][2], const Unit& u, int wr, int wc, int fr, int fq) const {
        asm volatile("" : "+v"(fr), "+v"(fq));
        f32x4 bv[2][2];
#pragma unroll
        for (int b = 0; b < 2; ++b)
#pragma unroll
            for (int n = 0; n < 2; ++n) bv[b][n] = *(const f32x4*)(bd + (size_t)u.e * 1024 + 256 * u.pn + 128 * b + 32 * wc + 8 * fq + 4 * n);
#pragma unroll
        for (int a = 0; a < 2; ++a)
#pragma unroll
            for (int m = 0; m < 4; ++m) { const int row = 256 * u.pm + 128 * a + 64 * wr + 16 * m + fr; const float gw = row_gate[row];
#pragma unroll
                for (int b = 0; b < 2; ++b) { const int col = 256 * u.pn + 128 * b + 32 * wc + 8 * fq;
                    const f32x4 v0 = (acc[a][b][m][0] + bv[b][0]) * gw, v1 = (acc[a][b][m][1] + bv[b][1]) * gw;
                    u32x4 w; w.x = pk2(v0[0], v0[1]); w.y = pk2(v0[2], v0[3]); w.z = pk2(v1[0], v1[1]); w.w = pk2(v1[2], v1[3]);
                    __builtin_nontemporal_store(w, (u32x4*)(Y + (size_t)row * 1024 + col)); } }
    }
};

__device__ __forceinline__ unsigned cvtpk_hw(float lo, float hi) { typedef __bf16 bf2 __attribute__((ext_vector_type(2))); f32x2 v = {lo, hi}; bf2 b = __builtin_convertvector(v, bf2); return __builtin_bit_cast(unsigned, b); }
__device__ __forceinline__ void conv_issue(const float* W, int ldw, int k0, int n0, LAS unsigned char* scr, int lane) {
#pragma unroll
    for (int i = 0; i < 4; ++i) __builtin_amdgcn_global_load_lds((const unsigned*)(W + (size_t)(k0 + 4 * (lane >> 3) + i) * ldw + n0 + 4 * (lane & 7)), (LAS unsigned*)(scr + i * 1024), 16, 0, 2);
}
__device__ __forceinline__ void conv_finish(bf16_t* WT, int ldt, int orow0, int ocol0, const LAS unsigned char* scr, int lane) {
    f32x4 r[4];
#pragma unroll
    for (int i = 0; i < 4; ++i) r[i] = *(const LAS f32x4*)(scr + i * 1024 + lane * 16);
#pragma unroll
    for (int j = 0; j < 4; ++j) { u32x2 o; o.x = cvtpk_hw(r[0][j], r[1][j]); o.y = cvtpk_hw(r[2][j], r[3][j]);
        *(u32x2*)(WT + (size_t)(orow0 + 4 * (lane & 7) + j) * ldt + ocol0 + 4 * (lane >> 3)) = o; }
}
constexpr int NEXP_ITEMS = 3 * NE * 1024;
__device__ __forceinline__ void expert_issue(const Params& p, int r, LAS unsigned char* scr, int lane) {
    const int mat = r >> 15, rr = r & 32767, e = rr >> 10, q = rr & 1023, kb = (q & 1) | ((q >> 6) << 1), nb = (q >> 1) & 31;
    const float* W = (mat == 0 ? p.w_gate : mat == 1 ? p.w_up : p.w_down) + (size_t)e * 1048576;
    conv_issue(W, 1024, 32 * kb, 32 * nb, scr, lane);
}
__device__ __forceinline__ void expert_finish(const Params& p, int r, const LAS unsigned char* scr, int lane) {
    const int mat = r >> 15, rr = r & 32767, e = rr >> 10, q = rr & 1023, kb = (q & 1) | ((q >> 6) << 1), nb = (q >> 1) & 31, n0 = 32 * nb;
    bf16_t* WguT = (bf16_t*)(p.ws + WS_WGU); bf16_t* WdT = (bf16_t*)(p.ws + WS_WD);
    if (mat == 2) conv_finish(WdT, 1024, e * 1024 + n0, 32 * kb, scr, lane);
    else conv_finish(WguT, 1024, e * 2048 + (n0 >> 7) * 256 + (mat == 1 ? 128 : 0) + (n0 & 127), 32 * kb, scr, lane);
}
struct BgConv { int next, stride, pend0, pend1, itc; };

__device__ __forceinline__ void tr_item(const float* W, int ldw, int k0, int n0, bf16_t* WT, int ldt, int orow0, int ocol0, const float* kscale, LAS float* scr, int lane) {
#pragma unroll 8
    for (int i = 0; i < 32; ++i) { const int kk = 2 * i + (lane >> 5); float v = W[(size_t)(k0 + kk) * ldw + n0 + (lane & 31)]; if (kscale) v *= kscale[k0 + kk]; scr[kk * 33 + (lane & 31)] = v; }
    asm volatile("s_waitcnt lgkmcnt(0)" ::: "memory");
    const int c = lane & 7;
#pragma unroll
    for (int j = 0; j < 4; ++j) { const int n = (lane >> 3) + 8 * j; const LAS float* s = scr + (8 * c) * 33 + n;
        u32x4 o; o.x = pk2(s[0 * 33], s[1 * 33]); o.y = pk2(s[2 * 33], s[3 * 33]); o.z = pk2(s[4 * 33], s[5 * 33]); o.w = pk2(s[6 * 33], s[7 * 33]);
        *(u32x4*)(WT + (size_t)(orow0 + n) * ldt + ocol0 + 8 * c) = o; }
    asm volatile("s_waitcnt lgkmcnt(0)" ::: "memory");
}
__device__ __forceinline__ void phase_prologue(const Params& p, LAS unsigned char* lds, int vcu, int G) {
    const int tid = threadIdx.x, wave = tid >> 6, lane = tid & 63;
    unsigned char* ws = p.ws;
    LAS float* scr = (LAS float*)(lds + wave * 16384);
    const int gw = vcu * NWAVES + wave, NGW = G * NWAVES;
    bf16_t* WinT = (bf16_t*)(ws + WS_WIN); bf16_t* WoT = (bf16_t*)(ws + WS_WO); bf16_t* WupT = (bf16_t*)(ws + WS_WUP);
    constexpr int I_IN = 16 * 61, I_QB = 4 * 24, I_KVB = 2 * 32, I_O = 16 * 32;
    constexpr int NITEMS = I_IN + I_QB + I_KVB + I_O;
    for (int it = gw; it < NITEMS; it += NGW) {
        int r = it;
        if (r < I_IN) { const int kb = r / 61, nb = r % 61; tr_item(p.w_in, IN_COLS, 64 * kb, 32 * nb, WinT, 1024, 32 * nb, 64 * kb, nullptr, scr, lane); continue; } r -= I_IN;
        if (r < I_QB) { const int kb = r / 24, nb = r % 24; tr_item(p.w_q_b, 768, 64 * kb, 32 * nb, WupT, KUP, 32 * nb, 64 * kb, p.q_a_norm, scr, lane); continue; } r -= I_QB;
        if (r < I_KVB) { const int kb = r / 32, nb = r % 32; tr_item(p.w_kv_b, 1024, 64 * kb, 32 * nb, WupT, KUP, 768 + 32 * nb, 256 + 64 * kb, p.kv_a_norm, scr, lane); continue; } r -= I_KVB;
        { const int kb = r / 32, nb = r % 32; tr_item(p.w_o, 1024, 64 * kb, 32 * nb, WoT, 1024, 32 * nb, 64 * kb, nullptr, scr, lane); }
    }
    const int gt = vcu * NTHREADS + tid, NGT = G * NTHREADS;
    for (int i = gt; i < 96 * 128; i += NGT) *(u32x4*)(WinT + (size_t)IN_COLS * 1024 + (size_t)i * 8) = (u32x4){0u, 0u, 0u, 0u};
    for (int i = gt; i < 768 * 16; i += NGT) { const int r = i / 16, c = i % 16; *(u32x4*)(WupT + (size_t)r * KUP + 256 + c * 8) = (u32x4){0u, 0u, 0u, 0u}; }
    for (int i = gt; i < 1024 * 32; i += NGT) { const int r = i / 32, c = i % 32; *(u32x4*)(WupT + (size_t)(768 + r) * KUP + c * 8) = (u32x4){0u, 0u, 0u, 0u}; }
    bf16_t* XB = (bf16_t*)(ws + WS_XB);
    for (int i = gt; i < NTOK * DM / 8; i += NGT) { const f32x4 a = *(const f32x4*)(p.x + (size_t)i * 8), b = *(const f32x4*)(p.x + (size_t)i * 8 + 4);
        u32x4 o; o.x = pk2(a[0], a[1]); o.y = pk2(a[2], a[3]); o.z = pk2(b[0], b[1]); o.w = pk2(b[2], b[3]); *(u32x4*)(XB + (size_t)i * 8) = o; }
    { float* WRL = (float*)(ws + WS_WRL);
      for (int n = gt; n < 32768; n += NGT) { const int e = ((n >> 8) & 7) * 4 + (n & 3), ln = (n >> 2) & 63, ji = n >> 11, j = ji >> 2, i = ji & 3; WRL[n] = p.w_router[(size_t)(4 * ln + 256 * j + i) * 32 + e]; } }
    float* ropeA = (float*)(ws + WS_ROPEA); float* ropeB = (float*)(ws + WS_ROPEB);
    for (int i = gt; i < NTOK * 24; i += NGT) { const int tok = i / 24, j = i % 24; const double f = (j < 16) ? p.invfA[j] : p.invfB[j - 16];
        const double rev = (double)p.pos[tok] * f * 0.15915494309189535; const float fr = (float)(rev - __builtin_rint(rev));
        const float cs = __builtin_amdgcn_cosf(fr), sn = __builtin_amdgcn_sinf(fr);
        if (j < 16) { ropeA[(size_t)tok * 32 + j] = cs; ropeA[(size_t)tok * 32 + 16 + j] = sn; } else { ropeB[(size_t)tok * 16 + (j - 16)] = cs; ropeB[(size_t)tok * 16 + 8 + (j - 16)] = sn; } }
}

__device__ __forceinline__ void phase_prep(const Params& p, LAS unsigned char* lds, int vcu, int G) {
    const int tid = threadIdx.x, wave = tid >> 6, lane = tid & 63;
    unsigned char* ws = p.ws;
    const bf16_t* PROJ = (const bf16_t*)(ws + WS_PROJ);
    float* rstd = (float*)(ws + WS_RSTD); const float* ropeA = (const float*)(ws + WS_ROPEA); const float* ropeB = (const float*)(ws + WS_ROPEB);
    bf16_t* KM = (bf16_t*)(ws + WS_KM); bf16_t* QB = (bf16_t*)(ws + WS_QB); bf16_t* KB = (bf16_t*)(ws + WS_KB); float* kmean = (float*)(ws + WS_KMEAN);
    const int gw = vcu * NWAVES + wave, NGW = G * NWAVES;
    for (int row = gw; row < NTOK; row += NGW) {
        float s = 0.f;
        if (lane < 48) { const u32x4 v = *(const u32x4*)(PROJ + (size_t)row * PN + lane * 8);
#pragma unroll
            for (int q = 0; q < 4; ++q) { const float a = __uint_as_float(v[q] << 16), b = __uint_as_float(v[q] & 0xffff0000u); s += a * a + b * b; } }
#pragma unroll
        for (int o = 1; o < 32; o <<= 1) s += __shfl_xor(s, o);
        if (lane == 0) rstd[2 * row] = 1.0f / sqrtf(s * (1.0f / 256.0f) + RMS_EPS);
        if (lane == 32) rstd[2 * row + 1] = 1.0f / sqrtf(s * (1.0f / 128.0f) + RMS_EPS);
    }
    const int gt = vcu * NTHREADS + tid, NGT = G * NTHREADS;
    for (int i = gt; i < NTOK * 16; i += NGT) { const int tok = i >> 4, j = i & 15;
        const float x1 = bf2f(PROJ[(size_t)tok * PN + C_KR + j]), x2 = bf2f(PROJ[(size_t)tok * PN + C_KR + 16 + j]);
        const float c = ropeA[(size_t)tok * 32 + j], s = ropeA[(size_t)tok * 32 + 16 + j];
        const bf16_t o1 = (bf16_t)f2bf(x1 * c - x2 * s), o2 = (bf16_t)f2bf(x2 * c + x1 * s);
#pragma unroll
        for (int h = 0; h < 8; ++h) { KM[(size_t)tok * 768 + h * 96 + 64 + j] = o1; KM[(size_t)tok * 768 + h * 96 + 80 + j] = o2; } }
    LAS float* red = (LAS float*)lds;
    for (int unit = vcu; unit < 512; unit += G) {
        const int ub = unit >> 3, h = unit & 7, tg = tid >> 6, d = tid & 63, c = h * 64 + d; float ksum = 0.f;
#pragma unroll 4
        for (int i = 0; i < 32; ++i) { const int tok = ub * 256 + tg * 32 + i; const bf16_t* pr = PROJ + (size_t)tok * PN;
            float qv = bf2f(pr[C_MQ + c]), kv = bf2f(pr[C_MK + c]);
            if (d < 16) { const int j = d & 7; const float cs = ropeB[(size_t)tok * 16 + j], sn = ropeB[(size_t)tok * 16 + 8 + j];
                if (d < 8) { const float q2 = bf2f(pr[C_MQ + c + 8]), k2 = bf2f(pr[C_MK + c + 8]); qv = qv * cs - q2 * sn; kv = kv * cs - k2 * sn; }
                else { const float q1 = bf2f(pr[C_MQ + c - 8]), k1 = bf2f(pr[C_MK + c - 8]); qv = qv * cs + q1 * sn; kv = kv * cs + k1 * sn; } }
            QB[(size_t)tok * 512 + c] = (bf16_t)f2bf(qv * C2B); KB[(size_t)tok * 512 + c] = (bf16_t)f2bf(kv); ksum += kv; }
        red[tg * 64 + d] = ksum;
        __syncthreads();
        if (tid < 64) { float t = 0.f;
#pragma unroll
            for (int g8 = 0; g8 < 8; ++g8) t += red[g8 * 64 + tid];
            kmean[(size_t)ub * 512 + h * 64 + tid] = t * (1.0f / 256.0f); }
        __syncthreads();
    }
}

typedef float f32x16 __attribute__((ext_vector_type(16)));
typedef short s16x4 __attribute__((ext_vector_type(4)));
namespace fa {
constexpr int KBUF = 12288, VBUF = 8192, VOFF = 3 * KBUF, WS_OFF = VOFF + 3 * VBUF, KML_OFF = WS_OFF + 8 * 256, LDS_NEED = KML_OFF + 2048;
__device__ __forceinline__ void wait_vm(int n) {
    switch (n) {
#define FA_W(k) case k: asm volatile("s_waitcnt vmcnt(" #k ")" ::: "memory"); break;
        FA_W(0) FA_W(1) FA_W(2) FA_W(3) FA_W(4) FA_W(5) FA_W(6) FA_W(7) FA_W(8) FA_W(9) FA_W(10) FA_W(11) FA_W(12) FA_W(13) FA_W(14) FA_W(15)
#undef FA_W
        default: asm volatile("s_waitcnt vmcnt(15)" ::: "memory"); break; }
}
constexpr float THR = 8.0f;
__device__ __forceinline__ int crow(int r, int hi) { return (r & 3) + 8 * (r >> 2) + 4 * hi; }
__device__ __forceinline__ unsigned cvtpk(float lo, float hi) { typedef __bf16 bf2 __attribute__((ext_vector_type(2))); f32x2 v = {lo, hi}; bf2 b = __builtin_convertvector(v, bf2); return __builtin_bit_cast(unsigned, b); }
__device__ __forceinline__ float xhalf_max(float m) { auto rr = __builtin_amdgcn_permlane32_swap(__float_as_uint(m), __float_as_uint(m), false, false); return fmaxf(__uint_as_float(rr[0]), __uint_as_float(rr[1])); }
__device__ __forceinline__ float xhalf_sum(float m) { auto rr = __builtin_amdgcn_permlane32_swap(__float_as_uint(m), __float_as_uint(m), false, false); return __uint_as_float(rr[0]) + __uint_as_float(rr[1]); }
__device__ __forceinline__ float mx3(float a, float b, float c) { return __builtin_fmaxf(__builtin_fmaxf(a, b), c); }
}
template <int DQK, int VAR>
__device__ __forceinline__ void attn_unit(LAS unsigned char* lds, const bf16_t* Q, int qpitch, const bf16_t* K, int kpitch, const bf16_t* V, int vpitch, bf16_t* O, int qb, const float* kmean, const Params& p, BgConv& bg) {
    using namespace fa;
    constexpr int ND = DQK / 16, NCH = DQK / 8;
    const int tid = threadIdx.x, lane = tid & 63, r32 = lane & 31, hi = lane >> 5, wid = __builtin_amdgcn_readfirstlane(tid >> 6);
    const int q0 = qb * 256, qrel = wid * 32 + r32;
    LAS float* wsf = (LAS float*)(lds + WS_OFF) + wid * 64;
    bf16x8 qr[ND];
#pragma unroll
    for (int d0 = 0; d0 < ND; ++d0) qr[d0] = *(const bf16x8*)(Q + (size_t)(q0 + qrel) * qpitch + d0 * 16 + hi * 8);
    unsigned sel = 0xffu;
    if (kmean) { const int n = tid >> 6, d = tid & 63; if (n < qb) ((LAS float*)(lds + KML_OFF))[tid] = kmean[(size_t)n * 1024 + d] + kmean[(size_t)n * 1024 + 512 + d]; }
    const bf16_t* ksrc = K + (size_t)lane * kpitch;
    const bf16_t* vsrc = V + (size_t)(16 * (wid & 3) + (lane >> 2)) * vpitch + (wid >> 2) * 32 + (lane & 3) * 8;
#define FA_DMA(ti, kslot, vslot) do { \
        __builtin_amdgcn_global_load_lds((const unsigned*)(ksrc + (size_t)(ti) * 64 * kpitch + wid * 8), (LAS unsigned*)(lds + (kslot) * KBUF + wid * 1024), 16, 0, 0); \
        if (NCH > 8 && wid < NCH - 8) __builtin_amdgcn_global_load_lds((const unsigned*)(ksrc + (size_t)(ti) * 64 * kpitch + (wid + 8) * 8), (LAS unsigned*)(lds + (kslot) * KBUF + (wid + 8) * 1024), 16, 0, 0); \
        __builtin_amdgcn_global_load_lds((const unsigned*)(vsrc + (size_t)(ti) * 64 * vpitch), (LAS unsigned*)(lds + VOFF + (vslot) * VBUF + wid * 1024), 16, 0, 0); } while (0)
#define FA_TILE(i) (((i) < 4) ? 4 * qb + (i) : (i) - 4)
#define FA_PV(vslot) do { const LAS unsigned char* vb_ = lds + VOFF + (vslot) * VBUF + voff; \
        _Pragma("unroll") for (int d0 = 0; d0 < 2; ++d0) _Pragma("unroll") for (int s_ = 0; s_ < 4; ++s_) { \
            const s16x4 lo_ = __builtin_bit_cast(s16x4, __builtin_amdgcn_ds_read_tr16_b64_v4i16((LAS s16x4*)(vb_ + d0 * 4096 + s_ * 1024))); \
            const s16x4 hh_ = __builtin_bit_cast(s16x4, __builtin_amdgcn_ds_read_tr16_b64_v4i16((LAS s16x4*)(vb_ + d0 * 4096 + s_ * 1024 + 512))); \
            const bf16x8 vf_ = (bf16x8){lo_[0], lo_[1], lo_[2], lo_[3], hh_[0], hh_[1], hh_[2], hh_[3]}; \
            o[d0] = __builtin_amdgcn_mfma_f32_32x32x16_bf16(__builtin_bit_cast(bf16x8, pw[s_]), vf_, o[d0], 0, 0, 0); } } while (0)
    const int NT = 4 * qb + 4;
    float mhat = 0.f, l_reg = 0.f; f32x16 o[2]; o[0] = f32x16{}; o[1] = f32x16{}; f32x16 negm = f32x16{};
    const int koff = hi * 1024 + r32 * 16;
    const int voff = ((lane >> 4) & 1) * 32 + (lane & 3) * 8 + (4 * hi + ((lane & 15) >> 2)) * 64;
    u32x4 pw[4];
    const int nkv = (NCH > 8 && wid < NCH - 8) ? 3 : 2;
    FA_DMA(FA_TILE(0), 0, 0);
    if (NT > 1) { FA_DMA(FA_TILE(1), 1, 1); }
    wait_vm(NT > 1 ? nkv : 0); asm volatile("s_waitcnt lgkmcnt(0)" ::: "memory"); __builtin_amdgcn_s_barrier(); asm volatile("" ::: "memory");
    if (kmean) {
        float gt[8];
#pragma unroll
        for (int n = 0; n < 8; ++n) { float s = 0.f; const LAS float* km = (const LAS float*)(lds + KML_OFF) + n * 64;
            if (n < qb) {
#pragma unroll
                for (int d0 = 0; d0 < ND; ++d0) { const f32x4 k0 = *(const LAS f32x4*)(km + d0 * 16 + hi * 8), k1 = *(const LAS f32x4*)(km + d0 * 16 + hi * 8 + 4);
#pragma unroll
                    for (int j = 0; j < 4; ++j) { s = fmaf(bf2f((unsigned short)qr[d0][j]), k0[j], s); s = fmaf(bf2f((unsigned short)qr[d0][4 + j]), k1[j], s); } }
                s = xhalf_sum(s); }
            gt[n] = (n < qb) ? s : -INFINITY; }
        sel = 0u;
#pragma unroll
        for (int n = 0; n < 8; ++n) { int cnt = 0;
#pragma unroll
            for (int n2 = 0; n2 < 8; ++n2) if (n2 != n) cnt += (n2 < qb && (gt[n2] > gt[n] || (gt[n2] == gt[n] && n2 < n))) ? 1 : 0;
            if (n < qb && cnt < 3) sel |= 1u << n; }
    }
    int sl = 0, prevB = 0, opsPrev = 0;
    for (int i = 0; i < NT; ++i) {
        const int sl1 = (sl == 2) ? 0 : sl + 1, sl2 = (sl1 == 2) ? 0 : sl1 + 1;
        LAS unsigned char* bscr = lds + LDS_NEED + wid * 8192 + (bg.itc & 1) * 4096;
        int young = prevB, ops = 0;
        if (bg.itc & 1) { if (bg.pend1 >= 0) { wait_vm(opsPrev); expert_finish(p, bg.pend1, bscr, lane); bg.pend1 = -1; ops += 4; asm volatile("s_waitcnt lgkmcnt(0)" ::: "memory"); } }
        else            { if (bg.pend0 >= 0) { wait_vm(opsPrev); expert_finish(p, bg.pend0, bscr, lane); bg.pend0 = -1; ops += 4; asm volatile("s_waitcnt lgkmcnt(0)" ::: "memory"); } }
        if constexpr (VAR != 4) { if (i + 2 < NT) { const int tn = FA_TILE(i + 2); FA_DMA(tn, sl2, sl2); ops += nkv; } }
        const bool bgdo = (bg.itc % 3 != 2) && bg.next < NEXP_ITEMS;
        if (bgdo) { expert_issue(p, bg.next, bscr, lane); if (bg.itc & 1) bg.pend1 = bg.next; else bg.pend0 = bg.next; bg.next += bg.stride; ops += 4; }
        young += ops; prevB = bgdo ? 4 : 0;
        ++bg.itc;
        const bool band = i < 4;
        if (!(band && 2 * i > wid)) {
            const LAS unsigned char* kb = lds + sl * KBUF + koff;
            f32x16 p0 = negm, p1 = negm;
            if (kmean && !band) { if (!__all((sel >> ((i - 4) >> 2)) & 1u)) {
                    const bool ok = ((sel >> ((i - 4) >> 2)) & 1u) != 0u;
#pragma unroll
                    for (int r = 0; r < 16; ++r) p0[r] = ok ? negm[r] : -INFINITY;
                    p1 = p0; } }
#pragma unroll
            for (int d0 = 0; d0 < (VAR == 5 ? 1 : ND); ++d0) { const bf16x8 a0 = *(const LAS bf16x8*)(kb + d0 * 2048), a1 = *(const LAS bf16x8*)(kb + d0 * 2048 + 512);
                p0 = __builtin_amdgcn_mfma_f32_32x32x16_bf16(a0, qr[d0], p0, 0, 0, 0); p1 = __builtin_amdgcn_mfma_f32_32x32x16_bf16(a1, qr[d0], p1, 0, 0, 0); }
            if (band) { if (64 * i + 63 > 32 * wid) {
#pragma unroll
                    for (int r = 0; r < 16; ++r) { const int kv = 64 * i + crow(r, hi); if (kv > qrel) p0[r] = -INFINITY; if (kv + 32 > qrel) p1[r] = -INFINITY; } } }
            if constexpr (VAR != 1 && VAR != 3) {
            float ra = mx3(p0[0], p0[1], p1[0]), rb = mx3(p0[2], p0[3], p1[1]); ra = mx3(ra, p1[2], p1[3]);
#pragma unroll
            for (int r = 4; r < 16; r += 4) { ra = mx3(ra, p0[r], p0[r + 1]); rb = mx3(rb, p0[r + 2], p0[r + 3]); ra = mx3(ra, p1[r], p1[r + 1]); rb = mx3(rb, p1[r + 2], p1[r + 3]); }
            const float rm = xhalf_max(__builtin_fmaxf(ra, rb));
            if (i == 0 || __any(rm > THR)) {
                const float dl = (i == 0) ? rm : fmaxf(rm, 0.f); mhat += dl;
#pragma unroll
                for (int r = 0; r < 16; ++r) { p0[r] -= dl; p1[r] -= dl; negm[r] = -mhat; }
                if (i != 0) { const float f = __builtin_amdgcn_exp2f(-dl); l_reg *= f; if (hi == 0) wsf[r32] = f;
                    asm volatile("s_waitcnt lgkmcnt(0)" ::: "memory");
#pragma unroll
                    for (int r = 0; r < 16; ++r) { const float fr_ = wsf[crow(r, hi)]; o[0][r] *= fr_; o[1][r] *= fr_; } }
            }
            f32x2 sacc = {0.f, 0.f};
#pragma unroll
            for (int r = 0; r < 16; ++r) { p0[r] = __builtin_amdgcn_exp2f(p0[r]); p1[r] = __builtin_amdgcn_exp2f(p1[r]); }
#pragma unroll
            for (int r = 0; r < 16; r += 2) { sacc += (f32x2){p0[r], p0[r + 1]}; sacc += (f32x2){p1[r], p1[r + 1]}; }
            l_reg += sacc[0] + sacc[1];
            }
#pragma unroll
            for (int s = 0; s < 2; ++s)
#pragma unroll
                for (int j = 0; j < 4; ++j) { pw[s][j] = cvtpk(p0[8 * s + 2 * j], p0[8 * s + 2 * j + 1]); pw[2 + s][j] = cvtpk(p1[8 * s + 2 * j], p1[8 * s + 2 * j + 1]); }
            if constexpr (VAR != 2 && VAR != 3) { FA_PV(sl); } else { o[0][0] += __uint_as_float(pw[0][0] ^ pw[1][1] ^ pw[2][2] ^ pw[3][3]); }
        }
        asm volatile("s_waitcnt lgkmcnt(0)" ::: "memory"); wait_vm(young);
        __builtin_amdgcn_s_barrier(); asm volatile("" ::: "memory");
        sl = sl1; opsPrev = ops;
    }
    l_reg = xhalf_sum(l_reg);
    if (hi == 0) wsf[32 + r32] = l_reg;
    asm volatile("s_waitcnt lgkmcnt(0)" ::: "memory");
#pragma unroll
    for (int r = 0; r < 16; ++r) { const float rl = 1.0f / wsf[32 + crow(r, hi)]; bf16_t* op = O + (size_t)(q0 + wid * 32 + crow(r, hi)) * 1024 + r32;
        op[0] = (bf16_t)f2bf(o[0][r] * rl); op[32] = (bf16_t)f2bf(o[1][r] * rl); }
    asm volatile("s_waitcnt lgkmcnt(0)" ::: "memory"); __builtin_amdgcn_s_barrier(); asm volatile("" ::: "memory");
#undef FA_DMA
#undef FA_TILE
#undef FA_PV
}
template <int VAR>
__device__ __forceinline__ void phase_attn_fast(const Params& p, LAS unsigned char* lds, int vcu, int G, bool do_conv) {
    unsigned char* ws = p.ws;
    const bf16_t* QM = (const bf16_t*)(ws + WS_QM); const bf16_t* KM = (const bf16_t*)(ws + WS_KM); const bf16_t* VM = (const bf16_t*)(ws + WS_VM);
    const bf16_t* QB = (const bf16_t*)(ws + WS_QB); const bf16_t* KB = (const bf16_t*)(ws + WS_KB); const bf16_t* VB = (const bf16_t*)(ws + WS_VB);
    const float* kmean = (const float*)(ws + WS_KMEANP); bf16_t* ATT = (bf16_t*)(ws + WS_ATT);
    const int wave_ = __builtin_amdgcn_readfirstlane(threadIdx.x >> 6);
    BgConv bg; bg.next = do_conv ? vcu * NWAVES + wave_ : NEXP_ITEMS; bg.stride = G * NWAVES; bg.pend0 = -1; bg.pend1 = -1; bg.itc = 0;
    for (int su = vcu; su < 256; su += G) {
        const int bh = su >> 2, j = su & 3, b = bh >> 3, h = bh & 7; const size_t r0 = (size_t)b * SEQ;
#pragma unroll 1
        for (int k = 0; k < 2; ++k) { const int qb = k ? 7 - j : j;
            attn_unit<96, VAR>(lds, QM + r0 * 768 + h * 96, 768, KM + r0 * 768 + h * 96, 768, VM + r0 * 512 + h * 64, 512, ATT + r0 * 1024 + h * 64, qb, nullptr, p, bg);
            attn_unit<64, VAR>(lds, QB + r0 * 512 + h * 64, 512, KB + r0 * 512 + h * 64, 512, VB + r0 * 512 + h * 64, 512, ATT + r0 * 1024 + 512 + h * 64, qb, kmean + (size_t)(b * 8) * 1024 + h * 64, p, bg); }
    }
    { const int lane = threadIdx.x & 63; LAS unsigned char* bscr = lds + fa::LDS_NEED + wave_ * 8192;
      asm volatile("s_waitcnt vmcnt(0)" ::: "memory");
      if (bg.pend0 >= 0) { expert_finish(p, bg.pend0, bscr, lane); bg.pend0 = -1; }
      if (bg.pend1 >= 0) { expert_finish(p, bg.pend1, bscr + 4096, lane); bg.pend1 = -1; }
      asm volatile("s_waitcnt lgkmcnt(0)" ::: "memory");
#pragma unroll 1
      for (; bg.next < NEXP_ITEMS; bg.next += bg.stride) { expert_issue(p, bg.next, bscr, lane); asm volatile("s_waitcnt vmcnt(0)" ::: "memory"); expert_finish(p, bg.next, bscr, lane); asm volatile("s_waitcnt lgkmcnt(0)" ::: "memory"); } }
}

__device__ __forceinline__ float rs32(float (&a)[32], int lane) {
#pragma unroll
    for (int e = 0; e < 16; ++e) { auto rr = __builtin_amdgcn_permlane32_swap(__float_as_uint(a[e]), __float_as_uint(a[e + 16]), false, false); a[e] = __uint_as_float(rr[0]) + __uint_as_float(rr[1]); }
#pragma unroll
    for (int e = 0; e < 8; ++e) { auto rr = __builtin_amdgcn_permlane16_swap(__float_as_uint(a[e]), __float_as_uint(a[e + 8]), false, false); a[e] = __uint_as_float(rr[0]) + __uint_as_float(rr[1]); }
    { const bool bit = (lane & 8) != 0;
#pragma unroll
      for (int e = 0; e < 4; ++e) { const float keep = bit ? a[e + 4] : a[e], send = bit ? a[e] : a[e + 4]; a[e] = keep + __shfl_xor(send, 8); } }
    { const bool bit = (lane & 4) != 0;
#pragma unroll
      for (int e = 0; e < 2; ++e) { const float keep = bit ? a[e + 2] : a[e], send = bit ? a[e] : a[e + 2]; a[e] = keep + __shfl_xor(send, 4); } }
    { const bool bit = (lane & 2) != 0; const float keep = bit ? a[1] : a[0], send = bit ? a[0] : a[1]; a[0] = keep + __shfl_xor(send, 2); }
    return a[0] + __shfl_xor(a[0], 1);
}
__device__ __forceinline__ void route_row(const Params& p, float logit, int tok, int tl, int lane, int* tidx, float* tgate, LAS int* lidx, LAS float* sc) {
    const int me = lane >> 1;
    const float my = logit + p.b_router[me];
    if (!(lane & 1)) sc[me] = my;
    asm volatile("s_waitcnt lgkmcnt(0)" ::: "memory");
    int rank = 0;
#pragma unroll
    for (int e4 = 0; e4 < 8; ++e4) { const f32x4 v = *(const LAS f32x4*)(sc + 4 * e4);
#pragma unroll
        for (int k = 0; k < 4; ++k) rank += (v[k] > my || (v[k] == my && (4 * e4 + k) < me)) ? 1 : 0; }
    int ti[4];
#pragma unroll
    for (int k = 0; k < 4; ++k) { const unsigned long long bal = __ballot(rank == k && !(lane & 1)); ti[k] = (__ffsll((long long)bal) - 1) >> 1; }
    if (lane == 0) { const float t0 = sc[ti[0]], e1 = expf(sc[ti[1]] - t0), e2 = expf(sc[ti[2]] - t0), e3 = expf(sc[ti[3]] - t0); const float is = 1.0f / (1.0f + e1 + e2 + e3);
        *(f32x4*)(tgate + (size_t)tok * 4) = (f32x4){is, e1 * is, e2 * is, e3 * is};
        int* tp = tidx + (size_t)tok * 4; tp[0] = ti[0]; tp[1] = ti[1]; tp[2] = ti[2]; tp[3] = ti[3];
        lidx[tl * 4 + 0] = ti[0]; lidx[tl * 4 + 1] = ti[1]; lidx[tl * 4 + 2] = ti[2]; lidx[tl * 4 + 3] = ti[3]; }
}
__device__ __forceinline__ void phase_ln1_route(const Params& p, LAS unsigned char* lds, int vcu, int G) {
    const int tid = threadIdx.x, wave = tid >> 6, lane = tid & 63;
    unsigned char* ws = p.ws;
    float* X1 = p.out; const float* X1P = (const float*)(ws + WS_X1PRE); bf16_t* X1B = (bf16_t*)(ws + WS_X1B);
    int* tidx = (int*)(ws + WS_TIDX); float* tgate = (float*)(ws + WS_TGATE); unsigned* hist = (unsigned*)(ws + WS_HIST);
    LAS int* lidx = (LAS int*)(lds + ROWTAB_OFF);
    { const float* WRL = (const float*)(ws + WS_WRL);
      for (int i = tid; i < 8192; i += NTHREADS) *(LAS f32x4*)(lds + (size_t)i * 16) = *(const f32x4*)(WRL + (size_t)i * 4); }
    __syncthreads();
    const LAS float* Wl = (const LAS float*)lds + lane * 4;
    for (int chunk = vcu; chunk < NCHUNK; chunk += G) {
#pragma unroll 1
        for (int rp = 0; rp < 4; ++rp) {
            const int tl = wave * 8 + 2 * rp, tok = chunk * 64 + tl;
            f32x4 v0[4], v1[4]; float s0 = 0.f, s1 = 0.f;
#pragma unroll
            for (int j = 0; j < 4; ++j) { v0[j] = *(const f32x4*)(X1P + (size_t)tok * DM + 4 * lane + 256 * j); v1[j] = *(const f32x4*)(X1P + (size_t)(tok + 1) * DM + 4 * lane + 256 * j);
                s0 += (v0[j][0] + v0[j][1]) + (v0[j][2] + v0[j][3]); s1 += (v1[j][0] + v1[j][1]) + (v1[j][2] + v1[j][3]); }
            const float mean0 = wave_sum(s0) * (1.0f / DM), mean1 = wave_sum(s1) * (1.0f / DM); float q0 = 0.f, q1 = 0.f;
#pragma unroll
            for (int j = 0; j < 4; ++j) { v0[j] = v0[j] - mean0; v1[j] = v1[j] - mean1;
                q0 += (v0[j][0] * v0[j][0] + v0[j][1] * v0[j][1]) + (v0[j][2] * v0[j][2] + v0[j][3] * v0[j][3]); q1 += (v1[j][0] * v1[j][0] + v1[j][1] * v1[j][1]) + (v1[j][2] * v1[j][2] + v1[j][3] * v1[j][3]); }
            const float rs0 = 1.0f / sqrtf(wave_sum(q0) * (1.0f / DM) + LN_EPS), rs1 = 1.0f / sqrtf(wave_sum(q1) * (1.0f / DM) + LN_EPS);
#pragma unroll
            for (int j = 0; j < 4; ++j) { const f32x4 g = *(const f32x4*)(p.ln1_g + 4 * lane + 256 * j), bb = *(const f32x4*)(p.ln1_b + 4 * lane + 256 * j);
                v0[j] = v0[j] * rs0 * g + bb; v1[j] = v1[j] * rs1 * g + bb;
                *(f32x4*)(X1 + (size_t)tok * DM + 4 * lane + 256 * j) = v0[j]; *(f32x4*)(X1 + (size_t)(tok + 1) * DM + 4 * lane + 256 * j) = v1[j];
                u32x2 w; w.x = pk2(v0[j][0], v0[j][1]); w.y = pk2(v0[j][2], v0[j][3]); *(u32x2*)(X1B + (size_t)tok * DM + 4 * lane + 256 * j) = w;
                w.x = pk2(v1[j][0], v1[j][1]); w.y = pk2(v1[j][2], v1[j][3]); *(u32x2*)(X1B + (size_t)(tok + 1) * DM + 4 * lane + 256 * j) = w; }
            float a0[32], a1[32];
#pragma unroll
            for (int e = 0; e < 32; ++e) { a0[e] = 0.f; a1[e] = 0.f; }
            const LAS float* wlo = Wl; const LAS float* whi = Wl + 8 * 2048;
            asm volatile("" : "+v"(wlo), "+v"(whi));
#pragma unroll
            for (int j = 0; j < 4; ++j)
#pragma unroll
                for (int i = 0; i < 4; ++i) { const float x0 = v0[j][i], x1 = v1[j][i]; const LAS float* wb = (j < 2) ? wlo + (j * 4 + i) * 2048 : whi + ((j - 2) * 4 + i) * 2048;
#pragma unroll
                    for (int e4 = 0; e4 < 8; ++e4) { const f32x4 w = *(const LAS f32x4*)(wb + e4 * 256);
#pragma unroll
                        for (int k = 0; k < 4; ++k) { a0[4 * e4 + k] = fmaf(x0, w[k], a0[4 * e4 + k]); a1[4 * e4 + k] = fmaf(x1, w[k], a1[4 * e4 + k]); } }
                    asm volatile("" ::: "memory"); }
            const float l0 = rs32(a0, lane), l1 = rs32(a1, lane);
            LAS float* sc = (LAS float*)(lds + ROWTAB_OFF + 2048) + wave * 64;
            route_row(p, l0, tok, tl, lane, tidx, tgate, lidx, sc);
            route_row(p, l1, tok + 1, tl + 1, lane, tidx, tgate, lidx, sc + 32);
        }
        __syncthreads();
        if (tid < 32) { unsigned c = 0; for (int a = 0; a < 256; ++a) c += (lidx[a] == tid) ? 1u : 0u; hist[chunk * 32 + tid] = c; }
        __syncthreads();
    }
}

__device__ __forceinline__ void phase_assign(const Params& p, LAS unsigned char* lds, int vcu, int G) {
    const int tid = threadIdx.x;
    unsigned char* ws = p.ws;
    const int* tidx = (const int*)(ws + WS_TIDX); const float* tgate = (const float*)(ws + WS_TGATE); const unsigned* hist = (const unsigned*)(ws + WS_HIST);
    int* dest = (int*)(ws + WS_DEST); int* row_tok = (int*)(ws + WS_ROWTOK); float* row_gate = (float*)(ws + WS_ROWGATE); int* tile_e = (int*)(ws + WS_TILEE);
    LAS int* lidx = (LAS int*)lds;
    LAS int* lcnt = (LAS int*)(lds + 1024);
    LAS int* lpre = (LAS int*)(lds + 1024 + 128);
    LAS int* lstart = (LAS int*)(lds + 1024 + 256);
    LAS int* ptot = (LAS int*)(lds + 2048);
    LAS int* ppre = (LAS int*)(lds + 4096);
    for (int chunk = vcu; chunk < NCHUNK; chunk += G) {
        if (tid < 256) lidx[tid] = tidx[chunk * 256 + tid];
        { const int e = tid & 31, cg = tid >> 5; int tot = 0, pre = 0;
#pragma unroll
          for (int k = 0; k < 16; ++k) { const int c = cg * 16 + k; const int hv = (int)hist[c * 32 + e]; tot += hv; pre += (c < chunk) ? hv : 0; }
          ptot[cg * 32 + e] = tot; ppre[cg * 32 + e] = pre; }
        __syncthreads();
        if (tid < 32) { int tot = 0, pre = 0;
#pragma unroll
            for (int cg = 0; cg < 16; ++cg) { tot += ptot[cg * 32 + tid]; pre += ppre[cg * 32 + tid]; }
            lcnt[tid] = tot; lpre[tid] = pre; }
        __syncthreads();
        if (tid == 0) { int s2 = 0; for (int e = 0; e < 32; ++e) { lstart[e] = s2; s2 += (lcnt[e] + 255) / 256 * 256; } lstart[32] = s2; }
        __syncthreads();
        if (tid < 256) { const int e = lidx[tid]; int rank = 0; for (int a = 0; a < tid; ++a) rank += (lidx[a] == e) ? 1 : 0;
            const int P = lstart[e] + lpre[e] + rank, tok = chunk * 64 + (tid >> 2);
            row_tok[P] = tok; row_gate[P] = tgate[chunk * 256 + tid]; dest[chunk * 256 + tid] = P; }
        if (chunk < 32) { const int e = chunk; for (int P = lstart[e] + lcnt[e] + tid; P < lstart[e + 1]; P += NTHREADS) { row_tok[P] = 0; row_gate[P] = 0.f; } }
        if (chunk == 0) { if (tid < 32) { for (int t = lstart[tid] / 256; t < lstart[tid + 1] / 256; ++t) tile_e[t] = tid; } if (tid == 32) tile_e[MAXTILES] = lstart[32] / 256; }
        __syncthreads();
    }
}

__device__ __forceinline__ void phase_final(const Params& p, int vcu, int G, float* outp) {
    const int tid = threadIdx.x, wave = tid >> 6, lane = tid & 63;
    unsigned char* ws = p.ws;
    const int* dest = (const int*)(ws + WS_DEST); const bf16_t* Y = (const bf16_t*)(ws + WS_Y); float* X1 = p.out;
    const int gw = vcu * NWAVES + wave, NGW = G * NWAVES;
    for (int t0 = gw * 8; t0 < NTOK; t0 += NGW * 8) {
        const int dl = (lane < 32) ? dest[t0 * 4 + lane] : 0;
#pragma unroll
        for (int pr = 0; pr < 4; ++pr) {
            const int tok = t0 + 2 * pr;
            int P[2][4];
#pragma unroll
            for (int t = 0; t < 2; ++t)
#pragma unroll
                for (int k = 0; k < 4; ++k) P[t][k] = __builtin_amdgcn_readlane(dl, (2 * pr + t) * 4 + k);
            f32x4 v[2][4]; u32x2 y[2][4][4];
#pragma unroll
            for (int t = 0; t < 2; ++t)
#pragma unroll
                for (int j = 0; j < 4; ++j) { v[t][j] = *(const f32x4*)(X1 + (size_t)(tok + t) * DM + 4 * lane + 256 * j);
#pragma unroll
                    for (int k = 0; k < 4; ++k) y[t][k][j] = *(const u32x2*)(Y + (size_t)P[t][k] * 1024 + 4 * lane + 256 * j); }
            float s[2], q[2];
#pragma unroll
            for (int t = 0; t < 2; ++t) { s[t] = 0.f;
#pragma unroll
                for (int j = 0; j < 4; ++j) { v[t][j] = v[t][j] * DN_ALPHA;
#pragma unroll
                    for (int k = 0; k < 4; ++k) { const u32x2 w = y[t][k][j];
                        v[t][j][0] += __uint_as_float(w.x << 16); v[t][j][1] += __uint_as_float(w.x & 0xffff0000u); v[t][j][2] += __uint_as_float(w.y << 16); v[t][j][3] += __uint_as_float(w.y & 0xffff0000u); }
                    s[t] += (v[t][j][0] + v[t][j][1]) + (v[t][j][2] + v[t][j][3]); } }
            const float mean0 = wave_sum(s[0]) * (1.0f / DM), mean1 = wave_sum(s[1]) * (1.0f / DM);
            q[0] = 0.f; q[1] = 0.f;
#pragma unroll
            for (int j = 0; j < 4; ++j) { v[0][j] = v[0][j] - mean0; v[1][j] = v[1][j] - mean1;
                q[0] += (v[0][j][0] * v[0][j][0] + v[0][j][1] * v[0][j][1]) + (v[0][j][2] * v[0][j][2] + v[0][j][3] * v[0][j][3]);
                q[1] += (v[1][j][0] * v[1][j][0] + v[1][j][1] * v[1][j][1]) + (v[1][j][2] * v[1][j][2] + v[1][j][3] * v[1][j][3]); }
            const float rs0 = 1.0f / sqrtf(wave_sum(q[0]) * (1.0f / DM) + LN_EPS), rs1 = 1.0f / sqrtf(wave_sum(q[1]) * (1.0f / DM) + LN_EPS);
#pragma unroll
            for (int j = 0; j < 4; ++j) { const f32x4 g = *(const f32x4*)(p.ln2_g + 4 * lane + 256 * j), bb = *(const f32x4*)(p.ln2_b + 4 * lane + 256 * j);
                *(f32x4*)(outp + (size_t)tok * DM + 4 * lane + 256 * j) = v[0][j] * rs0 * g + bb;
                *(f32x4*)(outp + (size_t)(tok + 1) * DM + 4 * lane + 256 * j) = v[1][j] * rs1 * g + bb; }
        }
    }
}

constexpr int NPHASE = 11;
__global__ void __launch_bounds__(NTHREADS, 2) fwd_kernel(Params p) {
    extern __shared__ __attribute__((aligned(16))) unsigned char lds_raw[];
    LAS unsigned char* lds = (LAS unsigned char*)lds_raw;
    const int tid = threadIdx.x;
    const int G = gridDim.x, bx = blockIdx.x;
    const int vcu = (G % 8 == 0) ? (bx % 8) * (G / 8) + bx / 8 : bx;
    unsigned char* ws = p.ws;
    volatile LAS unsigned* MISC = (volatile LAS unsigned*)(lds + MISC_OFF);
    if (tid < 32) MISC[tid] = 0u;
    __syncthreads();
    XcdBarrier bar; bar.bar = (unsigned*)(ws + WS_CTL) + CW_BAR; bar.x = 0; bar.st = nullptr;
    const bool one = (p.ph_hi - p.ph_lo) > 1;
    if (one) bar = xcd_barrier_post((unsigned*)(ws + WS_CTL) + CW_BAR, MISC + 8);
    const int lo = p.ph_lo, hi = p.ph_hi;
#ifdef ONLY_PHASE
#define IN(k) ((k) == ONLY_PHASE && lo <= (k) && (k) < hi)
#else
#define IN(k) (lo <= (k) && (k) < hi)
#endif
#ifndef NAIVE_GEMM_MASK
#define NAIVE_GEMM_MASK 0
#endif
#define GEMM_CALL(EPI, SCHED) do { if constexpr (NAIVE_GEMM_MASK != 0) gemm_phase_naive<EPI, SCHED>(lds, g, S, E); else gemm_phase<EPI, SCHED, true>(lds, g, S, E); } while (0)
#ifndef ATTN_VAR
#define ATTN_VAR 0
#endif
#ifndef REPEAT_PHASE
#define REPEAT_PHASE (-1)
#endif
#define SEAM(k) do { if (IN(k) && IN((k) == 1 ? 3 : (k) + 1)) xcd_barrier(bar); } while (0)

#define PHASE(k, ...) do { if (IN(k)) { if constexpr (REPEAT_PHASE == (k)) { __VA_ARGS__; xcd_barrier(bar); } __VA_ARGS__; } SEAM(k); } while (0)
    PHASE(0, phase_prologue(p, lds, vcu, G));
    PHASE(1, { GemmArgs g{(const bf16_t*)(ws + WS_XB), 1024, (const bf16_t*)(ws + WS_WIN), 1024, 1024}; DenseSched S; S.init(lds, NTOK, PN, G, vcu);
        EpiProj E{ws}; GEMM_CALL(EpiProj, DenseSched); });
    PHASE(3, { { GemmArgs g{(const bf16_t*)(ws + WS_LAT), KUP, (const bf16_t*)(ws + WS_WUP), KUP, 256}; DenseSched S; S.init(lds, NTOK, 768, G, vcu);
          EpiUp E{(bf16_t*)(ws + WS_QM), (bf16_t*)(ws + WS_KM), (bf16_t*)(ws + WS_VM), (const float*)(ws + WS_RSTDP), (const float*)(ws + WS_ROPEA), 0}; GEMM_CALL(EpiUp, DenseSched); }
        { GemmArgs g{(const bf16_t*)(ws + WS_LAT) + 256, KUP, (const bf16_t*)(ws + WS_WUP) + (size_t)768 * KUP + 256, KUP, 128}; DenseSched S; S.init(lds, NTOK, 1024, G, (vcu + 192) % G);
          EpiUp E{(bf16_t*)(ws + WS_QM), (bf16_t*)(ws + WS_KM), (bf16_t*)(ws + WS_VM), (const float*)(ws + WS_RSTDP), (const float*)(ws + WS_ROPEA), 24}; GEMM_CALL(EpiUp, DenseSched); } });
    if constexpr (REPEAT_PHASE == 44) { if (IN(4)) { phase_attn_fast<ATTN_VAR>(p, lds, vcu, G, false); xcd_barrier(bar); } }
    PHASE(4, phase_attn_fast<0>(p, lds, vcu, G, true));
    PHASE(5, { GemmArgs g{(const bf16_t*)(ws + WS_ATT), 1024, (const bf16_t*)(ws + WS_WO), 1024, 1024}; DenseSched S; S.init(lds, NTOK, DM, G, vcu);
        EpiWo E{p.x, (float*)(ws + WS_X1PRE)}; GEMM_CALL(EpiWo, DenseSched); });
    PHASE(6, phase_ln1_route(p, lds, vcu, G));
    PHASE(7, phase_assign(p, lds, vcu, G));
    PHASE(8, { GemmArgs g{(const bf16_t*)(ws + WS_X1B), 1024, (const bf16_t*)(ws + WS_WGU), 1024, 1024}; GroupSched<true> S; S.init(lds, (const int*)(ws + WS_TILEE), (const int*)(ws + WS_ROWTOK), 8, 2048, G, vcu);
        EpiGateUp E{(bf16_t*)(ws + WS_H), p.b_gate, p.b_up}; GEMM_CALL(EpiGateUp, GroupSched<true>); });
    PHASE(9, { GemmArgs g{(const bf16_t*)(ws + WS_H), 1024, (const bf16_t*)(ws + WS_WD), 1024, 1024}; GroupSched<false> S; S.init(lds, (const int*)(ws + WS_TILEE), (const int*)(ws + WS_ROWTOK), 4, 1024, G, vcu);
        EpiDown E{(bf16_t*)(ws + WS_Y), p.b_down, (const float*)(ws + WS_ROWGATE)}; GEMM_CALL(EpiDown, GroupSched<false>); });
    if (IN(10)) { if constexpr (REPEAT_PHASE == 10) { phase_final(p, vcu, G, (float*)(ws + WS_X1PRE)); xcd_barrier(bar); } phase_final(p, vcu, G, p.out); }
#undef IN
#undef SEAM
}

extern "C" void kernel_launch(void* const* d_in, const int* in_sizes, int n_in, void* d_out, int out_size, void* d_ws, size_t ws_size, hipStream_t stream) {
    static int grid = 0;
    if (grid == 0) {
        if (n_in != 20 || out_size != NTOK * DM || ws_size < WS_END) { fprintf(stderr, "kernel_launch: unexpected shapes (n_in %d out %d ws %zu)\n", n_in, out_size, ws_size); grid = -1; return; }
        int dev = 0, cus = 0, per_cu = 0;
        if (hipGetDevice(&dev) != hipSuccess || hipDeviceGetAttribute(&cus, hipDeviceAttributeMultiprocessorCount, dev) != hipSuccess) { grid = -1; return; }
        if (hipFuncSetAttribute((const void*)fwd_kernel, hipFuncAttributeMaxDynamicSharedMemorySize, LDS_BYTES) != hipSuccess) { fprintf(stderr, "kernel_launch: hipFuncSetAttribute failed\n"); grid = -1; return; }
        if (hipOccupancyMaxActiveBlocksPerMultiprocessor(&per_cu, (const void*)fwd_kernel, NTHREADS, LDS_BYTES) != hipSuccess || per_cu < 1) fprintf(stderr, "kernel_launch: occupancy query says %d\n", per_cu);
        (void)hipGetLastError();
        grid = cus;
    }
    if (grid < 0) return;
    (void)hipMemsetAsync((char*)d_ws + WS_CTL, 0, CTL_ZERO_BYTES, stream);
    Params p{};
    p.x = (const float*)d_in[0]; p.pos = (const int*)d_in[1]; p.w_in = (const float*)d_in[2]; p.q_a_norm = (const float*)d_in[3]; p.w_q_b = (const float*)d_in[4];
    p.kv_a_norm = (const float*)d_in[5]; p.w_kv_b = (const float*)d_in[6]; p.w_o = (const float*)d_in[7]; p.ln1_g = (const float*)d_in[8]; p.ln1_b = (const float*)d_in[9];
    p.w_router = (const float*)d_in[10]; p.b_router = (const float*)d_in[11]; p.w_gate = (const float*)d_in[12]; p.b_gate = (const float*)d_in[13];
    p.w_up = (const float*)d_in[14]; p.b_up = (const float*)d_in[15]; p.w_down = (const float*)d_in[16]; p.b_down = (const float*)d_in[17];
    p.ln2_g = (const float*)d_in[18]; p.ln2_b = (const float*)d_in[19];
    p.out = (float*)d_out; p.ws = (unsigned char*)d_ws;
    for (int i = 0; i < 16; ++i) p.invfA[i] = pow(500000.0, -(double)(2 * i) / 32.0);
    for (int i = 0; i < 8; ++i) p.invfB[i] = pow(500000.0, -(double)(2 * i) / 16.0);
#if MK_ONE_LAUNCH
    p.ph_lo = 0; p.ph_hi = NPHASE;
    hipLaunchKernelGGL(fwd_kernel, dim3(grid), dim3(NTHREADS), LDS_BYTES, stream, p);
#else
    for (int ph = 0; ph < NPHASE; ++ph) { p.ph_lo = ph; p.ph_hi = ph + 1; hipLaunchKernelGGL(fwd_kernel, dim3(grid), dim3(NTHREADS), LDS_BYTES, stream, p); }
#endif
}
```

```cpp
#include <hip/hip_runtime.h>
#include <cstdio>
#include <cstdint>
#include <cmath>

#ifndef MK_ONE_LAUNCH
#define MK_ONE_LAUNCH 1
#endif

#define GAS __attribute__((address_space(1)))
#define LAS __attribute__((address_space(3)))
typedef unsigned short bf16_t;
typedef short bf16x8 __attribute__((ext_vector_type(8)));
typedef float f32x4 __attribute__((ext_vector_type(4)));
typedef float f32x2 __attribute__((ext_vector_type(2)));
typedef unsigned u32x4 __attribute__((ext_vector_type(4)));
typedef unsigned u32x2 __attribute__((ext_vector_type(2)));

constexpr int NTOK = 16384, DM = 1024, SEQ = 2048, NBATCH = 8;
constexpr int PN = 2048;
constexpr int C_QL = 0, C_KVL = 256, C_KR = 384, C_MQ = 416, C_MK = 928, C_MV = 1440, IN_COLS = 1952;
constexpr int NUP = 1792, KUP = 384;
constexpr int NE = 32, TOPK = 4;
constexpr int MAXROWS = 65536 + NE * 256, MAXTILES = MAXROWS / 256;
constexpr int NCHUNK = NTOK / 64;
constexpr float LN_EPS = 1e-5f, RMS_EPS = 1e-6f;
constexpr float DN_ALPHA = 1.189207115002721f;
constexpr float LOG2E = 1.4426950408889634f;
constexpr float C2A = 0.10206207261596575f * LOG2E;
constexpr float C2B = 0.125f * LOG2E;
constexpr int NWAVES = 8, NTHREADS = 512;

constexpr size_t MiB = 1u << 20;
constexpr size_t WS_CTL = 0, CTL_ZERO_BYTES = 1 * MiB;
constexpr size_t WS_HIST = 1 * MiB;
constexpr size_t WS_TIDX = WS_HIST + 64 * 1024;
constexpr size_t WS_TGATE = WS_TIDX + 256 * 1024;
constexpr size_t WS_DEST = WS_TGATE + 256 * 1024;
constexpr size_t WS_ROWTOK = WS_DEST + 256 * 1024;
constexpr size_t WS_ROWGATE = WS_ROWTOK + 288 * 1024;
constexpr size_t WS_TILEE = WS_ROWGATE + 288 * 1024;
constexpr size_t WS_RSTD = WS_TILEE + 4 * 1024;
constexpr size_t WS_KMEAN = WS_RSTD + 128 * 1024;
constexpr size_t WS_WRL = WS_KMEAN + 128 * 1024;
static_assert(WS_WRL + 128 * 1024 <= 4 * MiB, "route region");
constexpr size_t WS_ROPEA = 4 * MiB;
constexpr size_t WS_ROPEB = 6 * MiB;
constexpr size_t WS_WIN = 8 * MiB;
constexpr size_t WS_WO = 12 * MiB;
constexpr size_t WS_WUP = 14 * MiB;
constexpr size_t WS_X1B = 16 * MiB;
constexpr size_t WS_WD = 48 * MiB;
constexpr size_t WS_XB = 112 * MiB;
constexpr size_t WS_PROJ = 144 * MiB;
constexpr size_t WS_QM = 208 * MiB;
constexpr size_t WS_KM = 232 * MiB;
constexpr size_t WS_VM = 256 * MiB;
constexpr size_t WS_QB = 272 * MiB;
constexpr size_t WS_KB = 288 * MiB;
constexpr size_t WS_ATT = 304 * MiB;
constexpr size_t WS_H = 112 * MiB;
constexpr size_t WS_WGU = 336 * MiB;
constexpr size_t WS_Y = 336 * MiB;
constexpr size_t WS_LAT = 144 * MiB;
constexpr size_t WS_VB = 160 * MiB;
constexpr size_t WS_RSTDP = 176 * MiB;
constexpr size_t WS_KMEANP = 177 * MiB;
constexpr size_t WS_X1PRE = 144 * MiB;
constexpr size_t WS_END = 480 * MiB;
static_assert(WS_H + (size_t)MAXROWS * 1024 * 2 <= WS_VM + 0 * MiB + 0 && WS_Y + (size_t)MAXROWS * 1024 * 2 <= WS_END, "ws map");
constexpr int CW_BAR = 4096;

constexpr int LDS_BYTES = 147456;
constexpr int MISC_OFF = 131072 + 320;

__device__ __forceinline__ float bf2f(unsigned v) { return __uint_as_float(v << 16); }
__device__ __forceinline__ unsigned f2bf(float f) { unsigned u = __float_as_uint(f); return (u + 0x7fffu + ((u >> 16) & 1u)) >> 16; }
__device__ __forceinline__ unsigned pk2(float lo, float hi) { typedef __bf16 bf2_t __attribute__((ext_vector_type(2))); f32x2 v = {lo, hi}; bf2_t b = __builtin_convertvector(v, bf2_t); return __builtin_bit_cast(unsigned, b); }
__device__ __forceinline__ float wave_sum(float v) {
#pragma unroll
    for (int o = 1; o < 64; o <<= 1) v += __shfl_xor(v, o);
    return v;
}
__device__ __forceinline__ float wave_max(float v) {
#pragma unroll
    for (int o = 1; o < 64; o <<= 1) v = fmaxf(v, __shfl_xor(v, o));
    return v;
}

#define XB_TMO      128
#define XB_XCNT(j)  (256  + 64 * (j))
#define XB_XSUB(j)  (1280 + 64 * (j))
#define XB_XGEN(j)  (2304 + 64 * (j))
#define XB_TOP      3328
#define XB_TOPGEN   3392
#define XCD_BAR_WORDS 3456
#define XB_SPIN_CAP (1u << 18)
__device__ __forceinline__ unsigned xb_ld(unsigned* p)              { return __hip_atomic_load(p, __ATOMIC_RELAXED, __HIP_MEMORY_SCOPE_AGENT); }
__device__ __forceinline__ unsigned xb_add(unsigned* p, unsigned v) { return __hip_atomic_fetch_add(p, v, __ATOMIC_RELAXED, __HIP_MEMORY_SCOPE_AGENT); }
__device__ __forceinline__ unsigned xb_xcc_id() { return (unsigned)__builtin_amdgcn_s_getreg((3 << 11) | 20) & 0xFu; }
#define XB_SPIN(cond, bar) do { unsigned _sp = 0; while (cond) { __builtin_amdgcn_s_sleep(1); \
    if ((++_sp & 255u) == 0u) { if (xb_ld(&(bar)[XB_TMO])) break; if (_sp > XB_SPIN_CAP) { atomicAdd(&(bar)[XB_TMO], 1u); break; } } } } while (0)
struct XcdBarrier { unsigned* bar; unsigned x; volatile LAS unsigned* st; };
__device__ __forceinline__ XcdBarrier xcd_barrier_post(unsigned* bar, volatile LAS unsigned* st) {
    XcdBarrier b; b.bar = bar; b.x = xb_xcc_id(); b.st = st;
    if (threadIdx.x == 0) (void)xb_add(&bar[XB_XCNT(b.x)], 1u);
    return b;
}
__device__ __forceinline__ void xcd_barrier_complete(unsigned* bar, unsigned x, unsigned& nloc, unsigned& nx) {
    const unsigned G = gridDim.x * gridDim.y * gridDim.z;
    unsigned sum, cnt, mine, sp = 0u;
    for (;;) {
        sum = 0u; cnt = 0u; mine = 0u;
#pragma unroll
        for (unsigned j = 0; j < 16; ++j) { const unsigned c = xb_ld(&bar[XB_XCNT(j)]); sum += c; cnt += (c > 0u) ? 1u : 0u; mine = (j == x) ? c : mine; }
        if (sum == G) break;
        __builtin_amdgcn_s_sleep(1);
        if ((++sp & 255u) == 0u) { if (xb_ld(&bar[XB_TMO])) break; if (sp > XB_SPIN_CAP) { atomicAdd(&bar[XB_TMO], 1u); break; } }
    }
    nloc = mine > 0u ? mine : 1u; nx = cnt > 0u ? cnt : 1u;
}
__device__ __forceinline__ void xcd_barrier(const XcdBarrier& b) {
    asm volatile("s_waitcnt vmcnt(0)" ::: "memory");
    __syncthreads();
    if (threadIdx.x == 0) {
        unsigned* bar = b.bar;
        __builtin_amdgcn_s_waitcnt(0);
        unsigned nloc = b.st[0], nx = b.st[1];
        if (nloc == 0u) { xcd_barrier_complete(bar, b.x, nloc, nx); b.st[0] = nloc; b.st[1] = nx; }
        const unsigned old = xb_add(&bar[XB_XSUB(b.x)], 1u);
        const unsigned gen = old / nloc;
        if (old + 1u == (gen + 1u) * nloc) {
            __builtin_amdgcn_fence(__ATOMIC_RELEASE, "agent");
            asm volatile("s_waitcnt vmcnt(0)" ::: "memory");
            const unsigned og = xb_add(&bar[XB_TOP], 1u);
            const unsigned tg = og / nx;
            if (og + 1u == (tg + 1u) * nx) xb_add(&bar[XB_TOPGEN], 1u);
            else XB_SPIN(xb_ld(&bar[XB_TOPGEN]) == tg, bar);
            __builtin_amdgcn_fence(__ATOMIC_ACQUIRE, "agent");
            xb_add(&bar[XB_XGEN(b.x)], 1u);
            asm volatile("s_waitcnt vmcnt(0)" ::: "memory");
        } else {
            XB_SPIN(xb_ld(&bar[XB_XGEN(b.x)]) == gen, bar);
            __builtin_amdgcn_fence(__ATOMIC_ACQUIRE, "agent");
            asm volatile("s_waitcnt vmcnt(0)" ::: "memory");
        }
    }
    __syncthreads();
}

struct Params {
    const float* x; const int* pos;
    const float *w_in, *q_a_norm, *w_q_b, *kv_a_norm, *w_kv_b, *w_o, *ln1_g, *ln1_b, *w_router, *b_router;
    const float *w_gate, *b_gate, *w_up, *b_up, *w_down, *b_down, *ln2_g, *ln2_b;
    float* out; unsigned char* ws;
    double invfA[16]; double invfB[8];
    int ph_lo, ph_hi;
};

struct Unit { int pm, pn, e; };
struct GemmArgs { const bf16_t* A; int lda; const bf16_t* Bt; int ldb; int K; };
template <bool PERM> __device__ __forceinline__ int ecol(int bj, int n, int wc, int fq) { return 128 * bj + 32 * wc + (PERM ? 8 * fq + 4 * n : 16 * n + 4 * fq); }

template <class Epi, class Sched>
__device__ __forceinline__ void gemm_phase_naive(LAS unsigned char* lds, const GemmArgs g, const Sched& S, const Epi& E) {
    const int tid = threadIdx.x, wid = __builtin_amdgcn_readfirstlane(tid >> 6), lane = tid & 63, wr = wid >> 2, wc = wid & 3, fr = lane & 15, fq = lane >> 4;
    Unit u;
    for (int ui = 0; S.next(ui, u); ++ui) {
        f32x4 acc[2][2][4][2];
#pragma unroll
        for (int a = 0; a < 2; ++a)
#pragma unroll
            for (int b = 0; b < 2; ++b)
#pragma unroll
                for (int m = 0; m < 4; ++m)
#pragma unroll
                    for (int n = 0; n < 2; ++n) acc[a][b][m][n] = (f32x4){0.f, 0.f, 0.f, 0.f};
        unsigned aoff[2][4];
#pragma unroll
        for (int a = 0; a < 2; ++a)
#pragma unroll
            for (int m = 0; m < 4; ++m) aoff[a][m] = (unsigned)S.arow(u, ui, 128 * a + 64 * wr + 16 * m + fr) * (unsigned)g.lda;
        const bf16_t* bb = g.Bt + (size_t)(S.brow0(u) + 32 * wc) * g.ldb;
        const unsigned bl0 = (unsigned)(4 * fq) * (unsigned)g.ldb, bl1 = (unsigned)(8 * fq) * (unsigned)g.ldb;
#pragma unroll 1
        for (int k = 0; k < g.K; k += 2) {
            float af[2][4][2];
#pragma unroll
            for (int a = 0; a < 2; ++a)
#pragma unroll
                for (int m = 0; m < 4; ++m) { const unsigned v = *(const unsigned*)(g.A + aoff[a][m] + k); af[a][m][0] = __uint_as_float(v << 16); af[a][m][1] = __uint_as_float(v & 0xffff0000u); }
#pragma unroll
            for (int b = 0; b < 2; ++b)
#pragma unroll
                for (int n = 0; n < 2; ++n)
#pragma unroll
                    for (int j = 0; j < 4; ++j) {
                        const int ccol = 128 * b + (Epi::PERM ? 4 * n : 16 * n) + j;
                        const unsigned v = *(const unsigned*)(bb + (size_t)ccol * g.ldb + ((Epi::PERM ? bl1 : bl0) + (unsigned)k));
                        const float b0 = __uint_as_float(v << 16), b1 = __uint_as_float(v & 0xffff0000u);
#pragma unroll
                        for (int a = 0; a < 2; ++a)
#pragma unroll
                            for (int m = 0; m < 4; ++m) acc[a][b][m][n][j] = fmaf(af[a][m][1], b1, fmaf(af[a][m][0], b0, acc[a][b][m][n][j]));
                    }
        }
        E(acc, u, wr, wc, fr, fq);
    }
}

namespace pg {
constexpr int BK = 64, HALF = 128, HTB = HALF * BK * 2;
__device__ __forceinline__ int lds_byte(int r, int c) { const int st = (r >> 4) * 2 + (c >> 5), rr = r & 15, cc = c & 31, ob = rr * 64 + cc * 2; return st * 1024 + (ob ^ (((ob >> 9) & 1) << 5)); }
__device__ __forceinline__ void stage_rc(int b, int& R, int& C) { const int st = b / 1024, sb = b % 1024, swz = sb ^ (((sb >> 9) & 1) << 5); R = (st >> 1) * 16 + swz / 64; C = (st & 1) * 32 + (swz % 64) / 2; }
__device__ __forceinline__ int perm32(int rho) { const int n = rho >> 4, i = rho & 15; return 8 * (i >> 2) + 4 * n + (i & 3); }
}
template <class Epi, class Sched, bool ALIGN_EPI>
__device__ __forceinline__ void gemm_phase(LAS unsigned char* lds, const GemmArgs g, const Sched& S, const Epi& E) {
    using namespace pg;
    const int tid = threadIdx.x, wid = __builtin_amdgcn_readfirstlane(tid >> 6), lane = tid & 63, wr = wid >> 2, wc = wid & 3, fr = lane & 15, fq = lane >> 4;
    const int nt = g.K / BK;
    int sR[2], sC[2], sRb[2];
#pragma unroll
    for (int i = 0; i < 2; ++i) { int R, C; stage_rc(tid * 16 + i * 8192, R, C); sR[i] = R; sC[i] = C; sRb[i] = Epi::PERM ? ((R & ~31) + perm32(R & 31)) : R; }
    const unsigned ldsw = (unsigned)wid * 1024u;
    const int aoff = lds_byte(wr * 64 + fr, fq * 8), boff = lds_byte(wc * 32 + fr, fq * 8);
    const char* Ab = (const char*)g.A; const char* Bb = (const char*)g.Bt;
#define PG_SA(b, h) (((b) * 2 + (h)) * HTB)
#define PG_SB(b, h) ((4 + (b) * 2 + (h)) * HTB)
#define PG_STAGE(bufoff, gptr, v0, v1) do { \
        __builtin_amdgcn_global_load_lds((const unsigned*)((gptr) + (v0)), (LAS unsigned*)(lds + (bufoff) + ldsw), 16, 0, 0); \
        __builtin_amdgcn_global_load_lds((const unsigned*)((gptr) + (v1)), (LAS unsigned*)(lds + (bufoff) + ldsw + 8192), 16, 0, 0); } while (0)
#define PG_LDA(dst, b, h) do { _Pragma("unroll") for (int m = 0; m < 4; ++m) _Pragma("unroll") for (int k = 0; k < 2; ++k) dst[m][k] = *(const LAS bf16x8*)(lds + PG_SA(b, h) + aoff + m * 2048 + k * 1024); } while (0)
#define PG_LDB(dst, b, h) do { _Pragma("unroll") for (int n = 0; n < 2; ++n) _Pragma("unroll") for (int k = 0; k < 2; ++k) dst[n][k] = *(const LAS bf16x8*)(lds + PG_SB(b, h) + boff + n * 2048 + k * 1024); } while (0)
#define PG_MMA(ai, bj, At, Bt) do { __builtin_amdgcn_s_setprio(1); _Pragma("unroll") for (int m = 0; m < 4; ++m) _Pragma("unroll") for (int n = 0; n < 2; ++n) _Pragma("unroll") for (int k = 0; k < 2; ++k) \
        acc[ai][bj][m][n] = __builtin_amdgcn_mfma_f32_16x16x32_bf16(Bt[n][k], At[m][k], acc[ai][bj][m][n], 0, 0, 0); __builtin_amdgcn_s_setprio(0); } while (0)
#define PG_WAIT_V(n) asm volatile("s_waitcnt vmcnt(" #n ")" ::: "memory")
#define PG_WAIT_L(n) asm volatile("s_waitcnt lgkmcnt(" #n ")" ::: "memory")
#define PG_BAR __builtin_amdgcn_s_barrier()
#define PG_SCHED __builtin_amdgcn_sched_barrier(0)
    constexpr bool GA = Sched::GATHER;
    unsigned cA[2], cB[2];
#pragma unroll
    for (int i = 0; i < 2; ++i) { cA[i] = ((unsigned)sR[i] * (unsigned)g.lda + (unsigned)sC[i]) * 2u; cB[i] = ((unsigned)sRb[i] * (unsigned)g.ldb + (unsigned)sC[i]) * 2u; }
    const size_t hA = (size_t)128 * g.lda * 2, hB = (size_t)128 * g.ldb * 2;
#define PG_GOFFS(u, uidx, VA) do { if constexpr (GA) { _Pragma("unroll") for (int h = 0; h < 2; ++h) _Pragma("unroll") for (int i = 0; i < 2; ++i) \
        VA[h][i] = ((unsigned)S.arow(u, uidx, 128 * h + sR[i]) * (unsigned)g.lda + (unsigned)sC[i]) * 2u; } } while (0)
#define PG_UA(u) (GA ? (size_t)0 : (size_t)S.arow(u, 0, 0) * g.lda * 2)
#define PG_UB(u) ((size_t)S.brow0(u) * g.ldb * 2)
#define PG_STAGE_A(bufoff, ab, VA, h) do { if constexpr (GA) { PG_STAGE(bufoff, (ab), VA[h][0], VA[h][1]); } else { PG_STAGE(bufoff, (ab) + (h) * hA, cA[0], cA[1]); } } while (0)
#define PG_STAGE_B(bufoff, bb, h) PG_STAGE(bufoff, (bb) + (h) * hB, cB[0], cB[1])
    Unit cur, nxt; int ui = 0;
    if (!S.next(0, cur)) return;
    f32x4 acc[2][2][4][2];
#pragma unroll
    for (int a = 0; a < 2; ++a)
#pragma unroll
        for (int b = 0; b < 2; ++b)
#pragma unroll
            for (int m = 0; m < 4; ++m)
#pragma unroll
                for (int n = 0; n < 2; ++n) acc[a][b][m][n] = (f32x4){0.f, 0.f, 0.f, 0.f};
    bf16x8 At[4][2], B0[2][2], B1[2][2];
    unsigned vA[2][2], nvA[2][2];
    PG_GOFFS(cur, 0, vA);
    const char* cAp = Ab + PG_UA(cur); const char* cBp = Bb + PG_UB(cur);
    PG_STAGE_B(PG_SB(0, 0), cBp, 0); PG_STAGE_B(PG_SB(0, 1), cBp, 1); PG_STAGE_A(PG_SA(0, 0), cAp, vA, 0); PG_STAGE_A(PG_SA(0, 1), cAp, vA, 1);
    if (wr == 1) PG_BAR;
    PG_WAIT_V(2); PG_BAR;
    PG_STAGE_B(PG_SB(1, 0), cBp + 128, 0); PG_STAGE_A(PG_SA(1, 0), cAp + 128, vA, 0); PG_STAGE_B(PG_SB(1, 1), cBp + 128, 1);
    PG_WAIT_V(6); PG_BAR;
    for (;;) {
        const bool has_next = S.next(ui + 1, nxt);
        const char* nAp = cAp; const char* nBp = cBp;
        if (has_next) { PG_GOFFS(nxt, ui + 1, nvA); nAp = Ab + PG_UA(nxt); nBp = Bb + PG_UB(nxt); }
        else { if constexpr (GA) {
#pragma unroll
            for (int h = 0; h < 2; ++h)
#pragma unroll
                for (int i = 0; i < 2; ++i) nvA[h][i] = vA[h][i]; } }
#pragma unroll 1
        for (int t = 0; t < nt; t += 2) {
            const bool last = (t == nt - 2);
            const char* a1 = cAp + (size_t)(t + 1) * 128;
            const char* a2 = last ? nAp : cAp + (size_t)(t + 2) * 128; const char* b2 = last ? nBp : cBp + (size_t)(t + 2) * 128;
            const char* a3 = a2 + 128; const char* b3 = b2 + 128;
            unsigned wA[2][2];
            if constexpr (GA) {
#pragma unroll
                for (int h = 0; h < 2; ++h)
#pragma unroll
                    for (int i = 0; i < 2; ++i) wA[h][i] = last ? nvA[h][i] : vA[h][i]; }
            PG_LDB(B0, 0, 0); PG_LDB(B1, 0, 1); PG_SCHED; PG_LDA(At, 0, 0); PG_STAGE_A(PG_SA(1, 1), a1, vA, 1);
            PG_WAIT_V(8); PG_WAIT_L(0); PG_BAR; PG_MMA(0, 0, At, B0); PG_MMA(0, 1, At, B1); PG_BAR; PG_SCHED;
            PG_LDA(At, 0, 1); PG_STAGE_B(PG_SB(0, 0), b2, 0); PG_STAGE_B(PG_SB(0, 1), b2, 1); PG_STAGE_A(PG_SA(0, 0), a2, wA, 0);
            PG_WAIT_V(8); PG_WAIT_L(0); PG_BAR; PG_MMA(1, 0, At, B0); PG_MMA(1, 1, At, B1); PG_BAR; PG_SCHED;
            PG_LDB(B0, 1, 0); PG_LDB(B1, 1, 1); PG_SCHED; PG_LDA(At, 1, 0); PG_STAGE_A(PG_SA(0, 1), a2, wA, 1);
            PG_WAIT_V(8); PG_WAIT_L(0); PG_BAR; PG_MMA(0, 0, At, B0); PG_MMA(0, 1, At, B1); PG_BAR; PG_SCHED;
            PG_LDA(At, 1, 1); PG_STAGE_B(PG_SB(1, 0), b3, 0); PG_STAGE_B(PG_SB(1, 1), b3, 1); PG_STAGE_A(PG_SA(1, 0), a3, wA, 0);
            PG_WAIT_V(8); PG_WAIT_L(0); PG_BAR; PG_MMA(1, 0, At, B0); PG_MMA(1, 1, At, B1); PG_BAR; PG_SCHED;
        }
        if constexpr (ALIGN_EPI) { if (wr == 0) PG_BAR; }
        E(acc, cur, wr, wc, fr, fq);
        if (!has_next) break;
#pragma unroll
        for (int a = 0; a < 2; ++a)
#pragma unroll
            for (int b = 0; b < 2; ++b)
#pragma unroll
                for (int m = 0; m < 4; ++m)
#pragma unroll
                    for (int n = 0; n < 2; ++n) acc[a][b][m][n] = (f32x4){0.f, 0.f, 0.f, 0.f};
        cur = nxt; ++ui; cAp = nAp; cBp = nBp;
        if constexpr (GA) {
#pragma unroll
            for (int h = 0; h < 2; ++h)
#pragma unroll
                for (int i = 0; i < 2; ++i) vA[h][i] = nvA[h][i]; }
        if constexpr (ALIGN_EPI) { if (wr == 1) PG_BAR; }
    }
    PG_WAIT_V(0);
    if constexpr (!ALIGN_EPI) { if (wr == 0) PG_BAR; }
    PG_BAR;
#undef PG_SA
#undef PG_SB
#undef PG_STAGE
#undef PG_LDA
#undef PG_LDB
#undef PG_MMA
#undef PG_WAIT_V
#undef PG_WAIT_L
#undef PG_BAR
#undef PG_SCHED
#undef PG_GOFFS
#undef PG_UA
#undef PG_UB
#undef PG_STAGE_A
#undef PG_STAGE_B
}

constexpr int ROWTAB_OFF = 132096, ETAB_OFF = ROWTAB_OFF + 12 * 1024, MAXU = 12;
struct DenseSched {
    static constexpr bool GATHER = false;
    int nN, nunits, G, c;
    __device__ __forceinline__ void init(LAS unsigned char*, int M, int N, int G_, int c_) { nN = N / 256; nunits = (M / 256) * nN; G = G_; c = c_; }
    __device__ __forceinline__ bool next(int i, Unit& u) const { const int L = i * G + c; if (L >= nunits) return false; u.pm = L / nN; u.pn = L % nN; u.e = 0; return true; }
    __device__ __forceinline__ int arow(const Unit& u, int, int r) const { return 256 * u.pm + r; }
    __device__ __forceinline__ int brow0(const Unit& u) const { return 256 * u.pn; }
};
template <bool GATHER_> struct GroupSched {
    static constexpr bool GATHER = GATHER_;
    LAS int* rowtab; LAS int* etab; int nN, nexp_rows, nunits, G, c;
    __device__ __forceinline__ void init(LAS unsigned char* lds, const int* te, const int* rt, int nN_, int nexp_rows_, int G_, int c_) {
        rowtab = (LAS int*)(lds + ROWTAB_OFF); etab = (LAS int*)(lds + ETAB_OFF); nN = nN_; nexp_rows = nexp_rows_; G = G_; c = c_;
        nunits = __builtin_amdgcn_readfirstlane(te[MAXTILES]) * nN_;
        for (int i = 0; i < MAXU; ++i) { const int L = i * G + c; if (L >= nunits) break; const int pm = L / nN;
            if (threadIdx.x == 0) etab[i] = te[pm];
            if (GATHER && threadIdx.x < 256) rowtab[i * 256 + threadIdx.x] = rt[256 * pm + threadIdx.x]; }
        __syncthreads();
    }
    __device__ __forceinline__ bool next(int i, Unit& u) const { const int L = i * G + c; if (L >= nunits || i >= MAXU) return false; u.pm = L / nN; u.pn = L % nN; u.e = etab[i]; return true; }
    __device__ __forceinline__ int arow(const Unit& u, int ui, int r) const { return GATHER ? rowtab[ui * 256 + r] : 256 * u.pm + r; }
    __device__ __forceinline__ int brow0(const Unit& u) const { return u.e * nexp_rows + 256 * u.pn; }
};

struct EpiProj {
    static constexpr bool PERM = true;
    unsigned char* ws;
    __device__ __forceinline__ void operator()(const f32x4 (&acc)[2][2][4][2], const Unit& u, int wr, int wc, int fr, int fq) const {
        asm volatile("" : "+v"(fr), "+v"(fq));
        bf16_t* LAT = (bf16_t*)(ws + WS_LAT); bf16_t* KM = (bf16_t*)(ws + WS_KM); bf16_t* QB = (bf16_t*)(ws + WS_QB); bf16_t* KB = (bf16_t*)(ws + WS_KB); bf16_t* VB = (bf16_t*)(ws + WS_VB);
        float* rstdp = (float*)(ws + WS_RSTDP); float* kmeanp = (float*)(ws + WS_KMEANP);
        const float* ropeA = (const float*)(ws + WS_ROPEA); const float* ropeB = (const float*)(ws + WS_ROPEB);
#pragma unroll
        for (int b = 0; b < 2; ++b) {
            const int g = 8 * u.pn + 4 * b + wc;
            if (g < 12) {
#pragma unroll
                for (int a = 0; a < 2; ++a)
#pragma unroll
                    for (int m = 0; m < 4; ++m) { const int row = 256 * u.pm + 128 * a + 64 * wr + 16 * m + fr; const f32x4 v0 = acc[a][b][m][0], v1 = acc[a][b][m][1];
                        u32x4 w; w.x = pk2(v0[0], v0[1]); w.y = pk2(v0[2], v0[3]); w.z = pk2(v1[0], v1[1]); w.w = pk2(v1[2], v1[3]);
                        *(u32x4*)(LAT + (size_t)row * 384 + g * 32 + 8 * fq) = w;
                        float ss = 0.f;
#pragma unroll
                        for (int k = 0; k < 4; ++k) { const float e0 = __uint_as_float(w[k] << 16), e1 = __uint_as_float(w[k] & 0xffff0000u); ss += e0 * e0 + e1 * e1; }
                        ss += __shfl_xor(ss, 16); ss += __shfl_xor(ss, 32);
                        if (fq == 0) rstdp[(size_t)row * 12 + g] = ss; }
            } else if (g == 12) {
#pragma unroll
                for (int a = 0; a < 2; ++a)
#pragma unroll
                    for (int m = 0; m < 4; ++m) { const int row = 256 * u.pm + 128 * a + 64 * wr + 16 * m + fr; u32x4 w;
#pragma unroll
                        for (int n = 0; n < 2; ++n) { const f32x4 v = acc[a][b][m][n]; f32x4 pv;
#pragma unroll
                            for (int j = 0; j < 4; ++j) { auto rr = __builtin_amdgcn_permlane32_swap(__float_as_uint(v[j]), __float_as_uint(v[j]), false, false); pv[j] = __uint_as_float(fq < 2 ? rr[1] : rr[0]); }
                            const f32x4 c = *(const f32x4*)(ropeA + (size_t)row * 32 + 8 * (fq & 1) + 4 * n), sn = *(const f32x4*)(ropeA + (size_t)row * 32 + 16 + 8 * (fq & 1) + 4 * n);
                            const f32x4 o = (fq < 2) ? (v * c - pv * sn) : (v * c + pv * sn);
                            w[2 * n] = pk2(o[0], o[1]); w[2 * n + 1] = pk2(o[2], o[3]); }
#pragma unroll
                        for (int h = 0; h < 8; ++h) *(u32x4*)(KM + (size_t)row * 768 + h * 96 + 64 + 8 * fq) = w; }
            } else if (g < 45) {
                const bool isk = g >= 29; const int rel = isk ? g - 29 : g - 13, head = rel >> 1, hf = rel & 1;
                bf16_t* dst = (isk ? KB : QB) + head * 64 + hf * 32 + 8 * fq;
                f32x4 cs0 = (f32x4){0.f, 0.f, 0.f, 0.f}, cs1 = cs0;
#pragma unroll
                for (int a = 0; a < 2; ++a)
#pragma unroll
                    for (int m = 0; m < 4; ++m) { const int row = 256 * u.pm + 128 * a + 64 * wr + 16 * m + fr; f32x4 v0 = acc[a][b][m][0], v1 = acc[a][b][m][1];
                        if (hf == 0) {
#pragma unroll
                            for (int n = 0; n < 2; ++n) { const f32x4 v = n ? v1 : v0; f32x4 pv;
#pragma unroll
                                for (int j = 0; j < 4; ++j) { auto rr = __builtin_amdgcn_permlane16_swap(__float_as_uint(v[j]), __float_as_uint(v[j]), false, false); pv[j] = __uint_as_float((fq & 1) ? rr[0] : rr[1]); }
                                const f32x4 c = *(const f32x4*)(ropeB + (size_t)row * 16 + 4 * n), sn = *(const f32x4*)(ropeB + (size_t)row * 16 + 8 + 4 * n);
                                const f32x4 o = (fq == 0) ? (v * c - pv * sn) : (fq == 1) ? (v * c + pv * sn) : v;
                                if (n) v1 = o; else v0 = o; } }
                        if (isk) { cs0 += v0; cs1 += v1; }
                        const f32x4 s0 = isk ? v0 : v0 * C2B, s1 = isk ? v1 : v1 * C2B;
                        u32x4 w; w.x = pk2(s0[0], s0[1]); w.y = pk2(s0[2], s0[3]); w.z = pk2(s1[0], s1[1]); w.w = pk2(s1[2], s1[3]);
                        *(u32x4*)(dst + (size_t)row * 512) = w; }
                if (isk) {
#pragma unroll
                    for (int j = 0; j < 4; ++j) {
#pragma unroll
                        for (int o = 1; o < 16; o <<= 1) { cs0[j] += __shfl_xor(cs0[j], o); cs1[j] += __shfl_xor(cs1[j], o); } }
                    if (fr == 0) { float* kp = kmeanp + ((size_t)u.pm * 2 + wr) * 512 + head * 64 + hf * 32 + 8 * fq; *(f32x4*)kp = cs0; *(f32x4*)(kp + 4) = cs1; } }
            } else if (g < 61) {
                const int rel = g - 45;
#pragma unroll
                for (int a = 0; a < 2; ++a)
#pragma unroll
                    for (int m = 0; m < 4; ++m) { const int row = 256 * u.pm + 128 * a + 64 * wr + 16 * m + fr; const f32x4 v0 = acc[a][b][m][0], v1 = acc[a][b][m][1];
                        u32x4 w; w.x = pk2(v0[0], v0[1]); w.y = pk2(v0[2], v0[3]); w.z = pk2(v1[0], v1[1]); w.w = pk2(v1[2], v1[3]);
                        *(u32x4*)(VB + (size_t)row * 512 + rel * 32 + 8 * fq) = w; }
            }
            asm volatile("" ::: "memory");
        }
    }
};
struct EpiUp {
    static constexpr bool PERM = true;
    bf16_t *QM, *KM, *VM; const float* rstd; const float* ropeA; int gbase;
    __device__ __forceinline__ void operator()(const f32x4 (&acc)[2][2][4][2], const Unit& u, int wr, int wc, int fr, int fq) const {
        asm volatile("" : "+v"(fr), "+v"(fq));
#pragma unroll
        for (int a = 0; a < 2; ++a)
#pragma unroll
            for (int m = 0; m < 4; ++m) { const int row = 256 * u.pm + 128 * a + 64 * wr + 16 * m + fr;
                const f32x4 s0 = *(const f32x4*)(rstd + (size_t)row * 12), s1 = *(const f32x4*)(rstd + (size_t)row * 12 + 4), s2 = *(const f32x4*)(rstd + (size_t)row * 12 + 8);
                const float rq = C2A / sqrtf((((s0[0] + s0[1]) + (s0[2] + s0[3])) + ((s1[0] + s1[1]) + (s1[2] + s1[3]))) * (1.0f / 256.0f) + RMS_EPS);
                const float rkv = 1.0f / sqrtf(((s2[0] + s2[1]) + (s2[2] + s2[3])) * (1.0f / 128.0f) + RMS_EPS);
#pragma unroll
                for (int b = 0; b < 2; ++b) {
                    const int gidx = gbase + 8 * u.pn + 4 * b + wc;
                    if (gidx < 24) {
                        const int h = gidx / 3, part = gidx % 3;
                        f32x4 v0 = acc[a][b][m][0] * rq, v1 = acc[a][b][m][1] * rq;
                        if (part == 2) {
#pragma unroll
                            for (int n = 0; n < 2; ++n) { const f32x4 v = n ? v1 : v0; f32x4 pv;
#pragma unroll
                                for (int j = 0; j < 4; ++j) { auto rr = __builtin_amdgcn_permlane32_swap(__float_as_uint(v[j]), __float_as_uint(v[j]), false, false); pv[j] = __uint_as_float(fq < 2 ? rr[1] : rr[0]); }
                                const f32x4 c = *(const f32x4*)(ropeA + (size_t)row * 32 + 8 * (fq & 1) + 4 * n), sn = *(const f32x4*)(ropeA + (size_t)row * 32 + 16 + 8 * (fq & 1) + 4 * n);
                                const f32x4 o = (fq < 2) ? (v * c - pv * sn) : (v * c + pv * sn);
                                if (n) v1 = o; else v0 = o; } }
                        u32x4 w; w.x = pk2(v0[0], v0[1]); w.y = pk2(v0[2], v0[3]); w.z = pk2(v1[0], v1[1]); w.w = pk2(v1[2], v1[3]);
                        *(u32x4*)(QM + (size_t)row * 768 + h * 96 + part * 32 + 8 * fq) = w;
                    } else {
                        const int g2 = gidx - 24, h = g2 >> 2, part = g2 & 3;
                        const f32x4 v0 = acc[a][b][m][0] * rkv, v1 = acc[a][b][m][1] * rkv;
                        bf16_t* pp = (part < 2) ? (KM + (size_t)row * 768 + h * 96 + part * 32 + 8 * fq) : (VM + (size_t)row * 512 + h * 64 + (part - 2) * 32 + 8 * fq);
                        u32x4 w; w.x = pk2(v0[0], v0[1]); w.y = pk2(v0[2], v0[3]); w.z = pk2(v1[0], v1[1]); w.w = pk2(v1[2], v1[3]);
                        *(u32x4*)pp = w;
                    }
                }
                asm volatile("" ::: "memory"); }
    }
};
struct EpiWo {
    static constexpr bool PERM = false;
    const float* x; float* O;
    __device__ __forceinline__ void operator()(const f32x4 (&acc)[2][2][4][2], const Unit& u, int wr, int wc, int fr, int fq) const {
        asm volatile("" : "+v"(fr), "+v"(fq));
#pragma unroll
        for (int a = 0; a < 2; ++a)
#pragma unroll
            for (int m = 0; m < 4; ++m) { const int row = 256 * u.pm + 128 * a + 64 * wr + 16 * m + fr;
#pragma unroll
                for (int b = 0; b < 2; ++b)
#pragma unroll
                    for (int n = 0; n < 2; ++n) { const size_t off = (size_t)row * DM + 256 * u.pn + ecol<PERM>(b, n, wc, fq);
                        const f32x4 xv = *(const f32x4*)(x + off); *(f32x4*)(O + off) = xv * DN_ALPHA + acc[a][b][m][n]; } }
    }
};
struct EpiGateUp {
    static constexpr bool PERM = true;
    bf16_t* H; const float *bg, *bu;
    __device__ __forceinline__ void operator()(const f32x4 (&acc)[2][2][4][2], const Unit& u, int wr, int wc, int fr, int fq) const {
        asm volatile("" : "+v"(fr), "+v"(fq));
        const int hc = 128 * u.pn + 32 * wc + 8 * fq;
        f32x4 vbg[2], vbu[2];
#pragma unroll
        for (int n = 0; n < 2; ++n) { vbg[n] = *(const f32x4*)(bg + (size_t)u.e * 1024 + hc + 4 * n); vbu[n] = *(const f32x4*)(bu + (size_t)u.e * 1024 + hc + 4 * n); }
#pragma unroll
        for (int a = 0; a < 2; ++a)
#pragma unroll
            for (int m = 0; m < 4; ++m) { const int row = 256 * u.pm + 128 * a + 64 * wr + 16 * m + fr; u32x4 w;
#pragma unroll
                for (int n = 0; n < 2; ++n) { const f32x4 gv = acc[a][0][m][n] + vbg[n], uv = acc[a][1][m][n] + vbu[n]; float hv[4];
#pragma unroll
                    for (int j = 0; j < 4; ++j) { const float gg = fminf(gv[j], 7.0f), uu = fminf(fmaxf(uv[j], -7.0f), 7.0f);
                        const float sg = __builtin_amdgcn_rcpf(1.0f + __builtin_amdgcn_exp2f(-1.702f * LOG2E * gg)); hv[j] = gg * sg * (uu + 1.0f); }
                    w[2 * n] = pk2(hv[0], hv[1]); w[2 * n + 1] = pk2(hv[2], hv[3]); }
                __builtin_nontemporal_store(w, (u32x4*)(H + (size_t)row * 1024 + hc)); }
    }
};
struct EpiDown {
    static constexpr bool PERM = true;
    bf16_t* Y; const float* bd; const float* row_gate;
    __device__ __forceinline__ void operator()(const f32x4 (&acc)[2][2][4][2], const Unit& u, int wr, int wc, int fr, int fq) const {
        asm volatile("" : "+v"(fr), "+v"(fq));
        f32x4 bv[2][2];
#pragma unroll
        for (int b = 0; b < 2; ++b)
#pragma unroll
            for (int n = 0; n < 2; ++n) bv[b][n] = *(const f32x4*)(bd + (size_t)u.e * 1024 + 256 * u.pn + 128 * b + 32 * wc + 8 * fq + 4 * n);
#pragma unroll
        for (int a = 0; a < 2; ++a)
#pragma unroll
            for (int m = 0; m < 4; ++m) { const int row = 256 * u.pm + 128 * a + 64 * wr + 16 * m + fr; const float gw = row_gate[row];
#pragma unroll
                for (int b = 0; b < 2; ++b) { const int col = 256 * u.pn + 128 * b + 32 * wc + 8 * fq;
                    const f32x4 v0 = (acc[a][b][m][0] + bv[b][0]) * gw, v1 = (acc[a][b][m][1] + bv[b][1]) * gw;
                    u32x4 w; w.x = pk2(v0[0], v0[1]); w.y = pk2(v0[2], v0[3]); w.z = pk2(v1[0], v1[1]); w.w = pk2(v1[2], v1[3]);
                    __builtin_nontemporal_store(w, (u32x4*)(Y + (size_t)row * 1024 + col)); } }
    }
};

__device__ __forceinline__ unsigned cvtpk_hw(float lo, float hi) { typedef __bf16 bf2 __attribute__((ext_vector_type(2))); f32x2 v = {lo, hi}; bf2 b = __builtin_convertvector(v, bf2); return __builtin_bit_cast(unsigned, b); }
__device__ __forceinline__ void conv_issue(const float* W, int ldw, int k0, int n0, LAS unsigned char* scr, int lane) {
#pragma unroll
    for (int i = 0; i < 4; ++i) __builtin_amdgcn_global_load_lds((const unsigned*)(W + (size_t)(k0 + 4 * (lane >> 3) + i) * ldw + n0 + 4 * (lane & 7)), (LAS unsigned*)(scr + i * 1024), 16, 0, 2);
}
__device__ __forceinline__ void conv_finish(bf16_t* WT, int ldt, int orow0, int ocol0, const LAS unsigned char* scr, int lane) {
    f32x4 r[4];
#pragma unroll
    for (int i = 0; i < 4; ++i) r[i] = *(const LAS f32x4*)(scr + i * 1024 + lane * 16);
#pragma unroll
    for (int j = 0; j < 4; ++j) { u32x2 o; o.x = cvtpk_hw(r[0][j], r[1][j]); o.y = cvtpk_hw(r[2][j], r[3][j]);
        *(u32x2*)(WT + (size_t)(orow0 + 4 * (lane & 7) + j) * ldt + ocol0 + 4 * (lane >> 3)) = o; }
}
constexpr int NEXP_ITEMS = 3 * NE * 1024;
__device__ __forceinline__ void expert_issue(const Params& p, int r, LAS unsigned char* scr, int lane) {
    const int mat = r >> 15, rr = r & 32767, e = rr >> 10, q = rr & 1023, kb = (q & 1) | ((q >> 6) << 1), nb = (q >> 1) & 31;
    const float* W = (mat == 0 ? p.w_gate : mat == 1 ? p.w_up : p.w_down) + (size_t)e * 1048576;
    conv_issue(W, 1024, 32 * kb, 32 * nb, scr, lane);
}
__device__ __forceinline__ void expert_finish(const Params& p, int r, const LAS unsigned char* scr, int lane) {
    const int mat = r >> 15, rr = r & 32767, e = rr >> 10, q = rr & 1023, kb = (q & 1) | ((q >> 6) << 1), nb = (q >> 1) & 31, n0 = 32 * nb;
    bf16_t* WguT = (bf16_t*)(p.ws + WS_WGU); bf16_t* WdT = (bf16_t*)(p.ws + WS_WD);
    if (mat == 2) conv_finish(WdT, 1024, e * 1024 + n0, 32 * kb, scr, lane);
    else conv_finish(WguT, 1024, e * 2048 + (n0 >> 7) * 256 + (mat == 1 ? 128 : 0) + (n0 & 127), 32 * kb, scr, lane);
}
struct BgConv { int next, stride, pend0, pend1, itc; };

__device__ __forceinline__ void tr_item(const float* W, int ldw, int k0, int n0, bf16_t* WT, int ldt, int orow0, int ocol0, const float* kscale, LAS float* scr, int lane) {
#pragma unroll 8
    for (int i = 0; i < 32; ++i) { const int kk = 2 * i + (lane >> 5); float v = W[(size_t)(k0 + kk) * ldw + n0 + (lane & 31)]; if (kscale) v *= kscale[k0 + kk]; scr[kk * 33 + (lane & 31)] = v; }
    asm volatile("s_waitcnt lgkmcnt(0)" ::: "memory");
    const int c = lane & 7;
#pragma unroll
    for (int j = 0; j < 4; ++j) { const int n = (lane >> 3) + 8 * j; const LAS float* s = scr + (8 * c) * 33 + n;
        u32x4 o; o.x = pk2(s[0 * 33], s[1 * 33]); o.y = pk2(s[2 * 33], s[3 * 33]); o.z = pk2(s[4 * 33], s[5 * 33]); o.w = pk2(s[6 * 33], s[7 * 33]);
        *(u32x4*)(WT + (size_t)(orow0 + n) * ldt + ocol0 + 8 * c) = o; }
    asm volatile("s_waitcnt lgkmcnt(0)" ::: "memory");
}
__device__ __forceinline__ void phase_prologue(const Params& p, LAS unsigned char* lds, int vcu, int G) {
    const int tid = threadIdx.x, wave = tid >> 6, lane = tid & 63;
    unsigned char* ws = p.ws;
    LAS float* scr = (LAS float*)(lds + wave * 16384);
    const int gw = vcu * NWAVES + wave, NGW = G * NWAVES;
    bf16_t* WinT = (bf16_t*)(ws + WS_WIN); bf16_t* WoT = (bf16_t*)(ws + WS_WO); bf16_t* WupT = (bf16_t*)(ws + WS_WUP);
    constexpr int I_IN = 16 * 61, I_QB = 4 * 24, I_KVB = 2 * 32, I_O = 16 * 32;
    constexpr int NITEMS = I_IN + I_QB + I_KVB + I_O;
    for (int it = gw; it < NITEMS; it += NGW) {
        int r = it;
        if (r < I_IN) { const int kb = r / 61, nb = r % 61; tr_item(p.w_in, IN_COLS, 64 * kb, 32 * nb, WinT, 1024, 32 * nb, 64 * kb, nullptr, scr, lane); continue; } r -= I_IN;
        if (r < I_QB) { const int kb = r / 24, nb = r % 24; tr_item(p.w_q_b, 768, 64 * kb, 32 * nb, WupT, KUP, 32 * nb, 64 * kb, p.q_a_norm, scr, lane); continue; } r -= I_QB;
        if (r < I_KVB) { const int kb = r / 32, nb = r % 32; tr_item(p.w_kv_b, 1024, 64 * kb, 32 * nb, WupT, KUP, 768 + 32 * nb, 256 + 64 * kb, p.kv_a_norm, scr, lane); continue; } r -= I_KVB;
        { const int kb = r / 32, nb = r % 32; tr_item(p.w_o, 1024, 64 * kb, 32 * nb, WoT, 1024, 32 * nb, 64 * kb, nullptr, scr, lane); }
    }
    const int gt = vcu * NTHREADS + tid, NGT = G * NTHREADS;
    for (int i = gt; i < 96 * 128; i += NGT) *(u32x4*)(WinT + (size_t)IN_COLS * 1024 + (size_t)i * 8) = (u32x4){0u, 0u, 0u, 0u};
    for (int i = gt; i < 768 * 16; i += NGT) { const int r = i / 16, c = i % 16; *(u32x4*)(WupT + (size_t)r * KUP + 256 + c * 8) = (u32x4){0u, 0u, 0u, 0u}; }
    for (int i = gt; i < 1024 * 32; i += NGT) { const int r = i / 32, c = i % 32; *(u32x4*)(WupT + (size_t)(768 + r) * KUP + c * 8) = (u32x4){0u, 0u, 0u, 0u}; }
    bf16_t* XB = (bf16_t*)(ws + WS_XB);
    for (int i = gt; i < NTOK * DM / 8; i += NGT) { const f32x4 a = *(const f32x4*)(p.x + (size_t)i * 8), b = *(const f32x4*)(p.x + (size_t)i * 8 + 4);
        u32x4 o; o.x = pk2(a[0], a[1]); o.y = pk2(a[2], a[3]); o.z = pk2(b[0], b[1]); o.w = pk2(b[2], b[3]); *(u32x4*)(XB + (size_t)i * 8) = o; }
    { float* WRL = (float*)(ws + WS_WRL);
      for (int n = gt; n < 32768; n += NGT) { const int e = ((n >> 8) & 7) * 4 + (n & 3), ln = (n >> 2) & 63, ji = n >> 11, j = ji >> 2, i = ji & 3; WRL[n] = p.w_router[(size_t)(4 * ln + 256 * j + i) * 32 + e]; } }
    float* ropeA = (float*)(ws + WS_ROPEA); float* ropeB = (float*)(ws + WS_ROPEB);
    for (int i = gt; i < NTOK * 24; i += NGT) { const int tok = i / 24, j = i % 24; const double f = (j < 16) ? p.invfA[j] : p.invfB[j - 16];
        const double rev = (double)p.pos[tok] * f * 0.15915494309189535; const float fr = (float)(rev - __builtin_rint(rev));
        const float cs = __builtin_amdgcn_cosf(fr), sn = __builtin_amdgcn_sinf(fr);
        if (j < 16) { ropeA[(size_t)tok * 32 + j] = cs; ropeA[(size_t)tok * 32 + 16 + j] = sn; } else { ropeB[(size_t)tok * 16 + (j - 16)] = cs; ropeB[(size_t)tok * 16 + 8 + (j - 16)] = sn; } }
}

__device__ __forceinline__ void phase_prep(const Params& p, LAS unsigned char* lds, int vcu, int G) {
    const int tid = threadIdx.x, wave = tid >> 6, lane = tid & 63;
    unsigned char* ws = p.ws;
    const bf16_t* PROJ = (const bf16_t*)(ws + WS_PROJ);
    float* rstd = (float*)(ws + WS_RSTD); const float* ropeA = (const float*)(ws + WS_ROPEA); const float* ropeB = (const float*)(ws + WS_ROPEB);
    bf16_t* KM = (bf16_t*)(ws + WS_KM); bf16_t* QB = (bf16_t*)(ws + WS_QB); bf16_t* KB = (bf16_t*)(ws + WS_KB); float* kmean = (float*)(ws + WS_KMEAN);
    const int gw = vcu * NWAVES + wave, NGW = G * NWAVES;
    for (int row = gw; row < NTOK; row += NGW) {
        float s = 0.f;
        if (lane < 48) { const u32x4 v = *(const u32x4*)(PROJ + (size_t)row * PN + lane * 8);
#pragma unroll
            for (int q = 0; q < 4; ++q) { const float a = __uint_as_float(v[q] << 16), b = __uint_as_float(v[q] & 0xffff0000u); s += a * a + b * b; } }
#pragma unroll
        for (int o = 1; o < 32; o <<= 1) s += __shfl_xor(s, o);
        if (lane == 0) rstd[2 * row] = 1.0f / sqrtf(s * (1.0f / 256.0f) + RMS_EPS);
        if (lane == 32) rstd[2 * row + 1] = 1.0f / sqrtf(s * (1.0f / 128.0f) + RMS_EPS);
    }
    const int gt = vcu * NTHREADS + tid, NGT = G * NTHREADS;
    for (int i = gt; i < NTOK * 16; i += NGT) { const int tok = i >> 4, j = i & 15;
        const float x1 = bf2f(PROJ[(size_t)tok * PN + C_KR + j]), x2 = bf2f(PROJ[(size_t)tok * PN + C_KR + 16 + j]);
        const float c = ropeA[(size_t)tok * 32 + j], s = ropeA[(size_t)tok * 32 + 16 + j];
        const bf16_t o1 = (bf16_t)f2bf(x1 * c - x2 * s), o2 = (bf16_t)f2bf(x2 * c + x1 * s);
#pragma unroll
        for (int h = 0; h < 8; ++h) { KM[(size_t)tok * 768 + h * 96 + 64 + j] = o1; KM[(size_t)tok * 768 + h * 96 + 80 + j] = o2; } }
    LAS float* red = (LAS float*)lds;
    for (int unit = vcu; unit < 512; unit += G) {
        const int ub = unit >> 3, h = unit & 7, tg = tid >> 6, d = tid & 63, c = h * 64 + d; float ksum = 0.f;
#pragma unroll 4
        for (int i = 0; i < 32; ++i) { const int tok = ub * 256 + tg * 32 + i; const bf16_t* pr = PROJ + (size_t)tok * PN;
            float qv = bf2f(pr[C_MQ + c]), kv = bf2f(pr[C_MK + c]);
            if (d < 16) { const int j = d & 7; const float cs = ropeB[(size_t)tok * 16 + j], sn = ropeB[(size_t)tok * 16 + 8 + j];
                if (d < 8) { const float q2 = bf2f(pr[C_MQ + c + 8]), k2 = bf2f(pr[C_MK + c + 8]); qv = qv * cs - q2 * sn; kv = kv * cs - k2 * sn; }
                else { const float q1 = bf2f(pr[C_MQ + c - 8]), k1 = bf2f(pr[C_MK + c - 8]); qv = qv * cs + q1 * sn; kv = kv * cs + k1 * sn; } }
            QB[(size_t)tok * 512 + c] = (bf16_t)f2bf(qv * C2B); KB[(size_t)tok * 512 + c] = (bf16_t)f2bf(kv); ksum += kv; }
        red[tg * 64 + d] = ksum;
        __syncthreads();
        if (tid < 64) { float t = 0.f;
#pragma unroll
            for (int g8 = 0; g8 < 8; ++g8) t += red[g8 * 64 + tid];
            kmean[(size_t)ub * 512 + h * 64 + tid] = t * (1.0f / 256.0f); }
        __syncthreads();
    }
}

typedef float f32x16 __attribute__((ext_vector_type(16)));
typedef short s16x4 __attribute__((ext_vector_type(4)));
namespace fa {
constexpr int KBUF = 12288, VBUF = 8192, VOFF = 3 * KBUF, WS_OFF = VOFF + 3 * VBUF, KML_OFF = WS_OFF + 8 * 256, LDS_NEED = KML_OFF + 2048;
__device__ __forceinline__ void wait_vm(int n) {
    switch (n) {
#define FA_W(k) case k: asm volatile("s_waitcnt vmcnt(" #k ")" ::: "memory"); break;
        FA_W(0) FA_W(1) FA_W(2) FA_W(3) FA_W(4) FA_W(5) FA_W(6) FA_W(7) FA_W(8) FA_W(9) FA_W(10) FA_W(11) FA_W(12) FA_W(13) FA_W(14) FA_W(15)
#undef FA_W
        default: asm volatile("s_waitcnt vmcnt(15)" ::: "memory"); break; }
}
constexpr float THR = 8.0f;
__device__ __forceinline__ int crow(int r, int hi) { return (r & 3) + 8 * (r >> 2) + 4 * hi; }
__device__ __forceinline__ unsigned cvtpk(float lo, float hi) { typedef __bf16 bf2 __attribute__((ext_vector_type(2))); f32x2 v = {lo, hi}; bf2 b = __builtin_convertvector(v, bf2); return __builtin_bit_cast(unsigned, b); }
__device__ __forceinline__ float xhalf_max(float m) { auto rr = __builtin_amdgcn_permlane32_swap(__float_as_uint(m), __float_as_uint(m), false, false); return fmaxf(__uint_as_float(rr[0]), __uint_as_float(rr[1])); }
__device__ __forceinline__ float xhalf_sum(float m) { auto rr = __builtin_amdgcn_permlane32_swap(__float_as_uint(m), __float_as_uint(m), false, false); return __uint_as_float(rr[0]) + __uint_as_float(rr[1]); }
__device__ __forceinline__ float mx3(float a, float b, float c) { return __builtin_fmaxf(__builtin_fmaxf(a, b), c); }
}
template <int DQK, int VAR>
__device__ __forceinline__ void attn_unit(LAS unsigned char* lds, const bf16_t* Q, int qpitch, const bf16_t* K, int kpitch, const bf16_t* V, int vpitch, bf16_t* O, int qb, const float* kmean, const Params& p, BgConv& bg) {
    using namespace fa;
    constexpr int ND = DQK / 16, NCH = DQK / 8;
    const int tid = threadIdx.x, lane = tid & 63, r32 = lane & 31, hi = lane >> 5, wid = __builtin_amdgcn_readfirstlane(tid >> 6);
    const int q0 = qb * 256, qrel = wid * 32 + r32;
    LAS float* wsf = (LAS float*)(lds + WS_OFF) + wid * 64;
    bf16x8 qr[ND];
#pragma unroll
    for (int d0 = 0; d0 < ND; ++d0) qr[d0] = *(const bf16x8*)(Q + (size_t)(q0 + qrel) * qpitch + d0 * 16 + hi * 8);
    unsigned sel = 0xffu;
    if (kmean) { const int n = tid >> 6, d = tid & 63; if (n < qb) ((LAS float*)(lds + KML_OFF))[tid] = kmean[(size_t)n * 1024 + d] + kmean[(size_t)n * 1024 + 512 + d]; }
    const bf16_t* ksrc = K + (size_t)lane * kpitch;
    const bf16_t* vsrc = V + (size_t)(16 * (wid & 3) + (lane >> 2)) * vpitch + (wid >> 2) * 32 + (lane & 3) * 8;
#define FA_DMA(ti, kslot, vslot) do { \
        __builtin_amdgcn_global_load_lds((const unsigned*)(ksrc + (size_t)(ti) * 64 * kpitch + wid * 8), (LAS unsigned*)(lds + (kslot) * KBUF + wid * 1024), 16, 0, 0); \
        if (NCH > 8 && wid < NCH - 8) __builtin_amdgcn_global_load_lds((const unsigned*)(ksrc + (size_t)(ti) * 64 * kpitch + (wid + 8) * 8), (LAS unsigned*)(lds + (kslot) * KBUF + (wid + 8) * 1024), 16, 0, 0); \
        __builtin_amdgcn_global_load_lds((const unsigned*)(vsrc + (size_t)(ti) * 64 * vpitch), (LAS unsigned*)(lds + VOFF + (vslot) * VBUF + wid * 1024), 16, 0, 0); } while (0)
#define FA_TILE(i) (((i) < 4) ? 4 * qb + (i) : (i) - 4)
#define FA_PV(vslot) do { const LAS unsigned char* vb_ = lds + VOFF + (vslot) * VBUF + voff; \
        _Pragma("unroll") for (int d0 = 0; d0 < 2; ++d0) _Pragma("unroll") for (int s_ = 0; s_ < 4; ++s_) { \
            const s16x4 lo_ = __builtin_bit_cast(s16x4, __builtin_amdgcn_ds_read_tr16_b64_v4i16((LAS s16x4*)(vb_ + d0 * 4096 + s_ * 1024))); \
            const s16x4 hh_ = __builtin_bit_cast(s16x4, __builtin_amdgcn_ds_read_tr16_b64_v4i16((LAS s16x4*)(vb_ + d0 * 4096 + s_ * 1024 + 512))); \
            const bf16x8 vf_ = (bf16x8){lo_[0], lo_[1], lo_[2], lo_[3], hh_[0], hh_[1], hh_[2], hh_[3]}; \
            o[d0] = __builtin_amdgcn_mfma_f32_32x32x16_bf16(__builtin_bit_cast(bf16x8, pw[s_]), vf_, o[d0], 0, 0, 0); } } while (0)
    const int NT = 4 * qb + 4;
    float mhat = 0.f, l_reg = 0.f; f32x16 o[2]; o[0] = f32x16{}; o[1] = f32x16{}; f32x16 negm = f32x16{};
    const int koff = hi * 1024 + r32 * 16;
    const int voff = ((lane >> 4) & 1) * 32 + (lane & 3) * 8 + (4 * hi + ((lane & 15) >> 2)) * 64;
    u32x4 pw[4];
    const int nkv = (NCH > 8 && wid < NCH - 8) ? 3 : 2;
    FA_DMA(FA_TILE(0), 0, 0);
    if (NT > 1) { FA_DMA(FA_TILE(1), 1, 1); }
    wait_vm(NT > 1 ? nkv : 0); asm volatile("s_waitcnt lgkmcnt(0)" ::: "memory"); __builtin_amdgcn_s_barrier(); asm volatile("" ::: "memory");
    if (kmean) {
        float gt[8];
#pragma unroll
        for (int n = 0; n < 8; ++n) { float s = 0.f; const LAS float* km = (const LAS float*)(lds + KML_OFF) + n * 64;
            if (n < qb) {
#pragma unroll
                for (int d0 = 0; d0 < ND; ++d0) { const f32x4 k0 = *(const LAS f32x4*)(km + d0 * 16 + hi * 8), k1 = *(const LAS f32x4*)(km + d0 * 16 + hi * 8 + 4);
#pragma unroll
                    for (int j = 0; j < 4; ++j) { s = fmaf(bf2f((unsigned short)qr[d0][j]), k0[j], s); s = fmaf(bf2f((unsigned short)qr[d0][4 + j]), k1[j], s); } }
                s = xhalf_sum(s); }
            gt[n] = (n < qb) ? s : -INFINITY; }
        sel = 0u;
#pragma unroll
        for (int n = 0; n < 8; ++n) { int cnt = 0;
#pragma unroll
            for (int n2 = 0; n2 < 8; ++n2) if (n2 != n) cnt += (n2 < qb && (gt[n2] > gt[n] || (gt[n2] == gt[n] && n2 < n))) ? 1 : 0;
            if (n < qb && cnt < 3) sel |= 1u << n; }
    }
    int sl = 0, prevB = 0, opsPrev = 0;
    for (int i = 0; i < NT; ++i) {
        const int sl1 = (sl == 2) ? 0 : sl + 1, sl2 = (sl1 == 2) ? 0 : sl1 + 1;
        LAS unsigned char* bscr = lds + LDS_NEED + wid * 8192 + (bg.itc & 1) * 4096;
        int young = prevB, ops = 0;
        if (bg.itc & 1) { if (bg.pend1 >= 0) { wait_vm(opsPrev); expert_finish(p, bg.pend1, bscr, lane); bg.pend1 = -1; ops += 4; asm volatile("s_waitcnt lgkmcnt(0)" ::: "memory"); } }
        else            { if (bg.pend0 >= 0) { wait_vm(opsPrev); expert_finish(p, bg.pend0, bscr, lane); bg.pend0 = -1; ops += 4; asm volatile("s_waitcnt lgkmcnt(0)" ::: "memory"); } }
        if constexpr (VAR != 4) { if (i + 2 < NT) { const int tn = FA_TILE(i + 2); FA_DMA(tn, sl2, sl2); ops += nkv; } }
        const bool bgdo = (bg.itc % 3 != 2) && bg.next < NEXP_ITEMS;
        if (bgdo) { expert_issue(p, bg.next, bscr, lane); if (bg.itc & 1) bg.pend1 = bg.next; else bg.pend0 = bg.next; bg.next += bg.stride; ops += 4; }
        young += ops; prevB = bgdo ? 4 : 0;
        ++bg.itc;
        const bool band = i < 4;
        if (!(band && 2 * i > wid)) {
            const LAS unsigned char* kb = lds + sl * KBUF + koff;
            f32x16 p0 = negm, p1 = negm;
            if (kmean && !band) { if (!__all((sel >> ((i - 4) >> 2)) & 1u)) {
                    const bool ok = ((sel >> ((i - 4) >> 2)) & 1u) != 0u;
#pragma unroll
                    for (int r = 0; r < 16; ++r) p0[r] = ok ? negm[r] : -INFINITY;
                    p1 = p0; } }
#pragma unroll
            for (int d0 = 0; d0 < (VAR == 5 ? 1 : ND); ++d0) { const bf16x8 a0 = *(const LAS bf16x8*)(kb + d0 * 2048), a1 = *(const LAS bf16x8*)(kb + d0 * 2048 + 512);
                p0 = __builtin_amdgcn_mfma_f32_32x32x16_bf16(a0, qr[d0], p0, 0, 0, 0); p1 = __builtin_amdgcn_mfma_f32_32x32x16_bf16(a1, qr[d0], p1, 0, 0, 0); }
            if (band) { if (64 * i + 63 > 32 * wid) {
#pragma unroll
                    for (int r = 0; r < 16; ++r) { const int kv = 64 * i + crow(r, hi); if (kv > qrel) p0[r] = -INFINITY; if (kv + 32 > qrel) p1[r] = -INFINITY; } } }
            if constexpr (VAR != 1 && VAR != 3) {
            float ra = mx3(p0[0], p0[1], p1[0]), rb = mx3(p0[2], p0[3], p1[1]); ra = mx3(ra, p1[2], p1[3]);
#pragma unroll
            for (int r = 4; r < 16; r += 4) { ra = mx3(ra, p0[r], p0[r + 1]); rb = mx3(rb, p0[r + 2], p0[r + 3]); ra = mx3(ra, p1[r], p1[r + 1]); rb = mx3(rb, p1[r + 2], p1[r + 3]); }
            const float rm = xhalf_max(__builtin_fmaxf(ra, rb));
            if (i == 0 || __any(rm > THR)) {
                const float dl = (i == 0) ? rm : fmaxf(rm, 0.f); mhat += dl;
#pragma unroll
                for (int r = 0; r < 16; ++r) { p0[r] -= dl; p1[r] -= dl; negm[r] = -mhat; }
                if (i != 0) { const float f = __builtin_amdgcn_exp2f(-dl); l_reg *= f; if (hi == 0) wsf[r32] = f;
                    asm volatile("s_waitcnt lgkmcnt(0)" ::: "memory");
#pragma unroll
                    for (int r = 0; r < 16; ++r) { const float fr_ = wsf[crow(r, hi)]; o[0][r] *= fr_; o[1][r] *= fr_; } }
            }
            f32x2 sacc = {0.f, 0.f};
#pragma unroll
            for (int r = 0; r < 16; ++r) { p0[r] = __builtin_amdgcn_exp2f(p0[r]); p1[r] = __builtin_amdgcn_exp2f(p1[r]); }
#pragma unroll
            for (int r = 0; r < 16; r += 2) { sacc += (f32x2){p0[r], p0[r + 1]}; sacc += (f32x2){p1[r], p1[r + 1]}; }
            l_reg += sacc[0] + sacc[1];
            }
#pragma unroll
            for (int s = 0; s < 2; ++s)
#pragma unroll
                for (int j = 0; j < 4; ++j) { pw[s][j] = cvtpk(p0[8 * s + 2 * j], p0[8 * s + 2 * j + 1]); pw[2 + s][j] = cvtpk(p1[8 * s + 2 * j], p1[8 * s + 2 * j + 1]); }
            if constexpr (VAR != 2 && VAR != 3) { FA_PV(sl); } else { o[0][0] += __uint_as_float(pw[0][0] ^ pw[1][1] ^ pw[2][2] ^ pw[3][3]); }
        }
        asm volatile("s_waitcnt lgkmcnt(0)" ::: "memory"); wait_vm(young);
        __builtin_amdgcn_s_barrier(); asm volatile("" ::: "memory");
        sl = sl1; opsPrev = ops;
    }
    l_reg = xhalf_sum(l_reg);
    if (hi == 0) wsf[32 + r32] = l_reg;
    asm volatile("s_waitcnt lgkmcnt(0)" ::: "memory");
#pragma unroll
    for (int r = 0; r < 16; ++r) { const float rl = 1.0f / wsf[32 + crow(r, hi)]; bf16_t* op = O + (size_t)(q0 + wid * 32 + crow(r, hi)) * 1024 + r32;
        op[0] = (bf16_t)f2bf(o[0][r] * rl); op[32] = (bf16_t)f2bf(o[1][r] * rl); }
    asm volatile("s_waitcnt lgkmcnt(0)" ::: "memory"); __builtin_amdgcn_s_barrier(); asm volatile("" ::: "memory");
#undef FA_DMA
#undef FA_TILE
#undef FA_PV
}
template <int VAR>
__device__ __forceinline__ void phase_attn_fast(const Params& p, LAS unsigned char* lds, int vcu, int G, bool do_conv) {
    unsigned char* ws = p.ws;
    const bf16_t* QM = (const bf16_t*)(ws + WS_QM); const bf16_t* KM = (const bf16_t*)(ws + WS_KM); const bf16_t* VM = (const bf16_t*)(ws + WS_VM);
    const bf16_t* QB = (const bf16_t*)(ws + WS_QB); const bf16_t* KB = (const bf16_t*)(ws + WS_KB); const bf16_t* VB = (const bf16_t*)(ws + WS_VB);
    const float* kmean = (const float*)(ws + WS_KMEANP); bf16_t* ATT = (bf16_t*)(ws + WS_ATT);
    const int wave_ = __builtin_amdgcn_readfirstlane(threadIdx.x >> 6);
    BgConv bg; bg.next = do_conv ? vcu * NWAVES + wave_ : NEXP_ITEMS; bg.stride = G * NWAVES; bg.pend0 = -1; bg.pend1 = -1; bg.itc = 0;
    for (int su = vcu; su < 256; su += G) {
        const int bh = su >> 2, j = su & 3, b = bh >> 3, h = bh & 7; const size_t r0 = (size_t)b * SEQ;
#pragma unroll 1
        for (int k = 0; k < 2; ++k) { const int qb = k ? 7 - j : j;
            attn_unit<96, VAR>(lds, QM + r0 * 768 + h * 96, 768, KM + r0 * 768 + h * 96, 768, VM + r0 * 512 + h * 64, 512, ATT + r0 * 1024 + h * 64, qb, nullptr, p, bg);
            attn_unit<64, VAR>(lds, QB + r0 * 512 + h * 64, 512, KB + r0 * 512 + h * 64, 512, VB + r0 * 512 + h * 64, 512, ATT + r0 * 1024 + 512 + h * 64, qb, kmean + (size_t)(b * 8) * 1024 + h * 64, p, bg); }
    }
    { const int lane = threadIdx.x & 63; LAS unsigned char* bscr = lds + fa::LDS_NEED + wave_ * 8192;
      asm volatile("s_waitcnt vmcnt(0)" ::: "memory");
      if (bg.pend0 >= 0) { expert_finish(p, bg.pend0, bscr, lane); bg.pend0 = -1; }
      if (bg.pend1 >= 0) { expert_finish(p, bg.pend1, bscr + 4096, lane); bg.pend1 = -1; }
      asm volatile("s_waitcnt lgkmcnt(0)" ::: "memory");
#pragma unroll 1
      for (; bg.next < NEXP_ITEMS; bg.next += bg.stride) { expert_issue(p, bg.next, bscr, lane); asm volatile("s_waitcnt vmcnt(0)" ::: "memory"); expert_finish(p, bg.next, bscr, lane); asm volatile("s_waitcnt lgkmcnt(0)" ::: "memory"); } }
}

__device__ __forceinline__ float rs32(float (&a)[32], int lane) {
#pragma unroll
    for (int e = 0; e < 16; ++e) { auto rr = __builtin_amdgcn_permlane32_swap(__float_as_uint(a[e]), __float_as_uint(a[e + 16]), false, false); a[e] = __uint_as_float(rr[0]) + __uint_as_float(rr[1]); }
#pragma unroll
    for (int e = 0; e < 8; ++e) { auto rr = __builtin_amdgcn_permlane16_swap(__float_as_uint(a[e]), __float_as_uint(a[e + 8]), false, false); a[e] = __uint_as_float(rr[0]) + __uint_as_float(rr[1]); }
    { const bool bit = (lane & 8) != 0;
#pragma unroll
      for (int e = 0; e < 4; ++e) { const float keep = bit ? a[e + 4] : a[e], send = bit ? a[e] : a[e + 4]; a[e] = keep + __shfl_xor(send, 8); } }
    { const bool bit = (lane & 4) != 0;
#pragma unroll
      for (int e = 0; e < 2; ++e) { const float keep = bit ? a[e + 2] : a[e], send = bit ? a[e] : a[e + 2]; a[e] = keep + __shfl_xor(send, 4); } }
    { const bool bit = (lane & 2) != 0; const float keep = bit ? a[1] : a[0], send = bit ? a[0] : a[1]; a[0] = keep + __shfl_xor(send, 2); }
    return a[0] + __shfl_xor(a[0], 1);
}
__device__ __forceinline__ void route_row(const Params& p, float logit, int tok, int tl, int lane, int* tidx, float* tgate, LAS int* lidx, LAS float* sc) {
    const int me = lane >> 1;
    const float my = logit + p.b_router[me];
    if (!(lane & 1)) sc[me] = my;
    asm volatile("s_waitcnt lgkmcnt(0)" ::: "memory");
    int rank = 0;
#pragma unroll
    for (int e4 = 0; e4 < 8; ++e4) { const f32x4 v = *(const LAS f32x4*)(sc + 4 * e4);
#pragma unroll
        for (int k = 0; k < 4; ++k) rank += (v[k] > my || (v[k] == my && (4 * e4 + k) < me)) ? 1 : 0; }
    int ti[4];
#pragma unroll
    for (int k = 0; k < 4; ++k) { const unsigned long long bal = __ballot(rank == k && !(lane & 1)); ti[k] = (__ffsll((long long)bal) - 1) >> 1; }
    if (lane == 0) { const float t0 = sc[ti[0]], e1 = expf(sc[ti[1]] - t0), e2 = expf(sc[ti[2]] - t0), e3 = expf(sc[ti[3]] - t0); const float is = 1.0f / (1.0f + e1 + e2 + e3);
        *(f32x4*)(tgate + (size_t)tok * 4) = (f32x4){is, e1 * is, e2 * is, e3 * is};
        int* tp = tidx + (size_t)tok * 4; tp[0] = ti[0]; tp[1] = ti[1]; tp[2] = ti[2]; tp[3] = ti[3];
        lidx[tl * 4 + 0] = ti[0]; lidx[tl * 4 + 1] = ti[1]; lidx[tl * 4 + 2] = ti[2]; lidx[tl * 4 + 3] = ti[3]; }
}
__device__ __forceinline__ void phase_ln1_route(const Params& p, LAS unsigned char* lds, int vcu, int G) {
    const int tid = threadIdx.x, wave = tid >> 6, lane = tid & 63;
    unsigned char* ws = p.ws;
    float* X1 = p.out; const float* X1P = (const float*)(ws + WS_X1PRE); bf16_t* X1B = (bf16_t*)(ws + WS_X1B);
    int* tidx = (int*)(ws + WS_TIDX); float* tgate = (float*)(ws + WS_TGATE); unsigned* hist = (unsigned*)(ws + WS_HIST);
    LAS int* lidx = (LAS int*)(lds + ROWTAB_OFF);
    { const float* WRL = (const float*)(ws + WS_WRL);
      for (int i = tid; i < 8192; i += NTHREADS) *(LAS f32x4*)(lds + (size_t)i * 16) = *(const f32x4*)(WRL + (size_t)i * 4); }
    __syncthreads();
    const LAS float* Wl = (const LAS float*)lds + lane * 4;
    for (int chunk = vcu; chunk < NCHUNK; chunk += G) {
#pragma unroll 1
        for (int rp = 0; rp < 4; ++rp) {
            const int tl = wave * 8 + 2 * rp, tok = chunk * 64 + tl;
            f32x4 v0[4], v1[4]; float s0 = 0.f, s1 = 0.f;
#pragma unroll
            for (int j = 0; j < 4; ++j) { v0[j] = *(const f32x4*)(X1P + (size_t)tok * DM + 4 * lane + 256 * j); v1[j] = *(const f32x4*)(X1P + (size_t)(tok + 1) * DM + 4 * lane + 256 * j);
                s0 += (v0[j][0] + v0[j][1]) + (v0[j][2] + v0[j][3]); s1 += (v1[j][0] + v1[j][1]) + (v1[j][2] + v1[j][3]); }
            const float mean0 = wave_sum(s0) * (1.0f / DM), mean1 = wave_sum(s1) * (1.0f / DM); float q0 = 0.f, q1 = 0.f;
#pragma unroll
            for (int j = 0; j < 4; ++j) { v0[j] = v0[j] - mean0; v1[j] = v1[j] - mean1;
                q0 += (v0[j][0] * v0[j][0] + v0[j][1] * v0[j][1]) + (v0[j][2] * v0[j][2] + v0[j][3] * v0[j][3]); q1 += (v1[j][0] * v1[j][0] + v1[j][1] * v1[j][1]) + (v1[j][2] * v1[j][2] + v1[j][3] * v1[j][3]); }
            const float rs0 = 1.0f / sqrtf(wave_sum(q0) * (1.0f / DM) + LN_EPS), rs1 = 1.0f / sqrtf(wave_sum(q1) * (1.0f / DM) + LN_EPS);
#pragma unroll
            for (int j = 0; j < 4; ++j) { const f32x4 g = *(const f32x4*)(p.ln1_g + 4 * lane + 256 * j), bb = *(const f32x4*)(p.ln1_b + 4 * lane + 256 * j);
                v0[j] = v0[j] * rs0 * g + bb; v1[j] = v1[j] * rs1 * g + bb;
                u32x2 w; w.x = pk2(v0[j][0], v0[j][1]); w.y = pk2(v0[j][2], v0[j][3]); *(u32x2*)(X1B + (size_t)tok * DM + 4 * lane + 256 * j) = w;
                w.x = pk2(v1[j][0], v1[j][1]); w.y = pk2(v1[j][2], v1[j][3]); *(u32x2*)(X1B + (size_t)(tok + 1) * DM + 4 * lane + 256 * j) = w; }
            float a0[32], a1[32];
#pragma unroll
            for (int e = 0; e < 32; ++e) { a0[e] = 0.f; a1[e] = 0.f; }
            const LAS float* wlo = Wl; const LAS float* whi = Wl + 8 * 2048;
            asm volatile("" : "+v"(wlo), "+v"(whi));
#pragma unroll
            for (int j = 0; j < 4; ++j)
#pragma unroll
                for (int i = 0; i < 4; ++i) { const float x0 = v0[j][i], x1 = v1[j][i]; const LAS float* wb = (j < 2) ? wlo + (j * 4 + i) * 2048 : whi + ((j - 2) * 4 + i) * 2048;
#pragma unroll
                    for (int e4 = 0; e4 < 8; ++e4) { const f32x4 w = *(const LAS f32x4*)(wb + e4 * 256);
#pragma unroll
                        for (int k = 0; k < 4; ++k) { a0[4 * e4 + k] = fmaf(x0, w[k], a0[4 * e4 + k]); a1[4 * e4 + k] = fmaf(x1, w[k], a1[4 * e4 + k]); } }
                    asm volatile("" ::: "memory"); }
            const float l0 = rs32(a0, lane), l1 = rs32(a1, lane);
            LAS float* sc = (LAS float*)(lds + ROWTAB_OFF + 2048) + wave * 64;
            route_row(p, l0, tok, tl, lane, tidx, tgate, lidx, sc);
            route_row(p, l1, tok + 1, tl + 1, lane, tidx, tgate, lidx, sc + 32);
        }
        __syncthreads();
        if (tid < 32) { unsigned c = 0; for (int a = 0; a < 256; ++a) c += (lidx[a] == tid) ? 1u : 0u; hist[chunk * 32 + tid] = c; }
        __syncthreads();
    }
}

__device__ __forceinline__ void phase_assign(const Params& p, LAS unsigned char* lds, int vcu, int G) {
    const int tid = threadIdx.x;
    unsigned char* ws = p.ws;
    const int* tidx = (const int*)(ws + WS_TIDX); const float* tgate = (const float*)(ws + WS_TGATE); const unsigned* hist = (const unsigned*)(ws + WS_HIST);
    int* dest = (int*)(ws + WS_DEST); int* row_tok = (int*)(ws + WS_ROWTOK); float* row_gate = (float*)(ws + WS_ROWGATE); int* tile_e = (int*)(ws + WS_TILEE);
    LAS int* lidx = (LAS int*)lds;
    LAS int* lcnt = (LAS int*)(lds + 1024);
    LAS int* lpre = (LAS int*)(lds + 1024 + 128);
    LAS int* lstart = (LAS int*)(lds + 1024 + 256);
    LAS int* ptot = (LAS int*)(lds + 2048);
    LAS int* ppre = (LAS int*)(lds + 4096);
    for (int chunk = vcu; chunk < NCHUNK; chunk += G) {
        if (tid < 256) lidx[tid] = tidx[chunk * 256 + tid];
        { const int e = tid & 31, cg = tid >> 5; int tot = 0, pre = 0;
#pragma unroll
          for (int k = 0; k < 16; ++k) { const int c = cg * 16 + k; const int hv = (int)hist[c * 32 + e]; tot += hv; pre += (c < chunk) ? hv : 0; }
          ptot[cg * 32 + e] = tot; ppre[cg * 32 + e] = pre; }
        __syncthreads();
        if (tid < 32) { int tot = 0, pre = 0;
#pragma unroll
            for (int cg = 0; cg < 16; ++cg) { tot += ptot[cg * 32 + tid]; pre += ppre[cg * 32 + tid]; }
            lcnt[tid] = tot; lpre[tid] = pre; }
        __syncthreads();
        if (tid == 0) { int s2 = 0; for (int e = 0; e < 32; ++e) { lstart[e] = s2; s2 += (lcnt[e] + 255) / 256 * 256; } lstart[32] = s2; }
        __syncthreads();
        if (tid < 256) { const int e = lidx[tid]; int rank = 0; for (int a = 0; a < tid; ++a) rank += (lidx[a] == e) ? 1 : 0;
            const int P = lstart[e] + lpre[e] + rank, tok = chunk * 64 + (tid >> 2);
            row_tok[P] = tok; row_gate[P] = tgate[chunk * 256 + tid]; dest[chunk * 256 + tid] = P; }
        if (chunk < 32) { const int e = chunk; for (int P = lstart[e] + lcnt[e] + tid; P < lstart[e + 1]; P += NTHREADS) { row_tok[P] = 0; row_gate[P] = 0.f; } }
        if (chunk == 0) { if (tid < 32) { for (int t = lstart[tid] / 256; t < lstart[tid + 1] / 256; ++t) tile_e[t] = tid; } if (tid == 32) tile_e[MAXTILES] = lstart[32] / 256; }
        __syncthreads();
    }
}

__device__ __forceinline__ void phase_final(const Params& p, int vcu, int G, float* outp) {
    const int tid = threadIdx.x, wave = tid >> 6, lane = tid & 63;
    unsigned char* ws = p.ws;
    const int* dest = (const int*)(ws + WS_DEST); const bf16_t* Y = (const bf16_t*)(ws + WS_Y); const bf16_t* X1B = (const bf16_t*)(ws + WS_X1B);
    const int gw = vcu * NWAVES + wave, NGW = G * NWAVES;
    for (int t0 = gw * 8; t0 < NTOK; t0 += NGW * 8) {
        const int dl = (lane < 32) ? dest[t0 * 4 + lane] : 0;
#pragma unroll
        for (int pr = 0; pr < 4; ++pr) {
            const int tok = t0 + 2 * pr;
            int P[2][4];
#pragma unroll
            for (int t = 0; t < 2; ++t)
#pragma unroll
                for (int k = 0; k < 4; ++k) P[t][k] = __builtin_amdgcn_readlane(dl, (2 * pr + t) * 4 + k);
            f32x4 v[2][4]; u32x2 y[2][4][4];
#pragma unroll
            for (int t = 0; t < 2; ++t)
#pragma unroll
                for (int j = 0; j < 4; ++j) { const u32x2 xw = *(const u32x2*)(X1B + (size_t)(tok + t) * DM + 4 * lane + 256 * j);
                    v[t][j] = (f32x4){__uint_as_float(xw.x << 16), __uint_as_float(xw.x & 0xffff0000u), __uint_as_float(xw.y << 16), __uint_as_float(xw.y & 0xffff0000u)};
#pragma unroll
                    for (int k = 0; k < 4; ++k) y[t][k][j] = *(const u32x2*)(Y + (size_t)P[t][k] * 1024 + 4 * lane + 256 * j); }
            float s[2], q[2];
#pragma unroll
            for (int t = 0; t < 2; ++t) { s[t] = 0.f;
#pragma unroll
                for (int j = 0; j < 4; ++j) { v[t][j] = v[t][j] * DN_ALPHA;
#pragma unroll
                    for (int k = 0; k < 4; ++k) { const u32x2 w = y[t][k][j];
                        v[t][j][0] += __uint_as_float(w.x << 16); v[t][j][1] += __uint_as_float(w.x & 0xffff0000u); v[t][j][2] += __uint_as_float(w.y << 16); v[t][j][3] += __uint_as_float(w.y & 0xffff0000u); }
                    s[t] += (v[t][j][0] + v[t][j][1]) + (v[t][j][2] + v[t][j][3]); } }
            const float mean0 = wave_sum(s[0]) * (1.0f / DM), mean1 = wave_sum(s[1]) * (1.0f / DM);
            q[0] = 0.f; q[1] = 0.f;
#pragma unroll
            for (int j = 0; j < 4; ++j) { v[0][j] = v[0][j] - mean0; v[1][j] = v[1][j] - mean1;
                q[0] += (v[0][j][0] * v[0][j][0] + v[0][j][1] * v[0][j][1]) + (v[0][j][2] * v[0][j][2] + v[0][j][3] * v[0][j][3]);
                q[1] += (v[1][j][0] * v[1][j][0] + v[1][j][1] * v[1][j][1]) + (v[1][j][2] * v[1][j][2] + v[1][j][3] * v[1][j][3]); }
            const float rs0 = 1.0f / sqrtf(wave_sum(q[0]) * (1.0f / DM) + LN_EPS), rs1 = 1.0f / sqrtf(wave_sum(q[1]) * (1.0f / DM) + LN_EPS);
#pragma unroll
            for (int j = 0; j < 4; ++j) { const f32x4 g = *(const f32x4*)(p.ln2_g + 4 * lane + 256 * j), bb = *(const f32x4*)(p.ln2_b + 4 * lane + 256 * j);
                *(f32x4*)(outp + (size_t)tok * DM + 4 * lane + 256 * j) = v[0][j] * rs0 * g + bb;
                *(f32x4*)(outp + (size_t)(tok + 1) * DM + 4 * lane + 256 * j) = v[1][j] * rs1 * g + bb; }
        }
    }
}

constexpr int NPHASE = 11;
__global__ void __launch_bounds__(NTHREADS, 2) fwd_kernel(Params p) {
    extern __shared__ __attribute__((aligned(16))) unsigned char lds_raw[];
    LAS unsigned char* lds = (LAS unsigned char*)lds_raw;
    const int tid = threadIdx.x;
    const int G = gridDim.x, bx = blockIdx.x;
    const int vcu = (G % 8 == 0) ? (bx % 8) * (G / 8) + bx / 8 : bx;
    unsigned char* ws = p.ws;
    volatile LAS unsigned* MISC = (volatile LAS unsigned*)(lds + MISC_OFF);
    if (tid < 32) MISC[tid] = 0u;
    __syncthreads();
    XcdBarrier bar; bar.bar = (unsigned*)(ws + WS_CTL) + CW_BAR; bar.x = 0; bar.st = nullptr;
    const bool one = (p.ph_hi - p.ph_lo) > 1;
    if (one) bar = xcd_barrier_post((unsigned*)(ws + WS_CTL) + CW_BAR, MISC + 8);
    const int lo = p.ph_lo, hi = p.ph_hi;
#ifdef ONLY_PHASE
#define IN(k) ((k) == ONLY_PHASE && lo <= (k) && (k) < hi)
#else
#define IN(k) (lo <= (k) && (k) < hi)
#endif
#ifndef NAIVE_GEMM_MASK
#define NAIVE_GEMM_MASK 0
#endif
#define GEMM_CALL(EPI, SCHED) do { if constexpr (NAIVE_GEMM_MASK != 0) gemm_phase_naive<EPI, SCHED>(lds, g, S, E); else gemm_phase<EPI, SCHED, true>(lds, g, S, E); } while (0)
#ifndef ATTN_VAR
#define ATTN_VAR 0
#endif
#ifndef REPEAT_PHASE
#define REPEAT_PHASE (-1)
#endif
#define SEAM(k) do { if (IN(k) && IN((k) == 1 ? 3 : (k) + 1)) xcd_barrier(bar); } while (0)

#define PHASE(k, ...) do { if (IN(k)) { if constexpr (REPEAT_PHASE == (k)) { __VA_ARGS__; xcd_barrier(bar); } __VA_ARGS__; } SEAM(k); } while (0)
    PHASE(0, phase_prologue(p, lds, vcu, G));
    PHASE(1, { GemmArgs g{(const bf16_t*)(ws + WS_XB), 1024, (const bf16_t*)(ws + WS_WIN), 1024, 1024}; DenseSched S; S.init(lds, NTOK, PN, G, vcu);
        EpiProj E{ws}; GEMM_CALL(EpiProj, DenseSched); });
    PHASE(3, { { GemmArgs g{(const bf16_t*)(ws + WS_LAT), KUP, (const bf16_t*)(ws + WS_WUP), KUP, 256}; DenseSched S; S.init(lds, NTOK, 768, G, vcu);
          EpiUp E{(bf16_t*)(ws + WS_QM), (bf16_t*)(ws + WS_KM), (bf16_t*)(ws + WS_VM), (const float*)(ws + WS_RSTDP), (const float*)(ws + WS_ROPEA), 0}; GEMM_CALL(EpiUp, DenseSched); }
        { GemmArgs g{(const bf16_t*)(ws + WS_LAT) + 256, KUP, (const bf16_t*)(ws + WS_WUP) + (size_t)768 * KUP + 256, KUP, 128}; DenseSched S; S.init(lds, NTOK, 1024, G, (vcu + 192) % G);
          EpiUp E{(bf16_t*)(ws + WS_QM), (bf16_t*)(ws + WS_KM), (bf16_t*)(ws + WS_VM), (const float*)(ws + WS_RSTDP), (const float*)(ws + WS_ROPEA), 24}; GEMM_CALL(EpiUp, DenseSched); } });
    if constexpr (REPEAT_PHASE == 44) { if (IN(4)) { phase_attn_fast<ATTN_VAR>(p, lds, vcu, G, false); xcd_barrier(bar); } }
    PHASE(4, phase_attn_fast<0>(p, lds, vcu, G, true));
    PHASE(5, { GemmArgs g{(const bf16_t*)(ws + WS_ATT), 1024, (const bf16_t*)(ws + WS_WO), 1024, 1024}; DenseSched S; S.init(lds, NTOK, DM, G, vcu);
        EpiWo E{p.x, (float*)(ws + WS_X1PRE)}; GEMM_CALL(EpiWo, DenseSched); });
    PHASE(6, phase_ln1_route(p, lds, vcu, G));
    PHASE(7, phase_assign(p, lds, vcu, G));
    PHASE(8, { GemmArgs g{(const bf16_t*)(ws + WS_X1B), 1024, (const bf16_t*)(ws + WS_WGU), 1024, 1024}; GroupSched<true> S; S.init(lds, (const int*)(ws + WS_TILEE), (const int*)(ws + WS_ROWTOK), 8, 2048, G, vcu);
        EpiGateUp E{(bf16_t*)(ws + WS_H), p.b_gate, p.b_up}; GEMM_CALL(EpiGateUp, GroupSched<true>); });
    PHASE(9, { GemmArgs g{(const bf16_t*)(ws + WS_H), 1024, (const bf16_t*)(ws + WS_WD), 1024, 1024}; GroupSched<false> S; S.init(lds, (const int*)(ws + WS_TILEE), (const int*)(ws + WS_ROWTOK), 4, 1024, G, vcu);
        EpiDown E{(bf16_t*)(ws + WS_Y), p.b_down, (const float*)(ws + WS_ROWGATE)}; GEMM_CALL(EpiDown, GroupSched<false>); });
    if (IN(10)) { if constexpr (REPEAT_PHASE == 10) { phase_final(p, vcu, G, (float*)(ws + WS_X1PRE)); xcd_barrier(bar); } phase_final(p, vcu, G, p.out); }
#undef IN
#undef SEAM
}

extern "C" void kernel_launch(void* const* d_in, const int* in_sizes, int n_in, void* d_out, int out_size, void* d_ws, size_t ws_size, hipStream_t stream) {
    static int grid = 0;
    if (grid == 0) {
        if (n_in != 20 || out_size != NTOK * DM || ws_size < WS_END) { fprintf(stderr, "kernel_launch: unexpected shapes (n_in %d out %d ws %zu)\n", n_in, out_size, ws_size); grid = -1; return; }
        int dev = 0, cus = 0, per_cu = 0;
        if (hipGetDevice(&dev) != hipSuccess || hipDeviceGetAttribute(&cus, hipDeviceAttributeMultiprocessorCount, dev) != hipSuccess) { grid = -1; return; }
        if (hipFuncSetAttribute((const void*)fwd_kernel, hipFuncAttributeMaxDynamicSharedMemorySize, LDS_BYTES) != hipSuccess) { fprintf(stderr, "kernel_launch: hipFuncSetAttribute failed\n"); grid = -1; return; }
        if (hipOccupancyMaxActiveBlocksPerMultiprocessor(&per_cu, (const void*)fwd_kernel, NTHREADS, LDS_BYTES) != hipSuccess || per_cu < 1) fprintf(stderr, "kernel_launch: occupancy query says %d\n", per_cu);
        (void)hipGetLastError();
        grid = cus;
    }
    if (grid < 0) return;
    (void)hipMemsetAsync((char*)d_ws + WS_CTL, 0, CTL_ZERO_BYTES, stream);
    Params p{};
    p.x = (const float*)d_in[0]; p.pos = (const int*)d_in[1]; p.w_in = (const float*)d_in[2]; p.q_a_norm = (const float*)d_in[3]; p.w_q_b = (const float*)d_in[4];
    p.kv_a_norm = (const float*)d_in[5]; p.w_kv_b = (const float*)d_in[6]; p.w_o = (const float*)d_in[7]; p.ln1_g = (const float*)d_in[8]; p.ln1_b = (const float*)d_in[9];
    p.w_router = (const float*)d_in[10]; p.b_router = (const float*)d_in[11]; p.w_gate = (const float*)d_in[12]; p.b_gate = (const float*)d_in[13];
    p.w_up = (const float*)d_in[14]; p.b_up = (const float*)d_in[15]; p.w_down = (const float*)d_in[16]; p.b_down = (const float*)d_in[17];
    p.ln2_g = (const float*)d_in[18]; p.ln2_b = (const float*)d_in[19];
    p.out = (float*)d_out; p.ws = (unsigned char*)d_ws;
    for (int i = 0; i < 16; ++i) p.invfA[i] = pow(500000.0, -(double)(2 * i) / 32.0);
    for (int i = 0; i < 8; ++i) p.invfB[i] = pow(500000.0, -(double)(2 * i) / 16.0);
#if MK_ONE_LAUNCH
    p.ph_lo = 0; p.ph_hi = NPHASE;
    hipLaunchKernelGGL(fwd_kernel, dim3(grid), dim3(NTHREADS), LDS_BYTES, stream, p);
#else
    for (int ph = 0; ph < NPHASE; ++ph) { p.ph_lo = ph; p.ph_hi = ph + 1; hipLaunchKernelGGL(fwd_kernel, dim3(grid), dim3(NTHREADS), LDS_BYTES, stream, p); }
#endif
}
```

```cpp
#include <hip/hip_runtime.h>
#include <cstdio>
#include <cstdint>
#include <cmath>

#ifndef MK_ONE_LAUNCH
#define MK_ONE_LAUNCH 1
#endif

#define GAS __attribute__((address_space(1)))
#define LAS __attribute__((address_space(3)))
typedef unsigned short bf16_t;
typedef short bf16x8 __attribute__((ext_vector_type(8)));
typedef float f32x4 __attribute__((ext_vector_type(4)));
typedef float f32x2 __attribute__((ext_vector_type(2)));
typedef unsigned u32x4 __attribute__((ext_vector_type(4)));
typedef unsigned u32x2 __attribute__((ext_vector_type(2)));

constexpr int NTOK = 16384, DM = 1024, SEQ = 2048, NBATCH = 8;
constexpr int PN = 2048;
constexpr int C_QL = 0, C_KVL = 256, C_KR = 384, C_MQ = 416, C_MK = 928, C_MV = 1440, IN_COLS = 1952;
constexpr int NUP = 1792, KUP = 384;
constexpr int NE = 32, TOPK = 4;
constexpr int MAXROWS = 65536 + NE * 256, MAXTILES = MAXROWS / 256;
constexpr int NCHUNK = NTOK / 64;
constexpr float LN_EPS = 1e-5f, RMS_EPS = 1e-6f;
constexpr float DN_ALPHA = 1.189207115002721f;
constexpr float LOG2E = 1.4426950408889634f;
constexpr float C2A = 0.10206207261596575f * LOG2E;
constexpr float C2B = 0.125f * LOG2E;
constexpr int NWAVES = 8, NTHREADS = 512;

constexpr size_t MiB = 1u << 20;
constexpr size_t WS_CTL = 0, CTL_ZERO_BYTES = 1 * MiB;
constexpr size_t WS_HIST = 1 * MiB;
constexpr size_t WS_TIDX = WS_HIST + 64 * 1024;
constexpr size_t WS_TGATE = WS_TIDX + 256 * 1024;
constexpr size_t WS_DEST = WS_TGATE + 256 * 1024;
constexpr size_t WS_ROWTOK = WS_DEST + 256 * 1024;
constexpr size_t WS_ROWGATE = WS_ROWTOK + 288 * 1024;
constexpr size_t WS_TILEE = WS_ROWGATE + 288 * 1024;
constexpr size_t WS_RSTD = WS_TILEE + 4 * 1024;
constexpr size_t WS_KMEAN = WS_RSTD + 128 * 1024;
constexpr size_t WS_WRL = WS_KMEAN + 128 * 1024;
static_assert(WS_WRL + 128 * 1024 <= 4 * MiB, "route region");
constexpr size_t WS_ROPEA = 4 * MiB;
constexpr size_t WS_ROPEB = 6 * MiB;
constexpr size_t WS_WIN = 8 * MiB;
constexpr size_t WS_WO = 12 * MiB;
constexpr size_t WS_WUP = 14 * MiB;
constexpr size_t WS_X1B = 16 * MiB;
constexpr size_t WS_WD = 48 * MiB;
constexpr size_t WS_XB = 112 * MiB;
constexpr size_t WS_PROJ = 144 * MiB;
constexpr size_t WS_QM = 208 * MiB;
constexpr size_t WS_KM = 232 * MiB;
constexpr size_t WS_VM = 256 * MiB;
constexpr size_t WS_QB = 272 * MiB;
constexpr size_t WS_KB = 288 * MiB;
constexpr size_t WS_ATT = 304 * MiB;
constexpr size_t WS_H = 112 * MiB;
constexpr size_t WS_WGU = 336 * MiB;
constexpr size_t WS_Y = 336 * MiB;
constexpr size_t WS_LAT = 144 * MiB;
constexpr size_t WS_VB = 160 * MiB;
constexpr size_t WS_RSTDP = 176 * MiB;
constexpr size_t WS_KMEANP = 177 * MiB;
constexpr size_t WS_X1PRE = 144 * MiB;
constexpr size_t WS_END = 480 * MiB;
static_assert(WS_H + (size_t)MAXROWS * 1024 * 2 <= WS_VM + 0 * MiB + 0 && WS_Y + (size_t)MAXROWS * 1024 * 2 <= WS_END, "ws map");
constexpr int CW_BAR = 4096;

constexpr int LDS_BYTES = 147456;
constexpr int MISC_OFF = 131072 + 320;

__device__ __forceinline__ float bf2f(unsigned v) { return __uint_as_float(v << 16); }
__device__ __forceinline__ unsigned f2bf(float f) { unsigned u = __float_as_uint(f); return (u + 0x7fffu + ((u >> 16) & 1u)) >> 16; }
__device__ __forceinline__ unsigned pk2(float lo, float hi) { typedef __bf16 bf2_t __attribute__((ext_vector_type(2))); f32x2 v = {lo, hi}; bf2_t b = __builtin_convertvector(v, bf2_t); return __builtin_bit_cast(unsigned, b); }
__device__ __forceinline__ float wave_sum(float v) {
#pragma unroll
    for (int o = 1; o < 64; o <<= 1) v += __shfl_xor(v, o);
    return v;
}
__device__ __forceinline__ float wave_max(float v) {
#pragma unroll
    for (int o = 1; o < 64; o <<= 1) v = fmaxf(v, __shfl_xor(v, o));
    return v;
}

#define XB_TMO      128
#define XB_XCNT(j)  (256  + 64 * (j))
#define XB_XSUB(j)  (1280 + 64 * (j))
#define XB_XGEN(j)  (2304 + 64 * (j))
#define XB_TOP      3328
#define XB_TOPGEN   3392
#define XCD_BAR_WORDS 3456
#define XB_SPIN_CAP (1u << 18)
__device__ __forceinline__ unsigned xb_ld(unsigned* p)              { return __hip_atomic_load(p, __ATOMIC_RELAXED, __HIP_MEMORY_SCOPE_AGENT); }
__device__ __forceinline__ unsigned xb_add(unsigned* p, unsigned v) { return __hip_atomic_fetch_add(p, v, __ATOMIC_RELAXED, __HIP_MEMORY_SCOPE_AGENT); }
__device__ __forceinline__ unsigned xb_xcc_id() { return (unsigned)__builtin_amdgcn_s_getreg((3 << 11) | 20) & 0xFu; }
#define XB_SPIN(cond, bar) do { unsigned _sp = 0; while (cond) { __builtin_amdgcn_s_sleep(1); \
    if ((++_sp & 255u) == 0u) { if (xb_ld(&(bar)[XB_TMO])) break; if (_sp > XB_SPIN_CAP) { atomicAdd(&(bar)[XB_TMO], 1u); break; } } } } while (0)
struct XcdBarrier { unsigned* bar; unsigned x; volatile LAS unsigned* st; };
__device__ __forceinline__ XcdBarrier xcd_barrier_post(unsigned* bar, volatile LAS unsigned* st) {
    XcdBarrier b; b.bar = bar; b.x = xb_xcc_id(); b.st = st;
    if (threadIdx.x == 0) (void)xb_add(&bar[XB_XCNT(b.x)], 1u);
    return b;
}
__device__ __forceinline__ void xcd_barrier_complete(unsigned* bar, unsigned x, unsigned& nloc, unsigned& nx) {
    const unsigned G = gridDim.x * gridDim.y * gridDim.z;
    unsigned sum, cnt, mine, sp = 0u;
    for (;;) {
        sum = 0u; cnt = 0u; mine = 0u;
#pragma unroll
        for (unsigned j = 0; j < 16; ++j) { const unsigned c = xb_ld(&bar[XB_XCNT(j)]); sum += c; cnt += (c > 0u) ? 1u : 0u; mine = (j == x) ? c : mine; }
        if (sum == G) break;
        __builtin_amdgcn_s_sleep(1);
        if ((++sp & 255u) == 0u) { if (xb_ld(&bar[XB_TMO])) break; if (sp > XB_SPIN_CAP) { atomicAdd(&bar[XB_TMO], 1u); break; } }
    }
    nloc = mine > 0u ? mine : 1u; nx = cnt > 0u ? cnt : 1u;
}
__device__ __forceinline__ void xcd_barrier(const XcdBarrier& b) {
    asm volatile("s_waitcnt vmcnt(0)" ::: "memory");
    __syncthreads();
    if (threadIdx.x == 0) {
        unsigned* bar = b.bar;
        __builtin_amdgcn_s_waitcnt(0);
        unsigned nloc = b.st[0], nx = b.st[1];
        if (nloc == 0u) { xcd_barrier_complete(bar, b.x, nloc, nx); b.st[0] = nloc; b.st[1] = nx; }
        const unsigned old = xb_add(&bar[XB_XSUB(b.x)], 1u);
        const unsigned gen = old / nloc;
        if (old + 1u == (gen + 1u) * nloc) {
            __builtin_amdgcn_fence(__ATOMIC_RELEASE, "agent");
            asm volatile("s_waitcnt vmcnt(0)" ::: "memory");
            const unsigned og = xb_add(&bar[XB_TOP], 1u);
            const unsigned tg = og / nx;
            if (og + 1u == (tg + 1u) * nx) xb_add(&bar[XB_TOPGEN], 1u);
            else XB_SPIN(xb_ld(&bar[XB_TOPGEN]) == tg, bar);
            __builtin_amdgcn_fence(__ATOMIC_ACQUIRE, "agent");
            xb_add(&bar[XB_XGEN(b.x)], 1u);
            asm volatile("s_waitcnt vmcnt(0)" ::: "memory");
        } else {
            XB_SPIN(xb_ld(&bar[XB_XGEN(b.x)]) == gen, bar);
            __builtin_amdgcn_fence(__ATOMIC_ACQUIRE, "agent");
            asm volatile("s_waitcnt vmcnt(0)" ::: "memory");
        }
    }
    __syncthreads();
}

struct Params {
    const float* x; const int* pos;
    const float *w_in, *q_a_norm, *w_q_b, *kv_a_norm, *w_kv_b, *w_o, *ln1_g, *ln1_b, *w_router, *b_router;
    const float *w_gate, *b_gate, *w_up, *b_up, *w_down, *b_down, *ln2_g, *ln2_b;
    float* out; unsigned char* ws;
    double invfA[16]; double invfB[8];
    int ph_lo, ph_hi;
};

struct Unit { int pm, pn, e; };
struct GemmArgs { const bf16_t* A; int lda; const bf16_t* Bt; int ldb; int K; };
template <bool PERM> __device__ __forceinline__ int ecol(int bj, int n, int wc, int fq) { return 128 * bj + 32 * wc + (PERM ? 8 * fq + 4 * n : 16 * n + 4 * fq); }

template <class Epi, class Sched>
__device__ __forceinline__ void gemm_phase_naive(LAS unsigned char* lds, const GemmArgs g, const Sched& S, const Epi& E) {
    const int tid = threadIdx.x, wid = __builtin_amdgcn_readfirstlane(tid >> 6), lane = tid & 63, wr = wid >> 2, wc = wid & 3, fr = lane & 15, fq = lane >> 4;
    Unit u;
    for (int ui = 0; S.next(ui, u); ++ui) {
        f32x4 acc[2][2][4][2];
#pragma unroll
        for (int a = 0; a < 2; ++a)
#pragma unroll
            for (int b = 0; b < 2; ++b)
#pragma unroll
                for (int m = 0; m < 4; ++m)
#pragma unroll
                    for (int n = 0; n < 2; ++n) acc[a][b][m][n] = (f32x4){0.f, 0.f, 0.f, 0.f};
        unsigned aoff[2][4];
#pragma unroll
        for (int a = 0; a < 2; ++a)
#pragma unroll
            for (int m = 0; m < 4; ++m) aoff[a][m] = (unsigned)S.arow(u, ui, 128 * a + 64 * wr + 16 * m + fr) * (unsigned)g.lda;
        const bf16_t* bb = g.Bt + (size_t)(S.brow0(u) + 32 * wc) * g.ldb;
        const unsigned bl0 = (unsigned)(4 * fq) * (unsigned)g.ldb, bl1 = (unsigned)(8 * fq) * (unsigned)g.ldb;
#pragma unroll 1
        for (int k = 0; k < g.K; k += 2) {
            float af[2][4][2];
#pragma unroll
            for (int a = 0; a < 2; ++a)
#pragma unroll
                for (int m = 0; m < 4; ++m) { const unsigned v = *(const unsigned*)(g.A + aoff[a][m] + k); af[a][m][0] = __uint_as_float(v << 16); af[a][m][1] = __uint_as_float(v & 0xffff0000u); }
#pragma unroll
            for (int b = 0; b < 2; ++b)
#pragma unroll
                for (int n = 0; n < 2; ++n)
#pragma unroll
                    for (int j = 0; j < 4; ++j) {
                        const int ccol = 128 * b + (Epi::PERM ? 4 * n : 16 * n) + j;
                        const unsigned v = *(const unsigned*)(bb + (size_t)ccol * g.ldb + ((Epi::PERM ? bl1 : bl0) + (unsigned)k));
                        const float b0 = __uint_as_float(v << 16), b1 = __uint_as_float(v & 0xffff0000u);
#pragma unroll
                        for (int a = 0; a < 2; ++a)
#pragma unroll
                            for (int m = 0; m < 4; ++m) acc[a][b][m][n][j] = fmaf(af[a][m][1], b1, fmaf(af[a][m][0], b0, acc[a][b][m][n][j]));
                    }
        }
        E(acc, u, wr, wc, fr, fq);
    }
}

namespace pg {
constexpr int BK = 64, HALF = 128, HTB = HALF * BK * 2;
__device__ __forceinline__ int lds_byte(int r, int c) { const int st = (r >> 4) * 2 + (c >> 5), rr = r & 15, cc = c & 31, ob = rr * 64 + cc * 2; return st * 1024 + (ob ^ (((ob >> 9) & 1) << 5)); }
__device__ __forceinline__ void stage_rc(int b, int& R, int& C) { const int st = b / 1024, sb = b % 1024, swz = sb ^ (((sb >> 9) & 1) << 5); R = (st >> 1) * 16 + swz / 64; C = (st & 1) * 32 + (swz % 64) / 2; }
__device__ __forceinline__ int perm32(int rho) { const int n = rho >> 4, i = rho & 15; return 8 * (i >> 2) + 4 * n + (i & 3); }
}
template <class Epi, class Sched, bool ALIGN_EPI>
__device__ __forceinline__ void gemm_phase(LAS unsigned char* lds, const GemmArgs g, const Sched& S, const Epi& E) {
    using namespace pg;
    const int tid = threadIdx.x, wid = __builtin_amdgcn_readfirstlane(tid >> 6), lane = tid & 63, wr = wid >> 2, wc = wid & 3, fr = lane & 15, fq = lane >> 4;
    const int nt = g.K / BK;
    int sR[2], sC[2], sRb[2];
#pragma unroll
    for (int i = 0; i < 2; ++i) { int R, C; stage_rc(tid * 16 + i * 8192, R, C); sR[i] = R; sC[i] = C; sRb[i] = Epi::PERM ? ((R & ~31) + perm32(R & 31)) : R; }
    const unsigned ldsw = (unsigned)wid * 1024u;
    const int aoff = lds_byte(wr * 64 + fr, fq * 8), boff = lds_byte(wc * 32 + fr, fq * 8);
    const char* Ab = (const char*)g.A; const char* Bb = (const char*)g.Bt;
#define PG_SA(b, h) (((b) * 2 + (h)) * HTB)
#define PG_SB(b, h) ((4 + (b) * 2 + (h)) * HTB)
#define PG_STAGE(bufoff, gptr, v0, v1) do { \
        __builtin_amdgcn_global_load_lds((const unsigned*)((gptr) + (v0)), (LAS unsigned*)(lds + (bufoff) + ldsw), 16, 0, 0); \
        __builtin_amdgcn_global_load_lds((const unsigned*)((gptr) + (v1)), (LAS unsigned*)(lds + (bufoff) + ldsw + 8192), 16, 0, 0); } while (0)
#define PG_LDA(dst, b, h) do { _Pragma("unroll") for (int m = 0; m < 4; ++m) _Pragma("unroll") for (int k = 0; k < 2; ++k) dst[m][k] = *(const LAS bf16x8*)(lds + PG_SA(b, h) + aoff + m * 2048 + k * 1024); } while (0)
#define PG_LDB(dst, b, h) do { _Pragma("unroll") for (int n = 0; n < 2; ++n) _Pragma("unroll") for (int k = 0; k < 2; ++k) dst[n][k] = *(const LAS bf16x8*)(lds + PG_SB(b, h) + boff + n * 2048 + k * 1024); } while (0)
#define PG_MMA(ai, bj, At, Bt) do { __builtin_amdgcn_s_setprio(1); _Pragma("unroll") for (int m = 0; m < 4; ++m) _Pragma("unroll") for (int n = 0; n < 2; ++n) _Pragma("unroll") for (int k = 0; k < 2; ++k) \
        acc[ai][bj][m][n] = __builtin_amdgcn_mfma_f32_16x16x32_bf16(Bt[n][k], At[m][k], acc[ai][bj][m][n], 0, 0, 0); __builtin_amdgcn_s_setprio(0); } while (0)
#define PG_WAIT_V(n) asm volatile("s_waitcnt vmcnt(" #n ")" ::: "memory")
#define PG_WAIT_L(n) asm volatile("s_waitcnt lgkmcnt(" #n ")" ::: "memory")
#define PG_BAR __builtin_amdgcn_s_barrier()
#define PG_SCHED __builtin_amdgcn_sched_barrier(0)
    constexpr bool GA = Sched::GATHER;
    unsigned cA[2], cB[2];
#pragma unroll
    for (int i = 0; i < 2; ++i) { cA[i] = ((unsigned)sR[i] * (unsigned)g.lda + (unsigned)sC[i]) * 2u; cB[i] = ((unsigned)sRb[i] * (unsigned)g.ldb + (unsigned)sC[i]) * 2u; }
    const size_t hA = (size_t)128 * g.lda * 2, hB = (size_t)128 * g.ldb * 2;
#define PG_GOFFS(u, uidx, VA) do { if constexpr (GA) { _Pragma("unroll") for (int h = 0; h < 2; ++h) _Pragma("unroll") for (int i = 0; i < 2; ++i) \
        VA[h][i] = ((unsigned)S.arow(u, uidx, 128 * h + sR[i]) * (unsigned)g.lda + (unsigned)sC[i]) * 2u; } } while (0)
#define PG_UA(u) (GA ? (size_t)0 : (size_t)S.arow(u, 0, 0) * g.lda * 2)
#define PG_UB(u) ((size_t)S.brow0(u) * g.ldb * 2)
#define PG_STAGE_A(bufoff, ab, VA, h) do { if constexpr (GA) { PG_STAGE(bufoff, (ab), VA[h][0], VA[h][1]); } else { PG_STAGE(bufoff, (ab) + (h) * hA, cA[0], cA[1]); } } while (0)
#define PG_STAGE_B(bufoff, bb, h) PG_STAGE(bufoff, (bb) + (h) * hB, cB[0], cB[1])
    Unit cur, nxt; int ui = 0;
    if (!S.next(0, cur)) return;
    f32x4 acc[2][2][4][2];
#pragma unroll
    for (int a = 0; a < 2; ++a)
#pragma unroll
        for (int b = 0; b < 2; ++b)
#pragma unroll
            for (int m = 0; m < 4; ++m)
#pragma unroll
                for (int n = 0; n < 2; ++n) acc[a][b][m][n] = (f32x4){0.f, 0.f, 0.f, 0.f};
    bf16x8 At[4][2], B0[2][2], B1[2][2];
    unsigned vA[2][2], nvA[2][2];
    PG_GOFFS(cur, 0, vA);
    const char* cAp = Ab + PG_UA(cur); const char* cBp = Bb + PG_UB(cur);
    PG_STAGE_B(PG_SB(0, 0), cBp, 0); PG_STAGE_B(PG_SB(0, 1), cBp, 1); PG_STAGE_A(PG_SA(0, 0), cAp, vA, 0); PG_STAGE_A(PG_SA(0, 1), cAp, vA, 1);
    if (wr == 1) PG_BAR;
    PG_WAIT_V(2); PG_BAR;
    PG_STAGE_B(PG_SB(1, 0), cBp + 128, 0); PG_STAGE_A(PG_SA(1, 0), cAp + 128, vA, 0); PG_STAGE_B(PG_SB(1, 1), cBp + 128, 1);
    PG_WAIT_V(6); PG_BAR;
    for (;;) {
        const bool has_next = S.next(ui + 1, nxt);
        const char* nAp = cAp; const char* nBp = cBp;
        if (has_next) { PG_GOFFS(nxt, ui + 1, nvA); nAp = Ab + PG_UA(nxt); nBp = Bb + PG_UB(nxt); }
        else { if constexpr (GA) {
#pragma unroll
            for (int h = 0; h < 2; ++h)
#pragma unroll
                for (int i = 0; i < 2; ++i) nvA[h][i] = vA[h][i]; } }
#pragma unroll 1
        for (int t = 0; t < nt; t += 2) {
            const bool last = (t == nt - 2);
            const char* a1 = cAp + (size_t)(t + 1) * 128;
            const char* a2 = last ? nAp : cAp + (size_t)(t + 2) * 128; const char* b2 = last ? nBp : cBp + (size_t)(t + 2) * 128;
            const char* a3 = a2 + 128; const char* b3 = b2 + 128;
            unsigned wA[2][2];
            if constexpr (GA) {
#pragma unroll
                for (int h = 0; h < 2; ++h)
#pragma unroll
                    for (int i = 0; i < 2; ++i) wA[h][i] = last ? nvA[h][i] : vA[h][i]; }
            PG_LDB(B0, 0, 0); PG_LDB(B1, 0, 1); PG_SCHED; PG_LDA(At, 0, 0); PG_STAGE_A(PG_SA(1, 1), a1, vA, 1);
            PG_WAIT_V(8); PG_WAIT_L(0); PG_BAR; PG_MMA(0, 0, At, B0); PG_MMA(0, 1, At, B1); PG_BAR; PG_SCHED;
            PG_LDA(At, 0, 1); PG_STAGE_B(PG_SB(0, 0), b2, 0); PG_STAGE_B(PG_SB(0, 1), b2, 1); PG_STAGE_A(PG_SA(0, 0), a2, wA, 0);
            PG_WAIT_V(8); PG_WAIT_L(0); PG_BAR; PG_MMA(1, 0, At, B0); PG_MMA(1, 1, At, B1); PG_BAR; PG_SCHED;
            PG_LDB(B0, 1, 0); PG_LDB(B1, 1, 1); PG_SCHED; PG_LDA(At, 1, 0); PG_STAGE_A(PG_SA(0, 1), a2, wA, 1);
            PG_WAIT_V(8); PG_WAIT_L(0); PG_BAR; PG_MMA(0, 0, At, B0); PG_MMA(0, 1, At, B1); PG_BAR; PG_SCHED;
            PG_LDA(At, 1, 1); PG_STAGE_B(PG_SB(1, 0), b3, 0); PG_STAGE_B(PG_SB(1, 1), b3, 1); PG_STAGE_A(PG_SA(1, 0), a3, wA, 0);
            PG_WAIT_V(8); PG_WAIT_L(0); PG_BAR; PG_MMA(1, 0, At, B0); PG_MMA(1, 1, At, B1); PG_BAR; PG_SCHED;
        }
        if constexpr (ALIGN_EPI) { if (wr == 0) PG_BAR; }
        E(acc, cur, wr, wc, fr, fq);
        if (!has_next) break;
#pragma unroll
        for (int a = 0; a < 2; ++a)
#pragma unroll
            for (int b = 0; b < 2; ++b)
#pragma unroll
                for (int m = 0; m < 4; ++m)
#pragma unroll
                    for (int n = 0; n < 2; ++n) acc[a][b][m][n] = (f32x4){0.f, 0.f, 0.f, 0.f};
        cur = nxt; ++ui; cAp = nAp; cBp = nBp;
        if constexpr (GA) {
#pragma unroll
            for (int h = 0; h < 2; ++h)
#pragma unroll
                for (int i = 0; i < 2; ++i) vA[h][i] = nvA[h][i]; }
        if constexpr (ALIGN_EPI) { if (wr == 1) PG_BAR; }
    }
    PG_WAIT_V(0);
    if constexpr (!ALIGN_EPI) { if (wr == 0) PG_BAR; }
    PG_BAR;
#undef PG_SA
#undef PG_SB
#undef PG_STAGE
#undef PG_LDA
#undef PG_LDB
#undef PG_MMA
#undef PG_WAIT_V
#undef PG_WAIT_L
#undef PG_BAR
#undef PG_SCHED
#undef PG_GOFFS
#undef PG_UA
#undef PG_UB
#undef PG_STAGE_A
#undef PG_STAGE_B
}

constexpr int ROWTAB_OFF = 132096, ETAB_OFF = ROWTAB_OFF + 12 * 1024, MAXU = 12;
struct DenseSched {
    static constexpr bool GATHER = false;
    int nN, nunits, G, c;
    __device__ __forceinline__ void init(LAS unsigned char*, int M, int N, int G_, int c_) { nN = N / 256; nunits = (M / 256) * nN; G = G_; c = c_; }
    __device__ __forceinline__ bool next(int i, Unit& u) const { const int L = i * G + c; if (L >= nunits) return false; u.pm = L / nN; u.pn = L % nN; u.e = 0; return true; }
    __device__ __forceinline__ int arow(const Unit& u, int, int r) const { return 256 * u.pm + r; }
    __device__ __forceinline__ int brow0(const Unit& u) const { return 256 * u.pn; }
};
template <bool GATHER_> struct GroupSched {
    static constexpr bool GATHER = GATHER_;
    LAS int* rowtab; LAS int* etab; int nN, nexp_rows, nunits, G, c;
    __device__ __forceinline__ void init(LAS unsigned char* lds, const int* te, const int* rt, int nN_, int nexp_rows_, int G_, int c_) {
        rowtab = (LAS int*)(lds + ROWTAB_OFF); etab = (LAS int*)(lds + ETAB_OFF); nN = nN_; nexp_rows = nexp_rows_; G = G_; c = c_;
        nunits = __builtin_amdgcn_readfirstlane(te[MAXTILES]) * nN_;
        for (int i = 0; i < MAXU; ++i) { const int L = i * G + c; if (L >= nunits) break; const int pm = L / nN;
            if (threadIdx.x == 0) etab[i] = te[pm];
            if (GATHER && threadIdx.x < 256) rowtab[i * 256 + threadIdx.x] = rt[256 * pm + threadIdx.x]; }
        __syncthreads();
    }
    __device__ __forceinline__ bool next(int i, Unit& u) const { const int L = i * G + c; if (L >= nunits || i >= MAXU) return false; u.pm = L / nN; u.pn = L % nN; u.e = etab[i]; return true; }
    __device__ __forceinline__ int arow(const Unit& u, int ui, int r) const { return GATHER ? rowtab[ui * 256 + r] : 256 * u.pm + r; }
    __device__ __forceinline__ int brow0(const Unit& u) const { return u.e * nexp_rows + 256 * u.pn; }
};

struct EpiProj {
    static constexpr bool PERM = true;
    unsigned char* ws;
    __device__ __forceinline__ void operator()(const f32x4 (&acc)[2][2][4][2], const Unit& u, int wr, int wc, int fr, int fq) const {
        asm volatile("" : "+v"(fr), "+v"(fq));
        bf16_t* LAT = (bf16_t*)(ws + WS_LAT); bf16_t* KM = (bf16_t*)(ws + WS_KM); bf16_t* QB = (bf16_t*)(ws + WS_QB); bf16_t* KB = (bf16_t*)(ws + WS_KB); bf16_t* VB = (bf16_t*)(ws + WS_VB);
        float* rstdp = (float*)(ws + WS_RSTDP); float* kmeanp = (float*)(ws + WS_KMEANP);
        const float* ropeA = (const float*)(ws + WS_ROPEA); const float* ropeB = (const float*)(ws + WS_ROPEB);
#pragma unroll
        for (int b = 0; b < 2; ++b) {
            const int g = 8 * u.pn + 4 * b + wc;
            if (g < 12) {
#pragma unroll
                for (int a = 0; a < 2; ++a)
#pragma unroll
                    for (int m = 0; m < 4; ++m) { const int row = 256 * u.pm + 128 * a + 64 * wr + 16 * m + fr; const f32x4 v0 = acc[a][b][m][0], v1 = acc[a][b][m][1];
                        u32x4 w; w.x = pk2(v0[0], v0[1]); w.y = pk2(v0[2], v0[3]); w.z = pk2(v1[0], v1[1]); w.w = pk2(v1[2], v1[3]);
                        *(u32x4*)(LAT + (size_t)row * 384 + g * 32 + 8 * fq) = w;
                        float ss = 0.f;
#pragma unroll
                        for (int k = 0; k < 4; ++k) { const float e0 = __uint_as_float(w[k] << 16), e1 = __uint_as_float(w[k] & 0xffff0000u); ss += e0 * e0 + e1 * e1; }
                        ss += __shfl_xor(ss, 16); ss += __shfl_xor(ss, 32);
                        if (fq == 0) rstdp[(size_t)row * 12 + g] = ss; }
            } else if (g == 12) {
#pragma unroll
                for (int a = 0; a < 2; ++a)
#pragma unroll
                    for (int m = 0; m < 4; ++m) { const int row = 256 * u.pm + 128 * a + 64 * wr + 16 * m + fr; u32x4 w;
#pragma unroll
                        for (int n = 0; n < 2; ++n) { const f32x4 v = acc[a][b][m][n]; f32x4 pv;
#pragma unroll
                            for (int j = 0; j < 4; ++j) { auto rr = __builtin_amdgcn_permlane32_swap(__float_as_uint(v[j]), __float_as_uint(v[j]), false, false); pv[j] = __uint_as_float(fq < 2 ? rr[1] : rr[0]); }
                            const f32x4 c = *(const f32x4*)(ropeA + (size_t)row * 32 + 8 * (fq & 1) + 4 * n), sn = *(const f32x4*)(ropeA + (size_t)row * 32 + 16 + 8 * (fq & 1) + 4 * n);
                            const f32x4 o = (fq < 2) ? (v * c - pv * sn) : (v * c + pv * sn);
                            w[2 * n] = pk2(o[0], o[1]); w[2 * n + 1] = pk2(o[2], o[3]); }
#pragma unroll
                        for (int h = 0; h < 8; ++h) *(u32x4*)(KM + (size_t)row * 768 + h * 96 + 64 + 8 * fq) = w; }
            } else if (g < 45) {
                const bool isk = g >= 29; const int rel = isk ? g - 29 : g - 13, head = rel >> 1, hf = rel & 1;
                bf16_t* dst = (isk ? KB : QB) + head * 64 + hf * 32 + 8 * fq;
                f32x4 cs0 = (f32x4){0.f, 0.f, 0.f, 0.f}, cs1 = cs0;
#pragma unroll
                for (int a = 0; a < 2; ++a)
#pragma unroll
                    for (int m = 0; m < 4; ++m) { const int row = 256 * u.pm + 128 * a + 64 * wr + 16 * m + fr; f32x4 v0 = acc[a][b][m][0], v1 = acc[a][b][m][1];
                        if (hf == 0) {
#pragma unroll
                            for (int n = 0; n < 2; ++n) { const f32x4 v = n ? v1 : v0; f32x4 pv;
#pragma unroll
                                for (int j = 0; j < 4; ++j) { auto rr = __builtin_amdgcn_permlane16_swap(__float_as_uint(v[j]), __float_as_uint(v[j]), false, false); pv[j] = __uint_as_float((fq & 1) ? rr[0] : rr[1]); }
                                const f32x4 c = *(const f32x4*)(ropeB + (size_t)row * 16 + 4 * n), sn = *(const f32x4*)(ropeB + (size_t)row * 16 + 8 + 4 * n);
                                const f32x4 o = (fq == 0) ? (v * c - pv * sn) : (fq == 1) ? (v * c + pv * sn) : v;
                                if (n) v1 = o; else v0 = o; } }
                        if (isk) { cs0 += v0; cs1 += v1; }
                        const f32x4 s0 = isk ? v0 : v0 * C2B, s1 = isk ? v1 : v1 * C2B;
                        u32x4 w; w.x = pk2(s0[0], s0[1]); w.y = pk2(s0[2], s0[3]); w.z = pk2(s1[0], s1[1]); w.w = pk2(s1[2], s1[3]);
                        *(u32x4*)(dst + (size_t)row * 512) = w; }
                if (isk) {
#pragma unroll
                    for (int j = 0; j < 4; ++j) {
#pragma unroll
                        for (int o = 1; o < 16; o <<= 1) { cs0[j] += __shfl_xor(cs0[j], o); cs1[j] += __shfl_xor(cs1[j], o); } }
                    if (fr == 0) { float* kp = kmeanp + ((size_t)u.pm * 2 + wr) * 512 + head * 64 + hf * 32 + 8 * fq; *(f32x4*)kp = cs0; *(f32x4*)(kp + 4) = cs1; } }
            } else if (g < 61) {
                const int rel = g - 45;
#pragma unroll
                for (int a = 0; a < 2; ++a)
#pragma unroll
                    for (int m = 0; m < 4; ++m) { const int row = 256 * u.pm + 128 * a + 64 * wr + 16 * m + fr; const f32x4 v0 = acc[a][b][m][0], v1 = acc[a][b][m][1];
                        u32x4 w; w.x = pk2(v0[0], v0[1]); w.y = pk2(v0[2], v0[3]); w.z = pk2(v1[0], v1[1]); w.w = pk2(v1[2], v1[3]);
                        *(u32x4*)(VB + (size_t)row * 512 + rel * 32 + 8 * fq) = w; }
            }
            asm volatile("" ::: "memory");
        }
    }
};
struct EpiUp {
    static constexpr bool PERM = true;
    bf16_t *QM, *KM, *VM; const float* rstd; const float* ropeA; int gbase;
    __device__ __forceinline__ void operator()(const f32x4 (&acc)[2][2][4][2], const Unit& u, int wr, int wc, int fr, int fq) const {
        asm volatile("" : "+v"(fr), "+v"(fq));
#pragma unroll
        for (int a = 0; a < 2; ++a)
#pragma unroll
            for (int m = 0; m < 4; ++m) { const int row = 256 * u.pm + 128 * a + 64 * wr + 16 * m + fr;
                const f32x4 s0 = *(const f32x4*)(rstd + (size_t)row * 12), s1 = *(const f32x4*)(rstd + (size_t)row * 12 + 4), s2 = *(const f32x4*)(rstd + (size_t)row * 12 + 8);
                const float rq = C2A / sqrtf((((s0[0] + s0[1]) + (s0[2] + s0[3])) + ((s1[0] + s1[1]) + (s1[2] + s1[3]))) * (1.0f / 256.0f) + RMS_EPS);
                const float rkv = 1.0f / sqrtf(((s2[0] + s2[1]) + (s2[2] + s2[3])) * (1.0f / 128.0f) + RMS_EPS);
#pragma unroll
                for (int b = 0; b < 2; ++b) {
                    const int gidx = gbase + 8 * u.pn + 4 * b + wc;
                    if (gidx < 24) {
                        const int h = gidx / 3, part = gidx % 3;
                        f32x4 v0 = acc[a][b][m][0] * rq, v1 = acc[a][b][m][1] * rq;
                        if (part == 2) {
#pragma unroll
                            for (int n = 0; n < 2; ++n) { const f32x4 v = n ? v1 : v0; f32x4 pv;
#pragma unroll
                                for (int j = 0; j < 4; ++j) { auto rr = __builtin_amdgcn_permlane32_swap(__float_as_uint(v[j]), __float_as_uint(v[j]), false, false); pv[j] = __uint_as_float(fq < 2 ? rr[1] : rr[0]); }
                                const f32x4 c = *(const f32x4*)(ropeA + (size_t)row * 32 + 8 * (fq & 1) + 4 * n), sn = *(const f32x4*)(ropeA + (size_t)row * 32 + 16 + 8 * (fq & 1) + 4 * n);
                                const f32x4 o = (fq < 2) ? (v * c - pv * sn) : (v * c + pv * sn);
                                if (n) v1 = o; else v0 = o; } }
                        u32x4 w; w.x = pk2(v0[0], v0[1]); w.y = pk2(v0[2], v0[3]); w.z = pk2(v1[0], v1[1]); w.w = pk2(v1[2], v1[3]);
                        *(u32x4*)(QM + (size_t)row * 768 + h * 96 + part * 32 + 8 * fq) = w;
                    } else {
                        const int g2 = gidx - 24, h = g2 >> 2, part = g2 & 3;
                        const f32x4 v0 = acc[a][b][m][0] * rkv, v1 = acc[a][b][m][1] * rkv;
                        bf16_t* pp = (part < 2) ? (KM + (size_t)row * 768 + h * 96 + part * 32 + 8 * fq) : (VM + (size_t)row * 512 + h * 64 + (part - 2) * 32 + 8 * fq);
                        u32x4 w; w.x = pk2(v0[0], v0[1]); w.y = pk2(v0[2], v0[3]); w.z = pk2(v1[0], v1[1]); w.w = pk2(v1[2], v1[3]);
                        *(u32x4*)pp = w;
                    }
                }
                asm volatile("" ::: "memory"); }
    }
};
struct EpiWo {
    static constexpr bool PERM = false;
    const float* x; float* O;
    __device__ __forceinline__ void operator()(const f32x4 (&acc)[2][2][4][2], const Unit& u, int wr, int wc, int fr, int fq) const {
        asm volatile("" : "+v"(fr), "+v"(fq));
#pragma unroll
        for (int a = 0; a < 2; ++a)
#pragma unroll
            for (int m = 0; m < 4; ++m) { const int row = 256 * u.pm + 128 * a + 64 * wr + 16 * m + fr;
#pragma unroll
                for (int b = 0; b < 2; ++b)
#pragma unroll
                    for (int n = 0; n < 2; ++n) { const size_t off = (size_t)row * DM + 256 * u.pn + ecol<PERM>(b, n, wc, fq);
                        const f32x4 xv = *(const f32x4*)(x + off); *(f32x4*)(O + off) = xv * DN_ALPHA + acc[a][b][m][n]; } }
    }
};
struct EpiGateUp {
    static constexpr bool PERM = true;
    bf16_t* H; const float *bg, *bu;
    __device__ __forceinline__ void operator()(const f32x4 (&acc)[2][2][4][2], const Unit& u, int wr, int wc, int fr, int fq) const {
        asm volatile("" : "+v"(fr), "+v"(fq));
        const int hc = 128 * u.pn + 32 * wc + 8 * fq;
        f32x4 vbg[2], vbu[2];
#pragma unroll
        for (int n = 0; n < 2; ++n) { vbg[n] = *(const f32x4*)(bg + (size_t)u.e * 1024 + hc + 4 * n); vbu[n] = *(const f32x4*)(bu + (size_t)u.e * 1024 + hc + 4 * n); }
#pragma unroll
        for (int a = 0; a < 2; ++a)
#pragma unroll
            for (int m = 0; m < 4; ++m) { const int row = 256 * u.pm + 128 * a + 64 * wr + 16 * m + fr; u32x4 w;
#pragma unroll
                for (int n = 0; n < 2; ++n) { const f32x4 gv = acc[a][0][m][n] + vbg[n], uv = acc[a][1][m][n] + vbu[n]; float hv[4];
#pragma unroll
                    for (int j = 0; j < 4; ++j) { const float gg = fminf(gv[j], 7.0f), uu = fminf(fmaxf(uv[j], -7.0f), 7.0f);
                        const float sg = __builtin_amdgcn_rcpf(1.0f + __builtin_amdgcn_exp2f(-1.702f * LOG2E * gg)); hv[j] = gg * sg * (uu + 1.0f); }
                    w[2 * n] = pk2(hv[0], hv[1]); w[2 * n + 1] = pk2(hv[2], hv[3]); }
                __builtin_nontemporal_store(w, (u32x4*)(H + (size_t)row * 1024 + hc)); }
    }
};
struct EpiDown {
    static constexpr bool PERM = true;
    bf16_t* Y; const float* bd; const float* row_gate;
    __device__ __forceinline__ void operator()(const f32x4 (&acc)[2][2][4][2], const Unit& u, int wr, int wc, int fr, int fq) const {
        asm volatile("" : "+v"(fr), "+v"(fq));
        f32x4 bv[2][2];
#pragma unroll
        for (int b = 0; b < 2; ++b)
#pragma unroll
            for (int n = 0; n < 2; ++n) bv[b][n] = *(const f32x4*)(bd + (size_t)u.e * 1024 + 256 * u.pn + 128 * b + 32 * wc + 8 * fq + 4 * n);
#pragma unroll
        for (int a = 0; a < 2; ++a)
#pragma unroll
            for (int m = 0; m < 4; ++m) { const int row = 256 * u.pm + 128 * a + 64 * wr + 16 * m + fr; const float gw = row_gate[row];
#pragma unroll
                for (int b = 0; b < 2; ++b) { const int col = 256 * u.pn + 128 * b + 32 * wc + 8 * fq;
                    const f32x4 v0 = (acc[a][b][m][0] + bv[b][0]) * gw, v1 = (acc[a][b][m][1] + bv[b][1]) * gw;
                    u32x4 w; w.x = pk2(v0[0], v0[1]); w.y = pk2(v0[2], v0[3]); w.z = pk2(v1[0], v1[1]); w.w = pk2(v1[2], v1[3]);
                    __builtin_nontemporal_store(w, (u32x4*)(Y + (size_t)row * 1024 + col)); } }
    }
};

__device__ __forceinline__ unsigned cvtpk_hw(float lo, float hi) { typedef __bf16 bf2 __attribute__((ext_vector_type(2))); f32x2 v = {lo, hi}; bf2 b = __builtin_convertvector(v, bf2); return __builtin_bit_cast(unsigned, b); }
__device__ __forceinline__ void conv_issue(const float* W, int ldw, int k0, int n0, LAS unsigned char* scr, int lane) {
#pragma unroll
    for (int i = 0; i < 4; ++i) __builtin_amdgcn_global_load_lds((const unsigned*)(W + (size_t)(k0 + 4 * (lane >> 3) + i) * ldw + n0 + 4 * (lane & 7)), (LAS unsigned*)(scr + i * 1024), 16, 0, 2);
}
__device__ __forceinline__ void conv_finish(bf16_t* WT, int ldt, int orow0, int ocol0, const LAS unsigned char* scr, int lane) {
    f32x4 r[4];
#pragma unroll
    for (int i = 0; i < 4; ++i) r[i] = *(const LAS f32x4*)(scr + i * 1024 + lane * 16);
#pragma unroll
    for (int j = 0; j < 4; ++j) { u32x2 o; o.x = cvtpk_hw(r[0][j], r[1][j]); o.y = cvtpk_hw(r[2][j], r[3][j]);
        *(u32x2*)(WT + (size_t)(orow0 + 4 * (lane & 7) + j) * ldt + ocol0 + 4 * (lane >> 3)) = o; }
}
constexpr int NEXP_ITEMS = 3 * NE * 1024;
__device__ __forceinline__ void expert_issue(const Params& p, int r, LAS unsigned char* scr, int lane) {
    const int mat = r >> 15, rr = r & 32767, e = rr >> 10, q = rr & 1023, kb = (q & 1) | ((q >> 6) << 1), nb = (q >> 1) & 31;
    const float* W = (mat == 0 ? p.w_gate : mat == 1 ? p.w_up : p.w_down) + (size_t)e * 1048576;
    conv_issue(W, 1024, 32 * kb, 32 * nb, scr, lane);
}
__device__ __forceinline__ void expert_finish(const Params& p, int r, const LAS unsigned char* scr, int lane) {
    const int mat = r >> 15, rr = r & 32767, e = rr >> 10, q = rr & 1023, kb = (q & 1) | ((q >> 6) << 1), nb = (q >> 1) & 31, n0 = 32 * nb;
    bf16_t* WguT = (bf16_t*)(p.ws + WS_WGU); bf16_t* WdT = (bf16_t*)(p.ws + WS_WD);
    if (mat == 2) conv_finish(WdT, 1024, e * 1024 + n0, 32 * kb, scr, lane);
    else conv_finish(WguT, 1024, e * 2048 + (n0 >> 7) * 256 + (mat == 1 ? 128 : 0) + (n0 & 127), 32 * kb, scr, lane);
}
struct BgConv { int next, stride, pend0, pend1, itc; };

__device__ __forceinline__ void tr_item(const float* W, int ldw, int k0, int n0, bf16_t* WT, int ldt, int orow0, int ocol0, const float* kscale, LAS float* scr, int lane) {
#pragma unroll 8
    for (int i = 0; i < 32; ++i) { const int kk = 2 * i + (lane >> 5); float v = W[(size_t)(k0 + kk) * ldw + n0 + (lane & 31)]; if (kscale) v *= kscale[k0 + kk]; scr[kk * 33 + (lane & 31)] = v; }
    asm volatile("s_waitcnt lgkmcnt(0)" ::: "memory");
    const int c = lane & 7;
#pragma unroll
    for (int j = 0; j < 4; ++j) { const int n = (lane >> 3) + 8 * j; const LAS float* s = scr + (8 * c) * 33 + n;
        u32x4 o; o.x = pk2(s[0 * 33], s[1 * 33]); o.y = pk2(s[2 * 33], s[3 * 33]); o.z = pk2(s[4 * 33], s[5 * 33]); o.w = pk2(s[6 * 33], s[7 * 33]);
        *(u32x4*)(WT + (size_t)(orow0 + n) * ldt + ocol0 + 8 * c) = o; }
    asm volatile("s_waitcnt lgkmcnt(0)" ::: "memory");
}
__device__ __forceinline__ void phase_prologue(const Params& p, LAS unsigned char* lds, int vcu, int G) {
    const int tid = threadIdx.x, wave = tid >> 6, lane = tid & 63;
    unsigned char* ws = p.ws;
    LAS float* scr = (LAS float*)(lds + wave * 16384);
    const int gw = vcu * NWAVES + wave, NGW = G * NWAVES;
    bf16_t* WinT = (bf16_t*)(ws + WS_WIN); bf16_t* WoT = (bf16_t*)(ws + WS_WO); bf16_t* WupT = (bf16_t*)(ws + WS_WUP);
    constexpr int I_IN = 16 * 61, I_QB = 4 * 24, I_KVB = 2 * 32, I_O = 16 * 32;
    constexpr int NITEMS = I_IN + I_QB + I_KVB + I_O;
    for (int it = gw; it < NITEMS; it += NGW) {
        int r = it;
        if (r < I_IN) { const int kb = r / 61, nb = r % 61; tr_item(p.w_in, IN_COLS, 64 * kb, 32 * nb, WinT, 1024, 32 * nb, 64 * kb, nullptr, scr, lane); continue; } r -= I_IN;
        if (r < I_QB) { const int kb = r / 24, nb = r % 24; tr_item(p.w_q_b, 768, 64 * kb, 32 * nb, WupT, KUP, 32 * nb, 64 * kb, p.q_a_norm, scr, lane); continue; } r -= I_QB;
        if (r < I_KVB) { const int kb = r / 32, nb = r % 32; tr_item(p.w_kv_b, 1024, 64 * kb, 32 * nb, WupT, KUP, 768 + 32 * nb, 256 + 64 * kb, p.kv_a_norm, scr, lane); continue; } r -= I_KVB;
        { const int kb = r / 32, nb = r % 32; tr_item(p.w_o, 1024, 64 * kb, 32 * nb, WoT, 1024, 32 * nb, 64 * kb, nullptr, scr, lane); }
    }
    const int gt = vcu * NTHREADS + tid, NGT = G * NTHREADS;
    for (int i = gt; i < 96 * 128; i += NGT) *(u32x4*)(WinT + (size_t)IN_COLS * 1024 + (size_t)i * 8) = (u32x4){0u, 0u, 0u, 0u};
    for (int i = gt; i < 768 * 16; i += NGT) { const int r = i / 16, c = i % 16; *(u32x4*)(WupT + (size_t)r * KUP + 256 + c * 8) = (u32x4){0u, 0u, 0u, 0u}; }
    for (int i = gt; i < 1024 * 32; i += NGT) { const int r = i / 32, c = i % 32; *(u32x4*)(WupT + (size_t)(768 + r) * KUP + c * 8) = (u32x4){0u, 0u, 0u, 0u}; }
    bf16_t* XB = (bf16_t*)(ws + WS_XB);
    for (int i = gt; i < NTOK * DM / 8; i += NGT) { const f32x4 a = *(const f32x4*)(p.x + (size_t)i * 8), b = *(const f32x4*)(p.x + (size_t)i * 8 + 4);
        u32x4 o; o.x = pk2(a[0], a[1]); o.y = pk2(a[2], a[3]); o.z = pk2(b[0], b[1]); o.w = pk2(b[2], b[3]); *(u32x4*)(XB + (size_t)i * 8) = o; }
    { bf16_t* WRF = (bf16_t*)(ws + WS_WRL);
      for (int n = gt; n < 32768; n += NGT) { const int j = n & 7, ln = (n >> 3) & 63, eh = (n >> 9) & 1, ks = n >> 10;
          const float w = p.w_router[(size_t)(32 * ks + 8 * (ln >> 4) + j) * 32 + 16 * eh + (ln & 15)];
          const unsigned h = f2bf(w); const float wl = w - __uint_as_float(h << 16);
          WRF[n] = (bf16_t)h; WRF[32768 + n] = (bf16_t)f2bf(wl); } }
    float* ropeA = (float*)(ws + WS_ROPEA); float* ropeB = (float*)(ws + WS_ROPEB);
    for (int i = gt; i < NTOK * 24; i += NGT) { const int tok = i / 24, j = i % 24; const double f = (j < 16) ? p.invfA[j] : p.invfB[j - 16];
        const double rev = (double)p.pos[tok] * f * 0.15915494309189535; const float fr = (float)(rev - __builtin_rint(rev));
        const float cs = __builtin_amdgcn_cosf(fr), sn = __builtin_amdgcn_sinf(fr);
        if (j < 16) { ropeA[(size_t)tok * 32 + j] = cs; ropeA[(size_t)tok * 32 + 16 + j] = sn; } else { ropeB[(size_t)tok * 16 + (j - 16)] = cs; ropeB[(size_t)tok * 16 + 8 + (j - 16)] = sn; } }
}

__device__ __forceinline__ void phase_prep(const Params& p, LAS unsigned char* lds, int vcu, int G) {
    const int tid = threadIdx.x, wave = tid >> 6, lane = tid & 63;
    unsigned char* ws = p.ws;
    const bf16_t* PROJ = (const bf16_t*)(ws + WS_PROJ);
    float* rstd = (float*)(ws + WS_RSTD); const float* ropeA = (const float*)(ws + WS_ROPEA); const float* ropeB = (const float*)(ws + WS_ROPEB);
    bf16_t* KM = (bf16_t*)(ws + WS_KM); bf16_t* QB = (bf16_t*)(ws + WS_QB); bf16_t* KB = (bf16_t*)(ws + WS_KB); float* kmean = (float*)(ws + WS_KMEAN);
    const int gw = vcu * NWAVES + wave, NGW = G * NWAVES;
    for (int row = gw; row < NTOK; row += NGW) {
        float s = 0.f;
        if (lane < 48) { const u32x4 v = *(const u32x4*)(PROJ + (size_t)row * PN + lane * 8);
#pragma unroll
            for (int q = 0; q < 4; ++q) { const float a = __uint_as_float(v[q] << 16), b = __uint_as_float(v[q] & 0xffff0000u); s += a * a + b * b; } }
#pragma unroll
        for (int o = 1; o < 32; o <<= 1) s += __shfl_xor(s, o);
        if (lane == 0) rstd[2 * row] = 1.0f / sqrtf(s * (1.0f / 256.0f) + RMS_EPS);
        if (lane == 32) rstd[2 * row + 1] = 1.0f / sqrtf(s * (1.0f / 128.0f) + RMS_EPS);
    }
    const int gt = vcu * NTHREADS + tid, NGT = G * NTHREADS;
    for (int i = gt; i < NTOK * 16; i += NGT) { const int tok = i >> 4, j = i & 15;
        const float x1 = bf2f(PROJ[(size_t)tok * PN + C_KR + j]), x2 = bf2f(PROJ[(size_t)tok * PN + C_KR + 16 + j]);
        const float c = ropeA[(size_t)tok * 32 + j], s = ropeA[(size_t)tok * 32 + 16 + j];
        const bf16_t o1 = (bf16_t)f2bf(x1 * c - x2 * s), o2 = (bf16_t)f2bf(x2 * c + x1 * s);
#pragma unroll
        for (int h = 0; h < 8; ++h) { KM[(size_t)tok * 768 + h * 96 + 64 + j] = o1; KM[(size_t)tok * 768 + h * 96 + 80 + j] = o2; } }
    LAS float* red = (LAS float*)lds;
    for (int unit = vcu; unit < 512; unit += G) {
        const int ub = unit >> 3, h = unit & 7, tg = tid >> 6, d = tid & 63, c = h * 64 + d; float ksum = 0.f;
#pragma unroll 4
        for (int i = 0; i < 32; ++i) { const int tok = ub * 256 + tg * 32 + i; const bf16_t* pr = PROJ + (size_t)tok * PN;
            float qv = bf2f(pr[C_MQ + c]), kv = bf2f(pr[C_MK + c]);
            if (d < 16) { const int j = d & 7; const float cs = ropeB[(size_t)tok * 16 + j], sn = ropeB[(size_t)tok * 16 + 8 + j];
                if (d < 8) { const float q2 = bf2f(pr[C_MQ + c + 8]), k2 = bf2f(pr[C_MK + c + 8]); qv = qv * cs - q2 * sn; kv = kv * cs - k2 * sn; }
                else { const float q1 = bf2f(pr[C_MQ + c - 8]), k1 = bf2f(pr[C_MK + c - 8]); qv = qv * cs + q1 * sn; kv = kv * cs + k1 * sn; } }
            QB[(size_t)tok * 512 + c] = (bf16_t)f2bf(qv * C2B); KB[(size_t)tok * 512 + c] = (bf16_t)f2bf(kv); ksum += kv; }
        red[tg * 64 + d] = ksum;
        __syncthreads();
        if (tid < 64) { float t = 0.f;
#pragma unroll
            for (int g8 = 0; g8 < 8; ++g8) t += red[g8 * 64 + tid];
            kmean[(size_t)ub * 512 + h * 64 + tid] = t * (1.0f / 256.0f); }
        __syncthreads();
    }
}

typedef float f32x16 __attribute__((ext_vector_type(16)));
typedef short s16x4 __attribute__((ext_vector_type(4)));
namespace fa {
constexpr int KBUF = 12288, VBUF = 8192, VOFF = 3 * KBUF, WS_OFF = VOFF + 3 * VBUF, KML_OFF = WS_OFF + 8 * 256, LDS_NEED = KML_OFF + 2048;
__device__ __forceinline__ void wait_vm(int n) {
    switch (n) {
#define FA_W(k) case k: asm volatile("s_waitcnt vmcnt(" #k ")" ::: "memory"); break;
        FA_W(0) FA_W(1) FA_W(2) FA_W(3) FA_W(4) FA_W(5) FA_W(6) FA_W(7) FA_W(8) FA_W(9) FA_W(10) FA_W(11) FA_W(12) FA_W(13) FA_W(14) FA_W(15)
#undef FA_W
        default: asm volatile("s_waitcnt vmcnt(15)" ::: "memory"); break; }
}
constexpr float THR = 8.0f;
__device__ __forceinline__ int crow(int r, int hi) { return (r & 3) + 8 * (r >> 2) + 4 * hi; }
__device__ __forceinline__ unsigned cvtpk(float lo, float hi) { typedef __bf16 bf2 __attribute__((ext_vector_type(2))); f32x2 v = {lo, hi}; bf2 b = __builtin_convertvector(v, bf2); return __builtin_bit_cast(unsigned, b); }
__device__ __forceinline__ float xhalf_max(float m) { auto rr = __builtin_amdgcn_permlane32_swap(__float_as_uint(m), __float_as_uint(m), false, false); return fmaxf(__uint_as_float(rr[0]), __uint_as_float(rr[1])); }
__device__ __forceinline__ float xhalf_sum(float m) { auto rr = __builtin_amdgcn_permlane32_swap(__float_as_uint(m), __float_as_uint(m), false, false); return __uint_as_float(rr[0]) + __uint_as_float(rr[1]); }
__device__ __forceinline__ float mx3(float a, float b, float c) { return __builtin_fmaxf(__builtin_fmaxf(a, b), c); }
}
template <int DQK, int VAR>
__device__ __forceinline__ void attn_unit(LAS unsigned char* lds, const bf16_t* Q, int qpitch, const bf16_t* K, int kpitch, const bf16_t* V, int vpitch, bf16_t* O, int qb, const float* kmean, const Params& p, BgConv& bg) {
    using namespace fa;
    constexpr int ND = DQK / 16, NCH = DQK / 8;
    const int tid = threadIdx.x, lane = tid & 63, r32 = lane & 31, hi = lane >> 5, wid = __builtin_amdgcn_readfirstlane(tid >> 6);
    const int q0 = qb * 256, qrel = wid * 32 + r32;
    LAS float* wsf = (LAS float*)(lds + WS_OFF) + wid * 64;
    bf16x8 qr[ND];
#pragma unroll
    for (int d0 = 0; d0 < ND; ++d0) qr[d0] = *(const bf16x8*)(Q + (size_t)(q0 + qrel) * qpitch + d0 * 16 + hi * 8);
    unsigned sel = 0xffu;
    if (kmean) { const int n = tid >> 6, d = tid & 63; if (n < qb) ((LAS float*)(lds + KML_OFF))[tid] = kmean[(size_t)n * 1024 + d] + kmean[(size_t)n * 1024 + 512 + d]; }
    const bf16_t* ksrc = K + (size_t)lane * kpitch;
    const bf16_t* vsrc = V + (size_t)(16 * (wid & 3) + (lane >> 2)) * vpitch + (wid >> 2) * 32 + (lane & 3) * 8;
#define FA_DMA(ti, kslot, vslot) do { \
        __builtin_amdgcn_global_load_lds((const unsigned*)(ksrc + (size_t)(ti) * 64 * kpitch + wid * 8), (LAS unsigned*)(lds + (kslot) * KBUF + wid * 1024), 16, 0, 0); \
        if (NCH > 8 && wid < NCH - 8) __builtin_amdgcn_global_load_lds((const unsigned*)(ksrc + (size_t)(ti) * 64 * kpitch + (wid + 8) * 8), (LAS unsigned*)(lds + (kslot) * KBUF + (wid + 8) * 1024), 16, 0, 0); \
        __builtin_amdgcn_global_load_lds((const unsigned*)(vsrc + (size_t)(ti) * 64 * vpitch), (LAS unsigned*)(lds + VOFF + (vslot) * VBUF + wid * 1024), 16, 0, 0); } while (0)
#define FA_TILE(i) (((i) < 4) ? 4 * qb + (i) : (i) - 4)
#define FA_PV(vslot) do { const LAS unsigned char* vb_ = lds + VOFF + (vslot) * VBUF + voff; \
        _Pragma("unroll") for (int d0 = 0; d0 < 2; ++d0) _Pragma("unroll") for (int s_ = 0; s_ < 4; ++s_) { \
            const s16x4 lo_ = __builtin_bit_cast(s16x4, __builtin_amdgcn_ds_read_tr16_b64_v4i16((LAS s16x4*)(vb_ + d0 * 4096 + s_ * 1024))); \
            const s16x4 hh_ = __builtin_bit_cast(s16x4, __builtin_amdgcn_ds_read_tr16_b64_v4i16((LAS s16x4*)(vb_ + d0 * 4096 + s_ * 1024 + 512))); \
            const bf16x8 vf_ = (bf16x8){lo_[0], lo_[1], lo_[2], lo_[3], hh_[0], hh_[1], hh_[2], hh_[3]}; \
            o[d0] = __builtin_amdgcn_mfma_f32_32x32x16_bf16(__builtin_bit_cast(bf16x8, pw[s_]), vf_, o[d0], 0, 0, 0); } } while (0)
    const int NT = 4 * qb + 4;
    float mhat = 0.f, l_reg = 0.f; f32x16 o[2]; o[0] = f32x16{}; o[1] = f32x16{}; f32x16 negm = f32x16{};
    const int koff = hi * 1024 + r32 * 16;
    const int voff = ((lane >> 4) & 1) * 32 + (lane & 3) * 8 + (4 * hi + ((lane & 15) >> 2)) * 64;
    u32x4 pw[4];
    const int nkv = (NCH > 8 && wid < NCH - 8) ? 3 : 2;
    FA_DMA(FA_TILE(0), 0, 0);
    if (NT > 1) { FA_DMA(FA_TILE(1), 1, 1); }
    wait_vm(NT > 1 ? nkv : 0); asm volatile("s_waitcnt lgkmcnt(0)" ::: "memory"); __builtin_amdgcn_s_barrier(); asm volatile("" ::: "memory");
    if (kmean) {
        float gt[8];
#pragma unroll
        for (int n = 0; n < 8; ++n) { float s = 0.f; const LAS float* km = (const LAS float*)(lds + KML_OFF) + n * 64;
            if (n < qb) {
#pragma unroll
                for (int d0 = 0; d0 < ND; ++d0) { const f32x4 k0 = *(const LAS f32x4*)(km + d0 * 16 + hi * 8), k1 = *(const LAS f32x4*)(km + d0 * 16 + hi * 8 + 4);
#pragma unroll
                    for (int j = 0; j < 4; ++j) { s = fmaf(bf2f((unsigned short)qr[d0][j]), k0[j], s); s = fmaf(bf2f((unsigned short)qr[d0][4 + j]), k1[j], s); } }
                s = xhalf_sum(s); }
            gt[n] = (n < qb) ? s : -INFINITY; }
        sel = 0u;
#pragma unroll
        for (int n = 0; n < 8; ++n) { int cnt = 0;
#pragma unroll
            for (int n2 = 0; n2 < 8; ++n2) if (n2 != n) cnt += (n2 < qb && (gt[n2] > gt[n] || (gt[n2] == gt[n] && n2 < n))) ? 1 : 0;
            if (n < qb && cnt < 3) sel |= 1u << n; }
    }
    int sl = 0, prevB = 0, opsPrev = 0;
    for (int i = 0; i < NT; ++i) {
        const int sl1 = (sl == 2) ? 0 : sl + 1, sl2 = (sl1 == 2) ? 0 : sl1 + 1;
        LAS unsigned char* bscr = lds + LDS_NEED + wid * 8192 + (bg.itc & 1) * 4096;
        int young = prevB, ops = 0;
        if (bg.itc & 1) { if (bg.pend1 >= 0) { wait_vm(opsPrev); expert_finish(p, bg.pend1, bscr, lane); bg.pend1 = -1; ops += 4; asm volatile("s_waitcnt lgkmcnt(0)" ::: "memory"); } }
        else            { if (bg.pend0 >= 0) { wait_vm(opsPrev); expert_finish(p, bg.pend0, bscr, lane); bg.pend0 = -1; ops += 4; asm volatile("s_waitcnt lgkmcnt(0)" ::: "memory"); } }
        if constexpr (VAR != 4) { if (i + 2 < NT) { const int tn = FA_TILE(i + 2); FA_DMA(tn, sl2, sl2); ops += nkv; } }
        const bool bgdo = (bg.itc % 3 != 2) && bg.next < NEXP_ITEMS;
        if (bgdo) { expert_issue(p, bg.next, bscr, lane); if (bg.itc & 1) bg.pend1 = bg.next; else bg.pend0 = bg.next; bg.next += bg.stride; ops += 4; }
        young += ops; prevB = bgdo ? 4 : 0;
        ++bg.itc;
        const bool band = i < 4;
        if (!(band && 2 * i > wid)) {
            const LAS unsigned char* kb = lds + sl * KBUF + koff;
            f32x16 p0 = negm, p1 = negm;
            if (kmean && !band) { if (!__all((sel >> ((i - 4) >> 2)) & 1u)) {
                    const bool ok = ((sel >> ((i - 4) >> 2)) & 1u) != 0u;
#pragma unroll
                    for (int r = 0; r < 16; ++r) p0[r] = ok ? negm[r] : -INFINITY;
                    p1 = p0; } }
#pragma unroll
            for (int d0 = 0; d0 < (VAR == 5 ? 1 : ND); ++d0) { const bf16x8 a0 = *(const LAS bf16x8*)(kb + d0 * 2048), a1 = *(const LAS bf16x8*)(kb + d0 * 2048 + 512);
                p0 = __builtin_amdgcn_mfma_f32_32x32x16_bf16(a0, qr[d0], p0, 0, 0, 0); p1 = __builtin_amdgcn_mfma_f32_32x32x16_bf16(a1, qr[d0], p1, 0, 0, 0); }
            if (band) { if (64 * i + 63 > 32 * wid) {
#pragma unroll
                    for (int r = 0; r < 16; ++r) { const int kv = 64 * i + crow(r, hi); if (kv > qrel) p0[r] = -INFINITY; if (kv + 32 > qrel) p1[r] = -INFINITY; } } }
            if constexpr (VAR != 1 && VAR != 3) {
            float ra = mx3(p0[0], p0[1], p1[0]), rb = mx3(p0[2], p0[3], p1[1]); ra = mx3(ra, p1[2], p1[3]);
#pragma unroll
            for (int r = 4; r < 16; r += 4) { ra = mx3(ra, p0[r], p0[r + 1]); rb = mx3(rb, p0[r + 2], p0[r + 3]); ra = mx3(ra, p1[r], p1[r + 1]); rb = mx3(rb, p1[r + 2], p1[r + 3]); }
            const float rm = xhalf_max(__builtin_fmaxf(ra, rb));
            if (i == 0 || __any(rm > THR)) {
                const float dl = (i == 0) ? rm : fmaxf(rm, 0.f); mhat += dl;
#pragma unroll
                for (int r = 0; r < 16; ++r) { p0[r] -= dl; p1[r] -= dl; negm[r] = -mhat; }
                if (i != 0) { const float f = __builtin_amdgcn_exp2f(-dl); l_reg *= f; if (hi == 0) wsf[r32] = f;
                    asm volatile("s_waitcnt lgkmcnt(0)" ::: "memory");
#pragma unroll
                    for (int r = 0; r < 16; ++r) { const float fr_ = wsf[crow(r, hi)]; o[0][r] *= fr_; o[1][r] *= fr_; } }
            }
            f32x2 sacc = {0.f, 0.f};
#pragma unroll
            for (int r = 0; r < 16; ++r) { p0[r] = __builtin_amdgcn_exp2f(p0[r]); p1[r] = __builtin_amdgcn_exp2f(p1[r]); }
#pragma unroll
            for (int r = 0; r < 16; r += 2) { float t0_ = p0[r] + p1[r], t1_ = p0[r + 1] + p1[r + 1]; asm volatile("" : "+v"(t0_), "+v"(t1_)); sacc[0] += t0_; sacc[1] += t1_; }
            l_reg += sacc[0] + sacc[1];
            }
#pragma unroll
            for (int s = 0; s < 2; ++s)
#pragma unroll
                for (int j = 0; j < 4; ++j) { pw[s][j] = cvtpk(p0[8 * s + 2 * j], p0[8 * s + 2 * j + 1]); pw[2 + s][j] = cvtpk(p1[8 * s + 2 * j], p1[8 * s + 2 * j + 1]); }
            if constexpr (VAR != 2 && VAR != 3) { FA_PV(sl); } else { o[0][0] += __uint_as_float(pw[0][0] ^ pw[1][1] ^ pw[2][2] ^ pw[3][3]); }
        }
        asm volatile("s_waitcnt lgkmcnt(0)" ::: "memory"); wait_vm(young);
        __builtin_amdgcn_s_barrier(); asm volatile("" ::: "memory");
        sl = sl1; opsPrev = ops;
    }
    l_reg = xhalf_sum(l_reg);
    if (hi == 0) wsf[32 + r32] = l_reg;
    asm volatile("s_waitcnt lgkmcnt(0)" ::: "memory");
#pragma unroll
    for (int r = 0; r < 16; ++r) { const float rl = 1.0f / wsf[32 + crow(r, hi)]; bf16_t* op = O + (size_t)(q0 + wid * 32 + crow(r, hi)) * 1024 + r32;
        op[0] = (bf16_t)f2bf(o[0][r] * rl); op[32] = (bf16_t)f2bf(o[1][r] * rl); }
    asm volatile("s_waitcnt lgkmcnt(0)" ::: "memory"); __builtin_amdgcn_s_barrier(); asm volatile("" ::: "memory");
#undef FA_DMA
#undef FA_TILE
#undef FA_PV
}
template <int VAR>
__device__ __forceinline__ void phase_attn_fast(const Params& p, LAS unsigned char* lds, int vcu, int G, bool do_conv) {
    unsigned char* ws = p.ws;
    const bf16_t* QM = (const bf16_t*)(ws + WS_QM); const bf16_t* KM = (const bf16_t*)(ws + WS_KM); const bf16_t* VM = (const bf16_t*)(ws + WS_VM);
    const bf16_t* QB = (const bf16_t*)(ws + WS_QB); const bf16_t* KB = (const bf16_t*)(ws + WS_KB); const bf16_t* VB = (const bf16_t*)(ws + WS_VB);
    const float* kmean = (const float*)(ws + WS_KMEANP); bf16_t* ATT = (bf16_t*)(ws + WS_ATT);
    const int wave_ = __builtin_amdgcn_readfirstlane(threadIdx.x >> 6);
    if (wave_ >= 4) __builtin_amdgcn_s_setprio(1);
    BgConv bg; bg.next = do_conv ? vcu * NWAVES + wave_ : NEXP_ITEMS; bg.stride = G * NWAVES; bg.pend0 = -1; bg.pend1 = -1; bg.itc = 0;
    for (int su = vcu; su < 256; su += G) {
        const int bh = su >> 2, j = su & 3, b = bh >> 3, h = bh & 7; const size_t r0 = (size_t)b * SEQ;
#pragma unroll 1
        for (int k = 0; k < 2; ++k) { const int qb = k ? 7 - j : j;
            attn_unit<96, VAR>(lds, QM + r0 * 768 + h * 96, 768, KM + r0 * 768 + h * 96, 768, VM + r0 * 512 + h * 64, 512, ATT + r0 * 1024 + h * 64, qb, nullptr, p, bg);
            attn_unit<64, VAR>(lds, QB + r0 * 512 + h * 64, 512, KB + r0 * 512 + h * 64, 512, VB + r0 * 512 + h * 64, 512, ATT + r0 * 1024 + 512 + h * 64, qb, kmean + (size_t)(b * 8) * 1024 + h * 64, p, bg); }
    }
    __builtin_amdgcn_s_setprio(0);
    { const int lane = threadIdx.x & 63; LAS unsigned char* bscr = lds + fa::LDS_NEED + wave_ * 8192;
      asm volatile("s_waitcnt vmcnt(0)" ::: "memory");
      if (bg.pend0 >= 0) { expert_finish(p, bg.pend0, bscr, lane); bg.pend0 = -1; }
      if (bg.pend1 >= 0) { expert_finish(p, bg.pend1, bscr + 4096, lane); bg.pend1 = -1; }
      asm volatile("s_waitcnt lgkmcnt(0)" ::: "memory");
#pragma unroll 1
      for (; bg.next < NEXP_ITEMS; bg.next += bg.stride) { expert_issue(p, bg.next, bscr, lane); asm volatile("s_waitcnt vmcnt(0)" ::: "memory"); expert_finish(p, bg.next, bscr, lane); asm volatile("s_waitcnt lgkmcnt(0)" ::: "memory"); } }
}

__device__ __forceinline__ float rs32(float (&a)[32], int lane) {
#pragma unroll
    for (int e = 0; e < 16; ++e) { auto rr = __builtin_amdgcn_permlane32_swap(__float_as_uint(a[e]), __float_as_uint(a[e + 16]), false, false); a[e] = __uint_as_float(rr[0]) + __uint_as_float(rr[1]); }
#pragma unroll
    for (int e = 0; e < 8; ++e) { auto rr = __builtin_amdgcn_permlane16_swap(__float_as_uint(a[e]), __float_as_uint(a[e + 8]), false, false); a[e] = __uint_as_float(rr[0]) + __uint_as_float(rr[1]); }
    { const bool bit = (lane & 8) != 0;
#pragma unroll
      for (int e = 0; e < 4; ++e) { const float keep = bit ? a[e + 4] : a[e], send = bit ? a[e] : a[e + 4]; a[e] = keep + __shfl_xor(send, 8); } }
    { const bool bit = (lane & 4) != 0;
#pragma unroll
      for (int e = 0; e < 2; ++e) { const float keep = bit ? a[e + 2] : a[e], send = bit ? a[e] : a[e + 2]; a[e] = keep + __shfl_xor(send, 4); } }
    { const bool bit = (lane & 2) != 0; const float keep = bit ? a[1] : a[0], send = bit ? a[0] : a[1]; a[0] = keep + __shfl_xor(send, 2); }
    return a[0] + __shfl_xor(a[0], 1);
}
__device__ __forceinline__ void phase_ln1_route(const Params& p, LAS unsigned char* lds, int vcu, int G) {
    const int tid = threadIdx.x, wave = __builtin_amdgcn_readfirstlane(tid >> 6), lane = tid & 63;
    unsigned char* ws = p.ws;
    const float* X1P = (const float*)(ws + WS_X1PRE); bf16_t* X1B = (bf16_t*)(ws + WS_X1B);
    int* tidx = (int*)(ws + WS_TIDX); float* tgate = (float*)(ws + WS_TGATE); unsigned* hist = (unsigned*)(ws + WS_HIST);
    constexpr int XP = 2064;
    LAS unsigned char* XH = lds; LAS unsigned char* XL = lds + 16 * XP; LAS float* PART = (LAS float*)(lds + 32 * XP); LAS float* LG = PART + 8 * 16 * 32;
    LAS int* lidx = (LAS int*)(lds + ROWTAB_OFF);
    bf16x8 bw[2][4][2];
    { const bf16_t* WRF = (const bf16_t*)(ws + WS_WRL);
#pragma unroll
      for (int pp = 0; pp < 2; ++pp)
#pragma unroll
          for (int ksl = 0; ksl < 4; ++ksl)
#pragma unroll
              for (int eh = 0; eh < 2; ++eh) bw[pp][ksl][eh] = *(const bf16x8*)(WRF + (size_t)pp * 32768 + ((size_t)((4 * wave + ksl) * 2 + eh) * 64 + lane) * 8); }
    const float brt = p.b_router[lane & 31];
    for (int chunk = vcu; chunk < NCHUNK; chunk += G) {
#pragma unroll 1
        for (int grp = 0; grp < 4; ++grp) {
            const int rl = 2 * wave, tl = grp * 16 + rl, tok = chunk * 64 + tl;
            f32x4 v0[4], v1[4]; float s0 = 0.f, s1 = 0.f;
#pragma unroll
            for (int j = 0; j < 4; ++j) { v0[j] = *(const f32x4*)(X1P + (size_t)tok * DM + 4 * lane + 256 * j); v1[j] = *(const f32x4*)(X1P + (size_t)(tok + 1) * DM + 4 * lane + 256 * j);
                s0 += (v0[j][0] + v0[j][1]) + (v0[j][2] + v0[j][3]); s1 += (v1[j][0] + v1[j][1]) + (v1[j][2] + v1[j][3]); }
            const float mean0 = wave_sum(s0) * (1.0f / DM), mean1 = wave_sum(s1) * (1.0f / DM); float q0 = 0.f, q1 = 0.f;
#pragma unroll
            for (int j = 0; j < 4; ++j) { v0[j] = v0[j] - mean0; v1[j] = v1[j] - mean1;
                q0 += (v0[j][0] * v0[j][0] + v0[j][1] * v0[j][1]) + (v0[j][2] * v0[j][2] + v0[j][3] * v0[j][3]); q1 += (v1[j][0] * v1[j][0] + v1[j][1] * v1[j][1]) + (v1[j][2] * v1[j][2] + v1[j][3] * v1[j][3]); }
            const float rs0 = 1.0f / sqrtf(wave_sum(q0) * (1.0f / DM) + LN_EPS), rs1 = 1.0f / sqrtf(wave_sum(q1) * (1.0f / DM) + LN_EPS);
#pragma unroll
            for (int j = 0; j < 4; ++j) { const f32x4 g = *(const f32x4*)(p.ln1_g + 4 * lane + 256 * j), bb = *(const f32x4*)(p.ln1_b + 4 * lane + 256 * j);
                v0[j] = v0[j] * rs0 * g + bb; v1[j] = v1[j] * rs1 * g + bb;
                u32x2 h0, h1, l0, l1;
                h0.x = pk2(v0[j][0], v0[j][1]); h0.y = pk2(v0[j][2], v0[j][3]); h1.x = pk2(v1[j][0], v1[j][1]); h1.y = pk2(v1[j][2], v1[j][3]);
                *(u32x2*)(X1B + (size_t)tok * DM + 4 * lane + 256 * j) = h0; *(u32x2*)(X1B + (size_t)(tok + 1) * DM + 4 * lane + 256 * j) = h1;
                l0.x = pk2(v0[j][0] - __uint_as_float(h0.x << 16), v0[j][1] - __uint_as_float(h0.x & 0xffff0000u)); l0.y = pk2(v0[j][2] - __uint_as_float(h0.y << 16), v0[j][3] - __uint_as_float(h0.y & 0xffff0000u));
                l1.x = pk2(v1[j][0] - __uint_as_float(h1.x << 16), v1[j][1] - __uint_as_float(h1.x & 0xffff0000u)); l1.y = pk2(v1[j][2] - __uint_as_float(h1.y << 16), v1[j][3] - __uint_as_float(h1.y & 0xffff0000u));
                const int cb = (4 * lane + 256 * j) * 2;
                *(LAS u32x2*)(XH + rl * XP + cb) = h0; *(LAS u32x2*)(XH + (rl + 1) * XP + cb) = h1;
                *(LAS u32x2*)(XL + rl * XP + cb) = l0; *(LAS u32x2*)(XL + (rl + 1) * XP + cb) = l1; }
            __syncthreads();
            f32x4 acc[2]; acc[0] = (f32x4){0.f, 0.f, 0.f, 0.f}; acc[1] = acc[0];
            { const int aoff = (lane & 15) * XP + (lane >> 4) * 16;
#pragma unroll
              for (int ksl = 0; ksl < 4; ++ksl) { const int ko = (4 * wave + ksl) * 64;
                  const bf16x8 xh = *(const LAS bf16x8*)(XH + aoff + ko), xl = *(const LAS bf16x8*)(XL + aoff + ko);
#pragma unroll
                  for (int eh = 0; eh < 2; ++eh) { acc[eh] = __builtin_amdgcn_mfma_f32_16x16x32_bf16(xh, bw[0][ksl][eh], acc[eh], 0, 0, 0);
                      acc[eh] = __builtin_amdgcn_mfma_f32_16x16x32_bf16(xl, bw[0][ksl][eh], acc[eh], 0, 0, 0);
                      acc[eh] = __builtin_amdgcn_mfma_f32_16x16x32_bf16(xh, bw[1][ksl][eh], acc[eh], 0, 0, 0); } } }
#pragma unroll
            for (int eh = 0; eh < 2; ++eh)
#pragma unroll
                for (int r = 0; r < 4; ++r) PART[(wave * 16 + 4 * (lane >> 4) + r) * 32 + 16 * eh + (lane & 15)] = acc[eh][r];
            __syncthreads();
            { const int hf = lane >> 5, me = lane & 31, row = rl + hf; float my = brt;
#pragma unroll
              for (int w8 = 0; w8 < 8; ++w8) my += PART[(w8 * 16 + row) * 32 + me];
              LAS float* lg = LG + row * 32; lg[me] = my;
              asm volatile("s_waitcnt lgkmcnt(0)" ::: "memory");
              int rank = 0;
#pragma unroll
              for (int e4 = 0; e4 < 8; ++e4) { const f32x4 vv = *(const LAS f32x4*)(lg + 4 * e4);
#pragma unroll
                  for (int k = 0; k < 4; ++k) rank += (vv[k] > my || (vv[k] == my && (4 * e4 + k) < me)) ? 1 : 0; }
              int ti[4];
#pragma unroll
              for (int k = 0; k < 4; ++k) { const unsigned long long bal = __ballot(rank == k); const int ia = __ffs((int)(unsigned)(bal & 0xffffffffull)) - 1, ib = __ffs((int)(unsigned)(bal >> 32)) - 1; ti[k] = hf ? ib : ia; }
              if (me == 0) { const float t0 = lg[ti[0]], e1 = expf(lg[ti[1]] - t0), e2 = expf(lg[ti[2]] - t0), e3 = expf(lg[ti[3]] - t0); const float is = 1.0f / (1.0f + e1 + e2 + e3);
                  const int tk = tok + hf, tll = tl + hf;
                  *(f32x4*)(tgate + (size_t)tk * 4) = (f32x4){is, e1 * is, e2 * is, e3 * is};
                  int* tp = tidx + (size_t)tk * 4; tp[0] = ti[0]; tp[1] = ti[1]; tp[2] = ti[2]; tp[3] = ti[3];
                  lidx[tll * 4 + 0] = ti[0]; lidx[tll * 4 + 1] = ti[1]; lidx[tll * 4 + 2] = ti[2]; lidx[tll * 4 + 3] = ti[3]; } }
        }
        __syncthreads();
        if (tid < 32) { unsigned c = 0; for (int a = 0; a < 256; ++a) c += (lidx[a] == tid) ? 1u : 0u; hist[chunk * 32 + tid] = c; }
        __syncthreads();
    }
}

__device__ __forceinline__ void phase_assign(const Params& p, LAS unsigned char* lds, int vcu, int G) {
    const int tid = threadIdx.x;
    unsigned char* ws = p.ws;
    const int* tidx = (const int*)(ws + WS_TIDX); const float* tgate = (const float*)(ws + WS_TGATE); const unsigned* hist = (const unsigned*)(ws + WS_HIST);
    int* dest = (int*)(ws + WS_DEST); int* row_tok = (int*)(ws + WS_ROWTOK); float* row_gate = (float*)(ws + WS_ROWGATE); int* tile_e = (int*)(ws + WS_TILEE);
    LAS int* lidx = (LAS int*)lds;
    LAS int* lcnt = (LAS int*)(lds + 1024);
    LAS int* lpre = (LAS int*)(lds + 1024 + 128);
    LAS int* lstart = (LAS int*)(lds + 1024 + 256);
    LAS int* ptot = (LAS int*)(lds + 2048);
    LAS int* ppre = (LAS int*)(lds + 4096);
    for (int chunk = vcu; chunk < NCHUNK; chunk += G) {
        if (tid < 256) lidx[tid] = tidx[chunk * 256 + tid];
        { const int e = tid & 31, cg = tid >> 5; int tot = 0, pre = 0;
#pragma unroll
          for (int k = 0; k < 16; ++k) { const int c = cg * 16 + k; const int hv = (int)hist[c * 32 + e]; tot += hv; pre += (c < chunk) ? hv : 0; }
          ptot[cg * 32 + e] = tot; ppre[cg * 32 + e] = pre; }
        __syncthreads();
        if (tid < 32) { int tot = 0, pre = 0;
#pragma unroll
            for (int cg = 0; cg < 16; ++cg) { tot += ptot[cg * 32 + tid]; pre += ppre[cg * 32 + tid]; }
            lcnt[tid] = tot; lpre[tid] = pre; }
        __syncthreads();
        if (tid == 0) { int s2 = 0; for (int e = 0; e < 32; ++e) { lstart[e] = s2; s2 += (lcnt[e] + 255) / 256 * 256; } lstart[32] = s2; }
        __syncthreads();
        if (tid < 256) { const int e = lidx[tid]; int rank = 0; for (int a = 0; a < tid; ++a) rank += (lidx[a] == e) ? 1 : 0;
            const int P = lstart[e] + lpre[e] + rank, tok = chunk * 64 + (tid >> 2);
            row_tok[P] = tok; row_gate[P] = tgate[chunk * 256 + tid]; dest[chunk * 256 + tid] = P; }
        if (chunk < 32) { const int e = chunk; for (int P = lstart[e] + lcnt[e] + tid; P < lstart[e + 1]; P += NTHREADS) { row_tok[P] = 0; row_gate[P] = 0.f; } }
        if (chunk == 0) { if (tid < 32) { for (int t = lstart[tid] / 256; t < lstart[tid + 1] / 256; ++t) tile_e[t] = tid; } if (tid == 32) tile_e[MAXTILES] = lstart[32] / 256; }
        __syncthreads();
    }
}

__device__ __forceinline__ void phase_final(const Params& p, int vcu, int G, float* outp) {
    const int tid = threadIdx.x, wave = tid >> 6, lane = tid & 63;
    unsigned char* ws = p.ws;
    const int* dest = (const int*)(ws + WS_DEST); const bf16_t* Y = (const bf16_t*)(ws + WS_Y); const bf16_t* X1B = (const bf16_t*)(ws + WS_X1B);
    const int gw = vcu * NWAVES + wave, NGW = G * NWAVES;
    for (int t0 = gw * 8; t0 < NTOK; t0 += NGW * 8) {
        const int dl = (lane < 32) ? dest[t0 * 4 + lane] : 0;
#pragma unroll
        for (int pr = 0; pr < 4; ++pr) {
            const int tok = t0 + 2 * pr;
            int P[2][4];
#pragma unroll
            for (int t = 0; t < 2; ++t)
#pragma unroll
                for (int k = 0; k < 4; ++k) P[t][k] = __builtin_amdgcn_readlane(dl, (2 * pr + t) * 4 + k);
            f32x4 v[2][4]; u32x2 y[2][4][4];
#pragma unroll
            for (int t = 0; t < 2; ++t)
#pragma unroll
                for (int j = 0; j < 4; ++j) { const u32x2 xw = *(const u32x2*)(X1B + (size_t)(tok + t) * DM + 4 * lane + 256 * j);
                    v[t][j] = (f32x4){__uint_as_float(xw.x << 16), __uint_as_float(xw.x & 0xffff0000u), __uint_as_float(xw.y << 16), __uint_as_float(xw.y & 0xffff0000u)};
#pragma unroll
                    for (int k = 0; k < 4; ++k) y[t][k][j] = *(const u32x2*)(Y + (size_t)P[t][k] * 1024 + 4 * lane + 256 * j); }
            float s[2], q[2];
#pragma unroll
            for (int t = 0; t < 2; ++t) { s[t] = 0.f;
#pragma unroll
                for (int j = 0; j < 4; ++j) { v[t][j] = v[t][j] * DN_ALPHA;
#pragma unroll
                    for (int k = 0; k < 4; ++k) { const u32x2 w = y[t][k][j];
                        v[t][j][0] += __uint_as_float(w.x << 16); v[t][j][1] += __uint_as_float(w.x & 0xffff0000u); v[t][j][2] += __uint_as_float(w.y << 16); v[t][j][3] += __uint_as_float(w.y & 0xffff0000u); }
                    s[t] += (v[t][j][0] + v[t][j][1]) + (v[t][j][2] + v[t][j][3]); } }
            const float mean0 = wave_sum(s[0]) * (1.0f / DM), mean1 = wave_sum(s[1]) * (1.0f / DM);
            q[0] = 0.f; q[1] = 0.f;
#pragma unroll
            for (int j = 0; j < 4; ++j) { v[0][j] = v[0][j] - mean0; v[1][j] = v[1][j] - mean1;
                q[0] += (v[0][j][0] * v[0][j][0] + v[0][j][1] * v[0][j][1]) + (v[0][j][2] * v[0][j][2] + v[0][j][3] * v[0][j][3]);
                q[1] += (v[1][j][0] * v[1][j][0] + v[1][j][1] * v[1][j][1]) + (v[1][j][2] * v[1][j][2] + v[1][j][3] * v[1][j][3]); }
            const float rs0 = 1.0f / sqrtf(wave_sum(q[0]) * (1.0f / DM) + LN_EPS), rs1 = 1.0f / sqrtf(wave_sum(q[1]) * (1.0f / DM) + LN_EPS);
#pragma unroll
            for (int j = 0; j < 4; ++j) { const f32x4 g = *(const f32x4*)(p.ln2_g + 4 * lane + 256 * j), bb = *(const f32x4*)(p.ln2_b + 4 * lane + 256 * j);
                *(f32x4*)(outp + (size_t)tok * DM + 4 * lane + 256 * j) = v[0][j] * rs0 * g + bb;
                *(f32x4*)(outp + (size_t)(tok + 1) * DM + 4 * lane + 256 * j) = v[1][j] * rs1 * g + bb; }
        }
    }
}

constexpr int NPHASE = 11;
__global__ void __launch_bounds__(NTHREADS, 2) fwd_kernel(Params p) {
    extern __shared__ __attribute__((aligned(16))) unsigned char lds_raw[];
    LAS unsigned char* lds = (LAS unsigned char*)lds_raw;
    const int tid = threadIdx.x;
    const int G = gridDim.x, bx = blockIdx.x;
    const int vcu = (G % 8 == 0) ? (bx % 8) * (G / 8) + bx / 8 : bx;
    unsigned char* ws = p.ws;
    volatile LAS unsigned* MISC = (volatile LAS unsigned*)(lds + MISC_OFF);
    if (tid < 32) MISC[tid] = 0u;
    __syncthreads();
    XcdBarrier bar; bar.bar = (unsigned*)(ws + WS_CTL) + CW_BAR; bar.x = 0; bar.st = nullptr;
    const bool one = (p.ph_hi - p.ph_lo) > 1;
    if (one) bar = xcd_barrier_post((unsigned*)(ws + WS_CTL) + CW_BAR, MISC + 8);
    const int lo = p.ph_lo, hi = p.ph_hi;
#ifdef ONLY_PHASE
#define IN(k) ((k) == ONLY_PHASE && lo <= (k) && (k) < hi)
#else
#define IN(k) (lo <= (k) && (k) < hi)
#endif
#ifndef NAIVE_GEMM_MASK
#define NAIVE_GEMM_MASK 0
#endif
#define GEMM_CALL(EPI, SCHED) do { if constexpr (NAIVE_GEMM_MASK != 0) gemm_phase_naive<EPI, SCHED>(lds, g, S, E); else gemm_phase<EPI, SCHED, true>(lds, g, S, E); } while (0)
#ifndef ATTN_VAR
#define ATTN_VAR 0
#endif
#ifndef REPEAT_PHASE
#define REPEAT_PHASE (-1)
#endif
#define SEAM(k) do { if (IN(k) && IN((k) == 1 ? 3 : (k) + 1)) xcd_barrier(bar); } while (0)

#define PHASE(k, ...) do { if (IN(k)) { if constexpr (REPEAT_PHASE == (k)) { __VA_ARGS__; xcd_barrier(bar); } __VA_ARGS__; } SEAM(k); } while (0)
    PHASE(0, phase_prologue(p, lds, vcu, G));
    PHASE(1, { GemmArgs g{(const bf16_t*)(ws + WS_XB), 1024, (const bf16_t*)(ws + WS_WIN), 1024, 1024}; DenseSched S; S.init(lds, NTOK, PN, G, vcu);
        EpiProj E{ws}; GEMM_CALL(EpiProj, DenseSched); });
    PHASE(3, { { GemmArgs g{(const bf16_t*)(ws + WS_LAT), KUP, (const bf16_t*)(ws + WS_WUP), KUP, 256}; DenseSched S; S.init(lds, NTOK, 768, G, vcu);
          EpiUp E{(bf16_t*)(ws + WS_QM), (bf16_t*)(ws + WS_KM), (bf16_t*)(ws + WS_VM), (const float*)(ws + WS_RSTDP), (const float*)(ws + WS_ROPEA), 0}; GEMM_CALL(EpiUp, DenseSched); }
        { GemmArgs g{(const bf16_t*)(ws + WS_LAT) + 256, KUP, (const bf16_t*)(ws + WS_WUP) + (size_t)768 * KUP + 256, KUP, 128}; DenseSched S; S.init(lds, NTOK, 1024, G, (vcu + 192) % G);
          EpiUp E{(bf16_t*)(ws + WS_QM), (bf16_t*)(ws + WS_KM), (bf16_t*)(ws + WS_VM), (const float*)(ws + WS_RSTDP), (const float*)(ws + WS_ROPEA), 24}; GEMM_CALL(EpiUp, DenseSched); } });
    if constexpr (REPEAT_PHASE == 44) { if (IN(4)) { phase_attn_fast<ATTN_VAR>(p, lds, vcu, G, false); xcd_barrier(bar); } }
    PHASE(4, phase_attn_fast<0>(p, lds, vcu, G, true));
    PHASE(5, { GemmArgs g{(const bf16_t*)(ws + WS_ATT), 1024, (const bf16_t*)(ws + WS_WO), 1024, 1024}; DenseSched S; S.init(lds, NTOK, DM, G, vcu);
        EpiWo E{p.x, (float*)(ws + WS_X1PRE)}; GEMM_CALL(EpiWo, DenseSched); });
    PHASE(6, phase_ln1_route(p, lds, vcu, G));
    PHASE(7, phase_assign(p, lds, vcu, G));
    PHASE(8, { GemmArgs g{(const bf16_t*)(ws + WS_X1B), 1024, (const bf16_t*)(ws + WS_WGU), 1024, 1024}; GroupSched<true> S; S.init(lds, (const int*)(ws + WS_TILEE), (const int*)(ws + WS_ROWTOK), 8, 2048, G, vcu);
        EpiGateUp E{(bf16_t*)(ws + WS_H), p.b_gate, p.b_up}; GEMM_CALL(EpiGateUp, GroupSched<true>); });
    PHASE(9, { GemmArgs g{(const bf16_t*)(ws + WS_H), 1024, (const bf16_t*)(ws + WS_WD), 1024, 1024}; GroupSched<false> S; S.init(lds, (const int*)(ws + WS_TILEE), (const int*)(ws + WS_ROWTOK), 4, 1024, G, vcu);
        EpiDown E{(bf16_t*)(ws + WS_Y), p.b_down, (const float*)(ws + WS_ROWGATE)}; GEMM_CALL(EpiDown, GroupSched<false>); });
    if (IN(10)) { if constexpr (REPEAT_PHASE == 10) { phase_final(p, vcu, G, (float*)(ws + WS_X1PRE)); xcd_barrier(bar); } phase_final(p, vcu, G, p.out); }
#undef IN
#undef SEAM
}

extern "C" void kernel_launch(void* const* d_in, const int* in_sizes, int n_in, void* d_out, int out_size, void* d_ws, size_t ws_size, hipStream_t stream) {
    static int grid = 0;
    if (grid == 0) {
        if (n_in != 20 || out_size != NTOK * DM || ws_size < WS_END) { fprintf(stderr, "kernel_launch: unexpected shapes (n_in %d out %d ws %zu)\n", n_in, out_size, ws_size); grid = -1; return; }
        int dev = 0, cus = 0, per_cu = 0;
        if (hipGetDevice(&dev) != hipSuccess || hipDeviceGetAttribute(&cus, hipDeviceAttributeMultiprocessorCount, dev) != hipSuccess) { grid = -1; return; }
        if (hipFuncSetAttribute((const void*)fwd_kernel, hipFuncAttributeMaxDynamicSharedMemorySize, LDS_BYTES) != hipSuccess) { fprintf(stderr, "kernel_launch: hipFuncSetAttribute failed\n"); grid = -1; return; }
        if (hipOccupancyMaxActiveBlocksPerMultiprocessor(&per_cu, (const void*)fwd_kernel, NTHREADS, LDS_BYTES) != hipSuccess || per_cu < 1) fprintf(stderr, "kernel_launch: occupancy query says %d\n", per_cu);
        (void)hipGetLastError();
        grid = cus;
    }
    if (grid < 0) return;
    (void)hipMemsetAsync((char*)d_ws + WS_CTL, 0, CTL_ZERO_BYTES, stream);
    Params p{};
    p.x = (const float*)d_in[0]; p.pos = (const int*)d_in[1]; p.w_in = (const float*)d_in[2]; p.q_a_norm = (const float*)d_in[3]; p.w_q_b = (const float*)d_in[4];
    p.kv_a_norm = (const float*)d_in[5]; p.w_kv_b = (const float*)d_in[6]; p.w_o = (const float*)d_in[7]; p.ln1_g = (const float*)d_in[8]; p.ln1_b = (const float*)d_in[9];
    p.w_router = (const float*)d_in[10]; p.b_router = (const float*)d_in[11]; p.w_gate = (const float*)d_in[12]; p.b_gate = (const float*)d_in[13];
    p.w_up = (const float*)d_in[14]; p.b_up = (const float*)d_in[15]; p.w_down = (const float*)d_in[16]; p.b_down = (const float*)d_in[17];
    p.ln2_g = (const float*)d_in[18]; p.ln2_b = (const float*)d_in[19];
    p.out = (float*)d_out; p.ws = (unsigned char*)d_ws;
    for (int i = 0; i < 16; ++i) p.invfA[i] = pow(500000.0, -(double)(2 * i) / 32.0);
    for (int i = 0; i < 8; ++i) p.invfB[i] = pow(500000.0, -(double)(2 * i) / 16.0);
#if MK_ONE_LAUNCH
    p.ph_lo = 0; p.ph_hi = NPHASE;
    hipLaunchKernelGGL(fwd_kernel, dim3(grid), dim3(NTHREADS), LDS_BYTES, stream, p);
#else
    for (int ph = 0; ph < NPHASE; ++ph) { p.ph_lo = ph; p.ph_hi = ph + 1; hipLaunchKernelGGL(fwd_kernel, dim3(grid), dim3(NTHREADS), LDS_BYTES, stream, p); }
#endif
}
```

```cpp
#include <hip/hip_runtime.h>
#include <cstdio>
#include <cstdint>
#include <cmath>

#ifndef MK_ONE_LAUNCH
#define MK_ONE_LAUNCH 1
#endif

#define GAS __attribute__((address_space(1)))
#define LAS __attribute__((address_space(3)))
typedef unsigned short bf16_t;
typedef short bf16x8 __attribute__((ext_vector_type(8)));
typedef float f32x4 __attribute__((ext_vector_type(4)));
typedef float f32x2 __attribute__((ext_vector_type(2)));
typedef unsigned u32x4 __attribute__((ext_vector_type(4)));
typedef unsigned u32x2 __attribute__((ext_vector_type(2)));

constexpr int NTOK = 16384, DM = 1024, SEQ = 2048, NBATCH = 8;
constexpr int PN = 2048;
constexpr int C_QL = 0, C_KVL = 256, C_KR = 384, C_MQ = 416, C_MK = 928, C_MV = 1440, IN_COLS = 1952;
constexpr int NUP = 1792, KUP = 384;
constexpr int NE = 32, TOPK = 4;
constexpr int MAXROWS = 65536 + NE * 256, MAXTILES = MAXROWS / 256;
constexpr int NCHUNK = NTOK / 64;
constexpr float LN_EPS = 1e-5f, RMS_EPS = 1e-6f;
constexpr float DN_ALPHA = 1.189207115002721f;
constexpr float LOG2E = 1.4426950408889634f;
constexpr float C2A = 0.10206207261596575f * LOG2E;
constexpr float C2B = 0.125f * LOG2E;
constexpr int NWAVES = 8, NTHREADS = 512;

constexpr size_t MiB = 1u << 20;
constexpr size_t WS_CTL = 0, CTL_ZERO_BYTES = 1 * MiB;
constexpr size_t WS_HIST = 1 * MiB;
constexpr size_t WS_TIDX = WS_HIST + 64 * 1024;
constexpr size_t WS_TGATE = WS_TIDX + 256 * 1024;
constexpr size_t WS_DEST = WS_TGATE + 256 * 1024;
constexpr size_t WS_ROWTOK = WS_DEST + 256 * 1024;
constexpr size_t WS_ROWGATE = WS_ROWTOK + 288 * 1024;
constexpr size_t WS_TILEE = WS_ROWGATE + 288 * 1024;
constexpr size_t WS_RSTD = WS_TILEE + 4 * 1024;
constexpr size_t WS_KMEAN = WS_RSTD + 128 * 1024;
constexpr size_t WS_WRL = WS_KMEAN + 128 * 1024;
static_assert(WS_WRL + 128 * 1024 <= 4 * MiB, "route region");
constexpr size_t WS_ROPEA = 4 * MiB;
constexpr size_t WS_ROPEB = 6 * MiB;
constexpr size_t WS_WIN = 8 * MiB;
constexpr size_t WS_WO = 12 * MiB;
constexpr size_t WS_WUP = 14 * MiB;
constexpr size_t WS_X1B = 16 * MiB;
constexpr size_t WS_WD = 48 * MiB;
constexpr size_t WS_XB = 112 * MiB;
constexpr size_t WS_PROJ = 144 * MiB;
constexpr size_t WS_QM = 208 * MiB;
constexpr size_t WS_KM = 232 * MiB;
constexpr size_t WS_VM = 256 * MiB;
constexpr size_t WS_QB = 272 * MiB;
constexpr size_t WS_KB = 288 * MiB;
constexpr size_t WS_ATT = 304 * MiB;
constexpr size_t WS_H = 112 * MiB;
constexpr size_t WS_WGU = 336 * MiB;
constexpr size_t WS_Y = 336 * MiB;
constexpr size_t WS_LAT = 144 * MiB;
constexpr size_t WS_VB = 160 * MiB;
constexpr size_t WS_RSTDP = 176 * MiB;
constexpr size_t WS_KMEANP = 177 * MiB;
constexpr size_t WS_X1PRE = 144 * MiB;
constexpr size_t WS_END = 480 * MiB;
static_assert(WS_H + (size_t)MAXROWS * 1024 * 2 <= WS_VM + 0 * MiB + 0 && WS_Y + (size_t)MAXROWS * 1024 * 2 <= WS_END, "ws map");
constexpr int CW_BAR = 4096;

constexpr int LDS_BYTES = 147456;
constexpr int MISC_OFF = 131072 + 320;

__device__ __forceinline__ float bf2f(unsigned v) { return __uint_as_float(v << 16); }
__device__ __forceinline__ unsigned f2bf(float f) { unsigned u = __float_as_uint(f); return (u + 0x7fffu + ((u >> 16) & 1u)) >> 16; }
__device__ __forceinline__ unsigned pk2(float lo, float hi) { typedef __bf16 bf2_t __attribute__((ext_vector_type(2))); f32x2 v = {lo, hi}; bf2_t b = __builtin_convertvector(v, bf2_t); return __builtin_bit_cast(unsigned, b); }
__device__ __forceinline__ float wave_sum(float v) {
#pragma unroll
    for (int o = 1; o < 64; o <<= 1) v += __shfl_xor(v, o);
    return v;
}
__device__ __forceinline__ float wave_max(float v) {
#pragma unroll
    for (int o = 1; o < 64; o <<= 1) v = fmaxf(v, __shfl_xor(v, o));
    return v;
}

#define XB_TMO      128
#define XB_XCNT(j)  (256  + 64 * (j))
#define XB_XSUB(j)  (1280 + 64 * (j))
#define XB_XGEN(j)  (2304 + 64 * (j))
#define XB_TOP      3328
#define XB_TOPGEN   3392
#define XCD_BAR_WORDS 3456
#define XB_SPIN_CAP (1u << 18)
__device__ __forceinline__ unsigned xb_ld(unsigned* p)              { return __hip_atomic_load(p, __ATOMIC_RELAXED, __HIP_MEMORY_SCOPE_AGENT); }
__device__ __forceinline__ unsigned xb_add(unsigned* p, unsigned v) { return __hip_atomic_fetch_add(p, v, __ATOMIC_RELAXED, __HIP_MEMORY_SCOPE_AGENT); }
__device__ __forceinline__ unsigned xb_xcc_id() { return (unsigned)__builtin_amdgcn_s_getreg((3 << 11) | 20) & 0xFu; }
#define XB_SPIN(cond, bar) do { unsigned _sp = 0; while (cond) { __builtin_amdgcn_s_sleep(1); \
    if ((++_sp & 255u) == 0u) { if (xb_ld(&(bar)[XB_TMO])) break; if (_sp > XB_SPIN_CAP) { atomicAdd(&(bar)[XB_TMO], 1u); break; } } } } while (0)
struct XcdBarrier { unsigned* bar; unsigned x; volatile LAS unsigned* st; };
__device__ __forceinline__ XcdBarrier xcd_barrier_post(unsigned* bar, volatile LAS unsigned* st) {
    XcdBarrier b; b.bar = bar; b.x = xb_xcc_id(); b.st = st;
    if (threadIdx.x == 0) (void)xb_add(&bar[XB_XCNT(b.x)], 1u);
    return b;
}
__device__ __forceinline__ void xcd_barrier_complete(unsigned* bar, unsigned x, unsigned& nloc, unsigned& nx) {
    const unsigned G = gridDim.x * gridDim.y * gridDim.z;
    unsigned sum, cnt, mine, sp = 0u;
    for (;;) {
        sum = 0u; cnt = 0u; mine = 0u;
#pragma unroll
        for (unsigned j = 0; j < 16; ++j) { const unsigned c = xb_ld(&bar[XB_XCNT(j)]); sum += c; cnt += (c > 0u) ? 1u : 0u; mine = (j == x) ? c : mine; }
        if (sum == G) break;
        __builtin_amdgcn_s_sleep(1);
        if ((++sp & 255u) == 0u) { if (xb_ld(&bar[XB_TMO])) break; if (sp > XB_SPIN_CAP) { atomicAdd(&bar[XB_TMO], 1u); break; } }
    }
    nloc = mine > 0u ? mine : 1u; nx = cnt > 0u ? cnt : 1u;
}
__device__ __forceinline__ void xcd_barrier(const XcdBarrier& b) {
    asm volatile("s_waitcnt vmcnt(0)" ::: "memory");
    __syncthreads();
    if (threadIdx.x == 0) {
        unsigned* bar = b.bar;
        __builtin_amdgcn_s_waitcnt(0);
        unsigned nloc = b.st[0], nx = b.st[1];
        if (nloc == 0u) { xcd_barrier_complete(bar, b.x, nloc, nx); b.st[0] = nloc; b.st[1] = nx; }
        const unsigned old = xb_add(&bar[XB_XSUB(b.x)], 1u);
        const unsigned gen = old / nloc;
        if (old + 1u == (gen + 1u) * nloc) {
            __builtin_amdgcn_fence(__ATOMIC_RELEASE, "agent");
            asm volatile("s_waitcnt vmcnt(0)" ::: "memory");
            const unsigned og = xb_add(&bar[XB_TOP], 1u);
            const unsigned tg = og / nx;
            if (og + 1u == (tg + 1u) * nx) xb_add(&bar[XB_TOPGEN], 1u);
            else XB_SPIN(xb_ld(&bar[XB_TOPGEN]) == tg, bar);
            __builtin_amdgcn_fence(__ATOMIC_ACQUIRE, "agent");
            xb_add(&bar[XB_XGEN(b.x)], 1u);
            asm volatile("s_waitcnt vmcnt(0)" ::: "memory");
        } else {
            XB_SPIN(xb_ld(&bar[XB_XGEN(b.x)]) == gen, bar);
            __builtin_amdgcn_fence(__ATOMIC_ACQUIRE, "agent");
            asm volatile("s_waitcnt vmcnt(0)" ::: "memory");
        }
    }
    __syncthreads();
}

struct Params {
    const float* x; const int* pos;
    const float *w_in, *q_a_norm, *w_q_b, *kv_a_norm, *w_kv_b, *w_o, *ln1_g, *ln1_b, *w_router, *b_router;
    const float *w_gate, *b_gate, *w_up, *b_up, *w_down, *b_down, *ln2_g, *ln2_b;
    float* out; unsigned char* ws;
    double invfA[16]; double invfB[8];
    int ph_lo, ph_hi;
};

struct Unit { int pm, pn, e; };
struct GemmArgs { const bf16_t* A; int lda; const bf16_t* Bt; int ldb; int K; };
template <bool PERM> __device__ __forceinline__ int ecol(int bj, int n, int wc, int fq) { return 128 * bj + 32 * wc + (PERM ? 8 * fq + 4 * n : 16 * n + 4 * fq); }

template <class Epi, class Sched>
__device__ __forceinline__ void gemm_phase_naive(LAS unsigned char* lds, const GemmArgs g, const Sched& S, const Epi& E) {
    const int tid = threadIdx.x, wid = __builtin_amdgcn_readfirstlane(tid >> 6), lane = tid & 63, wr = wid >> 2, wc = wid & 3, fr = lane & 15, fq = lane >> 4;
    Unit u;
    for (int ui = 0; S.next(ui, u); ++ui) {
        f32x4 acc[2][2][4][2];
#pragma unroll
        for (int a = 0; a < 2; ++a)
#pragma unroll
            for (int b = 0; b < 2; ++b)
#pragma unroll
                for (int m = 0; m < 4; ++m)
#pragma unroll
                    for (int n = 0; n < 2; ++n) acc[a][b][m][n] = (f32x4){0.f, 0.f, 0.f, 0.f};
        unsigned aoff[2][4];
#pragma unroll
        for (int a = 0; a < 2; ++a)
#pragma unroll
            for (int m = 0; m < 4; ++m) aoff[a][m] = (unsigned)S.arow(u, ui, 128 * a + 64 * wr + 16 * m + fr) * (unsigned)g.lda;
        const bf16_t* bb = g.Bt + (size_t)(S.brow0(u) + 32 * wc) * g.ldb;
        const unsigned bl0 = (unsigned)(4 * fq) * (unsigned)g.ldb, bl1 = (unsigned)(8 * fq) * (unsigned)g.ldb;
#pragma unroll 1
        for (int k = 0; k < g.K; k += 2) {
            float af[2][4][2];
#pragma unroll
            for (int a = 0; a < 2; ++a)
#pragma unroll
                for (int m = 0; m < 4; ++m) { const unsigned v = *(const unsigned*)(g.A + aoff[a][m] + k); af[a][m][0] = __uint_as_float(v << 16); af[a][m][1] = __uint_as_float(v & 0xffff0000u); }
#pragma unroll
            for (int b = 0; b < 2; ++b)
#pragma unroll
                for (int n = 0; n < 2; ++n)
#pragma unroll
                    for (int j = 0; j < 4; ++j) {
                        const int ccol = 128 * b + (Epi::PERM ? 4 * n : 16 * n) + j;
                        const unsigned v = *(const unsigned*)(bb + (size_t)ccol * g.ldb + ((Epi::PERM ? bl1 : bl0) + (unsigned)k));
                        const float b0 = __uint_as_float(v << 16), b1 = __uint_as_float(v & 0xffff0000u);
#pragma unroll
                        for (int a = 0; a < 2; ++a)
#pragma unroll
                            for (int m = 0; m < 4; ++m) acc[a][b][m][n][j] = fmaf(af[a][m][1], b1, fmaf(af[a][m][0], b0, acc[a][b][m][n][j]));
                    }
        }
        E(acc, u, wr, wc, fr, fq);
    }
}

namespace pg {
constexpr int BK = 64, HALF = 128, HTB = HALF * BK * 2;
__device__ __forceinline__ int lds_byte(int r, int c) { const int st = (r >> 4) * 2 + (c >> 5), rr = r & 15, cc = c & 31, ob = rr * 64 + cc * 2; return st * 1024 + (ob ^ (((ob >> 9) & 1) << 5)); }
__device__ __forceinline__ void stage_rc(int b, int& R, int& C) { const int st = b / 1024, sb = b % 1024, swz = sb ^ (((sb >> 9) & 1) << 5); R = (st >> 1) * 16 + swz / 64; C = (st & 1) * 32 + (swz % 64) / 2; }
__device__ __forceinline__ int perm32(int rho) { const int n = rho >> 4, i = rho & 15; return 8 * (i >> 2) + 4 * n + (i & 3); }
}
template <class Epi, class Sched, bool ALIGN_EPI>
__device__ __forceinline__ void gemm_phase(LAS unsigned char* lds, const GemmArgs g, const Sched& S, const Epi& E) {
    using namespace pg;
    const int tid = threadIdx.x, wid = __builtin_amdgcn_readfirstlane(tid >> 6), lane = tid & 63, wr = wid >> 2, wc = wid & 3, fr = lane & 15, fq = lane >> 4;
    const int nt = g.K / BK;
    int sR[2], sC[2], sRb[2];
#pragma unroll
    for (int i = 0; i < 2; ++i) { int R, C; stage_rc(tid * 16 + i * 8192, R, C); sR[i] = R; sC[i] = C; sRb[i] = Epi::PERM ? ((R & ~31) + perm32(R & 31)) : R; }
    const unsigned ldsw = (unsigned)wid * 1024u;
    const int aoff = lds_byte(wr * 64 + fr, fq * 8), boff = lds_byte(wc * 32 + fr, fq * 8);
    const char* Ab = (const char*)g.A; const char* Bb = (const char*)g.Bt;
#define PG_SA(b, h) (((b) * 2 + (h)) * HTB)
#define PG_SB(b, h) ((4 + (b) * 2 + (h)) * HTB)
#define PG_STAGE(bufoff, gptr, v0, v1) do { \
        __builtin_amdgcn_global_load_lds((const unsigned*)((gptr) + (v0)), (LAS unsigned*)(lds + (bufoff) + ldsw), 16, 0, 0); \
        __builtin_amdgcn_global_load_lds((const unsigned*)((gptr) + (v1)), (LAS unsigned*)(lds + (bufoff) + ldsw + 8192), 16, 0, 0); } while (0)
#define PG_LDA(dst, b, h) do { _Pragma("unroll") for (int m = 0; m < 4; ++m) _Pragma("unroll") for (int k = 0; k < 2; ++k) dst[m][k] = *(const LAS bf16x8*)(lds + PG_SA(b, h) + aoff + m * 2048 + k * 1024); } while (0)
#define PG_LDB(dst, b, h) do { _Pragma("unroll") for (int n = 0; n < 2; ++n) _Pragma("unroll") for (int k = 0; k < 2; ++k) dst[n][k] = *(const LAS bf16x8*)(lds + PG_SB(b, h) + boff + n * 2048 + k * 1024); } while (0)
#define PG_MMA(ai, bj, At, Bt) do { __builtin_amdgcn_s_setprio(1); _Pragma("unroll") for (int m = 0; m < 4; ++m) _Pragma("unroll") for (int n = 0; n < 2; ++n) _Pragma("unroll") for (int k = 0; k < 2; ++k) \
        acc[ai][bj][m][n] = __builtin_amdgcn_mfma_f32_16x16x32_bf16(Bt[n][k], At[m][k], acc[ai][bj][m][n], 0, 0, 0); __builtin_amdgcn_s_setprio(0); } while (0)
#define PG_WAIT_V(n) asm volatile("s_waitcnt vmcnt(" #n ")" ::: "memory")
#define PG_WAIT_L(n) asm volatile("s_waitcnt lgkmcnt(" #n ")" ::: "memory")
#define PG_BAR __builtin_amdgcn_s_barrier()
#define PG_SCHED __builtin_amdgcn_sched_barrier(0)
    constexpr bool GA = Sched::GATHER;
    unsigned cA[2], cB[2];
#pragma unroll
    for (int i = 0; i < 2; ++i) { cA[i] = ((unsigned)sR[i] * (unsigned)g.lda + (unsigned)sC[i]) * 2u; cB[i] = ((unsigned)sRb[i] * (unsigned)g.ldb + (unsigned)sC[i]) * 2u; }
    const size_t hA = (size_t)128 * g.lda * 2, hB = (size_t)128 * g.ldb * 2;
#define PG_GOFFS(u, uidx, VA) do { if constexpr (GA) { _Pragma("unroll") for (int h = 0; h < 2; ++h) _Pragma("unroll") for (int i = 0; i < 2; ++i) \
        VA[h][i] = ((unsigned)S.arow(u, uidx, 128 * h + sR[i]) * (unsigned)g.lda + (unsigned)sC[i]) * 2u; } } while (0)
#define PG_UA(u) (GA ? (size_t)0 : (size_t)S.arow(u, 0, 0) * g.lda * 2)
#define PG_UB(u) ((size_t)S.brow0(u) * g.ldb * 2)
#define PG_STAGE_A(bufoff, ab, VA, h) do { if constexpr (GA) { PG_STAGE(bufoff, (ab), VA[h][0], VA[h][1]); } else { PG_STAGE(bufoff, (ab) + (h) * hA, cA[0], cA[1]); } } while (0)
#define PG_STAGE_B(bufoff, bb, h) PG_STAGE(bufoff, (bb) + (h) * hB, cB[0], cB[1])
    Unit cur, nxt; int ui = 0;
    if (!S.next(0, cur)) return;
    f32x4 acc[2][2][4][2];
#pragma unroll
    for (int a = 0; a < 2; ++a)
#pragma unroll
        for (int b = 0; b < 2; ++b)
#pragma unroll
            for (int m = 0; m < 4; ++m)
#pragma unroll
                for (int n = 0; n < 2; ++n) acc[a][b][m][n] = (f32x4){0.f, 0.f, 0.f, 0.f};
    bf16x8 At[4][2], B0[2][2], B1[2][2];
    unsigned vA[2][2], nvA[2][2];
    PG_GOFFS(cur, 0, vA);
    const char* cAp = Ab + PG_UA(cur); const char* cBp = Bb + PG_UB(cur);
    PG_STAGE_B(PG_SB(0, 0), cBp, 0); PG_STAGE_B(PG_SB(0, 1), cBp, 1); PG_STAGE_A(PG_SA(0, 0), cAp, vA, 0); PG_STAGE_A(PG_SA(0, 1), cAp, vA, 1);
    if (wr == 1) PG_BAR;
    PG_WAIT_V(2); PG_BAR;
    PG_STAGE_B(PG_SB(1, 0), cBp + 128, 0); PG_STAGE_A(PG_SA(1, 0), cAp + 128, vA, 0); PG_STAGE_B(PG_SB(1, 1), cBp + 128, 1);
    PG_WAIT_V(6); PG_BAR;
    for (;;) {
        const bool has_next = S.next(ui + 1, nxt);
        const char* nAp = cAp; const char* nBp = cBp;
        if (has_next) { PG_GOFFS(nxt, ui + 1, nvA); nAp = Ab + PG_UA(nxt); nBp = Bb + PG_UB(nxt); }
        else { if constexpr (GA) {
#pragma unroll
            for (int h = 0; h < 2; ++h)
#pragma unroll
                for (int i = 0; i < 2; ++i) nvA[h][i] = vA[h][i]; } }
#pragma unroll 1
        for (int t = 0; t < nt; t += 2) {
            const bool last = (t == nt - 2);
            const char* a1 = cAp + (size_t)(t + 1) * 128;
            const char* a2 = last ? nAp : cAp + (size_t)(t + 2) * 128; const char* b2 = last ? nBp : cBp + (size_t)(t + 2) * 128;
            const char* a3 = a2 + 128; const char* b3 = b2 + 128;
            unsigned wA[2][2];
            if constexpr (GA) {
#pragma unroll
                for (int h = 0; h < 2; ++h)
#pragma unroll
                    for (int i = 0; i < 2; ++i) wA[h][i] = last ? nvA[h][i] : vA[h][i]; }
            PG_LDB(B0, 0, 0); PG_LDB(B1, 0, 1); PG_SCHED; PG_LDA(At, 0, 0); PG_STAGE_A(PG_SA(1, 1), a1, vA, 1);
            PG_WAIT_V(8); PG_WAIT_L(0); PG_BAR; PG_MMA(0, 0, At, B0); PG_MMA(0, 1, At, B1); PG_BAR; PG_SCHED;
            PG_LDA(At, 0, 1); PG_STAGE_B(PG_SB(0, 0), b2, 0); PG_STAGE_B(PG_SB(0, 1), b2, 1); PG_STAGE_A(PG_SA(0, 0), a2, wA, 0);
            PG_WAIT_V(8); PG_WAIT_L(0); PG_BAR; PG_MMA(1, 0, At, B0); PG_MMA(1, 1, At, B1); PG_BAR; PG_SCHED;
            PG_LDB(B0, 1, 0); PG_LDB(B1, 1, 1); PG_SCHED; PG_LDA(At, 1, 0); PG_STAGE_A(PG_SA(0, 1), a2, wA, 1);
            PG_WAIT_V(8); PG_WAIT_L(0); PG_BAR; PG_MMA(0, 0, At, B0); PG_MMA(0, 1, At, B1); PG_BAR; PG_SCHED;
            PG_LDA(At, 1, 1); PG_STAGE_B(PG_SB(1, 0), b3, 0); PG_STAGE_B(PG_SB(1, 1), b3, 1); PG_STAGE_A(PG_SA(1, 0), a3, wA, 0);
            PG_WAIT_V(8); PG_WAIT_L(0); PG_BAR; PG_MMA(1, 0, At, B0); PG_MMA(1, 1, At, B1); PG_BAR; PG_SCHED;
        }
        if constexpr (ALIGN_EPI) { if (wr == 0) PG_BAR; }
        E(acc, cur, wr, wc, fr, fq);
        if (!has_next) break;
#pragma unroll
        for (int a = 0; a < 2; ++a)
#pragma unroll
            for (int b = 0; b < 2; ++b)
#pragma unroll
                for (int m = 0; m < 4; ++m)
#pragma unroll
                    for (int n = 0; n < 2; ++n) acc[a][b][m][n] = (f32x4){0.f, 0.f, 0.f, 0.f};
        cur = nxt; ++ui; cAp = nAp; cBp = nBp;
        if constexpr (GA) {
#pragma unroll
            for (int h = 0; h < 2; ++h)
#pragma unroll
                for (int i = 0; i < 2; ++i) vA[h][i] = nvA[h][i]; }
        if constexpr (ALIGN_EPI) { if (wr == 1) PG_BAR; }
    }
    PG_WAIT_V(0);
    if constexpr (!ALIGN_EPI) { if (wr == 0) PG_BAR; }
    PG_BAR;
#undef PG_SA
#undef PG_SB
#undef PG_STAGE
#undef PG_LDA
#undef PG_LDB
#undef PG_MMA
#undef PG_WAIT_V
#undef PG_WAIT_L
#undef PG_BAR
#undef PG_SCHED
#undef PG_GOFFS
#undef PG_UA
#undef PG_UB
#undef PG_STAGE_A
#undef PG_STAGE_B
}

constexpr int ROWTAB_OFF = 132096, ETAB_OFF = ROWTAB_OFF + 12 * 1024, MAXU = 12;
struct DenseSched {
    static constexpr bool GATHER = false;
    int nN, nunits, G, c;
    __device__ __forceinline__ void init(LAS unsigned char*, int M, int N, int G_, int c_) { nN = N / 256; nunits = (M / 256) * nN; G = G_; c = c_; }
    __device__ __forceinline__ bool next(int i, Unit& u) const { const int L = i * G + c; if (L >= nunits) return false; u.pm = L / nN; u.pn = L % nN; u.e = 0; return true; }
    __device__ __forceinline__ int arow(const Unit& u, int, int r) const { return 256 * u.pm + r; }
    __device__ __forceinline__ int brow0(const Unit& u) const { return 256 * u.pn; }
};
template <bool GATHER_> struct GroupSched {
    static constexpr bool GATHER = GATHER_;
    LAS int* rowtab; LAS int* etab; int nN, nexp_rows, nunits, G, c;
    __device__ __forceinline__ void init(LAS unsigned char* lds, const int* te, const int* rt, int nN_, int nexp_rows_, int G_, int c_) {
        rowtab = (LAS int*)(lds + ROWTAB_OFF); etab = (LAS int*)(lds + ETAB_OFF); nN = nN_; nexp_rows = nexp_rows_; G = G_; c = c_;
        nunits = __builtin_amdgcn_readfirstlane(te[MAXTILES]) * nN_;
        for (int i = 0; i < MAXU; ++i) { const int L = i * G + c; if (L >= nunits) break; const int pm = L / nN;
            if (threadIdx.x == 0) etab[i] = te[pm];
            if (GATHER && threadIdx.x < 256) rowtab[i * 256 + threadIdx.x] = rt[256 * pm + threadIdx.x]; }
        __syncthreads();
    }
    __device__ __forceinline__ bool next(int i, Unit& u) const { const int L = i * G + c; if (L >= nunits || i >= MAXU) return false; u.pm = L / nN; u.pn = L % nN; u.e = etab[i]; return true; }
    __device__ __forceinline__ int arow(const Unit& u, int ui, int r) const { return GATHER ? rowtab[ui * 256 + r] : 256 * u.pm + r; }
    __device__ __forceinline__ int brow0(const Unit& u) const { return u.e * nexp_rows + 256 * u.pn; }
};

struct EpiProj {
    static constexpr bool PERM = true;
    unsigned char* ws;
    __device__ __forceinline__ void operator()(const f32x4 (&acc)[2][2][4][2], const Unit& u, int wr, int wc, int fr, int fq) const {
        asm volatile("" : "+v"(fr), "+v"(fq));
        bf16_t* LAT = (bf16_t*)(ws + WS_LAT); bf16_t* KM = (bf16_t*)(ws + WS_KM); bf16_t* QB = (bf16_t*)(ws + WS_QB); bf16_t* KB = (bf16_t*)(ws + WS_KB); bf16_t* VB = (bf16_t*)(ws + WS_VB);
        float* rstdp = (float*)(ws + WS_RSTDP); float* kmeanp = (float*)(ws + WS_KMEANP);
        const float* ropeA = (const float*)(ws + WS_ROPEA); const float* ropeB = (const float*)(ws + WS_ROPEB);
#pragma unroll
        for (int b = 0; b < 2; ++b) {
            const int g = 8 * u.pn + 4 * b + wc;
            if (g < 12) {
#pragma unroll
                for (int a = 0; a < 2; ++a)
#pragma unroll
                    for (int m = 0; m < 4; ++m) { const int row = 256 * u.pm + 128 * a + 64 * wr + 16 * m + fr; const f32x4 v0 = acc[a][b][m][0], v1 = acc[a][b][m][1];
                        u32x4 w; w.x = pk2(v0[0], v0[1]); w.y = pk2(v0[2], v0[3]); w.z = pk2(v1[0], v1[1]); w.w = pk2(v1[2], v1[3]);
                        *(u32x4*)(LAT + (size_t)row * 384 + g * 32 + 8 * fq) = w;
                        float ss = 0.f;
#pragma unroll
                        for (int k = 0; k < 4; ++k) { const float e0 = __uint_as_float(w[k] << 16), e1 = __uint_as_float(w[k] & 0xffff0000u); ss += e0 * e0 + e1 * e1; }
                        ss += __shfl_xor(ss, 16); ss += __shfl_xor(ss, 32);
                        if (fq == 0) rstdp[(size_t)row * 12 + g] = ss; }
            } else if (g == 12) {
#pragma unroll
                for (int a = 0; a < 2; ++a)
#pragma unroll
                    for (int m = 0; m < 4; ++m) { const int row = 256 * u.pm + 128 * a + 64 * wr + 16 * m + fr; u32x4 w;
#pragma unroll
                        for (int n = 0; n < 2; ++n) { const f32x4 v = acc[a][b][m][n]; f32x4 pv;
#pragma unroll
                            for (int j = 0; j < 4; ++j) { auto rr = __builtin_amdgcn_permlane32_swap(__float_as_uint(v[j]), __float_as_uint(v[j]), false, false); pv[j] = __uint_as_float(fq < 2 ? rr[1] : rr[0]); }
                            const f32x4 c = *(const f32x4*)(ropeA + (size_t)row * 32 + 8 * (fq & 1) + 4 * n), sn = *(const f32x4*)(ropeA + (size_t)row * 32 + 16 + 8 * (fq & 1) + 4 * n);
                            const f32x4 o = (fq < 2) ? (v * c - pv * sn) : (v * c + pv * sn);
                            w[2 * n] = pk2(o[0], o[1]); w[2 * n + 1] = pk2(o[2], o[3]); }
#pragma unroll
                        for (int h = 0; h < 8; ++h) *(u32x4*)(KM + (size_t)row * 768 + h * 96 + 64 + 8 * fq) = w; }
            } else if (g < 45) {
                const bool isk = g >= 29; const int rel = isk ? g - 29 : g - 13, head = rel >> 1, hf = rel & 1;
                bf16_t* dst = (isk ? KB : QB) + head * 64 + hf * 32 + 8 * fq;
                f32x4 cs0 = (f32x4){0.f, 0.f, 0.f, 0.f}, cs1 = cs0;
#pragma unroll
                for (int a = 0; a < 2; ++a)
#pragma unroll
                    for (int m = 0; m < 4; ++m) { const int row = 256 * u.pm + 128 * a + 64 * wr + 16 * m + fr; f32x4 v0 = acc[a][b][m][0], v1 = acc[a][b][m][1];
                        if (hf == 0) {
#pragma unroll
                            for (int n = 0; n < 2; ++n) { const f32x4 v = n ? v1 : v0; f32x4 pv;
#pragma unroll
                                for (int j = 0; j < 4; ++j) { auto rr = __builtin_amdgcn_permlane16_swap(__float_as_uint(v[j]), __float_as_uint(v[j]), false, false); pv[j] = __uint_as_float((fq & 1) ? rr[0] : rr[1]); }
                                const f32x4 c = *(const f32x4*)(ropeB + (size_t)row * 16 + 4 * n), sn = *(const f32x4*)(ropeB + (size_t)row * 16 + 8 + 4 * n);
                                const f32x4 o = (fq == 0) ? (v * c - pv * sn) : (fq == 1) ? (v * c + pv * sn) : v;
                                if (n) v1 = o; else v0 = o; } }
                        if (isk) { cs0 += v0; cs1 += v1; }
                        const f32x4 s0 = isk ? v0 : v0 * C2B, s1 = isk ? v1 : v1 * C2B;
                        u32x4 w; w.x = pk2(s0[0], s0[1]); w.y = pk2(s0[2], s0[3]); w.z = pk2(s1[0], s1[1]); w.w = pk2(s1[2], s1[3]);
                        *(u32x4*)(dst + (size_t)row * 512) = w; }
                if (isk) {
#pragma unroll
                    for (int j = 0; j < 4; ++j) {
#pragma unroll
                        for (int o = 1; o < 16; o <<= 1) { cs0[j] += __shfl_xor(cs0[j], o); cs1[j] += __shfl_xor(cs1[j], o); } }
                    if (fr == 0) { float* kp = kmeanp + ((size_t)u.pm * 2 + wr) * 512 + head * 64 + hf * 32 + 8 * fq; *(f32x4*)kp = cs0; *(f32x4*)(kp + 4) = cs1; } }
            } else if (g < 61) {
                const int rel = g - 45;
#pragma unroll
                for (int a = 0; a < 2; ++a)
#pragma unroll
                    for (int m = 0; m < 4; ++m) { const int row = 256 * u.pm + 128 * a + 64 * wr + 16 * m + fr; const f32x4 v0 = acc[a][b][m][0], v1 = acc[a][b][m][1];
                        u32x4 w; w.x = pk2(v0[0], v0[1]); w.y = pk2(v0[2], v0[3]); w.z = pk2(v1[0], v1[1]); w.w = pk2(v1[2], v1[3]);
                        *(u32x4*)(VB + (size_t)row * 512 + rel * 32 + 8 * fq) = w; }
            }
            asm volatile("" ::: "memory");
        }
    }
};
struct EpiUp {
    static constexpr bool PERM = true;
    bf16_t *QM, *KM, *VM; const float* rstd; const float* ropeA; int gbase;
    __device__ __forceinline__ void operator()(const f32x4 (&acc)[2][2][4][2], const Unit& u, int wr, int wc, int fr, int fq) const {
        asm volatile("" : "+v"(fr), "+v"(fq));
#pragma unroll
        for (int a = 0; a < 2; ++a)
#pragma unroll
            for (int m = 0; m < 4; ++m) { const int row = 256 * u.pm + 128 * a + 64 * wr + 16 * m + fr;
                const f32x4 s0 = *(const f32x4*)(rstd + (size_t)row * 12), s1 = *(const f32x4*)(rstd + (size_t)row * 12 + 4), s2 = *(const f32x4*)(rstd + (size_t)row * 12 + 8);
                const float rq = C2A / sqrtf((((s0[0] + s0[1]) + (s0[2] + s0[3])) + ((s1[0] + s1[1]) + (s1[2] + s1[3]))) * (1.0f / 256.0f) + RMS_EPS);
                const float rkv = 1.0f / sqrtf(((s2[0] + s2[1]) + (s2[2] + s2[3])) * (1.0f / 128.0f) + RMS_EPS);
#pragma unroll
                for (int b = 0; b < 2; ++b) {
                    const int gidx = gbase + 8 * u.pn + 4 * b + wc;
                    if (gidx < 24) {
                        const int h = gidx / 3, part = gidx % 3;
                        f32x4 v0 = acc[a][b][m][0] * rq, v1 = acc[a][b][m][1] * rq;
                        if (part == 2) {
#pragma unroll
                            for (int n = 0; n < 2; ++n) { const f32x4 v = n ? v1 : v0; f32x4 pv;
#pragma unroll
                                for (int j = 0; j < 4; ++j) { auto rr = __builtin_amdgcn_permlane32_swap(__float_as_uint(v[j]), __float_as_uint(v[j]), false, false); pv[j] = __uint_as_float(fq < 2 ? rr[1] : rr[0]); }
                                const f32x4 c = *(const f32x4*)(ropeA + (size_t)row * 32 + 8 * (fq & 1) + 4 * n), sn = *(const f32x4*)(ropeA + (size_t)row * 32 + 16 + 8 * (fq & 1) + 4 * n);
                                const f32x4 o = (fq < 2) ? (v * c - pv * sn) : (v * c + pv * sn);
                                if (n) v1 = o; else v0 = o; } }
                        u32x4 w; w.x = pk2(v0[0], v0[1]); w.y = pk2(v0[2], v0[3]); w.z = pk2(v1[0], v1[1]); w.w = pk2(v1[2], v1[3]);
                        *(u32x4*)(QM + (size_t)row * 768 + h * 96 + part * 32 + 8 * fq) = w;
                    } else {
                        const int g2 = gidx - 24, h = g2 >> 2, part = g2 & 3;
                        const f32x4 v0 = acc[a][b][m][0] * rkv, v1 = acc[a][b][m][1] * rkv;
                        bf16_t* pp = (part < 2) ? (KM + (size_t)row * 768 + h * 96 + part * 32 + 8 * fq) : (VM + (size_t)row * 512 + h * 64 + (part - 2) * 32 + 8 * fq);
                        u32x4 w; w.x = pk2(v0[0], v0[1]); w.y = pk2(v0[2], v0[3]); w.z = pk2(v1[0], v1[1]); w.w = pk2(v1[2], v1[3]);
                        *(u32x4*)pp = w;
                    }
                }
                asm volatile("" ::: "memory"); }
    }
};
struct EpiWo {
    static constexpr bool PERM = false;
    const float* x; float* O;
    __device__ __forceinline__ void operator()(const f32x4 (&acc)[2][2][4][2], const Unit& u, int wr, int wc, int fr, int fq) const {
        asm volatile("" : "+v"(fr), "+v"(fq));
#pragma unroll
        for (int a = 0; a < 2; ++a)
#pragma unroll
            for (int m = 0; m < 4; ++m) { const int row = 256 * u.pm + 128 * a + 64 * wr + 16 * m + fr;
#pragma unroll
                for (int b = 0; b < 2; ++b)
#pragma unroll
                    for (int n = 0; n < 2; ++n) { const size_t off = (size_t)row * DM + 256 * u.pn + ecol<PERM>(b, n, wc, fq);
                        const f32x4 xv = *(const f32x4*)(x + off); *(f32x4*)(O + off) = xv * DN_ALPHA + acc[a][b][m][n]; } }
    }
};
struct EpiGateUp {
    static constexpr bool PERM = true;
    bf16_t* H; const float *bg, *bu;
    __device__ __forceinline__ void operator()(const f32x4 (&acc)[2][2][4][2], const Unit& u, int wr, int wc, int fr, int fq) const {
        asm volatile("" : "+v"(fr), "+v"(fq));
        const int hc = 128 * u.pn + 32 * wc + 8 * fq;
        f32x4 vbg[2], vbu[2];
#pragma unroll
        for (int n = 0; n < 2; ++n) { vbg[n] = *(const f32x4*)(bg + (size_t)u.e * 1024 + hc + 4 * n); vbu[n] = *(const f32x4*)(bu + (size_t)u.e * 1024 + hc + 4 * n); }
#pragma unroll
        for (int a = 0; a < 2; ++a)
#pragma unroll
            for (int m = 0; m < 4; ++m) { const int row = 256 * u.pm + 128 * a + 64 * wr + 16 * m + fr; u32x4 w;
#pragma unroll
                for (int n = 0; n < 2; ++n) { const f32x4 gv = acc[a][0][m][n] + vbg[n], uv = acc[a][1][m][n] + vbu[n]; float hv[4];
#pragma unroll
                    for (int j = 0; j < 4; ++j) { const float gg = fminf(gv[j], 7.0f), uu = fminf(fmaxf(uv[j], -7.0f), 7.0f);
                        const float sg = __builtin_amdgcn_rcpf(1.0f + __builtin_amdgcn_exp2f(-1.702f * LOG2E * gg)); hv[j] = gg * sg * (uu + 1.0f); }
                    w[2 * n] = pk2(hv[0], hv[1]); w[2 * n + 1] = pk2(hv[2], hv[3]); }
                __builtin_nontemporal_store(w, (u32x4*)(H + (size_t)row * 1024 + hc)); }
    }
};
struct EpiDown {
    static constexpr bool PERM = true;
    bf16_t* Y; const float* bd; const float* row_gate;
    __device__ __forceinline__ void operator()(const f32x4 (&acc)[2][2][4][2], const Unit& u, int wr, int wc, int fr, int fq) const {
        asm volatile("" : "+v"(fr), "+v"(fq));
        f32x4 bv[2][2];
#pragma unroll
        for (int b = 0; b < 2; ++b)
#pragma unroll
            for (int n = 0; n < 2; ++n) bv[b][n] = *(const f32x4*)(bd + (size_t)u.e * 1024 + 256 * u.pn + 128 * b + 32 * wc + 8 * fq + 4 * n);
#pragma unroll
        for (int a = 0; a < 2; ++a)
#pragma unroll
            for (int m = 0; m < 4; ++m) { const int row = 256 * u.pm + 128 * a + 64 * wr + 16 * m + fr; const float gw = row_gate[row];
#pragma unroll
                for (int b = 0; b < 2; ++b) { const int col = 256 * u.pn + 128 * b + 32 * wc + 8 * fq;
                    const f32x4 v0 = (acc[a][b][m][0] + bv[b][0]) * gw, v1 = (acc[a][b][m][1] + bv[b][1]) * gw;
                    u32x4 w; w.x = pk2(v0[0], v0[1]); w.y = pk2(v0[2], v0[3]); w.z = pk2(v1[0], v1[1]); w.w = pk2(v1[2], v1[3]);
                    __builtin_nontemporal_store(w, (u32x4*)(Y + (size_t)row * 1024 + col)); } }
    }
};

__device__ __forceinline__ unsigned cvtpk_hw(float lo, float hi) { typedef __bf16 bf2 __attribute__((ext_vector_type(2))); f32x2 v = {lo, hi}; bf2 b = __builtin_convertvector(v, bf2); return __builtin_bit_cast(unsigned, b); }
__device__ __forceinline__ void conv_issue(const float* W, int ldw, int k0, int n0, LAS unsigned char* scr, int lane) {
#pragma unroll
    for (int i = 0; i < 4; ++i) __builtin_amdgcn_global_load_lds((const unsigned*)(W + (size_t)(k0 + 4 * (lane >> 3) + i) * ldw + n0 + 4 * (lane & 7)), (LAS unsigned*)(scr + i * 1024), 16, 0, 2);
}
__device__ __forceinline__ void conv_finish(bf16_t* WT, int ldt, int orow0, int ocol0, const LAS unsigned char* scr, int lane) {
    f32x4 r[4];
#pragma unroll
    for (int i = 0; i < 4; ++i) r[i] = *(const LAS f32x4*)(scr + i * 1024 + lane * 16);
#pragma unroll
    for (int j = 0; j < 4; ++j) { u32x2 o; o.x = cvtpk_hw(r[0][j], r[1][j]); o.y = cvtpk_hw(r[2][j], r[3][j]);
        *(u32x2*)(WT + (size_t)(orow0 + 4 * (lane & 7) + j) * ldt + ocol0 + 4 * (lane >> 3)) = o; }
}
constexpr int NEXP_ITEMS = 3 * NE * 1024;
__device__ __forceinline__ void expert_issue(const Params& p, int r, LAS unsigned char* scr, int lane) {
    const int mat = r >> 15, rr = r & 32767, e = rr >> 10, q = rr & 1023, kb = (q & 1) | ((q >> 6) << 1), nb = (q >> 1) & 31;
    const float* W = (mat == 0 ? p.w_gate : mat == 1 ? p.w_up : p.w_down) + (size_t)e * 1048576;
    conv_issue(W, 1024, 32 * kb, 32 * nb, scr, lane);
}
__device__ __forceinline__ void expert_finish(const Params& p, int r, const LAS unsigned char* scr, int lane) {
    const int mat = r >> 15, rr = r & 32767, e = rr >> 10, q = rr & 1023, kb = (q & 1) | ((q >> 6) << 1), nb = (q >> 1) & 31, n0 = 32 * nb;
    bf16_t* WguT = (bf16_t*)(p.ws + WS_WGU); bf16_t* WdT = (bf16_t*)(p.ws + WS_WD);
    if (mat == 2) conv_finish(WdT, 1024, e * 1024 + n0, 32 * kb, scr, lane);
    else conv_finish(WguT, 1024, e * 2048 + (n0 >> 7) * 256 + (mat == 1 ? 128 : 0) + (n0 & 127), 32 * kb, scr, lane);
}
struct BgConv { int next, stride, pend0, pend1, itc; };

__device__ __forceinline__ void tr_item(const float* W, int ldw, int k0, int n0, bf16_t* WT, int ldt, int orow0, int ocol0, const float* kscale, LAS float* scr, int lane) {
#pragma unroll 8
    for (int i = 0; i < 32; ++i) { const int kk = 2 * i + (lane >> 5); float v = W[(size_t)(k0 + kk) * ldw + n0 + (lane & 31)]; if (kscale) v *= kscale[k0 + kk]; scr[kk * 33 + (lane & 31)] = v; }
    asm volatile("s_waitcnt lgkmcnt(0)" ::: "memory");
    const int c = lane & 7;
#pragma unroll
    for (int j = 0; j < 4; ++j) { const int n = (lane >> 3) + 8 * j; const LAS float* s = scr + (8 * c) * 33 + n;
        u32x4 o; o.x = pk2(s[0 * 33], s[1 * 33]); o.y = pk2(s[2 * 33], s[3 * 33]); o.z = pk2(s[4 * 33], s[5 * 33]); o.w = pk2(s[6 * 33], s[7 * 33]);
        *(u32x4*)(WT + (size_t)(orow0 + n) * ldt + ocol0 + 8 * c) = o; }
    asm volatile("s_waitcnt lgkmcnt(0)" ::: "memory");
}
__device__ __forceinline__ void phase_prologue(const Params& p, LAS unsigned char* lds, int vcu, int G) {
    const int tid = threadIdx.x, wave = tid >> 6, lane = tid & 63;
    unsigned char* ws = p.ws;
    LAS float* scr = (LAS float*)(lds + wave * 16384);
    const int gw = vcu * NWAVES + wave, NGW = G * NWAVES;
    bf16_t* WinT = (bf16_t*)(ws + WS_WIN); bf16_t* WoT = (bf16_t*)(ws + WS_WO); bf16_t* WupT = (bf16_t*)(ws + WS_WUP);
    constexpr int I_IN = 16 * 61, I_QB = 4 * 24, I_KVB = 2 * 32, I_O = 16 * 32;
    constexpr int NITEMS = I_IN + I_QB + I_KVB + I_O;
    for (int it = gw; it < NITEMS; it += NGW) {
        int r = it;
        if (r < I_IN) { const int kb = r / 61, nb = r % 61; tr_item(p.w_in, IN_COLS, 64 * kb, 32 * nb, WinT, 1024, 32 * nb, 64 * kb, nullptr, scr, lane); continue; } r -= I_IN;
        if (r < I_QB) { const int kb = r / 24, nb = r % 24; tr_item(p.w_q_b, 768, 64 * kb, 32 * nb, WupT, KUP, 32 * nb, 64 * kb, p.q_a_norm, scr, lane); continue; } r -= I_QB;
        if (r < I_KVB) { const int kb = r / 32, nb = r % 32; tr_item(p.w_kv_b, 1024, 64 * kb, 32 * nb, WupT, KUP, 768 + 32 * nb, 256 + 64 * kb, p.kv_a_norm, scr, lane); continue; } r -= I_KVB;
        { const int kb = r / 32, nb = r % 32; tr_item(p.w_o, 1024, 64 * kb, 32 * nb, WoT, 1024, 32 * nb, 64 * kb, nullptr, scr, lane); }
    }
    const int gt = vcu * NTHREADS + tid, NGT = G * NTHREADS;
    for (int i = gt; i < 96 * 128; i += NGT) *(u32x4*)(WinT + (size_t)IN_COLS * 1024 + (size_t)i * 8) = (u32x4){0u, 0u, 0u, 0u};
    for (int i = gt; i < 768 * 16; i += NGT) { const int r = i / 16, c = i % 16; *(u32x4*)(WupT + (size_t)r * KUP + 256 + c * 8) = (u32x4){0u, 0u, 0u, 0u}; }
    for (int i = gt; i < 1024 * 32; i += NGT) { const int r = i / 32, c = i % 32; *(u32x4*)(WupT + (size_t)(768 + r) * KUP + c * 8) = (u32x4){0u, 0u, 0u, 0u}; }
    bf16_t* XB = (bf16_t*)(ws + WS_XB);
    for (int i = gt; i < NTOK * DM / 8; i += NGT) { const f32x4 a = *(const f32x4*)(p.x + (size_t)i * 8), b = *(const f32x4*)(p.x + (size_t)i * 8 + 4);
        u32x4 o; o.x = pk2(a[0], a[1]); o.y = pk2(a[2], a[3]); o.z = pk2(b[0], b[1]); o.w = pk2(b[2], b[3]); *(u32x4*)(XB + (size_t)i * 8) = o; }
    { bf16_t* WRF = (bf16_t*)(ws + WS_WRL);
      for (int n = gt; n < 32768; n += NGT) { const int j = n & 7, ln = (n >> 3) & 63, eh = (n >> 9) & 1, ks = n >> 10;
          const float w = p.w_router[(size_t)(32 * ks + 8 * (ln >> 4) + j) * 32 + 16 * eh + (ln & 15)];
          const unsigned h = f2bf(w); const float wl = w - __uint_as_float(h << 16);
          WRF[n] = (bf16_t)h; WRF[32768 + n] = (bf16_t)f2bf(wl); } }
    float* ropeA = (float*)(ws + WS_ROPEA); float* ropeB = (float*)(ws + WS_ROPEB);
    for (int i = gt; i < NTOK * 24; i += NGT) { const int tok = i / 24, j = i % 24; const double f = (j < 16) ? p.invfA[j] : p.invfB[j - 16];
        const double rev = (double)p.pos[tok] * f * 0.15915494309189535; const float fr = (float)(rev - __builtin_rint(rev));
        const float cs = __builtin_amdgcn_cosf(fr), sn = __builtin_amdgcn_sinf(fr);
        if (j < 16) { ropeA[(size_t)tok * 32 + j] = cs; ropeA[(size_t)tok * 32 + 16 + j] = sn; } else { ropeB[(size_t)tok * 16 + (j - 16)] = cs; ropeB[(size_t)tok * 16 + 8 + (j - 16)] = sn; } }
}

__device__ __forceinline__ void phase_prep(const Params& p, LAS unsigned char* lds, int vcu, int G) {
    const int tid = threadIdx.x, wave = tid >> 6, lane = tid & 63;
    unsigned char* ws = p.ws;
    const bf16_t* PROJ = (const bf16_t*)(ws + WS_PROJ);
    float* rstd = (float*)(ws + WS_RSTD); const float* ropeA = (const float*)(ws + WS_ROPEA); const float* ropeB = (const float*)(ws + WS_ROPEB);
    bf16_t* KM = (bf16_t*)(ws + WS_KM); bf16_t* QB = (bf16_t*)(ws + WS_QB); bf16_t* KB = (bf16_t*)(ws + WS_KB); float* kmean = (float*)(ws + WS_KMEAN);
    const int gw = vcu * NWAVES + wave, NGW = G * NWAVES;
    for (int row = gw; row < NTOK; row += NGW) {
        float s = 0.f;
        if (lane < 48) { const u32x4 v = *(const u32x4*)(PROJ + (size_t)row * PN + lane * 8);
#pragma unroll
            for (int q = 0; q < 4; ++q) { const float a = __uint_as_float(v[q] << 16), b = __uint_as_float(v[q] & 0xffff0000u); s += a * a + b * b; } }
#pragma unroll
        for (int o = 1; o < 32; o <<= 1) s += __shfl_xor(s, o);
        if (lane == 0) rstd[2 * row] = 1.0f / sqrtf(s * (1.0f / 256.0f) + RMS_EPS);
        if (lane == 32) rstd[2 * row + 1] = 1.0f / sqrtf(s * (1.0f / 128.0f) + RMS_EPS);
    }
    const int gt = vcu * NTHREADS + tid, NGT = G * NTHREADS;
    for (int i = gt; i < NTOK * 16; i += NGT) { const int tok = i >> 4, j = i & 15;
        const float x1 = bf2f(PROJ[(size_t)tok * PN + C_KR + j]), x2 = bf2f(PROJ[(size_t)tok * PN + C_KR + 16 + j]);
        const float c = ropeA[(size_t)tok * 32 + j], s = ropeA[(size_t)tok * 32 + 16 + j];
        const bf16_t o1 = (bf16_t)f2bf(x1 * c - x2 * s), o2 = (bf16_t)f2bf(x2 * c + x1 * s);
#pragma unroll
        for (int h = 0; h < 8; ++h) { KM[(size_t)tok * 768 + h * 96 + 64 + j] = o1; KM[(size_t)tok * 768 + h * 96 + 80 + j] = o2; } }
    LAS float* red = (LAS float*)lds;
    for (int unit = vcu; unit < 512; unit += G) {
        const int ub = unit >> 3, h = unit & 7, tg = tid >> 6, d = tid & 63, c = h * 64 + d; float ksum = 0.f;
#pragma unroll 4
        for (int i = 0; i < 32; ++i) { const int tok = ub * 256 + tg * 32 + i; const bf16_t* pr = PROJ + (size_t)tok * PN;
            float qv = bf2f(pr[C_MQ + c]), kv = bf2f(pr[C_MK + c]);
            if (d < 16) { const int j = d & 7; const float cs = ropeB[(size_t)tok * 16 + j], sn = ropeB[(size_t)tok * 16 + 8 + j];
                if (d < 8) { const float q2 = bf2f(pr[C_MQ + c + 8]), k2 = bf2f(pr[C_MK + c + 8]); qv = qv * cs - q2 * sn; kv = kv * cs - k2 * sn; }
                else { const float q1 = bf2f(pr[C_MQ + c - 8]), k1 = bf2f(pr[C_MK + c - 8]); qv = qv * cs + q1 * sn; kv = kv * cs + k1 * sn; } }
            QB[(size_t)tok * 512 + c] = (bf16_t)f2bf(qv * C2B); KB[(size_t)tok * 512 + c] = (bf16_t)f2bf(kv); ksum += kv; }
        red[tg * 64 + d] = ksum;
        __syncthreads();
        if (tid < 64) { float t = 0.f;
#pragma unroll
            for (int g8 = 0; g8 < 8; ++g8) t += red[g8 * 64 + tid];
            kmean[(size_t)ub * 512 + h * 64 + tid] = t * (1.0f / 256.0f); }
        __syncthreads();
    }
}

typedef float f32x16 __attribute__((ext_vector_type(16)));
typedef short s16x4 __attribute__((ext_vector_type(4)));
namespace fa {
constexpr int KBUF = 12288, VBUF = 8192, VOFF = 3 * KBUF, WS_OFF = VOFF + 3 * VBUF, KML_OFF = WS_OFF + 8 * 256, LDS_NEED = KML_OFF + 2048;
__device__ __forceinline__ void wait_vm(int n) {
    switch (n) {
#define FA_W(k) case k: asm volatile("s_waitcnt vmcnt(" #k ")" ::: "memory"); break;
        FA_W(0) FA_W(1) FA_W(2) FA_W(3) FA_W(4) FA_W(5) FA_W(6) FA_W(7) FA_W(8) FA_W(9) FA_W(10) FA_W(11) FA_W(12) FA_W(13) FA_W(14) FA_W(15)
#undef FA_W
        default: asm volatile("s_waitcnt vmcnt(15)" ::: "memory"); break; }
}
constexpr float THR = 8.0f;
__device__ __forceinline__ int crow(int r, int hi) { return (r & 3) + 8 * (r >> 2) + 4 * hi; }
__device__ __forceinline__ unsigned cvtpk(float lo, float hi) { typedef __bf16 bf2 __attribute__((ext_vector_type(2))); f32x2 v = {lo, hi}; bf2 b = __builtin_convertvector(v, bf2); return __builtin_bit_cast(unsigned, b); }
__device__ __forceinline__ float xhalf_max(float m) { auto rr = __builtin_amdgcn_permlane32_swap(__float_as_uint(m), __float_as_uint(m), false, false); return fmaxf(__uint_as_float(rr[0]), __uint_as_float(rr[1])); }
__device__ __forceinline__ float xhalf_sum(float m) { auto rr = __builtin_amdgcn_permlane32_swap(__float_as_uint(m), __float_as_uint(m), false, false); return __uint_as_float(rr[0]) + __uint_as_float(rr[1]); }
__device__ __forceinline__ float mx3(float a, float b, float c) { return __builtin_fmaxf(__builtin_fmaxf(a, b), c); }
}
template <int DQK, int VAR>
__device__ __forceinline__ void attn_unit(LAS unsigned char* lds, const bf16_t* Q, int qpitch, const bf16_t* K, int kpitch, const bf16_t* V, int vpitch, bf16_t* O, int qb, const float* kmean, const Params& p, BgConv& bg) {
    using namespace fa;
    constexpr int ND = DQK / 16, NCH = DQK / 8;
    const int tid = threadIdx.x, lane = tid & 63, r32 = lane & 31, hi = lane >> 5, wid = __builtin_amdgcn_readfirstlane(tid >> 6);
    const int q0 = qb * 256, qrel = wid * 32 + r32;
    LAS float* wsf = (LAS float*)(lds + WS_OFF) + wid * 64;
    bf16x8 qr[ND];
#pragma unroll
    for (int d0 = 0; d0 < ND; ++d0) qr[d0] = *(const bf16x8*)(Q + (size_t)(q0 + qrel) * qpitch + d0 * 16 + hi * 8);
    unsigned sel = 0xffu;
    if (kmean) { const int n = tid >> 6, d = tid & 63; if (n < qb) ((LAS float*)(lds + KML_OFF))[tid] = kmean[(size_t)n * 1024 + d] + kmean[(size_t)n * 1024 + 512 + d]; }
    const bf16_t* ksrc = K + (size_t)lane * kpitch;
    const bf16_t* vsrc = V + (size_t)(16 * (wid & 3) + (lane >> 2)) * vpitch + (wid >> 2) * 32 + (lane & 3) * 8;
#define FA_DMA(ti, kslot, vslot) do { \
        __builtin_amdgcn_global_load_lds((const unsigned*)(ksrc + (size_t)(ti) * 64 * kpitch + wid * 8), (LAS unsigned*)(lds + (kslot) * KBUF + wid * 1024), 16, 0, 0); \
        if (NCH > 8 && wid < NCH - 8) __builtin_amdgcn_global_load_lds((const unsigned*)(ksrc + (size_t)(ti) * 64 * kpitch + (wid + 8) * 8), (LAS unsigned*)(lds + (kslot) * KBUF + (wid + 8) * 1024), 16, 0, 0); \
        __builtin_amdgcn_global_load_lds((const unsigned*)(vsrc + (size_t)(ti) * 64 * vpitch), (LAS unsigned*)(lds + VOFF + (vslot) * VBUF + wid * 1024), 16, 0, 0); } while (0)
#define FA_TILE(i) (((i) < 4) ? 4 * qb + (i) : (i) - 4)
#define FA_PV(vslot) do { const LAS unsigned char* vb_ = lds + VOFF + (vslot) * VBUF + voff; \
        _Pragma("unroll") for (int d0 = 0; d0 < 2; ++d0) _Pragma("unroll") for (int s_ = 0; s_ < 4; ++s_) { \
            const s16x4 lo_ = __builtin_bit_cast(s16x4, __builtin_amdgcn_ds_read_tr16_b64_v4i16((LAS s16x4*)(vb_ + d0 * 4096 + s_ * 1024))); \
            const s16x4 hh_ = __builtin_bit_cast(s16x4, __builtin_amdgcn_ds_read_tr16_b64_v4i16((LAS s16x4*)(vb_ + d0 * 4096 + s_ * 1024 + 512))); \
            const bf16x8 vf_ = (bf16x8){lo_[0], lo_[1], lo_[2], lo_[3], hh_[0], hh_[1], hh_[2], hh_[3]}; \
            o[d0] = __builtin_amdgcn_mfma_f32_32x32x16_bf16(__builtin_bit_cast(bf16x8, pw[s_]), vf_, o[d0], 0, 0, 0); } } while (0)
    const int NT = 4 * qb + 4;
    float mhat = 0.f, l_reg = 0.f; f32x16 o[2]; o[0] = f32x16{}; o[1] = f32x16{}; f32x16 negm = f32x16{};
    const int koff = hi * 1024 + r32 * 16;
    const int voff = ((lane >> 4) & 1) * 32 + (lane & 3) * 8 + (4 * hi + ((lane & 15) >> 2)) * 64;
    u32x4 pw[4];
    const int nkv = (NCH > 8 && wid < NCH - 8) ? 3 : 2;
    FA_DMA(FA_TILE(0), 0, 0);
    if (NT > 1) { FA_DMA(FA_TILE(1), 1, 1); }
    wait_vm(NT > 1 ? nkv : 0); asm volatile("s_waitcnt lgkmcnt(0)" ::: "memory"); __builtin_amdgcn_s_barrier(); asm volatile("" ::: "memory");
    if (kmean) {
        float gt[8];
#pragma unroll
        for (int n = 0; n < 8; ++n) { float s = 0.f; const LAS float* km = (const LAS float*)(lds + KML_OFF) + n * 64;
            if (n < qb) {
#pragma unroll
                for (int d0 = 0; d0 < ND; ++d0) { const f32x4 k0 = *(const LAS f32x4*)(km + d0 * 16 + hi * 8), k1 = *(const LAS f32x4*)(km + d0 * 16 + hi * 8 + 4);
#pragma unroll
                    for (int j = 0; j < 4; ++j) { s = fmaf(bf2f((unsigned short)qr[d0][j]), k0[j], s); s = fmaf(bf2f((unsigned short)qr[d0][4 + j]), k1[j], s); } }
                s = xhalf_sum(s); }
            gt[n] = (n < qb) ? s : -INFINITY; }
        sel = 0u;
#pragma unroll
        for (int n = 0; n < 8; ++n) { int cnt = 0;
#pragma unroll
            for (int n2 = 0; n2 < 8; ++n2) if (n2 != n) cnt += (n2 < qb && (gt[n2] > gt[n] || (gt[n2] == gt[n] && n2 < n))) ? 1 : 0;
            if (n < qb && cnt < 3) sel |= 1u << n; }
    }
    int sl = 0, prevB = 0, opsPrev = 0;
    for (int i = 0; i < NT; ++i) {
        const int sl1 = (sl == 2) ? 0 : sl + 1, sl2 = (sl1 == 2) ? 0 : sl1 + 1;
        LAS unsigned char* bscr = lds + LDS_NEED + wid * 8192 + (bg.itc & 1) * 4096;
        int young = prevB, ops = 0;
        if (bg.itc & 1) { if (bg.pend1 >= 0) { wait_vm(opsPrev); expert_finish(p, bg.pend1, bscr, lane); bg.pend1 = -1; ops += 4; asm volatile("s_waitcnt lgkmcnt(0)" ::: "memory"); } }
        else            { if (bg.pend0 >= 0) { wait_vm(opsPrev); expert_finish(p, bg.pend0, bscr, lane); bg.pend0 = -1; ops += 4; asm volatile("s_waitcnt lgkmcnt(0)" ::: "memory"); } }
        if constexpr (VAR != 4) { if (i + 2 < NT) { const int tn = FA_TILE(i + 2); FA_DMA(tn, sl2, sl2); ops += nkv; } }
        const bool bgdo = (bg.itc % 3 != 2) && bg.next < NEXP_ITEMS;
        if (bgdo) { expert_issue(p, bg.next, bscr, lane); if (bg.itc & 1) bg.pend1 = bg.next; else bg.pend0 = bg.next; bg.next += bg.stride; ops += 4; }
        young += ops; prevB = bgdo ? 4 : 0;
        ++bg.itc;
        const bool band = i < 4;
        if (!(band && 2 * i > wid)) {
            const LAS unsigned char* kb = lds + sl * KBUF + koff;
            f32x16 p0 = negm, p1 = negm;
            if (kmean && !band) { if (!__all((sel >> ((i - 4) >> 2)) & 1u)) {
                    const bool ok = ((sel >> ((i - 4) >> 2)) & 1u) != 0u;
#pragma unroll
                    for (int r = 0; r < 16; ++r) p0[r] = ok ? negm[r] : -INFINITY;
                    p1 = p0; } }
#pragma unroll
            for (int d0 = 0; d0 < (VAR == 5 ? 1 : ND); ++d0) { const bf16x8 a0 = *(const LAS bf16x8*)(kb + d0 * 2048), a1 = *(const LAS bf16x8*)(kb + d0 * 2048 + 512);
                p0 = __builtin_amdgcn_mfma_f32_32x32x16_bf16(a0, qr[d0], p0, 0, 0, 0); p1 = __builtin_amdgcn_mfma_f32_32x32x16_bf16(a1, qr[d0], p1, 0, 0, 0); }
            if (band) { if (64 * i + 63 > 32 * wid) {
#pragma unroll
                    for (int r = 0; r < 16; ++r) { const int kv = 64 * i + crow(r, hi); if (kv > qrel) p0[r] = -INFINITY; if (kv + 32 > qrel) p1[r] = -INFINITY; } } }
            if constexpr (VAR != 1 && VAR != 3) {
            float ra = mx3(p0[0], p0[1], p1[0]), rb = mx3(p0[2], p0[3], p1[1]); ra = mx3(ra, p1[2], p1[3]);
#pragma unroll
            for (int r = 4; r < 16; r += 4) { ra = mx3(ra, p0[r], p0[r + 1]); rb = mx3(rb, p0[r + 2], p0[r + 3]); ra = mx3(ra, p1[r], p1[r + 1]); rb = mx3(rb, p1[r + 2], p1[r + 3]); }
            const float rm = xhalf_max(__builtin_fmaxf(ra, rb));
            if (i == 0 || __any(rm > THR)) {
                const float dl = (i == 0) ? rm : fmaxf(rm, 0.f); mhat += dl;
#pragma unroll
                for (int r = 0; r < 16; ++r) { p0[r] -= dl; p1[r] -= dl; negm[r] = -mhat; }
                if (i != 0) { const float f = __builtin_amdgcn_exp2f(-dl); l_reg *= f; if (hi == 0) wsf[r32] = f;
                    asm volatile("s_waitcnt lgkmcnt(0)" ::: "memory");
#pragma unroll
                    for (int r = 0; r < 16; ++r) { const float fr_ = wsf[crow(r, hi)]; o[0][r] *= fr_; o[1][r] *= fr_; } }
            }
            f32x2 sacc = {0.f, 0.f};
#pragma unroll
            for (int r = 0; r < 16; ++r) { p0[r] = __builtin_amdgcn_exp2f(p0[r]); p1[r] = __builtin_amdgcn_exp2f(p1[r]); }
#pragma unroll
            for (int r = 0; r < 16; r += 2) { float t0_ = p0[r] + p1[r], t1_ = p0[r + 1] + p1[r + 1]; asm volatile("" : "+v"(t0_), "+v"(t1_)); sacc[0] += t0_; sacc[1] += t1_; }
            l_reg += sacc[0] + sacc[1];
            }
#pragma unroll
            for (int s = 0; s < 2; ++s)
#pragma unroll
                for (int j = 0; j < 4; ++j) { pw[s][j] = cvtpk(p0[8 * s + 2 * j], p0[8 * s + 2 * j + 1]); pw[2 + s][j] = cvtpk(p1[8 * s + 2 * j], p1[8 * s + 2 * j + 1]); }
            if constexpr (VAR != 2 && VAR != 3) { FA_PV(sl); } else { o[0][0] += __uint_as_float(pw[0][0] ^ pw[1][1] ^ pw[2][2] ^ pw[3][3]); }
        }
        asm volatile("s_waitcnt lgkmcnt(0)" ::: "memory"); wait_vm(young);
        __builtin_amdgcn_s_barrier(); asm volatile("" ::: "memory");
        sl = sl1; opsPrev = ops;
    }
    l_reg = xhalf_sum(l_reg);
    if (hi == 0) wsf[32 + r32] = l_reg;
    asm volatile("s_waitcnt lgkmcnt(0)" ::: "memory");
#pragma unroll
    for (int r = 0; r < 16; ++r) { const float rl = 1.0f / wsf[32 + crow(r, hi)]; bf16_t* op = O + (size_t)(q0 + wid * 32 + crow(r, hi)) * 1024 + r32;
        op[0] = (bf16_t)f2bf(o[0][r] * rl); op[32] = (bf16_t)f2bf(o[1][r] * rl); }
    asm volatile("s_waitcnt lgkmcnt(0)" ::: "memory"); __builtin_amdgcn_s_barrier(); asm volatile("" ::: "memory");
#undef FA_DMA
#undef FA_TILE
#undef FA_PV
}
template <int VAR>
__device__ __forceinline__ void phase_attn_fast(const Params& p, LAS unsigned char* lds, int vcu, int G, bool do_conv) {
    unsigned char* ws = p.ws;
    const bf16_t* QM = (const bf16_t*)(ws + WS_QM); const bf16_t* KM = (const bf16_t*)(ws + WS_KM); const bf16_t* VM = (const bf16_t*)(ws + WS_VM);
    const bf16_t* QB = (const bf16_t*)(ws + WS_QB); const bf16_t* KB = (const bf16_t*)(ws + WS_KB); const bf16_t* VB = (const bf16_t*)(ws + WS_VB);
    const float* kmean = (const float*)(ws + WS_KMEANP); bf16_t* ATT = (bf16_t*)(ws + WS_ATT);
    const int wave_ = __builtin_amdgcn_readfirstlane(threadIdx.x >> 6);
    if (wave_ >= 4) __builtin_amdgcn_s_setprio(1);
    BgConv bg; bg.next = do_conv ? vcu * NWAVES + wave_ : NEXP_ITEMS; bg.stride = G * NWAVES; bg.pend0 = -1; bg.pend1 = -1; bg.itc = 0;
    for (int su = vcu; su < 256; su += G) {
        const int bh = su >> 2, j = su & 3, b = bh >> 3, h = bh & 7; const size_t r0 = (size_t)b * SEQ;
#pragma unroll 1
        for (int k = 0; k < 2; ++k) { const int qb = k ? 7 - j : j;
            attn_unit<96, VAR>(lds, QM + r0 * 768 + h * 96, 768, KM + r0 * 768 + h * 96, 768, VM + r0 * 512 + h * 64, 512, ATT + r0 * 1024 + h * 64, qb, nullptr, p, bg);
            attn_unit<64, VAR>(lds, QB + r0 * 512 + h * 64, 512, KB + r0 * 512 + h * 64, 512, VB + r0 * 512 + h * 64, 512, ATT + r0 * 1024 + 512 + h * 64, qb, kmean + (size_t)(b * 8) * 1024 + h * 64, p, bg); }
    }
    __builtin_amdgcn_s_setprio(0);
    { const int lane = threadIdx.x & 63; LAS unsigned char* bscr = lds + fa::LDS_NEED + wave_ * 8192;
      asm volatile("s_waitcnt vmcnt(0)" ::: "memory");
      if (bg.pend0 >= 0) { expert_finish(p, bg.pend0, bscr, lane); bg.pend0 = -1; }
      if (bg.pend1 >= 0) { expert_finish(p, bg.pend1, bscr + 4096, lane); bg.pend1 = -1; }
      asm volatile("s_waitcnt lgkmcnt(0)" ::: "memory");
#pragma unroll 1
      for (; bg.next < NEXP_ITEMS; bg.next += bg.stride) { expert_issue(p, bg.next, bscr, lane); asm volatile("s_waitcnt vmcnt(0)" ::: "memory"); expert_finish(p, bg.next, bscr, lane); asm volatile("s_waitcnt lgkmcnt(0)" ::: "memory"); } }
}

__device__ __forceinline__ float rs32(float (&a)[32], int lane) {
#pragma unroll
    for (int e = 0; e < 16; ++e) { auto rr = __builtin_amdgcn_permlane32_swap(__float_as_uint(a[e]), __float_as_uint(a[e + 16]), false, false); a[e] = __uint_as_float(rr[0]) + __uint_as_float(rr[1]); }
#pragma unroll
    for (int e = 0; e < 8; ++e) { auto rr = __builtin_amdgcn_permlane16_swap(__float_as_uint(a[e]), __float_as_uint(a[e + 8]), false, false); a[e] = __uint_as_float(rr[0]) + __uint_as_float(rr[1]); }
    { const bool bit = (lane & 8) != 0;
#pragma unroll
      for (int e = 0; e < 4; ++e) { const float keep = bit ? a[e + 4] : a[e], send = bit ? a[e] : a[e + 4]; a[e] = keep + __shfl_xor(send, 8); } }
    { const bool bit = (lane & 4) != 0;
#pragma unroll
      for (int e = 0; e < 2; ++e) { const float keep = bit ? a[e + 2] : a[e], send = bit ? a[e] : a[e + 2]; a[e] = keep + __shfl_xor(send, 4); } }
    { const bool bit = (lane & 2) != 0; const float keep = bit ? a[1] : a[0], send = bit ? a[0] : a[1]; a[0] = keep + __shfl_xor(send, 2); }
    return a[0] + __shfl_xor(a[0], 1);
}
__device__ __forceinline__ void phase_ln1_route(const Params& p, LAS unsigned char* lds, int vcu, int G) {
    const int tid = threadIdx.x, wave = __builtin_amdgcn_readfirstlane(tid >> 6), lane = tid & 63;
    unsigned char* ws = p.ws;
    const float* X1P = (const float*)(ws + WS_X1PRE); bf16_t* X1B = (bf16_t*)(ws + WS_X1B);
    int* tidx = (int*)(ws + WS_TIDX); float* tgate = (float*)(ws + WS_TGATE); unsigned* hist = (unsigned*)(ws + WS_HIST);
    constexpr int XP = 2064;
    LAS unsigned char* XH = lds; LAS unsigned char* XL = lds + 16 * XP; LAS float* PART = (LAS float*)(lds + 32 * XP); LAS float* LG = PART + 8 * 16 * 32;
    LAS int* lidx = (LAS int*)(lds + ROWTAB_OFF);
    bf16x8 bw[2][4][2];
    { const bf16_t* WRF = (const bf16_t*)(ws + WS_WRL);
#pragma unroll
      for (int pp = 0; pp < 2; ++pp)
#pragma unroll
          for (int ksl = 0; ksl < 4; ++ksl)
#pragma unroll
              for (int eh = 0; eh < 2; ++eh) bw[pp][ksl][eh] = *(const bf16x8*)(WRF + (size_t)pp * 32768 + ((size_t)((4 * wave + ksl) * 2 + eh) * 64 + lane) * 8); }
    const float brt = p.b_router[lane & 31];
    f32x4 gln[4], bln[4], nx0[4], nx1[4];
#pragma unroll
    for (int j = 0; j < 4; ++j) { gln[j] = *(const f32x4*)(p.ln1_g + 4 * lane + 256 * j); bln[j] = *(const f32x4*)(p.ln1_b + 4 * lane + 256 * j); }
    for (int chunk = vcu; chunk < NCHUNK; chunk += G) {
#pragma unroll 1
        for (int grp = 0; grp < 4; ++grp) {
            const int rl = 2 * wave, tl = grp * 16 + rl, tok = chunk * 64 + tl;
            f32x4 v0[4], v1[4]; float s0 = 0.f, s1 = 0.f;
            if (grp == 0) {
#pragma unroll
                for (int j = 0; j < 4; ++j) { nx0[j] = *(const f32x4*)(X1P + (size_t)tok * DM + 4 * lane + 256 * j); nx1[j] = *(const f32x4*)(X1P + (size_t)(tok + 1) * DM + 4 * lane + 256 * j); } }
#pragma unroll
            for (int j = 0; j < 4; ++j) { v0[j] = nx0[j]; v1[j] = nx1[j]; }
            if (grp < 3) {
#pragma unroll
                for (int j = 0; j < 4; ++j) { nx0[j] = *(const f32x4*)(X1P + (size_t)(tok + 16) * DM + 4 * lane + 256 * j); nx1[j] = *(const f32x4*)(X1P + (size_t)(tok + 17) * DM + 4 * lane + 256 * j); } }
#pragma unroll
            for (int j = 0; j < 4; ++j) { s0 += (v0[j][0] + v0[j][1]) + (v0[j][2] + v0[j][3]); s1 += (v1[j][0] + v1[j][1]) + (v1[j][2] + v1[j][3]); }
            const float mean0 = wave_sum(s0) * (1.0f / DM), mean1 = wave_sum(s1) * (1.0f / DM); float q0 = 0.f, q1 = 0.f;
#pragma unroll
            for (int j = 0; j < 4; ++j) { v0[j] = v0[j] - mean0; v1[j] = v1[j] - mean1;
                q0 += (v0[j][0] * v0[j][0] + v0[j][1] * v0[j][1]) + (v0[j][2] * v0[j][2] + v0[j][3] * v0[j][3]); q1 += (v1[j][0] * v1[j][0] + v1[j][1] * v1[j][1]) + (v1[j][2] * v1[j][2] + v1[j][3] * v1[j][3]); }
            const float rs0 = 1.0f / sqrtf(wave_sum(q0) * (1.0f / DM) + LN_EPS), rs1 = 1.0f / sqrtf(wave_sum(q1) * (1.0f / DM) + LN_EPS);
#pragma unroll
            for (int j = 0; j < 4; ++j) { const f32x4 g = gln[j], bb = bln[j];
                v0[j] = v0[j] * rs0 * g + bb; v1[j] = v1[j] * rs1 * g + bb;
                u32x2 h0, h1, l0, l1;
                h0.x = pk2(v0[j][0], v0[j][1]); h0.y = pk2(v0[j][2], v0[j][3]); h1.x = pk2(v1[j][0], v1[j][1]); h1.y = pk2(v1[j][2], v1[j][3]);
                *(u32x2*)(X1B + (size_t)tok * DM + 4 * lane + 256 * j) = h0; *(u32x2*)(X1B + (size_t)(tok + 1) * DM + 4 * lane + 256 * j) = h1;
                l0.x = pk2(v0[j][0] - __uint_as_float(h0.x << 16), v0[j][1] - __uint_as_float(h0.x & 0xffff0000u)); l0.y = pk2(v0[j][2] - __uint_as_float(h0.y << 16), v0[j][3] - __uint_as_float(h0.y & 0xffff0000u));
                l1.x = pk2(v1[j][0] - __uint_as_float(h1.x << 16), v1[j][1] - __uint_as_float(h1.x & 0xffff0000u)); l1.y = pk2(v1[j][2] - __uint_as_float(h1.y << 16), v1[j][3] - __uint_as_float(h1.y & 0xffff0000u));
                const int cb = (4 * lane + 256 * j) * 2;
                *(LAS u32x2*)(XH + rl * XP + cb) = h0; *(LAS u32x2*)(XH + (rl + 1) * XP + cb) = h1;
                *(LAS u32x2*)(XL + rl * XP + cb) = l0; *(LAS u32x2*)(XL + (rl + 1) * XP + cb) = l1; }
            __syncthreads();
            f32x4 acc[2]; acc[0] = (f32x4){0.f, 0.f, 0.f, 0.f}; acc[1] = acc[0];
            { const int aoff = (lane & 15) * XP + (lane >> 4) * 16;
#pragma unroll
              for (int ksl = 0; ksl < 4; ++ksl) { const int ko = (4 * wave + ksl) * 64;
                  const bf16x8 xh = *(const LAS bf16x8*)(XH + aoff + ko), xl = *(const LAS bf16x8*)(XL + aoff + ko);
#pragma unroll
                  for (int eh = 0; eh < 2; ++eh) { acc[eh] = __builtin_amdgcn_mfma_f32_16x16x32_bf16(xh, bw[0][ksl][eh], acc[eh], 0, 0, 0);
                      acc[eh] = __builtin_amdgcn_mfma_f32_16x16x32_bf16(xl, bw[0][ksl][eh], acc[eh], 0, 0, 0);
                      acc[eh] = __builtin_amdgcn_mfma_f32_16x16x32_bf16(xh, bw[1][ksl][eh], acc[eh], 0, 0, 0); } } }
#pragma unroll
            for (int eh = 0; eh < 2; ++eh)
#pragma unroll
                for (int r = 0; r < 4; ++r) PART[(wave * 16 + 4 * (lane >> 4) + r) * 32 + 16 * eh + (lane & 15)] = acc[eh][r];
            __syncthreads();
            { const int hf = lane >> 5, me = lane & 31, row = rl + hf; float my = brt;
#pragma unroll
              for (int w8 = 0; w8 < 8; ++w8) my += PART[(w8 * 16 + row) * 32 + me];
              LAS float* lg = LG + row * 32; lg[me] = my;
              asm volatile("s_waitcnt lgkmcnt(0)" ::: "memory");
              int rank = 0;
#pragma unroll
              for (int e4 = 0; e4 < 8; ++e4) { const f32x4 vv = *(const LAS f32x4*)(lg + 4 * e4);
#pragma unroll
                  for (int k = 0; k < 4; ++k) rank += (vv[k] > my || (vv[k] == my && (4 * e4 + k) < me)) ? 1 : 0; }
              int ti[4];
#pragma unroll
              for (int k = 0; k < 4; ++k) { const unsigned long long bal = __ballot(rank == k); const int ia = __ffs((int)(unsigned)(bal & 0xffffffffull)) - 1, ib = __ffs((int)(unsigned)(bal >> 32)) - 1; ti[k] = hf ? ib : ia; }
              if (me == 0) { const float t0 = lg[ti[0]], e1 = expf(lg[ti[1]] - t0), e2 = expf(lg[ti[2]] - t0), e3 = expf(lg[ti[3]] - t0); const float is = 1.0f / (1.0f + e1 + e2 + e3);
                  const int tk = tok + hf, tll = tl + hf;
                  *(f32x4*)(tgate + (size_t)tk * 4) = (f32x4){is, e1 * is, e2 * is, e3 * is};
                  int* tp = tidx + (size_t)tk * 4; tp[0] = ti[0]; tp[1] = ti[1]; tp[2] = ti[2]; tp[3] = ti[3];
                  lidx[tll * 4 + 0] = ti[0]; lidx[tll * 4 + 1] = ti[1]; lidx[tll * 4 + 2] = ti[2]; lidx[tll * 4 + 3] = ti[3]; } }
        }
        __syncthreads();
        if (tid < 32) { unsigned c = 0; for (int a = 0; a < 256; ++a) c += (lidx[a] == tid) ? 1u : 0u; hist[chunk * 32 + tid] = c; }
        __syncthreads();
    }
}

__device__ __forceinline__ void phase_assign(const Params& p, LAS unsigned char* lds, int vcu, int G) {
    const int tid = threadIdx.x;
    unsigned char* ws = p.ws;
    const int* tidx = (const int*)(ws + WS_TIDX); const float* tgate = (const float*)(ws + WS_TGATE); const unsigned* hist = (const unsigned*)(ws + WS_HIST);
    int* dest = (int*)(ws + WS_DEST); int* row_tok = (int*)(ws + WS_ROWTOK); float* row_gate = (float*)(ws + WS_ROWGATE); int* tile_e = (int*)(ws + WS_TILEE);
    LAS int* lidx = (LAS int*)lds;
    LAS int* lcnt = (LAS int*)(lds + 1024);
    LAS int* lpre = (LAS int*)(lds + 1024 + 128);
    LAS int* lstart = (LAS int*)(lds + 1024 + 256);
    LAS int* ptot = (LAS int*)(lds + 2048);
    LAS int* ppre = (LAS int*)(lds + 4096);
    for (int chunk = vcu; chunk < NCHUNK; chunk += G) {
        if (tid < 256) lidx[tid] = tidx[chunk * 256 + tid];
        { const int e = tid & 31, cg = tid >> 5; int tot = 0, pre = 0;
#pragma unroll
          for (int k = 0; k < 16; ++k) { const int c = cg * 16 + k; const int hv = (int)hist[c * 32 + e]; tot += hv; pre += (c < chunk) ? hv : 0; }
          ptot[cg * 32 + e] = tot; ppre[cg * 32 + e] = pre; }
        __syncthreads();
        if (tid < 32) { int tot = 0, pre = 0;
#pragma unroll
            for (int cg = 0; cg < 16; ++cg) { tot += ptot[cg * 32 + tid]; pre += ppre[cg * 32 + tid]; }
            lcnt[tid] = tot; lpre[tid] = pre; }
        __syncthreads();
        if (tid == 0) { int s2 = 0; for (int e = 0; e < 32; ++e) { lstart[e] = s2; s2 += (lcnt[e] + 255) / 256 * 256; } lstart[32] = s2; }
        __syncthreads();
        if (tid < 256) { const int e = lidx[tid]; int rank = 0; for (int a = 0; a < tid; ++a) rank += (lidx[a] == e) ? 1 : 0;
            const int P = lstart[e] + lpre[e] + rank, tok = chunk * 64 + (tid >> 2);
            row_tok[P] = tok; row_gate[P] = tgate[chunk * 256 + tid]; dest[chunk * 256 + tid] = P; }
        if (chunk < 32) { const int e = chunk; for (int P = lstart[e] + lcnt[e] + tid; P < lstart[e + 1]; P += NTHREADS) { row_tok[P] = 0; row_gate[P] = 0.f; } }
        if (chunk == 0) { if (tid < 32) { for (int t = lstart[tid] / 256; t < lstart[tid + 1] / 256; ++t) tile_e[t] = tid; } if (tid == 32) tile_e[MAXTILES] = lstart[32] / 256; }
        __syncthreads();
    }
}

__device__ __forceinline__ void phase_final(const Params& p, int vcu, int G, float* outp) {
    const int tid = threadIdx.x, wave = tid >> 6, lane = tid & 63;
    unsigned char* ws = p.ws;
    const int* dest = (const int*)(ws + WS_DEST); const bf16_t* Y = (const bf16_t*)(ws + WS_Y); const bf16_t* X1B = (const bf16_t*)(ws + WS_X1B);
    const int gw = vcu * NWAVES + wave, NGW = G * NWAVES;
    for (int t0 = gw * 8; t0 < NTOK; t0 += NGW * 8) {
        const int dl = (lane < 32) ? dest[t0 * 4 + lane] : 0;
#pragma unroll
        for (int pr = 0; pr < 4; ++pr) {
            const int tok = t0 + 2 * pr;
            int P[2][4];
#pragma unroll
            for (int t = 0; t < 2; ++t)
#pragma unroll
                for (int k = 0; k < 4; ++k) P[t][k] = __builtin_amdgcn_readlane(dl, (2 * pr + t) * 4 + k);
            f32x4 v[2][4]; u32x2 y[2][4][4];
#pragma unroll
            for (int t = 0; t < 2; ++t)
#pragma unroll
                for (int j = 0; j < 4; ++j) { const u32x2 xw = *(const u32x2*)(X1B + (size_t)(tok + t) * DM + 4 * lane + 256 * j);
                    v[t][j] = (f32x4){__uint_as_float(xw.x << 16), __uint_as_float(xw.x & 0xffff0000u), __uint_as_float(xw.y << 16), __uint_as_float(xw.y & 0xffff0000u)};
#pragma unroll
                    for (int k = 0; k < 4; ++k) y[t][k][j] = *(const u32x2*)(Y + (size_t)P[t][k] * 1024 + 4 * lane + 256 * j); }
            float s[2], q[2];
#pragma unroll
            for (int t = 0; t < 2; ++t) { s[t] = 0.f;
#pragma unroll
                for (int j = 0; j < 4; ++j) { v[t][j] = v[t][j] * DN_ALPHA;
#pragma unroll
                    for (int k = 0; k < 4; ++k) { const u32x2 w = y[t][k][j];
                        v[t][j][0] += __uint_as_float(w.x << 16); v[t][j][1] += __uint_as_float(w.x & 0xffff0000u); v[t][j][2] += __uint_as_float(w.y << 16); v[t][j][3] += __uint_as_float(w.y & 0xffff0000u); }
                    s[t] += (v[t][j][0] + v[t][j][1]) + (v[t][j][2] + v[t][j][3]); } }
            const float mean0 = wave_sum(s[0]) * (1.0f / DM), mean1 = wave_sum(s[1]) * (1.0f / DM);
            q[0] = 0.f; q[1] = 0.f;
#pragma unroll
            for (int j = 0; j < 4; ++j) { v[0][j] = v[0][j] - mean0; v[1][j] = v[1][j] - mean1;
                q[0] += (v[0][j][0] * v[0][j][0] + v[0][j][1] * v[0][j][1]) + (v[0][j][2] * v[0][j][2] + v[0][j][3] * v[0][j][3]);
                q[1] += (v[1][j][0] * v[1][j][0] + v[1][j][1] * v[1][j][1]) + (v[1][j][2] * v[1][j][2] + v[1][j][3] * v[1][j][3]); }
            const float rs0 = 1.0f / sqrtf(wave_sum(q[0]) * (1.0f / DM) + LN_EPS), rs1 = 1.0f / sqrtf(wave_sum(q[1]) * (1.0f / DM) + LN_EPS);
#pragma unroll
            for (int j = 0; j < 4; ++j) { const f32x4 g = *(const f32x4*)(p.ln2_g + 4 * lane + 256 * j), bb = *(const f32x4*)(p.ln2_b + 4 * lane + 256 * j);
                *(f32x4*)(outp + (size_t)tok * DM + 4 * lane + 256 * j) = v[0][j] * rs0 * g + bb;
                *(f32x4*)(outp + (size_t)(tok + 1) * DM + 4 * lane + 256 * j) = v[1][j] * rs1 * g + bb; }
        }
    }
}

constexpr int NPHASE = 11;
__global__ void __launch_bounds__(NTHREADS, 2) fwd_kernel(Params p) {
    extern __shared__ __attribute__((aligned(16))) unsigned char lds_raw[];
    LAS unsigned char* lds = (LAS unsigned char*)lds_raw;
    const int tid = threadIdx.x;
    const int G = gridDim.x, bx = blockIdx.x;
    const int vcu = (G % 8 == 0) ? (bx % 8) * (G / 8) + bx / 8 : bx;
    unsigned char* ws = p.ws;
    volatile LAS unsigned* MISC = (volatile LAS unsigned*)(lds + MISC_OFF);
    if (tid < 32) MISC[tid] = 0u;
    __syncthreads();
    XcdBarrier bar; bar.bar = (unsigned*)(ws + WS_CTL) + CW_BAR; bar.x = 0; bar.st = nullptr;
    const bool one = (p.ph_hi - p.ph_lo) > 1;
    if (one) bar = xcd_barrier_post((unsigned*)(ws + WS_CTL) + CW_BAR, MISC + 8);
    const int lo = p.ph_lo, hi = p.ph_hi;
#ifdef ONLY_PHASE
#define IN(k) ((k) == ONLY_PHASE && lo <= (k) && (k) < hi)
#else
#define IN(k) (lo <= (k) && (k) < hi)
#endif
#ifndef NAIVE_GEMM_MASK
#define NAIVE_GEMM_MASK 0
#endif
#define GEMM_CALL(EPI, SCHED) do { if constexpr (NAIVE_GEMM_MASK != 0) gemm_phase_naive<EPI, SCHED>(lds, g, S, E); else gemm_phase<EPI, SCHED, true>(lds, g, S, E); } while (0)
#ifndef ATTN_VAR
#define ATTN_VAR 0
#endif
#ifndef REPEAT_PHASE
#define REPEAT_PHASE (-1)
#endif
#define SEAM(k) do { if (IN(k) && IN((k) == 1 ? 3 : (k) + 1)) xcd_barrier(bar); } while (0)

#define PHASE(k, ...) do { if (IN(k)) { if constexpr (REPEAT_PHASE == (k)) { __VA_ARGS__; xcd_barrier(bar); } __VA_ARGS__; } SEAM(k); } while (0)
    PHASE(0, phase_prologue(p, lds, vcu, G));
    PHASE(1, { GemmArgs g{(const bf16_t*)(ws + WS_XB), 1024, (const bf16_t*)(ws + WS_WIN), 1024, 1024}; DenseSched S; S.init(lds, NTOK, PN, G, vcu);
        EpiProj E{ws}; GEMM_CALL(EpiProj, DenseSched); });
    PHASE(3, { { GemmArgs g{(const bf16_t*)(ws + WS_LAT), KUP, (const bf16_t*)(ws + WS_WUP), KUP, 256}; DenseSched S; S.init(lds, NTOK, 768, G, vcu);
          EpiUp E{(bf16_t*)(ws + WS_QM), (bf16_t*)(ws + WS_KM), (bf16_t*)(ws + WS_VM), (const float*)(ws + WS_RSTDP), (const float*)(ws + WS_ROPEA), 0}; GEMM_CALL(EpiUp, DenseSched); }
        { GemmArgs g{(const bf16_t*)(ws + WS_LAT) + 256, KUP, (const bf16_t*)(ws + WS_WUP) + (size_t)768 * KUP + 256, KUP, 128}; DenseSched S; S.init(lds, NTOK, 1024, G, (vcu + 192) % G);
          EpiUp E{(bf16_t*)(ws + WS_QM), (bf16_t*)(ws + WS_KM), (bf16_t*)(ws + WS_VM), (const float*)(ws + WS_RSTDP), (const float*)(ws + WS_ROPEA), 24}; GEMM_CALL(EpiUp, DenseSched); } });
    if constexpr (REPEAT_PHASE == 44) { if (IN(4)) { phase_attn_fast<ATTN_VAR>(p, lds, vcu, G, false); xcd_barrier(bar); } }
    PHASE(4, phase_attn_fast<0>(p, lds, vcu, G, true));
    PHASE(5, { GemmArgs g{(const bf16_t*)(ws + WS_ATT), 1024, (const bf16_t*)(ws + WS_WO), 1024, 1024}; DenseSched S; S.init(lds, NTOK, DM, G, vcu);
        EpiWo E{p.x, (float*)(ws + WS_X1PRE)}; GEMM_CALL(EpiWo, DenseSched); });
    PHASE(6, phase_ln1_route(p, lds, vcu, G));
    PHASE(7, phase_assign(p, lds, vcu, G));
    PHASE(8, { GemmArgs g{(const bf16_t*)(ws + WS_X1B), 1024, (const bf16_t*)(ws + WS_WGU), 1024, 1024}; GroupSched<true> S; S.init(lds, (const int*)(ws + WS_TILEE), (const int*)(ws + WS_ROWTOK), 8, 2048, G, vcu);
        EpiGateUp E{(bf16_t*)(ws + WS_H), p.b_gate, p.b_up}; GEMM_CALL(EpiGateUp, GroupSched<true>); });
    PHASE(9, { GemmArgs g{(const bf16_t*)(ws + WS_H), 1024, (const bf16_t*)(ws + WS_WD), 1024, 1024}; GroupSched<false> S; S.init(lds, (const int*)(ws + WS_TILEE), (const int*)(ws + WS_ROWTOK), 4, 1024, G, vcu);
        EpiDown E{(bf16_t*)(ws + WS_Y), p.b_down, (const float*)(ws + WS_ROWGATE)}; GEMM_CALL(EpiDown, GroupSched<false>); });
    if (IN(10)) { if constexpr (REPEAT_PHASE == 10) { phase_final(p, vcu, G, (float*)(ws + WS_X1PRE)); xcd_barrier(bar); } phase_final(p, vcu, G, p.out); }
#undef IN
#undef SEAM
}

extern "C" void kernel_launch(void* const* d_in, const int* in_sizes, int n_in, void* d_out, int out_size, void* d_ws, size_t ws_size, hipStream_t stream) {
    static int grid = 0;
    if (grid == 0) {
        if (n_in != 20 || out_size != NTOK * DM || ws_size < WS_END) { fprintf(stderr, "kernel_launch: unexpected shapes (n_in %d out %d ws %zu)\n", n_in, out_size, ws_size); grid = -1; return; }
        int dev = 0, cus = 0, per_cu = 0;
        if (hipGetDevice(&dev) != hipSuccess || hipDeviceGetAttribute(&cus, hipDeviceAttributeMultiprocessorCount, dev) != hipSuccess) { grid = -1; return; }
        if (hipFuncSetAttribute((const void*)fwd_kernel, hipFuncAttributeMaxDynamicSharedMemorySize, LDS_BYTES) != hipSuccess) { fprintf(stderr, "kernel_launch: hipFuncSetAttribute failed\n"); grid = -1; return; }
        if (hipOccupancyMaxActiveBlocksPerMultiprocessor(&per_cu, (const void*)fwd_kernel, NTHREADS, LDS_BYTES) != hipSuccess || per_cu < 1) fprintf(stderr, "kernel_launch: occupancy query says %d\n", per_cu);
        (void)hipGetLastError();
        grid = cus;
    }
    if (grid < 0) return;
    (void)hipMemsetAsync((char*)d_ws + WS_CTL, 0, CTL_ZERO_BYTES, stream);
    Params p{};
    p.x = (const float*)d_in[0]; p.pos = (const int*)d_in[1]; p.w_in = (const float*)d_in[2]; p.q_a_norm = (const float*)d_in[3]; p.w_q_b = (const float*)d_in[4];
    p.kv_a_norm = (const float*)d_in[5]; p.w_kv_b = (const float*)d_in[6]; p.w_o = (const float*)d_in[7]; p.ln1_g = (const float*)d_in[8]; p.ln1_b = (const float*)d_in[9];
    p.w_router = (const float*)d_in[10]; p.b_router = (const float*)d_in[11]; p.w_gate = (const float*)d_in[12]; p.b_gate = (const float*)d_in[13];
    p.w_up = (const float*)d_in[14]; p.b_up = (const float*)d_in[15]; p.w_down = (const float*)d_in[16]; p.b_down = (const float*)d_in[17];
    p.ln2_g = (const float*)d_in[18]; p.ln2_b = (const float*)d_in[19];
    p.out = (float*)d_out; p.ws = (unsigned char*)d_ws;
    for (int i = 0; i < 16; ++i) p.invfA[i] = pow(500000.0, -(double)(2 * i) / 32.0);
    for (int i = 0; i < 8; ++i) p.invfB[i] = pow(500000.0, -(double)(2 * i) / 16.0);
#if MK_ONE_LAUNCH
    p.ph_lo = 0; p.ph_hi = NPHASE;
    hipLaunchKernelGGL(fwd_kernel, dim3(grid), dim3(NTHREADS), LDS_BYTES, stream, p);
#else
    for (int ph = 0; ph < NPHASE; ++ph) { p.ph_lo = ph; p.ph_hi = ph + 1; hipLaunchKernelGGL(fwd_kernel, dim3(grid), dim3(NTHREADS), LDS_BYTES, stream, p); }
#endif
}
```

```cpp
#include <hip/hip_runtime.h>
#include <cstdio>
#include <cstdint>
#include <cmath>
#ifndef ATTN_REBAL
#define ATTN_REBAL 1
#endif
#ifndef CONV8
#define CONV8 1
#endif
#ifndef CONV_PLACE
#define CONV_PLACE 5
#endif
#ifndef CONV_PERIOD
#define CONV_PERIOD 4
#endif
#ifndef X1PRE_BF16
#define X1PRE_BF16 1
#endif
#ifndef WO_X_BF16
#define WO_X_BF16 1
#endif
#ifndef H_SC1
#define H_SC1 1
#endif
#ifndef HANDOFF89_BAR
#define HANDOFF89_BAR 0
#endif
#ifndef HANDOFF89
#define HANDOFF89 1
#endif
#ifndef HANDOFF67
#define HANDOFF67 1
#endif
#ifndef WO_FP8
#define WO_FP8 1
#endif
#ifndef PROJ_FP8
#define PROJ_FP8 1
#endif
#ifndef Y_FP8
#define Y_FP8 1
#endif
#ifndef GATEUP_FP8
#define GATEUP_FP8 2
#endif
#ifndef DOWN_FP8
#define DOWN_FP8 2
#endif
#ifndef ATTN_PIPE
#define ATTN_PIPE 0
#endif

#ifndef MK_ONE_LAUNCH
#define MK_ONE_LAUNCH 1
#endif

#define GAS __attribute__((address_space(1)))
#define LAS __attribute__((address_space(3)))
typedef unsigned short bf16_t;
typedef short bf16x8 __attribute__((ext_vector_type(8)));
typedef float f32x4 __attribute__((ext_vector_type(4)));
typedef float f32x2 __attribute__((ext_vector_type(2)));
typedef unsigned u32x4 __attribute__((ext_vector_type(4)));
typedef unsigned u32x2 __attribute__((ext_vector_type(2)));

constexpr int NTOK = 16384, DM = 1024, SEQ = 2048, NBATCH = 8;
constexpr int PN = 2048;
constexpr int C_QL = 0, C_KVL = 256, C_KR = 384, C_MQ = 416, C_MK = 928, C_MV = 1440, IN_COLS = 1952;
constexpr int NUP = 1792, KUP = 384;
constexpr int NE = 32, TOPK = 4;
constexpr int MAXROWS = 65536 + NE * 256, MAXTILES = MAXROWS / 256;
constexpr int NCHUNK = NTOK / 64;
constexpr float LN_EPS = 1e-5f, RMS_EPS = 1e-6f;
constexpr float DN_ALPHA = 1.189207115002721f;
constexpr float LOG2E = 1.4426950408889634f;
constexpr float C2A = 0.10206207261596575f * LOG2E;
constexpr float C2B = 0.125f * LOG2E;
constexpr int NWAVES = 8, NTHREADS = 512;

constexpr size_t MiB = 1u << 20;
constexpr size_t WS_CTL = 0, CTL_ZERO_BYTES = 1 * MiB;
constexpr size_t WS_HIST = 1 * MiB;
constexpr size_t WS_TIDX = WS_HIST + 64 * 1024;
constexpr size_t WS_TGATE = WS_TIDX + 256 * 1024;
constexpr size_t WS_DEST = WS_TGATE + 256 * 1024;
constexpr size_t WS_ROWTOK = WS_DEST + 256 * 1024;
constexpr size_t WS_ROWGATE = WS_ROWTOK + 288 * 1024;
constexpr size_t WS_TILEE = WS_ROWGATE + 288 * 1024;
constexpr size_t WS_RSTD = WS_TILEE + 4 * 1024;
constexpr size_t WS_KMEAN = WS_RSTD + 128 * 1024;
constexpr size_t WS_WRL = WS_KMEAN + 128 * 1024;
static_assert(WS_WRL + 128 * 1024 <= 4 * MiB, "route region");
constexpr size_t WS_ROPEA = 4 * MiB;
constexpr size_t WS_ROPEB = 6 * MiB;
constexpr size_t WS_WIN = 8 * MiB;
constexpr size_t WS_WO = 12 * MiB;
constexpr size_t WS_WUP = 14 * MiB;
constexpr size_t WS_X1B = 16 * MiB;
constexpr size_t WS_WD = 48 * MiB;
constexpr size_t WS_XB = 112 * MiB;
constexpr size_t WS_PROJ = 144 * MiB;
constexpr size_t WS_QM = 208 * MiB;
constexpr size_t WS_KM = 232 * MiB;
constexpr size_t WS_VM = 256 * MiB;
constexpr size_t WS_QB = 272 * MiB;
constexpr size_t WS_KB = 288 * MiB;
constexpr size_t WS_ATT = 304 * MiB;
constexpr size_t WS_H = 112 * MiB;
constexpr size_t WS_WGU = 336 * MiB;
constexpr size_t WS_Y = (HANDOFF89 != 0) ? 400 * MiB : 336 * MiB;
constexpr size_t WS_LAT = 144 * MiB;
constexpr size_t WS_VB = 160 * MiB;
constexpr size_t WS_RSTDP = 176 * MiB;
constexpr size_t WS_KMEANP = 177 * MiB;
constexpr size_t WS_X1PRE = 144 * MiB;
constexpr size_t WS_X1Q = 256 * MiB;
constexpr size_t WS_END = 480 * MiB;
static_assert(WS_H + (size_t)MAXROWS * 1024 * 2 <= WS_VM + 0 * MiB + 0 && WS_Y + (size_t)MAXROWS * 1024 * ((Y_FP8 != 0) ? 1 : 2) <= WS_END && (HANDOFF89 == 0 || (Y_FP8 != 0 && GATEUP_FP8 == 2 && DOWN_FP8 == 2)), "ws map");
constexpr int CW_BAR = 4096, CW_HDONE = 7936, CW_RT = 16384;
constexpr int CW_DUMMY_ = 0;

constexpr int LDS_BYTES = 147456;
constexpr int MISC_OFF = 131072 + 320;

__device__ __forceinline__ float bf2f(unsigned v) { return __uint_as_float(v << 16); }
__device__ __forceinline__ unsigned f2bf(float f) { unsigned u = __float_as_uint(f); return (u + 0x7fffu + ((u >> 16) & 1u)) >> 16; }
__device__ __forceinline__ unsigned pk2(float lo, float hi) { typedef __bf16 bf2_t __attribute__((ext_vector_type(2))); f32x2 v = {lo, hi}; bf2_t b = __builtin_convertvector(v, bf2_t); return __builtin_bit_cast(unsigned, b); }
__device__ __forceinline__ float wave_sum(float v) {
#pragma unroll
    for (int o = 1; o < 64; o <<= 1) v += __shfl_xor(v, o);
    return v;
}
__device__ __forceinline__ float wave_max(float v) {
#pragma unroll
    for (int o = 1; o < 64; o <<= 1) v = fmaxf(v, __shfl_xor(v, o));
    return v;
}

#define XB_TMO      128
#define XB_XCNT(j)  (256  + 64 * (j))
#define XB_XSUB(j)  (1280 + 64 * (j))
#define XB_XGEN(j)  (2304 + 64 * (j))
#define XB_TOP      3328
#define XB_TOPGEN   3392
#define XCD_BAR_WORDS 3456
#define XB_SPIN_CAP (1u << 18)
__device__ __forceinline__ unsigned xb_ld(unsigned* p)              { return __hip_atomic_load(p, __ATOMIC_RELAXED, __HIP_MEMORY_SCOPE_AGENT); }
__device__ __forceinline__ unsigned xb_add(unsigned* p, unsigned v) { return __hip_atomic_fetch_add(p, v, __ATOMIC_RELAXED, __HIP_MEMORY_SCOPE_AGENT); }
__device__ __forceinline__ unsigned xb_xcc_id() { return (unsigned)__builtin_amdgcn_s_getreg((3 << 11) | 20) & 0xFu; }
#define XB_SPIN(cond, bar) do { unsigned _sp = 0; while (cond) { __builtin_amdgcn_s_sleep(1); \
    if ((++_sp & 255u) == 0u) { if (xb_ld(&(bar)[XB_TMO])) break; if (_sp > XB_SPIN_CAP) { atomicAdd(&(bar)[XB_TMO], 1u); break; } } } } while (0)
struct XcdBarrier { unsigned* bar; unsigned x; volatile LAS unsigned* st; };
__device__ __forceinline__ XcdBarrier xcd_barrier_post(unsigned* bar, volatile LAS unsigned* st) {
    XcdBarrier b; b.bar = bar; b.x = xb_xcc_id(); b.st = st;
    if (threadIdx.x == 0) (void)xb_add(&bar[XB_XCNT(b.x)], 1u);
    return b;
}
__device__ __forceinline__ void xcd_barrier_complete(unsigned* bar, unsigned x, unsigned& nloc, unsigned& nx) {
    const unsigned G = gridDim.x * gridDim.y * gridDim.z;
    unsigned sum, cnt, mine, sp = 0u;
    for (;;) {
        sum = 0u; cnt = 0u; mine = 0u;
#pragma unroll
        for (unsigned j = 0; j < 16; ++j) { const unsigned c = xb_ld(&bar[XB_XCNT(j)]); sum += c; cnt += (c > 0u) ? 1u : 0u; mine = (j == x) ? c : mine; }
        if (sum == G) break;
        __builtin_amdgcn_s_sleep(1);
        if ((++sp & 255u) == 0u) { if (xb_ld(&bar[XB_TMO])) break; if (sp > XB_SPIN_CAP) { atomicAdd(&bar[XB_TMO], 1u); break; } }
    }
    nloc = mine > 0u ? mine : 1u; nx = cnt > 0u ? cnt : 1u;
}
__device__ __forceinline__ void xcd_barrier(const XcdBarrier& b) {
    asm volatile("s_waitcnt vmcnt(0)" ::: "memory");
    __syncthreads();
    if (threadIdx.x == 0) {
        unsigned* bar = b.bar;
        __builtin_amdgcn_s_waitcnt(0);
        unsigned nloc = b.st[0], nx = b.st[1];
        if (nloc == 0u) { xcd_barrier_complete(bar, b.x, nloc, nx); b.st[0] = nloc; b.st[1] = nx; }
        const unsigned old = xb_add(&bar[XB_XSUB(b.x)], 1u);
        const unsigned gen = old / nloc;
        if (old + 1u == (gen + 1u) * nloc) {
            __builtin_amdgcn_fence(__ATOMIC_RELEASE, "agent");
            asm volatile("s_waitcnt vmcnt(0)" ::: "memory");
            (void)xb_add(&bar[XB_TOP], 1u);
        }
        XB_SPIN(xb_ld(&bar[XB_TOP]) < (gen + 1u) * nx, bar);
        __builtin_amdgcn_fence(__ATOMIC_ACQUIRE, "agent");
        asm volatile("s_waitcnt vmcnt(0)" ::: "memory");
    }
    __syncthreads();
}

struct Params {
    const float* x; const int* pos;
    const float *w_in, *q_a_norm, *w_q_b, *kv_a_norm, *w_kv_b, *w_o, *ln1_g, *ln1_b, *w_router, *b_router;
    const float *w_gate, *b_gate, *w_up, *b_up, *w_down, *b_down, *ln2_g, *ln2_b;
    float* out; unsigned char* ws;
    double invfA[16]; double invfB[8];
    int ph_lo, ph_hi;
};

struct Unit { int pm, pn, e; };
struct GemmArgs { const bf16_t* A; int lda; const bf16_t* Bt; int ldb; int K; };
template <bool PERM> __device__ __forceinline__ int ecol(int bj, int n, int wc, int fq) { return 128 * bj + 32 * wc + (PERM ? 8 * fq + 4 * n : 16 * n + 4 * fq); }

template <class Epi, class Sched>
__device__ __forceinline__ void gemm_phase_naive(LAS unsigned char* lds, const GemmArgs g, const Sched& S, const Epi& E) {
    const int tid = threadIdx.x, wid = __builtin_amdgcn_readfirstlane(tid >> 6), lane = tid & 63, wr = wid >> 2, wc = wid & 3, fr = lane & 15, fq = lane >> 4;
    Unit u;
    for (int ui = 0; S.next(ui, u); ++ui) {
        f32x4 acc[2][2][4][2];
#pragma unroll
        for (int a = 0; a < 2; ++a)
#pragma unroll
            for (int b = 0; b < 2; ++b)
#pragma unroll
                for (int m = 0; m < 4; ++m)
#pragma unroll
                    for (int n = 0; n < 2; ++n) acc[a][b][m][n] = (f32x4){0.f, 0.f, 0.f, 0.f};
        unsigned aoff[2][4];
#pragma unroll
        for (int a = 0; a < 2; ++a)
#pragma unroll
            for (int m = 0; m < 4; ++m) aoff[a][m] = (unsigned)S.arow(u, ui, 128 * a + 64 * wr + 16 * m + fr) * (unsigned)g.lda;
        const bf16_t* bb = g.Bt + (size_t)(S.brow0(u) + 32 * wc) * g.ldb;
        const unsigned bl0 = (unsigned)(4 * fq) * (unsigned)g.ldb, bl1 = (unsigned)(8 * fq) * (unsigned)g.ldb;
#pragma unroll 1
        for (int k = 0; k < g.K; k += 2) {
            float af[2][4][2];
#pragma unroll
            for (int a = 0; a < 2; ++a)
#pragma unroll
                for (int m = 0; m < 4; ++m) { const unsigned v = *(const unsigned*)(g.A + aoff[a][m] + k); af[a][m][0] = __uint_as_float(v << 16); af[a][m][1] = __uint_as_float(v & 0xffff0000u); }
#pragma unroll
            for (int b = 0; b < 2; ++b)
#pragma unroll
                for (int n = 0; n < 2; ++n)
#pragma unroll
                    for (int j = 0; j < 4; ++j) {
                        const int ccol = 128 * b + (Epi::PERM ? 4 * n : 16 * n) + j;
                        const unsigned v = *(const unsigned*)(bb + (size_t)ccol * g.ldb + ((Epi::PERM ? bl1 : bl0) + (unsigned)k));
                        const float b0 = __uint_as_float(v << 16), b1 = __uint_as_float(v & 0xffff0000u);
#pragma unroll
                        for (int a = 0; a < 2; ++a)
#pragma unroll
                            for (int m = 0; m < 4; ++m) acc[a][b][m][n][j] = fmaf(af[a][m][1], b1, fmaf(af[a][m][0], b0, acc[a][b][m][n][j]));
                    }
        }
        E(acc, u, wr, wc, fr, fq);
    }
}

namespace pg {
constexpr int BK = 64, HALF = 128, HTB = HALF * BK * 2;
__device__ __forceinline__ int lds_byte(int r, int c) { const int st = (r >> 4) * 2 + (c >> 5), rr = r & 15, cc = c & 31, ob = rr * 64 + cc * 2; return st * 1024 + (ob ^ (((ob >> 9) & 1) << 5)); }
__device__ __forceinline__ void stage_rc(int b, int& R, int& C) { const int st = b / 1024, sb = b % 1024, swz = sb ^ (((sb >> 9) & 1) << 5); R = (st >> 1) * 16 + swz / 64; C = (st & 1) * 32 + (swz % 64) / 2; }
__device__ __forceinline__ int perm32(int rho) { const int n = rho >> 4, i = rho & 15; return 8 * (i >> 2) + 4 * n + (i & 3); }
}
typedef int v8i_t __attribute__((ext_vector_type(8)));
template <class E, class = void> struct epi_fp8 { static constexpr bool value = false; };
template <class E> struct epi_fp8<E, decltype((void)E::FP8)> { static constexpr bool value = E::FP8; };
template <class E, class = void> struct epi_wide { static constexpr bool value = false; };
template <class E> struct epi_wide<E, decltype((void)E::WIDE)> { static constexpr bool value = E::WIDE; };
template <class E, class = void> struct epi_nmap64 { static constexpr bool value = false; };
template <class E> struct epi_nmap64<E, decltype((void)E::NMAP64)> { static constexpr bool value = E::NMAP64; };
template <class S, class = void> struct sched_dep { static constexpr bool value = false; };
template <class S> struct sched_dep<S, decltype((void)S::DEP)> { static constexpr bool value = S::DEP; };
template <class Epi, class Sched, bool ALIGN_EPI>
__device__ __forceinline__ void gemm_phase(LAS unsigned char* lds, const GemmArgs g, const Sched& S, const Epi& E) {
    using namespace pg;
    constexpr bool F8 = epi_fp8<Epi>::value; constexpr bool F8W = epi_wide<Epi>::value;
    const int tid = threadIdx.x, wid = __builtin_amdgcn_readfirstlane(tid >> 6), lane = tid & 63, wr = wid >> 2, wc = wid & 3, fr = lane & 15, fq = lane >> 4;
    const int nt = g.K / BK;
    int sR[2], sC[2], sRb[2];
#pragma unroll
    for (int i = 0; i < 2; ++i) { int R, C; stage_rc(tid * 16 + i * 8192, R, C); sR[i] = R; sC[i] = C; sRb[i] = Epi::PERM ? ((R & ~31) + perm32(R & 31)) : R;
        if constexpr (epi_nmap64<Epi>::value) sRb[i] = ((sRb[i] >> 5) << 6) + (sRb[i] & 31); }
    const unsigned ldsw = (unsigned)wid * 1024u;
    const int aoff = lds_byte(wr * 64 + fr, fq * 8), boff = lds_byte(wc * 32 + fr, fq * 8);
    const char* Ab = (const char*)g.A; const char* Bb = (const char*)g.Bt;
#define PG_SA(b, h) (((b) * 2 + (h)) * HTB)
#define PG_SB(b, h) ((4 + (b) * 2 + (h)) * HTB)
#define PG_STAGE(bufoff, gptr, v0, v1) do { \
        __builtin_amdgcn_global_load_lds((const unsigned*)((gptr) + (v0)), (LAS unsigned*)(lds + (bufoff) + ldsw), 16, 0, 0); \
        __builtin_amdgcn_global_load_lds((const unsigned*)((gptr) + (v1)), (LAS unsigned*)(lds + (bufoff) + ldsw + 8192), 16, 0, 0); } while (0)
#define PG_LDA2(dst, b, h) do { _Pragma("unroll") for (int m = 0; m < 2; ++m) { \
            const u32x4 lo_ = *(const LAS u32x4*)(lds + PG_SA(b, h) + aoff + (m + 2) * 2048), hi_ = *(const LAS u32x4*)(lds + PG_SA(b, h) + aoff + (m + 2) * 2048 + 1024); \
            dst##8[m] = (v8i_t){(int)lo_.x, (int)lo_.y, (int)lo_.z, (int)lo_.w, (int)hi_.x, (int)hi_.y, (int)hi_.z, (int)hi_.w}; } } while (0)
#define PG_LDA(dst, b, h) do { if constexpr (F8) { _Pragma("unroll") for (int m = 0; m < (F8W ? 2 : 4); ++m) { \
            const u32x4 lo_ = *(const LAS u32x4*)(lds + PG_SA(b, h) + aoff + m * 2048), hi_ = *(const LAS u32x4*)(lds + PG_SA(b, h) + aoff + m * 2048 + 1024); \
            dst##8[m] = (v8i_t){(int)lo_.x, (int)lo_.y, (int)lo_.z, (int)lo_.w, (int)hi_.x, (int)hi_.y, (int)hi_.z, (int)hi_.w}; } } \
        else { _Pragma("unroll") for (int m = 0; m < 4; ++m) _Pragma("unroll") for (int k = 0; k < 2; ++k) dst[m][k] = *(const LAS bf16x8*)(lds + PG_SA(b, h) + aoff + m * 2048 + k * 1024); } } while (0)
#define PG_LDB(dst, b, h) do { if constexpr (F8) { _Pragma("unroll") for (int n = 0; n < 2; ++n) { \
            const u32x4 lo_ = *(const LAS u32x4*)(lds + PG_SB(b, h) + boff + n * 2048), hi_ = *(const LAS u32x4*)(lds + PG_SB(b, h) + boff + n * 2048 + 1024); \
            dst##8[n] = (v8i_t){(int)lo_.x, (int)lo_.y, (int)lo_.z, (int)lo_.w, (int)hi_.x, (int)hi_.y, (int)hi_.z, (int)hi_.w}; } } \
        else { _Pragma("unroll") for (int n = 0; n < 2; ++n) _Pragma("unroll") for (int k = 0; k < 2; ++k) dst[n][k] = *(const LAS bf16x8*)(lds + PG_SB(b, h) + boff + n * 2048 + k * 1024); } } while (0)
#define PG_MMA(ai, bj, At, Bt) do { __builtin_amdgcn_s_setprio(1); _Pragma("unroll") for (int m = 0; m < 4; ++m) _Pragma("unroll") for (int n = 0; n < 2; ++n) _Pragma("unroll") for (int k = 0; k < 2; ++k) \
        acc[ai][bj][m][n] = __builtin_amdgcn_mfma_f32_16x16x32_bf16(Bt[n][k], At[m][k], acc[ai][bj][m][n], 0, 0, 0); __builtin_amdgcn_s_setprio(0); } while (0)
#define PG_MMA8(ai, At, Bt) do { __builtin_amdgcn_s_setprio(1); _Pragma("unroll") for (int m = 0; m < 4; ++m) _Pragma("unroll") for (int n = 0; n < 2; ++n) \
        acc[ai][0][m][n] = __builtin_amdgcn_mfma_scale_f32_16x16x128_f8f6f4(Bt##8[n], At##8[m], acc[ai][0][m][n], 0, 0, 0, 0, 0, 0); __builtin_amdgcn_s_setprio(0); } while (0)
#define PG_MMA8W(ai, m0, At) do { _Pragma("unroll") for (int m = 0; m < 2; ++m) _Pragma("unroll") for (int n = 0; n < 2; ++n) { \
        acc[ai][0][(m0) + m][n] = __builtin_amdgcn_mfma_scale_f32_16x16x128_f8f6f4(B08[n], At##8[m], acc[ai][0][(m0) + m][n], 0, 0, 0, 0, 0, 0); \
        acc[ai][1][(m0) + m][n] = __builtin_amdgcn_mfma_scale_f32_16x16x128_f8f6f4(B18[n], At##8[m], acc[ai][1][(m0) + m][n], 0, 0, 0, 0, 0, 0); } } while (0)
#define PG_MM(ai, bj, At, Bt) do { if constexpr (F8) { if constexpr ((bj) == 0) PG_MMA8(ai, At, Bt); } else PG_MMA(ai, bj, At, Bt); } while (0)
#define PG_WAIT_LOOP() do { if constexpr (F8 && !F8W) { asm volatile("s_waitcnt vmcnt(6)" ::: "memory"); } else { asm volatile("s_waitcnt vmcnt(8)" ::: "memory"); } } while (0)
#define PG_WAIT_V(n) asm volatile("s_waitcnt vmcnt(" #n ")" ::: "memory")
#define PG_WAIT_L(n) asm volatile("s_waitcnt lgkmcnt(" #n ")" ::: "memory")
#define PG_BAR __builtin_amdgcn_s_barrier()
#define PG_SCHED __builtin_amdgcn_sched_barrier(0)
    constexpr bool GA = Sched::GATHER;

    unsigned cA[2], cB[2];
#pragma unroll
    for (int i = 0; i < 2; ++i) { cA[i] = ((unsigned)sR[i] * (unsigned)g.lda + (unsigned)sC[i]) * 2u; cB[i] = ((unsigned)sRb[i] * (unsigned)g.ldb + (unsigned)sC[i]) * 2u; }
    const size_t hA = (size_t)128 * g.lda * 2, hB = (size_t)(epi_nmap64<Epi>::value ? 32 : 128) * g.ldb * 2;
#define PG_GOFFS(u, uidx, VA) do { if constexpr (GA) { _Pragma("unroll") for (int h = 0; h < 2; ++h) _Pragma("unroll") for (int i = 0; i < 2; ++i) \
        VA[h][i] = ((unsigned)S.arow(u, uidx, 128 * h + sR[i]) * (unsigned)g.lda + (unsigned)sC[i]) * 2u; } } while (0)
#define PG_UA(u) (GA ? (size_t)0 : (size_t)S.arow(u, 0, 0) * g.lda * 2)
#define PG_UB(u) ((size_t)S.brow0(u) * g.ldb * 2)
#define PG_STAGE_A(bufoff, ab, VA, h) do { if constexpr (GA) { PG_STAGE(bufoff, (ab), VA[h][0], VA[h][1]); } else { PG_STAGE(bufoff, (ab) + (h) * hA, cA[0], cA[1]); } } while (0)
#define PG_STAGE_B(bufoff, bb, h) PG_STAGE(bufoff, (bb) + (h) * hB, cB[0], cB[1])
    Unit cur, nxt; int ui = 0;
    if (!S.next(0, cur)) return;
    if constexpr (sched_dep<Sched>::value) { S.prepoll(); S.wait(cur, 0); }
    f32x4 acc[2][2][4][2];
#pragma unroll
    for (int a = 0; a < 2; ++a)
#pragma unroll
        for (int b = 0; b < 2; ++b)
#pragma unroll
            for (int m = 0; m < 4; ++m)
#pragma unroll
                for (int n = 0; n < 2; ++n) acc[a][b][m][n] = (f32x4){0.f, 0.f, 0.f, 0.f};
    bf16x8 At[4][2], B0[2][2], B1[2][2]; v8i_t At8[4], B08[2], B18[2];
    unsigned vA[2][2], nvA[2][2];
    PG_GOFFS(cur, 0, vA);
    const char* cAp = Ab + PG_UA(cur); const char* cBp = Bb + PG_UB(cur);
    PG_STAGE_B(PG_SB(0, 0), cBp, 0); if constexpr (!F8 || F8W) PG_STAGE_B(PG_SB(0, 1), cBp, 1); PG_STAGE_A(PG_SA(0, 0), cAp, vA, 0); PG_STAGE_A(PG_SA(0, 1), cAp, vA, 1);
    if (wr == 1) PG_BAR;
    PG_WAIT_V(2); PG_BAR;
    PG_STAGE_B(PG_SB(1, 0), cBp + 128, 0); PG_STAGE_A(PG_SA(1, 0), cAp + 128, vA, 0); if constexpr (!F8 || F8W) PG_STAGE_B(PG_SB(1, 1), cBp + 128, 1);
    if constexpr (F8 && !F8W) PG_WAIT_V(4); else PG_WAIT_V(6);
    PG_BAR;
    for (;;) {
        const bool has_next = S.next(ui + 1, nxt);
        if constexpr (sched_dep<Sched>::value) { if (has_next) S.wait(nxt, ui + 1); }
        const char* nAp = cAp; const char* nBp = cBp;
        if (has_next) { if constexpr (!F8W) PG_GOFFS(nxt, ui + 1, nvA); nAp = Ab + PG_UA(nxt); nBp = Bb + PG_UB(nxt); }
        else { if constexpr (GA && !F8W) {
#pragma unroll
            for (int h = 0; h < 2; ++h)
#pragma unroll
                for (int i = 0; i < 2; ++i) nvA[h][i] = vA[h][i]; } }
#pragma unroll 1
        for (int t = 0; t < nt; t += 2) {
            const bool last = (t == nt - 2);
            const char* a1 = cAp + (size_t)(t + 1) * 128;
            const char* a2 = last ? nAp : cAp + (size_t)(t + 2) * 128; const char* b2 = last ? nBp : cBp + (size_t)(t + 2) * 128;
            const char* a3 = a2 + 128; const char* b3 = b2 + 128;
            unsigned wA[2][2];
            if constexpr (GA && F8W) {
#pragma unroll
                for (int h = 0; h < 2; ++h)
#pragma unroll
                    for (int i = 0; i < 2; ++i) wA[h][i] = vA[h][i];
                if (last && has_next) { int t_ = threadIdx.x; asm volatile("" : "+v"(t_));
#pragma unroll
                    for (int i = 0; i < 2; ++i) { int R_, C_; stage_rc(t_ * 16 + i * 8192, R_, C_);
#pragma unroll
                        for (int h = 0; h < 2; ++h) wA[h][i] = ((unsigned)S.arow(nxt, ui + 1, 128 * h + R_) * (unsigned)g.lda + (unsigned)C_) * 2u; } } }
            else if constexpr (GA) {
#pragma unroll
                for (int h = 0; h < 2; ++h)
#pragma unroll
                    for (int i = 0; i < 2; ++i) wA[h][i] = last ? nvA[h][i] : vA[h][i]; }
            PG_LDB(B0, 0, 0); if constexpr (!F8 || F8W) PG_LDB(B1, 0, 1); PG_SCHED; PG_LDA(At, 0, 0); PG_STAGE_A(PG_SA(1, 1), a1, vA, 1);
            PG_WAIT_LOOP(); PG_WAIT_L(0); PG_BAR; if constexpr (F8W) { __builtin_amdgcn_s_setprio(1); PG_MMA8W(0, 0, At); PG_LDA2(At, 0, 0); PG_WAIT_L(0); PG_MMA8W(0, 2, At); __builtin_amdgcn_s_setprio(0); } else { PG_MM(0, 0, At, B0); PG_MM(0, 1, At, B1); } PG_BAR; PG_SCHED;
            PG_LDA(At, 0, 1); PG_STAGE_B(PG_SB(0, 0), b2, 0); if constexpr (!F8 || F8W) PG_STAGE_B(PG_SB(0, 1), b2, 1); PG_STAGE_A(PG_SA(0, 0), a2, wA, 0);
            PG_WAIT_LOOP(); PG_WAIT_L(0); PG_BAR; if constexpr (F8W) { __builtin_amdgcn_s_setprio(1); PG_MMA8W(1, 0, At); PG_LDA2(At, 0, 1); PG_WAIT_L(0); PG_MMA8W(1, 2, At); __builtin_amdgcn_s_setprio(0); } else { PG_MM(1, 0, At, B0); PG_MM(1, 1, At, B1); } PG_BAR; PG_SCHED;
            PG_LDB(B0, 1, 0); if constexpr (!F8 || F8W) PG_LDB(B1, 1, 1); PG_SCHED; PG_LDA(At, 1, 0); PG_STAGE_A(PG_SA(0, 1), a2, wA, 1);
            PG_WAIT_LOOP(); PG_WAIT_L(0); PG_BAR; if constexpr (F8W) { __builtin_amdgcn_s_setprio(1); PG_MMA8W(0, 0, At); PG_LDA2(At, 1, 0); PG_WAIT_L(0); PG_MMA8W(0, 2, At); __builtin_amdgcn_s_setprio(0); } else { PG_MM(0, 0, At, B0); PG_MM(0, 1, At, B1); } PG_BAR; PG_SCHED;
            PG_LDA(At, 1, 1); PG_STAGE_B(PG_SB(1, 0), b3, 0); if constexpr (!F8 || F8W) PG_STAGE_B(PG_SB(1, 1), b3, 1); PG_STAGE_A(PG_SA(1, 0), a3, wA, 0);
            PG_WAIT_LOOP(); PG_WAIT_L(0); PG_BAR; if constexpr (F8W) { __builtin_amdgcn_s_setprio(1); PG_MMA8W(1, 0, At); PG_LDA2(At, 1, 1); PG_WAIT_L(0); PG_MMA8W(1, 2, At); __builtin_amdgcn_s_setprio(0); } else { PG_MM(1, 0, At, B0); PG_MM(1, 1, At, B1); } PG_BAR; PG_SCHED;
        }
        if constexpr (ALIGN_EPI) { if (wr == 0) PG_BAR; }
        E(acc, cur, wr, wc, fr, fq);
        if (!has_next) break;
#pragma unroll
        for (int a = 0; a < 2; ++a)
#pragma unroll
            for (int b = 0; b < 2; ++b)
#pragma unroll
                for (int m = 0; m < 4; ++m)
#pragma unroll
                    for (int n = 0; n < 2; ++n) acc[a][b][m][n] = (f32x4){0.f, 0.f, 0.f, 0.f};
        cur = nxt; ++ui; cAp = nAp; cBp = nBp;
        if constexpr (GA && F8W) { int t_ = threadIdx.x; asm volatile("" : "+v"(t_));
#pragma unroll
            for (int i = 0; i < 2; ++i) { int R_, C_; stage_rc(t_ * 16 + i * 8192, R_, C_);
#pragma unroll
                for (int h = 0; h < 2; ++h) vA[h][i] = ((unsigned)S.arow(cur, ui, 128 * h + R_) * (unsigned)g.lda + (unsigned)C_) * 2u; } }
        else if constexpr (GA) {
#pragma unroll
            for (int h = 0; h < 2; ++h)
#pragma unroll
                for (int i = 0; i < 2; ++i) vA[h][i] = nvA[h][i]; }
        if constexpr (ALIGN_EPI) { if (wr == 1) PG_BAR; }
    }
    PG_WAIT_V(0);
    if constexpr (!ALIGN_EPI) { if (wr == 0) PG_BAR; }
    PG_BAR;
#undef PG_SA
#undef PG_SB
#undef PG_STAGE
#undef PG_LDA
#undef PG_LDB
#undef PG_MMA
#undef PG_MMA8
#undef PG_MMA8W
#undef PG_LDA2
#undef PG_MM
#undef PG_WAIT_LOOP
#undef PG_WAIT_V
#undef PG_WAIT_L
#undef PG_BAR
#undef PG_SCHED
#undef PG_GOFFS
#undef PG_UA
#undef PG_UB
#undef PG_STAGE_A
#undef PG_STAGE_B
}

constexpr int ROWTAB_OFF = 132096, ETAB_OFF = ROWTAB_OFF + 12 * 1024, MAXU = 12;
struct DenseSched {
    static constexpr bool GATHER = false;
    int nN, nunits, G, c;
    __device__ __forceinline__ void init(LAS unsigned char*, int M, int N, int G_, int c_) { nN = N / 256; nunits = (M / 256) * nN; G = G_; c = c_; }
    __device__ __forceinline__ bool next(int i, Unit& u) const { const int L = i * G + c; if (L >= nunits) return false; u.pm = L / nN; u.pn = L % nN; u.e = 0; return true; }
    __device__ __forceinline__ int arow(const Unit& u, int, int r) const { return 256 * u.pm + r; }
    __device__ __forceinline__ int brow0(const Unit& u) const { return 256 * u.pn; }
};
__device__ __forceinline__ int lane_now() { int l_; asm volatile("v_mbcnt_lo_u32_b32 %0, -1, 0\n\tv_mbcnt_hi_u32_b32 %0, -1, %0" : "=v"(l_)); return l_; }
template <bool GATHER_, bool DEP_ = false> struct GroupSched {
    static constexpr bool GATHER = GATHER_; static constexpr bool DEP = DEP_;
    unsigned* ready = nullptr;
    mutable unsigned pend = 0xffffffffu;
    __device__ __forceinline__ void prepoll() const { if constexpr (DEP_) { unsigned v[6]; Unit u;
#pragma unroll
            for (int i = 0; i < 6; ++i) { v[i] = 0u; if (next(i, u)) v[i] = xb_ld(ready + u.pm * 64 + lane_now()); }
            unsigned m = 0xffffffffu;
#pragma unroll
            for (int i = 0; i < 6; ++i) m &= (__builtin_amdgcn_ballot_w64(v[i] != 0u) == ~0ull) ? ~(1u << i) : 0xffffffffu;
            pend = (unsigned)__builtin_amdgcn_readfirstlane((int)m); } }
    __device__ __forceinline__ void wait(const Unit& u, int i) const { if constexpr (DEP_) { if (i >= 32 || ((pend >> i) & 1u)) { XB_SPIN(__builtin_amdgcn_ballot_w64(xb_ld(ready + u.pm * 64 + lane_now()) != 0u) != ~0ull, ready + (CW_BAR - CW_RT)); } } }
    LAS int* rowtab; LAS int* etab; int nN, nexp_rows, nunits, G, c, bn = 256;
    __device__ __forceinline__ void init(LAS unsigned char* lds, const int* te, const int* rt, int nN_, int nexp_rows_, int G_, int c_) {
        rowtab = (LAS int*)(lds + ROWTAB_OFF); etab = (LAS int*)(lds + ETAB_OFF); nN = nN_; nexp_rows = nexp_rows_; G = G_; c = c_;
        nunits = __builtin_amdgcn_readfirstlane(te[MAXTILES]) * nN_;
        for (int i = 0; i < MAXU; ++i) { const int L = i * G + c; if (L >= nunits) break; const int pm = L / nN;
            if (threadIdx.x == 0) etab[i] = te[pm];
            if (GATHER && threadIdx.x < 256) rowtab[i * 256 + threadIdx.x] = rt[256 * pm + threadIdx.x]; }
        __syncthreads();
    }
    int split = 1;
    __device__ __forceinline__ bool next(int i, Unit& u) const { const int j = i / split, L = j * G + c; if (L >= nunits || j >= MAXU) return false; u.pm = L / nN; u.pn = (L % nN) * split + (i % split); u.e = etab[j]; return true; }
    __device__ __forceinline__ int arow(const Unit& u, int ui, int r) const { return GATHER ? rowtab[(ui / split) * 256 + r] : 256 * u.pm + r; }
    __device__ __forceinline__ int brow0(const Unit& u) const { return u.e * nexp_rows + bn * u.pn; }
};

struct EpiProj {
    static constexpr bool PERM = true;
    static constexpr bool FP8 = (PROJ_FP8 != 0); static constexpr bool WIDE = FP8; static constexpr float AS = FP8 ? (1.0f / 64.0f) : 1.0f;
    unsigned char* ws;
    __device__ __forceinline__ void operator()(const f32x4 (&acc)[2][2][4][2], const Unit& u, int wr, int wc, int fr, int fq) const {
        asm volatile("" : "+v"(fr), "+v"(fq));
        bf16_t* LAT = (bf16_t*)(ws + WS_LAT); bf16_t* KM = (bf16_t*)(ws + WS_KM); bf16_t* QB = (bf16_t*)(ws + WS_QB); bf16_t* KB = (bf16_t*)(ws + WS_KB); bf16_t* VB = (bf16_t*)(ws + WS_VB);
        float* rstdp = (float*)(ws + WS_RSTDP); float* kmeanp = (float*)(ws + WS_KMEANP);
        const float* ropeA = (const float*)(ws + WS_ROPEA); const float* ropeB = (const float*)(ws + WS_ROPEB);
#pragma unroll
        for (int b = 0; b < 2; ++b) {
            const int g = 8 * u.pn + 4 * b + wc;
            if (g < 12) {
#pragma unroll
                for (int a = 0; a < 2; ++a)
#pragma unroll
                    for (int m = 0; m < 4; ++m) { const int row = 256 * u.pm + 128 * a + 64 * wr + 16 * m + fr; const f32x4 v0 = (acc[a][b][m][0] * AS), v1 = (acc[a][b][m][1] * AS);
                        u32x4 w; w.x = pk2(v0[0], v0[1]); w.y = pk2(v0[2], v0[3]); w.z = pk2(v1[0], v1[1]); w.w = pk2(v1[2], v1[3]);
                        *(u32x4*)(LAT + (size_t)row * 384 + g * 32 + 8 * fq) = w;
                        float ss = 0.f;
#pragma unroll
                        for (int k = 0; k < 4; ++k) { const float e0 = __uint_as_float(w[k] << 16), e1 = __uint_as_float(w[k] & 0xffff0000u); ss += e0 * e0 + e1 * e1; }
                        ss += __shfl_xor(ss, 16); ss += __shfl_xor(ss, 32);
                        if (fq == 0) rstdp[(size_t)row * 12 + g] = ss; }
            } else if (g == 12) {
#pragma unroll
                for (int a = 0; a < 2; ++a)
#pragma unroll
                    for (int m = 0; m < 4; ++m) { const int row = 256 * u.pm + 128 * a + 64 * wr + 16 * m + fr; u32x4 w;
#pragma unroll
                        for (int n = 0; n < 2; ++n) { const f32x4 v = (acc[a][b][m][n] * AS); f32x4 pv;
#pragma unroll
                            for (int j = 0; j < 4; ++j) { auto rr = __builtin_amdgcn_permlane32_swap(__float_as_uint(v[j]), __float_as_uint(v[j]), false, false); pv[j] = __uint_as_float(fq < 2 ? rr[1] : rr[0]); }
                            const f32x4 c = *(const f32x4*)(ropeA + (size_t)row * 32 + 8 * (fq & 1) + 4 * n), sn = *(const f32x4*)(ropeA + (size_t)row * 32 + 16 + 8 * (fq & 1) + 4 * n);
                            const f32x4 o = (fq < 2) ? (v * c - pv * sn) : (v * c + pv * sn);
                            w[2 * n] = pk2(o[0], o[1]); w[2 * n + 1] = pk2(o[2], o[3]); }
#pragma unroll
                        for (int h = 0; h < 8; ++h) *(u32x4*)(KM + (size_t)row * 768 + h * 96 + 64 + 8 * fq) = w; }
            } else if (g < 45) {
                const bool isk = g >= 29; const int rel = isk ? g - 29 : g - 13, head = rel >> 1, hf = rel & 1;
                bf16_t* dst = (isk ? KB : QB) + head * 64 + hf * 32 + 8 * fq;
                f32x4 cs0 = (f32x4){0.f, 0.f, 0.f, 0.f}, cs1 = cs0;
#pragma unroll
                for (int a = 0; a < 2; ++a)
#pragma unroll
                    for (int m = 0; m < 4; ++m) { const int row = 256 * u.pm + 128 * a + 64 * wr + 16 * m + fr; f32x4 v0 = (acc[a][b][m][0] * AS), v1 = (acc[a][b][m][1] * AS);
                        if (hf == 0) {
#pragma unroll
                            for (int n = 0; n < 2; ++n) { const f32x4 v = n ? v1 : v0; f32x4 pv;
#pragma unroll
                                for (int j = 0; j < 4; ++j) { auto rr = __builtin_amdgcn_permlane16_swap(__float_as_uint(v[j]), __float_as_uint(v[j]), false, false); pv[j] = __uint_as_float((fq & 1) ? rr[0] : rr[1]); }
                                const f32x4 c = *(const f32x4*)(ropeB + (size_t)row * 16 + 4 * n), sn = *(const f32x4*)(ropeB + (size_t)row * 16 + 8 + 4 * n);
                                const f32x4 o = (fq == 0) ? (v * c - pv * sn) : (fq == 1) ? (v * c + pv * sn) : v;
                                if (n) v1 = o; else v0 = o; } }
                        if (isk) { cs0 += v0; cs1 += v1; }
                        const f32x4 s0 = isk ? v0 : v0 * C2B, s1 = isk ? v1 : v1 * C2B;
                        u32x4 w; w.x = pk2(s0[0], s0[1]); w.y = pk2(s0[2], s0[3]); w.z = pk2(s1[0], s1[1]); w.w = pk2(s1[2], s1[3]);
                        *(u32x4*)(dst + (size_t)row * 512) = w; }
                if (isk) {
#pragma unroll
                    for (int j = 0; j < 4; ++j) {
#pragma unroll
                        for (int o = 1; o < 16; o <<= 1) { cs0[j] += __shfl_xor(cs0[j], o); cs1[j] += __shfl_xor(cs1[j], o); } }
                    if (fr == 0) { float* kp = kmeanp + ((size_t)u.pm * 2 + wr) * 512 + head * 64 + hf * 32 + 8 * fq; *(f32x4*)kp = cs0; *(f32x4*)(kp + 4) = cs1; } }
            } else if (g < 61) {
                const int rel = g - 45;
#pragma unroll
                for (int a = 0; a < 2; ++a)
#pragma unroll
                    for (int m = 0; m < 4; ++m) { const int row = 256 * u.pm + 128 * a + 64 * wr + 16 * m + fr; const f32x4 v0 = (acc[a][b][m][0] * AS), v1 = (acc[a][b][m][1] * AS);
                        u32x4 w; w.x = pk2(v0[0], v0[1]); w.y = pk2(v0[2], v0[3]); w.z = pk2(v1[0], v1[1]); w.w = pk2(v1[2], v1[3]);
                        *(u32x4*)(VB + (size_t)row * 512 + rel * 32 + 8 * fq) = w; }
            }
            asm volatile("" ::: "memory");
        }
    }
};
struct EpiUp {
    static constexpr bool PERM = true;
    bf16_t *QM, *KM, *VM; const float* rstd; const float* ropeA; int gbase;
    LAS unsigned char* lds;
    __device__ __forceinline__ void operator()(const f32x4 (&acc)[2][2][4][2], const Unit& u, int wr, int wc, int fr, int fq) const {
        asm volatile("" : "+v"(fr), "+v"(fq));
        const int wid_ = __builtin_amdgcn_readfirstlane(threadIdx.x >> 6), ln_ = threadIdx.x & 63;
        LAS float* fac = (LAS float*)(lds + ROWTAB_OFF) + wid_ * 128;
#pragma unroll
        for (int q = 0; q < 2; ++q) { const int rho = ln_ + 64 * q, row = 256 * u.pm + 128 * (rho >> 6) + 64 * wr + (rho & 63);
            float f;
            if (gbase == 0) { const f32x4 s0 = *(const f32x4*)(rstd + (size_t)row * 12), s1 = *(const f32x4*)(rstd + (size_t)row * 12 + 4);
                f = C2A * __builtin_amdgcn_rsqf((((s0[0] + s0[1]) + (s0[2] + s0[3])) + ((s1[0] + s1[1]) + (s1[2] + s1[3]))) * (1.0f / 256.0f) + RMS_EPS); }
            else { const f32x4 s2 = *(const f32x4*)(rstd + (size_t)row * 12 + 8); f = __builtin_amdgcn_rsqf(((s2[0] + s2[1]) + (s2[2] + s2[3])) * (1.0f / 128.0f) + RMS_EPS); }
            fac[rho] = f; }
        asm volatile("s_waitcnt lgkmcnt(0)" ::: "memory");
#pragma unroll
        for (int a = 0; a < 2; ++a) {
#pragma unroll
            for (int m = 0; m < 4; ++m) { const int row = 256 * u.pm + 128 * a + 64 * wr + 16 * m + fr;
                const float rf = fac[64 * a + 16 * m + fr];
#pragma unroll
                for (int b = 0; b < 2; ++b) {
                    const int gidx = gbase + 8 * u.pn + 4 * b + wc;
                    if (gidx < 24) {
                        const int h = gidx / 3, part = gidx % 3;
                        f32x4 v0 = acc[a][b][m][0] * rf, v1 = acc[a][b][m][1] * rf;
                        if (part == 2) {
#pragma unroll
                            for (int n = 0; n < 2; ++n) { const f32x4 v = n ? v1 : v0; f32x4 pv;
#pragma unroll
                                for (int j = 0; j < 4; ++j) { auto rr = __builtin_amdgcn_permlane32_swap(__float_as_uint(v[j]), __float_as_uint(v[j]), false, false); pv[j] = __uint_as_float(fq < 2 ? rr[1] : rr[0]); }
                                const f32x4 c = *(const f32x4*)(ropeA + (size_t)row * 32 + 8 * (fq & 1) + 4 * n), sn = *(const f32x4*)(ropeA + (size_t)row * 32 + 16 + 8 * (fq & 1) + 4 * n);
                                const f32x4 o = (fq < 2) ? (v * c - pv * sn) : (v * c + pv * sn);
                                if (n) v1 = o; else v0 = o; } }
                        u32x4 w; w.x = pk2(v0[0], v0[1]); w.y = pk2(v0[2], v0[3]); w.z = pk2(v1[0], v1[1]); w.w = pk2(v1[2], v1[3]);
                        *(u32x4*)(QM + (size_t)row * 768 + h * 96 + part * 32 + 8 * fq) = w;
                    } else {
                        const int g2 = gidx - 24, h = g2 >> 2, part = g2 & 3;
                        const f32x4 v0 = acc[a][b][m][0] * rf, v1 = acc[a][b][m][1] * rf;
                        bf16_t* pp = (part < 2) ? (KM + (size_t)row * 768 + h * 96 + part * 32 + 8 * fq) : (VM + (size_t)row * 512 + h * 64 + (part - 2) * 32 + 8 * fq);
                        u32x4 w; w.x = pk2(v0[0], v0[1]); w.y = pk2(v0[2], v0[3]); w.z = pk2(v1[0], v1[1]); w.w = pk2(v1[2], v1[3]);
                        *(u32x4*)pp = w;
                    }
                } }
            asm volatile("" ::: "memory"); }
    }
};
struct EpiWo {
    static constexpr bool PERM = (X1PRE_BF16 != 0); static constexpr bool FP8 = (WO_FP8 != 0); static constexpr bool WIDE = FP8;
    const float* x; float* O; const bf16_t* xb;
    __device__ __forceinline__ void operator()(const f32x4 (&acc)[2][2][4][2], const Unit& u, int wr, int wc, int fr, int fq) const {
        asm volatile("" : "+v"(fr), "+v"(fq));
#pragma unroll
        for (int a = 0; a < 2; ++a)
#pragma unroll
            for (int m = 0; m < 4; ++m) { const int row = 256 * u.pm + 128 * a + 64 * wr + 16 * m + fr;
#pragma unroll
                for (int b = 0; b < 2; ++b) {
                    if constexpr (X1PRE_BF16 != 0) { const size_t off = (size_t)row * DM + 256 * u.pn + 128 * b + 32 * wc + 8 * fq; f32x4 x0, x1;
                        if constexpr (WO_X_BF16 != 0) { const u32x4 xw = *(const u32x4*)(xb + off);
                            x0 = (f32x4){__uint_as_float(xw.x << 16), __uint_as_float(xw.x & 0xffff0000u), __uint_as_float(xw.y << 16), __uint_as_float(xw.y & 0xffff0000u)};
                            x1 = (f32x4){__uint_as_float(xw.z << 16), __uint_as_float(xw.z & 0xffff0000u), __uint_as_float(xw.w << 16), __uint_as_float(xw.w & 0xffff0000u)}; }
                        else { x0 = *(const f32x4*)(x + off); x1 = *(const f32x4*)(x + off + 4); }
                        constexpr float AS = FP8 ? (1.0f / 4096.0f) : 1.0f; const f32x4 v0 = x0 * DN_ALPHA + acc[a][b][m][0] * AS, v1 = x1 * DN_ALPHA + acc[a][b][m][1] * AS;
                        u32x4 w; w.x = pk2(v0[0], v0[1]); w.y = pk2(v0[2], v0[3]); w.z = pk2(v1[0], v1[1]); w.w = pk2(v1[2], v1[3]);
                        *(u32x4*)((bf16_t*)O + off) = w; }
                    else {
#pragma unroll
                        for (int n = 0; n < 2; ++n) { const size_t off = (size_t)row * DM + 256 * u.pn + ecol<PERM>(b, n, wc, fq);
                            const f32x4 xv = *(const f32x4*)(x + off); *(f32x4*)(O + off) = xv * DN_ALPHA + acc[a][b][m][n]; } } } }
    }
};
__device__ __forceinline__ void st_wt(u32x4 w, void* ptr) {
#if 1
    __builtin_nontemporal_store(w, (u32x4*)ptr);
#else
    asm volatile("global_store_dwordx4 %0, %1, off nt\n\ts_nop 2" :: "v"(ptr), "v"(w) : "memory");
#endif
}
struct EpiGateUp {
    static constexpr bool FP8 = (GATEUP_FP8 == 2); static constexpr bool WIDE = FP8;
    static constexpr bool PERM = true;
    bf16_t* H; const float *bg, *bu; unsigned* rt = nullptr; mutable int prev = -1;
    __device__ __forceinline__ void signal(int wave, bool lane0) const { if (prev >= 0 && lane0) __hip_atomic_store(rt + prev * 8 + wave, 1u, __ATOMIC_RELAXED, __HIP_MEMORY_SCOPE_AGENT); }
    __device__ __forceinline__ void operator()(const f32x4 (&acc)[2][2][4][2], const Unit& u, int wr, int wc, int fr, int fq) const {
        asm volatile("" : "+v"(fr), "+v"(fq));
        const int hc = 128 * u.pn + 32 * wc + 8 * fq;
        f32x4 vbg[2], vbu[2];
#pragma unroll
        for (int n = 0; n < 2; ++n) { vbg[n] = *(const f32x4*)(bg + (size_t)u.e * 1024 + hc + 4 * n); vbu[n] = *(const f32x4*)(bu + (size_t)u.e * 1024 + hc + 4 * n) + 1.0f; }
        if constexpr (DOWN_FP8 != 0 && HANDOFF89 != 0 && H_SC1 != 0) {
            const __amdgpu_buffer_rsrc_t rs = __builtin_amdgcn_make_buffer_rsrc((void*)H, 0, (int)((size_t)MAXROWS * 1024), 0x00020000);
            const bool odd = (fq & 1) != 0;
#pragma unroll
            for (int a = 0; a < 2; ++a)
#pragma unroll
                for (int mp = 0; mp < 2; ++mp) { unsigned wq[2][2];
#pragma unroll
                    for (int q = 0; q < 2; ++q)
#pragma unroll
                        for (int n = 0; n < 2; ++n) { const int m = 2 * mp + q; const f32x4 gv = acc[a][0][m][n] * (1.0f / 64.0f) + vbg[n], uv = acc[a][1][m][n] * (1.0f / 64.0f) + vbu[n]; float hv[4];
#pragma unroll
                            for (int j = 0; j < 4; ++j) { const float gg = fminf(gv[j], 7.0f), uu1 = __builtin_amdgcn_fmed3f(uv[j], -6.0f, 8.0f);
                                const float sg = __builtin_amdgcn_rcpf(1.0f + __builtin_amdgcn_exp2f(-1.702f * LOG2E * gg)); hv[j] = (gg * uu1) * sg; }
                            unsigned q_ = 0u; q_ = __builtin_amdgcn_cvt_pk_fp8_f32(hv[0], hv[1], q_, false); q_ = __builtin_amdgcn_cvt_pk_fp8_f32(hv[2], hv[3], q_, true); wq[q][n] = q_; __builtin_amdgcn_sched_barrier(0); }
                    const unsigned s0 = odd ? wq[0][0] : wq[1][0], s1 = odd ? wq[0][1] : wq[1][1];
                    auto r0 = __builtin_amdgcn_permlane16_swap(s0, s0, false, false); auto r1 = __builtin_amdgcn_permlane16_swap(s1, s1, false, false);
                    const unsigned p0 = odd ? r0[0] : r0[1], p1 = odd ? r1[0] : r1[1];
                    const int row = 256 * u.pm + 128 * a + 64 * wr + 16 * (2 * mp + (odd ? 1 : 0)) + fr;
                    const u32x4 v = odd ? (u32x4){p0, p1, wq[1][0], wq[1][1]} : (u32x4){wq[0][0], wq[0][1], p0, p1};
                    __builtin_amdgcn_raw_buffer_store_b128(v, rs, row * 1024 + 128 * u.pn + 32 * wc + 16 * (fq >> 1), 0, 16); }
        } else
#pragma unroll
        for (int a = 0; a < 2; ++a)
#pragma unroll
            for (int m = 0; m < 4; ++m) { const int row = 256 * u.pm + 128 * a + 64 * wr + 16 * m + fr; u32x4 w;
#pragma unroll
                for (int n = 0; n < 2; ++n) { constexpr float AS = FP8 ? (1.0f / 64.0f) : 1.0f; const f32x4 gv = acc[a][0][m][n] * AS + vbg[n], uv = acc[a][1][m][n] * AS + vbu[n]; float hv[4];
#pragma unroll
                    for (int j = 0; j < 4; ++j) { const float gg = fminf(gv[j], 7.0f), uu1 = __builtin_amdgcn_fmed3f(uv[j], -6.0f, 8.0f);
                        const float sg = __builtin_amdgcn_rcpf(1.0f + __builtin_amdgcn_exp2f(-1.702f * LOG2E * gg)); hv[j] = (gg * uu1) * sg; }
                    if constexpr (DOWN_FP8 != 0) { unsigned q_ = 0u; q_ = __builtin_amdgcn_cvt_pk_fp8_f32(hv[0], hv[1], q_, false); q_ = __builtin_amdgcn_cvt_pk_fp8_f32(hv[2], hv[3], q_, true); w[n] = q_; }
                    else { w[2 * n] = pk2(hv[0], hv[1]); w[2 * n + 1] = pk2(hv[2], hv[3]); } }
                if constexpr (DOWN_FP8 != 0 && HANDOFF89 != 0 && H_SC1 != 0) __hip_atomic_store((unsigned long long*)((unsigned char*)H + (size_t)row * 1024 + hc), (unsigned long long)w[0] | ((unsigned long long)w[1] << 32), __ATOMIC_RELAXED, __HIP_MEMORY_SCOPE_AGENT);
                else if constexpr (DOWN_FP8 != 0) __builtin_nontemporal_store((u32x2){w[0], w[1]}, (u32x2*)((unsigned char*)H + (size_t)row * 1024 + hc));
                else st_wt(w, H + (size_t)row * 1024 + hc); }
        if constexpr (HANDOFF89 != 0) { signal(wr * 4 + wc, (fr | fq) == 0); prev = u.pm * 8 + u.pn; }
    }
};
struct EpiGateUp8 {
    static constexpr bool FP8 = true; static constexpr bool PERM = true;
    bf16_t* H; const float *bg, *bu;
    __device__ __forceinline__ void operator()(const f32x4 (&acc)[2][2][4][2], const Unit& u, int wr, int wc, int fr, int fq) const {
        asm volatile("" : "+v"(fr), "+v"(fq));
        const int hc = 64 * u.pn + 16 * wc + 4 * fq;
        const f32x4 vbg = *(const f32x4*)(bg + (size_t)u.e * 1024 + hc), vbu = *(const f32x4*)(bu + (size_t)u.e * 1024 + hc) + 1.0f;
        unsigned char* hq = (unsigned char*)H + 64 * u.pn + 16 * wc + 8 * (fq >> 1);
#pragma unroll
        for (int a = 0; a < 2; ++a)
#pragma unroll
            for (int mp = 0; mp < 2; ++mp) { unsigned d[2];
#pragma unroll
                for (int q = 0; q < 2; ++q) { const int m = 2 * mp + q; const f32x4 gv = acc[a][0][m][0] * (1.0f / 64.0f) + vbg, uv = acc[a][0][m][1] * (1.0f / 64.0f) + vbu; float hv[4];
#pragma unroll
                    for (int j = 0; j < 4; ++j) { const float gg = fminf(gv[j], 7.0f), uu1 = __builtin_amdgcn_fmed3f(uv[j], -6.0f, 8.0f);
                        const float sg = __builtin_amdgcn_rcpf(1.0f + __builtin_amdgcn_exp2f(-1.702f * LOG2E * gg)); hv[j] = (gg * uu1) * sg; }
                    unsigned w_ = 0u; w_ = __builtin_amdgcn_cvt_pk_fp8_f32(hv[0], hv[1], w_, false); w_ = __builtin_amdgcn_cvt_pk_fp8_f32(hv[2], hv[3], w_, true); d[q] = w_; }
                auto r0 = __builtin_amdgcn_permlane16_swap(d[0], d[0], false, false); auto r1 = __builtin_amdgcn_permlane16_swap(d[1], d[1], false, false);
                const unsigned p0 = (fq & 1) ? r0[0] : r0[1], p1 = (fq & 1) ? r1[0] : r1[1];
                const int m = 2 * mp + (fq & 1), row = 256 * u.pm + 128 * a + 64 * wr + 16 * m + fr;
                const u32x2 o = (fq & 1) ? (u32x2){p1, d[1]} : (u32x2){d[0], p0};
                __builtin_nontemporal_store(o, (u32x2*)(hq + (size_t)row * 1024)); }
    }
};
struct EpiDown {
    static constexpr bool FP8 = (DOWN_FP8 != 0); static constexpr bool WIDE = (DOWN_FP8 == 2);
    static constexpr bool PERM = true; static constexpr bool NMAP64 = !FP8 || WIDE;
    bf16_t* Y; const float* bd; const float* row_gate;
    __device__ __forceinline__ void operator()(const f32x4 (&acc)[2][2][4][2], const Unit& u, int wr, int wc, int fr, int fq) const {
        asm volatile("" : "+v"(fr), "+v"(fq));
        constexpr int NB = (FP8 && !WIDE) ? 1 : 2; constexpr float AS = FP8 ? (1.0f / 64.0f) : 1.0f; constexpr bool N1 = FP8 && !WIDE;
        f32x4 bv[2][2];
#pragma unroll
        for (int b = 0; b < NB; ++b)
#pragma unroll
            for (int n = 0; n < 2; ++n) bv[b][n] = *(const f32x4*)(bd + (size_t)u.e * 1024 + (N1 ? 128 * u.pn + 32 * wc : 256 * u.pn + 64 * wc + 32 * b) + 8 * fq + 4 * n);
        float gwv[2][4];
#pragma unroll
        for (int a = 0; a < 2; ++a)
#pragma unroll
            for (int m = 0; m < 4; ++m) gwv[a][m] = row_gate[256 * u.pm + 128 * a + 64 * wr + 16 * m + fr];
        asm volatile("" ::: "memory");
#pragma unroll
        for (int a = 0; a < 2; ++a)
#pragma unroll
            for (int m = 0; m < 4; ++m) { const int row = 256 * u.pm + 128 * a + 64 * wr + 16 * m + fr; const float gw = gwv[a][m];
#pragma unroll
                for (int b = 0; b < NB; ++b) { const int col = (N1 ? 128 * u.pn + 32 * wc : 256 * u.pn + 64 * wc + 32 * b) + 8 * fq;
                    if constexpr (Y_FP8 != 0) { const float gs = gw * 32.0f;
                        const f32x4 v0 = (acc[a][b][m][0] * AS + bv[b][0]) * gs, v1 = (acc[a][b][m][1] * AS + bv[b][1]) * gs; unsigned q0 = 0u, q1 = 0u;
                        q0 = __builtin_amdgcn_cvt_pk_fp8_f32(v0[0], v0[1], q0, false); q0 = __builtin_amdgcn_cvt_pk_fp8_f32(v0[2], v0[3], q0, true);
                        q1 = __builtin_amdgcn_cvt_pk_fp8_f32(v1[0], v1[1], q1, false); q1 = __builtin_amdgcn_cvt_pk_fp8_f32(v1[2], v1[3], q1, true);
                        __builtin_nontemporal_store((u32x2){q0, q1}, (u32x2*)((unsigned char*)Y + (size_t)row * 1024 + col)); }
                    else {
                    const f32x4 v0 = (acc[a][b][m][0] * AS + bv[b][0]) * gw, v1 = (acc[a][b][m][1] * AS + bv[b][1]) * gw;
                    u32x4 w; w.x = pk2(v0[0], v0[1]); w.y = pk2(v0[2], v0[3]); w.z = pk2(v1[0], v1[1]); w.w = pk2(v1[2], v1[3]);
                    __builtin_nontemporal_store(w, (u32x4*)(Y + (size_t)row * 1024 + col)); } } }
    }
};

__device__ __forceinline__ unsigned cvtpk_hw(float lo, float hi) { typedef __bf16 bf2 __attribute__((ext_vector_type(2))); f32x2 v = {lo, hi}; bf2 b = __builtin_convertvector(v, bf2); return __builtin_bit_cast(unsigned, b); }
__device__ __forceinline__ void conv_issue(const float* W, int ldw, int k0, int n0, LAS unsigned char* scr, int lane) {
#pragma unroll
    for (int i = 0; i < 4; ++i) __builtin_amdgcn_global_load_lds((const unsigned*)(W + (size_t)(k0 + 4 * (lane >> 3) + i) * ldw + n0 + 4 * (lane & 7)), (LAS unsigned*)(scr + i * 1024), 16, 0, 2);
}
template <int MODE = 0>
__device__ __forceinline__ void conv_finish(bf16_t* WT, int ldt, int orow0, int ocol0, const LAS unsigned char* scr, int lane) {
    f32x4 r[4];
#pragma unroll
    for (int i = 0; i < 4; ++i) r[i] = *(const LAS f32x4*)(scr + i * 1024 + lane * 16);
#pragma unroll
    for (int j = 0; j < 4; ++j) { u32x2 o; o.x = cvtpk_hw(r[0][j], r[1][j]); o.y = cvtpk_hw(r[2][j], r[3][j]);
        u32x2* dst = (u32x2*)(WT + (size_t)(orow0 + 4 * (lane & 7) + j) * ldt + ocol0 + 4 * (lane >> 3));
        if (MODE == 1) { asm volatile("" :: "v"(o.x), "v"(o.y), "v"(dst)); }
        else if (MODE == 2) __builtin_nontemporal_store(o, dst);
        else *dst = o; }
}
constexpr int NEXP_ITEMS = 3 * NE * 1024;
__device__ __forceinline__ void expert_issue(const Params& p, int r, LAS unsigned char* scr, int lane) {
    const int mat = r >> 15, rr = r & 32767, e = rr >> 10, q = rr & 1023, kb = (q & 1) | ((q >> 6) << 1), nb = (q >> 1) & 31;
    const float* W = (mat == 0 ? p.w_gate : mat == 1 ? p.w_up : p.w_down) + (size_t)e * 1048576;
    conv_issue(W, 1024, 32 * kb, 32 * nb, scr, lane);
}
template <int MODE = 0>
__device__ __forceinline__ void expert_finish(const Params& p, int r, const LAS unsigned char* scr, int lane) {
    const int mat = r >> 15, rr = r & 32767, e = rr >> 10, q = rr & 1023, kb = (q & 1) | ((q >> 6) << 1), nb = (q >> 1) & 31, n0 = 32 * nb;
    bf16_t* WguT = (bf16_t*)(p.ws + WS_WGU); bf16_t* WdT = (bf16_t*)(p.ws + WS_WD);
    if (mat == 2) conv_finish<MODE>(WdT, 1024, e * 1024 + n0, 32 * kb, scr, lane);
    else conv_finish<MODE>(WguT, 1024, e * 2048 + (n0 >> 7) * 256 + (mat == 1 ? 128 : 0) + (n0 & 127), 32 * kb, scr, lane);
}
constexpr int NEXP_ITEMS8 = 3 * NE * 512;
template <int I0 = 0, int I1 = 8>
__device__ __forceinline__ void expert_issue8(const Params& p, int r, LAS unsigned char* scr, int lane) {
    const int mat = r >> 14, rr = r & 16383, e = rr >> 9, q = rr & 511, kb = q >> 5, nb = q & 31;
    const float* W = (mat == 0 ? p.w_gate : mat == 1 ? p.w_up : p.w_down) + (size_t)e * 1048576 + (size_t)(64 * kb + 8 * (lane >> 3)) * 1024 + 32 * nb + 4 * (lane & 7);
#pragma unroll
    for (int i = I0; i < I1; ++i) __builtin_amdgcn_global_load_lds((const unsigned*)(W + i * 1024), (LAS unsigned*)(scr + i * 1024), 16, 0, 2);
}
__device__ __forceinline__ void expert_finish8(const Params& p, int r, const LAS unsigned char* scr, int lane) {
    const int mat = r >> 14, rr = r & 16383, e = rr >> 9, q = rr & 511, kb = q >> 5, nb = q & 31, n0 = 32 * nb;
    if (GATEUP_FP8 == 2 && mat != 2) {
        unsigned char* d8 = p.ws + WS_WGU + (size_t)(e * 2048 + (n0 >> 7) * 256 + (mat == 1 ? 128 : 0) + (n0 & 127) + 4 * (lane & 7)) * 1024 + 64 * kb + 8 * (lane >> 3);
        f32x4 v[8];
#pragma unroll
        for (int i = 0; i < 8; ++i) v[i] = *(const LAS f32x4*)(scr + i * 1024 + lane * 16) * 64.0f;
#pragma unroll
        for (int j = 0; j < 4; ++j) { unsigned w0 = 0u, w1 = 0u;
            w0 = __builtin_amdgcn_cvt_pk_fp8_f32(v[0][j], v[1][j], w0, false); w0 = __builtin_amdgcn_cvt_pk_fp8_f32(v[2][j], v[3][j], w0, true);
            w1 = __builtin_amdgcn_cvt_pk_fp8_f32(v[4][j], v[5][j], w1, false); w1 = __builtin_amdgcn_cvt_pk_fp8_f32(v[6][j], v[7][j], w1, true);
            __builtin_nontemporal_store((u32x2){w0, w1}, (u32x2*)(d8 + j * 1024)); }
        return; }
    if (GATEUP_FP8 == 1 && mat != 2) {
        const int hh = n0 + 4 * (lane & 7), r64 = hh & 63;
        unsigned char* d8 = p.ws + WS_WGU + (size_t)(e * 2048 + 128 * (hh >> 6) + 32 * (r64 >> 4) + 8 * ((r64 >> 2) & 3) + 4 * mat) * 1024 + 64 * kb + 8 * (lane >> 3);
        f32x4 v[8];
#pragma unroll
        for (int i = 0; i < 8; ++i) v[i] = *(const LAS f32x4*)(scr + i * 1024 + lane * 16) * 64.0f;
#pragma unroll
        for (int j = 0; j < 4; ++j) { unsigned w0 = 0u, w1 = 0u;
            w0 = __builtin_amdgcn_cvt_pk_fp8_f32(v[0][j], v[1][j], w0, false); w0 = __builtin_amdgcn_cvt_pk_fp8_f32(v[2][j], v[3][j], w0, true);
            w1 = __builtin_amdgcn_cvt_pk_fp8_f32(v[4][j], v[5][j], w1, false); w1 = __builtin_amdgcn_cvt_pk_fp8_f32(v[6][j], v[7][j], w1, true);
            __builtin_nontemporal_store((u32x2){w0, w1}, (u32x2*)(d8 + j * 1024)); }
        return; }
    if (DOWN_FP8 != 0 && mat == 2) {
        unsigned char* d8 = p.ws + WS_WD + (size_t)(e * 1024 + n0 + 4 * (lane & 7)) * 1024 + 64 * kb + 8 * (lane >> 3);
        f32x4 v[8];
#pragma unroll
        for (int i = 0; i < 8; ++i) v[i] = *(const LAS f32x4*)(scr + i * 1024 + lane * 16) * 64.0f;
#pragma unroll
        for (int j = 0; j < 4; ++j) { unsigned w0 = 0u, w1 = 0u;
            w0 = __builtin_amdgcn_cvt_pk_fp8_f32(v[0][j], v[1][j], w0, false); w0 = __builtin_amdgcn_cvt_pk_fp8_f32(v[2][j], v[3][j], w0, true);
            w1 = __builtin_amdgcn_cvt_pk_fp8_f32(v[4][j], v[5][j], w1, false); w1 = __builtin_amdgcn_cvt_pk_fp8_f32(v[6][j], v[7][j], w1, true);
            __builtin_nontemporal_store((u32x2){w0, w1}, (u32x2*)(d8 + j * 1024)); }
        return; }
    bf16_t* dst = (mat == 2) ? (bf16_t*)(p.ws + WS_WD) + (size_t)(e * 1024 + n0) * 1024 : (bf16_t*)(p.ws + WS_WGU) + (size_t)(e * 2048 + (n0 >> 7) * 256 + (mat == 1 ? 128 : 0) + (n0 & 127)) * 1024;
    dst += (size_t)(4 * (lane & 7)) * 1024 + 64 * kb + 8 * (lane >> 3);
    f32x4 v[8];
#pragma unroll
    for (int i = 0; i < 8; ++i) v[i] = *(const LAS f32x4*)(scr + i * 1024 + lane * 16);
#pragma unroll
    for (int j = 0; j < 4; ++j) { u32x4 o; o.x = cvtpk_hw(v[0][j], v[1][j]); o.y = cvtpk_hw(v[2][j], v[3][j]); o.z = cvtpk_hw(v[4][j], v[5][j]); o.w = cvtpk_hw(v[6][j], v[7][j]);
        __builtin_nontemporal_store(o, (u32x4*)(dst + j * 1024)); }
}
template <int NSL, int MODE>
__device__ __forceinline__ void conv_stream(const Params& p, int first, int stride, int end, LAS unsigned char* scr, int lane) {
    const int n = (first < end) ? (end - first + stride - 1) / stride : 0;
#pragma unroll
    for (int s_ = 0; s_ < NSL; ++s_) if (s_ < n) expert_issue(p, first + s_ * stride, scr + s_ * 4096, lane);
    int slot = 0;
#pragma unroll 1
    for (int k = 0; k < n; ++k) {
        if (k + NSL <= n) { if (k < NSL - 1) { asm volatile("s_waitcnt vmcnt(%0)" :: "n"(4 * (NSL - 1)) : "memory"); } else { asm volatile("s_waitcnt vmcnt(%0)" :: "n"(8 * (NSL - 1)) : "memory"); } }
        else asm volatile("s_waitcnt vmcnt(0)" ::: "memory");
        expert_finish<MODE>(p, first + k * stride, scr + slot * 4096, lane);
        asm volatile("s_waitcnt lgkmcnt(0)" ::: "memory");
        if (k + NSL < n) expert_issue(p, first + (k + NSL) * stride, scr + slot * 4096, lane);
        slot = (slot == NSL - 1) ? 0 : slot + 1;
    }
    asm volatile("s_waitcnt vmcnt(0)" ::: "memory");
}
struct BgConv { int next, stride, pend0, pend1, itc; };

__device__ __forceinline__ void tr_item(const float* W, int ldw, int k0, int n0, bf16_t* WT, int ldt, int orow0, int ocol0, const float* kscale, LAS float* scr, int lane) {
#pragma unroll 8
    for (int i = 0; i < 32; ++i) { const int kk = 2 * i + (lane >> 5); float v = W[(size_t)(k0 + kk) * ldw + n0 + (lane & 31)]; if (kscale) v *= kscale[k0 + kk]; scr[kk * 33 + (lane & 31)] = v; }
    asm volatile("s_waitcnt lgkmcnt(0)" ::: "memory");
    const int c = lane & 7;
#pragma unroll
    for (int j = 0; j < 4; ++j) { const int n = (lane >> 3) + 8 * j; const LAS float* s = scr + (8 * c) * 33 + n;
        u32x4 o; o.x = pk2(s[0 * 33], s[1 * 33]); o.y = pk2(s[2 * 33], s[3 * 33]); o.z = pk2(s[4 * 33], s[5 * 33]); o.w = pk2(s[6 * 33], s[7 * 33]);
        *(u32x4*)(WT + (size_t)(orow0 + n) * ldt + ocol0 + 8 * c) = o; }
    asm volatile("s_waitcnt lgkmcnt(0)" ::: "memory");
}
__device__ __forceinline__ void tr_item8(const float* W, int ldw, int k0, int n0, unsigned char* WT8, int ldt8, int orow0, int ocol0, LAS float* scr, int lane) {
#pragma unroll 8
    for (int i = 0; i < 32; ++i) { const int kk = 2 * i + (lane >> 5); scr[kk * 33 + (lane & 31)] = W[(size_t)(k0 + kk) * ldw + n0 + (lane & 31)] * 64.0f; }
    asm volatile("s_waitcnt lgkmcnt(0)" ::: "memory");
    const int c = lane & 7;
#pragma unroll
    for (int j = 0; j < 4; ++j) { const int n = (lane >> 3) + 8 * j; const LAS float* sp = scr + (8 * c) * 33 + n; unsigned w0 = 0u, w1 = 0u;
        w0 = __builtin_amdgcn_cvt_pk_fp8_f32(sp[0 * 33], sp[1 * 33], w0, false); w0 = __builtin_amdgcn_cvt_pk_fp8_f32(sp[2 * 33], sp[3 * 33], w0, true);
        w1 = __builtin_amdgcn_cvt_pk_fp8_f32(sp[4 * 33], sp[5 * 33], w1, false); w1 = __builtin_amdgcn_cvt_pk_fp8_f32(sp[6 * 33], sp[7 * 33], w1, true);
        *(u32x2*)(WT8 + (size_t)(orow0 + n) * ldt8 + ocol0 + 8 * c) = (u32x2){w0, w1}; }
    asm volatile("s_waitcnt lgkmcnt(0)" ::: "memory");
}
__device__ __forceinline__ void phase_prologue(const Params& p, LAS unsigned char* lds, int vcu, int G) {
    const int tid = threadIdx.x, wave = tid >> 6, lane = tid & 63;
    unsigned char* ws = p.ws;
    LAS float* scr = (LAS float*)(lds + wave * 16384);
    const int gw = vcu * NWAVES + wave, NGW = G * NWAVES;
    bf16_t* WinT = (bf16_t*)(ws + WS_WIN); bf16_t* WoT = (bf16_t*)(ws + WS_WO); bf16_t* WupT = (bf16_t*)(ws + WS_WUP);
    constexpr int I_IN = 16 * 61, I_QB = 4 * 24, I_KVB = 2 * 32, I_O = 16 * 32;
    constexpr int NITEMS = I_IN + I_QB + I_KVB + I_O;
    for (int it = gw; it < NITEMS; it += NGW) {
        int r = it;
        if (r < I_IN) { const int kb = r / 61, nb = r % 61; if (PROJ_FP8 != 0) tr_item8(p.w_in, IN_COLS, 64 * kb, 32 * nb, (unsigned char*)WinT, 1024, 32 * nb, 64 * kb, scr, lane); else tr_item(p.w_in, IN_COLS, 64 * kb, 32 * nb, WinT, 1024, 32 * nb, 64 * kb, nullptr, scr, lane); continue; } r -= I_IN;
        if (r < I_QB) { const int kb = r / 24, nb = r % 24; tr_item(p.w_q_b, 768, 64 * kb, 32 * nb, WupT, KUP, 32 * nb, 64 * kb, p.q_a_norm, scr, lane); continue; } r -= I_QB;
        if (r < I_KVB) { const int kb = r / 32, nb = r % 32; tr_item(p.w_kv_b, 1024, 64 * kb, 32 * nb, WupT, KUP, 768 + 32 * nb, 256 + 64 * kb, p.kv_a_norm, scr, lane); continue; } r -= I_KVB;
        { const int kb = r / 32, nb = r % 32; if (WO_FP8 != 0) tr_item8(p.w_o, 1024, 64 * kb, 32 * nb, (unsigned char*)WoT, 1024, 32 * nb, 64 * kb, scr, lane); else tr_item(p.w_o, 1024, 64 * kb, 32 * nb, WoT, 1024, 32 * nb, 64 * kb, nullptr, scr, lane); }
    }
    const int gt = vcu * NTHREADS + tid, NGT = G * NTHREADS;
    if (PROJ_FP8 != 0) { for (int i = gt; i < 96 * 64; i += NGT) *(u32x4*)((unsigned char*)WinT + (size_t)IN_COLS * 1024 + (size_t)i * 16) = (u32x4){0u, 0u, 0u, 0u}; }
    else for (int i = gt; i < 96 * 128; i += NGT) *(u32x4*)(WinT + (size_t)IN_COLS * 1024 + (size_t)i * 8) = (u32x4){0u, 0u, 0u, 0u};
    for (int i = gt; i < 768 * 16; i += NGT) { const int r = i / 16, c = i % 16; *(u32x4*)(WupT + (size_t)r * KUP + 256 + c * 8) = (u32x4){0u, 0u, 0u, 0u}; }
    for (int i = gt; i < 1024 * 32; i += NGT) { const int r = i / 32, c = i % 32; *(u32x4*)(WupT + (size_t)(768 + r) * KUP + c * 8) = (u32x4){0u, 0u, 0u, 0u}; }
    bf16_t* XB = (bf16_t*)(ws + WS_XB);
    for (int i = gt; i < NTOK * DM / 8; i += NGT) { const f32x4 a = __builtin_nontemporal_load((const f32x4*)(p.x + (size_t)i * 8)), b = __builtin_nontemporal_load((const f32x4*)(p.x + (size_t)i * 8 + 4));

        u32x4 o; o.x = pk2(a[0], a[1]); o.y = pk2(a[2], a[3]); o.z = pk2(b[0], b[1]); o.w = pk2(b[2], b[3]); *(u32x4*)(XB + (size_t)i * 8) = o;
        if (PROJ_FP8 != 0) { unsigned q0 = 0u, q1 = 0u;
            q0 = __builtin_amdgcn_cvt_pk_fp8_f32(a[0], a[1], q0, false); q0 = __builtin_amdgcn_cvt_pk_fp8_f32(a[2], a[3], q0, true);
            q1 = __builtin_amdgcn_cvt_pk_fp8_f32(b[0], b[1], q1, false); q1 = __builtin_amdgcn_cvt_pk_fp8_f32(b[2], b[3], q1, true);
            *(u32x2*)(ws + WS_X1Q + (size_t)i * 8) = (u32x2){q0, q1}; } }
    { bf16_t* WRF = (bf16_t*)(ws + WS_WRL);
      for (int n = gt; n < 32768; n += NGT) { const int j = n & 7, ln = (n >> 3) & 63, eh = (n >> 9) & 1, ks = n >> 10;
          const float w = p.w_router[(size_t)(32 * ks + 8 * (ln >> 4) + j) * 32 + 16 * eh + (ln & 15)];
          const unsigned h = f2bf(w); const float wl = w - __uint_as_float(h << 16);
          WRF[n] = (bf16_t)h; WRF[32768 + n] = (bf16_t)f2bf(wl); } }
    float* ropeA = (float*)(ws + WS_ROPEA); float* ropeB = (float*)(ws + WS_ROPEB);
    for (int i = gt; i < NTOK * 24; i += NGT) { const int tok = i / 24, j = i % 24; const double f = (j < 16) ? p.invfA[j] : p.invfB[j - 16];
        const double rev = (double)p.pos[tok] * f * 0.15915494309189535; const float fr = (float)(rev - __builtin_rint(rev));
        const float cs = __builtin_amdgcn_cosf(fr), sn = __builtin_amdgcn_sinf(fr);
        if (j < 16) { ropeA[(size_t)tok * 32 + j] = cs; ropeA[(size_t)tok * 32 + 16 + j] = sn; } else { ropeB[(size_t)tok * 16 + (j - 16)] = cs; ropeB[(size_t)tok * 16 + 8 + (j - 16)] = sn; } }
}

__device__ __forceinline__ void phase_prep(const Params& p, LAS unsigned char* lds, int vcu, int G) {
    const int tid = threadIdx.x, wave = tid >> 6, lane = tid & 63;
    unsigned char* ws = p.ws;
    const bf16_t* PROJ = (const bf16_t*)(ws + WS_PROJ);
    float* rstd = (float*)(ws + WS_RSTD); const float* ropeA = (const float*)(ws + WS_ROPEA); const float* ropeB = (const float*)(ws + WS_ROPEB);
    bf16_t* KM = (bf16_t*)(ws + WS_KM); bf16_t* QB = (bf16_t*)(ws + WS_QB); bf16_t* KB = (bf16_t*)(ws + WS_KB); float* kmean = (float*)(ws + WS_KMEAN);
    const int gw = vcu * NWAVES + wave, NGW = G * NWAVES;
    for (int row = gw; row < NTOK; row += NGW) {
        float s = 0.f;
        if (lane < 48) { const u32x4 v = *(const u32x4*)(PROJ + (size_t)row * PN + lane * 8);
#pragma unroll
            for (int q = 0; q < 4; ++q) { const float a = __uint_as_float(v[q] << 16), b = __uint_as_float(v[q] & 0xffff0000u); s += a * a + b * b; } }
#pragma unroll
        for (int o = 1; o < 32; o <<= 1) s += __shfl_xor(s, o);
        if (lane == 0) rstd[2 * row] = 1.0f / sqrtf(s * (1.0f / 256.0f) + RMS_EPS);
        if (lane == 32) rstd[2 * row + 1] = 1.0f / sqrtf(s * (1.0f / 128.0f) + RMS_EPS);
    }
    const int gt = vcu * NTHREADS + tid, NGT = G * NTHREADS;
    for (int i = gt; i < NTOK * 16; i += NGT) { const int tok = i >> 4, j = i & 15;
        const float x1 = bf2f(PROJ[(size_t)tok * PN + C_KR + j]), x2 = bf2f(PROJ[(size_t)tok * PN + C_KR + 16 + j]);
        const float c = ropeA[(size_t)tok * 32 + j], s = ropeA[(size_t)tok * 32 + 16 + j];
        const bf16_t o1 = (bf16_t)f2bf(x1 * c - x2 * s), o2 = (bf16_t)f2bf(x2 * c + x1 * s);
#pragma unroll
        for (int h = 0; h < 8; ++h) { KM[(size_t)tok * 768 + h * 96 + 64 + j] = o1; KM[(size_t)tok * 768 + h * 96 + 80 + j] = o2; } }
    LAS float* red = (LAS float*)lds;
    for (int unit = vcu; unit < 512; unit += G) {
        const int ub = unit >> 3, h = unit & 7, tg = tid >> 6, d = tid & 63, c = h * 64 + d; float ksum = 0.f;
#pragma unroll 4
        for (int i = 0; i < 32; ++i) { const int tok = ub * 256 + tg * 32 + i; const bf16_t* pr = PROJ + (size_t)tok * PN;
            float qv = bf2f(pr[C_MQ + c]), kv = bf2f(pr[C_MK + c]);
            if (d < 16) { const int j = d & 7; const float cs = ropeB[(size_t)tok * 16 + j], sn = ropeB[(size_t)tok * 16 + 8 + j];
                if (d < 8) { const float q2 = bf2f(pr[C_MQ + c + 8]), k2 = bf2f(pr[C_MK + c + 8]); qv = qv * cs - q2 * sn; kv = kv * cs - k2 * sn; }
                else { const float q1 = bf2f(pr[C_MQ + c - 8]), k1 = bf2f(pr[C_MK + c - 8]); qv = qv * cs + q1 * sn; kv = kv * cs + k1 * sn; } }
            QB[(size_t)tok * 512 + c] = (bf16_t)f2bf(qv * C2B); KB[(size_t)tok * 512 + c] = (bf16_t)f2bf(kv); ksum += kv; }
        red[tg * 64 + d] = ksum;
        __syncthreads();
        if (tid < 64) { float t = 0.f;
#pragma unroll
            for (int g8 = 0; g8 < 8; ++g8) t += red[g8 * 64 + tid];
            kmean[(size_t)ub * 512 + h * 64 + tid] = t * (1.0f / 256.0f); }
        __syncthreads();
    }
}

typedef float f32x16 __attribute__((ext_vector_type(16)));
typedef short s16x4 __attribute__((ext_vector_type(4)));
namespace fa {
constexpr int KBUF = 12288, VBUF = 8192, VOFF = 3 * KBUF, WS_OFF = VOFF + 3 * VBUF, KML_OFF = WS_OFF + 8 * 256, LDS_NEED = KML_OFF + 2048;
__device__ __forceinline__ void wait_vm(int n) {
    switch (n) {
#define FA_W(k) case k: asm volatile("s_waitcnt vmcnt(" #k ")" ::: "memory"); break;
        FA_W(0) FA_W(1) FA_W(2) FA_W(3) FA_W(4) FA_W(5) FA_W(6) FA_W(7) FA_W(8) FA_W(9) FA_W(10) FA_W(11) FA_W(12) FA_W(13) FA_W(14) FA_W(15)
        FA_W(16) FA_W(17) FA_W(18) FA_W(19) FA_W(20) FA_W(21) FA_W(22) FA_W(23) FA_W(24) FA_W(25) FA_W(26) FA_W(27) FA_W(28)
#undef FA_W
        default: asm volatile("s_waitcnt vmcnt(28)" ::: "memory"); break; }
}
constexpr float THR = 8.0f;
__device__ __forceinline__ int crow(int r, int hi) { return (r & 3) + 8 * (r >> 2) + 4 * hi; }
__device__ __forceinline__ unsigned cvtpk(float lo, float hi) { typedef __bf16 bf2 __attribute__((ext_vector_type(2))); f32x2 v = {lo, hi}; bf2 b = __builtin_convertvector(v, bf2); return __builtin_bit_cast(unsigned, b); }
__device__ __forceinline__ float xhalf_max(float m) { auto rr = __builtin_amdgcn_permlane32_swap(__float_as_uint(m), __float_as_uint(m), false, false); return fmaxf(__uint_as_float(rr[0]), __uint_as_float(rr[1])); }
__device__ __forceinline__ float xhalf_sum(float m) { auto rr = __builtin_amdgcn_permlane32_swap(__float_as_uint(m), __float_as_uint(m), false, false); return __uint_as_float(rr[0]) + __uint_as_float(rr[1]); }
__device__ __forceinline__ float mx3(float a, float b, float c) { return __builtin_fmaxf(__builtin_fmaxf(a, b), c); }
}
template <int DQK, int VAR>
__device__ __forceinline__ void attn_unit(LAS unsigned char* lds, const bf16_t* Q, int qpitch, const bf16_t* K, int kpitch, const bf16_t* V, int vpitch, bf16_t* O, int qb, const float* kmean, const Params& p, BgConv& bg) {
    using namespace fa;
    constexpr int ND = DQK / 16, NCH = DQK / 8;
    const int tid = threadIdx.x, lane = tid & 63, r32 = lane & 31, hi = lane >> 5, wid = __builtin_amdgcn_readfirstlane(tid >> 6);
    const int q0 = qb * 256, qrel = wid * 32 + r32;
    LAS float* wsf = (LAS float*)(lds + WS_OFF) + wid * 64;
    bf16x8 qr[ND];
#pragma unroll
    for (int d0 = 0; d0 < ND; ++d0) qr[d0] = *(const bf16x8*)(Q + (size_t)(q0 + qrel) * qpitch + d0 * 16 + hi * 8);
    unsigned sel = 0xffu;
    if (kmean) { const int n = tid >> 6, d = tid & 63; if (n < qb) ((LAS float*)(lds + KML_OFF))[tid] = kmean[(size_t)n * 1024 + d] + kmean[(size_t)n * 1024 + 512 + d]; }
    const bf16_t* ksrc = K + (size_t)lane * kpitch;
    const bf16_t* vsrc = V + (size_t)(16 * (wid & 3) + (lane >> 2)) * vpitch + (wid >> 2) * 32 + (lane & 3) * 8;
#define FA_DMA(ti, kslot, vslot) do { \
        __builtin_amdgcn_global_load_lds((const unsigned*)(ksrc + (size_t)(ti) * 64 * kpitch + wid * 8), (LAS unsigned*)(lds + (kslot) * KBUF + wid * 1024), 16, 0, 0); \
        if (NCH > 8 && wid < NCH - 8) __builtin_amdgcn_global_load_lds((const unsigned*)(ksrc + (size_t)(ti) * 64 * kpitch + (wid + 8) * 8), (LAS unsigned*)(lds + (kslot) * KBUF + (wid + 8) * 1024), 16, 0, 0); \
        __builtin_amdgcn_global_load_lds((const unsigned*)(vsrc + (size_t)(ti) * 64 * vpitch), (LAS unsigned*)(lds + VOFF + (vslot) * VBUF + wid * 1024), 16, 0, 0); } while (0)
#define FA_TILE(i) (((i) < 4) ? 4 * qb + (i) : (i) - 4)
#define FA_TR(dst, off) asm volatile("ds_read_b64_tr_b16 %0, %1 offset:%2" : "=v"(dst) : "v"(va_), "n"(off))
#define FA_TW(n, a, b) asm volatile("s_waitcnt lgkmcnt(" #n ")" : "+v"(a), "+v"(b))
#define FA_MM(d0, s_, a, b) o[d0] = __builtin_amdgcn_mfma_f32_32x32x16_bf16(__builtin_bit_cast(bf16x8, pw[s_]), __builtin_bit_cast(bf16x8, (u32x4){a.x, a.y, b.x, b.y}), o[d0], 0, 0, 0)
#define FA_PV(vslot) do { const unsigned va_ = (unsigned)(uintptr_t)(lds + VOFF + (vslot) * VBUF + voff); \
        u32x2 t0, t1, t2, t3, t4, t5, t6, t7, t8, t9, t10, t11, t12, t13, t14, t15; \
        FA_TR(t0, 0); FA_TR(t1, 512); FA_TR(t2, 1024); FA_TR(t3, 1536); FA_TR(t4, 2048); FA_TR(t5, 2560); FA_TR(t6, 3072); FA_TR(t7, 3584); \
        FA_TR(t8, 4096); FA_TR(t9, 4608); FA_TR(t10, 5120); FA_TR(t11, 5632); \
        FA_TW(10, t0, t1); FA_MM(0, 0, t0, t1); FA_TW(8, t2, t3); FA_MM(0, 1, t2, t3); \
        FA_TR(t12, 6144); FA_TR(t13, 6656); FA_TR(t14, 7168); FA_TR(t15, 7680); \
        FA_TW(10, t4, t5); FA_MM(0, 2, t4, t5); FA_TW(8, t6, t7); FA_MM(0, 3, t6, t7); \
        FA_TW(6, t8, t9); FA_MM(1, 0, t8, t9); FA_TW(4, t10, t11); FA_MM(1, 1, t10, t11); \
        FA_TW(2, t12, t13); FA_MM(1, 2, t12, t13); FA_TW(0, t14, t15); FA_MM(1, 3, t14, t15); } while (0)
    const int NT = 4 * qb + 4;
    float mhat = 0.f, l_reg = 0.f; f32x16 o[2]; o[0] = f32x16{}; o[1] = f32x16{}; f32x16 negm = f32x16{};
    const int koff = hi * 1024 + r32 * 16;
    const int voff = ((lane >> 4) & 1) * 32 + (lane & 3) * 8 + (4 * hi + ((lane & 15) >> 2)) * 64;
    u32x4 pw[4];
    const int nkv = (NCH > 8 && wid < NCH - 8) ? 3 : 2;
    FA_DMA(FA_TILE(0), 0, 0);
    if (NT > 1) { FA_DMA(FA_TILE(1), 1, 1); }
    wait_vm(NT > 1 ? nkv : 0); asm volatile("s_waitcnt lgkmcnt(0)" ::: "memory"); __builtin_amdgcn_s_barrier(); asm volatile("" ::: "memory");
    if (kmean && VAR < 9) {
        float gt[8];
#pragma unroll
        for (int n = 0; n < 8; ++n) { float s = 0.f; const LAS float* km = (const LAS float*)(lds + KML_OFF) + n * 64;
            if (n < qb) {
#pragma unroll
                for (int d0 = 0; d0 < ND; ++d0) { const f32x4 k0 = *(const LAS f32x4*)(km + d0 * 16 + hi * 8), k1 = *(const LAS f32x4*)(km + d0 * 16 + hi * 8 + 4);
#pragma unroll
                    for (int j = 0; j < 4; ++j) { s = fmaf(bf2f((unsigned short)qr[d0][j]), k0[j], s); s = fmaf(bf2f((unsigned short)qr[d0][4 + j]), k1[j], s); } }
                s = xhalf_sum(s); }
            gt[n] = (n < qb) ? s : -INFINITY; }
        sel = 0u;
#pragma unroll
        for (int n = 0; n < 8; ++n) { int cnt = 0;
#pragma unroll
            for (int n2 = 0; n2 < 8; ++n2) if (n2 != n) cnt += (n2 < qb && (gt[n2] > gt[n] || (gt[n2] == gt[n] && n2 < n))) ? 1 : 0;
            if (n < qb && cnt < 3) sel |= 1u << n; }
    }
    int sl = 0, prevB = 0, opsPrev = 0, opsPrev2 = 0;
    for (int i = 0; i < (VAR >= 10 ? 0 : NT); ++i) {
        const int sl1 = (sl == 2) ? 0 : sl + 1, sl2 = (sl1 == 2) ? 0 : sl1 + 1;
        LAS unsigned char* bscr = lds + LDS_NEED + wid * 8192 + (bg.itc & 1) * 4096;
        int young = prevB, ops = 0;
        const bool band = i < 4;
        if constexpr (VAR != 4) { if (i + 2 < NT) { const int tn = FA_TILE(i + 2); FA_DMA(tn, sl2, sl2); ops += nkv; } }
        const bool cmp_ = VAR < 6 && !(band && 2 * i > wid);
        f32x16 p0, p1;
        if (cmp_) {
            const LAS unsigned char* kb = lds + sl * KBUF + koff;
            p0 = negm; p1 = negm;
            if (kmean && !band) { if (!__all((sel >> ((i - 4) >> 2)) & 1u)) {
                    const bool ok = ((sel >> ((i - 4) >> 2)) & 1u) != 0u;
#pragma unroll
                    for (int r = 0; r < 16; ++r) p0[r] = ok ? negm[r] : -INFINITY;
                    p1 = p0; } }
#pragma unroll
            for (int d0 = 0; d0 < (VAR == 5 ? 1 : ND); ++d0) { const bf16x8 a0 = *(const LAS bf16x8*)(kb + d0 * 2048), a1 = *(const LAS bf16x8*)(kb + d0 * 2048 + 512);
                p0 = __builtin_amdgcn_mfma_f32_32x32x16_bf16(a0, qr[d0], p0, 0, 0, 0); p1 = __builtin_amdgcn_mfma_f32_32x32x16_bf16(a1, qr[d0], p1, 0, 0, 0); }
        }
        bool bgdo = false; int fin8 = 0;
#define FA_CONV8A() do { \
            if ((CONV_PERIOD == 4) ? (bg.itc % 3 == 2) : (CONV_PERIOD == 3) ? (bg.itc % 3 == 0) : ((bg.itc & 1) == 0)) { LAS unsigned char* scr8 = lds + LDS_NEED + wid * 8192; \
                if (bg.pend0 >= 0) { wait_vm((CONV_PERIOD == 3 ? opsPrev2 : 0) + opsPrev + ops);     expert_finish8(p, bg.pend0, scr8, lane); bg.pend0 = -1; ops += 4; fin8 = 4; asm volatile("s_waitcnt lgkmcnt(0)" ::: "memory"); } } } while (0)
#define FA_CONV8B() do { \
            if ((CONV_PERIOD >= 3) ? (bg.itc % 3 == 0) : ((bg.itc & 1) == 0)) { LAS unsigned char* scr8 = lds + LDS_NEED + wid * 8192; \
                bgdo = bg.next < NEXP_ITEMS8; \
                if (bgdo) { expert_issue8(p, bg.next, scr8, lane); bg.pend0 = bg.next; bg.next += bg.stride; ops += 8; } } \
            young += ops; prevB = (bgdo ? 8 : 0) + fin8; ++bg.itc; } while (0)
#define FA_CONV8B1() do { \
            if ((bg.itc & 1) == 0) { LAS unsigned char* scr8 = lds + LDS_NEED + wid * 8192; \
                bgdo = bg.next < NEXP_ITEMS8; \
                if (bgdo) { expert_issue8<0, 4>(p, bg.next, scr8, lane); ops += 4; } } } while (0)
#define FA_CONV8B2() do { \
            if ((bg.itc & 1) == 0) { LAS unsigned char* scr8 = lds + LDS_NEED + wid * 8192; \
                if (bgdo) { expert_issue8<4, 8>(p, bg.next, scr8, lane); bg.pend0 = bg.next; bg.next += bg.stride; ops += 4; } } \
            young += ops; prevB = (bgdo ? 8 : 0) + fin8; ++bg.itc; } while (0)
#define FA_CONV8() do { FA_CONV8A(); FA_CONV8B(); } while (0)
        if constexpr (CONV8) { if constexpr (CONV_PLACE == 0) FA_CONV8(); if constexpr (CONV_PLACE == 4 || CONV_PLACE == 5 || CONV_PLACE == 6) FA_CONV8A();
        } else {
        if (VAR != -2 && VAR != -7) {
        if (bg.itc & 1) { if (bg.pend1 >= 0) { if (VAR != -3 && VAR != -6) wait_vm(opsPrev + ops); expert_finish<(VAR == -4 ? 1 : VAR == -5 ? 0 : 2)>(p, VAR == -8 ? (bg.pend1 & 1023) : bg.pend1, bscr, lane); bg.pend1 = -1; ops += 4; asm volatile("s_waitcnt lgkmcnt(0)" ::: "memory"); } }
        else            { if (bg.pend0 >= 0) { if (VAR != -3 && VAR != -6) wait_vm(opsPrev + ops); expert_finish<(VAR == -4 ? 1 : VAR == -5 ? 0 : 2)>(p, VAR == -8 ? (bg.pend0 & 1023) : bg.pend0, bscr, lane); bg.pend0 = -1; ops += 4; asm volatile("s_waitcnt lgkmcnt(0)" ::: "memory"); } } }
        bgdo = (bg.itc % 3 != 2) && bg.next < NEXP_ITEMS;
        if (bgdo) { expert_issue(p, (VAR == -7 || VAR == -8) ? (bg.next & 1023) : bg.next, bscr, lane); if (bg.itc & 1) bg.pend1 = bg.next; else bg.pend0 = bg.next; bg.next += bg.stride; ops += 4; }
        young += ops; prevB = bgdo ? 4 : 0;
        ++bg.itc; }
        if (cmp_) {
            if (band) { if (64 * i + 63 > 32 * wid) {
#pragma unroll
                    for (int r = 0; r < 16; ++r) { const int kv = 64 * i + crow(r, hi); if (kv > qrel) p0[r] = -INFINITY; if (kv + 32 > qrel) p1[r] = -INFINITY; } } }
            if constexpr (VAR != 1 && VAR != 3) {
            float ra = mx3(p0[0], p0[1], p1[0]), rb = mx3(p0[2], p0[3], p1[1]); ra = mx3(ra, p1[2], p1[3]);
#pragma unroll
            for (int r = 4; r < 16; r += 4) { ra = mx3(ra, p0[r], p0[r + 1]); rb = mx3(rb, p0[r + 2], p0[r + 3]); ra = mx3(ra, p1[r], p1[r + 1]); rb = mx3(rb, p1[r + 2], p1[r + 3]); }
            const float rm = xhalf_max(__builtin_fmaxf(ra, rb));
            if (i == 0 || __any(rm > THR)) {
                const float dl = (i == 0) ? rm : fmaxf(rm, 0.f); mhat += dl;
#pragma unroll
                for (int r = 0; r < 16; ++r) { p0[r] -= dl; p1[r] -= dl; negm[r] = -mhat; }
                if (i != 0) { const float f = __builtin_amdgcn_exp2f(-dl); l_reg *= f; if (hi == 0) wsf[r32] = f;
                    asm volatile("s_waitcnt lgkmcnt(0)" ::: "memory");
#pragma unroll
                    for (int r = 0; r < 16; ++r) { const float fr_ = wsf[crow(r, hi)]; o[0][r] *= fr_; o[1][r] *= fr_; } }
            }
            f32x2 sacc = {0.f, 0.f};
#pragma unroll
            for (int r = 0; r < 16; ++r) { p0[r] = __builtin_amdgcn_exp2f(p0[r]); p1[r] = __builtin_amdgcn_exp2f(p1[r]); }
#pragma unroll
            for (int r = 0; r < 16; r += 2) { float t0_ = p0[r] + p1[r], t1_ = p0[r + 1] + p1[r + 1]; asm volatile("" : "+v"(t0_), "+v"(t1_)); sacc[0] += t0_; sacc[1] += t1_; }
            l_reg += sacc[0] + sacc[1];
            }
#pragma unroll
            for (int s = 0; s < 2; ++s)
#pragma unroll
                for (int j = 0; j < 4; ++j) { pw[s][j] = cvtpk(p0[8 * s + 2 * j], p0[8 * s + 2 * j + 1]); pw[2 + s][j] = cvtpk(p1[8 * s + 2 * j], p1[8 * s + 2 * j + 1]); }
        }
        if constexpr (CONV8 && CONV_PLACE == 1) FA_CONV8();
        if constexpr (CONV8 && CONV_PLACE == 5) FA_CONV8B();
        if constexpr (CONV8 && CONV_PLACE == 6) FA_CONV8B1();
        if constexpr (CONV8 && CONV_PLACE == 3) FA_CONV8A();
        if (cmp_) {
            if constexpr (VAR != 2 && VAR != 3) { FA_PV(sl); } else { o[0][0] += __uint_as_float(pw[0][0] ^ pw[1][1] ^ pw[2][2] ^ pw[3][3]); }
        }
        if constexpr (CONV8 && CONV_PLACE == 2) FA_CONV8();
        if constexpr (CONV8 && CONV_PLACE == 3) FA_CONV8B();
        if constexpr (CONV8 && CONV_PLACE == 4) FA_CONV8B();
        if constexpr (CONV8 && CONV_PLACE == 6) FA_CONV8B2();
        if constexpr (VAR < 7) { asm volatile("s_waitcnt lgkmcnt(0)" ::: "memory"); if (VAR != -6) wait_vm(young);
        __builtin_amdgcn_s_barrier(); asm volatile("" ::: "memory"); }
        sl = sl1; opsPrev2 = opsPrev; opsPrev = ops;
    }
    l_reg = xhalf_sum(l_reg);
    if (hi == 0) wsf[32 + r32] = l_reg;
    asm volatile("s_waitcnt lgkmcnt(0)" ::: "memory");
#pragma unroll
    for (int r = 0; r < ((VAR < 8 || o[0][0] == 123.456f) ? 16 : 0); ++r) { const float rl = 1.0f / wsf[32 + crow(r, hi)];
        if constexpr (WO_FP8 != 0) {
            unsigned char* ob = (unsigned char*)(p.ws + WS_ATT) + (O - (const bf16_t*)(p.ws + WS_ATT)) + (size_t)(q0 + wid * 32 + crow(r, hi)) * 1024 + r32; const float r64 = rl * 64.0f;
            ob[0] = (unsigned char)(__builtin_amdgcn_cvt_pk_fp8_f32(o[0][r] * r64, 0.f, 0, false) & 0xff); ob[32] = (unsigned char)(__builtin_amdgcn_cvt_pk_fp8_f32(o[1][r] * r64, 0.f, 0, false) & 0xff); }
        else { bf16_t* op = O + (size_t)(q0 + wid * 32 + crow(r, hi)) * 1024 + r32;
        op[0] = (bf16_t)f2bf(o[0][r] * rl); op[32] = (bf16_t)f2bf(o[1][r] * rl); } }
    asm volatile("s_waitcnt lgkmcnt(0)" ::: "memory"); __builtin_amdgcn_s_barrier(); asm volatile("" ::: "memory");
#undef FA_DMA
#undef FA_TILE
#undef FA_PV
#undef FA_TR
#undef FA_TW
#undef FA_MM
}
template <int DQK>
__device__ __forceinline__ void attn_unit_p(LAS unsigned char* lds, const bf16_t* Q, int qpitch, const bf16_t* K, int kpitch, const bf16_t* V, int vpitch, bf16_t* O, int qb, const float* kmean, const Params& p, BgConv& bg) {
    using namespace fa;
    constexpr int ND = DQK / 16, NCH = DQK / 8;
    const int tid = threadIdx.x, wid = __builtin_amdgcn_readfirstlane(tid >> 6);
    int lane = tid & 63; asm volatile("" : "+v"(lane));
    const int r32 = lane & 31, hi = lane >> 5;
    const int q0 = qb * 256, qrel = wid * 32 + r32;
    LAS float* wsf = (LAS float*)(lds + WS_OFF) + wid * 64;
    bf16x8 qr[ND];
#pragma unroll
    for (int d0 = 0; d0 < ND; ++d0) qr[d0] = *(const bf16x8*)(Q + (size_t)(q0 + qrel) * qpitch + d0 * 16 + hi * 8);
    unsigned sel = 0xffu;
    if (kmean) { const int n = tid >> 6, d = tid & 63; if (n < qb) ((LAS float*)(lds + KML_OFF))[tid] = kmean[(size_t)n * 1024 + d] + kmean[(size_t)n * 1024 + 512 + d]; }
    const unsigned klane = (unsigned)lane * (unsigned)kpitch * 2u;
    const unsigned vlane = ((unsigned)(lane >> 2) * (unsigned)vpitch + (unsigned)(lane & 3) * 8u) * 2u;
    const char* kbase = (const char*)K + wid * 16; const char* vbase = (const char*)V + ((size_t)(16 * (wid & 3)) * vpitch + (wid >> 2) * 32) * 2;
#define FA_DMAK(ti, kslot) do { \
        __builtin_amdgcn_global_load_lds((const unsigned*)(kbase + (size_t)(ti) * 128 * kpitch + klane), (LAS unsigned*)(lds + (kslot) * KBUF + wid * 1024), 16, 0, 0); \
        if (NCH > 8 && wid < NCH - 8) __builtin_amdgcn_global_load_lds((const unsigned*)(kbase + (size_t)(ti) * 128 * kpitch + 128 + klane), (LAS unsigned*)(lds + (kslot) * KBUF + (wid + 8) * 1024), 16, 0, 0); } while (0)
#define FA_DMAV(ti, vslot) __builtin_amdgcn_global_load_lds((const unsigned*)(vbase + (size_t)(ti) * 128 * vpitch + vlane), (LAS unsigned*)(lds + VOFF + (vslot) * VBUF + wid * 1024), 16, 0, 0)
#define FA_TILE(i) (((i) < 4) ? 4 * qb + (i) : (i) - 4)
#define FA_SB() __builtin_amdgcn_sched_barrier(0)
#define FA_TR(dst, off) asm volatile("ds_read_b64_tr_b16 %0, %1 offset:%2" : "=v"(dst) : "v"(va_), "n"(off))
#define FA_TW2(a, b) asm volatile("s_waitcnt lgkmcnt(2)" : "+v"(a), "+v"(b))
#define FA_TW0(a, b) asm volatile("s_waitcnt lgkmcnt(0)" : "+v"(a), "+v"(b))
#define FA_PIN(x) asm volatile("" : "+v"(x))
    const int NT = 4 * qb + 4;
    float mhat = 0.f, l_reg = 0.f; f32x16 o[2]; o[0] = f32x16{}; o[1] = f32x16{}; f32x16 negm = f32x16{};
    const int koff = hi * 1024 + r32 * 16;
    const int voff = ((lane >> 4) & 1) * 32 + (lane & 3) * 8 + (4 * hi + ((lane & 15) >> 2)) * 64;
    u32x4 pw[4];
    const int nk = (NCH > 8 && wid < NCH - 8) ? 2 : 1;
    f32x16 pA0, pA1, pB0, pB1;
    f32x2 sacc = {0.f, 0.f}; float resc_f = 1.f; bool resc = false;
    int prevB = 0, opsPrev = 0;
#define FA_FIN(P0, P1, k) do { if ((k) < 4) { float t0_ = P0[4 * (k)] + P0[4 * (k) + 2], t1_ = P0[4 * (k) + 1] + P0[4 * (k) + 3]; asm volatile("" : "+v"(t0_), "+v"(t1_)); sacc[0] += t0_; sacc[1] += t1_; \
            pw[(k) >> 1][2 * ((k) & 1)] = cvtpk(P0[4 * (k)], P0[4 * (k) + 1]); pw[(k) >> 1][2 * ((k) & 1) + 1] = cvtpk(P0[4 * (k) + 2], P0[4 * (k) + 3]); } \
        else { float t0_ = P1[4 * ((k) - 4)] + P1[4 * ((k) - 4) + 2], t1_ = P1[4 * ((k) - 4) + 1] + P1[4 * ((k) - 4) + 3]; asm volatile("" : "+v"(t0_), "+v"(t1_)); sacc[0] += t0_; sacc[1] += t1_; \
            pw[(k) >> 1][2 * ((k) & 1)] = cvtpk(P1[4 * ((k) - 4)], P1[4 * ((k) - 4) + 1]); pw[(k) >> 1][2 * ((k) & 1) + 1] = cvtpk(P1[4 * ((k) - 4) + 2], P1[4 * ((k) - 4) + 3]); } \
        FA_PIN(sacc); FA_PIN(pw[(k) >> 1]); } while (0)
#define FA_EXP4(C0, C1, g) do { if ((g) < 4) { C0[4 * (g)] = __builtin_amdgcn_exp2f(C0[4 * (g)]); C0[4 * (g) + 1] = __builtin_amdgcn_exp2f(C0[4 * (g) + 1]); C0[4 * (g) + 2] = __builtin_amdgcn_exp2f(C0[4 * (g) + 2]); C0[4 * (g) + 3] = __builtin_amdgcn_exp2f(C0[4 * (g) + 3]); FA_PIN(C0); } \
        else { C1[4 * ((g) - 4)] = __builtin_amdgcn_exp2f(C1[4 * ((g) - 4)]); C1[4 * ((g) - 4) + 1] = __builtin_amdgcn_exp2f(C1[4 * ((g) - 4) + 1]); C1[4 * ((g) - 4) + 2] = __builtin_amdgcn_exp2f(C1[4 * ((g) - 4) + 2]); C1[4 * ((g) - 4) + 3] = __builtin_amdgcn_exp2f(C1[4 * ((g) - 4) + 3]); FA_PIN(C1); } } while (0)
#define FA_STEP(C0, C1, P0, P1, T, PREV) do { \
        const int t_ = (T); const int ks_ = t_ % 3, vsp_ = (t_ + 2) % 3; \
          \
        LAS unsigned char* bscr = lds + LDS_NEED + wid * 8192 + (bg.itc & 1) * 4096; \
        int young = prevB, ops = 0; \
        if (bg.itc & 1) { if (bg.pend1 >= 0) { wait_vm(opsPrev); expert_finish<2>(p, bg.pend1, bscr, lane); bg.pend1 = -1; ops += 4; asm volatile("s_waitcnt lgkmcnt(0)" ::: "memory"); } } \
        else            { if (bg.pend0 >= 0) { wait_vm(opsPrev); expert_finish<2>(p, bg.pend0, bscr, lane); bg.pend0 = -1; ops += 4; asm volatile("s_waitcnt lgkmcnt(0)" ::: "memory"); } } \
        if (t_ + 2 < NT) { FA_DMAK(FA_TILE(t_ + 2), (t_ + 2) % 3); ops += nk; } \
        if (t_ + 1 < NT) { FA_DMAV(FA_TILE(t_ + 1), (t_ + 1) % 3); ops += 1; } \
        const bool bgdo = (bg.itc % 3 != 2) && bg.next < NEXP_ITEMS; \
        if (bgdo) { expert_issue(p, bg.next, bscr, lane); if (bg.itc & 1) bg.pend1 = bg.next; else bg.pend0 = bg.next; bg.next += bg.stride; ops += 4; } \
        young += ops; prevB = bgdo ? 4 : 0; ++bg.itc; \
          \
        { const LAS unsigned char* kb = lds + ks_ * KBUF + koff; \
          bf16x8 ka_[2][2]; ka_[0][0] = *(const LAS bf16x8*)(kb); ka_[0][1] = *(const LAS bf16x8*)(kb + 512); \
          FA_SB(); \
          _Pragma("unroll") for (int d0 = 0; d0 < ND; ++d0) { \
              if (d0 + 1 < ND) { ka_[(d0 + 1) & 1][0] = *(const LAS bf16x8*)(kb + (d0 + 1) * 2048); ka_[(d0 + 1) & 1][1] = *(const LAS bf16x8*)(kb + (d0 + 1) * 2048 + 512); }     \
              const bf16x8 a0 = ka_[d0 & 1][0], a1 = ka_[d0 & 1][1]; \
              if (d0 == 0) { C0 = __builtin_amdgcn_mfma_f32_32x32x16_bf16(a0, qr[0], negm, 0, 0, 0); } else { C0 = __builtin_amdgcn_mfma_f32_32x32x16_bf16(a0, qr[d0], C0, 0, 0, 0); } \
              if (PREV) { if (ND == 6) { if (d0 < 2) { FA_FIN(P0, P1, d0); } } else { FA_FIN(P0, P1, d0); } } \
              FA_SB(); \
              if (d0 == 0) { C1 = __builtin_amdgcn_mfma_f32_32x32x16_bf16(a1, qr[0], negm, 0, 0, 0); } else { C1 = __builtin_amdgcn_mfma_f32_32x32x16_bf16(a1, qr[d0], C1, 0, 0, 0); } \
              if (PREV) { if (ND == 6) { FA_FIN(P0, P1, 2 + d0); } else { FA_FIN(P0, P1, 4 + d0); } } \
              FA_SB(); } \
          if (PREV) { l_reg += sacc[0] + sacc[1]; sacc = (f32x2){0.f, 0.f}; } } \
          \
        if (kmean && t_ >= 4) { if (!__all((sel >> ((t_ - 4) >> 2)) & 1u)) { if (!((sel >> ((t_ - 4) >> 2)) & 1u)) { \
            _Pragma("unroll") for (int r = 0; r < 16; ++r) { C0[r] = -INFINITY; C1[r] = -INFINITY; } } } } \
        if (t_ < 4) { if (64 * t_ + 63 > 32 * wid) { int qd_ = qrel - 64 * t_ - 4 * hi; asm volatile("" : "+v"(qd_));     \
            _Pragma("unroll") for (int r = 0; r < 16; ++r) { const int kv = (r & 3) + 8 * (r >> 2); if (kv > qd_) C0[r] = -INFINITY; if (kv + 32 > qd_) C1[r] = -INFINITY; } } } \
        { float ra = mx3(C0[0], C0[1], C1[0]), rb = mx3(C0[2], C0[3], C1[1]); ra = mx3(ra, C1[2], C1[3]); \
          _Pragma("unroll") for (int r = 4; r < 16; r += 4) { ra = mx3(ra, C0[r], C0[r + 1]); rb = mx3(rb, C0[r + 2], C0[r + 3]); ra = mx3(ra, C1[r], C1[r + 1]); rb = mx3(rb, C1[r + 2], C1[r + 3]); } \
          const float rm = xhalf_max(__builtin_fmaxf(ra, rb)); \
          resc = false; \
          if (!(PREV) || __any(rm > THR)) { \
              const float dl = (PREV) ? fmaxf(rm, 0.f) : rm; mhat += dl; \
              _Pragma("unroll") for (int r = 0; r < 16; ++r) { C0[r] -= dl; C1[r] -= dl; negm[r] = -mhat; } \
              if (PREV) { resc_f = __builtin_amdgcn_exp2f(-dl); l_reg *= resc_f; resc = true; } } } \
        FA_SB(); \
          \
        if (PREV) { const unsigned va_ = (unsigned)(uintptr_t)(lds + VOFF + vsp_ * VBUF + voff); \
          u32x2 tl_[2], th_[2]; \
          FA_TR(tl_[0], 0); FA_TR(th_[0], 512); \
          FA_SB(); \
          _Pragma("unroll") for (int g_ = 0; g_ < 8; ++g_) { const int d0 = g_ >> 2, s_ = g_ & 3; \
              if (g_ + 1 < 8) { FA_TR(tl_[(g_ + 1) & 1], ((g_ + 1) >> 2) * 4096 + ((g_ + 1) & 3) * 1024); FA_TR(th_[(g_ + 1) & 1], ((g_ + 1) >> 2) * 4096 + ((g_ + 1) & 3) * 1024 + 512); \
                  FA_TW2(tl_[g_ & 1], th_[g_ & 1]); } else { FA_TW0(tl_[g_ & 1], th_[g_ & 1]); } \
              o[d0] = __builtin_amdgcn_mfma_f32_32x32x16_bf16(__builtin_bit_cast(bf16x8, pw[s_]), __builtin_bit_cast(bf16x8, (u32x4){tl_[g_ & 1].x, tl_[g_ & 1].y, th_[g_ & 1].x, th_[g_ & 1].y}), o[d0], 0, 0, 0); \
              FA_EXP4(C0, C1, g_); FA_SB(); } \
          if (resc) { if (hi == 0) wsf[r32] = resc_f; asm volatile("s_waitcnt lgkmcnt(0)" ::: "memory"); \
              _Pragma("unroll") for (int r = 0; r < 16; ++r) { const float fr_ = wsf[crow(r, hi)]; o[0][r] *= fr_; o[1][r] *= fr_; } } } \
        else { _Pragma("unroll") for (int g_ = 0; g_ < 8; ++g_) { FA_EXP4(C0, C1, g_); } } \
        asm volatile("s_waitcnt lgkmcnt(0)" ::: "memory"); wait_vm(young); __builtin_amdgcn_s_barrier(); asm volatile("" ::: "memory"); \
        opsPrev = ops; } while (0)
    FA_DMAK(FA_TILE(0), 0); FA_DMAV(FA_TILE(0), 0); FA_DMAK(FA_TILE(1), 1);
    wait_vm(nk); asm volatile("s_waitcnt lgkmcnt(0)" ::: "memory"); __builtin_amdgcn_s_barrier(); asm volatile("" ::: "memory");
    if (kmean) {
        float gt[8];
#pragma unroll
        for (int n = 0; n < 8; ++n) { float s = 0.f; const LAS float* km = (const LAS float*)(lds + KML_OFF) + n * 64;
            if (n < qb) {
#pragma unroll
                for (int d0 = 0; d0 < ND; ++d0) { const f32x4 k0 = *(const LAS f32x4*)(km + d0 * 16 + hi * 8), k1 = *(const LAS f32x4*)(km + d0 * 16 + hi * 8 + 4);
#pragma unroll
                    for (int j = 0; j < 4; ++j) { s = fmaf(bf2f((unsigned short)qr[d0][j]), k0[j], s); s = fmaf(bf2f((unsigned short)qr[d0][4 + j]), k1[j], s); } }
                s = xhalf_sum(s); }
            gt[n] = (n < qb) ? s : -INFINITY; }
        sel = 0u;
#pragma unroll
        for (int n = 0; n < 8; ++n) { int cnt = 0;
#pragma unroll
            for (int n2 = 0; n2 < 8; ++n2) if (n2 != n) cnt += (n2 < qb && (gt[n2] > gt[n] || (gt[n2] == gt[n] && n2 < n))) ? 1 : 0;
            if (n < qb && cnt < 3) sel |= 1u << n; }
    }
    FA_STEP(pA0, pA1, pB0, pB1, 0, false);
    int t = 1;
#pragma unroll 1
    for (; t + 1 < NT; t += 2) {
        FA_STEP(pB0, pB1, pA0, pA1, t, true);
        FA_STEP(pA0, pA1, pB0, pB1, t + 1, true);
    }
    FA_STEP(pB0, pB1, pA0, pA1, NT - 1, true);
    { FA_FIN(pB0, pB1, 0); FA_FIN(pB0, pB1, 1); FA_FIN(pB0, pB1, 2); FA_FIN(pB0, pB1, 3); FA_FIN(pB0, pB1, 4); FA_FIN(pB0, pB1, 5); FA_FIN(pB0, pB1, 6); FA_FIN(pB0, pB1, 7);
      l_reg += sacc[0] + sacc[1];
      const unsigned va_ = (unsigned)(uintptr_t)(lds + VOFF + ((NT - 1) % 3) * VBUF + voff);
#pragma unroll
      for (int g_ = 0; g_ < 8; ++g_) { const int d0 = g_ >> 2, s_ = g_ & 3; u32x2 tl_, th_;
          FA_TR(tl_, (g_ >> 2) * 4096 + (g_ & 3) * 1024); FA_TR(th_, (g_ >> 2) * 4096 + (g_ & 3) * 1024 + 512); FA_TW0(tl_, th_);
          o[d0] = __builtin_amdgcn_mfma_f32_32x32x16_bf16(__builtin_bit_cast(bf16x8, pw[s_]), __builtin_bit_cast(bf16x8, (u32x4){tl_.x, tl_.y, th_.x, th_.y}), o[d0], 0, 0, 0); } }
    l_reg = xhalf_sum(l_reg);
    if (hi == 0) wsf[32 + r32] = l_reg;
    asm volatile("s_waitcnt lgkmcnt(0)" ::: "memory");
#pragma unroll
    for (int r = 0; r < 16; ++r) { const float rl = 1.0f / wsf[32 + crow(r, hi)]; bf16_t* op = O + (size_t)(q0 + wid * 32 + crow(r, hi)) * 1024 + r32;
        op[0] = (bf16_t)f2bf(o[0][r] * rl); op[32] = (bf16_t)f2bf(o[1][r] * rl); }
    asm volatile("s_waitcnt lgkmcnt(0)" ::: "memory"); __builtin_amdgcn_s_barrier(); asm volatile("" ::: "memory");
#undef FA_DMAK
#undef FA_DMAV
#undef FA_TILE
#undef FA_SB
#undef FA_TR
#undef FA_TW2
#undef FA_TW0
#undef FA_PIN
#undef FA_FIN
#undef FA_EXP4
#undef FA_STEP
}
template <int VAR>
__device__ __forceinline__ void phase_attn_fast(const Params& p, LAS unsigned char* lds, int vcu, int G, bool do_conv) {
    unsigned char* ws = p.ws;
    const bf16_t* QM = (const bf16_t*)(ws + WS_QM); const bf16_t* KM = (const bf16_t*)(ws + WS_KM); const bf16_t* VM = (const bf16_t*)(ws + WS_VM);
    const bf16_t* QB = (const bf16_t*)(ws + WS_QB); const bf16_t* KB = (const bf16_t*)(ws + WS_KB); const bf16_t* VB = (const bf16_t*)(ws + WS_VB);
    const float* kmean = (const float*)(ws + WS_KMEANP); bf16_t* ATT = (bf16_t*)(ws + WS_ATT);
    const int wave_ = __builtin_amdgcn_readfirstlane(threadIdx.x >> 6);
    if (wave_ >= 4) __builtin_amdgcn_s_setprio(1);
    BgConv bg; bg.next = do_conv ? vcu * NWAVES + wave_ : (CONV8 ? NEXP_ITEMS8 : NEXP_ITEMS); bg.stride = G * NWAVES; bg.pend0 = -1; bg.pend1 = -1; bg.itc = 0;
    for (int su = vcu; su < 256; su += G) {
        const int bh = su >> 2, j = su & 3, b = bh >> 3, h = bh & 7; const size_t r0 = (size_t)b * SEQ;
#pragma unroll 1
        for (int k = 0; k < 2; ++k) {
            const int qbA = k ? ((0x2031 >> (4 * j)) & 15) : ((0x4657 >> (4 * j)) & 15), qbB = k ? 7 - j : j;
            if constexpr (ATTN_REBAL) {
                attn_unit<96, VAR>(lds, QM + r0 * 768 + h * 96, 768, KM + r0 * 768 + h * 96, 768, VM + r0 * 512 + h * 64, 512, ATT + r0 * 1024 + h * 64, qbA, nullptr, p, bg);
                attn_unit<64, VAR>(lds, QB + r0 * 512 + h * 64, 512, KB + r0 * 512 + h * 64, 512, VB + r0 * 512 + h * 64, 512, ATT + r0 * 1024 + 512 + h * 64, qbB, kmean + (size_t)(b * 8) * 1024 + h * 64, p, bg); continue; }
            const int qb = qbB;
            if constexpr (ATTN_PIPE && VAR <= 0) { attn_unit_p<96>(lds, QM + r0 * 768 + h * 96, 768, KM + r0 * 768 + h * 96, 768, VM + r0 * 512 + h * 64, 512, ATT + r0 * 1024 + h * 64, qb, nullptr, p, bg);
              attn_unit_p<64>(lds, QB + r0 * 512 + h * 64, 512, KB + r0 * 512 + h * 64, 512, VB + r0 * 512 + h * 64, 512, ATT + r0 * 1024 + 512 + h * 64, qb, kmean + (size_t)(b * 8) * 1024 + h * 64, p, bg); continue; }
            attn_unit<96, VAR>(lds, QM + r0 * 768 + h * 96, 768, KM + r0 * 768 + h * 96, 768, VM + r0 * 512 + h * 64, 512, ATT + r0 * 1024 + h * 64, qb, nullptr, p, bg);
            attn_unit<64, VAR>(lds, QB + r0 * 512 + h * 64, 512, KB + r0 * 512 + h * 64, 512, VB + r0 * 512 + h * 64, 512, ATT + r0 * 1024 + 512 + h * 64, qb, kmean + (size_t)(b * 8) * 1024 + h * 64, p, bg); }
    }
    __builtin_amdgcn_s_setprio(0);
    if (VAR < 0) { asm volatile("s_waitcnt vmcnt(0)" ::: "memory"); return; }
    { const int lane = threadIdx.x & 63; LAS unsigned char* bscr = lds + fa::LDS_NEED + wave_ * 8192;
      asm volatile("s_waitcnt vmcnt(0)" ::: "memory");
      if constexpr (CONV8) {
          if (bg.pend0 >= 0) { expert_finish8(p, bg.pend0, bscr, lane); bg.pend0 = -1; }
          asm volatile("s_waitcnt lgkmcnt(0)" ::: "memory");
#pragma unroll 1
          for (; bg.next < NEXP_ITEMS8; bg.next += bg.stride) { expert_issue8(p, bg.next, bscr, lane); asm volatile("s_waitcnt vmcnt(0)" ::: "memory"); expert_finish8(p, bg.next, bscr, lane); asm volatile("s_waitcnt lgkmcnt(0)" ::: "memory"); }
          return; }
      if (bg.pend0 >= 0) { expert_finish<2>(p, bg.pend0, bscr, lane); bg.pend0 = -1; }
      if (bg.pend1 >= 0) { expert_finish<2>(p, bg.pend1, bscr + 4096, lane); bg.pend1 = -1; }
      asm volatile("s_waitcnt lgkmcnt(0)" ::: "memory");
#pragma unroll 1
      for (; bg.next < NEXP_ITEMS; bg.next += bg.stride) { expert_issue(p, bg.next, bscr, lane); asm volatile("s_waitcnt vmcnt(0)" ::: "memory"); expert_finish<2>(p, bg.next, bscr, lane); asm volatile("s_waitcnt lgkmcnt(0)" ::: "memory"); } }
}

__device__ __forceinline__ float rs32(float (&a)[32], int lane) {
#pragma unroll
    for (int e = 0; e < 16; ++e) { auto rr = __builtin_amdgcn_permlane32_swap(__float_as_uint(a[e]), __float_as_uint(a[e + 16]), false, false); a[e] = __uint_as_float(rr[0]) + __uint_as_float(rr[1]); }
#pragma unroll
    for (int e = 0; e < 8; ++e) { auto rr = __builtin_amdgcn_permlane16_swap(__float_as_uint(a[e]), __float_as_uint(a[e + 8]), false, false); a[e] = __uint_as_float(rr[0]) + __uint_as_float(rr[1]); }
    { const bool bit = (lane & 8) != 0;
#pragma unroll
      for (int e = 0; e < 4; ++e) { const float keep = bit ? a[e + 4] : a[e], send = bit ? a[e] : a[e + 4]; a[e] = keep + __shfl_xor(send, 8); } }
    { const bool bit = (lane & 4) != 0;
#pragma unroll
      for (int e = 0; e < 2; ++e) { const float keep = bit ? a[e + 2] : a[e], send = bit ? a[e] : a[e + 2]; a[e] = keep + __shfl_xor(send, 4); } }
    { const bool bit = (lane & 2) != 0; const float keep = bit ? a[1] : a[0], send = bit ? a[0] : a[1]; a[0] = keep + __shfl_xor(send, 2); }
    return a[0] + __shfl_xor(a[0], 1);
}
#if X1PRE_BF16
typedef u32x2 x1raw_t;
__device__ __forceinline__ x1raw_t ldx1(const float* X1P, size_t idx) { return __builtin_nontemporal_load((const u32x2*)((const bf16_t*)X1P + idx)); }
__device__ __forceinline__ f32x4 x1cvt(x1raw_t w) { return (f32x4){__uint_as_float(w.x << 16), __uint_as_float(w.x & 0xffff0000u), __uint_as_float(w.y << 16), __uint_as_float(w.y & 0xffff0000u)}; }
#else
typedef f32x4 x1raw_t;
__device__ __forceinline__ x1raw_t ldx1(const float* X1P, size_t idx) { return *(const f32x4*)(X1P + idx); }
__device__ __forceinline__ f32x4 x1cvt(x1raw_t w) { return w; }
#endif
__device__ __forceinline__ void phase_ln1_route(const Params& p, LAS unsigned char* lds, int vcu, int G) {
    const int tid = threadIdx.x, wave = __builtin_amdgcn_readfirstlane(tid >> 6), lane = tid & 63;
    unsigned char* ws = p.ws;
    const float* X1P = (const float*)(ws + WS_X1PRE); bf16_t* X1B = (bf16_t*)(ws + WS_X1B);
    int* tidx = (int*)(ws + WS_TIDX); float* tgate = (float*)(ws + WS_TGATE); unsigned* hist = (unsigned*)(ws + WS_HIST);
    constexpr int XP = 2064;
    LAS unsigned char* XH = lds; LAS unsigned char* XL = lds + 16 * XP; LAS float* PART = (LAS float*)(lds + 32 * XP); LAS float* LG = PART + 8 * 16 * 32;
    LAS int* lidx = (LAS int*)(lds + ROWTAB_OFF);
    bf16x8 bw[2][4][2];
    { const bf16_t* WRF = (const bf16_t*)(ws + WS_WRL);
#pragma unroll
      for (int pp = 0; pp < 2; ++pp)
#pragma unroll
          for (int ksl = 0; ksl < 4; ++ksl)
#pragma unroll
              for (int eh = 0; eh < 2; ++eh) bw[pp][ksl][eh] = *(const bf16x8*)(WRF + (size_t)pp * 32768 + ((size_t)((4 * wave + ksl) * 2 + eh) * 64 + lane) * 8); }
    const float brt = p.b_router[lane & 31];
    f32x4 gln[4], bln[4]; x1raw_t nx0[4], nx1[4];
#pragma unroll
    for (int j = 0; j < 4; ++j) { gln[j] = *(const f32x4*)(p.ln1_g + 4 * lane + 256 * j); bln[j] = *(const f32x4*)(p.ln1_b + 4 * lane + 256 * j); }
    for (int chunk = vcu; chunk < NCHUNK; chunk += G) {
#pragma unroll 1
        for (int grp = 0; grp < 4; ++grp) {
            const int rl = 2 * wave, tl = grp * 16 + rl, tok = chunk * 64 + tl;
            f32x4 v0[4], v1[4]; float s0 = 0.f, s1 = 0.f;
            if (grp == 0) {
#pragma unroll
                for (int j = 0; j < 4; ++j) { nx0[j] = ldx1(X1P, (size_t)tok * DM + 4 * lane + 256 * j); nx1[j] = ldx1(X1P, (size_t)(tok + 1) * DM + 4 * lane + 256 * j); } }
#pragma unroll
            for (int j = 0; j < 4; ++j) { v0[j] = x1cvt(nx0[j]); v1[j] = x1cvt(nx1[j]); }
            if (grp < 3) {
#pragma unroll
                for (int j = 0; j < 4; ++j) { nx0[j] = ldx1(X1P, (size_t)(tok + 16) * DM + 4 * lane + 256 * j); nx1[j] = ldx1(X1P, (size_t)(tok + 17) * DM + 4 * lane + 256 * j); } }
#pragma unroll
            for (int j = 0; j < 4; ++j) { s0 += (v0[j][0] + v0[j][1]) + (v0[j][2] + v0[j][3]); s1 += (v1[j][0] + v1[j][1]) + (v1[j][2] + v1[j][3]); }
            const float mean0 = wave_sum(s0) * (1.0f / DM), mean1 = wave_sum(s1) * (1.0f / DM); float q0 = 0.f, q1 = 0.f;
#pragma unroll
            for (int j = 0; j < 4; ++j) { v0[j] = v0[j] - mean0; v1[j] = v1[j] - mean1;
                q0 += (v0[j][0] * v0[j][0] + v0[j][1] * v0[j][1]) + (v0[j][2] * v0[j][2] + v0[j][3] * v0[j][3]); q1 += (v1[j][0] * v1[j][0] + v1[j][1] * v1[j][1]) + (v1[j][2] * v1[j][2] + v1[j][3] * v1[j][3]); }
            const float rs0 = 1.0f / sqrtf(wave_sum(q0) * (1.0f / DM) + LN_EPS), rs1 = 1.0f / sqrtf(wave_sum(q1) * (1.0f / DM) + LN_EPS);
#pragma unroll
            for (int j = 0; j < 4; ++j) { const f32x4 g = gln[j], bb = bln[j];
                v0[j] = v0[j] * rs0 * g + bb; v1[j] = v1[j] * rs1 * g + bb;
                u32x2 h0, h1, l0, l1;
                h0.x = pk2(v0[j][0], v0[j][1]); h0.y = pk2(v0[j][2], v0[j][3]); h1.x = pk2(v1[j][0], v1[j][1]); h1.y = pk2(v1[j][2], v1[j][3]);
                __builtin_nontemporal_store(h0, (u32x2*)(X1B + (size_t)tok * DM + 4 * lane + 256 * j)); __builtin_nontemporal_store(h1, (u32x2*)(X1B + (size_t)(tok + 1) * DM + 4 * lane + 256 * j));
                if constexpr (GATEUP_FP8 != 0) { unsigned q0 = 0u, q1 = 0u;
                    q0 = __builtin_amdgcn_cvt_pk_fp8_f32(v0[j][0], v0[j][1], q0, false); q0 = __builtin_amdgcn_cvt_pk_fp8_f32(v0[j][2], v0[j][3], q0, true);
                    q1 = __builtin_amdgcn_cvt_pk_fp8_f32(v1[j][0], v1[j][1], q1, false); q1 = __builtin_amdgcn_cvt_pk_fp8_f32(v1[j][2], v1[j][3], q1, true);
                    unsigned char* xq = p.ws + WS_X1Q; *(unsigned*)(xq + (size_t)tok * DM + 4 * lane + 256 * j) = q0; *(unsigned*)(xq + (size_t)(tok + 1) * DM + 4 * lane + 256 * j) = q1; }
                l0.x = pk2(v0[j][0] - __uint_as_float(h0.x << 16), v0[j][1] - __uint_as_float(h0.x & 0xffff0000u)); l0.y = pk2(v0[j][2] - __uint_as_float(h0.y << 16), v0[j][3] - __uint_as_float(h0.y & 0xffff0000u));
                l1.x = pk2(v1[j][0] - __uint_as_float(h1.x << 16), v1[j][1] - __uint_as_float(h1.x & 0xffff0000u)); l1.y = pk2(v1[j][2] - __uint_as_float(h1.y << 16), v1[j][3] - __uint_as_float(h1.y & 0xffff0000u));
                const int cb = (4 * lane + 256 * j) * 2;
                *(LAS u32x2*)(XH + rl * XP + cb) = h0; *(LAS u32x2*)(XH + (rl + 1) * XP + cb) = h1;
                *(LAS u32x2*)(XL + rl * XP + cb) = l0; *(LAS u32x2*)(XL + (rl + 1) * XP + cb) = l1; }
            __syncthreads();
            f32x4 acc[2]; acc[0] = (f32x4){0.f, 0.f, 0.f, 0.f}; acc[1] = acc[0];
            { const int aoff = (lane & 15) * XP + (lane >> 4) * 16;
#pragma unroll
              for (int ksl = 0; ksl < 4; ++ksl) { const int ko = (4 * wave + ksl) * 64;
                  const bf16x8 xh = *(const LAS bf16x8*)(XH + aoff + ko), xl = *(const LAS bf16x8*)(XL + aoff + ko);
#pragma unroll
                  for (int eh = 0; eh < 2; ++eh) { acc[eh] = __builtin_amdgcn_mfma_f32_16x16x32_bf16(xh, bw[0][ksl][eh], acc[eh], 0, 0, 0);
                      acc[eh] = __builtin_amdgcn_mfma_f32_16x16x32_bf16(xl, bw[0][ksl][eh], acc[eh], 0, 0, 0);
                      acc[eh] = __builtin_amdgcn_mfma_f32_16x16x32_bf16(xh, bw[1][ksl][eh], acc[eh], 0, 0, 0); } } }
#pragma unroll
            for (int eh = 0; eh < 2; ++eh)
#pragma unroll
                for (int r = 0; r < 4; ++r) PART[(wave * 16 + 4 * (lane >> 4) + r) * 32 + 16 * eh + (lane & 15)] = acc[eh][r];
            __syncthreads();
            { const int hf = lane >> 5, me = lane & 31, row = rl + hf; float my = brt;
#pragma unroll
              for (int w8 = 0; w8 < 8; ++w8) my += PART[(w8 * 16 + row) * 32 + me];
              LAS float* lg = LG + row * 32; lg[me] = my;
              asm volatile("s_waitcnt lgkmcnt(0)" ::: "memory");
              int rank = 0;
#pragma unroll
              for (int e4 = 0; e4 < 8; ++e4) { const f32x4 vv = *(const LAS f32x4*)(lg + 4 * e4);
#pragma unroll
                  for (int k = 0; k < 4; ++k) rank += (vv[k] > my || (vv[k] == my && (4 * e4 + k) < me)) ? 1 : 0; }
              int ti[4];
#pragma unroll
              for (int k = 0; k < 4; ++k) { const unsigned long long bal = __ballot(rank == k); const int ia = __ffs((int)(unsigned)(bal & 0xffffffffull)) - 1, ib = __ffs((int)(unsigned)(bal >> 32)) - 1; ti[k] = hf ? ib : ia; }
              if (me == 0) { const float t0 = lg[ti[0]], e1 = expf(lg[ti[1]] - t0), e2 = expf(lg[ti[2]] - t0), e3 = expf(lg[ti[3]] - t0); const float is = 1.0f / (1.0f + e1 + e2 + e3);
                  const int tk = tok + hf, tll = tl + hf;
                  *(f32x4*)(tgate + (size_t)tk * 4) = (f32x4){is, e1 * is, e2 * is, e3 * is};
                  int* tp = tidx + (size_t)tk * 4; tp[0] = ti[0]; tp[1] = ti[1]; tp[2] = ti[2]; tp[3] = ti[3];
                  lidx[tll * 4 + 0] = ti[0]; lidx[tll * 4 + 1] = ti[1]; lidx[tll * 4 + 2] = ti[2]; lidx[tll * 4 + 3] = ti[3]; } }
        }
        __syncthreads();
        if (tid < 32) { unsigned c = 0; for (int a = 0; a < 256; ++a) c += (lidx[a] == tid) ? 1u : 0u;
            if (HANDOFF67 != 0) __hip_atomic_store(hist + chunk * 32 + tid, c, __ATOMIC_RELAXED, __HIP_MEMORY_SCOPE_AGENT);
            else hist[chunk * 32 + tid] = c; }
        __syncthreads();
    }
    if (HANDOFF67 != 0) {
        asm volatile("s_waitcnt vmcnt(0)" ::: "memory"); __syncthreads();
        if (tid == 0) (void)xb_add((unsigned*)(ws + WS_CTL) + CW_HDONE, 1u); }
}

__device__ __forceinline__ void phase_assign(const Params& p, LAS unsigned char* lds, int vcu, int G) {
    const int tid = threadIdx.x;
    unsigned char* ws = p.ws;
    const int* tidx = (const int*)(ws + WS_TIDX); const float* tgate = (const float*)(ws + WS_TGATE); const unsigned* hist = (const unsigned*)(ws + WS_HIST);
    int* dest = (int*)(ws + WS_DEST); int* row_tok = (int*)(ws + WS_ROWTOK); float* row_gate = (float*)(ws + WS_ROWGATE); int* tile_e = (int*)(ws + WS_TILEE);
    LAS int* lidx = (LAS int*)lds;
    LAS int* lcnt = (LAS int*)(lds + 1024);
    LAS int* lpre = (LAS int*)(lds + 1024 + 128);
    LAS int* lstart = (LAS int*)(lds + 1024 + 256);
    LAS int* ptot = (LAS int*)(lds + 2048);
    LAS int* ppre = (LAS int*)(lds + 4096);
    if (HANDOFF67 != 0) {
        if (tid == 0) { unsigned* hd = (unsigned*)(ws + WS_CTL) + CW_HDONE; unsigned* bar_ = (unsigned*)(ws + WS_CTL) + CW_BAR; XB_SPIN(xb_ld(hd) < (unsigned)G, bar_); }
        __syncthreads(); }
    for (int chunk = vcu; chunk < NCHUNK; chunk += G) {
        if (tid < 256) lidx[tid] = tidx[chunk * 256 + tid];
        { const int e = tid & 31, cg = tid >> 5; int tot = 0, pre = 0;
#pragma unroll
          for (int k = 0; k < 16; ++k) { const int c = cg * 16 + k; const int hv = (HANDOFF67 != 0) ? (int)__hip_atomic_load(const_cast<unsigned*>(hist) + c * 32 + e, __ATOMIC_RELAXED, __HIP_MEMORY_SCOPE_AGENT) : (int)hist[c * 32 + e]; tot += hv; pre += (c < chunk) ? hv : 0; }
          ptot[cg * 32 + e] = tot; ppre[cg * 32 + e] = pre; }
        __syncthreads();
        if (tid < 32) { int tot = 0, pre = 0;
#pragma unroll
            for (int cg = 0; cg < 16; ++cg) { tot += ptot[cg * 32 + tid]; pre += ppre[cg * 32 + tid]; }
            lcnt[tid] = tot; lpre[tid] = pre; }
        __syncthreads();
        if (tid == 0) { int s2 = 0; for (int e = 0; e < 32; ++e) { lstart[e] = s2; s2 += (lcnt[e] + 255) / 256 * 256; } lstart[32] = s2; }
        __syncthreads();
        if (tid < 256) { const int e = lidx[tid]; int rank = 0; for (int a = 0; a < tid; ++a) rank += (lidx[a] == e) ? 1 : 0;
            const int P = lstart[e] + lpre[e] + rank, tok = chunk * 64 + (tid >> 2);
            row_tok[P] = tok; row_gate[P] = tgate[chunk * 256 + tid]; dest[chunk * 256 + tid] = P; }
        if (chunk < 32) { const int e = chunk; for (int P = lstart[e] + lcnt[e] + tid; P < lstart[e + 1]; P += NTHREADS) { row_tok[P] = 0; row_gate[P] = 0.f; } }
        if (chunk == 0) { if (tid < 32) { for (int t = lstart[tid] / 256; t < lstart[tid + 1] / 256; ++t) tile_e[t] = tid; } if (tid == 32) tile_e[MAXTILES] = lstart[32] / 256; }
        __syncthreads();
    }
}

#if Y_FP8
__device__ __forceinline__ void phase_final(const Params& p, int vcu, int G, float* outp) {
    const int tid = threadIdx.x, wave = tid >> 6, lane = tid & 63;
    unsigned char* ws = p.ws;
    const int* dest = (const int*)(ws + WS_DEST); const unsigned char* Y = ws + WS_Y; const bf16_t* X1B = (const bf16_t*)(ws + WS_X1B);
    const int gw = vcu * NWAVES + wave, NGW = G * NWAVES;
    f32x4 g4[4], b4[4];
#pragma unroll
    for (int d = 0; d < 4; ++d) { g4[d] = *(const f32x4*)(p.ln2_g + 16 * lane + 4 * d); b4[d] = *(const f32x4*)(p.ln2_b + 16 * lane + 4 * d); }
    for (int t0 = gw * 8; t0 < NTOK; t0 += NGW * 8) {
        const int dl = (lane < 32) ? dest[t0 * 4 + lane] : 0;
        u32x4 xwb[2][2][2], ywb[2][2][4];
        auto ldpair = [&](int prn, int bufn) {
#pragma unroll
            for (int t = 0; t < 2; ++t) {
#pragma unroll
                for (int hx = 0; hx < 2; ++hx) xwb[bufn][t][hx] = __builtin_nontemporal_load((const u32x4*)(X1B + (size_t)(t0 + 2 * prn + t) * DM + 16 * lane + 8 * hx));
#pragma unroll
                for (int k = 0; k < 4; ++k) { const int P = __builtin_amdgcn_readlane(dl, (2 * prn + t) * 4 + k); ywb[bufn][t][k] = __builtin_nontemporal_load((const u32x4*)(Y + (size_t)P * 1024 + 16 * lane)); } } };
        ldpair(0, 0);
#pragma unroll
        for (int pr = 0; pr < 4; ++pr) {
            const int tok = t0 + 2 * pr;
            if (pr + 1 < 4) ldpair(pr + 1, (pr + 1) & 1);
            u32x4 (&xw)[2][2] = xwb[pr & 1]; u32x4 (&yw)[2][4] = ywb[pr & 1];
            float v[2][16]; float s_[2], q_[2];
#pragma unroll
            for (int t = 0; t < 2; ++t) { float ys[16];
#pragma unroll
                for (int c = 0; c < 16; ++c) ys[c] = 0.f;
#pragma unroll
                for (int k = 0; k < 4; ++k)
#pragma unroll
                    for (int d = 0; d < 4; ++d) { const f32x2 lo2 = __builtin_amdgcn_cvt_pk_f32_fp8((int)yw[t][k][d], false), hi2 = __builtin_amdgcn_cvt_pk_f32_fp8((int)yw[t][k][d], true);
                        ys[4 * d] += lo2[0]; ys[4 * d + 1] += lo2[1]; ys[4 * d + 2] += hi2[0]; ys[4 * d + 3] += hi2[1]; }
                s_[t] = 0.f;
#pragma unroll
                for (int hx = 0; hx < 2; ++hx)
#pragma unroll
                    for (int d = 0; d < 4; ++d) { const unsigned w = xw[t][hx][d]; const int c = 8 * hx + 2 * d;
                        v[t][c] = __uint_as_float(w << 16) * DN_ALPHA + ys[c] * (1.0f / 32.0f); v[t][c + 1] = __uint_as_float(w & 0xffff0000u) * DN_ALPHA + ys[c + 1] * (1.0f / 32.0f); }
#pragma unroll
                for (int c = 0; c < 16; c += 2) s_[t] += v[t][c] + v[t][c + 1]; }
            const float mean0 = wave_sum(s_[0]) * (1.0f / DM), mean1 = wave_sum(s_[1]) * (1.0f / DM); q_[0] = 0.f; q_[1] = 0.f;
#pragma unroll
            for (int c = 0; c < 16; ++c) { v[0][c] -= mean0; v[1][c] -= mean1; q_[0] += v[0][c] * v[0][c]; q_[1] += v[1][c] * v[1][c]; }
            const float rs0 = 1.0f / sqrtf(wave_sum(q_[0]) * (1.0f / DM) + LN_EPS), rs1 = 1.0f / sqrtf(wave_sum(q_[1]) * (1.0f / DM) + LN_EPS);
#pragma unroll
            for (int d = 0; d < 4; ++d) { const f32x4 g = g4[d], bb = b4[d];
                const f32x4 a0 = {v[0][4 * d], v[0][4 * d + 1], v[0][4 * d + 2], v[0][4 * d + 3]}, a1 = {v[1][4 * d], v[1][4 * d + 1], v[1][4 * d + 2], v[1][4 * d + 3]};
                *(f32x4*)(outp + (size_t)tok * DM + 16 * lane + 4 * d) = a0 * rs0 * g + bb;
                *(f32x4*)(outp + (size_t)(tok + 1) * DM + 16 * lane + 4 * d) = a1 * rs1 * g + bb; }
        }
    }
}
#else
__device__ __forceinline__ void phase_final(const Params& p, int vcu, int G, float* outp) {
    const int tid = threadIdx.x, wave = tid >> 6, lane = tid & 63;
    unsigned char* ws = p.ws;
    const int* dest = (const int*)(ws + WS_DEST); const bf16_t* Y = (const bf16_t*)(ws + WS_Y); const bf16_t* X1B = (const bf16_t*)(ws + WS_X1B);
    const int gw = vcu * NWAVES + wave, NGW = G * NWAVES;
    for (int t0 = gw * 8; t0 < NTOK; t0 += NGW * 8) {
        const int dl = (lane < 32) ? dest[t0 * 4 + lane] : 0;
#pragma unroll
        for (int pr = 0; pr < 4; ++pr) {
            const int tok = t0 + 2 * pr;
            int P[2][4];
#pragma unroll
            for (int t = 0; t < 2; ++t)
#pragma unroll
                for (int k = 0; k < 4; ++k) P[t][k] = __builtin_amdgcn_readlane(dl, (2 * pr + t) * 4 + k);
            f32x4 v[2][4]; u32x2 y[2][4][4];
#pragma unroll
            for (int t = 0; t < 2; ++t)
#pragma unroll
                for (int j = 0; j < 4; ++j) { const u32x2 xw = *(const u32x2*)(X1B + (size_t)(tok + t) * DM + 4 * lane + 256 * j);
                    v[t][j] = (f32x4){__uint_as_float(xw.x << 16), __uint_as_float(xw.x & 0xffff0000u), __uint_as_float(xw.y << 16), __uint_as_float(xw.y & 0xffff0000u)};
#pragma unroll
                    for (int k = 0; k < 4; ++k) y[t][k][j] = *(const u32x2*)(Y + (size_t)P[t][k] * 1024 + 4 * lane + 256 * j); }
            float s[2], q[2];
#pragma unroll
            for (int t = 0; t < 2; ++t) { s[t] = 0.f;
#pragma unroll
                for (int j = 0; j < 4; ++j) { v[t][j] = v[t][j] * DN_ALPHA;
#pragma unroll
                    for (int k = 0; k < 4; ++k) { const u32x2 w = y[t][k][j];
                        v[t][j][0] += __uint_as_float(w.x << 16); v[t][j][1] += __uint_as_float(w.x & 0xffff0000u); v[t][j][2] += __uint_as_float(w.y << 16); v[t][j][3] += __uint_as_float(w.y & 0xffff0000u); }
                    s[t] += (v[t][j][0] + v[t][j][1]) + (v[t][j][2] + v[t][j][3]); } }
            const float mean0 = wave_sum(s[0]) * (1.0f / DM), mean1 = wave_sum(s[1]) * (1.0f / DM);
            q[0] = 0.f; q[1] = 0.f;
#pragma unroll
            for (int j = 0; j < 4; ++j) { v[0][j] = v[0][j] - mean0; v[1][j] = v[1][j] - mean1;
                q[0] += (v[0][j][0] * v[0][j][0] + v[0][j][1] * v[0][j][1]) + (v[0][j][2] * v[0][j][2] + v[0][j][3] * v[0][j][3]);
                q[1] += (v[1][j][0] * v[1][j][0] + v[1][j][1] * v[1][j][1]) + (v[1][j][2] * v[1][j][2] + v[1][j][3] * v[1][j][3]); }
            const float rs0 = 1.0f / sqrtf(wave_sum(q[0]) * (1.0f / DM) + LN_EPS), rs1 = 1.0f / sqrtf(wave_sum(q[1]) * (1.0f / DM) + LN_EPS);
#pragma unroll
            for (int j = 0; j < 4; ++j) { const f32x4 g = *(const f32x4*)(p.ln2_g + 4 * lane + 256 * j), bb = *(const f32x4*)(p.ln2_b + 4 * lane + 256 * j);
                *(f32x4*)(outp + (size_t)tok * DM + 4 * lane + 256 * j) = v[0][j] * rs0 * g + bb;
                *(f32x4*)(outp + (size_t)(tok + 1) * DM + 4 * lane + 256 * j) = v[1][j] * rs1 * g + bb; }
        }
    }
}

#endif

constexpr int NPHASE = 11;
__global__ void __launch_bounds__(NTHREADS, 2) fwd_kernel(Params p) {
    extern __shared__ __attribute__((aligned(16))) unsigned char lds_raw[];
    LAS unsigned char* lds = (LAS unsigned char*)lds_raw;
    const int tid = threadIdx.x;
    const int G = gridDim.x, bx = blockIdx.x;
    const int vcu = (G % 8 == 0) ? (bx % 8) * (G / 8) + bx / 8 : bx;
    unsigned char* ws = p.ws;
    volatile LAS unsigned* MISC = (volatile LAS unsigned*)(lds + MISC_OFF);
    if (tid < 32) MISC[tid] = 0u;
    __syncthreads();
    XcdBarrier bar; bar.bar = (unsigned*)(ws + WS_CTL) + CW_BAR; bar.x = 0; bar.st = nullptr;
    const bool one = (p.ph_hi - p.ph_lo) > 1;
    if (one) bar = xcd_barrier_post((unsigned*)(ws + WS_CTL) + CW_BAR, MISC + 8);
    const int lo = __builtin_amdgcn_readfirstlane(p.ph_lo), hi = __builtin_amdgcn_readfirstlane(p.ph_hi);
#ifdef ONLY_PHASE
#define IN(k) ((k) == ONLY_PHASE && lo <= (k) && (k) < hi)
#else
#define IN(k) (lo <= (k) && (k) < hi)
#endif
#ifndef NAIVE_GEMM_MASK
#define NAIVE_GEMM_MASK 0
#endif
#define GEMM_CALL(EPI, SCHED) do { if constexpr (NAIVE_GEMM_MASK != 0) gemm_phase_naive<EPI, SCHED>(lds, g, S, E); else gemm_phase<EPI, SCHED, true>(lds, g, S, E); } while (0)
#ifndef ATTN_VAR
#define ATTN_VAR 0
#endif
#ifndef CONV_DIV
#define CONV_DIV 1
#endif
#ifndef CONV_NSL
#define CONV_NSL 4
#endif
#ifndef REPEAT_PHASE
#define REPEAT_PHASE (-1)
#endif
#define SEAM(k) do { if (!(((k) == 6 && HANDOFF67 != 0) || ((k) == 8 && HANDOFF89 != 0 && HANDOFF89_BAR == 0))) { if (IN(k) && IN((k) == 1 ? 3 : (k) + 1)) xcd_barrier(bar); } } while (0)

#define PHASE(k, ...) do { if (IN(k)) { if constexpr (REPEAT_PHASE == (k)) { __VA_ARGS__; xcd_barrier(bar); } __VA_ARGS__; } SEAM(k); } while (0)
    PHASE(0, phase_prologue(p, lds, vcu, G));
    PHASE(1, { GemmArgs g = (PROJ_FP8 != 0) ? GemmArgs{(const bf16_t*)(ws + WS_X1Q), 512, (const bf16_t*)(ws + WS_WIN), 512, 512}
                                          : GemmArgs{(const bf16_t*)(ws + WS_XB), 1024, (const bf16_t*)(ws + WS_WIN), 1024, 1024}; DenseSched S; S.init(lds, NTOK, PN, G, vcu);
        EpiProj E{ws}; GEMM_CALL(EpiProj, DenseSched); });
    PHASE(3, { { GemmArgs g{(const bf16_t*)(ws + WS_LAT), KUP, (const bf16_t*)(ws + WS_WUP), KUP, 256}; DenseSched S; S.init(lds, NTOK, 768, G, vcu);
          EpiUp E{(bf16_t*)(ws + WS_QM), (bf16_t*)(ws + WS_KM), (bf16_t*)(ws + WS_VM), (const float*)(ws + WS_RSTDP), (const float*)(ws + WS_ROPEA), 0, lds}; GEMM_CALL(EpiUp, DenseSched); }
        { GemmArgs g{(const bf16_t*)(ws + WS_LAT) + 256, KUP, (const bf16_t*)(ws + WS_WUP) + (size_t)768 * KUP + 256, KUP, 128}; DenseSched S; S.init(lds, NTOK, 1024, G, (vcu + 192) % G);
          EpiUp E{(bf16_t*)(ws + WS_QM), (bf16_t*)(ws + WS_KM), (bf16_t*)(ws + WS_VM), (const float*)(ws + WS_RSTDP), (const float*)(ws + WS_ROPEA), 24, lds}; GEMM_CALL(EpiUp, DenseSched); } });
    if constexpr (REPEAT_PHASE == 46) { if (IN(4)) { if (vcu % CONV_DIV == 0) conv_stream<CONV_NSL, 2>(p, (vcu / CONV_DIV) * NWAVES + (threadIdx.x >> 6), (G / CONV_DIV) * NWAVES, NEXP_ITEMS, lds + (threadIdx.x >> 6) * 16384, threadIdx.x & 63); xcd_barrier(bar); } }
    if constexpr (REPEAT_PHASE == 45) { if (IN(4)) { phase_attn_fast<ATTN_VAR>(p, lds, vcu, G, true); xcd_barrier(bar); } }
    if constexpr (REPEAT_PHASE == 44) { if (IN(4)) { phase_attn_fast<ATTN_VAR>(p, lds, vcu, G, false); xcd_barrier(bar); } }
    PHASE(4, phase_attn_fast<0>(p, lds, vcu, G, true));
    PHASE(5, { GemmArgs g = (WO_FP8 != 0) ? GemmArgs{(const bf16_t*)(ws + WS_ATT), 512, (const bf16_t*)(ws + WS_WO), 512, 512} : GemmArgs{(const bf16_t*)(ws + WS_ATT), 1024, (const bf16_t*)(ws + WS_WO), 1024, 1024}; DenseSched S; S.init(lds, NTOK, DM, G, vcu);
        EpiWo E{p.x, (float*)(ws + WS_X1PRE), (const bf16_t*)(ws + WS_XB)}; GEMM_CALL(EpiWo, DenseSched); });
    PHASE(6, phase_ln1_route(p, lds, vcu, G));
    PHASE(7, phase_assign(p, lds, vcu, G));
    PHASE(8, { if constexpr (GATEUP_FP8 == 2) { GemmArgs g{(const bf16_t*)(ws + WS_X1Q), 512, (const bf16_t*)(ws + WS_WGU), 512, 512};
            GroupSched<true> S; S.init(lds, (const int*)(ws + WS_TILEE), (const int*)(ws + WS_ROWTOK), 8, 2048, G, vcu);
            EpiGateUp E{(bf16_t*)(ws + WS_H), p.b_gate, p.b_up, (unsigned*)(ws + WS_CTL) + CW_RT}; GEMM_CALL(EpiGateUp, GroupSched<true>);
            if constexpr (HANDOFF89 != 0) { asm volatile("s_waitcnt vmcnt(0)" ::: "memory"); E.signal(__builtin_amdgcn_readfirstlane((int)(threadIdx.x >> 6)), (threadIdx.x & 63) == 0); } }
        else if constexpr (GATEUP_FP8 != 0) { GemmArgs g{(const bf16_t*)(ws + WS_X1Q), 512, (const bf16_t*)(ws + WS_WGU), 512, 512};
            GroupSched<true> S; S.bn = 128; S.split = 2; S.init(lds, (const int*)(ws + WS_TILEE), (const int*)(ws + WS_ROWTOK), 8, 2048, G, vcu);
            EpiGateUp8 E{(bf16_t*)(ws + WS_H), p.b_gate, p.b_up}; GEMM_CALL(EpiGateUp8, GroupSched<true>); }
        else { GemmArgs g{(const bf16_t*)(ws + WS_X1B), 1024, (const bf16_t*)(ws + WS_WGU), 1024, 1024}; GroupSched<true> S; S.init(lds, (const int*)(ws + WS_TILEE), (const int*)(ws + WS_ROWTOK), 8, 2048, G, vcu);
            EpiGateUp E{(bf16_t*)(ws + WS_H), p.b_gate, p.b_up}; GEMM_CALL(EpiGateUp, GroupSched<true>); } });
    PHASE(9, { GemmArgs g = (DOWN_FP8 != 0) ? GemmArgs{(const bf16_t*)(ws + WS_H), 512, (const bf16_t*)(ws + WS_WD), 512, 512}
                                           : GemmArgs{(const bf16_t*)(ws + WS_H), 1024, (const bf16_t*)(ws + WS_WD), 1024, 1024};
        constexpr bool DEP9 = (HANDOFF89 != 0); int c9 = vcu;
        if constexpr (DEP9) { const int rem = (__builtin_amdgcn_readfirstlane(((const int*)(ws + WS_TILEE))[MAXTILES]) * 8) % G; c9 = (vcu + G - rem) % G; }
        using Sched9 = GroupSched<false, DEP9>; Sched9 S; if (DOWN_FP8 == 1) { S.bn = 128; S.split = 2; } S.ready = (unsigned*)(ws + WS_CTL) + CW_RT;
        S.init(lds, (const int*)(ws + WS_TILEE), (const int*)(ws + WS_ROWTOK), 4, 1024, G, c9);
        EpiDown E{(bf16_t*)(ws + WS_Y), p.b_down, (const float*)(ws + WS_ROWGATE)}; GEMM_CALL(EpiDown, Sched9); });
    if (IN(10)) { if constexpr (REPEAT_PHASE == 10) { phase_final(p, vcu, G, (float*)(ws + WS_X1PRE)); xcd_barrier(bar); } phase_final(p, vcu, G, p.out); }
#undef IN
#undef SEAM
}

extern "C" void kernel_launch(void* const* d_in, const int* in_sizes, int n_in, void* d_out, int out_size, void* d_ws, size_t ws_size, hipStream_t stream) {
    static int grid = 0;
    if (grid == 0) {
        if (n_in != 20 || out_size != NTOK * DM || ws_size < WS_END) { fprintf(stderr, "kernel_launch: unexpected shapes (n_in %d out %d ws %zu)\n", n_in, out_size, ws_size); grid = -1; return; }
        int dev = 0, cus = 0, per_cu = 0;
        if (hipGetDevice(&dev) != hipSuccess || hipDeviceGetAttribute(&cus, hipDeviceAttributeMultiprocessorCount, dev) != hipSuccess) { grid = -1; return; }
        if (hipFuncSetAttribute((const void*)fwd_kernel, hipFuncAttributeMaxDynamicSharedMemorySize, LDS_BYTES) != hipSuccess) { fprintf(stderr, "kernel_launch: hipFuncSetAttribute failed\n"); grid = -1; return; }
        if (hipOccupancyMaxActiveBlocksPerMultiprocessor(&per_cu, (const void*)fwd_kernel, NTHREADS, LDS_BYTES) != hipSuccess || per_cu < 1) fprintf(stderr, "kernel_launch: occupancy query says %d\n", per_cu);
        (void)hipGetLastError();
        grid = cus;
    }
    if (grid < 0) return;
    (void)hipMemsetAsync((char*)d_ws + WS_CTL, 0, CTL_ZERO_BYTES, stream);
    Params p{};
    p.x = (const float*)d_in[0]; p.pos = (const int*)d_in[1]; p.w_in = (const float*)d_in[2]; p.q_a_norm = (const float*)d_in[3]; p.w_q_b = (const float*)d_in[4];
    p.kv_a_norm = (const float*)d_in[5]; p.w_kv_b = (const float*)d_in[6]; p.w_o = (const float*)d_in[7]; p.ln1_g = (const float*)d_in[8]; p.ln1_b = (const float*)d_in[9];
    p.w_router = (const float*)d_in[10]; p.b_router = (const float*)d_in[11]; p.w_gate = (const float*)d_in[12]; p.b_gate = (const float*)d_in[13];
    p.w_up = (const float*)d_in[14]; p.b_up = (const float*)d_in[15]; p.w_down = (const float*)d_in[16]; p.b_down = (const float*)d_in[17];
    p.ln2_g = (const float*)d_in[18]; p.ln2_b = (const float*)d_in[19];
    p.out = (float*)d_out; p.ws = (unsigned char*)d_ws;
    for (int i = 0; i < 16; ++i) p.invfA[i] = pow(500000.0, -(double)(2 * i) / 32.0);
    for (int i = 0; i < 8; ++i) p.invfB[i] = pow(500000.0, -(double)(2 * i) / 16.0);
#if MK_ONE_LAUNCH
    p.ph_lo = 0; p.ph_hi = NPHASE;
    hipLaunchKernelGGL(fwd_kernel, dim3(grid), dim3(NTHREADS), LDS_BYTES, stream, p);
#else
    for (int ph = 0; ph < NPHASE; ++ph) { p.ph_lo = ph; p.ph_hi = ph + 1; hipLaunchKernelGGL(fwd_kernel, dim3(grid), dim3(NTHREADS), LDS_BYTES, stream, p); }
#endif
}
```
